# Optimizing an MI355X kernel written in HIP

```python
import jax, jax.numpy as jnp
from jax import lax
import numpy as np

D_MODEL = 2048
BATCH = 8
SEQ = 2048
DEPTH = 2

HEAD_DIM = 128
DSA_HEADS = 6
SB_HEADS = 5
MOBA_HEADS = 5
N_HEADS = DSA_HEADS + SB_HEADS + MOBA_HEADS
MIX_WIDTH = N_HEADS * HEAD_DIM
IDX_HEADS = 16
IDX_DIM = 64
DSA_TOPK = 256
MOBA_BLOCK = 256
MOBA_TOPK = 3
Q_BLOCK = 128
MOBA_Q_BLOCK = 16
PEER_HEADS = 8
PEER_NKEYS = 128
PEER_EXPERTS = PEER_NKEYS * PEER_NKEYS
PEER_DKEY = 256
PEER_TOPK = 16
PEER_TOK_BLOCK = 128
ROPE_THETA = 10000.0
EPS = 1e-6
IN_SPLITS = (DSA_HEADS * HEAD_DIM, HEAD_DIM, HEAD_DIM,
             IDX_HEADS * IDX_DIM, IDX_DIM, IDX_HEADS,
             SB_HEADS * HEAD_DIM, SB_HEADS * HEAD_DIM, SB_HEADS * HEAD_DIM,
             MOBA_HEADS * HEAD_DIM, MOBA_HEADS * HEAD_DIM, MOBA_HEADS * HEAD_DIM)
IN_WIDTH = sum(IN_SPLITS)

kernel_name = 'hybrid_dsa_stickbreak_moba_peer_adaln'


def _rmsnorm(x, g):
    xf = x.astype(jnp.float32)
    y = xf * lax.rsqrt(jnp.mean(xf * xf, axis=-1, keepdims=True) + EPS)
    return (y * g.astype(jnp.float32)).astype(x.dtype)


def _rope(x):
    S, d = x.shape[1], x.shape[-1]
    half = d // 2
    inv = ROPE_THETA ** (-jnp.arange(half, dtype=jnp.float32) / half)
    ang = jnp.arange(S, dtype=jnp.float32)[:, None] * inv[None, :]
    cos = jnp.cos(ang)[None, :, None, :]
    sin = jnp.sin(ang)[None, :, None, :]
    xf = x.astype(jnp.float32)
    x1, x2 = xf[..., :half], xf[..., half:]
    return jnp.concatenate([x1 * cos - x2 * sin, x2 * cos + x1 * sin], axis=-1).astype(x.dtype)


def _unblock(y):
    n, B, T = y.shape[:3]
    return jnp.moveaxis(y, 0, 1).reshape(B, n * T, -1)


def _dsa_attention(q, k, v, iq, ik, iw):
    B, S, H, d = q.shape
    topk = min(DSA_TOPK, S // 4)
    kpos = jnp.arange(S)
    idx_scale = IDX_DIM ** -0.5
    w_scale = IDX_HEADS ** -0.5

    def block(i):
        t0 = i * Q_BLOCK
        qb = lax.dynamic_slice_in_dim(q, t0, Q_BLOCK, axis=1)
        iqb = lax.dynamic_slice_in_dim(iq, t0, Q_BLOCK, axis=1)
        iwb = lax.dynamic_slice_in_dim(iw, t0, Q_BLOCK, axis=1)
        qpos = t0 + jnp.arange(Q_BLOCK)
        rel = jax.nn.relu(jnp.einsum('bthe,bse->bths', iqb, ik).astype(jnp.float32) * idx_scale)
        score = jnp.einsum('bth,bths->bts', iwb.astype(jnp.float32) * w_scale, rel)
        score = jnp.where(kpos[None, None, :] <= qpos[None, :, None], score, -jnp.inf)
        _, sel = lax.top_k(score, topk)
        valid = sel <= qpos[None, :, None]
        kg = jax.vmap(lambda kk, ss: kk[ss])(k, sel)
        vg = jax.vmap(lambda vv, ss: vv[ss])(v, sel)
        s = jnp.einsum('bthd,btkd->bthk', qb, kg).astype(jnp.float32) * d ** -0.5
        s = jnp.where(valid[:, :, None, :], s, -jnp.inf)
        p = jax.nn.softmax(s, axis=-1).astype(v.dtype)
        return jnp.einsum('bthk,btkd->bthd', p, vg)

    return _unblock(lax.map(block, jnp.arange(S // Q_BLOCK)))


def _stick_breaking_attention(q, k, v):
    B, S, H, d = q.shape
    kpos = jnp.arange(S)

    def block(i):
        t0 = i * Q_BLOCK
        qb = lax.dynamic_slice_in_dim(q, t0, Q_BLOCK, axis=1)
        qpos = t0 + jnp.arange(Q_BLOCK)
        z = jnp.einsum('bthd,bshd->bhts', qb, k).astype(jnp.float32) * d ** -0.5
        strict = kpos[None, :] < qpos[:, None]
        log_keep = jnp.where(strict, jax.nn.log_sigmoid(-z), 0.0)
        log_between = lax.cumsum(log_keep, axis=3, reverse=True) - log_keep
        a = jnp.where(strict, jnp.exp(jax.nn.log_sigmoid(z) + log_between), 0.0)
        return jnp.einsum('bhts,bshd->bthd', a.astype(v.dtype), v)

    return _unblock(lax.map(block, jnp.arange(S // Q_BLOCK)))


def _moba_attention(q, k, v):
    B, S, H, d = q.shape
    nkb = -(-S // MOBA_BLOCK)
    pad = nkb * MOBA_BLOCK - S

    def to_blocks(t):
        t = jnp.pad(t, ((0, 0), (0, pad), (0, 0), (0, 0)))
        return t.reshape(B, nkb, MOBA_BLOCK, H, d).transpose(0, 3, 1, 2, 4)

    kb, vb = to_blocks(k), to_blocks(v)
    kmean = jnp.mean(kb.astype(jnp.float32), axis=3)
    topk = min(MOBA_TOPK, nkb - 1)
    scale = d ** -0.5
    blk_pos = jnp.arange(MOBA_BLOCK)
    bi = jnp.arange(B)[:, None, None, None]
    hi = jnp.arange(H)[None, :, None, None]

    def block(i):
        t0 = i * MOBA_Q_BLOCK
        qb = lax.dynamic_slice_in_dim(q, t0, MOBA_Q_BLOCK, axis=1).transpose(0, 2, 1, 3)
        qpos = t0 + jnp.arange(MOBA_Q_BLOCK)
        own = t0 // MOBA_BLOCK
        k_own = lax.dynamic_index_in_dim(kb, own, axis=2, keepdims=False)
        v_own = lax.dynamic_index_in_dim(vb, own, axis=2, keepdims=False)
        s_own = jnp.einsum('bhtd,bhpd->bhtp', qb, k_own).astype(jnp.float32) * scale
        s_own = jnp.where(own * MOBA_BLOCK + blk_pos[None, :] <= qpos[:, None], s_own, -jnp.inf)
        if topk == 0:
            p_own = jax.nn.softmax(s_own, axis=-1).astype(v.dtype)
            out = jnp.einsum('bhtp,bhpd->bhtd', p_own, v_own)
        else:
            gate = jnp.einsum('bhtd,bhnd->bhtn', qb.astype(jnp.float32), kmean)
            gate = jnp.where(jnp.arange(nkb) < own, gate, -jnp.inf)
            _, sel = lax.top_k(gate, topk)
            valid = sel < own
            kg = kb[bi, hi, sel]
            vg = vb[bi, hi, sel]
            s_sel = jnp.einsum('bhtd,bhtkpd->bhtkp', qb, kg).astype(jnp.float32) * scale
            s_sel = jnp.where(valid[..., None], s_sel, -jnp.inf)
            n_sel = topk * MOBA_BLOCK
            s_all = jnp.concatenate([s_sel.reshape(B, H, MOBA_Q_BLOCK, n_sel), s_own], axis=-1)
            p = jax.nn.softmax(s_all, axis=-1).astype(v.dtype)
            p_sel = p[..., :n_sel].reshape(B, H, MOBA_Q_BLOCK, topk, MOBA_BLOCK)
            out = (jnp.einsum('bhtkp,bhtkpd->bhtd', p_sel, vg)
                   + jnp.einsum('bhtp,bhpd->bhtd', p[..., n_sel:], v_own))
        return out.transpose(0, 2, 1, 3)

    return _unblock(lax.map(block, jnp.arange(S // MOBA_Q_BLOCK)))


def _mixer(h, w_in, out_g, w_out):
    B, S, _ = h.shape
    offsets = np.cumsum(IN_SPLITS)[:-1].tolist()
    q_a, k_a, v_a, iq, ik, iw, q_b, k_b, v_b, q_c, k_c, v_c = jnp.split(h @ w_in, offsets, axis=-1)
    heads = lambda t, n: t.reshape(B, S, n, -1)
    y_a = _dsa_attention(_rope(heads(q_a, DSA_HEADS)), _rope(k_a[:, :, None, :])[:, :, 0], v_a,
                         _rope(heads(iq, IDX_HEADS)), _rope(ik[:, :, None, :])[:, :, 0], iw)
    y_b = _stick_breaking_attention(heads(q_b, SB_HEADS), heads(k_b, SB_HEADS), heads(v_b, SB_HEADS))
    y_c = _moba_attention(_rope(heads(q_c, MOBA_HEADS)), _rope(heads(k_c, MOBA_HEADS)), heads(v_c, MOBA_HEADS))
    y = jnp.concatenate([y_a, y_b, y_c], axis=-1).reshape(B, S, N_HEADS, HEAD_DIM)
    y = _rmsnorm(y, out_g.reshape(N_HEADS, HEAD_DIM)).reshape(B, S, MIX_WIDTH)
    return y @ w_out


def _peer(h, w_q, sub_keys, expert_u, expert_v):
    B, S, D = h.shape
    T = B * S
    ht = h.reshape(T, D)
    q = (ht @ w_q).reshape(T, PEER_HEADS, 2, PEER_DKEY // 2)
    s = jnp.einsum('tpce,pcne->tpcn', q, sub_keys).astype(jnp.float32)
    sv, si = lax.top_k(s, PEER_TOPK)
    cand_s = (sv[:, :, 0, :, None] + sv[:, :, 1, None, :]).reshape(T, PEER_HEADS, PEER_TOPK * PEER_TOPK)
    cand_i = (si[:, :, 0, :, None] * PEER_NKEYS + si[:, :, 1, None, :]).reshape(T, PEER_HEADS, PEER_TOPK * PEER_TOPK)
    top_s, pick = lax.top_k(cand_s, PEER_TOPK)
    experts = jnp.take_along_axis(cand_i, pick, axis=-1)
    gates = jax.nn.softmax(top_s, axis=-1).astype(h.dtype)
    nb = T // PEER_TOK_BLOCK

    def block(args):
        xb, eb, gb = args
        act = jax.nn.gelu(jnp.einsum('td,tpkd->tpk', xb, expert_u[eb]), approximate=False)
        return jnp.einsum('tpk,tpkd->td', gb * act, expert_v[eb])

    out = lax.map(block, (ht.reshape(nb, PEER_TOK_BLOCK, D),
                          experts.reshape(nb, PEER_TOK_BLOCK, PEER_HEADS, PEER_TOPK),
                          gates.reshape(nb, PEER_TOK_BLOCK, PEER_HEADS, PEER_TOPK)))
    return out.reshape(B, S, D)


def setup_inputs(seed: int = 0) -> dict:
    key = jax.random.key(seed)
    ks = jax.random.split(key, 14)
    nrm = lambda k, shape, s: jax.random.normal(k, shape, jnp.float32) * s
    return {
        'x': nrm(ks[0], (BATCH, SEQ, D_MODEL), 1.0),
        'c': nrm(ks[1], (BATCH, D_MODEL), 1.0),
        'ada_w': nrm(ks[2], (DEPTH, D_MODEL, 6 * D_MODEL), 0.3 * D_MODEL ** -0.5),
        'ada_b': nrm(ks[3], (DEPTH, 6 * D_MODEL), 0.02),
        'norm1_g': 1.0 + nrm(ks[4], (DEPTH, D_MODEL), 0.02),
        'norm2_g': 1.0 + nrm(ks[5], (DEPTH, D_MODEL), 0.02),
        'w_in': nrm(ks[6], (DEPTH, D_MODEL, IN_WIDTH), D_MODEL ** -0.5),
        'out_norm_g': 1.0 + nrm(ks[7], (DEPTH, MIX_WIDTH), 0.02),
        'w_out': nrm(ks[8], (DEPTH, MIX_WIDTH, D_MODEL), MIX_WIDTH ** -0.5),
        'peer_wq': nrm(ks[9], (DEPTH, D_MODEL, PEER_HEADS * PEER_DKEY), D_MODEL ** -0.5),
        'peer_subkeys': nrm(ks[10], (DEPTH, PEER_HEADS, 2, PEER_NKEYS, PEER_DKEY // 2), (PEER_DKEY // 2) ** -0.5),
        'peer_u': nrm(ks[11], (DEPTH, PEER_EXPERTS, D_MODEL), D_MODEL ** -0.5),
        'peer_v': nrm(ks[12], (DEPTH, PEER_EXPERTS, D_MODEL), 0.5),
        'final_g': 1.0 + nrm(ks[13], (D_MODEL,), 0.02),
    }


def reference(x, c, ada_w, ada_b, norm1_g, norm2_g, w_in, out_norm_g, w_out,
              peer_wq, peer_subkeys, peer_u, peer_v, final_g):
    cond = jax.nn.silu(c)
    for l in range(DEPTH):
        mod = (cond @ ada_w[l] + ada_b[l])[:, None, :]
        shift1, scale1, gate1, shift2, scale2, gate2 = jnp.split(mod, 6, axis=-1)
        h = _rmsnorm(x, norm1_g[l]) * (1 + scale1) + shift1
        x = x + gate1 * _mixer(h, w_in[l], out_norm_g[l], w_out[l])
        h = _rmsnorm(x, norm2_g[l]) * (1 + scale2) + shift2
        x = x + gate2 * _peer(h, peer_wq[l], peer_subkeys[l], peer_u[l], peer_v[l])
    return _rmsnorm(x, final_g)
```

```cpp
#include <hip/hip_runtime.h>
#include <hip/hip_cooperative_groups.h>
#include <cstdio>
#include <cstdint>
namespace cg = cooperative_groups;

#define LAS __attribute__((address_space(3)))
typedef _Float16 f16;
typedef _Float16 h2_t __attribute__((ext_vector_type(2)));
typedef _Float16 h4_t __attribute__((ext_vector_type(4)));
typedef _Float16 h8_t __attribute__((ext_vector_type(8)));
typedef float f32x4 __attribute__((ext_vector_type(4)));
typedef unsigned u32x4 __attribute__((ext_vector_type(4)));
typedef unsigned u32x2 __attribute__((ext_vector_type(2)));

constexpr int NB = 8, SEQ = 2048, DM = 2048, NT = NB * SEQ, DEPTH = 2;
constexpr int HD = 128, HA = 6, HB = 5, HC = 5, NHEADS = 16;
constexpr int IH = 16, IDM = 64, DSA_TOPK = 256;
constexpr int MOBA_BLK = 256, MOBA_NB = 8;
constexpr int INW = 5968, INWP = 6144;
constexpr int PH = 8, PNK = 128, PTOPK = 16, PEXP = 16384;
constexpr float EPS = 1e-6f;
constexpr int C_QA = 0, C_KA = 768, C_VA = 896, C_IQ = 1024, C_IK = 2048, C_IW = 2112, C_QB = 2176, C_KB = 2816, C_VB = 3456,
              C_QC = 4096, C_KC = 4736, C_VC = 5376, C_END = 6016;

constexpr int NTHREADS = 512, NWAVES = 8;
constexpr int LDS_BYTES = 147456;

constexpr size_t al256(size_t x) { return (x + 255) & ~(size_t)255; }
constexpr size_t WS_WTIN = 0;
constexpr size_t WS_WTOUT = WS_WTIN + (size_t)DEPTH * INWP * DM * 2;
constexpr size_t WS_WTQ = WS_WTOUT + (size_t)DEPTH * DM * DM * 2;
constexpr size_t WS_U16 = WS_WTQ + (size_t)DEPTH * DM * DM * 2;
constexpr size_t WS_V16 = WS_U16 + (size_t)DEPTH * PEXP * DM * 2;
constexpr size_t WS_SUBK = WS_V16 + (size_t)DEPTH * PEXP * DM * 2;
constexpr size_t WS_MOD = WS_SUBK + (size_t)DEPTH * PH * 2 * PNK * 128 * 2;
constexpr size_t WS_ROPE128 = WS_MOD + (size_t)DEPTH * NB * 6 * DM * 4;
constexpr size_t WS_ROPE64 = WS_ROPE128 + (size_t)SEQ * 64 * 8;
constexpr size_t WS_H = WS_ROPE64 + (size_t)SEQ * 32 * 8;
constexpr size_t WS_PROJ = WS_H + (size_t)NT * DM * 2;
constexpr size_t WS_KMEAN = WS_PROJ + (size_t)NT * INWP * 2;
constexpr size_t WS_MASK = WS_KMEAN + al256((size_t)NB * HC * MOBA_NB * HD * 4);
constexpr size_t WS_Y = WS_MASK + (size_t)NB * SEQ * 64 * 4;
constexpr size_t WS_X1 = WS_Y + (size_t)NT * DM * 2;
constexpr size_t WS_PE = WS_X1 + (size_t)NT * DM * 4;
constexpr size_t WS_PG = WS_PE + (size_t)NT * 128 * 4;
constexpr size_t WS_END = WS_PG + (size_t)NT * 128 * 4;

struct Params {
    const float *x, *c, *ada_w, *ada_b, *n1g, *n2g, *w_in, *ong, *w_out, *wq, *subk, *pu, *pv, *fg;
    float* out;
    unsigned char* ws;
    int ph_lo, ph_hi;
};

__device__ __forceinline__ int otid() { int t = threadIdx.x; asm volatile("" : "+v"(t)); return t; }
__device__ __forceinline__ int obid() { int t = blockIdx.x; asm volatile("" : "+s"(t)); return t; }
__device__ __forceinline__ float wave_sum(float v) {
#pragma unroll
    for (int o = 32; o >= 1; o >>= 1) v += __shfl_xor(v, o);
    return v;
}
__device__ __forceinline__ float wave_max(float v) {
#pragma unroll
    for (int o = 32; o >= 1; o >>= 1) v = fmaxf(v, __shfl_xor(v, o));
    return v;
}
__device__ __forceinline__ unsigned pack_h2(float a, float b) { h2_t r; r.x = (f16)a; r.y = (f16)b; return __builtin_bit_cast(unsigned, r); }
__device__ __forceinline__ float h_lo(unsigned u) { h2_t r = __builtin_bit_cast(h2_t, u); return (float)r.x; }
__device__ __forceinline__ float h_hi(unsigned u) { h2_t r = __builtin_bit_cast(h2_t, u); return (float)r.y; }
__device__ __forceinline__ float dot2(unsigned a, unsigned b, float c) {
    return __builtin_amdgcn_fdot2(__builtin_bit_cast(h2_t, a), __builtin_bit_cast(h2_t, b), c, false);
}

namespace pg8 {
constexpr int BM = 256, BK = 64, HALF = 128, HTB = HALF * BK * 2, STAGE_BYTES = 8 * HTB, NXCD = 8, WGM = 8;
__host__ __device__ __forceinline__ int lds_byte(int r, int c) { const int st = (r >> 4) * 2 + (c >> 5), rr = r & 15, cc = c & 31, ob = rr * 64 + cc * 2; return st * 1024 + (ob ^ (((ob >> 9) & 1) << 5)); }
__host__ __device__ __forceinline__ void stage_rc(int b, int& R, int& C) { const int st = b / 1024, sb = b % 1024, swz = sb ^ (((sb >> 9) & 1) << 5); R = (st >> 1) * 16 + swz / 64; C = (st & 1) * 32 + (swz % 64) / 2; }
struct Unit { int pm, pn; };
struct Gemm { const unsigned short* A; const unsigned short* Bt; int M, N, K; };
struct StaticOrder {
    int nM, nN, nwg, G, c;
    __host__ __device__ void init(int M, int N, int G_, int c_) { nM = M / BM; nN = N / BM; nwg = nM * nN; G = G_; c = c_; }
    __host__ __device__ bool next(int i, Unit& u) const {
        const long L = (long)i * G + c; if (L >= nwg) return false;
        int wgid = (int)L; { const int q = nwg / NXCD, r = nwg % NXCD, xcd = wgid % NXCD, off = wgid / NXCD; wgid = (xcd < r ? xcd * (q + 1) : r * (q + 1) + (xcd - r) * q) + off; }
        const int nig = WGM * nN, gid = wgid / nig, fm = gid * WGM, gsz = (nM - fm) < WGM ? (nM - fm) : WGM;
        u.pm = fm + ((wgid % nig) % gsz); u.pn = (wgid % nig) / gsz; return true;
    }
};

template <class Epi>
__device__ __forceinline__ void gemm_phase(LAS unsigned char* lds, const Gemm g, const StaticOrder& S, const Epi& E) {
    const int tid = otid(), wid = __builtin_amdgcn_readfirstlane(tid >> 6), lane = tid & 63, wr = wid >> 2, wc = wid & 3, fr = lane & 15, fq = lane >> 4;
    const int K = g.K, nt = K / BK;
    unsigned voffA[2], voffB[2];
#pragma unroll
    for (int i = 0; i < 2; ++i) { int R, C; stage_rc(tid * 16 + i * 8192, R, C); voffA[i] = (unsigned)(R * K + C) * 2u; voffB[i] = (unsigned)(R * K + C) * 2u; }
    const size_t kstep = (size_t)(BK * 2);
    const size_t hstep = (size_t)HALF * K * 2;
    const size_t tstep = 2 * hstep;
    const unsigned ldsw = (unsigned)wid * 1024u;
    const int aoff = lds_byte(wr * 64 + fr, fq * 8), boff = lds_byte(wc * 32 + fr, fq * 8);
#define PG8_SA(b, h) (((b) * 2 + (h)) * HTB)
#define PG8_SB(b, h) ((4 + (b) * 2 + (h)) * HTB)
#define PG8_STAGE(bufoff, gbase, voff) do { _Pragma("unroll") for (int _i = 0; _i < 2; ++_i) \
        __builtin_amdgcn_global_load_lds((const unsigned*)((const char*)(gbase) + (voff)[_i]), (LAS unsigned*)(lds + (bufoff) + ldsw + _i * 8192), 16, 0, 0); } while (0)
#define PG8_LDA(dst, b, h) do { _Pragma("unroll") for (int m = 0; m < 4; ++m) _Pragma("unroll") for (int k = 0; k < 2; ++k) dst[m][k] = *(const LAS h8_t*)(lds + PG8_SA(b, h) + aoff + m * 2048 + k * 1024); } while (0)
#define PG8_LDB(dst, b, h) do { _Pragma("unroll") for (int n = 0; n < 2; ++n) _Pragma("unroll") for (int k = 0; k < 2; ++k) dst[n][k] = *(const LAS h8_t*)(lds + PG8_SB(b, h) + boff + n * 2048 + k * 1024); } while (0)
#define PG8_MMA(ai, bj, At, Bt) do { __builtin_amdgcn_s_setprio(1); _Pragma("unroll") for (int m = 0; m < 4; ++m) _Pragma("unroll") for (int n = 0; n < 2; ++n) _Pragma("unroll") for (int k = 0; k < 2; ++k) \
        acc[ai][bj][m][n] = __builtin_amdgcn_mfma_f32_16x16x32_f16(Bt[n][k], At[m][k], acc[ai][bj][m][n], 0, 0, 0); __builtin_amdgcn_s_setprio(0); } while (0)
#define PG8_WAIT_V(n) asm volatile("s_waitcnt vmcnt(" #n ")" ::: "memory")
#define PG8_WAIT_L(n) asm volatile("s_waitcnt lgkmcnt(" #n ")" ::: "memory")
#define PG8_BAR __builtin_amdgcn_s_barrier()
#define PG8_SCHED __builtin_amdgcn_sched_barrier(0)
    Unit cur, nxt; int ui = 0;
    if (!S.next(0, cur)) return;
    f32x4 acc[2][2][4][2];
#pragma unroll
    for (int a = 0; a < 2; ++a)
#pragma unroll
        for (int b = 0; b < 2; ++b)
#pragma unroll
            for (int m = 0; m < 4; ++m)
#pragma unroll
                for (int n = 0; n < 2; ++n) acc[a][b][m][n] = (f32x4){0.f, 0.f, 0.f, 0.f};
    h8_t At[4][2], B0[2][2], B1[2][2];
    const char* cA = (const char*)g.A + (size_t)cur.pm * tstep; const char* cB = (const char*)g.Bt + (size_t)cur.pn * tstep;
    PG8_STAGE(PG8_SB(0, 0), cB, voffB); PG8_STAGE(PG8_SA(0, 0), cA, voffA); PG8_STAGE(PG8_SB(0, 1), cB + hstep, voffB); PG8_STAGE(PG8_SA(0, 1), cA + hstep, voffA);
    if (wr == 1) PG8_BAR;
    PG8_WAIT_V(4); PG8_BAR;
    PG8_STAGE(PG8_SB(1, 0), cB + kstep, voffB); PG8_STAGE(PG8_SA(1, 0), cA + kstep, voffA); PG8_STAGE(PG8_SB(1, 1), cB + hstep + kstep, voffB);
    PG8_WAIT_V(6); PG8_BAR;
    for (;;) {
        const bool has_next = S.next(ui + 1, nxt);
        const char* nA = has_next ? (const char*)g.A + (size_t)nxt.pm * tstep : cA; const char* nB = has_next ? (const char*)g.Bt + (size_t)nxt.pn * tstep : cB;
        for (int t = 0; t < nt; t += 2) {
            const bool last = (t == nt - 2);
            const char* a1 = cA + (size_t)(t + 1) * kstep;
            const char* a2 = last ? nA : cA + (size_t)(t + 2) * kstep; const char* b2 = last ? nB : cB + (size_t)(t + 2) * kstep;
            const char* a3 = a2 + kstep; const char* b3 = b2 + kstep;
            PG8_LDB(B0, 0, 0); PG8_SCHED; PG8_LDA(At, 0, 0); PG8_STAGE(PG8_SA(1, 1), a1 + hstep, voffA);
            PG8_WAIT_L(8); PG8_BAR; PG8_WAIT_L(0); PG8_MMA(0, 0, At, B0); PG8_BAR; PG8_SCHED;
            PG8_LDB(B1, 0, 1); PG8_STAGE(PG8_SB(0, 0), b2, voffB);
            PG8_BAR; PG8_WAIT_L(0); PG8_MMA(0, 1, At, B1); PG8_BAR;
            PG8_LDA(At, 0, 1); PG8_STAGE(PG8_SA(0, 0), a2, voffA);
            PG8_BAR; PG8_WAIT_L(0); PG8_MMA(1, 0, At, B0); PG8_BAR; PG8_SCHED;
            PG8_STAGE(PG8_SB(0, 1), b2 + hstep, voffB);
            PG8_WAIT_V(6); PG8_BAR; PG8_MMA(1, 1, At, B1); PG8_BAR;
            PG8_LDB(B0, 1, 0); PG8_SCHED; PG8_LDA(At, 1, 0); PG8_STAGE(PG8_SA(0, 1), a2 + hstep, voffA);
            PG8_WAIT_L(8); PG8_BAR; PG8_WAIT_L(0); PG8_MMA(0, 0, At, B0); PG8_BAR; PG8_SCHED;
            PG8_LDB(B1, 1, 1); PG8_STAGE(PG8_SB(1, 0), b3, voffB);
            PG8_BAR; PG8_WAIT_L(0); PG8_MMA(0, 1, At, B1); PG8_BAR;
            PG8_LDA(At, 1, 1); PG8_STAGE(PG8_SA(1, 0), a3, voffA);
            PG8_BAR; PG8_WAIT_L(0); PG8_MMA(1, 0, At, B0); PG8_BAR; PG8_SCHED;
            PG8_STAGE(PG8_SB(1, 1), b3 + hstep, voffB);
            PG8_WAIT_V(6); PG8_BAR; PG8_MMA(1, 1, At, B1); PG8_BAR;
        }
        E(acc, cur, wr, wc, fr, fq);
        if (!has_next) break;
#pragma unroll
        for (int a = 0; a < 2; ++a)
#pragma unroll
            for (int b = 0; b < 2; ++b)
#pragma unroll
                for (int m = 0; m < 4; ++m)
#pragma unroll
                    for (int n = 0; n < 2; ++n) acc[a][b][m][n] = (f32x4){0.f, 0.f, 0.f, 0.f};
        cur = nxt; cA = nA; cB = nB; ++ui;
    }
    PG8_WAIT_V(0);
    if (wr == 0) PG8_BAR;
    PG8_BAR;
#undef PG8_SA
#undef PG8_SB
#undef PG8_STAGE
#undef PG8_LDA
#undef PG8_LDB
#undef PG8_MMA
#undef PG8_WAIT_V
#undef PG8_WAIT_L
#undef PG8_BAR
#undef PG8_SCHED
}
}

struct Epi {
    int mode; f16* o16; int ldc; float* o32; const float* xin; const float* gate;
    __device__ __forceinline__ void operator()(const f32x4 (&acc)[2][2][4][2], const pg8::Unit& u, int wr, int wc, int fr, int fq) const {
        const int row0 = u.pm * 256 + wr * 64 + fr, col0 = u.pn * 256 + wc * 32 + 4 * fq;
#pragma unroll
        for (int ai = 0; ai < 2; ++ai)
#pragma unroll
            for (int m = 0; m < 4; ++m) {
                const int row = row0 + ai * 128 + m * 16;
#pragma unroll
                for (int bj = 0; bj < 2; ++bj)
#pragma unroll
                    for (int n = 0; n < 2; ++n) {
                        const int col = col0 + bj * 128 + n * 16;
                        const f32x4 v = acc[ai][bj][m][n];
                        if (mode == 0) {
                            u32x2 w; w.x = pack_h2(v[0], v[1]); w.y = pack_h2(v[2], v[3]);
                            *(u32x2*)(o16 + (size_t)row * ldc + col) = w;
                        } else {
                            const int b = row / SEQ;
                            const f32x4 xi = *(const f32x4*)(xin + (size_t)row * DM + col);
                            const f32x4 gt = *(const f32x4*)(gate + (size_t)b * 6 * DM + col);
                            *(f32x4*)(o32 + (size_t)row * DM + col) = xi + gt * v;
                        }
                    }
            }
    }
};

__device__ __forceinline__ void gemm_run(const Params& p, LAS unsigned char* lds, const f16* A, const f16* Bt, int N, const Epi& E) {
    pg8::Gemm g; g.A = (const unsigned short*)A; g.Bt = (const unsigned short*)Bt; g.M = NT; g.N = N; g.K = DM;
    pg8::StaticOrder S; S.init(NT, N, (int)gridDim.x, (int)blockIdx.x);
    pg8::gemm_phase<Epi>(lds, g, S, E);
}

__device__ __forceinline__ int win_src_col(int pc) { return pc < 2128 ? pc : (pc < C_QB ? -1 : (pc < C_END ? pc - 48 : -1)); }

__device__ __forceinline__ void transpose_tiles(const float* src, int ldsrc, int ncols_phys, bool is_win, f16* dst, float* tile  , int& unit_base, int unit_lo) {
    const int tn = ncols_phys / 64, tk = DM / 64, ntile = tn * tk;
    const int tid = otid();
    for (int u = blockIdx.x; u < ntile; u += gridDim.x) {
        const int n0 = (u % tn) * 64, k0 = (u / tn) * 64;
        __syncthreads();
#pragma unroll
        for (int i = 0; i < 8; ++i) {
            const int e = tid + i * 512, r = e >> 6, c = e & 63;
            const int pc = n0 + c; const int sc = is_win ? win_src_col(pc) : pc;
            tile[r * 65 + c] = sc >= 0 ? src[(size_t)(k0 + r) * ldsrc + sc] : 0.f;
        }
        __syncthreads();
        {
            const int n = tid >> 3, kq = (tid & 7) * 8;
            u32x4 w;
            w.x = pack_h2(tile[(kq + 0) * 65 + n], tile[(kq + 1) * 65 + n]); w.y = pack_h2(tile[(kq + 2) * 65 + n], tile[(kq + 3) * 65 + n]);
            w.z = pack_h2(tile[(kq + 4) * 65 + n], tile[(kq + 5) * 65 + n]); w.w = pack_h2(tile[(kq + 6) * 65 + n], tile[(kq + 7) * 65 + n]);
            *(u32x4*)(dst + (size_t)(n0 + n) * DM + k0 + kq) = w;
        }
    }
    (void)unit_base; (void)unit_lo;
}

__device__ __forceinline__ void cvt_f16_stream(const float* src, f16* dst, size_t n) {
    const size_t stride = (size_t)gridDim.x * NTHREADS;
    for (size_t i = (size_t)blockIdx.x * NTHREADS + otid(); i < n / 8; i += stride) {
        const f32x4 a = *(const f32x4*)(src + i * 8), b = *(const f32x4*)(src + i * 8 + 4);
        u32x4 w; w.x = pack_h2(a[0], a[1]); w.y = pack_h2(a[2], a[3]); w.z = pack_h2(b[0], b[1]); w.w = pack_h2(b[2], b[3]);
        *(u32x4*)(dst + i * 8) = w;
    }
}

__device__ __forceinline__ void phase_conv(const Params& p, LAS unsigned char* lds_) {
    float* smem = (float*)(unsigned char*)lds_;
    unsigned char* ws = p.ws;
    const int tid = otid();
    int dummy = 0;
    {
        float* cond = smem;
        float* red = smem + NB * DM;
        for (int i = tid; i < NB * DM; i += NTHREADS) { const float v = p.c[i]; cond[i] = v / (1.f + __expf(-v)); }
        __syncthreads();
        for (int u = blockIdx.x; u < DEPTH * 128; u += gridDim.x) {
            const int l = u >> 7, j0 = (u & 127) * 96;
            const int col = tid % 96, kg = tid / 96;
            float acc[NB];
#pragma unroll
            for (int b = 0; b < NB; ++b) acc[b] = 0.f;
            if (kg < 5) {
                const float* wp = p.ada_w + (size_t)l * DM * 6 * DM + j0 + col;
                for (int k = kg; k < DM; k += 5) {
                    const float w = wp[(size_t)k * 6 * DM];
#pragma unroll
                    for (int b = 0; b < NB; ++b) acc[b] += cond[b * DM + k] * w;
                }
#pragma unroll
                for (int b = 0; b < NB; ++b) red[(kg * NB + b) * 96 + col] = acc[b];
            }
            __syncthreads();
            for (int i = tid; i < NB * 96; i += NTHREADS) {
                const int b = i / 96, cc = i % 96;
                float s = p.ada_b[(size_t)l * 6 * DM + j0 + cc];
#pragma unroll
                for (int g = 0; g < 5; ++g) s += red[(g * NB + b) * 96 + cc];
                ((float*)(ws + WS_MOD))[((size_t)l * NB + b) * 6 * DM + j0 + cc] = s;
            }
            __syncthreads();
        }
    }
    {
        float2* r128 = (float2*)(ws + WS_ROPE128); float2* r64 = (float2*)(ws + WS_ROPE64);
        for (int i = blockIdx.x * NTHREADS + tid; i < SEQ * 64; i += gridDim.x * NTHREADS) {
            const int pos = i >> 6, j = i & 63;
            const float inv = powf(10000.f, -(float)j / 64.f); const float ang = (float)pos * inv;
            r128[i] = make_float2((float)cos((double)ang), (float)sin((double)ang));
        }
        for (int i = blockIdx.x * NTHREADS + tid; i < SEQ * 32; i += gridDim.x * NTHREADS) {
            const int pos = i >> 5, j = i & 31;
            const float inv = powf(10000.f, -(float)j / 32.f); const float ang = (float)pos * inv;
            r64[i] = make_float2((float)cos((double)ang), (float)sin((double)ang));
        }
    }
    __syncthreads();
    for (int l = 0; l < DEPTH; ++l) {
        transpose_tiles(p.w_in + (size_t)l * DM * INW, INW, INWP, true, (f16*)(ws + WS_WTIN) + (size_t)l * INWP * DM, smem, dummy, 0);
        transpose_tiles(p.w_out + (size_t)l * DM * DM, DM, DM, false, (f16*)(ws + WS_WTOUT) + (size_t)l * DM * DM, smem, dummy, 0);
        transpose_tiles(p.wq + (size_t)l * DM * DM, DM, DM, false, (f16*)(ws + WS_WTQ) + (size_t)l * DM * DM, smem, dummy, 0);
    }
    cvt_f16_stream(p.pu, (f16*)(ws + WS_U16), (size_t)DEPTH * PEXP * DM);
    cvt_f16_stream(p.pv, (f16*)(ws + WS_V16), (size_t)DEPTH * PEXP * DM);
    cvt_f16_stream(p.subk, (f16*)(ws + WS_SUBK), (size_t)DEPTH * PH * 2 * PNK * 128);
}

__device__ __forceinline__ void phase_norm(const Params& p, const float* xin, const float* g, const float* shift, const float* scale, f16* hout) {
    const int tid_ = otid(); const int wid = tid_ >> 6, lane = tid_ & 63;
    for (int row = blockIdx.x * NWAVES + wid; row < NT; row += gridDim.x * NWAVES) {
        const int b = row / SEQ;
        const float* xr = xin + (size_t)row * DM;
        f32x4 v[8]; float ss = 0.f;
#pragma unroll
        for (int i = 0; i < 8; ++i) { v[i] = *(const f32x4*)(xr + i * 256 + lane * 4); ss += v[i][0] * v[i][0] + v[i][1] * v[i][1] + v[i][2] * v[i][2] + v[i][3] * v[i][3]; }
        ss = wave_sum(ss);
        const float rstd = rsqrtf(ss * (1.f / DM) + EPS);
#pragma unroll
        for (int i = 0; i < 8; ++i) {
            const int col = i * 256 + lane * 4;
            const f32x4 gg = *(const f32x4*)(g + col), sh = *(const f32x4*)(shift + (size_t)b * 6 * DM + col), sc = *(const f32x4*)(scale + (size_t)b * 6 * DM + col);
            f32x4 y = v[i] * rstd * gg * (sc + 1.f) + sh;
            u32x2 w; w.x = pack_h2(y[0], y[1]); w.y = pack_h2(y[2], y[3]);
            *(u32x2*)(hout + (size_t)row * DM + col) = w;
        }
    }
}

__device__ __forceinline__ void phase_rope(const Params& p) {
    f16* proj = (f16*)(p.ws + WS_PROJ);
    const float2* r128 = (const float2*)(p.ws + WS_ROPE128); const float2* r64 = (const float2*)(p.ws + WS_ROPE64);
    constexpr int PER_TOK = (1088 + 544) / 2;
    const size_t total = (size_t)NT * PER_TOK;
    for (size_t i = (size_t)blockIdx.x * NTHREADS + otid(); i < total; i += (size_t)gridDim.x * NTHREADS) {
        const int t = (int)(i / PER_TOK); int r = (int)(i % PER_TOK) * 2;
        const int pos = t % SEQ;
        int base, half, j;
        if (r < 1088) {
            const int hh = r >> 6; j = r & 63; half = 64;
            base = hh < 6 ? C_QA + hh * 128 : (hh == 6 ? C_KA : (hh < 12 ? C_QC + (hh - 7) * 128 : C_KC + (hh - 12) * 128));
        } else {
            r -= 1088; const int hh = r >> 5; j = r & 31; half = 32;
            base = hh < 16 ? C_IQ + hh * 64 : C_IK;
        }
        f16* pp = proj + (size_t)t * INWP + base + j;
        const h2_t a = *(const h2_t*)pp, bq = *(const h2_t*)(pp + half);
        float2 cs0, cs1;
        if (half == 64) { cs0 = r128[pos * 64 + j]; cs1 = r128[pos * 64 + j + 1]; } else { cs0 = r64[pos * 32 + j]; cs1 = r64[pos * 32 + j + 1]; }
        const float a0 = (float)a.x, a1 = (float)a.y, b0 = (float)bq.x, b1 = (float)bq.y;
        h2_t oa, ob;
        oa.x = (f16)(a0 * cs0.x - b0 * cs0.y); oa.y = (f16)(a1 * cs1.x - b1 * cs1.y);
        ob.x = (f16)(b0 * cs0.x + a0 * cs0.y); ob.y = (f16)(b1 * cs1.x + a1 * cs1.y);
        *(h2_t*)pp = oa; *(h2_t*)(pp + half) = ob;
    }
}

__device__ __forceinline__ void phase_index(const Params& p, LAS unsigned char* lds_) {
    const f16* proj = (const f16*)(p.ws + WS_PROJ);
    float* smem = (float*)(unsigned char*)lds_;
    const int tid = otid(), wid = tid >> 6, lane = tid & 63;
    {
        float* red = smem;
        float* km = (float*)(p.ws + WS_KMEAN);
        for (int u = blockIdx.x; u < NB * HC * MOBA_NB; u += gridDim.x) {
            const int blk = u % MOBA_NB, h = (u / MOBA_NB) % HC, b = u / (MOBA_NB * HC);
            const int d = tid & 127, part = tid >> 7;
            float s = 0.f;
            const f16* kp = proj + ((size_t)b * SEQ + blk * MOBA_BLK + part * 64) * INWP + C_KC + h * HD + d;
            for (int k = 0; k < 64; ++k) s += (float)kp[(size_t)k * INWP];
            __syncthreads();
            red[part * 128 + d] = s;
            __syncthreads();
            if (tid < 128) km[(size_t)u * HD + tid] = (red[tid] + red[128 + tid] + red[256 + tid] + red[384 + tid]) * (1.f / MOBA_BLK);
        }
        __syncthreads();
    }
    float* wq_ = smem + wid * (IH * IDM + IH);
    float* sc = smem + NWAVES * (IH * IDM + IH) + wid * SEQ;
    unsigned* mask = (unsigned*)(p.ws + WS_MASK);
    for (int q = blockIdx.x * NWAVES + wid; q < NT; q += gridDim.x * NWAVES) {
        const int b = q / SEQ, t = q % SEQ;
        const f16* row = proj + (size_t)q * INWP;
        for (int i = lane; i < IH * IDM; i += 64) wq_[i] = (float)row[C_IQ + i];
        if (lane < IH) wq_[IH * IDM + lane] = (float)row[C_IW + lane] * 0.25f;
        __builtin_amdgcn_wave_barrier();
        const int nk = t + 1;
        for (int s = lane; s < nk; s += 64) {
            const f16* kr = proj + ((size_t)b * SEQ + s) * INWP + C_IK;
            float kf[IDM];
#pragma unroll
            for (int e8 = 0; e8 < IDM / 8; ++e8) { const h8_t kv = *(const h8_t*)(kr + e8 * 8);
#pragma unroll
                for (int j = 0; j < 8; ++j) kf[e8 * 8 + j] = (float)kv[j]; }
            float score = 0.f;
            for (int h = 0; h < IH; ++h) {
                float d = 0.f;
#pragma unroll
                for (int e = 0; e < IDM; ++e) d += wq_[h * IDM + e] * kf[e];
                score += wq_[IH * IDM + h] * fmaxf(d * 0.125f, 0.f);
            }
            sc[s] = score;
        }
        __builtin_amdgcn_wave_barrier();
        unsigned key[32];
#pragma unroll
        for (int i = 0; i < 32; ++i) {
            const int s = lane + 64 * i;
            unsigned u = 0u;
            if (s < nk) { const unsigned bits = __float_as_uint(sc[s]); u = (bits & 0x80000000u) ? ~bits : (bits | 0x80000000u); if (u == 0u) u = 1u; }
            key[i] = u;
        }
        unsigned thr = 1u;
        if (nk > DSA_TOPK) {
            thr = 0u;
            for (int bit = 31; bit >= 0; --bit) {
                const unsigned cand = thr | (1u << bit);
                int cnt = 0;
#pragma unroll
                for (int i = 0; i < 32; ++i) cnt += __builtin_popcountll(__ballot(key[i] >= cand));
                if (cnt >= DSA_TOPK) thr = cand;
            }
        }
        unsigned* mrow = mask + (size_t)q * 64;
#pragma unroll
        for (int i = 0; i < 32; ++i) {
            const unsigned long long bal = __ballot(key[i] >= thr && key[i] != 0u);
            if (lane == 0) { mrow[2 * i] = (unsigned)bal; mrow[2 * i + 1] = (unsigned)(bal >> 32); }
        }
        __builtin_amdgcn_wave_barrier();
    }
}

__device__ __forceinline__ void phase_attn(const Params& p, LAS unsigned char* lds_, const float* ong) {
    const f16* proj = (const f16*)(p.ws + WS_PROJ);
    float* smem = (float*)(unsigned char*)lds_;
    const int tid = otid(), wid = tid >> 6, lane = tid & 63;
    float* pbuf = smem + wid * SEQ;
    const float* km = (const float*)(p.ws + WS_KMEAN);
    const unsigned* mask = (const unsigned*)(p.ws + WS_MASK);
    f16* y = (f16*)(p.ws + WS_Y);
    const float scale = 0.08838834764831845f;
    const size_t nitems = (size_t)NT * NHEADS;
    for (size_t it = (size_t)blockIdx.x * NWAVES + wid; it < nitems; it += (size_t)gridDim.x * NWAVES) {
        const int hh = (int)(it % NHEADS); const int q = (int)(it / NHEADS);
        const int b = q / SEQ, t = q % SEQ;
        int qc, kc, vc, var;
        if (hh < HA) { var = 0; qc = C_QA + hh * HD; kc = C_KA; vc = C_VA; }
        else if (hh < HA + HB) { var = 1; qc = C_QB + (hh - HA) * HD; kc = C_KB + (hh - HA) * HD; vc = C_VB + (hh - HA) * HD; }
        else { var = 2; qc = C_QC + (hh - HA - HB) * HD; kc = C_KC + (hh - HA - HB) * HD; vc = C_VC + (hh - HA - HB) * HD; }
        unsigned qv[64];
        { const u32x4* qp = (const u32x4*)(proj + (size_t)q * INWP + qc);
#pragma unroll
          for (int i = 0; i < 16; ++i) { const u32x4 w = qp[i]; qv[4 * i] = w.x; qv[4 * i + 1] = w.y; qv[4 * i + 2] = w.z; qv[4 * i + 3] = w.w; } }
        unsigned allowed = 0xffu;
        const int own = t / MOBA_BLK;
        if (var == 2) {
            float g = -INFINITY;
            if (lane < own) {
                const float* kmp = km + (((size_t)b * HC + (hh - HA - HB)) * MOBA_NB + lane) * HD;
                float s = 0.f;
#pragma unroll
                for (int i = 0; i < 64; ++i) s += h_lo(qv[i]) * kmp[2 * i] + h_hi(qv[i]) * kmp[2 * i + 1];
                g = s;
            }
            float gs[MOBA_NB];
#pragma unroll
            for (int j = 0; j < MOBA_NB; ++j) gs[j] = __shfl(g, j);
            allowed = 1u << own;
#pragma unroll
            for (int j = 0; j < MOBA_NB; ++j) {
                if (j < own) {
                    int rank = 0;
#pragma unroll
                    for (int k2 = 0; k2 < MOBA_NB; ++k2) if (k2 < own && (gs[k2] > gs[j] || (gs[k2] == gs[j] && k2 < j))) ++rank;
                    if (rank < 3) allowed |= 1u << j;
                }
            }
        }
        const int nk = t + 1;
        const int nkl = (nk + 63) >> 6;
        const unsigned* mrow = mask + (size_t)q * 64;
        float z[32];
#pragma unroll
        for (int i = 0; i < 32; ++i) {
            z[i] = -INFINITY;
            if (i < nkl) {
                const int s = nkl * lane + i;
                if (s < nk) {
                    bool ok = true;
                    if (var == 0) ok = (mrow[s >> 5] >> (s & 31)) & 1u;
                    if (var == 2) ok = (allowed >> (s / MOBA_BLK)) & 1u;
                    if (var == 1) ok = s < t;
                    if (ok) {
                        const u32x4* kp = (const u32x4*)(proj + ((size_t)b * SEQ + s) * INWP + kc);
                        float d = 0.f;
#pragma unroll
                        for (int c4 = 0; c4 < 16; ++c4) { const u32x4 w = kp[c4]; d = dot2(qv[4 * c4], w.x, d); d = dot2(qv[4 * c4 + 1], w.y, d); d = dot2(qv[4 * c4 + 2], w.z, d); d = dot2(qv[4 * c4 + 3], w.w, d); }
                        z[i] = d * scale;
                    }
                }
            }
        }
        float inv_l = 1.f;
        if (var != 1) {
            float m = -INFINITY;
#pragma unroll
            for (int i = 0; i < 32; ++i) m = fmaxf(m, z[i]);
            m = wave_max(m);
            float l = 0.f;
#pragma unroll
            for (int i = 0; i < 32; ++i) { const float e = (z[i] == -INFINITY) ? 0.f : __expf(z[i] - m); z[i] = e; l += e; }
            l = wave_sum(l);
            inv_l = 1.f / l;
        } else {
            float lk[32]; float tot = 0.f;
#pragma unroll
            for (int i = 31; i >= 0; --i) {
                float v = 0.f;
                if (z[i] != -INFINITY) { const float zz = z[i]; v = -(fmaxf(zz, 0.f) + log1pf(__expf(-fabsf(zz)))); }
                tot += v; lk[i] = tot;
            }
            float incl = tot;
#pragma unroll
            for (int o = 1; o < 64; o <<= 1) { const float v = __shfl_down(incl, o); if (lane + o < 64) incl += v; }
            const float excl = incl - tot;
#pragma unroll
            for (int i = 0; i < 32; ++i) z[i] = (z[i] == -INFINITY) ? 0.f : __expf(z[i] + lk[i] + excl);
        }
#pragma unroll
        for (int i = 0; i < 32; ++i) if (i < nkl) { const int s = nkl * lane + i; if (s < SEQ) pbuf[s] = z[i]; }
        __builtin_amdgcn_wave_barrier();
        float o0 = 0.f, o1 = 0.f;
        const f16* vp = proj + (size_t)b * SEQ * INWP + vc + 2 * lane;
        for (int s0 = 0; s0 < nk; s0 += 8) {
            float pr[8]; bool any = false;
#pragma unroll
            for (int j = 0; j < 8; ++j) { pr[j] = pbuf[s0 + j]; any = any || (pr[j] != 0.f); }
            if (any) {
                unsigned w[8];
#pragma unroll
                for (int j = 0; j < 8; ++j) w[j] = *(const unsigned*)(vp + (size_t)(s0 + j) * INWP);
#pragma unroll
                for (int j = 0; j < 8; ++j) { o0 += pr[j] * h_lo(w[j]); o1 += pr[j] * h_hi(w[j]); }
            }
        }
        o0 *= inv_l; o1 *= inv_l;
        const float ss = wave_sum(o0 * o0 + o1 * o1);
        const float rstd = rsqrtf(ss * (1.f / HD) + EPS);
        const float g0 = ong[hh * HD + 2 * lane], g1 = ong[hh * HD + 2 * lane + 1];
        *(unsigned*)(y + (size_t)q * DM + hh * HD + 2 * lane) = pack_h2(o0 * rstd * g0, o1 * rstd * g1);
        __builtin_amdgcn_wave_barrier();
    }
}

__device__ __forceinline__ void wave_argmax(float& v, int& idx) {
#pragma unroll
    for (int o = 32; o >= 1; o >>= 1) {
        const float ov = __shfl_xor(v, o); const int oi = __shfl_xor(idx, o);
        if (ov > v || (ov == v && oi < idx)) { v = ov; idx = oi; }
    }
}
__device__ __forceinline__ void phase_route(const Params& p, LAS unsigned char* lds_, const f16* subk) {
    const f16* qp = (const f16*)(p.ws + WS_Y);
    float* smem = (float*)(unsigned char*)lds_;
    const int tid = otid(), wid = tid >> 6, lane = tid & 63;
    float* qs = smem + wid * 256;
    unsigned* pe = (unsigned*)(p.ws + WS_PE); float* pg = (float*)(p.ws + WS_PG);
    const size_t nitems = (size_t)NT * PH;
    for (size_t it = (size_t)blockIdx.x * NWAVES + wid; it < nitems; it += (size_t)gridDim.x * NWAVES) {
        const int hp = (int)(it % PH); const int t = (int)(it / PH);
        const f16* qrow = qp + (size_t)t * DM + hp * 256;
        for (int i = lane; i < 256; i += 64) qs[i] = (float)qrow[i];
        __builtin_amdgcn_wave_barrier();
        float sv[2]; int si[2];
#pragma unroll
        for (int c = 0; c < 2; ++c) {
            float v0, v1;
            {
                const f16* k0 = subk + (((size_t)hp * 2 + c) * PNK + lane) * 128;
                const f16* k1 = k0 + 64 * 128;
                float a0 = 0.f, a1 = 0.f;
#pragma unroll 4
                for (int e8 = 0; e8 < 16; ++e8) {
                    const h8_t x0 = *(const h8_t*)(k0 + e8 * 8), x1 = *(const h8_t*)(k1 + e8 * 8);
#pragma unroll
                    for (int j = 0; j < 8; ++j) { const float qq = qs[c * 128 + e8 * 8 + j]; a0 += qq * (float)x0[j]; a1 += qq * (float)x1[j]; }
                }
                v0 = a0; v1 = a1;
            }
            float mysv = 0.f; int mysi = 0;
            for (int r = 0; r < PTOPK; ++r) {
                float v; int idx;
                if (v0 >= v1) { v = v0; idx = lane; } else { v = v1; idx = lane + 64; }
                wave_argmax(v, idx);
                if (idx == lane) v0 = -INFINITY;
                if (idx == lane + 64) v1 = -INFINITY;
                if (lane == r) { mysv = v; mysi = idx; }
            }
            sv[c] = mysv; si[c] = mysi;
        }
        float cs[4];
#pragma unroll
        for (int k = 0; k < 4; ++k) { const int id = 4 * lane + k; cs[k] = __shfl(sv[0], id >> 4) + __shfl(sv[1], id & 15); }
        float tops = 0.f; int pick = 0;
        for (int r = 0; r < PTOPK; ++r) {
            float v = cs[0]; int idx = 4 * lane;
#pragma unroll
            for (int k = 1; k < 4; ++k) if (cs[k] > v) { v = cs[k]; idx = 4 * lane + k; }
            wave_argmax(v, idx);
#pragma unroll
            for (int k = 0; k < 4; ++k) if (idx == 4 * lane + k) cs[k] = -INFINITY;
            if (lane == r) { tops = v; pick = idx; }
        }
        const int e0 = __shfl(si[0], pick >> 4), e1 = __shfl(si[1], pick & 15);
        const float mx = __shfl(tops, 0);
        float ex = lane < PTOPK ? __expf(tops - mx) : 0.f;
        const float sum = wave_sum(ex);
        if (lane < PTOPK) { pe[(size_t)t * 128 + hp * 16 + lane] = (unsigned)(e0 * PNK + e1); pg[(size_t)t * 128 + hp * 16 + lane] = ex / sum; }
        __builtin_amdgcn_wave_barrier();
    }
}

__device__ __forceinline__ void phase_experts(const Params& p, const f16* h2, const float* x1, const float* gate2  , const f16* u16, const f16* v16,
                              float* xout  , bool final_norm, const float* ng, const float* nshift, const float* nscale, f16* hnext, float* fout) {
    const int tid_ = otid(); const int wid = tid_ >> 6, lane = tid_ & 63;
    const unsigned* pe = (const unsigned*)(p.ws + WS_PE); const float* pg = (const float*)(p.ws + WS_PG);
    for (int t = blockIdx.x * NWAVES + wid; t < NT; t += gridDim.x * NWAVES) {
        const int b = t / SEQ;
        u32x4 hv[4];
#pragma unroll
        for (int i = 0; i < 4; ++i) hv[i] = *(const u32x4*)(h2 + (size_t)t * DM + 512 * i + 8 * lane);
        float acc[32];
#pragma unroll
        for (int i = 0; i < 32; ++i) acc[i] = 0.f;
        for (int g8 = 0; g8 < 32; ++g8) {
            const unsigned myexp = pe[(size_t)t * 128 + g8 * 4 + (lane & 3)];
            const float mygate = pg[(size_t)t * 128 + g8 * 4 + (lane & 3)];
            float part[4];
#pragma unroll
            for (int k = 0; k < 4; ++k) {
                const unsigned e = __shfl(myexp, k);
                const f16* ur = u16 + (size_t)e * DM + 8 * lane;
                float d = 0.f;
#pragma unroll
                for (int i = 0; i < 4; ++i) { const u32x4 w = *(const u32x4*)(ur + 512 * i); d = dot2(hv[i].x, w.x, d); d = dot2(hv[i].y, w.y, d); d = dot2(hv[i].z, w.z, d); d = dot2(hv[i].w, w.w, d); }
                part[k] = d;
            }
#pragma unroll
            for (int k = 0; k < 4; ++k) part[k] = wave_sum(part[k]);
#pragma unroll
            for (int k = 0; k < 4; ++k) {
                const float d = part[k];
                const float act = 0.5f * d * (1.f + erff(d * 0.70710678118654752f));
                const float coef = __shfl(mygate, k) * act;
                const unsigned e = __shfl(myexp, k);
                const f16* vr = v16 + (size_t)e * DM + 8 * lane;
#pragma unroll
                for (int i = 0; i < 4; ++i) {
                    const u32x4 w = *(const u32x4*)(vr + 512 * i);
                    acc[8 * i + 0] += coef * h_lo(w.x); acc[8 * i + 1] += coef * h_hi(w.x); acc[8 * i + 2] += coef * h_lo(w.y); acc[8 * i + 3] += coef * h_hi(w.y);
                    acc[8 * i + 4] += coef * h_lo(w.z); acc[8 * i + 5] += coef * h_hi(w.z); acc[8 * i + 6] += coef * h_lo(w.w); acc[8 * i + 7] += coef * h_hi(w.w);
                }
            }
        }
        float ss = 0.f;
#pragma unroll
        for (int i = 0; i < 4; ++i) {
            const int col = 512 * i + 8 * lane;
#pragma unroll
            for (int hf = 0; hf < 2; ++hf) {
                const f32x4 xi = *(const f32x4*)(x1 + (size_t)t * DM + col + 4 * hf);
                const f32x4 gt = *(const f32x4*)(gate2 + (size_t)b * 6 * DM + col + 4 * hf);
                f32x4 r;
#pragma unroll
                for (int j = 0; j < 4; ++j) { r[j] = xi[j] + gt[j] * acc[8 * i + 4 * hf + j]; acc[8 * i + 4 * hf + j] = r[j]; ss += r[j] * r[j]; }
                if (xout) *(f32x4*)(xout + (size_t)t * DM + col + 4 * hf) = r;
            }
        }
        ss = wave_sum(ss);
        const float rstd = rsqrtf(ss * (1.f / DM) + EPS);
#pragma unroll
        for (int i = 0; i < 4; ++i) {
            const int col = 512 * i + 8 * lane;
            if (final_norm) {
#pragma unroll
                for (int hf = 0; hf < 2; ++hf) {
                    const f32x4 gg = *(const f32x4*)(ng + col + 4 * hf);
                    f32x4 r;
#pragma unroll
                    for (int j = 0; j < 4; ++j) r[j] = acc[8 * i + 4 * hf + j] * rstd * gg[j];
                    *(f32x4*)(fout + (size_t)t * DM + col + 4 * hf) = r;
                }
            } else {
                float yv[8];
#pragma unroll
                for (int hf = 0; hf < 2; ++hf) {
                    const f32x4 gg = *(const f32x4*)(ng + col + 4 * hf), sh = *(const f32x4*)(nshift + (size_t)b * 6 * DM + col + 4 * hf), sc = *(const f32x4*)(nscale + (size_t)b * 6 * DM + col + 4 * hf);
#pragma unroll
                    for (int j = 0; j < 4; ++j) yv[4 * hf + j] = acc[8 * i + 4 * hf + j] * rstd * gg[j] * (1.f + sc[j]) + sh[j];
                }
                u32x4 w; w.x = pack_h2(yv[0], yv[1]); w.y = pack_h2(yv[2], yv[3]); w.z = pack_h2(yv[4], yv[5]); w.w = pack_h2(yv[6], yv[7]);
                *(u32x4*)(hnext + (size_t)t * DM + col) = w;
            }
        }
    }
}

constexpr int PH_CONV = 0, PH_N1 = 1, PH_L0 = 2, PH_PER_LAYER = 9, PH_TOTAL = PH_L0 + DEPTH * PH_PER_LAYER;

__global__ void __launch_bounds__(NTHREADS, 2) mega(Params p_arg) {
    extern __shared__ __attribute__((aligned(16))) unsigned char shm[];
    LAS unsigned char* lds = (LAS unsigned char*)shm;
    typedef const Params __attribute__((address_space(4)))* KP;
    const int ph_lo = p_arg.ph_lo, ph_hi = p_arg.ph_hi;
#ifndef PMASK
#define PMASK 0xff
#endif
#define EN(k) ((PMASK >> (k)) & 1)
    for (int ph = ph_lo; ph < ph_hi; ++ph) {
        KP kp = (KP)__builtin_amdgcn_kernarg_segment_ptr();
        asm volatile("" : "+s"(kp));
#if defined(__HIP_DEVICE_COMPILE__)
        const Params p = *kp;
#else
        const Params p = p_arg;
#endif
        unsigned char* ws = p.ws;
        const float* mod = (const float*)(ws + WS_MOD);
        int kind, l = 0, s = -1;
        if (ph == PH_CONV) kind = 0;
        else if (ph == PH_N1) kind = 1;
        else {
            l = (ph - PH_L0) / PH_PER_LAYER; s = (ph - PH_L0) % PH_PER_LAYER;
            kind = (s == 0 || s == 4 || s == 6) ? 2 : (s == 1 ? 3 : (s == 2 ? 4 : (s == 3 ? 5 : (s == 5 ? 1 : (s == 7 ? 6 : 7)))));
        }
        const float* modl = mod + (size_t)l * NB * 6 * DM;
        const float* xin = l == 0 ? p.x : p.out;
        float* x1 = (float*)(ws + WS_X1);
        if (kind == 0) { if (EN(0)) phase_conv(p, lds); }
        else if (kind == 1) {
            if (EN(1)) {
                if (s < 0) phase_norm(p, p.x, p.n1g, mod + 0 * DM, mod + 1 * DM, (f16*)(ws + WS_H));
                else phase_norm(p, x1, p.n2g + (size_t)l * DM, modl + 3 * DM, modl + 4 * DM, (f16*)(ws + WS_H));
            }
        } else if (kind == 2) {
            if (EN(2)) {
                Epi E{}; const f16* A; const f16* Bt; int N;
                if (s == 0) { E.mode = 0; E.o16 = (f16*)(ws + WS_PROJ); E.ldc = INWP; A = (const f16*)(ws + WS_H); Bt = (const f16*)(ws + WS_WTIN) + (size_t)l * INWP * DM; N = INWP; }
                else if (s == 4) { E.mode = 1; E.o32 = x1; E.xin = xin; E.gate = modl + 2 * DM; A = (const f16*)(ws + WS_Y); Bt = (const f16*)(ws + WS_WTOUT) + (size_t)l * DM * DM; N = DM; }
                else { E.mode = 0; E.o16 = (f16*)(ws + WS_Y); E.ldc = DM; A = (const f16*)(ws + WS_H); Bt = (const f16*)(ws + WS_WTQ) + (size_t)l * DM * DM; N = DM; }
                gemm_run(p, lds, A, Bt, N, E);
            }
        } else if (kind == 3) { if (EN(3)) phase_rope(p); }
        else if (kind == 4) { if (EN(4)) phase_index(p, lds); }
        else if (kind == 5) { if (EN(5)) phase_attn(p, lds, p.ong + (size_t)l * DM); }
        else if (kind == 6) { if (EN(6)) phase_route(p, lds, (const f16*)(ws + WS_SUBK) + (size_t)l * PH * 2 * PNK * 128); }
        else if (EN(7)) {
            const bool fin = (l == DEPTH - 1);
            const float* modn = mod + (size_t)(fin ? l : l + 1) * NB * 6 * DM;
            phase_experts(p, (const f16*)(ws + WS_H), x1, modl + 5 * DM, (const f16*)(ws + WS_U16) + (size_t)l * PEXP * DM, (const f16*)(ws + WS_V16) + (size_t)l * PEXP * DM,
                          fin ? nullptr : p.out, fin, fin ? p.fg : p.n1g + (size_t)(l + 1) * DM, modn + 0 * DM, modn + 1 * DM, (f16*)(ws + WS_H), p.out);
        }
        if (ph + 1 < ph_hi) cg::this_grid().sync();
    }
}

extern "C" void kernel_launch(void* const* d_in, const int* in_sizes, int n_in, void* d_out, int out_size, void* d_ws, size_t ws_size, hipStream_t stream) {
    static int grid = 0;
    if (grid == 0) {
        if (n_in != 14 || out_size != NT * DM || ws_size < WS_END) { fprintf(stderr, "kernel_launch: unexpected sizes (n_in %d out %d ws %zu need %zu)\n", n_in, out_size, ws_size, (size_t)WS_END); grid = -1; return; }
        if (hipFuncSetAttribute((const void*)mega, hipFuncAttributeMaxDynamicSharedMemorySize, LDS_BYTES) != hipSuccess) { fprintf(stderr, "kernel_launch: hipFuncSetAttribute failed\n"); grid = -1; return; }
        int dev = 0, cus = 0, per_cu = 0;
        hipGetDevice(&dev); hipDeviceGetAttribute(&cus, hipDeviceAttributeMultiprocessorCount, dev);
        hipOccupancyMaxActiveBlocksPerMultiprocessor(&per_cu, (const void*)mega, NTHREADS, LDS_BYTES);
        if (per_cu < 1) { fprintf(stderr, "kernel_launch: occupancy query says %d blocks per CU\n", per_cu); grid = -1; return; }
        grid = cus;
    }
    if (grid < 0) return;
    Params p{};
    p.x = (const float*)d_in[0]; p.c = (const float*)d_in[1]; p.ada_w = (const float*)d_in[2]; p.ada_b = (const float*)d_in[3];
    p.n1g = (const float*)d_in[4]; p.n2g = (const float*)d_in[5]; p.w_in = (const float*)d_in[6]; p.ong = (const float*)d_in[7];
    p.w_out = (const float*)d_in[8]; p.wq = (const float*)d_in[9]; p.subk = (const float*)d_in[10]; p.pu = (const float*)d_in[11];
    p.pv = (const float*)d_in[12]; p.fg = (const float*)d_in[13];
    p.out = (float*)d_out; p.ws = (unsigned char*)d_ws;
#if 0
    for (int ph = 0; ph < PH_TOTAL; ++ph) {
        p.ph_lo = ph; p.ph_hi = ph + 1;
        hipLaunchKernelGGL(mega, dim3(grid), dim3(NTHREADS), LDS_BYTES, stream, p);
    }
#else
    p.ph_lo = 0; p.ph_hi = PH_TOTAL;
    void* args[] = {&p};
    hipError_t e = hipLaunchCooperativeKernel((const void*)mega, dim3(grid), dim3(NTHREADS), args, LDS_BYTES, stream);
    if (e != hipSuccess) fprintf(stderr, "cooperative launch failed: %s (grid %d)\n", hipGetErrorString(e), grid);
#endif
}
```

```cpp
#include <hip/hip_runtime.h>
#include <hip/hip_cooperative_groups.h>
#include <cstdio>
#include <cstdint>
namespace cg = cooperative_groups;

#define LAS __attribute__((address_space(3)))
typedef _Float16 f16;
typedef _Float16 h2_t __attribute__((ext_vector_type(2)));
typedef _Float16 h4_t __attribute__((ext_vector_type(4)));
typedef _Float16 h8_t __attribute__((ext_vector_type(8)));
typedef float f32x4 __attribute__((ext_vector_type(4)));
typedef unsigned u32x4 __attribute__((ext_vector_type(4)));
typedef unsigned u32x2 __attribute__((ext_vector_type(2)));

constexpr int NB = 8, SEQ = 2048, DM = 2048, NT = NB * SEQ, DEPTH = 2;
constexpr int HD = 128, HA = 6, HB = 5, HC = 5, NHEADS = 16;
constexpr int IH = 16, IDM = 64, DSA_TOPK = 256;
constexpr int MOBA_BLK = 256, MOBA_NB = 8;
constexpr int INW = 5968, INWP = 6144;
constexpr int PH = 8, PNK = 128, PTOPK = 16, PEXP = 16384;
constexpr float EPS = 1e-6f;
constexpr int C_QA = 0, C_KA = 768, C_VA = 896, C_IQ = 1024, C_IK = 2048, C_IW = 2112, C_QB = 2176, C_KB = 2816, C_VB = 3456,
              C_QC = 4096, C_KC = 4736, C_VC = 5376, C_END = 6016;

constexpr int NTHREADS = 512, NWAVES = 8;
constexpr int LDS_BYTES = 147456;

constexpr size_t al256(size_t x) { return (x + 255) & ~(size_t)255; }
constexpr size_t WS_WTIN = 0;
constexpr size_t WS_WTOUT = WS_WTIN + (size_t)DEPTH * INWP * DM * 2;
constexpr size_t WS_WTQ = WS_WTOUT + (size_t)DEPTH * DM * DM * 2;
constexpr size_t WS_U16 = WS_WTQ + (size_t)DEPTH * DM * DM * 2;
constexpr size_t WS_V16 = WS_U16 + (size_t)DEPTH * PEXP * DM * 2;
constexpr size_t WS_SUBK = WS_V16 + (size_t)DEPTH * PEXP * DM * 2;
constexpr size_t WS_MOD = WS_SUBK + (size_t)DEPTH * PH * 2 * PNK * 128 * 2;
constexpr size_t WS_ROPE128 = WS_MOD + (size_t)DEPTH * NB * 6 * DM * 4;
constexpr size_t WS_ROPE64 = WS_ROPE128 + (size_t)SEQ * 64 * 8;
constexpr size_t WS_H = WS_ROPE64 + (size_t)SEQ * 32 * 8;
constexpr size_t WS_PROJ = WS_H + (size_t)NT * DM * 2;
constexpr size_t WS_KMEAN = WS_PROJ + (size_t)NT * INWP * 2;
constexpr size_t WS_MASK = WS_KMEAN + al256((size_t)NB * HC * MOBA_NB * HD * 4);
constexpr size_t WS_Y = WS_MASK + (size_t)NB * SEQ * 64 * 4;
constexpr size_t WS_X1 = WS_Y + (size_t)NT * DM * 2;
constexpr size_t WS_PE = WS_X1 + (size_t)NT * DM * 4;
constexpr size_t WS_PG = WS_PE + (size_t)NT * 128 * 4;
constexpr size_t WS_END = WS_PG + (size_t)NT * 128 * 4;

struct Params {
    const float *x, *c, *ada_w, *ada_b, *n1g, *n2g, *w_in, *ong, *w_out, *wq, *subk, *pu, *pv, *fg;
    float* out;
    unsigned char* ws;
    int ph_lo, ph_hi;
};

__device__ __forceinline__ int otid() { int t = threadIdx.x; asm volatile("" : "+v"(t)); return t; }
__device__ __forceinline__ int obid() { int t = blockIdx.x; asm volatile("" : "+s"(t)); return t; }
__device__ __forceinline__ float wave_sum(float v) {
#pragma unroll
    for (int o = 32; o >= 1; o >>= 1) v += __shfl_xor(v, o);
    return v;
}
__device__ __forceinline__ float wave_max(float v) {
#pragma unroll
    for (int o = 32; o >= 1; o >>= 1) v = fmaxf(v, __shfl_xor(v, o));
    return v;
}
__device__ __forceinline__ unsigned pack_h2(float a, float b) { h2_t r; r.x = (f16)a; r.y = (f16)b; return __builtin_bit_cast(unsigned, r); }
__device__ __forceinline__ float h_lo(unsigned u) { h2_t r = __builtin_bit_cast(h2_t, u); return (float)r.x; }
__device__ __forceinline__ float h_hi(unsigned u) { h2_t r = __builtin_bit_cast(h2_t, u); return (float)r.y; }
__device__ __forceinline__ float dot2(unsigned a, unsigned b, float c) {
    return __builtin_amdgcn_fdot2(__builtin_bit_cast(h2_t, a), __builtin_bit_cast(h2_t, b), c, false);
}

namespace pg8 {
constexpr int BM = 256, BK = 64, HALF = 128, HTB = HALF * BK * 2, STAGE_BYTES = 8 * HTB, NXCD = 8, WGM = 8;
__host__ __device__ __forceinline__ int lds_byte(int r, int c) { const int st = (r >> 4) * 2 + (c >> 5), rr = r & 15, cc = c & 31, ob = rr * 64 + cc * 2; return st * 1024 + (ob ^ (((ob >> 9) & 1) << 5)); }
__host__ __device__ __forceinline__ void stage_rc(int b, int& R, int& C) { const int st = b / 1024, sb = b % 1024, swz = sb ^ (((sb >> 9) & 1) << 5); R = (st >> 1) * 16 + swz / 64; C = (st & 1) * 32 + (swz % 64) / 2; }
struct Unit { int pm, pn; };
struct Gemm { const unsigned short* A; const unsigned short* Bt; int M, N, K; };
struct StaticOrder {
    int nM, nN, nwg, G, c;
    __host__ __device__ void init(int M, int N, int G_, int c_) { nM = M / BM; nN = N / BM; nwg = nM * nN; G = G_; c = c_; }
    __host__ __device__ bool next(int i, Unit& u) const {
        const long L = (long)i * G + c; if (L >= nwg) return false;
        int wgid = (int)L; { const int q = nwg / NXCD, r = nwg % NXCD, xcd = wgid % NXCD, off = wgid / NXCD; wgid = (xcd < r ? xcd * (q + 1) : r * (q + 1) + (xcd - r) * q) + off; }
        const int nig = WGM * nN, gid = wgid / nig, fm = gid * WGM, gsz = (nM - fm) < WGM ? (nM - fm) : WGM;
        u.pm = fm + ((wgid % nig) % gsz); u.pn = (wgid % nig) / gsz; return true;
    }
};

template <class Epi>
__device__ __forceinline__ void gemm_phase(LAS unsigned char* lds, const Gemm g, const StaticOrder& S, const Epi& E) {
    const int tid = otid(), wid = __builtin_amdgcn_readfirstlane(tid >> 6), lane = tid & 63, wr = wid >> 2, wc = wid & 3, fr = lane & 15, fq = lane >> 4;
    const int K = g.K, nt = K / BK;
    unsigned voffA[2], voffB[2];
#pragma unroll
    for (int i = 0; i < 2; ++i) { int R, C; stage_rc(tid * 16 + i * 8192, R, C); voffA[i] = (unsigned)(R * K + C) * 2u; voffB[i] = (unsigned)(R * K + C) * 2u; }
    const size_t kstep = (size_t)(BK * 2);
    const size_t hstep = (size_t)HALF * K * 2;
    const size_t tstep = 2 * hstep;
    const unsigned ldsw = (unsigned)wid * 1024u;
    const int aoff = lds_byte(wr * 64 + fr, fq * 8), boff = lds_byte(wc * 32 + fr, fq * 8);
#define PG8_SA(b, h) (((b) * 2 + (h)) * HTB)
#define PG8_SB(b, h) ((4 + (b) * 2 + (h)) * HTB)
#define PG8_STAGE(bufoff, gbase, voff) do { _Pragma("unroll") for (int _i = 0; _i < 2; ++_i) \
        __builtin_amdgcn_global_load_lds((const unsigned*)((const char*)(gbase) + (voff)[_i]), (LAS unsigned*)(lds + (bufoff) + ldsw + _i * 8192), 16, 0, 0); } while (0)
#define PG8_LDA(dst, b, h) do { _Pragma("unroll") for (int m = 0; m < 4; ++m) _Pragma("unroll") for (int k = 0; k < 2; ++k) dst[m][k] = *(const LAS h8_t*)(lds + PG8_SA(b, h) + aoff + m * 2048 + k * 1024); } while (0)
#define PG8_LDB(dst, b, h) do { _Pragma("unroll") for (int n = 0; n < 2; ++n) _Pragma("unroll") for (int k = 0; k < 2; ++k) dst[n][k] = *(const LAS h8_t*)(lds + PG8_SB(b, h) + boff + n * 2048 + k * 1024); } while (0)
#define PG8_MMA(ai, bj, At, Bt) do { __builtin_amdgcn_s_setprio(1); _Pragma("unroll") for (int m = 0; m < 4; ++m) _Pragma("unroll") for (int n = 0; n < 2; ++n) _Pragma("unroll") for (int k = 0; k < 2; ++k) \
        acc[ai][bj][m][n] = __builtin_amdgcn_mfma_f32_16x16x32_f16(Bt[n][k], At[m][k], acc[ai][bj][m][n], 0, 0, 0); __builtin_amdgcn_s_setprio(0); } while (0)
#define PG8_WAIT_V(n) asm volatile("s_waitcnt vmcnt(" #n ")" ::: "memory")
#define PG8_WAIT_L(n) asm volatile("s_waitcnt lgkmcnt(" #n ")" ::: "memory")
#define PG8_BAR __builtin_amdgcn_s_barrier()
#define PG8_SCHED __builtin_amdgcn_sched_barrier(0)
    Unit cur, nxt; int ui = 0;
    if (!S.next(0, cur)) return;
    f32x4 acc[2][2][4][2];
#pragma unroll
    for (int a = 0; a < 2; ++a)
#pragma unroll
        for (int b = 0; b < 2; ++b)
#pragma unroll
            for (int m = 0; m < 4; ++m)
#pragma unroll
                for (int n = 0; n < 2; ++n) acc[a][b][m][n] = (f32x4){0.f, 0.f, 0.f, 0.f};
    h8_t At[4][2], B0[2][2], B1[2][2];
    const char* cA = (const char*)g.A + (size_t)cur.pm * tstep; const char* cB = (const char*)g.Bt + (size_t)cur.pn * tstep;
    PG8_STAGE(PG8_SB(0, 0), cB, voffB); PG8_STAGE(PG8_SA(0, 0), cA, voffA); PG8_STAGE(PG8_SB(0, 1), cB + hstep, voffB); PG8_STAGE(PG8_SA(0, 1), cA + hstep, voffA);
    if (wr == 1) PG8_BAR;
    PG8_WAIT_V(4); PG8_BAR;
    PG8_STAGE(PG8_SB(1, 0), cB + kstep, voffB); PG8_STAGE(PG8_SA(1, 0), cA + kstep, voffA); PG8_STAGE(PG8_SB(1, 1), cB + hstep + kstep, voffB);
    PG8_WAIT_V(6); PG8_BAR;
    for (;;) {
        const bool has_next = S.next(ui + 1, nxt);
        const char* nA = has_next ? (const char*)g.A + (size_t)nxt.pm * tstep : cA; const char* nB = has_next ? (const char*)g.Bt + (size_t)nxt.pn * tstep : cB;
        for (int t = 0; t < nt; t += 2) {
            const bool last = (t == nt - 2);
            const char* a1 = cA + (size_t)(t + 1) * kstep;
            const char* a2 = last ? nA : cA + (size_t)(t + 2) * kstep; const char* b2 = last ? nB : cB + (size_t)(t + 2) * kstep;
            const char* a3 = a2 + kstep; const char* b3 = b2 + kstep;
            PG8_LDB(B0, 0, 0); PG8_SCHED; PG8_LDA(At, 0, 0); PG8_STAGE(PG8_SA(1, 1), a1 + hstep, voffA);
            PG8_WAIT_L(8); PG8_BAR; PG8_WAIT_L(0); PG8_MMA(0, 0, At, B0); PG8_BAR; PG8_SCHED;
            PG8_LDB(B1, 0, 1); PG8_STAGE(PG8_SB(0, 0), b2, voffB);
            PG8_BAR; PG8_WAIT_L(0); PG8_MMA(0, 1, At, B1); PG8_BAR;
            PG8_LDA(At, 0, 1); PG8_STAGE(PG8_SA(0, 0), a2, voffA);
            PG8_BAR; PG8_WAIT_L(0); PG8_MMA(1, 0, At, B0); PG8_BAR; PG8_SCHED;
            PG8_STAGE(PG8_SB(0, 1), b2 + hstep, voffB);
            PG8_WAIT_V(6); PG8_BAR; PG8_MMA(1, 1, At, B1); PG8_BAR;
            PG8_LDB(B0, 1, 0); PG8_SCHED; PG8_LDA(At, 1, 0); PG8_STAGE(PG8_SA(0, 1), a2 + hstep, voffA);
            PG8_WAIT_L(8); PG8_BAR; PG8_WAIT_L(0); PG8_MMA(0, 0, At, B0); PG8_BAR; PG8_SCHED;
            PG8_LDB(B1, 1, 1); PG8_STAGE(PG8_SB(1, 0), b3, voffB);
            PG8_BAR; PG8_WAIT_L(0); PG8_MMA(0, 1, At, B1); PG8_BAR;
            PG8_LDA(At, 1, 1); PG8_STAGE(PG8_SA(1, 0), a3, voffA);
            PG8_BAR; PG8_WAIT_L(0); PG8_MMA(1, 0, At, B0); PG8_BAR; PG8_SCHED;
            PG8_STAGE(PG8_SB(1, 1), b3 + hstep, voffB);
            PG8_WAIT_V(6); PG8_BAR; PG8_MMA(1, 1, At, B1); PG8_BAR;
        }
        E(acc, cur, wr, wc, fr, fq);
        if (!has_next) break;
#pragma unroll
        for (int a = 0; a < 2; ++a)
#pragma unroll
            for (int b = 0; b < 2; ++b)
#pragma unroll
                for (int m = 0; m < 4; ++m)
#pragma unroll
                    for (int n = 0; n < 2; ++n) acc[a][b][m][n] = (f32x4){0.f, 0.f, 0.f, 0.f};
        cur = nxt; cA = nA; cB = nB; ++ui;
    }
    PG8_WAIT_V(0);
    if (wr == 0) PG8_BAR;
    PG8_BAR;
#undef PG8_SA
#undef PG8_SB
#undef PG8_STAGE
#undef PG8_LDA
#undef PG8_LDB
#undef PG8_MMA
#undef PG8_WAIT_V
#undef PG8_WAIT_L
#undef PG8_BAR
#undef PG8_SCHED
}
}

struct Epi {
    int mode; f16* o16; int ldc; float* o32; const float* xin; const float* gate;
    __device__ __forceinline__ void operator()(const f32x4 (&acc)[2][2][4][2], const pg8::Unit& u, int wr, int wc, int fr, int fq) const {
        const int row0 = u.pm * 256 + wr * 64 + fr, col0 = u.pn * 256 + wc * 32 + 4 * fq;
#pragma unroll
        for (int ai = 0; ai < 2; ++ai)
#pragma unroll
            for (int m = 0; m < 4; ++m) {
                const int row = row0 + ai * 128 + m * 16;
#pragma unroll
                for (int bj = 0; bj < 2; ++bj)
#pragma unroll
                    for (int n = 0; n < 2; ++n) {
                        const int col = col0 + bj * 128 + n * 16;
                        const f32x4 v = acc[ai][bj][m][n];
                        if (mode == 0) {
                            u32x2 w; w.x = pack_h2(v[0], v[1]); w.y = pack_h2(v[2], v[3]);
                            *(u32x2*)(o16 + (size_t)row * ldc + col) = w;
                        } else {
                            const int b = row / SEQ;
                            const f32x4 xi = *(const f32x4*)(xin + (size_t)row * DM + col);
                            const f32x4 gt = *(const f32x4*)(gate + (size_t)b * 6 * DM + col);
                            *(f32x4*)(o32 + (size_t)row * DM + col) = xi + gt * v;
                        }
                    }
            }
    }
};

__device__ __forceinline__ void gemm_run(const Params& p, LAS unsigned char* lds, const f16* A, const f16* Bt, int N, const Epi& E) {
    pg8::Gemm g; g.A = (const unsigned short*)A; g.Bt = (const unsigned short*)Bt; g.M = NT; g.N = N; g.K = DM;
    pg8::StaticOrder S; S.init(NT, N, (int)gridDim.x, (int)blockIdx.x);
    pg8::gemm_phase<Epi>(lds, g, S, E);
}

__device__ __forceinline__ int win_src_col(int pc) { return pc < 2128 ? pc : (pc < C_QB ? -1 : (pc < C_END ? pc - 48 : -1)); }

__device__ __forceinline__ void transpose_tiles(const float* src, int ldsrc, int ncols_phys, bool is_win, f16* dst, float* tile  , int& unit_base, int unit_lo) {
    const int tn = ncols_phys / 64, tk = DM / 64, ntile = tn * tk;
    const int tid = otid();
    for (int u = blockIdx.x; u < ntile; u += gridDim.x) {
        const int n0 = (u % tn) * 64, k0 = (u / tn) * 64;
        __syncthreads();
#pragma unroll
        for (int i = 0; i < 8; ++i) {
            const int e = tid + i * 512, r = e >> 6, c = e & 63;
            const int pc = n0 + c; const int sc = is_win ? win_src_col(pc) : pc;
            tile[r * 65 + c] = sc >= 0 ? src[(size_t)(k0 + r) * ldsrc + sc] : 0.f;
        }
        __syncthreads();
        {
            const int n = tid >> 3, kq = (tid & 7) * 8;
            u32x4 w;
            w.x = pack_h2(tile[(kq + 0) * 65 + n], tile[(kq + 1) * 65 + n]); w.y = pack_h2(tile[(kq + 2) * 65 + n], tile[(kq + 3) * 65 + n]);
            w.z = pack_h2(tile[(kq + 4) * 65 + n], tile[(kq + 5) * 65 + n]); w.w = pack_h2(tile[(kq + 6) * 65 + n], tile[(kq + 7) * 65 + n]);
            *(u32x4*)(dst + (size_t)(n0 + n) * DM + k0 + kq) = w;
        }
    }
    (void)unit_base; (void)unit_lo;
}

__device__ __forceinline__ void cvt_f16_stream(const float* src, f16* dst, size_t n) {
    const size_t stride = (size_t)gridDim.x * NTHREADS;
    for (size_t i = (size_t)blockIdx.x * NTHREADS + otid(); i < n / 8; i += stride) {
        const f32x4 a = *(const f32x4*)(src + i * 8), b = *(const f32x4*)(src + i * 8 + 4);
        u32x4 w; w.x = pack_h2(a[0], a[1]); w.y = pack_h2(a[2], a[3]); w.z = pack_h2(b[0], b[1]); w.w = pack_h2(b[2], b[3]);
        *(u32x4*)(dst + i * 8) = w;
    }
}

__device__ __forceinline__ void phase_conv(const Params& p, LAS unsigned char* lds_) {
    float* smem = (float*)(unsigned char*)lds_;
    unsigned char* ws = p.ws;
    const int tid = otid();
    int dummy = 0;
    {
        float* cond = smem;
        float* red = smem + NB * DM;
        for (int i = tid; i < NB * DM; i += NTHREADS) { const float v = p.c[i]; cond[i] = v / (1.f + __expf(-v)); }
        __syncthreads();
        for (int u = blockIdx.x; u < DEPTH * 128; u += gridDim.x) {
            const int l = u >> 7, j0 = (u & 127) * 96;
            const int col = tid % 96, kg = tid / 96;
            float acc[NB];
#pragma unroll
            for (int b = 0; b < NB; ++b) acc[b] = 0.f;
            if (kg < 5) {
                const float* wp = p.ada_w + (size_t)l * DM * 6 * DM + j0 + col;
                for (int k = kg; k < DM; k += 5) {
                    const float w = wp[(size_t)k * 6 * DM];
#pragma unroll
                    for (int b = 0; b < NB; ++b) acc[b] += cond[b * DM + k] * w;
                }
#pragma unroll
                for (int b = 0; b < NB; ++b) red[(kg * NB + b) * 96 + col] = acc[b];
            }
            __syncthreads();
            for (int i = tid; i < NB * 96; i += NTHREADS) {
                const int b = i / 96, cc = i % 96;
                float s = p.ada_b[(size_t)l * 6 * DM + j0 + cc];
#pragma unroll
                for (int g = 0; g < 5; ++g) s += red[(g * NB + b) * 96 + cc];
                ((float*)(ws + WS_MOD))[((size_t)l * NB + b) * 6 * DM + j0 + cc] = s;
            }
            __syncthreads();
        }
    }
    {
        float2* r128 = (float2*)(ws + WS_ROPE128); float2* r64 = (float2*)(ws + WS_ROPE64);
        for (int i = blockIdx.x * NTHREADS + tid; i < SEQ * 64; i += gridDim.x * NTHREADS) {
            const int pos = i >> 6, j = i & 63;
            const float inv = powf(10000.f, -(float)j / 64.f); const float ang = (float)pos * inv;
            r128[i] = make_float2((float)cos((double)ang), (float)sin((double)ang));
        }
        for (int i = blockIdx.x * NTHREADS + tid; i < SEQ * 32; i += gridDim.x * NTHREADS) {
            const int pos = i >> 5, j = i & 31;
            const float inv = powf(10000.f, -(float)j / 32.f); const float ang = (float)pos * inv;
            r64[i] = make_float2((float)cos((double)ang), (float)sin((double)ang));
        }
    }
    __syncthreads();
    for (int l = 0; l < DEPTH; ++l) {
        transpose_tiles(p.w_in + (size_t)l * DM * INW, INW, INWP, true, (f16*)(ws + WS_WTIN) + (size_t)l * INWP * DM, smem, dummy, 0);
        transpose_tiles(p.w_out + (size_t)l * DM * DM, DM, DM, false, (f16*)(ws + WS_WTOUT) + (size_t)l * DM * DM, smem, dummy, 0);
        transpose_tiles(p.wq + (size_t)l * DM * DM, DM, DM, false, (f16*)(ws + WS_WTQ) + (size_t)l * DM * DM, smem, dummy, 0);
    }
    cvt_f16_stream(p.pu, (f16*)(ws + WS_U16), (size_t)DEPTH * PEXP * DM);
    cvt_f16_stream(p.pv, (f16*)(ws + WS_V16), (size_t)DEPTH * PEXP * DM);
    cvt_f16_stream(p.subk, (f16*)(ws + WS_SUBK), (size_t)DEPTH * PH * 2 * PNK * 128);
}

__device__ __forceinline__ void phase_norm(const Params& p, const float* xin, const float* g, const float* shift, const float* scale, f16* hout) {
    const int tid_ = otid(); const int wid = tid_ >> 6, lane = tid_ & 63;
    for (int row = blockIdx.x * NWAVES + wid; row < NT; row += gridDim.x * NWAVES) {
        const int b = row / SEQ;
        const float* xr = xin + (size_t)row * DM;
        f32x4 v[8]; float ss = 0.f;
#pragma unroll
        for (int i = 0; i < 8; ++i) { v[i] = *(const f32x4*)(xr + i * 256 + lane * 4); ss += v[i][0] * v[i][0] + v[i][1] * v[i][1] + v[i][2] * v[i][2] + v[i][3] * v[i][3]; }
        ss = wave_sum(ss);
        const float rstd = rsqrtf(ss * (1.f / DM) + EPS);
#pragma unroll
        for (int i = 0; i < 8; ++i) {
            const int col = i * 256 + lane * 4;
            const f32x4 gg = *(const f32x4*)(g + col), sh = *(const f32x4*)(shift + (size_t)b * 6 * DM + col), sc = *(const f32x4*)(scale + (size_t)b * 6 * DM + col);
            f32x4 y = v[i] * rstd * gg * (sc + 1.f) + sh;
            u32x2 w; w.x = pack_h2(y[0], y[1]); w.y = pack_h2(y[2], y[3]);
            *(u32x2*)(hout + (size_t)row * DM + col) = w;
        }
    }
}

__device__ __forceinline__ void phase_rope(const Params& p) {
    f16* proj = (f16*)(p.ws + WS_PROJ);
    const float2* r128 = (const float2*)(p.ws + WS_ROPE128); const float2* r64 = (const float2*)(p.ws + WS_ROPE64);
    constexpr int PER_TOK = (1088 + 544) / 2;
    const size_t total = (size_t)NT * PER_TOK;
    for (size_t i = (size_t)blockIdx.x * NTHREADS + otid(); i < total; i += (size_t)gridDim.x * NTHREADS) {
        const int t = (int)(i / PER_TOK); int r = (int)(i % PER_TOK) * 2;
        const int pos = t % SEQ;
        int base, half, j;
        if (r < 1088) {
            const int hh = r >> 6; j = r & 63; half = 64;
            base = hh < 6 ? C_QA + hh * 128 : (hh == 6 ? C_KA : (hh < 12 ? C_QC + (hh - 7) * 128 : C_KC + (hh - 12) * 128));
        } else {
            r -= 1088; const int hh = r >> 5; j = r & 31; half = 32;
            base = hh < 16 ? C_IQ + hh * 64 : C_IK;
        }
        f16* pp = proj + (size_t)t * INWP + base + j;
        const h2_t a = *(const h2_t*)pp, bq = *(const h2_t*)(pp + half);
        float2 cs0, cs1;
        if (half == 64) { cs0 = r128[pos * 64 + j]; cs1 = r128[pos * 64 + j + 1]; } else { cs0 = r64[pos * 32 + j]; cs1 = r64[pos * 32 + j + 1]; }
        const float a0 = (float)a.x, a1 = (float)a.y, b0 = (float)bq.x, b1 = (float)bq.y;
        h2_t oa, ob;
        oa.x = (f16)(a0 * cs0.x - b0 * cs0.y); oa.y = (f16)(a1 * cs1.x - b1 * cs1.y);
        ob.x = (f16)(b0 * cs0.x + a0 * cs0.y); ob.y = (f16)(b1 * cs1.x + a1 * cs1.y);
        *(h2_t*)pp = oa; *(h2_t*)(pp + half) = ob;
    }
}

__device__ __forceinline__ void phase_index(const Params& p, LAS unsigned char* lds_) {
    const f16* proj = (const f16*)(p.ws + WS_PROJ);
    float* smem = (float*)(unsigned char*)lds_;
    const int tid = otid(), wid = tid >> 6, lane = tid & 63;
    {
        float* red = smem;
        float* km = (float*)(p.ws + WS_KMEAN);
        for (int u = blockIdx.x; u < NB * HC * MOBA_NB; u += gridDim.x) {
            const int blk = u % MOBA_NB, h = (u / MOBA_NB) % HC, b = u / (MOBA_NB * HC);
            const int d = tid & 127, part = tid >> 7;
            float s = 0.f;
            const f16* kp = proj + ((size_t)b * SEQ + blk * MOBA_BLK + part * 64) * INWP + C_KC + h * HD + d;
            for (int k = 0; k < 64; ++k) s += (float)kp[(size_t)k * INWP];
            __syncthreads();
            red[part * 128 + d] = s;
            __syncthreads();
            if (tid < 128) km[(size_t)u * HD + tid] = (red[tid] + red[128 + tid] + red[256 + tid] + red[384 + tid]) * (1.f / MOBA_BLK);
        }
        __syncthreads();
    }
    float* wq_ = smem + wid * (IH * IDM + IH);
    float* sc = smem + NWAVES * (IH * IDM + IH) + wid * SEQ;
    unsigned* mask = (unsigned*)(p.ws + WS_MASK);
    for (int q = blockIdx.x * NWAVES + wid; q < NT; q += gridDim.x * NWAVES) {
        const int b = q / SEQ, t = q % SEQ;
        const f16* row = proj + (size_t)q * INWP;
        for (int i = lane; i < IH * IDM; i += 64) wq_[i] = (float)row[C_IQ + i];
        if (lane < IH) wq_[IH * IDM + lane] = (float)row[C_IW + lane] * 0.25f;
        __builtin_amdgcn_wave_barrier();
        const int nk = t + 1;
        for (int s = lane; s < nk; s += 64) {
            const f16* kr = proj + ((size_t)b * SEQ + s) * INWP + C_IK;
            float kf[IDM];
#pragma unroll
            for (int e8 = 0; e8 < IDM / 8; ++e8) { const h8_t kv = *(const h8_t*)(kr + e8 * 8);
#pragma unroll
                for (int j = 0; j < 8; ++j) kf[e8 * 8 + j] = (float)kv[j]; }
            float score = 0.f;
            for (int h = 0; h < IH; ++h) {
                float d = 0.f;
#pragma unroll
                for (int e = 0; e < IDM; ++e) d += wq_[h * IDM + e] * kf[e];
                score += wq_[IH * IDM + h] * fmaxf(d * 0.125f, 0.f);
            }
            sc[s] = score;
        }
        __builtin_amdgcn_wave_barrier();
        unsigned key[32];
#pragma unroll
        for (int i = 0; i < 32; ++i) {
            const int s = lane + 64 * i;
            unsigned u = 0u;
            if (s < nk) { const unsigned bits = __float_as_uint(sc[s]); u = (bits & 0x80000000u) ? ~bits : (bits | 0x80000000u); if (u == 0u) u = 1u; }
            key[i] = u;
        }
        unsigned thr = 1u;
        if (nk > DSA_TOPK) {
            thr = 0u;
            for (int bit = 31; bit >= 0; --bit) {
                const unsigned cand = thr | (1u << bit);
                int cnt = 0;
#pragma unroll
                for (int i = 0; i < 32; ++i) cnt += __builtin_popcountll(__ballot(key[i] >= cand));
                if (cnt >= DSA_TOPK) thr = cand;
            }
        }
        unsigned* mrow = mask + (size_t)q * 64;
#pragma unroll
        for (int i = 0; i < 32; ++i) {
            const unsigned long long bal = __ballot(key[i] >= thr && key[i] != 0u);
            if (lane == 0) { mrow[2 * i] = (unsigned)bal; mrow[2 * i + 1] = (unsigned)(bal >> 32); }
        }
        __builtin_amdgcn_wave_barrier();
    }
}

constexpr int IX_ROW = SEQ + 4;
__device__ __forceinline__ void index_item(const Params& p, LAS unsigned char* lds, int b, int qg) {
    const f16* proj = (const f16*)(p.ws + WS_PROJ);
    LAS float* sc = (LAS float*)lds;
    const int tid = otid(), wid = __builtin_amdgcn_readfirstlane(tid >> 6), lane = tid & 63, fr = lane & 15, fq = lane >> 4;
    const int t0 = qg * 16, nkt = qg + 1;
    h8_t Bq[IH][2]; float wq[IH];
    {
        const f16* qrow = proj + ((size_t)b * SEQ + t0 + fr) * INWP;
#pragma unroll
        for (int h = 0; h < IH; ++h) {
            Bq[h][0] = *(const h8_t*)(qrow + C_IQ + h * IDM + 8 * fq);
            Bq[h][1] = *(const h8_t*)(qrow + C_IQ + h * IDM + 32 + 8 * fq);
        }
        const h8_t w0 = *(const h8_t*)(qrow + C_IW), w1 = *(const h8_t*)(qrow + C_IW + 8);
#pragma unroll
        for (int h = 0; h < 8; ++h) { wq[h] = (float)w0[h] * (0.25f * 0.125f); wq[8 + h] = (float)w1[h] * (0.25f * 0.125f); }
    }
    __syncthreads();
    const f16* kbase = proj + ((size_t)b * SEQ + fr) * INWP + C_IK + 8 * fq;
    h8_t a0, a1, n0, n1;
    int kt = wid;
    if (kt < nkt) { a0 = *(const h8_t*)(kbase + (size_t)kt * 16 * INWP); a1 = *(const h8_t*)(kbase + (size_t)kt * 16 * INWP + 32); }
    for (; kt < nkt; kt += NWAVES) {
        const int ktn = kt + NWAVES;
        if (ktn < nkt) { n0 = *(const h8_t*)(kbase + (size_t)ktn * 16 * INWP); n1 = *(const h8_t*)(kbase + (size_t)ktn * 16 * INWP + 32); }
        f32x4 acc = {0.f, 0.f, 0.f, 0.f};
#pragma unroll
        for (int h = 0; h < IH; ++h) {
            f32x4 c = {0.f, 0.f, 0.f, 0.f};
            c = __builtin_amdgcn_mfma_f32_16x16x32_f16(a0, Bq[h][0], c, 0, 0, 0);
            c = __builtin_amdgcn_mfma_f32_16x16x32_f16(a1, Bq[h][1], c, 0, 0, 0);
#pragma unroll
            for (int j = 0; j < 4; ++j) acc[j] += wq[h] * fmaxf(c[j], 0.f);
        }
        *(LAS f32x4*)(sc + fr * IX_ROW + kt * 16 + 4 * fq) = acc;
        a0 = n0; a1 = n1;
    }
    __syncthreads();
    unsigned* mask = (unsigned*)(p.ws + WS_MASK);
#pragma unroll 1
    for (int qq = 0; qq < 2; ++qq) {
        const int ql = 2 * wid + qq, t = t0 + ql, nk = t + 1;
        unsigned key[32];
#pragma unroll
        for (int i = 0; i < 32; ++i) {
            const int s = lane + 64 * i;
            unsigned u = 0u;
            if (s < nk) { const unsigned bits = __float_as_uint(sc[ql * IX_ROW + s]); u = (bits & 0x80000000u) ? ~bits : (bits | 0x80000000u); if (u == 0u) u = 1u; }
            key[i] = u;
        }
        unsigned thr = 1u;
        if (nk > DSA_TOPK) {
            thr = 0u;
            for (int bit = 31; bit >= 0; --bit) {
                const unsigned cand = thr | (1u << bit);
                int cnt = 0;
#pragma unroll
                for (int i = 0; i < 32; ++i) cnt += __builtin_popcountll(__ballot(key[i] >= cand));
                if (cnt >= DSA_TOPK) thr = cand;
            }
        }
        unsigned* mrow = mask + ((size_t)b * SEQ + t) * 64;
        unsigned myw = 0u;
#pragma unroll
        for (int i = 0; i < 32; ++i) {
            const unsigned long long bal = __ballot(key[i] >= thr && key[i] != 0u);
            if (lane == 2 * i) myw = (unsigned)bal;
            if (lane == 2 * i + 1) myw = (unsigned)(bal >> 32);
        }
        mrow[lane] = myw;
    }
}

__device__ __forceinline__ void phase_index2(const Params& p, LAS unsigned char* lds_) {
    const f16* proj = (const f16*)(p.ws + WS_PROJ);
    float* smem = (float*)(unsigned char*)lds_;
    const int tid = otid();
    {
        float* red = smem;
        float* km = (float*)(p.ws + WS_KMEAN);
        for (int u = obid(); u < NB * HC * MOBA_NB; u += gridDim.x) {
            const int blk = u % MOBA_NB, h = (u / MOBA_NB) % HC, b = u / (MOBA_NB * HC);
            const int d = tid & 127, part = tid >> 7;
            float s = 0.f;
            const f16* kp = proj + ((size_t)b * SEQ + blk * MOBA_BLK + part * 64) * INWP + C_KC + h * HD + d;
            for (int k = 0; k < 64; ++k) s += (float)kp[(size_t)k * INWP];
            __syncthreads();
            red[part * 128 + d] = s;
            __syncthreads();
            if (tid < 128) km[(size_t)u * HD + tid] = (red[tid] + red[128 + tid] + red[256 + tid] + red[384 + tid]) * (1.f / MOBA_BLK);
        }
        __syncthreads();
    }
    for (int pi = obid(); pi < NB * 64; pi += gridDim.x) {
        const int b = pi >> 6, a = pi & 63;
        index_item(p, lds_, b, 127 - a);
        index_item(p, lds_, b, a);
    }
}

__device__ __forceinline__ void phase_attn(const Params& p, LAS unsigned char* lds_, const float* ong) {
    const f16* proj = (const f16*)(p.ws + WS_PROJ);
    float* smem = (float*)(unsigned char*)lds_;
    const int tid = otid(), wid = tid >> 6, lane = tid & 63;
    float* pbuf = smem + wid * SEQ;
    const float* km = (const float*)(p.ws + WS_KMEAN);
    const unsigned* mask = (const unsigned*)(p.ws + WS_MASK);
    f16* y = (f16*)(p.ws + WS_Y);
    const float scale = 0.08838834764831845f;
    const size_t nitems = (size_t)NT * NHEADS;
    for (size_t it = (size_t)blockIdx.x * NWAVES + wid; it < nitems; it += (size_t)gridDim.x * NWAVES) {
        const int hh = (int)(it % NHEADS); const int q = (int)(it / NHEADS);
        const int b = q / SEQ, t = q % SEQ;
        int qc, kc, vc, var;
        if (hh < HA) { var = 0; qc = C_QA + hh * HD; kc = C_KA; vc = C_VA; }
        else if (hh < HA + HB) { var = 1; qc = C_QB + (hh - HA) * HD; kc = C_KB + (hh - HA) * HD; vc = C_VB + (hh - HA) * HD; }
        else { var = 2; qc = C_QC + (hh - HA - HB) * HD; kc = C_KC + (hh - HA - HB) * HD; vc = C_VC + (hh - HA - HB) * HD; }
        unsigned qv[64];
        { const u32x4* qp = (const u32x4*)(proj + (size_t)q * INWP + qc);
#pragma unroll
          for (int i = 0; i < 16; ++i) { const u32x4 w = qp[i]; qv[4 * i] = w.x; qv[4 * i + 1] = w.y; qv[4 * i + 2] = w.z; qv[4 * i + 3] = w.w; } }
        unsigned allowed = 0xffu;
        const int own = t / MOBA_BLK;
        if (var == 2) {
            float g = -INFINITY;
            if (lane < own) {
                const float* kmp = km + (((size_t)b * HC + (hh - HA - HB)) * MOBA_NB + lane) * HD;
                float s = 0.f;
#pragma unroll
                for (int i = 0; i < 64; ++i) s += h_lo(qv[i]) * kmp[2 * i] + h_hi(qv[i]) * kmp[2 * i + 1];
                g = s;
            }
            float gs[MOBA_NB];
#pragma unroll
            for (int j = 0; j < MOBA_NB; ++j) gs[j] = __shfl(g, j);
            allowed = 1u << own;
#pragma unroll
            for (int j = 0; j < MOBA_NB; ++j) {
                if (j < own) {
                    int rank = 0;
#pragma unroll
                    for (int k2 = 0; k2 < MOBA_NB; ++k2) if (k2 < own && (gs[k2] > gs[j] || (gs[k2] == gs[j] && k2 < j))) ++rank;
                    if (rank < 3) allowed |= 1u << j;
                }
            }
        }
        const int nk = t + 1;
        const int nkl = (nk + 63) >> 6;
        const unsigned* mrow = mask + (size_t)q * 64;
        float z[32];
#pragma unroll
        for (int i = 0; i < 32; ++i) {
            z[i] = -INFINITY;
            if (i < nkl) {
                const int s = nkl * lane + i;
                if (s < nk) {
                    bool ok = true;
                    if (var == 0) ok = (mrow[s >> 5] >> (s & 31)) & 1u;
                    if (var == 2) ok = (allowed >> (s / MOBA_BLK)) & 1u;
                    if (var == 1) ok = s < t;
                    if (ok) {
                        const u32x4* kp = (const u32x4*)(proj + ((size_t)b * SEQ + s) * INWP + kc);
                        float d = 0.f;
#pragma unroll
                        for (int c4 = 0; c4 < 16; ++c4) { const u32x4 w = kp[c4]; d = dot2(qv[4 * c4], w.x, d); d = dot2(qv[4 * c4 + 1], w.y, d); d = dot2(qv[4 * c4 + 2], w.z, d); d = dot2(qv[4 * c4 + 3], w.w, d); }
                        z[i] = d * scale;
                    }
                }
            }
        }
        float inv_l = 1.f;
        if (var != 1) {
            float m = -INFINITY;
#pragma unroll
            for (int i = 0; i < 32; ++i) m = fmaxf(m, z[i]);
            m = wave_max(m);
            float l = 0.f;
#pragma unroll
            for (int i = 0; i < 32; ++i) { const float e = (z[i] == -INFINITY) ? 0.f : __expf(z[i] - m); z[i] = e; l += e; }
            l = wave_sum(l);
            inv_l = 1.f / l;
        } else {
            float lk[32]; float tot = 0.f;
#pragma unroll
            for (int i = 31; i >= 0; --i) {
                float v = 0.f;
                if (z[i] != -INFINITY) { const float zz = z[i]; v = -(fmaxf(zz, 0.f) + log1pf(__expf(-fabsf(zz)))); }
                tot += v; lk[i] = tot;
            }
            float incl = tot;
#pragma unroll
            for (int o = 1; o < 64; o <<= 1) { const float v = __shfl_down(incl, o); if (lane + o < 64) incl += v; }
            const float excl = incl - tot;
#pragma unroll
            for (int i = 0; i < 32; ++i) z[i] = (z[i] == -INFINITY) ? 0.f : __expf(z[i] + lk[i] + excl);
        }
#pragma unroll
        for (int i = 0; i < 32; ++i) if (i < nkl) { const int s = nkl * lane + i; if (s < SEQ) pbuf[s] = z[i]; }
        __builtin_amdgcn_wave_barrier();
        float o0 = 0.f, o1 = 0.f;
        const f16* vp = proj + (size_t)b * SEQ * INWP + vc + 2 * lane;
        for (int s0 = 0; s0 < nk; s0 += 8) {
            float pr[8]; bool any = false;
#pragma unroll
            for (int j = 0; j < 8; ++j) { pr[j] = pbuf[s0 + j]; any = any || (pr[j] != 0.f); }
            if (any) {
                unsigned w[8];
#pragma unroll
                for (int j = 0; j < 8; ++j) w[j] = *(const unsigned*)(vp + (size_t)(s0 + j) * INWP);
#pragma unroll
                for (int j = 0; j < 8; ++j) { o0 += pr[j] * h_lo(w[j]); o1 += pr[j] * h_hi(w[j]); }
            }
        }
        o0 *= inv_l; o1 *= inv_l;
        const float ss = wave_sum(o0 * o0 + o1 * o1);
        const float rstd = rsqrtf(ss * (1.f / HD) + EPS);
        const float g0 = ong[hh * HD + 2 * lane], g1 = ong[hh * HD + 2 * lane + 1];
        *(unsigned*)(y + (size_t)q * DM + hh * HD + 2 * lane) = pack_h2(o0 * rstd * g0, o1 * rstd * g1);
        __builtin_amdgcn_wave_barrier();
    }
}

typedef short s4_t __attribute__((ext_vector_type(4)));
typedef float f32x16 __attribute__((ext_vector_type(16)));
constexpr int AT_KSTR = 272, AT_VSTR = 320, AT_KBYTES = 64 * AT_KSTR, AT_VBYTES = 64 * AT_VSTR, AT_STAGE = AT_KBYTES + AT_VBYTES;
__device__ __forceinline__ float fexp2(float x) { return __builtin_amdgcn_exp2f(x); }
__device__ __forceinline__ float flog2(float x) { return __builtin_amdgcn_logf(x); }

template <int VAR>
__device__ __forceinline__ void attn_item(const Params& p, LAS unsigned char* lds, const float* ong, int b, int hh, int qt, int qc, int kc, int vc) {
    const f16* proj = (const f16*)(p.ws + WS_PROJ);
    const int tid = otid(), wid = __builtin_amdgcn_readfirstlane(tid >> 6), lane = tid & 63, qn = lane & 31, hf = lane >> 5;
    const int q0 = qt * 256, qrow = q0 + 32 * wid + qn;
    const size_t grow = (size_t)b * SEQ + qrow;
    h8_t Qf[8];
    {
        const float sc = 0.08838834764831845f * 1.4426950408889634f;
        const f16* qp = proj + grow * INWP + qc + 8 * hf;
#pragma unroll
        for (int ks = 0; ks < 8; ++ks) {
            const h8_t v = *(const h8_t*)(qp + 16 * ks);
            h8_t w;
#pragma unroll
            for (int j = 0; j < 8; ++j) w[j] = (f16)((float)v[j] * sc);
            Qf[ks] = w;
        }
    }
    unsigned allowed = 0xffu;
    if (VAR == 2) {
        const int own = qt;
        const float* km = (const float*)(p.ws + WS_KMEAN) + ((size_t)b * HC + (hh - HA - HB)) * MOBA_NB * HD + 8 * hf;
        float gs[MOBA_NB];
#pragma unroll
        for (int j = 0; j < MOBA_NB; ++j) gs[j] = -INFINITY;
#pragma unroll
        for (int j = 0; j < MOBA_NB - 1; ++j) {
            if (j < own) {
                float s = 0.f;
#pragma unroll
                for (int ks = 0; ks < 8; ++ks) {
                    const f32x4 k0 = *(const f32x4*)(km + j * HD + 16 * ks), k1 = *(const f32x4*)(km + j * HD + 16 * ks + 4);
                    s += (float)Qf[ks][0] * k0[0] + (float)Qf[ks][1] * k0[1] + (float)Qf[ks][2] * k0[2] + (float)Qf[ks][3] * k0[3]
                       + (float)Qf[ks][4] * k1[0] + (float)Qf[ks][5] * k1[1] + (float)Qf[ks][6] * k1[2] + (float)Qf[ks][7] * k1[3];
                }
                gs[j] = s + __shfl_xor(s, 32);
            }
        }
        allowed = 1u << own;
#pragma unroll
        for (int j = 0; j < MOBA_NB - 1; ++j) {
            if (j < own) {
                int rank = 0;
#pragma unroll
                for (int k2 = 0; k2 < MOBA_NB - 1; ++k2) if (k2 < own && (gs[k2] > gs[j] || (gs[k2] == gs[j] && k2 < j))) ++rank;
                if (rank < 3) allowed |= 1u << j;
            }
        }
    }
    f32x16 O[4];
#pragma unroll
    for (int dt = 0; dt < 4; ++dt)
#pragma unroll
        for (int r = 0; r < 16; ++r) O[dt][r] = 0.f;
    float m_run = -INFINITY, l_run = 0.f, carry = 0.f;
    const int nst = (qt + 1) * 4;
    const int st_hi_w = qt * 4 + (wid >> 1);
    const int sr0 = tid >> 4, sc0 = tid & 15;
    const f16* kg = proj + ((size_t)b * SEQ + sr0) * INWP + kc + 8 * sc0;
    const f16* vg = proj + ((size_t)b * SEQ + sr0) * INWP + vc + 8 * sc0;
    const unsigned kw = sr0 * AT_KSTR + 16 * sc0, vw = AT_KBYTES + sr0 * AT_VSTR + 16 * sc0;
    const unsigned* mrow = (const unsigned*)(p.ws + WS_MASK) + grow * 64;
    const unsigned ka = qn * AT_KSTR + 16 * hf;
    const unsigned va = AT_KBYTES + (4 * hf + ((lane & 15) >> 2)) * AT_VSTR + (16 * ((lane >> 4) & 1) + 4 * (lane & 3)) * 2;
    u32x4 rk0, rk1, rv0, rv1; u32x2 mw = {0u, 0u}, mwn = {0u, 0u};
#define AT_LOAD(st_) do { const size_t o_ = (size_t)(st_) * 64 * INWP; rk0 = *(const u32x4*)(kg + o_); rk1 = *(const u32x4*)(kg + o_ + (size_t)32 * INWP); \
        rv0 = *(const u32x4*)(vg + o_); rv1 = *(const u32x4*)(vg + o_ + (size_t)32 * INWP); if (VAR == 0) mwn = *(const u32x2*)(mrow + 2 * (st_)); } while (0)
#define AT_WRITE(buf_) do { LAS unsigned char* b_ = lds + (buf_) * AT_STAGE; *(LAS u32x4*)(b_ + kw) = rk0; *(LAS u32x4*)(b_ + kw + 32 * AT_KSTR) = rk1; \
        *(LAS u32x4*)(b_ + vw) = rv0; *(LAS u32x4*)(b_ + vw + 32 * AT_VSTR) = rv1; } while (0)
    __syncthreads();
    AT_LOAD(nst - 1); AT_WRITE(0); mw = mwn;
    __syncthreads();
    int cur = 0;
    for (int st = nst - 1; st >= 0; --st) {
        if (st > 0) AT_LOAD(st - 1);
        if (st <= st_hi_w) {
            LAS unsigned char* kb = lds + cur * AT_STAGE;
            f32x16 S[2];
#pragma unroll
            for (int r = 0; r < 16; ++r) { S[0][r] = 0.f; S[1][r] = 0.f; }
#pragma unroll
            for (int ks = 0; ks < 8; ++ks) {
                const h8_t a0 = *(const LAS h8_t*)(kb + ka + 32 * ks), a1 = *(const LAS h8_t*)(kb + ka + 32 * ks + 32 * AT_KSTR);
                S[0] = __builtin_amdgcn_mfma_f32_32x32x16_f16(a0, Qf[ks], S[0], 0, 0, 0);
                S[1] = __builtin_amdgcn_mfma_f32_32x32x16_f16(a1, Qf[ks], S[1], 0, 0, 0);
            }
            const bool diag = (64 * st + 63 > q0 + 32 * wid);
            const int kbase = 64 * st + 4 * hf;
            if (VAR != 1) {
                const bool blk_ok = (VAR == 2) ? ((allowed >> (st >> 2)) & 1u) : true;
                float mx = -INFINITY;
#pragma unroll
                for (int sub = 0; sub < 2; ++sub)
#pragma unroll
                    for (int r = 0; r < 16; ++r) {
                        const int kl = (r & 3) + 8 * (r >> 2);
                        bool ok;
                        if (VAR == 0) ok = ((sub == 0 ? mw.x : mw.y) >> (kl + 4 * hf)) & 1u;
                        else ok = blk_ok && (!diag || (kbase + 32 * sub + kl <= qrow));
                        const float v = ok ? S[sub][r] : -INFINITY;
                        S[sub][r] = v; mx = fmaxf(mx, v);
                    }
                mx = fmaxf(mx, __shfl_xor(mx, 32));
                const float m_new = fmaxf(m_run, mx);
                const float m_use = (m_new == -INFINITY) ? 0.f : m_new;
                const float alpha = fexp2(m_run - m_use);
                float ps = 0.f;
#pragma unroll
                for (int sub = 0; sub < 2; ++sub)
#pragma unroll
                    for (int r = 0; r < 16; ++r) { const float e = fexp2(S[sub][r] - m_use); S[sub][r] = e; ps += e; }
                l_run = l_run * alpha + ps;
                m_run = m_new;
                if (__ballot(alpha != 1.f) != 0ull) {
#pragma unroll
                    for (int dt = 0; dt < 4; ++dt)
#pragma unroll
                        for (int r = 0; r < 16; ++r) O[dt][r] *= alpha;
                }
            } else {
#pragma unroll
                for (int sub = 1; sub >= 0; --sub) {
                    float lk[16];
#pragma unroll
                    for (int r = 0; r < 16; ++r) {
                        const int kl = (r & 3) + 8 * (r >> 2);
                        const bool ok = !diag || (kbase + 32 * sub + kl < qrow);
                        const float zl = S[sub][r];
                        const float sp = fmaxf(zl, 0.f) + flog2(1.f + fexp2(-fabsf(zl)));
                        lk[r] = ok ? -sp : 0.f;
                        S[sub][r] = ok ? zl : -INFINITY;
                    }
                    float gsum[4], pg[4], T[4];
#pragma unroll
                    for (int g = 0; g < 4; ++g) { gsum[g] = (lk[4 * g] + lk[4 * g + 1]) + (lk[4 * g + 2] + lk[4 * g + 3]); pg[g] = __shfl_xor(gsum[g], 32); T[g] = gsum[g] + pg[g]; }
                    float after[4];
                    after[3] = 0.f; after[2] = T[3]; after[1] = T[3] + T[2]; after[0] = T[3] + T[2] + T[1];
#pragma unroll
                    for (int g = 0; g < 4; ++g) {
                        const float base = carry + after[g] + (hf == 0 ? pg[g] : 0.f);
                        const float c3 = lk[4 * g + 3], c2 = lk[4 * g + 2] + c3, c1 = lk[4 * g + 1] + c2, c0 = lk[4 * g] + c1;
                        S[sub][4 * g + 3] = fexp2(S[sub][4 * g + 3] + base + c3);
                        S[sub][4 * g + 2] = fexp2(S[sub][4 * g + 2] + base + c2);
                        S[sub][4 * g + 1] = fexp2(S[sub][4 * g + 1] + base + c1);
                        S[sub][4 * g + 0] = fexp2(S[sub][4 * g + 0] + base + c0);
                    }
                    carry += (T[0] + T[1]) + (T[2] + T[3]);
                }
            }
#pragma unroll
            for (int sub = 0; sub < 2; ++sub)
#pragma unroll
                for (int s2 = 0; s2 < 2; ++s2) {
                    h8_t pb;
#pragma unroll
                    for (int j = 0; j < 8; ++j) pb[j] = (f16)S[sub][8 * s2 + j];
#pragma unroll
                    for (int dt = 0; dt < 4; ++dt) {
                        const LAS unsigned char* ap = kb + va + (32 * sub + 16 * s2) * AT_VSTR + 64 * dt;
                        const s4_t t0 = __builtin_amdgcn_ds_read_tr16_b64_v4i16((LAS s4_t*)ap);
                        const s4_t t1 = __builtin_amdgcn_ds_read_tr16_b64_v4i16((LAS s4_t*)(ap + 8 * AT_VSTR));
                        typedef short s8_t __attribute__((ext_vector_type(8)));
                        const s8_t a8 = __builtin_shufflevector(t0, t1, 0, 1, 2, 3, 4, 5, 6, 7);
                        O[dt] = __builtin_amdgcn_mfma_f32_32x32x16_f16(__builtin_bit_cast(h8_t, a8), pb, O[dt], 0, 0, 0);
                    }
                }
        }
        if (st > 0) { AT_WRITE(cur ^ 1); }
        mw = mwn;
        __syncthreads();
        cur ^= 1;
    }
#undef AT_LOAD
#undef AT_WRITE
    float inv = 1.f;
    if (VAR != 1) { const float lt = l_run + __shfl_xor(l_run, 32); inv = 1.f / lt; }
    float ss = 0.f;
#pragma unroll
    for (int dt = 0; dt < 4; ++dt)
#pragma unroll
        for (int r = 0; r < 16; ++r) { const float v = O[dt][r] * inv; O[dt][r] = v; ss += v * v; }
    ss += __shfl_xor(ss, 32);
    const float rstd = rsqrtf(ss * (1.f / HD) + EPS);
    f16* yp = (f16*)(p.ws + WS_Y) + grow * DM + hh * HD + 4 * hf;
    const float* gp = ong + hh * HD + 4 * hf;
#pragma unroll
    for (int dt = 0; dt < 4; ++dt)
#pragma unroll
        for (int g = 0; g < 4; ++g) {
            const f32x4 gg = *(const f32x4*)(gp + 32 * dt + 8 * g);
            u32x2 w; w.x = pack_h2(O[dt][4 * g] * rstd * gg[0], O[dt][4 * g + 1] * rstd * gg[1]); w.y = pack_h2(O[dt][4 * g + 2] * rstd * gg[2], O[dt][4 * g + 3] * rstd * gg[3]);
            *(u32x2*)(yp + 32 * dt + 8 * g) = w;
        }
}

__device__ __forceinline__ void phase_attn2(const Params& p, LAS unsigned char* lds, const float* ong) {
    for (int pi = obid(); pi < 512; pi += gridDim.x) {
        const int a = pi & 3, bh = pi >> 2, b = bh >> 4;
        int hh = bh & 15; if (pi >= 256) hh = (hh + 8) & 15;
        for (int e = 0; e < 2; ++e) {
            const int qt = e == 0 ? 7 - a : a;
            if (hh < HA) attn_item<0>(p, lds, ong, b, hh, qt, C_QA + hh * HD, C_KA, C_VA);
            else if (hh < HA + HB) attn_item<1>(p, lds, ong, b, hh, qt, C_QB + (hh - HA) * HD, C_KB + (hh - HA) * HD, C_VB + (hh - HA) * HD);
            else attn_item<2>(p, lds, ong, b, hh, qt, C_QC + (hh - HA - HB) * HD, C_KC + (hh - HA - HB) * HD, C_VC + (hh - HA - HB) * HD);
        }
    }
}

__device__ __forceinline__ void wave_argmax(float& v, int& idx) {
#pragma unroll
    for (int o = 32; o >= 1; o >>= 1) {
        const float ov = __shfl_xor(v, o); const int oi = __shfl_xor(idx, o);
        if (ov > v || (ov == v && oi < idx)) { v = ov; idx = oi; }
    }
}
__device__ __forceinline__ void phase_route(const Params& p, LAS unsigned char* lds_, const f16* subk) {
    const f16* qp = (const f16*)(p.ws + WS_Y);
    float* smem = (float*)(unsigned char*)lds_;
    const int tid = otid(), wid = tid >> 6, lane = tid & 63;
    float* qs = smem + wid * 256;
    unsigned* pe = (unsigned*)(p.ws + WS_PE); float* pg = (float*)(p.ws + WS_PG);
    const size_t nitems = (size_t)NT * PH;
    for (size_t it = (size_t)blockIdx.x * NWAVES + wid; it < nitems; it += (size_t)gridDim.x * NWAVES) {
        const int hp = (int)(it % PH); const int t = (int)(it / PH);
        const f16* qrow = qp + (size_t)t * DM + hp * 256;
        for (int i = lane; i < 256; i += 64) qs[i] = (float)qrow[i];
        __builtin_amdgcn_wave_barrier();
        float sv[2]; int si[2];
#pragma unroll
        for (int c = 0; c < 2; ++c) {
            float v0, v1;
            {
                const f16* k0 = subk + (((size_t)hp * 2 + c) * PNK + lane) * 128;
                const f16* k1 = k0 + 64 * 128;
                float a0 = 0.f, a1 = 0.f;
#pragma unroll 4
                for (int e8 = 0; e8 < 16; ++e8) {
                    const h8_t x0 = *(const h8_t*)(k0 + e8 * 8), x1 = *(const h8_t*)(k1 + e8 * 8);
#pragma unroll
                    for (int j = 0; j < 8; ++j) { const float qq = qs[c * 128 + e8 * 8 + j]; a0 += qq * (float)x0[j]; a1 += qq * (float)x1[j]; }
                }
                v0 = a0; v1 = a1;
            }
            float mysv = 0.f; int mysi = 0;
            for (int r = 0; r < PTOPK; ++r) {
                float v; int idx;
                if (v0 >= v1) { v = v0; idx = lane; } else { v = v1; idx = lane + 64; }
                wave_argmax(v, idx);
                if (idx == lane) v0 = -INFINITY;
                if (idx == lane + 64) v1 = -INFINITY;
                if (lane == r) { mysv = v; mysi = idx; }
            }
            sv[c] = mysv; si[c] = mysi;
        }
        float cs[4];
#pragma unroll
        for (int k = 0; k < 4; ++k) { const int id = 4 * lane + k; cs[k] = __shfl(sv[0], id >> 4) + __shfl(sv[1], id & 15); }
        float tops = 0.f; int pick = 0;
        for (int r = 0; r < PTOPK; ++r) {
            float v = cs[0]; int idx = 4 * lane;
#pragma unroll
            for (int k = 1; k < 4; ++k) if (cs[k] > v) { v = cs[k]; idx = 4 * lane + k; }
            wave_argmax(v, idx);
#pragma unroll
            for (int k = 0; k < 4; ++k) if (idx == 4 * lane + k) cs[k] = -INFINITY;
            if (lane == r) { tops = v; pick = idx; }
        }
        const int e0 = __shfl(si[0], pick >> 4), e1 = __shfl(si[1], pick & 15);
        const float mx = __shfl(tops, 0);
        float ex = lane < PTOPK ? __expf(tops - mx) : 0.f;
        const float sum = wave_sum(ex);
        if (lane < PTOPK) { pe[(size_t)t * 128 + hp * 16 + lane] = (unsigned)(e0 * PNK + e1); pg[(size_t)t * 128 + hp * 16 + lane] = ex / sum; }
        __builtin_amdgcn_wave_barrier();
    }
}

#define CE_DESC(a, b) do { const unsigned _x = (a) > (b) ? (a) : (b), _y = (a) > (b) ? (b) : (a); (a) = _x; (b) = _y; } while (0)
__device__ __forceinline__ void sort16_desc(unsigned (&k)[16]) {
#pragma unroll
    for (int kk = 2; kk <= 16; kk <<= 1)
#pragma unroll
        for (int j = kk >> 1; j > 0; j >>= 1)
#pragma unroll
            for (int i = 0; i < 16; ++i) { const int l = i ^ j; if (l > i) { if ((i & kk) == 0) CE_DESC(k[i], k[l]); else CE_DESC(k[l], k[i]); } }
}
__device__ __forceinline__ void merge16_desc(unsigned (&a)[16], const unsigned (&b)[16]) {
#pragma unroll
    for (int i = 0; i < 16; ++i) a[i] = a[i] > b[15 - i] ? a[i] : b[15 - i];
#pragma unroll
    for (int j = 8; j > 0; j >>= 1)
#pragma unroll
        for (int i = 0; i < 16; ++i) { const int l = i ^ j; if (l > i) CE_DESC(a[i], a[l]); }
}
__device__ __forceinline__ unsigned f2sort(float f) { const unsigned b = __float_as_uint(f); return b ^ ((unsigned)((int)b >> 31) | 0x80000000u); }
__device__ __forceinline__ float sort2f(unsigned u) { const unsigned b = (u & 0x80000000u) ? (u ^ 0x80000000u) : ~u; return __uint_as_float(b); }
constexpr int RT_STR = 272;
__device__ __forceinline__ void phase_route2(const Params& p, LAS unsigned char* lds, const f16* subk) {
    const f16* qp = (const f16*)(p.ws + WS_Y);
    unsigned* pe = (unsigned*)(p.ws + WS_PE); float* pg = (float*)(p.ws + WS_PG);
    const int tid = otid(), wid = __builtin_amdgcn_readfirstlane(tid >> 6), lane = tid & 63, qn = lane & 31, hf = lane >> 5;
    for (int item = obid(); item < 256; item += gridDim.x) {
        const int hp = item & 7, tg = item >> 3;
        __syncthreads();
        {
            const f16* src = subk + (size_t)hp * 256 * 128;
#pragma unroll
            for (int i = 0; i < 8; ++i) { const int e = tid + i * 512, r = e >> 4, c = e & 15; *(LAS u32x4*)(lds + r * RT_STR + 16 * c) = *(const u32x4*)(src + r * 128 + 8 * c); }
        }
        __syncthreads();
#pragma unroll 1
        for (int it = 0; it < 2; ++it) {
            const int t = (tg * 16 + wid * 2 + it) * 32 + qn;
            unsigned top[2][16];
#pragma unroll
            for (int c = 0; c < 2; ++c) {
                h8_t Bq[8];
                const f16* qrow = qp + (size_t)t * DM + hp * 256 + c * 128 + 8 * hf;
#pragma unroll
                for (int ks = 0; ks < 8; ++ks) Bq[ks] = *(const h8_t*)(qrow + 16 * ks);
                unsigned run[16];
#pragma unroll 1
                for (int nt = 0; nt < 4; ++nt) {
                    f32x16 S;
#pragma unroll
                    for (int r = 0; r < 16; ++r) S[r] = 0.f;
#pragma unroll
                    for (int ks = 0; ks < 8; ++ks) {
                        const h8_t a = *(const LAS h8_t*)(lds + (c * 128 + nt * 32 + qn) * RT_STR + 32 * ks + 16 * hf);
                        S = __builtin_amdgcn_mfma_f32_32x32x16_f16(a, Bq[ks], S, 0, 0, 0);
                    }
                    unsigned k[16];
#pragma unroll
                    for (int r = 0; r < 16; ++r) { const int n = 32 * nt + (r & 3) + 8 * (r >> 2) + 4 * hf; k[r] = (f2sort(S[r]) & ~127u) | (unsigned)(127 - n); }
                    sort16_desc(k);
                    if (nt == 0) {
#pragma unroll
                        for (int r = 0; r < 16; ++r) run[r] = k[r];
                    } else merge16_desc(run, k);
                }
#pragma unroll
                for (int r = 0; r < 16; ++r) top[c][r] = run[r];
            }
            unsigned mine[16], oth[16];
#pragma unroll
            for (int r = 0; r < 16; ++r) { const unsigned send = hf ? top[0][r] : top[1][r]; oth[r] = __shfl_xor(send, 32); mine[r] = hf ? top[1][r] : top[0][r]; }
            merge16_desc(mine, oth);
            unsigned ka[16], kb2[16];
#pragma unroll
            for (int r = 0; r < 16; ++r) { const unsigned o = __shfl_xor(mine[r], 32); ka[r] = hf ? o : mine[r]; kb2[r] = hf ? mine[r] : o; }
            float sa[16], sb[16]; unsigned na[4] = {0u, 0u, 0u, 0u}, nb[4] = {0u, 0u, 0u, 0u};
#pragma unroll
            for (int r = 0; r < 16; ++r) {
                sa[r] = sort2f(ka[r] & ~127u); sb[r] = sort2f(kb2[r] & ~127u);
                na[r >> 2] |= (127u - (ka[r] & 127u)) << (8 * (r & 3)); nb[r >> 2] |= (127u - (kb2[r] & 127u)) << (8 * (r & 3));
            }
            unsigned cand[4][16];
#pragma unroll
            for (int g = 0; g < 4; ++g)
#pragma unroll
                for (int r = 0; r < 16; ++r) cand[g][r] = 0u;
#pragma unroll
            for (int slot = 0; slot < 50; ++slot) {
                constexpr unsigned char CIJ[64] = {0, 1, 2, 3, 4, 5, 6, 7, 8, 9, 10, 11, 12, 13, 14, 15, 16, 17, 18, 19, 20, 21, 22, 23, 32, 33, 34, 35, 36, 48, 49, 50, 51, 64, 65, 66, 80, 81, 96, 97, 112, 113, 128, 144, 160, 176, 192, 208, 224, 240, 255, 255, 255, 255, 255, 255, 255, 255, 255, 255, 255, 255, 255, 255};
                const int ij = CIJ[slot], i = ij >> 4, j = ij & 15;
                cand[slot >> 4][slot & 15] = (f2sort(sa[i] + sb[j]) & ~255u) | (unsigned)(255 - ij);
            }
#pragma unroll
            for (int g = 1; g < 4; ++g) sort16_desc(cand[g]);
            merge16_desc(cand[0], cand[1]); merge16_desc(cand[2], cand[3]); merge16_desc(cand[0], cand[2]);
            float ex[16]; float sum = 0.f;
            const float mx = sort2f(cand[0][0] & ~255u);
#pragma unroll
            for (int r = 0; r < 16; ++r) { ex[r] = __expf(sort2f(cand[0][r] & ~255u) - mx); sum += ex[r]; }
            const float inv = 1.f / sum;
            unsigned eo[16];
#pragma unroll
            for (int r = 0; r < 16; ++r) {
                const unsigned id = 255u - (cand[0][r] & 255u), i = id >> 4, j = id & 15u;
                const unsigned wa = (i & 8u) ? ((i & 4u) ? na[3] : na[2]) : ((i & 4u) ? na[1] : na[0]);
                const unsigned wb = (j & 8u) ? ((j & 4u) ? nb[3] : nb[2]) : ((j & 4u) ? nb[1] : nb[0]);
                eo[r] = ((wa >> (8 * (i & 3u))) & 255u) * PNK + ((wb >> (8 * (j & 3u))) & 255u);
                ex[r] *= inv;
            }
            if (hf == 0) {
#pragma unroll
                for (int r4 = 0; r4 < 4; ++r4) { u32x4 w; w.x = eo[4 * r4]; w.y = eo[4 * r4 + 1]; w.z = eo[4 * r4 + 2]; w.w = eo[4 * r4 + 3]; *(u32x4*)(pe + (size_t)t * 128 + hp * 16 + 4 * r4) = w; }
            } else {
#pragma unroll
                for (int r4 = 0; r4 < 4; ++r4) { f32x4 w; w[0] = ex[4 * r4]; w[1] = ex[4 * r4 + 1]; w[2] = ex[4 * r4 + 2]; w[3] = ex[4 * r4 + 3]; *(f32x4*)(pg + (size_t)t * 128 + hp * 16 + 4 * r4) = w; }
            }
        }
    }
}

__device__ __forceinline__ void phase_experts(const Params& p, const f16* h2, const float* x1, const float* gate2  , const f16* u16, const f16* v16,
                              float* xout  , bool final_norm, const float* ng, const float* nshift, const float* nscale, f16* hnext, float* fout) {
    const int tid_ = otid(); const int wid = tid_ >> 6, lane = tid_ & 63;
    const unsigned* pe = (const unsigned*)(p.ws + WS_PE); const float* pg = (const float*)(p.ws + WS_PG);
    for (int t = blockIdx.x * NWAVES + wid; t < NT; t += gridDim.x * NWAVES) {
        const int b = t / SEQ;
        u32x4 hv[4];
#pragma unroll
        for (int i = 0; i < 4; ++i) hv[i] = *(const u32x4*)(h2 + (size_t)t * DM + 512 * i + 8 * lane);
        float acc[32];
#pragma unroll
        for (int i = 0; i < 32; ++i) acc[i] = 0.f;
        for (int g8 = 0; g8 < 32; ++g8) {
            const unsigned myexp = pe[(size_t)t * 128 + g8 * 4 + (lane & 3)];
            const float mygate = pg[(size_t)t * 128 + g8 * 4 + (lane & 3)];
            float part[4];
#pragma unroll
            for (int k = 0; k < 4; ++k) {
                const unsigned e = __shfl(myexp, k);
                const f16* ur = u16 + (size_t)e * DM + 8 * lane;
                float d = 0.f;
#pragma unroll
                for (int i = 0; i < 4; ++i) { const u32x4 w = *(const u32x4*)(ur + 512 * i); d = dot2(hv[i].x, w.x, d); d = dot2(hv[i].y, w.y, d); d = dot2(hv[i].z, w.z, d); d = dot2(hv[i].w, w.w, d); }
                part[k] = d;
            }
#pragma unroll
            for (int k = 0; k < 4; ++k) part[k] = wave_sum(part[k]);
#pragma unroll
            for (int k = 0; k < 4; ++k) {
                const float d = part[k];
                const float act = 0.5f * d * (1.f + erff(d * 0.70710678118654752f));
                const float coef = __shfl(mygate, k) * act;
                const unsigned e = __shfl(myexp, k);
                const f16* vr = v16 + (size_t)e * DM + 8 * lane;
#pragma unroll
                for (int i = 0; i < 4; ++i) {
                    const u32x4 w = *(const u32x4*)(vr + 512 * i);
                    acc[8 * i + 0] += coef * h_lo(w.x); acc[8 * i + 1] += coef * h_hi(w.x); acc[8 * i + 2] += coef * h_lo(w.y); acc[8 * i + 3] += coef * h_hi(w.y);
                    acc[8 * i + 4] += coef * h_lo(w.z); acc[8 * i + 5] += coef * h_hi(w.z); acc[8 * i + 6] += coef * h_lo(w.w); acc[8 * i + 7] += coef * h_hi(w.w);
                }
            }
        }
        float ss = 0.f;
#pragma unroll
        for (int i = 0; i < 4; ++i) {
            const int col = 512 * i + 8 * lane;
#pragma unroll
            for (int hf = 0; hf < 2; ++hf) {
                const f32x4 xi = *(const f32x4*)(x1 + (size_t)t * DM + col + 4 * hf);
                const f32x4 gt = *(const f32x4*)(gate2 + (size_t)b * 6 * DM + col + 4 * hf);
                f32x4 r;
#pragma unroll
                for (int j = 0; j < 4; ++j) { r[j] = xi[j] + gt[j] * acc[8 * i + 4 * hf + j]; acc[8 * i + 4 * hf + j] = r[j]; ss += r[j] * r[j]; }
                if (xout) *(f32x4*)(xout + (size_t)t * DM + col + 4 * hf) = r;
            }
        }
        ss = wave_sum(ss);
        const float rstd = rsqrtf(ss * (1.f / DM) + EPS);
#pragma unroll
        for (int i = 0; i < 4; ++i) {
            const int col = 512 * i + 8 * lane;
            if (final_norm) {
#pragma unroll
                for (int hf = 0; hf < 2; ++hf) {
                    const f32x4 gg = *(const f32x4*)(ng + col + 4 * hf);
                    f32x4 r;
#pragma unroll
                    for (int j = 0; j < 4; ++j) r[j] = acc[8 * i + 4 * hf + j] * rstd * gg[j];
                    *(f32x4*)(fout + (size_t)t * DM + col + 4 * hf) = r;
                }
            } else {
                float yv[8];
#pragma unroll
                for (int hf = 0; hf < 2; ++hf) {
                    const f32x4 gg = *(const f32x4*)(ng + col + 4 * hf), sh = *(const f32x4*)(nshift + (size_t)b * 6 * DM + col + 4 * hf), sc = *(const f32x4*)(nscale + (size_t)b * 6 * DM + col + 4 * hf);
#pragma unroll
                    for (int j = 0; j < 4; ++j) yv[4 * hf + j] = acc[8 * i + 4 * hf + j] * rstd * gg[j] * (1.f + sc[j]) + sh[j];
                }
                u32x4 w; w.x = pack_h2(yv[0], yv[1]); w.y = pack_h2(yv[2], yv[3]); w.z = pack_h2(yv[4], yv[5]); w.w = pack_h2(yv[6], yv[7]);
                *(u32x4*)(hnext + (size_t)t * DM + col) = w;
            }
        }
    }
}

constexpr int PH_CONV = 0, PH_N1 = 1, PH_L0 = 2, PH_PER_LAYER = 9, PH_TOTAL = PH_L0 + DEPTH * PH_PER_LAYER;

__global__ void __launch_bounds__(NTHREADS, 2) mega(Params p_arg) {
    extern __shared__ __attribute__((aligned(16))) unsigned char shm[];
    LAS unsigned char* lds = (LAS unsigned char*)shm;
    typedef const Params __attribute__((address_space(4)))* KP;
    const int ph_lo = p_arg.ph_lo, ph_hi = p_arg.ph_hi;
#ifndef PMASK
#define PMASK 0xff
#endif
#define EN(k) ((PMASK >> (k)) & 1)
    for (int ph = ph_lo; ph < ph_hi; ++ph) {
        KP kp = (KP)__builtin_amdgcn_kernarg_segment_ptr();
        asm volatile("" : "+s"(kp));
#if defined(__HIP_DEVICE_COMPILE__)
        const Params p = *kp;
#else
        const Params p = p_arg;
#endif
        unsigned char* ws = p.ws;
        const float* mod = (const float*)(ws + WS_MOD);
        int kind, l = 0, s = -1;
        if (ph == PH_CONV) kind = 0;
        else if (ph == PH_N1) kind = 1;
        else {
            l = (ph - PH_L0) / PH_PER_LAYER; s = (ph - PH_L0) % PH_PER_LAYER;
            kind = (s == 0 || s == 4 || s == 6) ? 2 : (s == 1 ? 3 : (s == 2 ? 4 : (s == 3 ? 5 : (s == 5 ? 1 : (s == 7 ? 6 : 7)))));
        }
        const float* modl = mod + (size_t)l * NB * 6 * DM;
        const float* xin = l == 0 ? p.x : p.out;
        float* x1 = (float*)(ws + WS_X1);
#ifndef REPEAT_KIND
#define REPEAT_KIND -1
#endif
        for (int rep = 0; rep < ((kind == REPEAT_KIND) ? 2 : 1); ++rep) {
        if (rep == 1) cg::this_grid().sync();
        if (kind == 0) { if (EN(0)) phase_conv(p, lds); }
        else if (kind == 1) {
            if (EN(1)) {
                if (s < 0) phase_norm(p, p.x, p.n1g, mod + 0 * DM, mod + 1 * DM, (f16*)(ws + WS_H));
                else phase_norm(p, x1, p.n2g + (size_t)l * DM, modl + 3 * DM, modl + 4 * DM, (f16*)(ws + WS_H));
            }
        } else if (kind == 2) {
            if (EN(2)) {
                Epi E{}; const f16* A; const f16* Bt; int N;
                if (s == 0) { E.mode = 0; E.o16 = (f16*)(ws + WS_PROJ); E.ldc = INWP; A = (const f16*)(ws + WS_H); Bt = (const f16*)(ws + WS_WTIN) + (size_t)l * INWP * DM; N = INWP; }
                else if (s == 4) { E.mode = 1; E.o32 = x1; E.xin = xin; E.gate = modl + 2 * DM; A = (const f16*)(ws + WS_Y); Bt = (const f16*)(ws + WS_WTOUT) + (size_t)l * DM * DM; N = DM; }
                else { E.mode = 0; E.o16 = (f16*)(ws + WS_Y); E.ldc = DM; A = (const f16*)(ws + WS_H); Bt = (const f16*)(ws + WS_WTQ) + (size_t)l * DM * DM; N = DM; }
                gemm_run(p, lds, A, Bt, N, E);
            }
        } else if (kind == 3) { if (EN(3)) phase_rope(p); }
        else if (kind == 4) { if (EN(4)) phase_index2(p, lds); }
        else if (kind == 5) { if (EN(5)) phase_attn2(p, lds, p.ong + (size_t)l * DM); }
        else if (kind == 6) { if (EN(6)) phase_route2(p, lds, (const f16*)(ws + WS_SUBK) + (size_t)l * PH * 2 * PNK * 128); }
        else if (EN(7)) {
            const bool fin = (l == DEPTH - 1);
            const float* modn = mod + (size_t)(fin ? l : l + 1) * NB * 6 * DM;
            if (REPEAT_KIND == 7 && rep == 0)
                phase_experts(p, (const f16*)(ws + WS_H), x1, modl + 5 * DM, (const f16*)(ws + WS_U16) + (size_t)l * PEXP * DM, (const f16*)(ws + WS_V16) + (size_t)l * PEXP * DM,
                              nullptr, false, p.n1g, modn + 0 * DM, modn + 1 * DM, (f16*)(ws + WS_PROJ), p.out);
            else
            phase_experts(p, (const f16*)(ws + WS_H), x1, modl + 5 * DM, (const f16*)(ws + WS_U16) + (size_t)l * PEXP * DM, (const f16*)(ws + WS_V16) + (size_t)l * PEXP * DM,
                          fin ? nullptr : p.out, fin, fin ? p.fg : p.n1g + (size_t)(l + 1) * DM, modn + 0 * DM, modn + 1 * DM, (f16*)(ws + WS_H), p.out);
        }
        }
        if (ph + 1 < ph_hi) cg::this_grid().sync();
    }
}

extern "C" void kernel_launch(void* const* d_in, const int* in_sizes, int n_in, void* d_out, int out_size, void* d_ws, size_t ws_size, hipStream_t stream) {
    static int grid = 0;
    if (grid == 0) {
        if (n_in != 14 || out_size != NT * DM || ws_size < WS_END) { fprintf(stderr, "kernel_launch: unexpected sizes (n_in %d out %d ws %zu need %zu)\n", n_in, out_size, ws_size, (size_t)WS_END); grid = -1; return; }
        if (hipFuncSetAttribute((const void*)mega, hipFuncAttributeMaxDynamicSharedMemorySize, LDS_BYTES) != hipSuccess) { fprintf(stderr, "kernel_launch: hipFuncSetAttribute failed\n"); grid = -1; return; }
        int dev = 0, cus = 0, per_cu = 0;
        hipGetDevice(&dev); hipDeviceGetAttribute(&cus, hipDeviceAttributeMultiprocessorCount, dev);
        hipOccupancyMaxActiveBlocksPerMultiprocessor(&per_cu, (const void*)mega, NTHREADS, LDS_BYTES);
        if (per_cu < 1) { fprintf(stderr, "kernel_launch: occupancy query says %d blocks per CU\n", per_cu); grid = -1; return; }
        grid = cus;
    }
    if (grid < 0) return;
    Params p{};
    p.x = (const float*)d_in[0]; p.c = (const float*)d_in[1]; p.ada_w = (const float*)d_in[2]; p.ada_b = (const float*)d_in[3];
    p.n1g = (const float*)d_in[4]; p.n2g = (const float*)d_in[5]; p.w_in = (const float*)d_in[6]; p.ong = (const float*)d_in[7];
    p.w_out = (const float*)d_in[8]; p.wq = (const float*)d_in[9]; p.subk = (const float*)d_in[10]; p.pu = (const float*)d_in[11];
    p.pv = (const float*)d_in[12]; p.fg = (const float*)d_in[13];
    p.out = (float*)d_out; p.ws = (unsigned char*)d_ws;
#if 0
    for (int ph = 0; ph < PH_TOTAL; ++ph) {
        p.ph_lo = ph; p.ph_hi = ph + 1;
        hipLaunchKernelGGL(mega, dim3(grid), dim3(NTHREADS), LDS_BYTES, stream, p);
    }
#else
    p.ph_lo = 0; p.ph_hi = PH_TOTAL;
    void* args[] = {&p};
    hipError_t e = hipLaunchCooperativeKernel((const void*)mega, dim3(grid), dim3(NTHREADS), args, LDS_BYTES, stream);
    if (e != hipSuccess) fprintf(stderr, "cooperative launch failed: %s (grid %d)\n", hipGetErrorString(e), grid);
#endif
}
```

```cpp
#include <hip/hip_runtime.h>
#include <hip/hip_cooperative_groups.h>
#include <cstdio>
#include <cstdint>
namespace cg = cooperative_groups;

#define LAS __attribute__((address_space(3)))
typedef _Float16 f16;
typedef _Float16 h2_t __attribute__((ext_vector_type(2)));
typedef _Float16 h4_t __attribute__((ext_vector_type(4)));
typedef _Float16 h8_t __attribute__((ext_vector_type(8)));
typedef float f32x4 __attribute__((ext_vector_type(4)));
typedef unsigned u32x4 __attribute__((ext_vector_type(4)));
typedef unsigned u32x2 __attribute__((ext_vector_type(2)));

constexpr int NB = 8, SEQ = 2048, DM = 2048, NT = NB * SEQ, DEPTH = 2;
constexpr int HD = 128, HA = 6, HB = 5, HC = 5, NHEADS = 16;
constexpr int IH = 16, IDM = 64, DSA_TOPK = 256;
constexpr int MOBA_BLK = 256, MOBA_NB = 8;
constexpr int INW = 5968, INWP = 6144;
constexpr int PH = 8, PNK = 128, PTOPK = 16, PEXP = 16384;
constexpr float EPS = 1e-6f;
constexpr int C_QA = 0, C_KA = 768, C_VA = 896, C_IQ = 1024, C_IK = 2048, C_IW = 2112, C_QB = 2176, C_KB = 2816, C_VB = 3456,
              C_QC = 4096, C_KC = 4736, C_VC = 5376, C_END = 6016;

constexpr int NTHREADS = 512, NWAVES = 8;
constexpr int LDS_BYTES = 147456;

constexpr size_t al256(size_t x) { return (x + 255) & ~(size_t)255; }
constexpr size_t WS_WTIN = 0;
constexpr size_t WS_WTOUT = WS_WTIN + (size_t)DEPTH * INWP * DM * 2;
constexpr size_t WS_WTQ = WS_WTOUT + (size_t)DEPTH * DM * DM * 2;
constexpr size_t WS_U8 = WS_WTQ + (size_t)DEPTH * DM * DM * 2;
constexpr size_t WS_V8 = WS_U8 + (size_t)DEPTH * PEXP * DM;
constexpr size_t WS_SU = WS_V8 + (size_t)DEPTH * PEXP * DM;
constexpr size_t WS_SV = WS_SU + (size_t)DEPTH * PEXP * 4;
constexpr size_t WS_H8 = WS_SV + (size_t)DEPTH * PEXP * 4;
constexpr size_t WS_SH = WS_H8 + (size_t)NT * DM;
constexpr size_t WS_SUBK = WS_SH + (size_t)NT * 4;
constexpr size_t WS_MOD = WS_SUBK + (size_t)DEPTH * PH * 2 * PNK * 128 * 2;
constexpr size_t WS_ROPE128 = WS_MOD + (size_t)DEPTH * NB * 6 * DM * 4;
constexpr size_t WS_ROPE64 = WS_ROPE128 + (size_t)SEQ * 64 * 8;
constexpr size_t WS_H = WS_ROPE64 + (size_t)SEQ * 32 * 8;
constexpr size_t WS_PROJ = WS_H + (size_t)NT * DM * 2;
constexpr size_t WS_KMEAN = WS_PROJ + (size_t)NT * INWP * 2;
constexpr size_t WS_MASK = WS_KMEAN + al256((size_t)NB * HC * MOBA_NB * HD * 4);
constexpr size_t WS_Y = WS_MASK + (size_t)NB * SEQ * 64 * 4;
constexpr size_t WS_X1 = WS_Y + (size_t)NT * DM * 2;
constexpr size_t WS_PE = WS_X1 + (size_t)NT * DM * 4;
constexpr size_t WS_PG = WS_PE + (size_t)NT * 128 * 4;
constexpr size_t WS_LIST = WS_PG + (size_t)NT * 128 * 4;
constexpr size_t WS_CTL = WS_LIST + (size_t)NT * 128 * 4;
constexpr size_t CTL_BYTES = 16384;
constexpr size_t WS_END = WS_CTL + CTL_BYTES;

struct Params {
    const float *x, *c, *ada_w, *ada_b, *n1g, *n2g, *w_in, *ong, *w_out, *wq, *subk, *pu, *pv, *fg;
    float* out;
    unsigned char* ws;
    int ph_lo, ph_hi;
};

__device__ __forceinline__ int otid() { int t = threadIdx.x; asm volatile("" : "+v"(t)); return t; }
__device__ __forceinline__ int obid() { int t = blockIdx.x; asm volatile("" : "+s"(t)); return t; }
__device__ __forceinline__ float wave_sum(float v) {
#pragma unroll
    for (int o = 32; o >= 1; o >>= 1) v += __shfl_xor(v, o);
    return v;
}
__device__ __forceinline__ float wave_max(float v) {
#pragma unroll
    for (int o = 32; o >= 1; o >>= 1) v = fmaxf(v, __shfl_xor(v, o));
    return v;
}
__device__ __forceinline__ unsigned pack_h2(float a, float b) { h2_t r; r.x = (f16)a; r.y = (f16)b; return __builtin_bit_cast(unsigned, r); }
__device__ __forceinline__ float h_lo(unsigned u) { h2_t r = __builtin_bit_cast(h2_t, u); return (float)r.x; }
__device__ __forceinline__ float h_hi(unsigned u) { h2_t r = __builtin_bit_cast(h2_t, u); return (float)r.y; }
__device__ __forceinline__ float dot2(unsigned a, unsigned b, float c) {
    return __builtin_amdgcn_fdot2(__builtin_bit_cast(h2_t, a), __builtin_bit_cast(h2_t, b), c, false);
}

namespace pg8 {
constexpr int BM = 256, BK = 64, HALF = 128, HTB = HALF * BK * 2, STAGE_BYTES = 8 * HTB, NXCD = 8, WGM = 8;
__host__ __device__ __forceinline__ int lds_byte(int r, int c) { const int st = (r >> 4) * 2 + (c >> 5), rr = r & 15, cc = c & 31, ob = rr * 64 + cc * 2; return st * 1024 + (ob ^ (((ob >> 9) & 1) << 5)); }
__host__ __device__ __forceinline__ void stage_rc(int b, int& R, int& C) { const int st = b / 1024, sb = b % 1024, swz = sb ^ (((sb >> 9) & 1) << 5); R = (st >> 1) * 16 + swz / 64; C = (st & 1) * 32 + (swz % 64) / 2; }
struct Unit { int pm, pn; };
struct Gemm { const unsigned short* A; const unsigned short* Bt; int M, N, K; };
struct StaticOrder {
    int nM, nN, nwg, G, c;
    __host__ __device__ void init(int M, int N, int G_, int c_) { nM = M / BM; nN = N / BM; nwg = nM * nN; G = G_; c = c_; }
    __host__ __device__ bool next(int i, Unit& u) const {
        const long L = (long)i * G + c; if (L >= nwg) return false;
        int wgid = (int)L; { const int q = nwg / NXCD, r = nwg % NXCD, xcd = wgid % NXCD, off = wgid / NXCD; wgid = (xcd < r ? xcd * (q + 1) : r * (q + 1) + (xcd - r) * q) + off; }
        const int nig = WGM * nN, gid = wgid / nig, fm = gid * WGM, gsz = (nM - fm) < WGM ? (nM - fm) : WGM;
        u.pm = fm + ((wgid % nig) % gsz); u.pn = (wgid % nig) / gsz; return true;
    }
};

template <class Epi>
__device__ __forceinline__ void gemm_phase(LAS unsigned char* lds, const Gemm g, const StaticOrder& S, const Epi& E) {
    const int tid = otid(), wid = __builtin_amdgcn_readfirstlane(tid >> 6), lane = tid & 63, wr = wid >> 2, wc = wid & 3, fr = lane & 15, fq = lane >> 4;
    const int K = g.K, nt = K / BK;
    unsigned voffA[2], voffB[2];
#pragma unroll
    for (int i = 0; i < 2; ++i) { int R, C; stage_rc(tid * 16 + i * 8192, R, C); voffA[i] = (unsigned)(R * K + C) * 2u; voffB[i] = (unsigned)(R * K + C) * 2u; }
    const size_t kstep = (size_t)(BK * 2);
    const size_t hstep = (size_t)HALF * K * 2;
    const size_t tstep = 2 * hstep;
    const unsigned ldsw = (unsigned)wid * 1024u;
    const int aoff = lds_byte(wr * 64 + fr, fq * 8), boff = lds_byte(wc * 32 + fr, fq * 8);
#define PG8_SA(b, h) (((b) * 2 + (h)) * HTB)
#define PG8_SB(b, h) ((4 + (b) * 2 + (h)) * HTB)
#define PG8_STAGE(bufoff, gbase, voff) do { _Pragma("unroll") for (int _i = 0; _i < 2; ++_i) \
        __builtin_amdgcn_global_load_lds((const unsigned*)((const char*)(gbase) + (voff)[_i]), (LAS unsigned*)(lds + (bufoff) + ldsw + _i * 8192), 16, 0, 0); } while (0)
#define PG8_LDA(dst, b, h) do { _Pragma("unroll") for (int m = 0; m < 4; ++m) _Pragma("unroll") for (int k = 0; k < 2; ++k) dst[m][k] = *(const LAS h8_t*)(lds + PG8_SA(b, h) + aoff + m * 2048 + k * 1024); } while (0)
#define PG8_LDB(dst, b, h) do { _Pragma("unroll") for (int n = 0; n < 2; ++n) _Pragma("unroll") for (int k = 0; k < 2; ++k) dst[n][k] = *(const LAS h8_t*)(lds + PG8_SB(b, h) + boff + n * 2048 + k * 1024); } while (0)
#define PG8_MMA(ai, bj, At, Bt) do { __builtin_amdgcn_s_setprio(1); _Pragma("unroll") for (int m = 0; m < 4; ++m) _Pragma("unroll") for (int n = 0; n < 2; ++n) _Pragma("unroll") for (int k = 0; k < 2; ++k) \
        acc[ai][bj][m][n] = __builtin_amdgcn_mfma_f32_16x16x32_f16(Bt[n][k], At[m][k], acc[ai][bj][m][n], 0, 0, 0); __builtin_amdgcn_s_setprio(0); } while (0)
#define PG8_WAIT_V(n) asm volatile("s_waitcnt vmcnt(" #n ")" ::: "memory")
#define PG8_WAIT_L(n) asm volatile("s_waitcnt lgkmcnt(" #n ")" ::: "memory")
#define PG8_BAR __builtin_amdgcn_s_barrier()
#define PG8_SCHED __builtin_amdgcn_sched_barrier(0)
    Unit cur, nxt; int ui = 0;
    if (!S.next(0, cur)) return;
    f32x4 acc[2][2][4][2];
#pragma unroll
    for (int a = 0; a < 2; ++a)
#pragma unroll
        for (int b = 0; b < 2; ++b)
#pragma unroll
            for (int m = 0; m < 4; ++m)
#pragma unroll
                for (int n = 0; n < 2; ++n) acc[a][b][m][n] = (f32x4){0.f, 0.f, 0.f, 0.f};
    h8_t At[4][2], B0[2][2], B1[2][2];
    const char* cA = (const char*)g.A + (size_t)cur.pm * tstep; const char* cB = (const char*)g.Bt + (size_t)cur.pn * tstep;
    PG8_STAGE(PG8_SB(0, 0), cB, voffB); PG8_STAGE(PG8_SA(0, 0), cA, voffA); PG8_STAGE(PG8_SB(0, 1), cB + hstep, voffB); PG8_STAGE(PG8_SA(0, 1), cA + hstep, voffA);
    if (wr == 1) PG8_BAR;
    PG8_WAIT_V(4); PG8_BAR;
    PG8_STAGE(PG8_SB(1, 0), cB + kstep, voffB); PG8_STAGE(PG8_SA(1, 0), cA + kstep, voffA); PG8_STAGE(PG8_SB(1, 1), cB + hstep + kstep, voffB);
    PG8_WAIT_V(6); PG8_BAR;
    for (;;) {
        const bool has_next = S.next(ui + 1, nxt);
        const char* nA = has_next ? (const char*)g.A + (size_t)nxt.pm * tstep : cA; const char* nB = has_next ? (const char*)g.Bt + (size_t)nxt.pn * tstep : cB;
        for (int t = 0; t < nt; t += 2) {
            const bool last = (t == nt - 2);
            const char* a1 = cA + (size_t)(t + 1) * kstep;
            const char* a2 = last ? nA : cA + (size_t)(t + 2) * kstep; const char* b2 = last ? nB : cB + (size_t)(t + 2) * kstep;
            const char* a3 = a2 + kstep; const char* b3 = b2 + kstep;
            PG8_LDB(B0, 0, 0); PG8_SCHED; PG8_LDA(At, 0, 0); PG8_STAGE(PG8_SA(1, 1), a1 + hstep, voffA);
            PG8_WAIT_L(8); PG8_BAR; PG8_WAIT_L(0); PG8_MMA(0, 0, At, B0); PG8_BAR; PG8_SCHED;
            PG8_LDB(B1, 0, 1); PG8_STAGE(PG8_SB(0, 0), b2, voffB);
            PG8_BAR; PG8_WAIT_L(0); PG8_MMA(0, 1, At, B1); PG8_BAR;
            PG8_LDA(At, 0, 1); PG8_STAGE(PG8_SA(0, 0), a2, voffA);
            PG8_BAR; PG8_WAIT_L(0); PG8_MMA(1, 0, At, B0); PG8_BAR; PG8_SCHED;
            PG8_STAGE(PG8_SB(0, 1), b2 + hstep, voffB);
            PG8_WAIT_V(6); PG8_BAR; PG8_MMA(1, 1, At, B1); PG8_BAR;
            PG8_LDB(B0, 1, 0); PG8_SCHED; PG8_LDA(At, 1, 0); PG8_STAGE(PG8_SA(0, 1), a2 + hstep, voffA);
            PG8_WAIT_L(8); PG8_BAR; PG8_WAIT_L(0); PG8_MMA(0, 0, At, B0); PG8_BAR; PG8_SCHED;
            PG8_LDB(B1, 1, 1); PG8_STAGE(PG8_SB(1, 0), b3, voffB);
            PG8_BAR; PG8_WAIT_L(0); PG8_MMA(0, 1, At, B1); PG8_BAR;
            PG8_LDA(At, 1, 1); PG8_STAGE(PG8_SA(1, 0), a3, voffA);
            PG8_BAR; PG8_WAIT_L(0); PG8_MMA(1, 0, At, B0); PG8_BAR; PG8_SCHED;
            PG8_STAGE(PG8_SB(1, 1), b3 + hstep, voffB);
            PG8_WAIT_V(6); PG8_BAR; PG8_MMA(1, 1, At, B1); PG8_BAR;
        }
        E(acc, cur, wr, wc, fr, fq);
        if (!has_next) break;
#pragma unroll
        for (int a = 0; a < 2; ++a)
#pragma unroll
            for (int b = 0; b < 2; ++b)
#pragma unroll
                for (int m = 0; m < 4; ++m)
#pragma unroll
                    for (int n = 0; n < 2; ++n) acc[a][b][m][n] = (f32x4){0.f, 0.f, 0.f, 0.f};
        cur = nxt; cA = nA; cB = nB; ++ui;
    }
    PG8_WAIT_V(0);
    if (wr == 0) PG8_BAR;
    PG8_BAR;
#undef PG8_SA
#undef PG8_SB
#undef PG8_STAGE
#undef PG8_LDA
#undef PG8_LDB
#undef PG8_MMA
#undef PG8_WAIT_V
#undef PG8_WAIT_L
#undef PG8_BAR
#undef PG8_SCHED
}
}

struct Epi {
    int mode; f16* o16; int ldc; float* o32; const float* xin; const float* gate;
    __device__ __forceinline__ void operator()(const f32x4 (&acc)[2][2][4][2], const pg8::Unit& u, int wr, int wc, int fr, int fq) const {
        const int row0 = u.pm * 256 + wr * 64 + fr, col0 = u.pn * 256 + wc * 32 + 4 * fq;
#pragma unroll
        for (int ai = 0; ai < 2; ++ai)
#pragma unroll
            for (int m = 0; m < 4; ++m) {
                const int row = row0 + ai * 128 + m * 16;
#pragma unroll
                for (int bj = 0; bj < 2; ++bj)
#pragma unroll
                    for (int n = 0; n < 2; ++n) {
                        const int col = col0 + bj * 128 + n * 16;
                        const f32x4 v = acc[ai][bj][m][n];
                        if (mode == 0) {
                            u32x2 w; w.x = pack_h2(v[0], v[1]); w.y = pack_h2(v[2], v[3]);
                            *(u32x2*)(o16 + (size_t)row * ldc + col) = w;
                        } else {
                            const int b = row / SEQ;
                            const f32x4 xi = *(const f32x4*)(xin + (size_t)row * DM + col);
                            const f32x4 gt = *(const f32x4*)(gate + (size_t)b * 6 * DM + col);
                            *(f32x4*)(o32 + (size_t)row * DM + col) = xi + gt * v;
                        }
                    }
            }
    }
};

__device__ __forceinline__ void gemm_run(const Params& p, LAS unsigned char* lds, const f16* A, const f16* Bt, int N, const Epi& E) {
    pg8::Gemm g; g.A = (const unsigned short*)A; g.Bt = (const unsigned short*)Bt; g.M = NT; g.N = N; g.K = DM;
    pg8::StaticOrder S; S.init(NT, N, (int)gridDim.x, (int)blockIdx.x);
    pg8::gemm_phase<Epi>(lds, g, S, E);
}

__device__ __forceinline__ int win_src_col(int pc) { return pc < 2128 ? pc : (pc < C_QB ? -1 : (pc < C_END ? pc - 48 : -1)); }

__device__ __forceinline__ void transpose_tiles(const float* src, int ldsrc, int ncols_phys, bool is_win, f16* dst, float* tile  , int& unit_base, int unit_lo) {
    const int tn = ncols_phys / 64, tk = DM / 64, ntile = tn * tk;
    const int tid = otid();
    for (int u = blockIdx.x; u < ntile; u += gridDim.x) {
        const int n0 = (u % tn) * 64, k0 = (u / tn) * 64;
        __syncthreads();
#pragma unroll
        for (int i = 0; i < 8; ++i) {
            const int e = tid + i * 512, r = e >> 6, c = e & 63;
            const int pc = n0 + c; const int sc = is_win ? win_src_col(pc) : pc;
            tile[r * 65 + c] = sc >= 0 ? src[(size_t)(k0 + r) * ldsrc + sc] : 0.f;
        }
        __syncthreads();
        {
            const int n = tid >> 3, kq = (tid & 7) * 8;
            u32x4 w;
            w.x = pack_h2(tile[(kq + 0) * 65 + n], tile[(kq + 1) * 65 + n]); w.y = pack_h2(tile[(kq + 2) * 65 + n], tile[(kq + 3) * 65 + n]);
            w.z = pack_h2(tile[(kq + 4) * 65 + n], tile[(kq + 5) * 65 + n]); w.w = pack_h2(tile[(kq + 6) * 65 + n], tile[(kq + 7) * 65 + n]);
            *(u32x4*)(dst + (size_t)(n0 + n) * DM + k0 + kq) = w;
        }
    }
    (void)unit_base; (void)unit_lo;
}

__device__ __forceinline__ void cvt_f16_stream(const float* src, f16* dst, size_t n) {
    const size_t stride = (size_t)gridDim.x * NTHREADS;
    for (size_t i = (size_t)blockIdx.x * NTHREADS + otid(); i < n / 8; i += stride) {
        const f32x4 a = *(const f32x4*)(src + i * 8), b = *(const f32x4*)(src + i * 8 + 4);
        u32x4 w; w.x = pack_h2(a[0], a[1]); w.y = pack_h2(a[2], a[3]); w.z = pack_h2(b[0], b[1]); w.w = pack_h2(b[2], b[3]);
        *(u32x4*)(dst + i * 8) = w;
    }
}

__device__ __forceinline__ void quant_rows(const float* src, int nrows, unsigned* dst, float* scale, int bias) {
    const int tid_ = otid(); const int wid = tid_ >> 6, lane = tid_ & 63;
    for (int row = blockIdx.x * NWAVES + wid; row < nrows; row += gridDim.x * NWAVES) {
        const float* xr = src + (size_t)row * DM;
        f32x4 v[8]; float am = 0.f;
#pragma unroll
        for (int i = 0; i < 8; ++i) { v[i] = *(const f32x4*)(xr + i * 256 + lane * 4); am = fmaxf(am, fmaxf(fmaxf(fabsf(v[i][0]), fabsf(v[i][1])), fmaxf(fabsf(v[i][2]), fabsf(v[i][3])))); }
        am = wave_max(am);
        const float sc = am > 0.f ? am * (1.f / 127.f) : 1.f, inv = 1.f / sc;
        if (lane == 0) scale[row] = sc;
#pragma unroll
        for (int i = 0; i < 8; ++i) {
            unsigned w = 0u;
#pragma unroll
            for (int j = 0; j < 4; ++j) { const int q = (int)rintf(v[i][j] * inv) + bias; w |= ((unsigned)q & 255u) << (8 * j); }
            dst[(size_t)row * (DM / 4) + i * 64 + lane] = w;
        }
    }
}

constexpr int QV_STR = DM + 8;
__device__ __forceinline__ void quant_v_sliced(const float* src, unsigned char* dst, float* scale, LAS unsigned char* lds) {
    const int tid = otid(), wid = tid >> 6, lane = tid & 63;
    for (int blk = obid(); blk < DEPTH * PEXP / 64; blk += gridDim.x) {
        const int row0 = blk * 64, layer = row0 / PEXP, e0 = row0 % PEXP;
        __syncthreads();
        for (int rr = wid; rr < 64; rr += NWAVES) {
            const float* xr = src + (size_t)(row0 + rr) * DM;
            f32x4 v[8]; float am = 0.f;
#pragma unroll
            for (int i = 0; i < 8; ++i) { v[i] = *(const f32x4*)(xr + i * 256 + lane * 4); am = fmaxf(am, fmaxf(fmaxf(fabsf(v[i][0]), fabsf(v[i][1])), fmaxf(fabsf(v[i][2]), fabsf(v[i][3])))); }
            am = wave_max(am);
            const float sc = am > 0.f ? am * (1.f / 127.f) : 1.f, inv = 1.f / sc;
            if (lane == 0) scale[row0 + rr] = sc;
#pragma unroll
            for (int i = 0; i < 8; ++i) {
                unsigned w = 0u;
#pragma unroll
                for (int j = 0; j < 4; ++j) { const int q = (int)rintf(v[i][j] * inv) + 128; w |= ((unsigned)q & 255u) << (8 * j); }
                *(LAS unsigned*)(lds + rr * QV_STR + i * 256 + lane * 4) = w;
            }
        }
        __syncthreads();
        for (int c = wid; c < 256; c += NWAVES) {
            const u32x2 w = *(const LAS u32x2*)(lds + lane * QV_STR + c * 8);
            *(u32x2*)(dst + (((size_t)layer * 256 + c) * PEXP + e0 + lane) * 8) = w;
        }
    }
}

__device__ __forceinline__ void phase_conv(const Params& p, LAS unsigned char* lds_) {
    float* smem = (float*)(unsigned char*)lds_;
    unsigned char* ws = p.ws;
    const int tid = otid();
    int dummy = 0;
    {
        float* cond = smem;
        float* red = smem + NB * DM;
        for (int i = tid; i < NB * DM; i += NTHREADS) { const float v = p.c[i]; cond[i] = v / (1.f + __expf(-v)); }
        __syncthreads();
        for (int u = blockIdx.x; u < DEPTH * 128; u += gridDim.x) {
            const int l = u >> 7, j0 = (u & 127) * 96;
            const int col = tid % 96, kg = tid / 96;
            float acc[NB];
#pragma unroll
            for (int b = 0; b < NB; ++b) acc[b] = 0.f;
            if (kg < 5) {
                const float* wp = p.ada_w + (size_t)l * DM * 6 * DM + j0 + col;
                for (int k = kg; k < DM; k += 5) {
                    const float w = wp[(size_t)k * 6 * DM];
#pragma unroll
                    for (int b = 0; b < NB; ++b) acc[b] += cond[b * DM + k] * w;
                }
#pragma unroll
                for (int b = 0; b < NB; ++b) red[(kg * NB + b) * 96 + col] = acc[b];
            }
            __syncthreads();
            for (int i = tid; i < NB * 96; i += NTHREADS) {
                const int b = i / 96, cc = i % 96;
                float s = p.ada_b[(size_t)l * 6 * DM + j0 + cc];
#pragma unroll
                for (int g = 0; g < 5; ++g) s += red[(g * NB + b) * 96 + cc];
                ((float*)(ws + WS_MOD))[((size_t)l * NB + b) * 6 * DM + j0 + cc] = s;
            }
            __syncthreads();
        }
    }
    {
        float2* r128 = (float2*)(ws + WS_ROPE128); float2* r64 = (float2*)(ws + WS_ROPE64);
        for (int i = blockIdx.x * NTHREADS + tid; i < SEQ * 64; i += gridDim.x * NTHREADS) {
            const int pos = i >> 6, j = i & 63;
            const float inv = powf(10000.f, -(float)j / 64.f); const float ang = (float)pos * inv;
            r128[i] = make_float2((float)cos((double)ang), (float)sin((double)ang));
        }
        for (int i = blockIdx.x * NTHREADS + tid; i < SEQ * 32; i += gridDim.x * NTHREADS) {
            const int pos = i >> 5, j = i & 31;
            const float inv = powf(10000.f, -(float)j / 32.f); const float ang = (float)pos * inv;
            r64[i] = make_float2((float)cos((double)ang), (float)sin((double)ang));
        }
    }
    __syncthreads();
    for (int l = 0; l < DEPTH; ++l) {
        transpose_tiles(p.w_in + (size_t)l * DM * INW, INW, INWP, true, (f16*)(ws + WS_WTIN) + (size_t)l * INWP * DM, smem, dummy, 0);
        transpose_tiles(p.w_out + (size_t)l * DM * DM, DM, DM, false, (f16*)(ws + WS_WTOUT) + (size_t)l * DM * DM, smem, dummy, 0);
        transpose_tiles(p.wq + (size_t)l * DM * DM, DM, DM, false, (f16*)(ws + WS_WTQ) + (size_t)l * DM * DM, smem, dummy, 0);
    }
    quant_rows(p.pu, DEPTH * PEXP, (unsigned*)(ws + WS_U8), (float*)(ws + WS_SU), 0);
    quant_v_sliced(p.pv, ws + WS_V8, (float*)(ws + WS_SV), lds_);
    cvt_f16_stream(p.subk, (f16*)(ws + WS_SUBK), (size_t)DEPTH * PH * 2 * PNK * 128);
}

__device__ __forceinline__ void phase_norm(const Params& p, const float* xin, const float* g, const float* shift, const float* scale, f16* hout, unsigned* h8 = nullptr, float* sh8 = nullptr) {
    const int tid_ = otid(); const int wid = tid_ >> 6, lane = tid_ & 63;
    for (int row = blockIdx.x * NWAVES + wid; row < NT; row += gridDim.x * NWAVES) {
        const int b = row / SEQ;
        const float* xr = xin + (size_t)row * DM;
        f32x4 v[8]; float ss = 0.f;
#pragma unroll
        for (int i = 0; i < 8; ++i) { v[i] = *(const f32x4*)(xr + i * 256 + lane * 4); ss += v[i][0] * v[i][0] + v[i][1] * v[i][1] + v[i][2] * v[i][2] + v[i][3] * v[i][3]; }
        ss = wave_sum(ss);
        const float rstd = rsqrtf(ss * (1.f / DM) + EPS);
#pragma unroll
        for (int i = 0; i < 8; ++i) {
            const int col = i * 256 + lane * 4;
            const f32x4 gg = *(const f32x4*)(g + col), sh = *(const f32x4*)(shift + (size_t)b * 6 * DM + col), sc = *(const f32x4*)(scale + (size_t)b * 6 * DM + col);
            f32x4 y = v[i] * rstd * gg * (sc + 1.f) + sh;
            u32x2 w; w.x = pack_h2(y[0], y[1]); w.y = pack_h2(y[2], y[3]);
            *(u32x2*)(hout + (size_t)row * DM + col) = w;
            v[i] = y;
        }
        if (h8) {
            float am = 0.f;
#pragma unroll
            for (int i = 0; i < 8; ++i) am = fmaxf(am, fmaxf(fmaxf(fabsf(v[i][0]), fabsf(v[i][1])), fmaxf(fabsf(v[i][2]), fabsf(v[i][3]))));
            am = wave_max(am);
            const float qs = am > 0.f ? am * (1.f / 127.f) : 1.f, inv = 1.f / qs;
            if (lane == 0) sh8[row] = qs;
#pragma unroll
            for (int i = 0; i < 8; ++i) {
                unsigned w = 0u;
#pragma unroll
                for (int j = 0; j < 4; ++j) { const int q = (int)rintf(v[i][j] * inv); w |= ((unsigned)q & 255u) << (8 * j); }
                h8[(size_t)row * (DM / 4) + i * 64 + lane] = w;
            }
        }
    }
}

__device__ __forceinline__ void phase_rope(const Params& p) {
    f16* proj = (f16*)(p.ws + WS_PROJ);
    const float2* r128 = (const float2*)(p.ws + WS_ROPE128); const float2* r64 = (const float2*)(p.ws + WS_ROPE64);
    constexpr int PER_TOK = (1088 + 544) / 2;
    const size_t total = (size_t)NT * PER_TOK;
    for (size_t i = (size_t)blockIdx.x * NTHREADS + otid(); i < total; i += (size_t)gridDim.x * NTHREADS) {
        const int t = (int)(i / PER_TOK); int r = (int)(i % PER_TOK) * 2;
        const int pos = t % SEQ;
        int base, half, j;
        if (r < 1088) {
            const int hh = r >> 6; j = r & 63; half = 64;
            base = hh < 6 ? C_QA + hh * 128 : (hh == 6 ? C_KA : (hh < 12 ? C_QC + (hh - 7) * 128 : C_KC + (hh - 12) * 128));
        } else {
            r -= 1088; const int hh = r >> 5; j = r & 31; half = 32;
            base = hh < 16 ? C_IQ + hh * 64 : C_IK;
        }
        f16* pp = proj + (size_t)t * INWP + base + j;
        const h2_t a = *(const h2_t*)pp, bq = *(const h2_t*)(pp + half);
        float2 cs0, cs1;
        if (half == 64) { cs0 = r128[pos * 64 + j]; cs1 = r128[pos * 64 + j + 1]; } else { cs0 = r64[pos * 32 + j]; cs1 = r64[pos * 32 + j + 1]; }
        const float a0 = (float)a.x, a1 = (float)a.y, b0 = (float)bq.x, b1 = (float)bq.y;
        h2_t oa, ob;
        oa.x = (f16)(a0 * cs0.x - b0 * cs0.y); oa.y = (f16)(a1 * cs1.x - b1 * cs1.y);
        ob.x = (f16)(b0 * cs0.x + a0 * cs0.y); ob.y = (f16)(b1 * cs1.x + a1 * cs1.y);
        *(h2_t*)pp = oa; *(h2_t*)(pp + half) = ob;
    }
}

__device__ __forceinline__ void phase_index(const Params& p, LAS unsigned char* lds_) {
    const f16* proj = (const f16*)(p.ws + WS_PROJ);
    float* smem = (float*)(unsigned char*)lds_;
    const int tid = otid(), wid = tid >> 6, lane = tid & 63;
    {
        float* red = smem;
        float* km = (float*)(p.ws + WS_KMEAN);
        for (int u = blockIdx.x; u < NB * HC * MOBA_NB; u += gridDim.x) {
            const int blk = u % MOBA_NB, h = (u / MOBA_NB) % HC, b = u / (MOBA_NB * HC);
            const int d = tid & 127, part = tid >> 7;
            float s = 0.f;
            const f16* kp = proj + ((size_t)b * SEQ + blk * MOBA_BLK + part * 64) * INWP + C_KC + h * HD + d;
            for (int k = 0; k < 64; ++k) s += (float)kp[(size_t)k * INWP];
            __syncthreads();
            red[part * 128 + d] = s;
            __syncthreads();
            if (tid < 128) km[(size_t)u * HD + tid] = (red[tid] + red[128 + tid] + red[256 + tid] + red[384 + tid]) * (1.f / MOBA_BLK);
        }
        __syncthreads();
    }
    float* wq_ = smem + wid * (IH * IDM + IH);
    float* sc = smem + NWAVES * (IH * IDM + IH) + wid * SEQ;
    unsigned* mask = (unsigned*)(p.ws + WS_MASK);
    for (int q = blockIdx.x * NWAVES + wid; q < NT; q += gridDim.x * NWAVES) {
        const int b = q / SEQ, t = q % SEQ;
        const f16* row = proj + (size_t)q * INWP;
        for (int i = lane; i < IH * IDM; i += 64) wq_[i] = (float)row[C_IQ + i];
        if (lane < IH) wq_[IH * IDM + lane] = (float)row[C_IW + lane] * 0.25f;
        __builtin_amdgcn_wave_barrier();
        const int nk = t + 1;
        for (int s = lane; s < nk; s += 64) {
            const f16* kr = proj + ((size_t)b * SEQ + s) * INWP + C_IK;
            float kf[IDM];
#pragma unroll
            for (int e8 = 0; e8 < IDM / 8; ++e8) { const h8_t kv = *(const h8_t*)(kr + e8 * 8);
#pragma unroll
                for (int j = 0; j < 8; ++j) kf[e8 * 8 + j] = (float)kv[j]; }
            float score = 0.f;
            for (int h = 0; h < IH; ++h) {
                float d = 0.f;
#pragma unroll
                for (int e = 0; e < IDM; ++e) d += wq_[h * IDM + e] * kf[e];
                score += wq_[IH * IDM + h] * fmaxf(d * 0.125f, 0.f);
            }
            sc[s] = score;
        }
        __builtin_amdgcn_wave_barrier();
        unsigned key[32];
#pragma unroll
        for (int i = 0; i < 32; ++i) {
            const int s = lane + 64 * i;
            unsigned u = 0u;
            if (s < nk) { const unsigned bits = __float_as_uint(sc[s]); u = (bits & 0x80000000u) ? ~bits : (bits | 0x80000000u); if (u == 0u) u = 1u; }
            key[i] = u;
        }
        unsigned thr = 1u;
        if (nk > DSA_TOPK) {
            thr = 0u;
            for (int bit = 31; bit >= 0; --bit) {
                const unsigned cand = thr | (1u << bit);
                int cnt = 0;
#pragma unroll
                for (int i = 0; i < 32; ++i) cnt += __builtin_popcountll(__ballot(key[i] >= cand));
                if (cnt >= DSA_TOPK) thr = cand;
            }
        }
        unsigned* mrow = mask + (size_t)q * 64;
#pragma unroll
        for (int i = 0; i < 32; ++i) {
            const unsigned long long bal = __ballot(key[i] >= thr && key[i] != 0u);
            if (lane == 0) { mrow[2 * i] = (unsigned)bal; mrow[2 * i + 1] = (unsigned)(bal >> 32); }
        }
        __builtin_amdgcn_wave_barrier();
    }
}

constexpr int IX_ROW = SEQ + 4;
__device__ __forceinline__ void index_item(const Params& p, LAS unsigned char* lds, int b, int qg) {
    const f16* proj = (const f16*)(p.ws + WS_PROJ);
    LAS float* sc = (LAS float*)lds;
    const int tid = otid(), wid = __builtin_amdgcn_readfirstlane(tid >> 6), lane = tid & 63, fr = lane & 15, fq = lane >> 4;
    const int t0 = qg * 16, nkt = qg + 1;
    h8_t Bq[IH][2]; float wq[IH];
    {
        const f16* qrow = proj + ((size_t)b * SEQ + t0 + fr) * INWP;
#pragma unroll
        for (int h = 0; h < IH; ++h) {
            Bq[h][0] = *(const h8_t*)(qrow + C_IQ + h * IDM + 8 * fq);
            Bq[h][1] = *(const h8_t*)(qrow + C_IQ + h * IDM + 32 + 8 * fq);
        }
        const h8_t w0 = *(const h8_t*)(qrow + C_IW), w1 = *(const h8_t*)(qrow + C_IW + 8);
#pragma unroll
        for (int h = 0; h < 8; ++h) { wq[h] = (float)w0[h] * (0.25f * 0.125f); wq[8 + h] = (float)w1[h] * (0.25f * 0.125f); }
    }
    __syncthreads();
    const f16* kbase = proj + ((size_t)b * SEQ + fr) * INWP + C_IK + 8 * fq;
    h8_t a0, a1, n0, n1;
    int kt = wid;
    if (kt < nkt) { a0 = *(const h8_t*)(kbase + (size_t)kt * 16 * INWP); a1 = *(const h8_t*)(kbase + (size_t)kt * 16 * INWP + 32); }
    for (; kt < nkt; kt += NWAVES) {
        const int ktn = kt + NWAVES;
        if (ktn < nkt) { n0 = *(const h8_t*)(kbase + (size_t)ktn * 16 * INWP); n1 = *(const h8_t*)(kbase + (size_t)ktn * 16 * INWP + 32); }
        f32x4 acc = {0.f, 0.f, 0.f, 0.f};
#pragma unroll
        for (int h = 0; h < IH; ++h) {
            f32x4 c = {0.f, 0.f, 0.f, 0.f};
            c = __builtin_amdgcn_mfma_f32_16x16x32_f16(a0, Bq[h][0], c, 0, 0, 0);
            c = __builtin_amdgcn_mfma_f32_16x16x32_f16(a1, Bq[h][1], c, 0, 0, 0);
#pragma unroll
            for (int j = 0; j < 4; ++j) acc[j] += wq[h] * fmaxf(c[j], 0.f);
        }
        *(LAS f32x4*)(sc + fr * IX_ROW + kt * 16 + 4 * fq) = acc;
        a0 = n0; a1 = n1;
    }
    __syncthreads();
    unsigned* mask = (unsigned*)(p.ws + WS_MASK);
#pragma unroll 1
    for (int qq = 0; qq < 2; ++qq) {
        const int ql = 2 * wid + qq, t = t0 + ql, nk = t + 1;
        unsigned key[32];
#pragma unroll
        for (int i = 0; i < 32; ++i) {
            const int s = lane + 64 * i;
            unsigned u = 0u;
            if (s < nk) { const unsigned bits = __float_as_uint(sc[ql * IX_ROW + s]); u = (bits & 0x80000000u) ? ~bits : (bits | 0x80000000u); if (u == 0u) u = 1u; }
            key[i] = u;
        }
        unsigned thr = 1u;
        if (nk > DSA_TOPK) {
            thr = 0u;
            for (int bit = 31; bit >= 0; --bit) {
                const unsigned cand = thr | (1u << bit);
                int cnt = 0;
#pragma unroll
                for (int i = 0; i < 32; ++i) cnt += __builtin_popcountll(__ballot(key[i] >= cand));
                if (cnt >= DSA_TOPK) thr = cand;
            }
        }
        unsigned* mrow = mask + ((size_t)b * SEQ + t) * 64;
        unsigned myw = 0u;
#pragma unroll
        for (int i = 0; i < 32; ++i) {
            const unsigned long long bal = __ballot(key[i] >= thr && key[i] != 0u);
            if (lane == 2 * i) myw = (unsigned)bal;
            if (lane == 2 * i + 1) myw = (unsigned)(bal >> 32);
        }
        mrow[lane] = myw;
    }
}

__device__ __forceinline__ void phase_index2(const Params& p, LAS unsigned char* lds_) {
    const f16* proj = (const f16*)(p.ws + WS_PROJ);
    float* smem = (float*)(unsigned char*)lds_;
    const int tid = otid();
    {
        float* red = smem;
        float* km = (float*)(p.ws + WS_KMEAN);
        for (int u = obid(); u < NB * HC * MOBA_NB; u += gridDim.x) {
            const int blk = u % MOBA_NB, h = (u / MOBA_NB) % HC, b = u / (MOBA_NB * HC);
            const int d = tid & 127, part = tid >> 7;
            float s = 0.f;
            const f16* kp = proj + ((size_t)b * SEQ + blk * MOBA_BLK + part * 64) * INWP + C_KC + h * HD + d;
            for (int k = 0; k < 64; ++k) s += (float)kp[(size_t)k * INWP];
            __syncthreads();
            red[part * 128 + d] = s;
            __syncthreads();
            if (tid < 128) km[(size_t)u * HD + tid] = (red[tid] + red[128 + tid] + red[256 + tid] + red[384 + tid]) * (1.f / MOBA_BLK);
        }
        __syncthreads();
    }
    for (int pi = obid(); pi < NB * 64; pi += gridDim.x) {
        const int b = pi >> 6, a = pi & 63;
        index_item(p, lds_, b, 127 - a);
        index_item(p, lds_, b, a);
    }
}

__device__ __forceinline__ void phase_attn(const Params& p, LAS unsigned char* lds_, const float* ong) {
    const f16* proj = (const f16*)(p.ws + WS_PROJ);
    float* smem = (float*)(unsigned char*)lds_;
    const int tid = otid(), wid = tid >> 6, lane = tid & 63;
    float* pbuf = smem + wid * SEQ;
    const float* km = (const float*)(p.ws + WS_KMEAN);
    const unsigned* mask = (const unsigned*)(p.ws + WS_MASK);
    f16* y = (f16*)(p.ws + WS_Y);
    const float scale = 0.08838834764831845f;
    const size_t nitems = (size_t)NT * NHEADS;
    for (size_t it = (size_t)blockIdx.x * NWAVES + wid; it < nitems; it += (size_t)gridDim.x * NWAVES) {
        const int hh = (int)(it % NHEADS); const int q = (int)(it / NHEADS);
        const int b = q / SEQ, t = q % SEQ;
        int qc, kc, vc, var;
        if (hh < HA) { var = 0; qc = C_QA + hh * HD; kc = C_KA; vc = C_VA; }
        else if (hh < HA + HB) { var = 1; qc = C_QB + (hh - HA) * HD; kc = C_KB + (hh - HA) * HD; vc = C_VB + (hh - HA) * HD; }
        else { var = 2; qc = C_QC + (hh - HA - HB) * HD; kc = C_KC + (hh - HA - HB) * HD; vc = C_VC + (hh - HA - HB) * HD; }
        unsigned qv[64];
        { const u32x4* qp = (const u32x4*)(proj + (size_t)q * INWP + qc);
#pragma unroll
          for (int i = 0; i < 16; ++i) { const u32x4 w = qp[i]; qv[4 * i] = w.x; qv[4 * i + 1] = w.y; qv[4 * i + 2] = w.z; qv[4 * i + 3] = w.w; } }
        unsigned allowed = 0xffu;
        const int own = t / MOBA_BLK;
        if (var == 2) {
            float g = -INFINITY;
            if (lane < own) {
                const float* kmp = km + (((size_t)b * HC + (hh - HA - HB)) * MOBA_NB + lane) * HD;
                float s = 0.f;
#pragma unroll
                for (int i = 0; i < 64; ++i) s += h_lo(qv[i]) * kmp[2 * i] + h_hi(qv[i]) * kmp[2 * i + 1];
                g = s;
            }
            float gs[MOBA_NB];
#pragma unroll
            for (int j = 0; j < MOBA_NB; ++j) gs[j] = __shfl(g, j);
            allowed = 1u << own;
#pragma unroll
            for (int j = 0; j < MOBA_NB; ++j) {
                if (j < own) {
                    int rank = 0;
#pragma unroll
                    for (int k2 = 0; k2 < MOBA_NB; ++k2) if (k2 < own && (gs[k2] > gs[j] || (gs[k2] == gs[j] && k2 < j))) ++rank;
                    if (rank < 3) allowed |= 1u << j;
                }
            }
        }
        const int nk = t + 1;
        const int nkl = (nk + 63) >> 6;
        const unsigned* mrow = mask + (size_t)q * 64;
        float z[32];
#pragma unroll
        for (int i = 0; i < 32; ++i) {
            z[i] = -INFINITY;
            if (i < nkl) {
                const int s = nkl * lane + i;
                if (s < nk) {
                    bool ok = true;
                    if (var == 0) ok = (mrow[s >> 5] >> (s & 31)) & 1u;
                    if (var == 2) ok = (allowed >> (s / MOBA_BLK)) & 1u;
                    if (var == 1) ok = s < t;
                    if (ok) {
                        const u32x4* kp = (const u32x4*)(proj + ((size_t)b * SEQ + s) * INWP + kc);
                        float d = 0.f;
#pragma unroll
                        for (int c4 = 0; c4 < 16; ++c4) { const u32x4 w = kp[c4]; d = dot2(qv[4 * c4], w.x, d); d = dot2(qv[4 * c4 + 1], w.y, d); d = dot2(qv[4 * c4 + 2], w.z, d); d = dot2(qv[4 * c4 + 3], w.w, d); }
                        z[i] = d * scale;
                    }
                }
            }
        }
        float inv_l = 1.f;
        if (var != 1) {
            float m = -INFINITY;
#pragma unroll
            for (int i = 0; i < 32; ++i) m = fmaxf(m, z[i]);
            m = wave_max(m);
            float l = 0.f;
#pragma unroll
            for (int i = 0; i < 32; ++i) { const float e = (z[i] == -INFINITY) ? 0.f : __expf(z[i] - m); z[i] = e; l += e; }
            l = wave_sum(l);
            inv_l = 1.f / l;
        } else {
            float lk[32]; float tot = 0.f;
#pragma unroll
            for (int i = 31; i >= 0; --i) {
                float v = 0.f;
                if (z[i] != -INFINITY) { const float zz = z[i]; v = -(fmaxf(zz, 0.f) + log1pf(__expf(-fabsf(zz)))); }
                tot += v; lk[i] = tot;
            }
            float incl = tot;
#pragma unroll
            for (int o = 1; o < 64; o <<= 1) { const float v = __shfl_down(incl, o); if (lane + o < 64) incl += v; }
            const float excl = incl - tot;
#pragma unroll
            for (int i = 0; i < 32; ++i) z[i] = (z[i] == -INFINITY) ? 0.f : __expf(z[i] + lk[i] + excl);
        }
#pragma unroll
        for (int i = 0; i < 32; ++i) if (i < nkl) { const int s = nkl * lane + i; if (s < SEQ) pbuf[s] = z[i]; }
        __builtin_amdgcn_wave_barrier();
        float o0 = 0.f, o1 = 0.f;
        const f16* vp = proj + (size_t)b * SEQ * INWP + vc + 2 * lane;
        for (int s0 = 0; s0 < nk; s0 += 8) {
            float pr[8]; bool any = false;
#pragma unroll
            for (int j = 0; j < 8; ++j) { pr[j] = pbuf[s0 + j]; any = any || (pr[j] != 0.f); }
            if (any) {
                unsigned w[8];
#pragma unroll
                for (int j = 0; j < 8; ++j) w[j] = *(const unsigned*)(vp + (size_t)(s0 + j) * INWP);
#pragma unroll
                for (int j = 0; j < 8; ++j) { o0 += pr[j] * h_lo(w[j]); o1 += pr[j] * h_hi(w[j]); }
            }
        }
        o0 *= inv_l; o1 *= inv_l;
        const float ss = wave_sum(o0 * o0 + o1 * o1);
        const float rstd = rsqrtf(ss * (1.f / HD) + EPS);
        const float g0 = ong[hh * HD + 2 * lane], g1 = ong[hh * HD + 2 * lane + 1];
        *(unsigned*)(y + (size_t)q * DM + hh * HD + 2 * lane) = pack_h2(o0 * rstd * g0, o1 * rstd * g1);
        __builtin_amdgcn_wave_barrier();
    }
}

typedef short s4_t __attribute__((ext_vector_type(4)));
typedef float f32x16 __attribute__((ext_vector_type(16)));
constexpr int AT_KSTR = 272, AT_VSTR = 320, AT_KBYTES = 64 * AT_KSTR, AT_VBYTES = 64 * AT_VSTR, AT_STAGE = AT_KBYTES + AT_VBYTES;
__device__ __forceinline__ float fexp2(float x) { return __builtin_amdgcn_exp2f(x); }
__device__ __forceinline__ float flog2(float x) { return __builtin_amdgcn_logf(x); }

template <int VAR>
__device__ __forceinline__ void attn_item(const Params& p, LAS unsigned char* lds, const float* ong, int b, int hh, int qt, int qc, int kc, int vc) {
    const f16* proj = (const f16*)(p.ws + WS_PROJ);
    const int tid = otid(), wid = __builtin_amdgcn_readfirstlane(tid >> 6), lane = tid & 63, qn = lane & 31, hf = lane >> 5;
    const int q0 = qt * 256, qrow = q0 + 32 * wid + qn;
    const size_t grow = (size_t)b * SEQ + qrow;
    h8_t Qf[8];
    {
        const float sc = 0.08838834764831845f * 1.4426950408889634f;
        const f16* qp = proj + grow * INWP + qc + 8 * hf;
#pragma unroll
        for (int ks = 0; ks < 8; ++ks) {
            const h8_t v = *(const h8_t*)(qp + 16 * ks);
            h8_t w;
#pragma unroll
            for (int j = 0; j < 8; ++j) w[j] = (f16)((float)v[j] * sc);
            Qf[ks] = w;
        }
    }
    unsigned allowed = 0xffu;
    if (VAR == 2) {
        const int own = qt;
        const float* km = (const float*)(p.ws + WS_KMEAN) + ((size_t)b * HC + (hh - HA - HB)) * MOBA_NB * HD + 8 * hf;
        float gs[MOBA_NB];
#pragma unroll
        for (int j = 0; j < MOBA_NB; ++j) gs[j] = -INFINITY;
#pragma unroll
        for (int j = 0; j < MOBA_NB - 1; ++j) {
            if (j < own) {
                float s = 0.f;
#pragma unroll
                for (int ks = 0; ks < 8; ++ks) {
                    const f32x4 k0 = *(const f32x4*)(km + j * HD + 16 * ks), k1 = *(const f32x4*)(km + j * HD + 16 * ks + 4);
                    s += (float)Qf[ks][0] * k0[0] + (float)Qf[ks][1] * k0[1] + (float)Qf[ks][2] * k0[2] + (float)Qf[ks][3] * k0[3]
                       + (float)Qf[ks][4] * k1[0] + (float)Qf[ks][5] * k1[1] + (float)Qf[ks][6] * k1[2] + (float)Qf[ks][7] * k1[3];
                }
                gs[j] = s + __shfl_xor(s, 32);
            }
        }
        allowed = 1u << own;
#pragma unroll
        for (int j = 0; j < MOBA_NB - 1; ++j) {
            if (j < own) {
                int rank = 0;
#pragma unroll
                for (int k2 = 0; k2 < MOBA_NB - 1; ++k2) if (k2 < own && (gs[k2] > gs[j] || (gs[k2] == gs[j] && k2 < j))) ++rank;
                if (rank < 3) allowed |= 1u << j;
            }
        }
    }
    f32x16 O[4];
#pragma unroll
    for (int dt = 0; dt < 4; ++dt)
#pragma unroll
        for (int r = 0; r < 16; ++r) O[dt][r] = 0.f;
    float m_run = -INFINITY, l_run = 0.f, carry = 0.f;
    const int nst = (qt + 1) * 4;
    const int st_hi_w = qt * 4 + (wid >> 1);
    const int sr0 = tid >> 4, sc0 = tid & 15;
    const f16* kg = proj + ((size_t)b * SEQ + sr0) * INWP + kc + 8 * sc0;
    const f16* vg = proj + ((size_t)b * SEQ + sr0) * INWP + vc + 8 * sc0;
    const unsigned kw = sr0 * AT_KSTR + 16 * sc0, vw = AT_KBYTES + sr0 * AT_VSTR + 16 * sc0;
    const unsigned* mrow = (const unsigned*)(p.ws + WS_MASK) + grow * 64;
    const unsigned ka = qn * AT_KSTR + 16 * hf;
    const unsigned va = AT_KBYTES + (4 * hf + ((lane & 15) >> 2)) * AT_VSTR + (16 * ((lane >> 4) & 1) + 4 * (lane & 3)) * 2;
    u32x4 rk0, rk1, rv0, rv1; u32x2 mw = {0u, 0u}, mwn = {0u, 0u};
#define AT_LOAD(st_) do { const size_t o_ = (size_t)(st_) * 64 * INWP; rk0 = *(const u32x4*)(kg + o_); rk1 = *(const u32x4*)(kg + o_ + (size_t)32 * INWP); \
        rv0 = *(const u32x4*)(vg + o_); rv1 = *(const u32x4*)(vg + o_ + (size_t)32 * INWP); if (VAR == 0) mwn = *(const u32x2*)(mrow + 2 * (st_)); } while (0)
#define AT_WRITE(buf_) do { LAS unsigned char* b_ = lds + (buf_) * AT_STAGE; *(LAS u32x4*)(b_ + kw) = rk0; *(LAS u32x4*)(b_ + kw + 32 * AT_KSTR) = rk1; \
        *(LAS u32x4*)(b_ + vw) = rv0; *(LAS u32x4*)(b_ + vw + 32 * AT_VSTR) = rv1; } while (0)
    __syncthreads();
    AT_LOAD(nst - 1); AT_WRITE(0); mw = mwn;
    __syncthreads();
    int cur = 0;
    for (int st = nst - 1; st >= 0; --st) {
        if (st > 0) AT_LOAD(st - 1);
        if (st <= st_hi_w) {
            LAS unsigned char* kb = lds + cur * AT_STAGE;
            f32x16 S[2];
#pragma unroll
            for (int r = 0; r < 16; ++r) { S[0][r] = 0.f; S[1][r] = 0.f; }
#pragma unroll
            for (int ks = 0; ks < 8; ++ks) {
                const h8_t a0 = *(const LAS h8_t*)(kb + ka + 32 * ks), a1 = *(const LAS h8_t*)(kb + ka + 32 * ks + 32 * AT_KSTR);
                S[0] = __builtin_amdgcn_mfma_f32_32x32x16_f16(a0, Qf[ks], S[0], 0, 0, 0);
                S[1] = __builtin_amdgcn_mfma_f32_32x32x16_f16(a1, Qf[ks], S[1], 0, 0, 0);
            }
            const bool diag = (64 * st + 63 > q0 + 32 * wid);
            const int kbase = 64 * st + 4 * hf;
            if (VAR != 1) {
                const bool blk_ok = (VAR == 2) ? ((allowed >> (st >> 2)) & 1u) : true;
                float mx = -INFINITY;
#pragma unroll
                for (int sub = 0; sub < 2; ++sub)
#pragma unroll
                    for (int r = 0; r < 16; ++r) {
                        const int kl = (r & 3) + 8 * (r >> 2);
                        bool ok;
                        if (VAR == 0) ok = ((sub == 0 ? mw.x : mw.y) >> (kl + 4 * hf)) & 1u;
                        else ok = blk_ok && (!diag || (kbase + 32 * sub + kl <= qrow));
                        const float v = ok ? S[sub][r] : -INFINITY;
                        S[sub][r] = v; mx = fmaxf(mx, v);
                    }
                mx = fmaxf(mx, __shfl_xor(mx, 32));
                const float m_new = fmaxf(m_run, mx);
                const float m_use = (m_new == -INFINITY) ? 0.f : m_new;
                const float alpha = fexp2(m_run - m_use);
                float ps = 0.f;
#pragma unroll
                for (int sub = 0; sub < 2; ++sub)
#pragma unroll
                    for (int r = 0; r < 16; ++r) { const float e = fexp2(S[sub][r] - m_use); S[sub][r] = e; ps += e; }
                l_run = l_run * alpha + ps;
                m_run = m_new;
                if (__ballot(alpha != 1.f) != 0ull) {
#pragma unroll
                    for (int dt = 0; dt < 4; ++dt)
#pragma unroll
                        for (int r = 0; r < 16; ++r) O[dt][r] *= alpha;
                }
            } else {
#pragma unroll
                for (int sub = 1; sub >= 0; --sub) {
                    float lk[16];
#pragma unroll
                    for (int r = 0; r < 16; ++r) {
                        const int kl = (r & 3) + 8 * (r >> 2);
                        const bool ok = !diag || (kbase + 32 * sub + kl < qrow);
                        const float zl = S[sub][r];
                        const float sp = fmaxf(zl, 0.f) + flog2(1.f + fexp2(-fabsf(zl)));
                        lk[r] = ok ? -sp : 0.f;
                        S[sub][r] = ok ? zl : -INFINITY;
                    }
                    float gsum[4], pg[4], T[4];
#pragma unroll
                    for (int g = 0; g < 4; ++g) { gsum[g] = (lk[4 * g] + lk[4 * g + 1]) + (lk[4 * g + 2] + lk[4 * g + 3]); pg[g] = __shfl_xor(gsum[g], 32); T[g] = gsum[g] + pg[g]; }
                    float after[4];
                    after[3] = 0.f; after[2] = T[3]; after[1] = T[3] + T[2]; after[0] = T[3] + T[2] + T[1];
#pragma unroll
                    for (int g = 0; g < 4; ++g) {
                        const float base = carry + after[g] + (hf == 0 ? pg[g] : 0.f);
                        const float c3 = lk[4 * g + 3], c2 = lk[4 * g + 2] + c3, c1 = lk[4 * g + 1] + c2, c0 = lk[4 * g] + c1;
                        S[sub][4 * g + 3] = fexp2(S[sub][4 * g + 3] + base + c3);
                        S[sub][4 * g + 2] = fexp2(S[sub][4 * g + 2] + base + c2);
                        S[sub][4 * g + 1] = fexp2(S[sub][4 * g + 1] + base + c1);
                        S[sub][4 * g + 0] = fexp2(S[sub][4 * g + 0] + base + c0);
                    }
                    carry += (T[0] + T[1]) + (T[2] + T[3]);
                }
            }
#pragma unroll
            for (int sub = 0; sub < 2; ++sub)
#pragma unroll
                for (int s2 = 0; s2 < 2; ++s2) {
                    h8_t pb;
#pragma unroll
                    for (int j = 0; j < 8; ++j) pb[j] = (f16)S[sub][8 * s2 + j];
#pragma unroll
                    for (int dt = 0; dt < 4; ++dt) {
                        const LAS unsigned char* ap = kb + va + (32 * sub + 16 * s2) * AT_VSTR + 64 * dt;
                        const s4_t t0 = __builtin_amdgcn_ds_read_tr16_b64_v4i16((LAS s4_t*)ap);
                        const s4_t t1 = __builtin_amdgcn_ds_read_tr16_b64_v4i16((LAS s4_t*)(ap + 8 * AT_VSTR));
                        typedef short s8_t __attribute__((ext_vector_type(8)));
                        const s8_t a8 = __builtin_shufflevector(t0, t1, 0, 1, 2, 3, 4, 5, 6, 7);
                        O[dt] = __builtin_amdgcn_mfma_f32_32x32x16_f16(__builtin_bit_cast(h8_t, a8), pb, O[dt], 0, 0, 0);
                    }
                }
        }
        if (st > 0) { AT_WRITE(cur ^ 1); }
        mw = mwn;
        __syncthreads();
        cur ^= 1;
    }
#undef AT_LOAD
#undef AT_WRITE
    float inv = 1.f;
    if (VAR != 1) { const float lt = l_run + __shfl_xor(l_run, 32); inv = 1.f / lt; }
    float ss = 0.f;
#pragma unroll
    for (int dt = 0; dt < 4; ++dt)
#pragma unroll
        for (int r = 0; r < 16; ++r) { const float v = O[dt][r] * inv; O[dt][r] = v; ss += v * v; }
    ss += __shfl_xor(ss, 32);
    const float rstd = rsqrtf(ss * (1.f / HD) + EPS);
    f16* yp = (f16*)(p.ws + WS_Y) + grow * DM + hh * HD + 4 * hf;
    const float* gp = ong + hh * HD + 4 * hf;
#pragma unroll
    for (int dt = 0; dt < 4; ++dt)
#pragma unroll
        for (int g = 0; g < 4; ++g) {
            const f32x4 gg = *(const f32x4*)(gp + 32 * dt + 8 * g);
            u32x2 w; w.x = pack_h2(O[dt][4 * g] * rstd * gg[0], O[dt][4 * g + 1] * rstd * gg[1]); w.y = pack_h2(O[dt][4 * g + 2] * rstd * gg[2], O[dt][4 * g + 3] * rstd * gg[3]);
            *(u32x2*)(yp + 32 * dt + 8 * g) = w;
        }
}

__device__ __forceinline__ void phase_attn2(const Params& p, LAS unsigned char* lds, const float* ong) {
    for (int pi = obid(); pi < 512; pi += gridDim.x) {
        const int a = pi & 3, bh = pi >> 2, b = bh >> 4;
        int hh = bh & 15; if (pi >= 256) hh = (hh + 8) & 15;
        for (int e = 0; e < 2; ++e) {
            const int qt = e == 0 ? 7 - a : a;
            if (hh < HA) attn_item<0>(p, lds, ong, b, hh, qt, C_QA + hh * HD, C_KA, C_VA);
            else if (hh < HA + HB) attn_item<1>(p, lds, ong, b, hh, qt, C_QB + (hh - HA) * HD, C_KB + (hh - HA) * HD, C_VB + (hh - HA) * HD);
            else attn_item<2>(p, lds, ong, b, hh, qt, C_QC + (hh - HA - HB) * HD, C_KC + (hh - HA - HB) * HD, C_VC + (hh - HA - HB) * HD);
        }
    }
}

__device__ __forceinline__ void wave_argmax(float& v, int& idx) {
#pragma unroll
    for (int o = 32; o >= 1; o >>= 1) {
        const float ov = __shfl_xor(v, o); const int oi = __shfl_xor(idx, o);
        if (ov > v || (ov == v && oi < idx)) { v = ov; idx = oi; }
    }
}
__device__ __forceinline__ void phase_route(const Params& p, LAS unsigned char* lds_, const f16* subk) {
    const f16* qp = (const f16*)(p.ws + WS_Y);
    float* smem = (float*)(unsigned char*)lds_;
    const int tid = otid(), wid = tid >> 6, lane = tid & 63;
    float* qs = smem + wid * 256;
    unsigned* pe = (unsigned*)(p.ws + WS_PE); float* pg = (float*)(p.ws + WS_PG);
    const size_t nitems = (size_t)NT * PH;
    for (size_t it = (size_t)blockIdx.x * NWAVES + wid; it < nitems; it += (size_t)gridDim.x * NWAVES) {
        const int hp = (int)(it % PH); const int t = (int)(it / PH);
        const f16* qrow = qp + (size_t)t * DM + hp * 256;
        for (int i = lane; i < 256; i += 64) qs[i] = (float)qrow[i];
        __builtin_amdgcn_wave_barrier();
        float sv[2]; int si[2];
#pragma unroll
        for (int c = 0; c < 2; ++c) {
            float v0, v1;
            {
                const f16* k0 = subk + (((size_t)hp * 2 + c) * PNK + lane) * 128;
                const f16* k1 = k0 + 64 * 128;
                float a0 = 0.f, a1 = 0.f;
#pragma unroll 4
                for (int e8 = 0; e8 < 16; ++e8) {
                    const h8_t x0 = *(const h8_t*)(k0 + e8 * 8), x1 = *(const h8_t*)(k1 + e8 * 8);
#pragma unroll
                    for (int j = 0; j < 8; ++j) { const float qq = qs[c * 128 + e8 * 8 + j]; a0 += qq * (float)x0[j]; a1 += qq * (float)x1[j]; }
                }
                v0 = a0; v1 = a1;
            }
            float mysv = 0.f; int mysi = 0;
            for (int r = 0; r < PTOPK; ++r) {
                float v; int idx;
                if (v0 >= v1) { v = v0; idx = lane; } else { v = v1; idx = lane + 64; }
                wave_argmax(v, idx);
                if (idx == lane) v0 = -INFINITY;
                if (idx == lane + 64) v1 = -INFINITY;
                if (lane == r) { mysv = v; mysi = idx; }
            }
            sv[c] = mysv; si[c] = mysi;
        }
        float cs[4];
#pragma unroll
        for (int k = 0; k < 4; ++k) { const int id = 4 * lane + k; cs[k] = __shfl(sv[0], id >> 4) + __shfl(sv[1], id & 15); }
        float tops = 0.f; int pick = 0;
        for (int r = 0; r < PTOPK; ++r) {
            float v = cs[0]; int idx = 4 * lane;
#pragma unroll
            for (int k = 1; k < 4; ++k) if (cs[k] > v) { v = cs[k]; idx = 4 * lane + k; }
            wave_argmax(v, idx);
#pragma unroll
            for (int k = 0; k < 4; ++k) if (idx == 4 * lane + k) cs[k] = -INFINITY;
            if (lane == r) { tops = v; pick = idx; }
        }
        const int e0 = __shfl(si[0], pick >> 4), e1 = __shfl(si[1], pick & 15);
        const float mx = __shfl(tops, 0);
        float ex = lane < PTOPK ? __expf(tops - mx) : 0.f;
        const float sum = wave_sum(ex);
        if (lane < PTOPK) { pe[(size_t)t * 128 + hp * 16 + lane] = (unsigned)(e0 * PNK + e1); pg[(size_t)t * 128 + hp * 16 + lane] = ex / sum; }
        __builtin_amdgcn_wave_barrier();
    }
}

#define CE_DESC(a, b) do { const unsigned _x = (a) > (b) ? (a) : (b), _y = (a) > (b) ? (b) : (a); (a) = _x; (b) = _y; } while (0)
__device__ __forceinline__ void sort16_desc(unsigned (&k)[16]) {
#pragma unroll
    for (int kk = 2; kk <= 16; kk <<= 1)
#pragma unroll
        for (int j = kk >> 1; j > 0; j >>= 1)
#pragma unroll
            for (int i = 0; i < 16; ++i) { const int l = i ^ j; if (l > i) { if ((i & kk) == 0) CE_DESC(k[i], k[l]); else CE_DESC(k[l], k[i]); } }
}
__device__ __forceinline__ void merge16_desc(unsigned (&a)[16], const unsigned (&b)[16]) {
#pragma unroll
    for (int i = 0; i < 16; ++i) a[i] = a[i] > b[15 - i] ? a[i] : b[15 - i];
#pragma unroll
    for (int j = 8; j > 0; j >>= 1)
#pragma unroll
        for (int i = 0; i < 16; ++i) { const int l = i ^ j; if (l > i) CE_DESC(a[i], a[l]); }
}
__device__ __forceinline__ unsigned f2sort(float f) { const unsigned b = __float_as_uint(f); return b ^ ((unsigned)((int)b >> 31) | 0x80000000u); }
__device__ __forceinline__ float sort2f(unsigned u) { const unsigned b = (u & 0x80000000u) ? (u ^ 0x80000000u) : ~u; return __uint_as_float(b); }
constexpr int RT_STR = 272;
__device__ __forceinline__ void phase_route2(const Params& p, LAS unsigned char* lds, const f16* subk) {
    const f16* qp = (const f16*)(p.ws + WS_Y);
    unsigned* pe = (unsigned*)(p.ws + WS_PE); float* pg = (float*)(p.ws + WS_PG);
    const int tid = otid(), wid = __builtin_amdgcn_readfirstlane(tid >> 6), lane = tid & 63, qn = lane & 31, hf = lane >> 5;
    for (int item = obid(); item < 256; item += gridDim.x) {
        const int hp = item & 7, tg = item >> 3;
        __syncthreads();
        {
            const f16* src = subk + (size_t)hp * 256 * 128;
#pragma unroll
            for (int i = 0; i < 8; ++i) { const int e = tid + i * 512, r = e >> 4, c = e & 15; *(LAS u32x4*)(lds + r * RT_STR + 16 * c) = *(const u32x4*)(src + r * 128 + 8 * c); }
        }
        __syncthreads();
#pragma unroll 1
        for (int it = 0; it < 2; ++it) {
            const int t = (tg * 16 + wid * 2 + it) * 32 + qn;
            unsigned top[2][16];
#pragma unroll
            for (int c = 0; c < 2; ++c) {
                h8_t Bq[8];
                const f16* qrow = qp + (size_t)t * DM + hp * 256 + c * 128 + 8 * hf;
#pragma unroll
                for (int ks = 0; ks < 8; ++ks) Bq[ks] = *(const h8_t*)(qrow + 16 * ks);
                unsigned run[16];
#pragma unroll 1
                for (int nt = 0; nt < 4; ++nt) {
                    f32x16 S;
#pragma unroll
                    for (int r = 0; r < 16; ++r) S[r] = 0.f;
#pragma unroll
                    for (int ks = 0; ks < 8; ++ks) {
                        const h8_t a = *(const LAS h8_t*)(lds + (c * 128 + nt * 32 + qn) * RT_STR + 32 * ks + 16 * hf);
                        S = __builtin_amdgcn_mfma_f32_32x32x16_f16(a, Bq[ks], S, 0, 0, 0);
                    }
                    unsigned k[16];
#pragma unroll
                    for (int r = 0; r < 16; ++r) { const int n = 32 * nt + (r & 3) + 8 * (r >> 2) + 4 * hf; k[r] = (f2sort(S[r]) & ~127u) | (unsigned)(127 - n); }
                    sort16_desc(k);
                    if (nt == 0) {
#pragma unroll
                        for (int r = 0; r < 16; ++r) run[r] = k[r];
                    } else merge16_desc(run, k);
                }
#pragma unroll
                for (int r = 0; r < 16; ++r) top[c][r] = run[r];
            }
            unsigned mine[16], oth[16];
#pragma unroll
            for (int r = 0; r < 16; ++r) { const unsigned send = hf ? top[0][r] : top[1][r]; oth[r] = __shfl_xor(send, 32); mine[r] = hf ? top[1][r] : top[0][r]; }
            merge16_desc(mine, oth);
            unsigned ka[16], kb2[16];
#pragma unroll
            for (int r = 0; r < 16; ++r) { const unsigned o = __shfl_xor(mine[r], 32); ka[r] = hf ? o : mine[r]; kb2[r] = hf ? mine[r] : o; }
            float sa[16], sb[16]; unsigned na[4] = {0u, 0u, 0u, 0u}, nb[4] = {0u, 0u, 0u, 0u};
#pragma unroll
            for (int r = 0; r < 16; ++r) {
                sa[r] = sort2f(ka[r] & ~127u); sb[r] = sort2f(kb2[r] & ~127u);
                na[r >> 2] |= (127u - (ka[r] & 127u)) << (8 * (r & 3)); nb[r >> 2] |= (127u - (kb2[r] & 127u)) << (8 * (r & 3));
            }
            unsigned cand[4][16];
#pragma unroll
            for (int g = 0; g < 4; ++g)
#pragma unroll
                for (int r = 0; r < 16; ++r) cand[g][r] = 0u;
#pragma unroll
            for (int slot = 0; slot < 50; ++slot) {
                constexpr unsigned char CIJ[64] = {0, 1, 2, 3, 4, 5, 6, 7, 8, 9, 10, 11, 12, 13, 14, 15, 16, 17, 18, 19, 20, 21, 22, 23, 32, 33, 34, 35, 36, 48, 49, 50, 51, 64, 65, 66, 80, 81, 96, 97, 112, 113, 128, 144, 160, 176, 192, 208, 224, 240, 255, 255, 255, 255, 255, 255, 255, 255, 255, 255, 255, 255, 255, 255};
                const int ij = CIJ[slot], i = ij >> 4, j = ij & 15;
                cand[slot >> 4][slot & 15] = (f2sort(sa[i] + sb[j]) & ~255u) | (unsigned)(255 - ij);
            }
#pragma unroll
            for (int g = 1; g < 4; ++g) sort16_desc(cand[g]);
            merge16_desc(cand[0], cand[1]); merge16_desc(cand[2], cand[3]); merge16_desc(cand[0], cand[2]);
            float ex[16]; float sum = 0.f;
            const float mx = sort2f(cand[0][0] & ~255u);
#pragma unroll
            for (int r = 0; r < 16; ++r) { ex[r] = __expf(sort2f(cand[0][r] & ~255u) - mx); sum += ex[r]; }
            const float inv = 1.f / sum;
            unsigned eo[16];
#pragma unroll
            for (int r = 0; r < 16; ++r) {
                const unsigned id = 255u - (cand[0][r] & 255u), i = id >> 4, j = id & 15u;
                const unsigned wa = (i & 8u) ? ((i & 4u) ? na[3] : na[2]) : ((i & 4u) ? na[1] : na[0]);
                const unsigned wb = (j & 8u) ? ((j & 4u) ? nb[3] : nb[2]) : ((j & 4u) ? nb[1] : nb[0]);
                eo[r] = ((wa >> (8 * (i & 3u))) & 255u) * PNK + ((wb >> (8 * (j & 3u))) & 255u);
                ex[r] *= inv;
            }
            if (hf == 0) {
#pragma unroll
                for (int r4 = 0; r4 < 4; ++r4) { u32x4 w; w.x = eo[4 * r4]; w.y = eo[4 * r4 + 1]; w.z = eo[4 * r4 + 2]; w.w = eo[4 * r4 + 3]; *(u32x4*)(pe + (size_t)t * 128 + hp * 16 + 4 * r4) = w; }
            } else {
#pragma unroll
                for (int r4 = 0; r4 < 4; ++r4) { f32x4 w; w[0] = ex[4 * r4]; w[1] = ex[4 * r4 + 1]; w[2] = ex[4 * r4 + 2]; w[3] = ex[4 * r4 + 3]; *(f32x4*)(pg + (size_t)t * 128 + hp * 16 + 4 * r4) = w; }
            }
        }
    }
}

__device__ __forceinline__ void phase_experts(const Params& p, const f16* h2, const float* x1, const float* gate2  , const f16* u16, const f16* v16,
                              float* xout  , bool final_norm, const float* ng, const float* nshift, const float* nscale, f16* hnext, float* fout) {
    const int tid_ = otid(); const int wid = tid_ >> 6, lane = tid_ & 63;
    const unsigned* pe = (const unsigned*)(p.ws + WS_PE); const float* pg = (const float*)(p.ws + WS_PG);
    for (int t = blockIdx.x * NWAVES + wid; t < NT; t += gridDim.x * NWAVES) {
        const int b = t / SEQ;
        u32x4 hv[4];
#pragma unroll
        for (int i = 0; i < 4; ++i) hv[i] = *(const u32x4*)(h2 + (size_t)t * DM + 512 * i + 8 * lane);
        float acc[32];
#pragma unroll
        for (int i = 0; i < 32; ++i) acc[i] = 0.f;
        for (int g8 = 0; g8 < 32; ++g8) {
            const unsigned myexp = pe[(size_t)t * 128 + g8 * 4 + (lane & 3)];
            const float mygate = pg[(size_t)t * 128 + g8 * 4 + (lane & 3)];
            float part[4];
#pragma unroll
            for (int k = 0; k < 4; ++k) {
                const unsigned e = __shfl(myexp, k);
                const f16* ur = u16 + (size_t)e * DM + 8 * lane;
                float d = 0.f;
#pragma unroll
                for (int i = 0; i < 4; ++i) { const u32x4 w = *(const u32x4*)(ur + 512 * i); d = dot2(hv[i].x, w.x, d); d = dot2(hv[i].y, w.y, d); d = dot2(hv[i].z, w.z, d); d = dot2(hv[i].w, w.w, d); }
                part[k] = d;
            }
#pragma unroll
            for (int k = 0; k < 4; ++k) part[k] = wave_sum(part[k]);
#pragma unroll
            for (int k = 0; k < 4; ++k) {
                const float d = part[k];
                const float act = 0.5f * d * (1.f + erff(d * 0.70710678118654752f));
                const float coef = __shfl(mygate, k) * act;
                const unsigned e = __shfl(myexp, k);
                const f16* vr = v16 + (size_t)e * DM + 8 * lane;
#pragma unroll
                for (int i = 0; i < 4; ++i) {
                    const u32x4 w = *(const u32x4*)(vr + 512 * i);
                    acc[8 * i + 0] += coef * h_lo(w.x); acc[8 * i + 1] += coef * h_hi(w.x); acc[8 * i + 2] += coef * h_lo(w.y); acc[8 * i + 3] += coef * h_hi(w.y);
                    acc[8 * i + 4] += coef * h_lo(w.z); acc[8 * i + 5] += coef * h_hi(w.z); acc[8 * i + 6] += coef * h_lo(w.w); acc[8 * i + 7] += coef * h_hi(w.w);
                }
            }
        }
        float ss = 0.f;
#pragma unroll
        for (int i = 0; i < 4; ++i) {
            const int col = 512 * i + 8 * lane;
#pragma unroll
            for (int hf = 0; hf < 2; ++hf) {
                const f32x4 xi = *(const f32x4*)(x1 + (size_t)t * DM + col + 4 * hf);
                const f32x4 gt = *(const f32x4*)(gate2 + (size_t)b * 6 * DM + col + 4 * hf);
                f32x4 r;
#pragma unroll
                for (int j = 0; j < 4; ++j) { r[j] = xi[j] + gt[j] * acc[8 * i + 4 * hf + j]; acc[8 * i + 4 * hf + j] = r[j]; ss += r[j] * r[j]; }
                if (xout) *(f32x4*)(xout + (size_t)t * DM + col + 4 * hf) = r;
            }
        }
        ss = wave_sum(ss);
        const float rstd = rsqrtf(ss * (1.f / DM) + EPS);
#pragma unroll
        for (int i = 0; i < 4; ++i) {
            const int col = 512 * i + 8 * lane;
            if (final_norm) {
#pragma unroll
                for (int hf = 0; hf < 2; ++hf) {
                    const f32x4 gg = *(const f32x4*)(ng + col + 4 * hf);
                    f32x4 r;
#pragma unroll
                    for (int j = 0; j < 4; ++j) r[j] = acc[8 * i + 4 * hf + j] * rstd * gg[j];
                    *(f32x4*)(fout + (size_t)t * DM + col + 4 * hf) = r;
                }
            } else {
                float yv[8];
#pragma unroll
                for (int hf = 0; hf < 2; ++hf) {
                    const f32x4 gg = *(const f32x4*)(ng + col + 4 * hf), sh = *(const f32x4*)(nshift + (size_t)b * 6 * DM + col + 4 * hf), sc = *(const f32x4*)(nscale + (size_t)b * 6 * DM + col + 4 * hf);
#pragma unroll
                    for (int j = 0; j < 4; ++j) yv[4 * hf + j] = acc[8 * i + 4 * hf + j] * rstd * gg[j] * (1.f + sc[j]) + sh[j];
                }
                u32x4 w; w.x = pack_h2(yv[0], yv[1]); w.y = pack_h2(yv[2], yv[3]); w.z = pack_h2(yv[4], yv[5]); w.w = pack_h2(yv[6], yv[7]);
                *(u32x4*)(hnext + (size_t)t * DM + col) = w;
            }
        }
    }
}

__device__ __forceinline__ void phase_experts8(const Params& p, const float* x1, const float* gate2, const unsigned char* u8, const unsigned char* v8, const float* su, const float* sv,
                              float* xout  , bool final_norm, const float* ng, const float* nshift, const float* nscale, f16* hnext, float* fout) {
    const int tid_ = otid(); const int wid = tid_ >> 6, lane = tid_ & 63;
    const unsigned* pe = (const unsigned*)(p.ws + WS_PE); const float* pg = (const float*)(p.ws + WS_PG);
    const unsigned char* h8 = (const unsigned char*)(p.ws + WS_H8); const float* shv = (const float*)(p.ws + WS_SH);
    for (int t = blockIdx.x * NWAVES + wid; t < NT; t += gridDim.x * NWAVES) {
        const int b = t / SEQ;
        u32x4 hv[2];
#pragma unroll
        for (int i = 0; i < 2; ++i) hv[i] = *(const u32x4*)(h8 + (size_t)t * DM + 1024 * i + 16 * lane);
        const float sht = shv[t];
        float acc[32]; float csum = 0.f;
#pragma unroll
        for (int i = 0; i < 32; ++i) acc[i] = 0.f;
        for (int g4 = 0; g4 < 32; ++g4) {
            const unsigned myexp = pe[(size_t)t * 128 + g4 * 4 + (lane & 3)];
            const float mygate = pg[(size_t)t * 128 + g4 * 4 + (lane & 3)];
            const float mysc = mygate * sv[myexp];
            const float mydsc = su[myexp] * sht;
            int part[4]; u32x4 vr[4][2];
#pragma unroll
            for (int k = 0; k < 4; ++k) {
                const unsigned e = __shfl(myexp, k);
                const unsigned char* ur = u8 + (size_t)e * DM + 16 * lane;
                const unsigned char* vp = v8 + (size_t)e * DM + 16 * lane;
                int d = 0;
#pragma unroll
                for (int i = 0; i < 2; ++i) {
                    const u32x4 w = *(const u32x4*)(ur + 1024 * i);
                    d = __builtin_amdgcn_sdot4((int)hv[i].x, (int)w.x, d, false); d = __builtin_amdgcn_sdot4((int)hv[i].y, (int)w.y, d, false);
                    d = __builtin_amdgcn_sdot4((int)hv[i].z, (int)w.z, d, false); d = __builtin_amdgcn_sdot4((int)hv[i].w, (int)w.w, d, false);
                    vr[k][i] = *(const u32x4*)(vp + 1024 * i);
                }
                part[k] = d;
            }
#pragma unroll
            for (int k = 0; k < 4; ++k) {
#pragma unroll
                for (int o = 32; o >= 1; o >>= 1) part[k] += __shfl_xor(part[k], o);
            }
#pragma unroll
            for (int k = 0; k < 4; ++k) {
                const float d = (float)part[k] * __shfl(mydsc, k);
                const float act = 0.5f * d * (1.f + erff(d * 0.70710678118654752f));
                const float coef = __shfl(mysc, k) * act;
                csum += coef;
#pragma unroll
                for (int i = 0; i < 2; ++i) {
                    const unsigned ww[4] = {vr[k][i].x, vr[k][i].y, vr[k][i].z, vr[k][i].w};
#pragma unroll
                    for (int q = 0; q < 4; ++q) {
                        acc[16 * i + 4 * q + 0] += coef * (float)(ww[q] & 255u); acc[16 * i + 4 * q + 1] += coef * (float)((ww[q] >> 8) & 255u);
                        acc[16 * i + 4 * q + 2] += coef * (float)((ww[q] >> 16) & 255u); acc[16 * i + 4 * q + 3] += coef * (float)(ww[q] >> 24);
                    }
                }
            }
        }
        float ss = 0.f;
#pragma unroll
        for (int i = 0; i < 2; ++i)
#pragma unroll
            for (int q = 0; q < 4; ++q) {
                const int col = 1024 * i + 16 * lane + 4 * q;
                const f32x4 xi = *(const f32x4*)(x1 + (size_t)t * DM + col);
                const f32x4 gt = *(const f32x4*)(gate2 + (size_t)b * 6 * DM + col);
                f32x4 r;
#pragma unroll
                for (int j = 0; j < 4; ++j) { r[j] = xi[j] + gt[j] * (acc[16 * i + 4 * q + j] - 128.f * csum); acc[16 * i + 4 * q + j] = r[j]; ss += r[j] * r[j]; }
                if (xout) *(f32x4*)(xout + (size_t)t * DM + col) = r;
            }
        ss = wave_sum(ss);
        const float rstd = rsqrtf(ss * (1.f / DM) + EPS);
#pragma unroll
        for (int i = 0; i < 2; ++i) {
            const int col0 = 1024 * i + 16 * lane;
            if (final_norm) {
#pragma unroll
                for (int q = 0; q < 4; ++q) {
                    const f32x4 gg = *(const f32x4*)(ng + col0 + 4 * q);
                    f32x4 r;
#pragma unroll
                    for (int j = 0; j < 4; ++j) r[j] = acc[16 * i + 4 * q + j] * rstd * gg[j];
                    *(f32x4*)(fout + (size_t)t * DM + col0 + 4 * q) = r;
                }
            } else {
                float yv[16];
#pragma unroll
                for (int q = 0; q < 4; ++q) {
                    const f32x4 gg = *(const f32x4*)(ng + col0 + 4 * q), sh = *(const f32x4*)(nshift + (size_t)b * 6 * DM + col0 + 4 * q), sc = *(const f32x4*)(nscale + (size_t)b * 6 * DM + col0 + 4 * q);
#pragma unroll
                    for (int j = 0; j < 4; ++j) yv[4 * q + j] = acc[16 * i + 4 * q + j] * rstd * gg[j] * (1.f + sc[j]) + sh[j];
                }
                u32x4 w0, w1;
                w0.x = pack_h2(yv[0], yv[1]); w0.y = pack_h2(yv[2], yv[3]); w0.z = pack_h2(yv[4], yv[5]); w0.w = pack_h2(yv[6], yv[7]);
                w1.x = pack_h2(yv[8], yv[9]); w1.y = pack_h2(yv[10], yv[11]); w1.z = pack_h2(yv[12], yv[13]); w1.w = pack_h2(yv[14], yv[15]);
                *(u32x4*)(hnext + (size_t)t * DM + col0) = w0; *(u32x4*)(hnext + (size_t)t * DM + col0 + 8) = w1;
            }
        }
    }
}

__device__ __forceinline__ unsigned xcc_id() { return (unsigned)__builtin_amdgcn_s_getreg((3 << 11) | 20) & 0xFu; }
__device__ __forceinline__ void phase_exu(const Params& p, LAS unsigned char* lds, const unsigned char* u8, const float* su, const float* sv) {
    const int tid = otid(), wid = __builtin_amdgcn_readfirstlane(tid >> 6), lane = tid & 63, sub = lane & 15, qd = lane >> 4;
    const unsigned* pe = (const unsigned*)(p.ws + WS_PE); const float* pg = (const float*)(p.ws + WS_PG);
    const unsigned char* h8 = (const unsigned char*)(p.ws + WS_H8); const float* shv = (const float*)(p.ws + WS_SH);
    unsigned* list = (unsigned*)(p.ws + WS_LIST);
    const unsigned* ctl = (const unsigned*)(p.ws + WS_CTL);
    const unsigned myx = *(const LAS unsigned*)(lds + LDS_BYTES - 16), mybi = *(const LAS unsigned*)(lds + LDS_BYTES - 12);
    int G = 0, g = 0, nb = 1;
#pragma unroll
    for (int j = 0; j < 16; ++j) { const unsigned c = __builtin_amdgcn_readfirstlane(__hip_atomic_load(ctl + j, __ATOMIC_RELAXED, __HIP_MEMORY_SCOPE_AGENT)); if (c > 0u) { if ((unsigned)j < myx) ++g; ++G; } if ((unsigned)j == myx) nb = (int)c; }
    const int tstep = nb * NWAVES, tfirst = (int)mybi * NWAVES + wid;
    const int nvis_t = (tfirst < NT) ? (NT - tfirst + tstep - 1) / tstep : 0;
    const int nrange = (16 - g + G - 1) / G;
    const int nvis = nvis_t * nrange;
    unsigned ne0 = 0u, ne1 = 0u; u32x4 nhv[8]; float nsh = 0.f;
#define EXU_FETCH(v_) do { const int tt_ = tfirst + ((v_) % nvis_t) * tstep; ne0 = pe[(size_t)tt_ * 128 + lane]; ne1 = pe[(size_t)tt_ * 128 + 64 + lane]; \
        _Pragma("unroll") for (int m = 0; m < 8; ++m) nhv[m] = *(const u32x4*)(h8 + (size_t)tt_ * DM + 256 * m + 16 * sub); nsh = shv[tt_]; } while (0)
    if (nvis > 0) EXU_FETCH(0);
    for (int v = 0; v < nvis; ++v) {
        const int t = tfirst + (v % nvis_t) * tstep, r = g + (v / nvis_t) * G;
        const unsigned e0 = ne0, e1 = ne1; const float sht = nsh;
        u32x4 hv[8];
#pragma unroll
        for (int m = 0; m < 8; ++m) hv[m] = nhv[m];
        if (v + 1 < nvis) EXU_FETCH(v + 1);
        const bool in0 = (int)(e0 >> 10) == r, in1 = (int)(e1 >> 10) == r;
        const unsigned long long m0 = __ballot(in0), m1 = __ballot(in1);
        const int n0 = __builtin_popcountll(m0), n = n0 + __builtin_popcountll(m1);
        if (n == 0) continue;
        LAS unsigned* wl = (LAS unsigned*)(lds + wid * 1024 + (v & 1) * 512);
        const unsigned long long below = (1ull << lane) - 1ull;
        if (in0) wl[__builtin_popcountll(m0 & below)] = ((unsigned)lane << 16) | e0;
        if (in1) wl[n0 + __builtin_popcountll(m1 & below)] = ((unsigned)(lane + 64) << 16) | e1;
        __builtin_amdgcn_wave_barrier();
        const int nit = (n + 3) >> 2;
        u32x4 wb[2][8]; unsigned entb[2];
        {
            const bool valid = qd < n; entb[0] = wl[valid ? qd : 0];
            const unsigned char* row = u8 + (size_t)(entb[0] & 0xffffu) * DM + 16 * sub;
#pragma unroll
            for (int m = 0; m < 8; ++m) wb[0][m] = *(const u32x4*)(row + 256 * m);
        }
        for (int it = 0; it < nit; it += 2) {
#pragma unroll
            for (int ph2 = 0; ph2 < 2; ++ph2) {
                const int cit = it + ph2;
                if (cit < nit) {
                    if (cit + 1 < nit) {
                        const int idx = (cit + 1) * 4 + qd; const bool valid = idx < n; entb[ph2 ^ 1] = wl[valid ? idx : 0];
                        const unsigned char* row = u8 + (size_t)(entb[ph2 ^ 1] & 0xffffu) * DM + 16 * sub;
#pragma unroll
                        for (int m = 0; m < 8; ++m) wb[ph2 ^ 1][m] = *(const u32x4*)(row + 256 * m);
                    }
                    int d = 0;
#pragma unroll
                    for (int m = 0; m < 8; ++m) {
                        const u32x4 w = wb[ph2][m];
                        d = __builtin_amdgcn_sdot4((int)hv[m].x, (int)w.x, d, false); d = __builtin_amdgcn_sdot4((int)hv[m].y, (int)w.y, d, false);
                        d = __builtin_amdgcn_sdot4((int)hv[m].z, (int)w.z, d, false); d = __builtin_amdgcn_sdot4((int)hv[m].w, (int)w.w, d, false);
                    }
                    d += __shfl_xor(d, 1); d += __shfl_xor(d, 2); d += __shfl_xor(d, 4); d += __shfl_xor(d, 8);
                    const bool valid = cit * 4 + qd < n;
                    if (valid && sub == 0) {
                        const unsigned ent = entb[ph2], j = ent >> 16, e = ent & 0xffffu;
                        const float dd = (float)d * su[e] * sht;
                        const float act = 0.5f * dd * (1.f + erff(dd * 0.70710678118654752f));
                        const float coef = pg[(size_t)t * 128 + j] * sv[e] * act * 1024.f;
                        const f16 ch = (f16)coef;
                        list[((size_t)(j >> 2) * NT + t) * 4 + (j & 3u)] = (e << 16) | (unsigned)__builtin_bit_cast(unsigned short, ch);
                    }
                }
            }
        }
    }
#undef EXU_FETCH
}

__device__ __forceinline__ void phase_exv(const Params& p, LAS unsigned char* lds, const float* x1, const float* gate2, const unsigned char* v8c, float* xout) {
    const int tid = otid();
    const u32x4* list = (const u32x4*)(p.ws + WS_LIST);
    for (int c = obid(); c < 256; c += gridDim.x) {
        __syncthreads();
        {
            const u32x4* src = (const u32x4*)(v8c + (size_t)c * PEXP * 8);
#pragma unroll 4
            for (int i = 0; i < 16; ++i) *(LAS u32x4*)(lds + (size_t)(i * 512 + tid) * 16) = src[i * 512 + tid];
        }
        __syncthreads();
        for (int t = tid; t < NT; t += NTHREADS) {
            float acc[8]; float csum = 0.f;
#pragma unroll
            for (int k = 0; k < 8; ++k) acc[k] = 0.f;
#pragma unroll 1
            for (int jb = 0; jb < 2; ++jb) {
                u32x4 wv[16];
#pragma unroll
                for (int j4 = 0; j4 < 16; ++j4) wv[j4] = list[(size_t)(jb * 16 + j4) * NT + t];
#pragma unroll
                for (int j4 = 0; j4 < 16; ++j4) {
                    const unsigned ww[4] = {wv[j4].x, wv[j4].y, wv[j4].z, wv[j4].w};
#pragma unroll
                    for (int q = 0; q < 4; ++q) {
                        const float coef = (float)__builtin_bit_cast(f16, (unsigned short)(ww[q] & 0xffffu));
                        const u32x2 vb = *(const LAS u32x2*)(lds + (ww[q] >> 16) * 8);
                        csum += coef;
                        acc[0] += coef * (float)(vb.x & 255u); acc[1] += coef * (float)((vb.x >> 8) & 255u); acc[2] += coef * (float)((vb.x >> 16) & 255u); acc[3] += coef * (float)(vb.x >> 24);
                        acc[4] += coef * (float)(vb.y & 255u); acc[5] += coef * (float)((vb.y >> 8) & 255u); acc[6] += coef * (float)((vb.y >> 16) & 255u); acc[7] += coef * (float)(vb.y >> 24);
                    }
                }
            }
            const int b = t / SEQ, col = 8 * c;
            const float off = 128.f * csum;
#pragma unroll
            for (int hfi = 0; hfi < 2; ++hfi) {
                const f32x4 xi = *(const f32x4*)(x1 + (size_t)t * DM + col + 4 * hfi);
                const f32x4 gt = *(const f32x4*)(gate2 + (size_t)b * 6 * DM + col + 4 * hfi);
                f32x4 r;
#pragma unroll
                for (int k = 0; k < 4; ++k) r[k] = xi[k] + gt[k] * ((acc[4 * hfi + k] - off) * (1.f / 1024.f));
                *(f32x4*)(xout + (size_t)t * DM + col + 4 * hfi) = r;
            }
        }
    }
}

__device__ __forceinline__ void phase_norm_out(const Params& p, float* x2, bool final_norm, const float* g, const float* shift, const float* scale, f16* hout) {
    const int tid_ = otid(); const int wid = tid_ >> 6, lane = tid_ & 63;
    for (int row = blockIdx.x * NWAVES + wid; row < NT; row += gridDim.x * NWAVES) {
        const int b = row / SEQ;
        float* xr = x2 + (size_t)row * DM;
        f32x4 v[8]; float ss = 0.f;
#pragma unroll
        for (int i = 0; i < 8; ++i) { v[i] = *(const f32x4*)(xr + i * 256 + lane * 4); ss += v[i][0] * v[i][0] + v[i][1] * v[i][1] + v[i][2] * v[i][2] + v[i][3] * v[i][3]; }
        ss = wave_sum(ss);
        const float rstd = rsqrtf(ss * (1.f / DM) + EPS);
#pragma unroll
        for (int i = 0; i < 8; ++i) {
            const int col = i * 256 + lane * 4;
            const f32x4 gg = *(const f32x4*)(g + col);
            if (final_norm) { *(f32x4*)(xr + col) = v[i] * rstd * gg; }
            else {
                const f32x4 sh = *(const f32x4*)(shift + (size_t)b * 6 * DM + col), sc = *(const f32x4*)(scale + (size_t)b * 6 * DM + col);
                const f32x4 y = v[i] * rstd * gg * (sc + 1.f) + sh;
                u32x2 w; w.x = pack_h2(y[0], y[1]); w.y = pack_h2(y[2], y[3]);
                *(u32x2*)(hout + (size_t)row * DM + col) = w;
            }
        }
    }
}

#define XB_TMO      128
#define XB_XCNT(j)  (256  + 64 * (j))
#define XB_XSUB(j)  (1280 + 64 * (j))
#define XB_XGEN(j)  (2304 + 64 * (j))
#define XB_TOP      3328
#define XB_TOPGEN   3392
#define XCD_BAR_WORDS 3456
#define XB_SPIN_CAP (1u << 22)
__device__ __forceinline__ unsigned xb_ld(unsigned* p) { return __hip_atomic_load(p, __ATOMIC_RELAXED, __HIP_MEMORY_SCOPE_AGENT); }
__device__ __forceinline__ unsigned xb_add(unsigned* p, unsigned v) { return __hip_atomic_fetch_add(p, v, __ATOMIC_RELAXED, __HIP_MEMORY_SCOPE_AGENT); }
#define XB_SPIN(cond, bar) do { unsigned _sp = 0; while (cond) { __builtin_amdgcn_s_sleep(1); \
    if ((++_sp & 255u) == 0u) { if (xb_ld(&(bar)[XB_TMO])) break; if (_sp > XB_SPIN_CAP) { atomicAdd(&(bar)[XB_TMO], 1u); break; } } } } while (0)
struct XcdBarrier { unsigned* bar; unsigned x; volatile LAS unsigned* st; };
__device__ __forceinline__ void xcd_barrier_complete(unsigned* bar, unsigned x, unsigned& nloc, unsigned& nx) {
    const unsigned G = gridDim.x * gridDim.y * gridDim.z;
    unsigned sum, cnt, mine, sp = 0u;
    for (;;) {
        sum = 0u; cnt = 0u; mine = 0u;
#pragma unroll
        for (unsigned j = 0; j < 16; ++j) { const unsigned c = xb_ld(&bar[XB_XCNT(j)]); sum += c; cnt += (c > 0u) ? 1u : 0u; mine = (j == x) ? c : mine; }
        if (sum == G) break;
        __builtin_amdgcn_s_sleep(1);
        if ((++sp & 255u) == 0u) { if (xb_ld(&bar[XB_TMO])) break; if (sp > XB_SPIN_CAP) { atomicAdd(&bar[XB_TMO], 1u); break; } }
    }
    nloc = mine > 0u ? mine : 1u; nx = cnt > 0u ? cnt : 1u;
}
__device__ __forceinline__ void xcd_barrier(const XcdBarrier& b) {
    asm volatile("s_waitcnt vmcnt(0)" ::: "memory");
    __syncthreads();
    if (threadIdx.x == 0) {
        unsigned* bar = b.bar;
        __builtin_amdgcn_s_waitcnt(0);
        unsigned nloc = b.st[0], nx = b.st[1];
        if (nloc == 0u) { xcd_barrier_complete(bar, b.x, nloc, nx); b.st[0] = nloc; b.st[1] = nx; }
        const unsigned old = xb_add(&bar[XB_XSUB(b.x)], 1u);
        const unsigned gen = old / nloc;
        if (old + 1u == (gen + 1u) * nloc) {
            __builtin_amdgcn_fence(__ATOMIC_RELEASE, "agent");
            asm volatile("s_waitcnt vmcnt(0)" ::: "memory");
            const unsigned og = xb_add(&bar[XB_TOP], 1u);
            const unsigned tg = og / nx;
            if (og + 1u == (tg + 1u) * nx) xb_add(&bar[XB_TOPGEN], 1u);
            else XB_SPIN(xb_ld(&bar[XB_TOPGEN]) == tg, bar);
            __builtin_amdgcn_fence(__ATOMIC_ACQUIRE, "agent");
            xb_add(&bar[XB_XGEN(b.x)], 1u);
            asm volatile("s_waitcnt vmcnt(0)" ::: "memory");
        } else {
            XB_SPIN(xb_ld(&bar[XB_XGEN(b.x)]) == gen, bar);
            __builtin_amdgcn_fence(__ATOMIC_ACQUIRE, "agent");
            asm volatile("s_waitcnt vmcnt(0)" ::: "memory");
        }
    }
    __syncthreads();
}

constexpr int PH_CONV = 0, PH_N1 = 1, PH_L0 = 2, PH_PER_LAYER = 11, PH_TOTAL = PH_L0 + DEPTH * PH_PER_LAYER;

__global__ void __launch_bounds__(NTHREADS, 2) mega(Params p_arg) {
    extern __shared__ __attribute__((aligned(16))) unsigned char shm[];
    LAS unsigned char* lds = (LAS unsigned char*)shm;
    typedef const Params __attribute__((address_space(4)))* KP;
    const int ph_lo = p_arg.ph_lo, ph_hi = p_arg.ph_hi;
    if (threadIdx.x == 0) {
        const unsigned x = xcc_id();
        const unsigned bi = __hip_atomic_fetch_add((unsigned*)(p_arg.ws + WS_CTL) + x, 1u, __ATOMIC_RELAXED, __HIP_MEMORY_SCOPE_AGENT);
        *(LAS unsigned*)(lds + LDS_BYTES - 16) = x; *(LAS unsigned*)(lds + LDS_BYTES - 12) = bi;
        *(LAS unsigned*)(lds + LDS_BYTES - 32) = 0u; *(LAS unsigned*)(lds + LDS_BYTES - 28) = 0u;
        (void)xb_add((unsigned*)(p_arg.ws + WS_CTL + 256) + XB_XCNT(x), 1u);
    }
    __syncthreads();
    XcdBarrier xbar; xbar.bar = (unsigned*)(p_arg.ws + WS_CTL + 256); xbar.x = *(const LAS unsigned*)(lds + LDS_BYTES - 16); xbar.st = (volatile LAS unsigned*)(lds + LDS_BYTES - 32);
#ifndef PMASK
#define PMASK 0xff
#endif
#define EN(k) ((PMASK >> (k)) & 1)
    for (int ph = ph_lo; ph < ph_hi; ++ph) {
        KP kp = (KP)__builtin_amdgcn_kernarg_segment_ptr();
        asm volatile("" : "+s"(kp));
#if defined(__HIP_DEVICE_COMPILE__)
        const Params p = *kp;
#else
        const Params p = p_arg;
#endif
        unsigned char* ws = p.ws;
        const float* mod = (const float*)(ws + WS_MOD);
        int kind, l = 0, s = -1;
        if (ph == PH_CONV) kind = 0;
        else if (ph == PH_N1) kind = 1;
        else {
            l = (ph - PH_L0) / PH_PER_LAYER; s = (ph - PH_L0) % PH_PER_LAYER;
            kind = (s == 0 || s == 4 || s == 6) ? 2 : (s == 1 ? 3 : (s == 2 ? 4 : (s == 3 ? 5 : (s == 5 ? 1 : (s == 7 ? 6 : (s == 8 ? 7 : (s == 9 ? 8 : 9)))))));
        }
        const float* modl = mod + (size_t)l * NB * 6 * DM;
        const float* xin = l == 0 ? p.x : p.out;
        float* x1 = (float*)(ws + WS_X1);
#ifndef REPEAT_KIND
#define REPEAT_KIND -1
#endif
        for (int rep = 0; rep < ((kind == REPEAT_KIND) ? 2 : 1); ++rep) {
        if (rep == 1) xcd_barrier(xbar);
        if (kind == 0) { if (EN(0)) phase_conv(p, lds); }
        else if (kind == 1) {
            if (EN(1)) {
                if (s < 0) phase_norm(p, p.x, p.n1g, mod + 0 * DM, mod + 1 * DM, (f16*)(ws + WS_H));
                else phase_norm(p, x1, p.n2g + (size_t)l * DM, modl + 3 * DM, modl + 4 * DM, (f16*)(ws + WS_H), (unsigned*)(ws + WS_H8), (float*)(ws + WS_SH));
            }
        } else if (kind == 2) {
            if (EN(2)) {
                Epi E{}; const f16* A; const f16* Bt; int N;
                if (s == 0) { E.mode = 0; E.o16 = (f16*)(ws + WS_PROJ); E.ldc = INWP; A = (const f16*)(ws + WS_H); Bt = (const f16*)(ws + WS_WTIN) + (size_t)l * INWP * DM; N = INWP; }
                else if (s == 4) { E.mode = 1; E.o32 = x1; E.xin = xin; E.gate = modl + 2 * DM; A = (const f16*)(ws + WS_Y); Bt = (const f16*)(ws + WS_WTOUT) + (size_t)l * DM * DM; N = DM; }
                else { E.mode = 0; E.o16 = (f16*)(ws + WS_Y); E.ldc = DM; A = (const f16*)(ws + WS_H); Bt = (const f16*)(ws + WS_WTQ) + (size_t)l * DM * DM; N = DM; }
                gemm_run(p, lds, A, Bt, N, E);
            }
        } else if (kind == 3) { if (EN(3)) phase_rope(p); }
        else if (kind == 4) { if (EN(4)) phase_index2(p, lds); }
        else if (kind == 5) { if (EN(5)) phase_attn2(p, lds, p.ong + (size_t)l * DM); }
        else if (kind == 6) { if (EN(6)) phase_route2(p, lds, (const f16*)(ws + WS_SUBK) + (size_t)l * PH * 2 * PNK * 128); }
        else if (kind == 7) {
            if (EN(7)) phase_exu(p, lds, ws + WS_U8 + (size_t)l * PEXP * DM, (const float*)(ws + WS_SU) + (size_t)l * PEXP, (const float*)(ws + WS_SV) + (size_t)l * PEXP);
        } else if (kind == 8) {
            if (EN(7)) phase_exv(p, lds, x1, modl + 5 * DM, ws + WS_V8 + (size_t)l * PEXP * DM, p.out);
        } else {
            const bool fin = (l == DEPTH - 1);
            const float* modn = mod + (size_t)(fin ? l : l + 1) * NB * 6 * DM;
            if (EN(1)) phase_norm_out(p, p.out, fin, fin ? p.fg : p.n1g + (size_t)(l + 1) * DM, modn + 0 * DM, modn + 1 * DM, (f16*)(ws + WS_H));
        }
        }
        if (ph + 1 < ph_hi) { if (ph == ph_lo) cg::this_grid().sync(); else xcd_barrier(xbar); }
    }
}

extern "C" void kernel_launch(void* const* d_in, const int* in_sizes, int n_in, void* d_out, int out_size, void* d_ws, size_t ws_size, hipStream_t stream) {
    static int grid = 0;
    if (grid == 0) {
        if (n_in != 14 || out_size != NT * DM || ws_size < WS_END) { fprintf(stderr, "kernel_launch: unexpected sizes (n_in %d out %d ws %zu need %zu)\n", n_in, out_size, ws_size, (size_t)WS_END); grid = -1; return; }
        if (hipFuncSetAttribute((const void*)mega, hipFuncAttributeMaxDynamicSharedMemorySize, LDS_BYTES) != hipSuccess) { fprintf(stderr, "kernel_launch: hipFuncSetAttribute failed\n"); grid = -1; return; }
        int dev = 0, cus = 0, per_cu = 0;
        hipGetDevice(&dev); hipDeviceGetAttribute(&cus, hipDeviceAttributeMultiprocessorCount, dev);
        hipOccupancyMaxActiveBlocksPerMultiprocessor(&per_cu, (const void*)mega, NTHREADS, LDS_BYTES);
        if (per_cu < 1) { fprintf(stderr, "kernel_launch: occupancy query says %d blocks per CU\n", per_cu); grid = -1; return; }
        grid = cus;
    }
    if (grid < 0) return;
    Params p{};
    p.x = (const float*)d_in[0]; p.c = (const float*)d_in[1]; p.ada_w = (const float*)d_in[2]; p.ada_b = (const float*)d_in[3];
    p.n1g = (const float*)d_in[4]; p.n2g = (const float*)d_in[5]; p.w_in = (const float*)d_in[6]; p.ong = (const float*)d_in[7];
    p.w_out = (const float*)d_in[8]; p.wq = (const float*)d_in[9]; p.subk = (const float*)d_in[10]; p.pu = (const float*)d_in[11];
    p.pv = (const float*)d_in[12]; p.fg = (const float*)d_in[13];
    p.out = (float*)d_out; p.ws = (unsigned char*)d_ws;
#if 0
    for (int ph = 0; ph < PH_TOTAL; ++ph) {
        p.ph_lo = ph; p.ph_hi = ph + 1;
        hipLaunchKernelGGL(mega, dim3(grid), dim3(NTHREADS), LDS_BYTES, stream, p);
    }
#else
    p.ph_lo = 0; p.ph_hi = PH_TOTAL;
    if (hipMemsetAsync((char*)d_ws + WS_CTL, 0, CTL_BYTES, stream) != hipSuccess) { fprintf(stderr, "kernel_launch: memset of control words failed\n"); return; }
    void* args[] = {&p};
    hipError_t e = hipLaunchCooperativeKernel((const void*)mega, dim3(grid), dim3(NTHREADS), args, LDS_BYTES, stream);
    if (e != hipSuccess) fprintf(stderr, "cooperative launch failed: %s (grid %d)\n", hipGetErrorString(e), grid);
#endif
}
```

```cpp
#include <hip/hip_runtime.h>
#include <hip/hip_cooperative_groups.h>
#include <cstdio>
#include <cstdint>
namespace cg = cooperative_groups;

#define LAS __attribute__((address_space(3)))
typedef _Float16 f16;
typedef _Float16 h2_t __attribute__((ext_vector_type(2)));
typedef _Float16 h4_t __attribute__((ext_vector_type(4)));
typedef _Float16 h8_t __attribute__((ext_vector_type(8)));
typedef float f32x4 __attribute__((ext_vector_type(4)));
typedef unsigned u32x4 __attribute__((ext_vector_type(4)));
typedef unsigned u32x2 __attribute__((ext_vector_type(2)));

constexpr int NB = 8, SEQ = 2048, DM = 2048, NT = NB * SEQ, DEPTH = 2;
constexpr int HD = 128, HA = 6, HB = 5, HC = 5, NHEADS = 16;
constexpr int IH = 16, IDM = 64, DSA_TOPK = 256;
constexpr int MOBA_BLK = 256, MOBA_NB = 8;
constexpr int INW = 5968, INWP = 6144;
constexpr int PH = 8, PNK = 128, PTOPK = 16, PEXP = 16384;
constexpr float EPS = 1e-6f;
constexpr int C_QA = 0, C_KA = 768, C_VA = 896, C_IQ = 1024, C_IK = 2048, C_IW = 2112, C_QB = 2176, C_KB = 2816, C_VB = 3456,
              C_QC = 4096, C_KC = 4736, C_VC = 5376, C_END = 6016;

constexpr int NTHREADS = 512, NWAVES = 8;
constexpr int LDS_BYTES = 147456;

constexpr size_t al256(size_t x) { return (x + 255) & ~(size_t)255; }
constexpr size_t WS_WTIN = 0;
constexpr size_t WS_WTOUT = WS_WTIN + (size_t)DEPTH * INWP * DM * 2;
constexpr size_t WS_WTQ = WS_WTOUT + (size_t)DEPTH * DM * DM * 2;
constexpr size_t WS_U8 = WS_WTQ + (size_t)DEPTH * DM * DM * 2;
constexpr size_t WS_V8 = WS_U8 + (size_t)DEPTH * PEXP * DM;
constexpr size_t WS_SU = WS_V8 + (size_t)DEPTH * PEXP * DM;
constexpr size_t WS_SV = WS_SU + (size_t)DEPTH * PEXP * 4;
constexpr size_t WS_H8 = WS_SV + (size_t)DEPTH * PEXP * 4;
constexpr size_t WS_SH = WS_H8 + (size_t)NT * DM;
constexpr size_t WS_SUBK = WS_SH + (size_t)NT * 4;
constexpr size_t WS_MOD = WS_SUBK + (size_t)DEPTH * PH * 2 * PNK * 128 * 2;
constexpr size_t WS_ROPE128 = WS_MOD + (size_t)DEPTH * NB * 6 * DM * 4;
constexpr size_t WS_ROPE64 = WS_ROPE128 + (size_t)SEQ * 64 * 8;
constexpr size_t WS_H = WS_ROPE64 + (size_t)SEQ * 32 * 8;
constexpr size_t WS_PROJ = WS_H + (size_t)NT * DM * 2;
constexpr size_t WS_KMEAN = WS_PROJ + (size_t)NT * INWP * 2;
constexpr size_t WS_MASK = WS_KMEAN + al256((size_t)NB * HC * MOBA_NB * HD * 4);
constexpr size_t WS_Y = WS_MASK + (size_t)NB * SEQ * 64 * 4;
constexpr size_t WS_X1 = WS_Y + (size_t)NT * DM * 2;
constexpr size_t WS_PE = WS_X1 + (size_t)NT * DM * 4;
constexpr size_t WS_PG = WS_PE + (size_t)NT * 128 * 4;
constexpr size_t WS_LIST = WS_PG + (size_t)NT * 128 * 4;
constexpr size_t WS_CTL = WS_LIST + (size_t)NT * 128 * 4;
constexpr size_t CTL_BYTES = 16384;
constexpr size_t WS_END = WS_CTL + CTL_BYTES;

struct Params {
    const float *x, *c, *ada_w, *ada_b, *n1g, *n2g, *w_in, *ong, *w_out, *wq, *subk, *pu, *pv, *fg;
    float* out;
    unsigned char* ws;
    int ph_lo, ph_hi;
};

__device__ __forceinline__ int otid() { int t = threadIdx.x; asm volatile("" : "+v"(t)); return t; }
__device__ __forceinline__ int obid() { int t = blockIdx.x; asm volatile("" : "+s"(t)); return t; }
__device__ __forceinline__ float wave_sum(float v) {
#pragma unroll
    for (int o = 32; o >= 1; o >>= 1) v += __shfl_xor(v, o);
    return v;
}
__device__ __forceinline__ float wave_max(float v) {
#pragma unroll
    for (int o = 32; o >= 1; o >>= 1) v = fmaxf(v, __shfl_xor(v, o));
    return v;
}
__device__ __forceinline__ unsigned pack_h2(float a, float b) { h2_t r; r.x = (f16)a; r.y = (f16)b; return __builtin_bit_cast(unsigned, r); }
__device__ __forceinline__ float h_lo(unsigned u) { h2_t r = __builtin_bit_cast(h2_t, u); return (float)r.x; }
__device__ __forceinline__ float h_hi(unsigned u) { h2_t r = __builtin_bit_cast(h2_t, u); return (float)r.y; }
__device__ __forceinline__ float dot2(unsigned a, unsigned b, float c) {
    return __builtin_amdgcn_fdot2(__builtin_bit_cast(h2_t, a), __builtin_bit_cast(h2_t, b), c, false);
}

namespace pg8 {
constexpr int BM = 256, BK = 64, HALF = 128, HTB = HALF * BK * 2, STAGE_BYTES = 8 * HTB, NXCD = 8, WGM = 8;
__host__ __device__ __forceinline__ int lds_byte(int r, int c) { const int st = (r >> 4) * 2 + (c >> 5), rr = r & 15, cc = c & 31, ob = rr * 64 + cc * 2; return st * 1024 + (ob ^ (((ob >> 9) & 1) << 5)); }
__host__ __device__ __forceinline__ void stage_rc(int b, int& R, int& C) { const int st = b / 1024, sb = b % 1024, swz = sb ^ (((sb >> 9) & 1) << 5); R = (st >> 1) * 16 + swz / 64; C = (st & 1) * 32 + (swz % 64) / 2; }
struct Unit { int pm, pn; };
struct Gemm { const unsigned short* A; const unsigned short* Bt; int M, N, K; };
struct StaticOrder {
    int nM, nN, nwg, G, c;
    __host__ __device__ void init(int M, int N, int G_, int c_) { nM = M / BM; nN = N / BM; nwg = nM * nN; G = G_; c = c_; }
    __host__ __device__ bool next(int i, Unit& u) const {
        const long L = (long)i * G + c; if (L >= nwg) return false;
        int wgid = (int)L; { const int q = nwg / NXCD, r = nwg % NXCD, xcd = wgid % NXCD, off = wgid / NXCD; wgid = (xcd < r ? xcd * (q + 1) : r * (q + 1) + (xcd - r) * q) + off; }
        const int nig = WGM * nN, gid = wgid / nig, fm = gid * WGM, gsz = (nM - fm) < WGM ? (nM - fm) : WGM;
        u.pm = fm + ((wgid % nig) % gsz); u.pn = (wgid % nig) / gsz; return true;
    }
};

template <class Epi>
__device__ __forceinline__ void gemm_phase(LAS unsigned char* lds, const Gemm g, const StaticOrder& S, const Epi& E) {
    const int tid = otid(), wid = __builtin_amdgcn_readfirstlane(tid >> 6), lane = tid & 63, wr = wid >> 2, wc = wid & 3, fr = lane & 15, fq = lane >> 4;
    const int K = g.K, nt = K / BK;
    unsigned voffA[2], voffB[2];
#pragma unroll
    for (int i = 0; i < 2; ++i) { int R, C; stage_rc(tid * 16 + i * 8192, R, C); voffA[i] = (unsigned)(R * K + C) * 2u; voffB[i] = (unsigned)(R * K + C) * 2u; }
    const size_t kstep = (size_t)(BK * 2);
    const size_t hstep = (size_t)HALF * K * 2;
    const size_t tstep = 2 * hstep;
    const unsigned ldsw = (unsigned)wid * 1024u;
    const int aoff = lds_byte(wr * 64 + fr, fq * 8), boff = lds_byte(wc * 32 + fr, fq * 8);
#define PG8_SA(b, h) (((b) * 2 + (h)) * HTB)
#define PG8_SB(b, h) ((4 + (b) * 2 + (h)) * HTB)
#define PG8_STAGE(bufoff, gbase, voff) do { _Pragma("unroll") for (int _i = 0; _i < 2; ++_i) \
        __builtin_amdgcn_global_load_lds((const unsigned*)((const char*)(gbase) + (voff)[_i]), (LAS unsigned*)(lds + (bufoff) + ldsw + _i * 8192), 16, 0, 0); } while (0)
#define PG8_LDA(dst, b, h) do { _Pragma("unroll") for (int m = 0; m < 4; ++m) _Pragma("unroll") for (int k = 0; k < 2; ++k) dst[m][k] = *(const LAS h8_t*)(lds + PG8_SA(b, h) + aoff + m * 2048 + k * 1024); } while (0)
#define PG8_LDB(dst, b, h) do { _Pragma("unroll") for (int n = 0; n < 2; ++n) _Pragma("unroll") for (int k = 0; k < 2; ++k) dst[n][k] = *(const LAS h8_t*)(lds + PG8_SB(b, h) + boff + n * 2048 + k * 1024); } while (0)
#define PG8_MMA(ai, bj, At, Bt) do { __builtin_amdgcn_s_setprio(1); _Pragma("unroll") for (int m = 0; m < 4; ++m) _Pragma("unroll") for (int n = 0; n < 2; ++n) _Pragma("unroll") for (int k = 0; k < 2; ++k) \
        acc[ai][bj][m][n] = __builtin_amdgcn_mfma_f32_16x16x32_f16(Bt[n][k], At[m][k], acc[ai][bj][m][n], 0, 0, 0); __builtin_amdgcn_s_setprio(0); } while (0)
#define PG8_WAIT_V(n) asm volatile("s_waitcnt vmcnt(" #n ")" ::: "memory")
#define PG8_WAIT_L(n) asm volatile("s_waitcnt lgkmcnt(" #n ")" ::: "memory")
#define PG8_BAR __builtin_amdgcn_s_barrier()
#define PG8_SCHED __builtin_amdgcn_sched_barrier(0)
    Unit cur, nxt; int ui = 0;
    if (!S.next(0, cur)) return;
    f32x4 acc[2][2][4][2];
#pragma unroll
    for (int a = 0; a < 2; ++a)
#pragma unroll
        for (int b = 0; b < 2; ++b)
#pragma unroll
            for (int m = 0; m < 4; ++m)
#pragma unroll
                for (int n = 0; n < 2; ++n) acc[a][b][m][n] = (f32x4){0.f, 0.f, 0.f, 0.f};
    h8_t At[4][2], B0[2][2], B1[2][2];
    const char* cA = (const char*)g.A + (size_t)cur.pm * tstep; const char* cB = (const char*)g.Bt + (size_t)cur.pn * tstep;
    PG8_STAGE(PG8_SB(0, 0), cB, voffB); PG8_STAGE(PG8_SA(0, 0), cA, voffA); PG8_STAGE(PG8_SB(0, 1), cB + hstep, voffB); PG8_STAGE(PG8_SA(0, 1), cA + hstep, voffA);
    if (wr == 1) PG8_BAR;
    PG8_WAIT_V(4); PG8_BAR;
    PG8_STAGE(PG8_SB(1, 0), cB + kstep, voffB); PG8_STAGE(PG8_SA(1, 0), cA + kstep, voffA); PG8_STAGE(PG8_SB(1, 1), cB + hstep + kstep, voffB);
    PG8_WAIT_V(6); PG8_BAR;
    for (;;) {
        const bool has_next = S.next(ui + 1, nxt);
        const char* nA = has_next ? (const char*)g.A + (size_t)nxt.pm * tstep : cA; const char* nB = has_next ? (const char*)g.Bt + (size_t)nxt.pn * tstep : cB;
        for (int t = 0; t < nt; t += 2) {
            const bool last = (t == nt - 2);
            const char* a1 = cA + (size_t)(t + 1) * kstep;
            const char* a2 = last ? nA : cA + (size_t)(t + 2) * kstep; const char* b2 = last ? nB : cB + (size_t)(t + 2) * kstep;
            const char* a3 = a2 + kstep; const char* b3 = b2 + kstep;
            PG8_LDB(B0, 0, 0); PG8_SCHED; PG8_LDA(At, 0, 0); PG8_STAGE(PG8_SA(1, 1), a1 + hstep, voffA);
            PG8_WAIT_L(8); PG8_BAR; PG8_WAIT_L(0); PG8_MMA(0, 0, At, B0); PG8_BAR; PG8_SCHED;
            PG8_LDB(B1, 0, 1); PG8_STAGE(PG8_SB(0, 0), b2, voffB);
            PG8_BAR; PG8_WAIT_L(0); PG8_MMA(0, 1, At, B1); PG8_BAR;
            PG8_LDA(At, 0, 1); PG8_STAGE(PG8_SA(0, 0), a2, voffA);
            PG8_BAR; PG8_WAIT_L(0); PG8_MMA(1, 0, At, B0); PG8_BAR; PG8_SCHED;
            PG8_STAGE(PG8_SB(0, 1), b2 + hstep, voffB);
            PG8_WAIT_V(6); PG8_BAR; PG8_MMA(1, 1, At, B1); PG8_BAR;
            PG8_LDB(B0, 1, 0); PG8_SCHED; PG8_LDA(At, 1, 0); PG8_STAGE(PG8_SA(0, 1), a2 + hstep, voffA);
            PG8_WAIT_L(8); PG8_BAR; PG8_WAIT_L(0); PG8_MMA(0, 0, At, B0); PG8_BAR; PG8_SCHED;
            PG8_LDB(B1, 1, 1); PG8_STAGE(PG8_SB(1, 0), b3, voffB);
            PG8_BAR; PG8_WAIT_L(0); PG8_MMA(0, 1, At, B1); PG8_BAR;
            PG8_LDA(At, 1, 1); PG8_STAGE(PG8_SA(1, 0), a3, voffA);
            PG8_BAR; PG8_WAIT_L(0); PG8_MMA(1, 0, At, B0); PG8_BAR; PG8_SCHED;
            PG8_STAGE(PG8_SB(1, 1), b3 + hstep, voffB);
            PG8_WAIT_V(6); PG8_BAR; PG8_MMA(1, 1, At, B1); PG8_BAR;
        }
        E(acc, cur, wr, wc, fr, fq);
        if (!has_next) break;
#pragma unroll
        for (int a = 0; a < 2; ++a)
#pragma unroll
            for (int b = 0; b < 2; ++b)
#pragma unroll
                for (int m = 0; m < 4; ++m)
#pragma unroll
                    for (int n = 0; n < 2; ++n) acc[a][b][m][n] = (f32x4){0.f, 0.f, 0.f, 0.f};
        cur = nxt; cA = nA; cB = nB; ++ui;
    }
    PG8_WAIT_V(0);
    if (wr == 0) PG8_BAR;
    PG8_BAR;
#undef PG8_SA
#undef PG8_SB
#undef PG8_STAGE
#undef PG8_LDA
#undef PG8_LDB
#undef PG8_MMA
#undef PG8_WAIT_V
#undef PG8_WAIT_L
#undef PG8_BAR
#undef PG8_SCHED
}
}

__device__ __forceinline__ int win_src_col_l(int pc) { return pc < 2128 ? pc : (pc < C_QB ? -1 : (pc < C_END ? pc - 48 : -1)); }
__device__ __forceinline__ int rope_type(int g) { return (g <= 6 || (g >= 32 && g <= 41)) ? 1 : ((g >= 8 && g <= 15) ? 2 : (g == 16 ? 3 : 0)); }
__device__ __forceinline__ int win_src_col(int pc) {
    const int g = pc >> 7, p = pc & 127, ty = rope_type(g);
    int l = p;
    if (ty == 1) { const int q4 = p >> 2, e = p & 3; l = 2 * q4 + (e >> 1) + 64 * (e & 1); }
    else if (ty == 2 || (ty == 3 && p < 64)) { const int hb = p >> 6, pp = p & 63, q4 = pp >> 2, e = pp & 3; l = hb * 64 + 2 * q4 + (e >> 1) + 32 * (e & 1); }
    return win_src_col_l(g * 128 + l);
}


struct Epi {
    int mode; f16* o16; int ldc; float* o32; const float* xin; const float* gate; const float* rope128; const float* rope64;
    __device__ __forceinline__ void operator()(const f32x4 (&acc)[2][2][4][2], const pg8::Unit& u, int wr, int wc, int fr, int fq) const {
        const int row0 = u.pm * 256 + wr * 64 + fr, col0 = u.pn * 256 + wc * 32 + 4 * fq;
        if (mode == 2) {
#pragma unroll
            for (int bj = 0; bj < 2; ++bj) {
                const int g = __builtin_amdgcn_readfirstlane(u.pn * 2 + bj);
                int ty = rope_type(g); if (ty == 3) ty = (wc < 2) ? 2 : 0;
                f16* ob = o16 + (size_t)g * 128;
                if (ty == 0) {
#pragma unroll
                    for (int ai = 0; ai < 2; ++ai)
#pragma unroll
                        for (int m = 0; m < 4; ++m)
#pragma unroll
                            for (int n = 0; n < 2; ++n) {
                                const f32x4 v = acc[ai][bj][m][n];
                                u32x2 w; w.x = pack_h2(v[0], v[1]); w.y = pack_h2(v[2], v[3]);
                                *(u32x2*)(ob + (size_t)(row0 + ai * 128 + m * 16) * ldc + wc * 32 + n * 16 + 4 * fq) = w;
                            }
                } else {
                    const float* tab = ty == 1 ? rope128 : rope64;
                    const int half = ty == 1 ? 64 : 32, tw = ty == 1 ? 128 : 64;
#pragma unroll
                    for (int ai = 0; ai < 2; ++ai)
#pragma unroll
                        for (int m = 0; m < 4; ++m) {
                            const int row = row0 + ai * 128 + m * 16, pos = row & (SEQ - 1);
#pragma unroll
                            for (int n = 0; n < 2; ++n) {
                                const int p = wc * 32 + n * 16 + 4 * fq;
                                const int j = ty == 1 ? (p >> 1) : ((p & 63) >> 1), base = ty == 1 ? 0 : (p & 64);
                                const f32x4 cs = *(const f32x4*)(tab + (size_t)pos * tw + 2 * j);
                                const f32x4 v = acc[ai][bj][m][n];
                                const float o1a = v[0] * cs[0] - v[1] * cs[1], o2a = v[1] * cs[0] + v[0] * cs[1];
                                const float o1b = v[2] * cs[2] - v[3] * cs[3], o2b = v[3] * cs[2] + v[2] * cs[3];
                                f16* op = ob + (size_t)row * ldc + base + j;
                                *(unsigned*)op = pack_h2(o1a, o1b); *(unsigned*)(op + half) = pack_h2(o2a, o2b);
                            }
                        }
                }
            }
            return;
        }
#pragma unroll
        for (int ai = 0; ai < 2; ++ai)
#pragma unroll
            for (int m = 0; m < 4; ++m) {
                const int row = row0 + ai * 128 + m * 16;
#pragma unroll
                for (int bj = 0; bj < 2; ++bj)
#pragma unroll
                    for (int n = 0; n < 2; ++n) {
                        const int col = col0 + bj * 128 + n * 16;
                        const f32x4 v = acc[ai][bj][m][n];
                        if (mode == 0) {
                            u32x2 w; w.x = pack_h2(v[0], v[1]); w.y = pack_h2(v[2], v[3]);
                            *(u32x2*)(o16 + (size_t)row * ldc + col) = w;
                        } else {
                            const int b = row / SEQ;
                            const f32x4 xi = *(const f32x4*)(xin + (size_t)row * DM + col);
                            const f32x4 gt = *(const f32x4*)(gate + (size_t)b * 6 * DM + col);
                            *(f32x4*)(o32 + (size_t)row * DM + col) = xi + gt * v;
                        }
                    }
            }
    }
};

__device__ __forceinline__ void gemm_run(const Params& p, LAS unsigned char* lds, const f16* A, const f16* Bt, int N, const Epi& E) {
    pg8::Gemm g; g.A = (const unsigned short*)A; g.Bt = (const unsigned short*)Bt; g.M = NT; g.N = N; g.K = DM;
    pg8::StaticOrder S; S.init(NT, N, (int)gridDim.x, (int)blockIdx.x);
    pg8::gemm_phase<Epi>(lds, g, S, E);
}

__device__ __forceinline__ void transpose_tiles(const float* src, int ldsrc, int ncols_phys, bool is_win, f16* dst, float* tile  , int& unit_base, int unit_lo) {
    const int tn = ncols_phys / 64, tk = DM / 64, ntile = tn * tk;
    const int tid = otid();
    for (int u = blockIdx.x; u < ntile; u += gridDim.x) {
        const int n0 = (u % tn) * 64, k0 = (u / tn) * 64;
        __syncthreads();
#pragma unroll
        for (int i = 0; i < 8; ++i) {
            const int e = tid + i * 512, r = e >> 6, c = e & 63;
            const int pc = n0 + c; const int sc = is_win ? win_src_col(pc) : pc;
            tile[r * 65 + c] = sc >= 0 ? src[(size_t)(k0 + r) * ldsrc + sc] : 0.f;
        }
        __syncthreads();
        {
            const int n = tid >> 3, kq = (tid & 7) * 8;
            u32x4 w;
            w.x = pack_h2(tile[(kq + 0) * 65 + n], tile[(kq + 1) * 65 + n]); w.y = pack_h2(tile[(kq + 2) * 65 + n], tile[(kq + 3) * 65 + n]);
            w.z = pack_h2(tile[(kq + 4) * 65 + n], tile[(kq + 5) * 65 + n]); w.w = pack_h2(tile[(kq + 6) * 65 + n], tile[(kq + 7) * 65 + n]);
            *(u32x4*)(dst + (size_t)(n0 + n) * DM + k0 + kq) = w;
        }
    }
    (void)unit_base; (void)unit_lo;
}

__device__ __forceinline__ void cvt_f16_stream(const float* src, f16* dst, size_t n) {
    const size_t stride = (size_t)gridDim.x * NTHREADS;
    for (size_t i = (size_t)blockIdx.x * NTHREADS + otid(); i < n / 8; i += stride) {
        const f32x4 a = *(const f32x4*)(src + i * 8), b = *(const f32x4*)(src + i * 8 + 4);
        u32x4 w; w.x = pack_h2(a[0], a[1]); w.y = pack_h2(a[2], a[3]); w.z = pack_h2(b[0], b[1]); w.w = pack_h2(b[2], b[3]);
        *(u32x4*)(dst + i * 8) = w;
    }
}

__device__ __forceinline__ void quant_rows(const float* src, int nrows, unsigned* dst, float* scale, int bias) {
    const int tid_ = otid(); const int wid = tid_ >> 6, lane = tid_ & 63;
    for (int row = blockIdx.x * NWAVES + wid; row < nrows; row += gridDim.x * NWAVES) {
        const float* xr = src + (size_t)row * DM;
        f32x4 v[8]; float am = 0.f;
#pragma unroll
        for (int i = 0; i < 8; ++i) { v[i] = *(const f32x4*)(xr + i * 256 + lane * 4); am = fmaxf(am, fmaxf(fmaxf(fabsf(v[i][0]), fabsf(v[i][1])), fmaxf(fabsf(v[i][2]), fabsf(v[i][3])))); }
        am = wave_max(am);
        const float sc = am > 0.f ? am * (1.f / 127.f) : 1.f, inv = 1.f / sc;
        if (lane == 0) scale[row] = sc;
#pragma unroll
        for (int i = 0; i < 8; ++i) {
            unsigned w = 0u;
#pragma unroll
            for (int j = 0; j < 4; ++j) { const int q = (int)rintf(v[i][j] * inv) + bias; w |= ((unsigned)q & 255u) << (8 * j); }
            dst[(size_t)row * (DM / 4) + i * 64 + lane] = w;
        }
    }
}

constexpr int QV_STR = DM + 8;
__device__ __forceinline__ void quant_v_sliced(const float* src, unsigned char* dst, float* scale, LAS unsigned char* lds) {
    const int tid = otid(), wid = tid >> 6, lane = tid & 63;
    for (int blk = obid(); blk < DEPTH * PEXP / 64; blk += gridDim.x) {
        const int row0 = blk * 64, layer = row0 / PEXP, e0 = row0 % PEXP;
        __syncthreads();
        for (int rr = wid; rr < 64; rr += NWAVES) {
            const float* xr = src + (size_t)(row0 + rr) * DM;
            f32x4 v[8]; float am = 0.f;
#pragma unroll
            for (int i = 0; i < 8; ++i) { v[i] = *(const f32x4*)(xr + i * 256 + lane * 4); am = fmaxf(am, fmaxf(fmaxf(fabsf(v[i][0]), fabsf(v[i][1])), fmaxf(fabsf(v[i][2]), fabsf(v[i][3])))); }
            am = wave_max(am);
            const float sc = am > 0.f ? am * (1.f / 127.f) : 1.f, inv = 1.f / sc;
            if (lane == 0) scale[row0 + rr] = sc;
#pragma unroll
            for (int i = 0; i < 8; ++i) {
                unsigned w = 0u;
#pragma unroll
                for (int j = 0; j < 4; ++j) { const int q = (int)rintf(v[i][j] * inv) + 128; w |= ((unsigned)q & 255u) << (8 * j); }
                *(LAS unsigned*)(lds + rr * QV_STR + i * 256 + lane * 4) = w;
            }
        }
        __syncthreads();
        for (int c = wid; c < 256; c += NWAVES) {
            const u32x2 w = *(const LAS u32x2*)(lds + lane * QV_STR + c * 8);
            *(u32x2*)(dst + (((size_t)layer * 256 + c) * PEXP + e0 + lane) * 8) = w;
        }
    }
}

__device__ __forceinline__ void phase_conv(const Params& p, LAS unsigned char* lds_) {
    float* smem = (float*)(unsigned char*)lds_;
    unsigned char* ws = p.ws;
    const int tid = otid();
    int dummy = 0;
    {
        float* cond = smem;
        float* red = smem + NB * DM;
        for (int i = tid; i < NB * DM; i += NTHREADS) { const float v = p.c[i]; cond[i] = v / (1.f + __expf(-v)); }
        __syncthreads();
        for (int u = blockIdx.x; u < DEPTH * 128; u += gridDim.x) {
            const int l = u >> 7, j0 = (u & 127) * 96;
            const int col = tid % 96, kg = tid / 96;
            float acc[NB];
#pragma unroll
            for (int b = 0; b < NB; ++b) acc[b] = 0.f;
            if (kg < 5) {
                const float* wp = p.ada_w + (size_t)l * DM * 6 * DM + j0 + col;
                for (int k = kg; k < DM; k += 5) {
                    const float w = wp[(size_t)k * 6 * DM];
#pragma unroll
                    for (int b = 0; b < NB; ++b) acc[b] += cond[b * DM + k] * w;
                }
#pragma unroll
                for (int b = 0; b < NB; ++b) red[(kg * NB + b) * 96 + col] = acc[b];
            }
            __syncthreads();
            for (int i = tid; i < NB * 96; i += NTHREADS) {
                const int b = i / 96, cc = i % 96;
                float s = p.ada_b[(size_t)l * 6 * DM + j0 + cc];
#pragma unroll
                for (int g = 0; g < 5; ++g) s += red[(g * NB + b) * 96 + cc];
                ((float*)(ws + WS_MOD))[((size_t)l * NB + b) * 6 * DM + j0 + cc] = s;
            }
            __syncthreads();
        }
    }
    {
        float2* r128 = (float2*)(ws + WS_ROPE128); float2* r64 = (float2*)(ws + WS_ROPE64);
        for (int i = blockIdx.x * NTHREADS + tid; i < SEQ * 64; i += gridDim.x * NTHREADS) {
            const int pos = i >> 6, j = i & 63;
            const float inv = powf(10000.f, -(float)j / 64.f); const float ang = (float)pos * inv;
            r128[i] = make_float2((float)cos((double)ang), (float)sin((double)ang));
        }
        for (int i = blockIdx.x * NTHREADS + tid; i < SEQ * 32; i += gridDim.x * NTHREADS) {
            const int pos = i >> 5, j = i & 31;
            const float inv = powf(10000.f, -(float)j / 32.f); const float ang = (float)pos * inv;
            r64[i] = make_float2((float)cos((double)ang), (float)sin((double)ang));
        }
    }
    __syncthreads();
    for (int l = 0; l < DEPTH; ++l) {
        transpose_tiles(p.w_in + (size_t)l * DM * INW, INW, INWP, true, (f16*)(ws + WS_WTIN) + (size_t)l * INWP * DM, smem, dummy, 0);
        transpose_tiles(p.w_out + (size_t)l * DM * DM, DM, DM, false, (f16*)(ws + WS_WTOUT) + (size_t)l * DM * DM, smem, dummy, 0);
        transpose_tiles(p.wq + (size_t)l * DM * DM, DM, DM, false, (f16*)(ws + WS_WTQ) + (size_t)l * DM * DM, smem, dummy, 0);
    }
    quant_rows(p.pu, DEPTH * PEXP, (unsigned*)(ws + WS_U8), (float*)(ws + WS_SU), 0);
    quant_v_sliced(p.pv, ws + WS_V8, (float*)(ws + WS_SV), lds_);
    cvt_f16_stream(p.subk, (f16*)(ws + WS_SUBK), (size_t)DEPTH * PH * 2 * PNK * 128);
}

__device__ __forceinline__ void phase_norm(const Params& p, const float* xin, const float* g, const float* shift, const float* scale, f16* hout, unsigned* h8 = nullptr, float* sh8 = nullptr) {
    const int tid_ = otid(); const int wid = tid_ >> 6, lane = tid_ & 63;
    for (int row = blockIdx.x * NWAVES + wid; row < NT; row += gridDim.x * NWAVES) {
        const int b = row / SEQ;
        const float* xr = xin + (size_t)row * DM;
        f32x4 v[8]; float ss = 0.f;
#pragma unroll
        for (int i = 0; i < 8; ++i) { v[i] = *(const f32x4*)(xr + i * 256 + lane * 4); ss += v[i][0] * v[i][0] + v[i][1] * v[i][1] + v[i][2] * v[i][2] + v[i][3] * v[i][3]; }
        ss = wave_sum(ss);
        const float rstd = rsqrtf(ss * (1.f / DM) + EPS);
#pragma unroll
        for (int i = 0; i < 8; ++i) {
            const int col = i * 256 + lane * 4;
            const f32x4 gg = *(const f32x4*)(g + col), sh = *(const f32x4*)(shift + (size_t)b * 6 * DM + col), sc = *(const f32x4*)(scale + (size_t)b * 6 * DM + col);
            f32x4 y = v[i] * rstd * gg * (sc + 1.f) + sh;
            u32x2 w; w.x = pack_h2(y[0], y[1]); w.y = pack_h2(y[2], y[3]);
            *(u32x2*)(hout + (size_t)row * DM + col) = w;
            v[i] = y;
        }
        if (h8) {
            float am = 0.f;
#pragma unroll
            for (int i = 0; i < 8; ++i) am = fmaxf(am, fmaxf(fmaxf(fabsf(v[i][0]), fabsf(v[i][1])), fmaxf(fabsf(v[i][2]), fabsf(v[i][3]))));
            am = wave_max(am);
            const float qs = am > 0.f ? am * (1.f / 127.f) : 1.f, inv = 1.f / qs;
            if (lane == 0) sh8[row] = qs;
#pragma unroll
            for (int i = 0; i < 8; ++i) {
                unsigned w = 0u;
#pragma unroll
                for (int j = 0; j < 4; ++j) { const int q = (int)rintf(v[i][j] * inv); w |= ((unsigned)q & 255u) << (8 * j); }
                h8[(size_t)row * (DM / 4) + i * 64 + lane] = w;
            }
        }
    }
}

template <int MODE>
__device__ __forceinline__ void phase_norm2(const float* xin, float* xio, const float* g, const float* shift, const float* scale, f16* hout, unsigned* h8, float* sh8) {
    const int tid_ = otid(); const int wid = tid_ >> 6, lane = tid_ & 63;
    for (int r0 = (blockIdx.x * NWAVES + wid) * 8; r0 < NT; r0 += gridDim.x * NWAVES * 8) {
        const int b = r0 / SEQ;
        f32x4 gm[8], sh[8];
#pragma unroll
        for (int i = 0; i < 8; ++i) {
            const int col = i * 256 + lane * 4;
            gm[i] = *(const f32x4*)(g + col);
            if (MODE != 2) { gm[i] = gm[i] * (*(const f32x4*)(scale + (size_t)b * 6 * DM + col) + 1.f); sh[i] = *(const f32x4*)(shift + (size_t)b * 6 * DM + col); }
        }
        const float* xb = (MODE == 2 ? (const float*)xio : xin) + (size_t)r0 * DM + lane * 4;
        f32x4 v[8], nv[8];
#pragma unroll
        for (int i = 0; i < 8; ++i) nv[i] = *(const f32x4*)(xb + i * 256);
#pragma unroll 1
        for (int k = 0; k < 8; ++k) {
            const int row = r0 + k;
#pragma unroll
            for (int i = 0; i < 8; ++i) v[i] = nv[i];
            if (k < 7) {
#pragma unroll
                for (int i = 0; i < 8; ++i) nv[i] = *(const f32x4*)(xb + (size_t)(k + 1) * DM + i * 256);
            }
            float ss = 0.f;
#pragma unroll
            for (int i = 0; i < 8; ++i) ss += v[i][0] * v[i][0] + v[i][1] * v[i][1] + v[i][2] * v[i][2] + v[i][3] * v[i][3];
            ss = wave_sum(ss);
            const float rstd = rsqrtf(ss * (1.f / DM) + EPS);
            float am = 0.f;
#pragma unroll
            for (int i = 0; i < 8; ++i) {
                const int col = i * 256 + lane * 4;
                if (MODE == 2) { *(f32x4*)(xio + (size_t)row * DM + col) = v[i] * rstd * gm[i]; }
                else {
                    const f32x4 y = v[i] * rstd * gm[i] + sh[i];
                    u32x2 w; w.x = pack_h2(y[0], y[1]); w.y = pack_h2(y[2], y[3]);
                    *(u32x2*)(hout + (size_t)row * DM + col) = w;
                    if (MODE == 1) { v[i] = y; am = fmaxf(am, fmaxf(fmaxf(fabsf(y[0]), fabsf(y[1])), fmaxf(fabsf(y[2]), fabsf(y[3])))); }
                }
            }
            if (MODE == 1) {
                am = wave_max(am);
                const float qs = am > 0.f ? am * (1.f / 127.f) : 1.f, inv = 1.f / qs;
                if (lane == 0) sh8[row] = qs;
#pragma unroll
                for (int i = 0; i < 8; ++i) {
                    unsigned w = 0u;
#pragma unroll
                    for (int j = 0; j < 4; ++j) { const int q = (int)rintf(v[i][j] * inv); w |= ((unsigned)q & 255u) << (8 * j); }
                    h8[(size_t)row * (DM / 4) + i * 64 + lane] = w;
                }
            }
        }
    }
}

__device__ __forceinline__ void phase_rope(const Params& p) {
    f16* proj = (f16*)(p.ws + WS_PROJ);
    const float2* r128 = (const float2*)(p.ws + WS_ROPE128); const float2* r64 = (const float2*)(p.ws + WS_ROPE64);
    constexpr int PER_TOK = (1088 + 544) / 2;
    const size_t total = (size_t)NT * PER_TOK;
    for (size_t i = (size_t)blockIdx.x * NTHREADS + otid(); i < total; i += (size_t)gridDim.x * NTHREADS) {
        const int t = (int)(i / PER_TOK); int r = (int)(i % PER_TOK) * 2;
        const int pos = t % SEQ;
        int base, half, j;
        if (r < 1088) {
            const int hh = r >> 6; j = r & 63; half = 64;
            base = hh < 6 ? C_QA + hh * 128 : (hh == 6 ? C_KA : (hh < 12 ? C_QC + (hh - 7) * 128 : C_KC + (hh - 12) * 128));
        } else {
            r -= 1088; const int hh = r >> 5; j = r & 31; half = 32;
            base = hh < 16 ? C_IQ + hh * 64 : C_IK;
        }
        f16* pp = proj + (size_t)t * INWP + base + j;
        const h2_t a = *(const h2_t*)pp, bq = *(const h2_t*)(pp + half);
        float2 cs0, cs1;
        if (half == 64) { cs0 = r128[pos * 64 + j]; cs1 = r128[pos * 64 + j + 1]; } else { cs0 = r64[pos * 32 + j]; cs1 = r64[pos * 32 + j + 1]; }
        const float a0 = (float)a.x, a1 = (float)a.y, b0 = (float)bq.x, b1 = (float)bq.y;
        h2_t oa, ob;
        oa.x = (f16)(a0 * cs0.x - b0 * cs0.y); oa.y = (f16)(a1 * cs1.x - b1 * cs1.y);
        ob.x = (f16)(b0 * cs0.x + a0 * cs0.y); ob.y = (f16)(b1 * cs1.x + a1 * cs1.y);
        *(h2_t*)pp = oa; *(h2_t*)(pp + half) = ob;
    }
}

__device__ __forceinline__ void phase_index(const Params& p, LAS unsigned char* lds_) {
    const f16* proj = (const f16*)(p.ws + WS_PROJ);
    float* smem = (float*)(unsigned char*)lds_;
    const int tid = otid(), wid = tid >> 6, lane = tid & 63;
    {
        float* red = smem;
        float* km = (float*)(p.ws + WS_KMEAN);
        for (int u = blockIdx.x; u < NB * HC * MOBA_NB; u += gridDim.x) {
            const int blk = u % MOBA_NB, h = (u / MOBA_NB) % HC, b = u / (MOBA_NB * HC);
            const int d = tid & 127, part = tid >> 7;
            float s = 0.f;
            const f16* kp = proj + ((size_t)b * SEQ + blk * MOBA_BLK + part * 64) * INWP + C_KC + h * HD + d;
            for (int k = 0; k < 64; ++k) s += (float)kp[(size_t)k * INWP];
            __syncthreads();
            red[part * 128 + d] = s;
            __syncthreads();
            if (tid < 128) km[(size_t)u * HD + tid] = (red[tid] + red[128 + tid] + red[256 + tid] + red[384 + tid]) * (1.f / MOBA_BLK);
        }
        __syncthreads();
    }
    float* wq_ = smem + wid * (IH * IDM + IH);
    float* sc = smem + NWAVES * (IH * IDM + IH) + wid * SEQ;
    unsigned* mask = (unsigned*)(p.ws + WS_MASK);
    for (int q = blockIdx.x * NWAVES + wid; q < NT; q += gridDim.x * NWAVES) {
        const int b = q / SEQ, t = q % SEQ;
        const f16* row = proj + (size_t)q * INWP;
        for (int i = lane; i < IH * IDM; i += 64) wq_[i] = (float)row[C_IQ + i];
        if (lane < IH) wq_[IH * IDM + lane] = (float)row[C_IW + lane] * 0.25f;
        __builtin_amdgcn_wave_barrier();
        const int nk = t + 1;
        for (int s = lane; s < nk; s += 64) {
            const f16* kr = proj + ((size_t)b * SEQ + s) * INWP + C_IK;
            float kf[IDM];
#pragma unroll
            for (int e8 = 0; e8 < IDM / 8; ++e8) { const h8_t kv = *(const h8_t*)(kr + e8 * 8);
#pragma unroll
                for (int j = 0; j < 8; ++j) kf[e8 * 8 + j] = (float)kv[j]; }
            float score = 0.f;
            for (int h = 0; h < IH; ++h) {
                float d = 0.f;
#pragma unroll
                for (int e = 0; e < IDM; ++e) d += wq_[h * IDM + e] * kf[e];
                score += wq_[IH * IDM + h] * fmaxf(d * 0.125f, 0.f);
            }
            sc[s] = score;
        }
        __builtin_amdgcn_wave_barrier();
        unsigned key[32];
#pragma unroll
        for (int i = 0; i < 32; ++i) {
            const int s = lane + 64 * i;
            unsigned u = 0u;
            if (s < nk) { const unsigned bits = __float_as_uint(sc[s]); u = (bits & 0x80000000u) ? ~bits : (bits | 0x80000000u); if (u == 0u) u = 1u; }
            key[i] = u;
        }
        unsigned thr = 1u;
        if (nk > DSA_TOPK) {
            thr = 0u;
            for (int bit = 31; bit >= 0; --bit) {
                const unsigned cand = thr | (1u << bit);
                int cnt = 0;
#pragma unroll
                for (int i = 0; i < 32; ++i) cnt += __builtin_popcountll(__ballot(key[i] >= cand));
                if (cnt >= DSA_TOPK) thr = cand;
            }
        }
        unsigned* mrow = mask + (size_t)q * 64;
#pragma unroll
        for (int i = 0; i < 32; ++i) {
            const unsigned long long bal = __ballot(key[i] >= thr && key[i] != 0u);
            if (lane == 0) { mrow[2 * i] = (unsigned)bal; mrow[2 * i + 1] = (unsigned)(bal >> 32); }
        }
        __builtin_amdgcn_wave_barrier();
    }
}

constexpr int IX_ROW = SEQ + 4;
__device__ __forceinline__ void index_item(const Params& p, LAS unsigned char* lds, int b, int qg) {
    const f16* proj = (const f16*)(p.ws + WS_PROJ);
    LAS float* sc = (LAS float*)lds;
    const int tid = otid(), wid = __builtin_amdgcn_readfirstlane(tid >> 6), lane = tid & 63, fr = lane & 15, fq = lane >> 4;
    const int t0 = qg * 16, nkt = qg + 1;
    h8_t Bq[IH][2]; float wq[IH];
    {
        const f16* qrow = proj + ((size_t)b * SEQ + t0 + fr) * INWP;
#pragma unroll
        for (int h = 0; h < IH; ++h) {
            Bq[h][0] = *(const h8_t*)(qrow + C_IQ + h * IDM + 8 * fq);
            Bq[h][1] = *(const h8_t*)(qrow + C_IQ + h * IDM + 32 + 8 * fq);
        }
        const h8_t w0 = *(const h8_t*)(qrow + C_IW), w1 = *(const h8_t*)(qrow + C_IW + 8);
#pragma unroll
        for (int h = 0; h < 8; ++h) { wq[h] = (float)w0[h] * (0.25f * 0.125f); wq[8 + h] = (float)w1[h] * (0.25f * 0.125f); }
    }
    __syncthreads();
    const f16* kbase = proj + ((size_t)b * SEQ + fr) * INWP + C_IK + 8 * fq;
    h8_t a0, a1, n0, n1;
    int kt = wid;
    if (kt < nkt) { a0 = *(const h8_t*)(kbase + (size_t)kt * 16 * INWP); a1 = *(const h8_t*)(kbase + (size_t)kt * 16 * INWP + 32); }
    for (; kt < nkt; kt += NWAVES) {
        const int ktn = kt + NWAVES;
        if (ktn < nkt) { n0 = *(const h8_t*)(kbase + (size_t)ktn * 16 * INWP); n1 = *(const h8_t*)(kbase + (size_t)ktn * 16 * INWP + 32); }
        f32x4 acc = {0.f, 0.f, 0.f, 0.f};
#pragma unroll
        for (int h = 0; h < IH; ++h) {
            f32x4 c = {0.f, 0.f, 0.f, 0.f};
            c = __builtin_amdgcn_mfma_f32_16x16x32_f16(a0, Bq[h][0], c, 0, 0, 0);
            c = __builtin_amdgcn_mfma_f32_16x16x32_f16(a1, Bq[h][1], c, 0, 0, 0);
#pragma unroll
            for (int j = 0; j < 4; ++j) acc[j] += wq[h] * fmaxf(c[j], 0.f);
        }
        *(LAS f32x4*)(sc + fr * IX_ROW + kt * 16 + 4 * fq) = acc;
        a0 = n0; a1 = n1;
    }
    __syncthreads();
    unsigned* mask = (unsigned*)(p.ws + WS_MASK);
#pragma unroll 1
    for (int qq = 0; qq < 2; ++qq) {
        const int ql = 2 * wid + qq, t = t0 + ql, nk = t + 1;
        unsigned key[32];
#pragma unroll
        for (int i = 0; i < 32; ++i) {
            const int s = lane + 64 * i;
            unsigned u = 0u;
            if (s < nk) { const unsigned bits = __float_as_uint(sc[ql * IX_ROW + s]); u = (bits & 0x80000000u) ? ~bits : (bits | 0x80000000u); if (u == 0u) u = 1u; }
            key[i] = u;
        }
        unsigned thr = 1u;
        if (nk > DSA_TOPK) {
            thr = 0u;
            const int nreg8 = (nk + 511) >> 9;
            for (int bit = 31; bit >= 0; --bit) {
                const unsigned cand = thr | (1u << bit);
                int cnt = 0;
#pragma unroll
                for (int i8 = 0; i8 < 4; ++i8) {
                    if (i8 < nreg8) {
#pragma unroll
                        for (int i = 0; i < 8; ++i) cnt += __builtin_popcountll(__ballot(key[8 * i8 + i] >= cand));
                    }
                }
                if (cnt >= DSA_TOPK) { thr = cand; if (cnt == DSA_TOPK) break; }
            }
        }
        unsigned* mrow = mask + ((size_t)b * SEQ + t) * 64;
        unsigned myw = 0u;
#pragma unroll
        for (int i = 0; i < 32; ++i) {
            const unsigned long long bal = __ballot(key[i] >= thr && key[i] != 0u);
            if (lane == 2 * i) myw = (unsigned)bal;
            if (lane == 2 * i + 1) myw = (unsigned)(bal >> 32);
        }
        mrow[lane] = myw;
    }
}

__device__ __forceinline__ void phase_index2(const Params& p, LAS unsigned char* lds_) {
    const f16* proj = (const f16*)(p.ws + WS_PROJ);
    float* smem = (float*)(unsigned char*)lds_;
    const int tid = otid();
    {
        float* red = smem;
        float* km = (float*)(p.ws + WS_KMEAN);
        for (int u = obid(); u < NB * HC * MOBA_NB; u += gridDim.x) {
            const int blk = u % MOBA_NB, h = (u / MOBA_NB) % HC, b = u / (MOBA_NB * HC);
            const int d = tid & 127, part = tid >> 7;
            float s = 0.f;
            const f16* kp = proj + ((size_t)b * SEQ + blk * MOBA_BLK + part * 64) * INWP + C_KC + h * HD + d;
            for (int k = 0; k < 64; ++k) s += (float)kp[(size_t)k * INWP];
            __syncthreads();
            red[part * 128 + d] = s;
            __syncthreads();
            if (tid < 128) km[(size_t)u * HD + tid] = (red[tid] + red[128 + tid] + red[256 + tid] + red[384 + tid]) * (1.f / MOBA_BLK);
        }
        __syncthreads();
    }
    for (int pi = obid(); pi < NB * 64; pi += gridDim.x) {
        const int b = pi >> 6, a = pi & 63;
        index_item(p, lds_, b, 127 - a);
        index_item(p, lds_, b, a);
    }
}

__device__ __forceinline__ void phase_attn(const Params& p, LAS unsigned char* lds_, const float* ong) {
    const f16* proj = (const f16*)(p.ws + WS_PROJ);
    float* smem = (float*)(unsigned char*)lds_;
    const int tid = otid(), wid = tid >> 6, lane = tid & 63;
    float* pbuf = smem + wid * SEQ;
    const float* km = (const float*)(p.ws + WS_KMEAN);
    const unsigned* mask = (const unsigned*)(p.ws + WS_MASK);
    f16* y = (f16*)(p.ws + WS_Y);
    const float scale = 0.08838834764831845f;
    const size_t nitems = (size_t)NT * NHEADS;
    for (size_t it = (size_t)blockIdx.x * NWAVES + wid; it < nitems; it += (size_t)gridDim.x * NWAVES) {
        const int hh = (int)(it % NHEADS); const int q = (int)(it / NHEADS);
        const int b = q / SEQ, t = q % SEQ;
        int qc, kc, vc, var;
        if (hh < HA) { var = 0; qc = C_QA + hh * HD; kc = C_KA; vc = C_VA; }
        else if (hh < HA + HB) { var = 1; qc = C_QB + (hh - HA) * HD; kc = C_KB + (hh - HA) * HD; vc = C_VB + (hh - HA) * HD; }
        else { var = 2; qc = C_QC + (hh - HA - HB) * HD; kc = C_KC + (hh - HA - HB) * HD; vc = C_VC + (hh - HA - HB) * HD; }
        unsigned qv[64];
        { const u32x4* qp = (const u32x4*)(proj + (size_t)q * INWP + qc);
#pragma unroll
          for (int i = 0; i < 16; ++i) { const u32x4 w = qp[i]; qv[4 * i] = w.x; qv[4 * i + 1] = w.y; qv[4 * i + 2] = w.z; qv[4 * i + 3] = w.w; } }
        unsigned allowed = 0xffu;
        const int own = t / MOBA_BLK;
        if (var == 2) {
            float g = -INFINITY;
            if (lane < own) {
                const float* kmp = km + (((size_t)b * HC + (hh - HA - HB)) * MOBA_NB + lane) * HD;
                float s = 0.f;
#pragma unroll
                for (int i = 0; i < 64; ++i) s += h_lo(qv[i]) * kmp[2 * i] + h_hi(qv[i]) * kmp[2 * i + 1];
                g = s;
            }
            float gs[MOBA_NB];
#pragma unroll
            for (int j = 0; j < MOBA_NB; ++j) gs[j] = __shfl(g, j);
            allowed = 1u << own;
#pragma unroll
            for (int j = 0; j < MOBA_NB; ++j) {
                if (j < own) {
                    int rank = 0;
#pragma unroll
                    for (int k2 = 0; k2 < MOBA_NB; ++k2) if (k2 < own && (gs[k2] > gs[j] || (gs[k2] == gs[j] && k2 < j))) ++rank;
                    if (rank < 3) allowed |= 1u << j;
                }
            }
        }
        const int nk = t + 1;
        const int nkl = (nk + 63) >> 6;
        const unsigned* mrow = mask + (size_t)q * 64;
        float z[32];
#pragma unroll
        for (int i = 0; i < 32; ++i) {
            z[i] = -INFINITY;
            if (i < nkl) {
                const int s = nkl * lane + i;
                if (s < nk) {
                    bool ok = true;
                    if (var == 0) ok = (mrow[s >> 5] >> (s & 31)) & 1u;
                    if (var == 2) ok = (allowed >> (s / MOBA_BLK)) & 1u;
                    if (var == 1) ok = s < t;
                    if (ok) {
                        const u32x4* kp = (const u32x4*)(proj + ((size_t)b * SEQ + s) * INWP + kc);
                        float d = 0.f;
#pragma unroll
                        for (int c4 = 0; c4 < 16; ++c4) { const u32x4 w = kp[c4]; d = dot2(qv[4 * c4], w.x, d); d = dot2(qv[4 * c4 + 1], w.y, d); d = dot2(qv[4 * c4 + 2], w.z, d); d = dot2(qv[4 * c4 + 3], w.w, d); }
                        z[i] = d * scale;
                    }
                }
            }
        }
        float inv_l = 1.f;
        if (var != 1) {
            float m = -INFINITY;
#pragma unroll
            for (int i = 0; i < 32; ++i) m = fmaxf(m, z[i]);
            m = wave_max(m);
            float l = 0.f;
#pragma unroll
            for (int i = 0; i < 32; ++i) { const float e = (z[i] == -INFINITY) ? 0.f : __expf(z[i] - m); z[i] = e; l += e; }
            l = wave_sum(l);
            inv_l = 1.f / l;
        } else {
            float lk[32]; float tot = 0.f;
#pragma unroll
            for (int i = 31; i >= 0; --i) {
                float v = 0.f;
                if (z[i] != -INFINITY) { const float zz = z[i]; v = -(fmaxf(zz, 0.f) + log1pf(__expf(-fabsf(zz)))); }
                tot += v; lk[i] = tot;
            }
            float incl = tot;
#pragma unroll
            for (int o = 1; o < 64; o <<= 1) { const float v = __shfl_down(incl, o); if (lane + o < 64) incl += v; }
            const float excl = incl - tot;
#pragma unroll
            for (int i = 0; i < 32; ++i) z[i] = (z[i] == -INFINITY) ? 0.f : __expf(z[i] + lk[i] + excl);
        }
#pragma unroll
        for (int i = 0; i < 32; ++i) if (i < nkl) { const int s = nkl * lane + i; if (s < SEQ) pbuf[s] = z[i]; }
        __builtin_amdgcn_wave_barrier();
        float o0 = 0.f, o1 = 0.f;
        const f16* vp = proj + (size_t)b * SEQ * INWP + vc + 2 * lane;
        for (int s0 = 0; s0 < nk; s0 += 8) {
            float pr[8]; bool any = false;
#pragma unroll
            for (int j = 0; j < 8; ++j) { pr[j] = pbuf[s0 + j]; any = any || (pr[j] != 0.f); }
            if (any) {
                unsigned w[8];
#pragma unroll
                for (int j = 0; j < 8; ++j) w[j] = *(const unsigned*)(vp + (size_t)(s0 + j) * INWP);
#pragma unroll
                for (int j = 0; j < 8; ++j) { o0 += pr[j] * h_lo(w[j]); o1 += pr[j] * h_hi(w[j]); }
            }
        }
        o0 *= inv_l; o1 *= inv_l;
        const float ss = wave_sum(o0 * o0 + o1 * o1);
        const float rstd = rsqrtf(ss * (1.f / HD) + EPS);
        const float g0 = ong[hh * HD + 2 * lane], g1 = ong[hh * HD + 2 * lane + 1];
        *(unsigned*)(y + (size_t)q * DM + hh * HD + 2 * lane) = pack_h2(o0 * rstd * g0, o1 * rstd * g1);
        __builtin_amdgcn_wave_barrier();
    }
}

typedef short s4_t __attribute__((ext_vector_type(4)));
typedef float f32x16 __attribute__((ext_vector_type(16)));
constexpr int AT_KSTR = 272, AT_VSTR = 320, AT_KBYTES = 64 * AT_KSTR, AT_VBYTES = 64 * AT_VSTR, AT_STAGE = AT_KBYTES + AT_VBYTES;
__device__ __forceinline__ float fexp2(float x) { return __builtin_amdgcn_exp2f(x); }
__device__ __forceinline__ float flog2(float x) { return __builtin_amdgcn_logf(x); }

template <int VAR>
__device__ __forceinline__ void attn_item(const Params& p, LAS unsigned char* lds, const float* ong, int b, int hh, int qt, int qc, int kc, int vc) {
    const f16* proj = (const f16*)(p.ws + WS_PROJ);
    const int tid = otid(), wid = __builtin_amdgcn_readfirstlane(tid >> 6), lane = tid & 63, qn = lane & 31, hf = lane >> 5;
    const int q0 = qt * 256, qrow = q0 + 32 * wid + qn;
    const size_t grow = (size_t)b * SEQ + qrow;
    h8_t Qf[8];
    {
        const float sc = 0.08838834764831845f * 1.4426950408889634f;
        const f16* qp = proj + grow * INWP + qc + 8 * hf;
#pragma unroll
        for (int ks = 0; ks < 8; ++ks) {
            const h8_t v = *(const h8_t*)(qp + 16 * ks);
            h8_t w;
#pragma unroll
            for (int j = 0; j < 8; ++j) w[j] = (f16)((float)v[j] * sc);
            Qf[ks] = w;
        }
    }
    unsigned allowed = 0xffu;
    if (VAR == 2) {
        const int own = qt;
        const float* km = (const float*)(p.ws + WS_KMEAN) + ((size_t)b * HC + (hh - HA - HB)) * MOBA_NB * HD + 8 * hf;
        float gs[MOBA_NB];
#pragma unroll
        for (int j = 0; j < MOBA_NB; ++j) gs[j] = -INFINITY;
#pragma unroll
        for (int j = 0; j < MOBA_NB - 1; ++j) {
            if (j < own) {
                float s = 0.f;
#pragma unroll
                for (int ks = 0; ks < 8; ++ks) {
                    const f32x4 k0 = *(const f32x4*)(km + j * HD + 16 * ks), k1 = *(const f32x4*)(km + j * HD + 16 * ks + 4);
                    s += (float)Qf[ks][0] * k0[0] + (float)Qf[ks][1] * k0[1] + (float)Qf[ks][2] * k0[2] + (float)Qf[ks][3] * k0[3]
                       + (float)Qf[ks][4] * k1[0] + (float)Qf[ks][5] * k1[1] + (float)Qf[ks][6] * k1[2] + (float)Qf[ks][7] * k1[3];
                }
                gs[j] = s + __shfl_xor(s, 32);
            }
        }
        allowed = 1u << own;
#pragma unroll
        for (int j = 0; j < MOBA_NB - 1; ++j) {
            if (j < own) {
                int rank = 0;
#pragma unroll
                for (int k2 = 0; k2 < MOBA_NB - 1; ++k2) if (k2 < own && (gs[k2] > gs[j] || (gs[k2] == gs[j] && k2 < j))) ++rank;
                if (rank < 3) allowed |= 1u << j;
            }
        }
    }
    f32x16 O[4];
#pragma unroll
    for (int dt = 0; dt < 4; ++dt)
#pragma unroll
        for (int r = 0; r < 16; ++r) O[dt][r] = 0.f;
    float m_run = -INFINITY, l_run = 0.f, carry = 0.f;
    const int nst = (qt + 1) * 4;
    const int st_hi_w = qt * 4 + (wid >> 1);
    const int sr0 = tid >> 4, sc0 = tid & 15;
    const f16* kg = proj + ((size_t)b * SEQ + sr0) * INWP + kc + 8 * sc0;
    const f16* vg = proj + ((size_t)b * SEQ + sr0) * INWP + vc + 8 * sc0;
    const unsigned kw = sr0 * AT_KSTR + 16 * sc0, vw = AT_KBYTES + sr0 * AT_VSTR + 16 * sc0;
    const unsigned* mrow = (const unsigned*)(p.ws + WS_MASK) + grow * 64;
    const unsigned ka = qn * AT_KSTR + 16 * hf;
    const unsigned va = AT_KBYTES + (4 * hf + ((lane & 15) >> 2)) * AT_VSTR + (16 * ((lane >> 4) & 1) + 4 * (lane & 3)) * 2;
    u32x4 rk0, rk1, rv0, rv1; u32x2 mw = {0u, 0u}, mwn = {0u, 0u};
#define AT_LOAD(st_) do { const size_t o_ = (size_t)(st_) * 64 * INWP; rk0 = *(const u32x4*)(kg + o_); rk1 = *(const u32x4*)(kg + o_ + (size_t)32 * INWP); \
        rv0 = *(const u32x4*)(vg + o_); rv1 = *(const u32x4*)(vg + o_ + (size_t)32 * INWP); if (VAR == 0) mwn = *(const u32x2*)(mrow + 2 * (st_)); } while (0)
#define AT_WRITE(buf_) do { LAS unsigned char* b_ = lds + (buf_) * AT_STAGE; *(LAS u32x4*)(b_ + kw) = rk0; *(LAS u32x4*)(b_ + kw + 32 * AT_KSTR) = rk1; \
        *(LAS u32x4*)(b_ + vw) = rv0; *(LAS u32x4*)(b_ + vw + 32 * AT_VSTR) = rv1; } while (0)
    __syncthreads();
    AT_LOAD(nst - 1); AT_WRITE(0); mw = mwn;
    __syncthreads();
    int cur = 0;
    for (int st = nst - 1; st >= 0; --st) {
        if (st > 0) AT_LOAD(st - 1);
        if (st <= st_hi_w) {
            LAS unsigned char* kb = lds + cur * AT_STAGE;
            f32x16 S[2];
#pragma unroll
            for (int r = 0; r < 16; ++r) { S[0][r] = 0.f; S[1][r] = 0.f; }
#pragma unroll
            for (int ks = 0; ks < 8; ++ks) {
                const h8_t a0 = *(const LAS h8_t*)(kb + ka + 32 * ks), a1 = *(const LAS h8_t*)(kb + ka + 32 * ks + 32 * AT_KSTR);
                S[0] = __builtin_amdgcn_mfma_f32_32x32x16_f16(a0, Qf[ks], S[0], 0, 0, 0);
                S[1] = __builtin_amdgcn_mfma_f32_32x32x16_f16(a1, Qf[ks], S[1], 0, 0, 0);
            }
            const bool diag = (64 * st + 63 > q0 + 32 * wid);
            const int kbase = 64 * st + 4 * hf;
            if (VAR != 1) {
                const bool blk_ok = (VAR == 2) ? ((allowed >> (st >> 2)) & 1u) : true;
                float mx = -INFINITY;
#pragma unroll
                for (int sub = 0; sub < 2; ++sub)
#pragma unroll
                    for (int r = 0; r < 16; ++r) {
                        const int kl = (r & 3) + 8 * (r >> 2);
                        bool ok;
                        if (VAR == 0) ok = ((sub == 0 ? mw.x : mw.y) >> (kl + 4 * hf)) & 1u;
                        else ok = blk_ok && (!diag || (kbase + 32 * sub + kl <= qrow));
                        const float v = ok ? S[sub][r] : -INFINITY;
                        S[sub][r] = v; mx = fmaxf(mx, v);
                    }
                mx = fmaxf(mx, __shfl_xor(mx, 32));
                const float m_new = fmaxf(m_run, mx);
                const float m_use = (m_new == -INFINITY) ? 0.f : m_new;
                const float alpha = fexp2(m_run - m_use);
                float ps = 0.f;
#pragma unroll
                for (int sub = 0; sub < 2; ++sub)
#pragma unroll
                    for (int r = 0; r < 16; ++r) { const float e = fexp2(S[sub][r] - m_use); S[sub][r] = e; ps += e; }
                l_run = l_run * alpha + ps;
                m_run = m_new;
                if (__ballot(alpha != 1.f) != 0ull) {
#pragma unroll
                    for (int dt = 0; dt < 4; ++dt)
#pragma unroll
                        for (int r = 0; r < 16; ++r) O[dt][r] *= alpha;
                }
            } else {
#pragma unroll
                for (int sub = 1; sub >= 0; --sub) {
                    float lk[16];
#pragma unroll
                    for (int r = 0; r < 16; ++r) {
                        const int kl = (r & 3) + 8 * (r >> 2);
                        const bool ok = !diag || (kbase + 32 * sub + kl < qrow);
                        const float zl = S[sub][r];
                        const float sp = fmaxf(zl, 0.f) + flog2(1.f + fexp2(-fabsf(zl)));
                        lk[r] = ok ? -sp : 0.f;
                        S[sub][r] = ok ? zl : -INFINITY;
                    }
                    float gsum[4], pg[4], T[4];
#pragma unroll
                    for (int g = 0; g < 4; ++g) { gsum[g] = (lk[4 * g] + lk[4 * g + 1]) + (lk[4 * g + 2] + lk[4 * g + 3]); pg[g] = __shfl_xor(gsum[g], 32); T[g] = gsum[g] + pg[g]; }
                    float after[4];
                    after[3] = 0.f; after[2] = T[3]; after[1] = T[3] + T[2]; after[0] = T[3] + T[2] + T[1];
#pragma unroll
                    for (int g = 0; g < 4; ++g) {
                        const float base = carry + after[g] + (hf == 0 ? pg[g] : 0.f);
                        const float c3 = lk[4 * g + 3], c2 = lk[4 * g + 2] + c3, c1 = lk[4 * g + 1] + c2, c0 = lk[4 * g] + c1;
                        S[sub][4 * g + 3] = fexp2(S[sub][4 * g + 3] + base + c3);
                        S[sub][4 * g + 2] = fexp2(S[sub][4 * g + 2] + base + c2);
                        S[sub][4 * g + 1] = fexp2(S[sub][4 * g + 1] + base + c1);
                        S[sub][4 * g + 0] = fexp2(S[sub][4 * g + 0] + base + c0);
                    }
                    carry += (T[0] + T[1]) + (T[2] + T[3]);
                }
            }
#pragma unroll
            for (int sub = 0; sub < 2; ++sub)
#pragma unroll
                for (int s2 = 0; s2 < 2; ++s2) {
                    h8_t pb;
#pragma unroll
                    for (int j = 0; j < 8; ++j) pb[j] = (f16)S[sub][8 * s2 + j];
#pragma unroll
                    for (int dt = 0; dt < 4; ++dt) {
                        const LAS unsigned char* ap = kb + va + (32 * sub + 16 * s2) * AT_VSTR + 64 * dt;
                        const s4_t t0 = __builtin_amdgcn_ds_read_tr16_b64_v4i16((LAS s4_t*)ap);
                        const s4_t t1 = __builtin_amdgcn_ds_read_tr16_b64_v4i16((LAS s4_t*)(ap + 8 * AT_VSTR));
                        typedef short s8_t __attribute__((ext_vector_type(8)));
                        const s8_t a8 = __builtin_shufflevector(t0, t1, 0, 1, 2, 3, 4, 5, 6, 7);
                        O[dt] = __builtin_amdgcn_mfma_f32_32x32x16_f16(__builtin_bit_cast(h8_t, a8), pb, O[dt], 0, 0, 0);
                    }
                }
        }
        if (st > 0) { AT_WRITE(cur ^ 1); }
        mw = mwn;
        __syncthreads();
        cur ^= 1;
    }
#undef AT_LOAD
#undef AT_WRITE
    float inv = 1.f;
    if (VAR != 1) { const float lt = l_run + __shfl_xor(l_run, 32); inv = 1.f / lt; }
    float ss = 0.f;
#pragma unroll
    for (int dt = 0; dt < 4; ++dt)
#pragma unroll
        for (int r = 0; r < 16; ++r) { const float v = O[dt][r] * inv; O[dt][r] = v; ss += v * v; }
    ss += __shfl_xor(ss, 32);
    const float rstd = rsqrtf(ss * (1.f / HD) + EPS);
    f16* yp = (f16*)(p.ws + WS_Y) + grow * DM + hh * HD + 4 * hf;
    const float* gp = ong + hh * HD + 4 * hf;
#pragma unroll
    for (int dt = 0; dt < 4; ++dt)
#pragma unroll
        for (int g = 0; g < 4; ++g) {
            const f32x4 gg = *(const f32x4*)(gp + 32 * dt + 8 * g);
            u32x2 w; w.x = pack_h2(O[dt][4 * g] * rstd * gg[0], O[dt][4 * g + 1] * rstd * gg[1]); w.y = pack_h2(O[dt][4 * g + 2] * rstd * gg[2], O[dt][4 * g + 3] * rstd * gg[3]);
            *(u32x2*)(yp + 32 * dt + 8 * g) = w;
        }
}

__device__ __forceinline__ void phase_attn2(const Params& p, LAS unsigned char* lds, const float* ong) {
    for (int pi = obid(); pi < 512; pi += gridDim.x) {
        const int a = pi & 3, bh = pi >> 2, b = bh >> 4;
        int hh = bh & 15; if (pi >= 256) hh = (hh + 8) & 15;
        for (int e = 0; e < 2; ++e) {
            const int qt = e == 0 ? 7 - a : a;
            if (hh < HA) attn_item<0>(p, lds, ong, b, hh, qt, C_QA + hh * HD, C_KA, C_VA);
            else if (hh < HA + HB) attn_item<1>(p, lds, ong, b, hh, qt, C_QB + (hh - HA) * HD, C_KB + (hh - HA) * HD, C_VB + (hh - HA) * HD);
            else attn_item<2>(p, lds, ong, b, hh, qt, C_QC + (hh - HA - HB) * HD, C_KC + (hh - HA - HB) * HD, C_VC + (hh - HA - HB) * HD);
        }
    }
}

__device__ __forceinline__ void wave_argmax(float& v, int& idx) {
#pragma unroll
    for (int o = 32; o >= 1; o >>= 1) {
        const float ov = __shfl_xor(v, o); const int oi = __shfl_xor(idx, o);
        if (ov > v || (ov == v && oi < idx)) { v = ov; idx = oi; }
    }
}
__device__ __forceinline__ void phase_route(const Params& p, LAS unsigned char* lds_, const f16* subk) {
    const f16* qp = (const f16*)(p.ws + WS_Y);
    float* smem = (float*)(unsigned char*)lds_;
    const int tid = otid(), wid = tid >> 6, lane = tid & 63;
    float* qs = smem + wid * 256;
    unsigned* pe = (unsigned*)(p.ws + WS_PE); float* pg = (float*)(p.ws + WS_PG);
    const size_t nitems = (size_t)NT * PH;
    for (size_t it = (size_t)blockIdx.x * NWAVES + wid; it < nitems; it += (size_t)gridDim.x * NWAVES) {
        const int hp = (int)(it % PH); const int t = (int)(it / PH);
        const f16* qrow = qp + (size_t)t * DM + hp * 256;
        for (int i = lane; i < 256; i += 64) qs[i] = (float)qrow[i];
        __builtin_amdgcn_wave_barrier();
        float sv[2]; int si[2];
#pragma unroll
        for (int c = 0; c < 2; ++c) {
            float v0, v1;
            {
                const f16* k0 = subk + (((size_t)hp * 2 + c) * PNK + lane) * 128;
                const f16* k1 = k0 + 64 * 128;
                float a0 = 0.f, a1 = 0.f;
#pragma unroll 4
                for (int e8 = 0; e8 < 16; ++e8) {
                    const h8_t x0 = *(const h8_t*)(k0 + e8 * 8), x1 = *(const h8_t*)(k1 + e8 * 8);
#pragma unroll
                    for (int j = 0; j < 8; ++j) { const float qq = qs[c * 128 + e8 * 8 + j]; a0 += qq * (float)x0[j]; a1 += qq * (float)x1[j]; }
                }
                v0 = a0; v1 = a1;
            }
            float mysv = 0.f; int mysi = 0;
            for (int r = 0; r < PTOPK; ++r) {
                float v; int idx;
                if (v0 >= v1) { v = v0; idx = lane; } else { v = v1; idx = lane + 64; }
                wave_argmax(v, idx);
                if (idx == lane) v0 = -INFINITY;
                if (idx == lane + 64) v1 = -INFINITY;
                if (lane == r) { mysv = v; mysi = idx; }
            }
            sv[c] = mysv; si[c] = mysi;
        }
        float cs[4];
#pragma unroll
        for (int k = 0; k < 4; ++k) { const int id = 4 * lane + k; cs[k] = __shfl(sv[0], id >> 4) + __shfl(sv[1], id & 15); }
        float tops = 0.f; int pick = 0;
        for (int r = 0; r < PTOPK; ++r) {
            float v = cs[0]; int idx = 4 * lane;
#pragma unroll
            for (int k = 1; k < 4; ++k) if (cs[k] > v) { v = cs[k]; idx = 4 * lane + k; }
            wave_argmax(v, idx);
#pragma unroll
            for (int k = 0; k < 4; ++k) if (idx == 4 * lane + k) cs[k] = -INFINITY;
            if (lane == r) { tops = v; pick = idx; }
        }
        const int e0 = __shfl(si[0], pick >> 4), e1 = __shfl(si[1], pick & 15);
        const float mx = __shfl(tops, 0);
        float ex = lane < PTOPK ? __expf(tops - mx) : 0.f;
        const float sum = wave_sum(ex);
        if (lane < PTOPK) { pe[(size_t)t * 128 + hp * 16 + lane] = (unsigned)(e0 * PNK + e1); pg[(size_t)t * 128 + hp * 16 + lane] = ex / sum; }
        __builtin_amdgcn_wave_barrier();
    }
}

#define CE_DESC(a, b) do { const unsigned _x = (a) > (b) ? (a) : (b), _y = (a) > (b) ? (b) : (a); (a) = _x; (b) = _y; } while (0)
__device__ __forceinline__ void sort16_desc(unsigned (&k)[16]) {
#pragma unroll
    for (int kk = 2; kk <= 16; kk <<= 1)
#pragma unroll
        for (int j = kk >> 1; j > 0; j >>= 1)
#pragma unroll
            for (int i = 0; i < 16; ++i) { const int l = i ^ j; if (l > i) { if ((i & kk) == 0) CE_DESC(k[i], k[l]); else CE_DESC(k[l], k[i]); } }
}
__device__ __forceinline__ void merge16_desc(unsigned (&a)[16], const unsigned (&b)[16]) {
#pragma unroll
    for (int i = 0; i < 16; ++i) a[i] = a[i] > b[15 - i] ? a[i] : b[15 - i];
#pragma unroll
    for (int j = 8; j > 0; j >>= 1)
#pragma unroll
        for (int i = 0; i < 16; ++i) { const int l = i ^ j; if (l > i) CE_DESC(a[i], a[l]); }
}
__device__ __forceinline__ unsigned f2sort(float f) { const unsigned b = __float_as_uint(f); return b ^ ((unsigned)((int)b >> 31) | 0x80000000u); }
__device__ __forceinline__ float sort2f(unsigned u) { const unsigned b = (u & 0x80000000u) ? (u ^ 0x80000000u) : ~u; return __uint_as_float(b); }
constexpr int RT_STR = 272;
__device__ __forceinline__ void phase_route2(const Params& p, LAS unsigned char* lds, const f16* subk) {
    const f16* qp = (const f16*)(p.ws + WS_Y);
    unsigned* pe = (unsigned*)(p.ws + WS_PE); float* pg = (float*)(p.ws + WS_PG);
    const int tid = otid(), wid = __builtin_amdgcn_readfirstlane(tid >> 6), lane = tid & 63, qn = lane & 31, hf = lane >> 5;
    for (int item = obid(); item < 256; item += gridDim.x) {
        const int hp = item & 7, tg = item >> 3;
        __syncthreads();
        {
            const f16* src = subk + (size_t)hp * 256 * 128;
#pragma unroll
            for (int i = 0; i < 8; ++i) { const int e = tid + i * 512, r = e >> 4, c = e & 15; *(LAS u32x4*)(lds + r * RT_STR + 16 * c) = *(const u32x4*)(src + r * 128 + 8 * c); }
        }
        __syncthreads();
#pragma unroll 1
        for (int it = 0; it < 2; ++it) {
            const int t = (tg * 16 + wid * 2 + it) * 32 + qn;
            unsigned top[2][16];
#pragma unroll
            for (int c = 0; c < 2; ++c) {
                h8_t Bq[8];
                const f16* qrow = qp + (size_t)t * DM + hp * 256 + c * 128 + 8 * hf;
#pragma unroll
                for (int ks = 0; ks < 8; ++ks) Bq[ks] = *(const h8_t*)(qrow + 16 * ks);
                unsigned run[16];
#pragma unroll 1
                for (int nt = 0; nt < 4; ++nt) {
                    f32x16 S;
#pragma unroll
                    for (int r = 0; r < 16; ++r) S[r] = 0.f;
#pragma unroll
                    for (int ks = 0; ks < 8; ++ks) {
                        const h8_t a = *(const LAS h8_t*)(lds + (c * 128 + nt * 32 + qn) * RT_STR + 32 * ks + 16 * hf);
                        S = __builtin_amdgcn_mfma_f32_32x32x16_f16(a, Bq[ks], S, 0, 0, 0);
                    }
                    unsigned k[16];
#pragma unroll
                    for (int r = 0; r < 16; ++r) { const int n = 32 * nt + (r & 3) + 8 * (r >> 2) + 4 * hf; k[r] = (f2sort(S[r]) & ~127u) | (unsigned)(127 - n); }
                    sort16_desc(k);
                    if (nt == 0) {
#pragma unroll
                        for (int r = 0; r < 16; ++r) run[r] = k[r];
                    } else merge16_desc(run, k);
                }
#pragma unroll
                for (int r = 0; r < 16; ++r) top[c][r] = run[r];
            }
            unsigned mine[16], oth[16];
#pragma unroll
            for (int r = 0; r < 16; ++r) { const unsigned send = hf ? top[0][r] : top[1][r]; oth[r] = __shfl_xor(send, 32); mine[r] = hf ? top[1][r] : top[0][r]; }
            merge16_desc(mine, oth);
            unsigned ka[16], kb2[16];
#pragma unroll
            for (int r = 0; r < 16; ++r) { const unsigned o = __shfl_xor(mine[r], 32); ka[r] = hf ? o : mine[r]; kb2[r] = hf ? mine[r] : o; }
            float sa[16], sb[16]; unsigned na[4] = {0u, 0u, 0u, 0u}, nb[4] = {0u, 0u, 0u, 0u};
#pragma unroll
            for (int r = 0; r < 16; ++r) {
                sa[r] = sort2f(ka[r] & ~127u); sb[r] = sort2f(kb2[r] & ~127u);
                na[r >> 2] |= (127u - (ka[r] & 127u)) << (8 * (r & 3)); nb[r >> 2] |= (127u - (kb2[r] & 127u)) << (8 * (r & 3));
            }
            unsigned cand[4][16];
#pragma unroll
            for (int g = 0; g < 4; ++g)
#pragma unroll
                for (int r = 0; r < 16; ++r) cand[g][r] = 0u;
#pragma unroll
            for (int slot = 0; slot < 50; ++slot) {
                constexpr unsigned char CIJ[64] = {0, 1, 2, 3, 4, 5, 6, 7, 8, 9, 10, 11, 12, 13, 14, 15, 16, 17, 18, 19, 20, 21, 22, 23, 32, 33, 34, 35, 36, 48, 49, 50, 51, 64, 65, 66, 80, 81, 96, 97, 112, 113, 128, 144, 160, 176, 192, 208, 224, 240, 255, 255, 255, 255, 255, 255, 255, 255, 255, 255, 255, 255, 255, 255};
                const int ij = CIJ[slot], i = ij >> 4, j = ij & 15;
                cand[slot >> 4][slot & 15] = (f2sort(sa[i] + sb[j]) & ~255u) | (unsigned)(255 - ij);
            }
#pragma unroll
            for (int g = 1; g < 4; ++g) sort16_desc(cand[g]);
            merge16_desc(cand[0], cand[1]); merge16_desc(cand[2], cand[3]); merge16_desc(cand[0], cand[2]);
            float ex[16]; float sum = 0.f;
            const float mx = sort2f(cand[0][0] & ~255u);
#pragma unroll
            for (int r = 0; r < 16; ++r) { ex[r] = __expf(sort2f(cand[0][r] & ~255u) - mx); sum += ex[r]; }
            const float inv = 1.f / sum;
            unsigned eo[16];
#pragma unroll
            for (int r = 0; r < 16; ++r) {
                const unsigned id = 255u - (cand[0][r] & 255u), i = id >> 4, j = id & 15u;
                const unsigned wa = (i & 8u) ? ((i & 4u) ? na[3] : na[2]) : ((i & 4u) ? na[1] : na[0]);
                const unsigned wb = (j & 8u) ? ((j & 4u) ? nb[3] : nb[2]) : ((j & 4u) ? nb[1] : nb[0]);
                eo[r] = ((wa >> (8 * (i & 3u))) & 255u) * PNK + ((wb >> (8 * (j & 3u))) & 255u);
                ex[r] *= inv;
            }
            if (hf == 0) {
#pragma unroll
                for (int r4 = 0; r4 < 4; ++r4) { u32x4 w; w.x = eo[4 * r4]; w.y = eo[4 * r4 + 1]; w.z = eo[4 * r4 + 2]; w.w = eo[4 * r4 + 3]; *(u32x4*)(pe + (size_t)t * 128 + hp * 16 + 4 * r4) = w; }
            } else {
#pragma unroll
                for (int r4 = 0; r4 < 4; ++r4) { f32x4 w; w[0] = ex[4 * r4]; w[1] = ex[4 * r4 + 1]; w[2] = ex[4 * r4 + 2]; w[3] = ex[4 * r4 + 3]; *(f32x4*)(pg + (size_t)t * 128 + hp * 16 + 4 * r4) = w; }
            }
        }
    }
}

__device__ __forceinline__ void phase_experts(const Params& p, const f16* h2, const float* x1, const float* gate2  , const f16* u16, const f16* v16,
                              float* xout  , bool final_norm, const float* ng, const float* nshift, const float* nscale, f16* hnext, float* fout) {
    const int tid_ = otid(); const int wid = tid_ >> 6, lane = tid_ & 63;
    const unsigned* pe = (const unsigned*)(p.ws + WS_PE); const float* pg = (const float*)(p.ws + WS_PG);
    for (int t = blockIdx.x * NWAVES + wid; t < NT; t += gridDim.x * NWAVES) {
        const int b = t / SEQ;
        u32x4 hv[4];
#pragma unroll
        for (int i = 0; i < 4; ++i) hv[i] = *(const u32x4*)(h2 + (size_t)t * DM + 512 * i + 8 * lane);
        float acc[32];
#pragma unroll
        for (int i = 0; i < 32; ++i) acc[i] = 0.f;
        for (int g8 = 0; g8 < 32; ++g8) {
            const unsigned myexp = pe[(size_t)t * 128 + g8 * 4 + (lane & 3)];
            const float mygate = pg[(size_t)t * 128 + g8 * 4 + (lane & 3)];
            float part[4];
#pragma unroll
            for (int k = 0; k < 4; ++k) {
                const unsigned e = __shfl(myexp, k);
                const f16* ur = u16 + (size_t)e * DM + 8 * lane;
                float d = 0.f;
#pragma unroll
                for (int i = 0; i < 4; ++i) { const u32x4 w = *(const u32x4*)(ur + 512 * i); d = dot2(hv[i].x, w.x, d); d = dot2(hv[i].y, w.y, d); d = dot2(hv[i].z, w.z, d); d = dot2(hv[i].w, w.w, d); }
                part[k] = d;
            }
#pragma unroll
            for (int k = 0; k < 4; ++k) part[k] = wave_sum(part[k]);
#pragma unroll
            for (int k = 0; k < 4; ++k) {
                const float d = part[k];
                const float act = 0.5f * d * (1.f + erff(d * 0.70710678118654752f));
                const float coef = __shfl(mygate, k) * act;
                const unsigned e = __shfl(myexp, k);
                const f16* vr = v16 + (size_t)e * DM + 8 * lane;
#pragma unroll
                for (int i = 0; i < 4; ++i) {
                    const u32x4 w = *(const u32x4*)(vr + 512 * i);
                    acc[8 * i + 0] += coef * h_lo(w.x); acc[8 * i + 1] += coef * h_hi(w.x); acc[8 * i + 2] += coef * h_lo(w.y); acc[8 * i + 3] += coef * h_hi(w.y);
                    acc[8 * i + 4] += coef * h_lo(w.z); acc[8 * i + 5] += coef * h_hi(w.z); acc[8 * i + 6] += coef * h_lo(w.w); acc[8 * i + 7] += coef * h_hi(w.w);
                }
            }
        }
        float ss = 0.f;
#pragma unroll
        for (int i = 0; i < 4; ++i) {
            const int col = 512 * i + 8 * lane;
#pragma unroll
            for (int hf = 0; hf < 2; ++hf) {
                const f32x4 xi = *(const f32x4*)(x1 + (size_t)t * DM + col + 4 * hf);
                const f32x4 gt = *(const f32x4*)(gate2 + (size_t)b * 6 * DM + col + 4 * hf);
                f32x4 r;
#pragma unroll
                for (int j = 0; j < 4; ++j) { r[j] = xi[j] + gt[j] * acc[8 * i + 4 * hf + j]; acc[8 * i + 4 * hf + j] = r[j]; ss += r[j] * r[j]; }
                if (xout) *(f32x4*)(xout + (size_t)t * DM + col + 4 * hf) = r;
            }
        }
        ss = wave_sum(ss);
        const float rstd = rsqrtf(ss * (1.f / DM) + EPS);
#pragma unroll
        for (int i = 0; i < 4; ++i) {
            const int col = 512 * i + 8 * lane;
            if (final_norm) {
#pragma unroll
                for (int hf = 0; hf < 2; ++hf) {
                    const f32x4 gg = *(const f32x4*)(ng + col + 4 * hf);
                    f32x4 r;
#pragma unroll
                    for (int j = 0; j < 4; ++j) r[j] = acc[8 * i + 4 * hf + j] * rstd * gg[j];
                    *(f32x4*)(fout + (size_t)t * DM + col + 4 * hf) = r;
                }
            } else {
                float yv[8];
#pragma unroll
                for (int hf = 0; hf < 2; ++hf) {
                    const f32x4 gg = *(const f32x4*)(ng + col + 4 * hf), sh = *(const f32x4*)(nshift + (size_t)b * 6 * DM + col + 4 * hf), sc = *(const f32x4*)(nscale + (size_t)b * 6 * DM + col + 4 * hf);
#pragma unroll
                    for (int j = 0; j < 4; ++j) yv[4 * hf + j] = acc[8 * i + 4 * hf + j] * rstd * gg[j] * (1.f + sc[j]) + sh[j];
                }
                u32x4 w; w.x = pack_h2(yv[0], yv[1]); w.y = pack_h2(yv[2], yv[3]); w.z = pack_h2(yv[4], yv[5]); w.w = pack_h2(yv[6], yv[7]);
                *(u32x4*)(hnext + (size_t)t * DM + col) = w;
            }
        }
    }
}

__device__ __forceinline__ void phase_experts8(const Params& p, const float* x1, const float* gate2, const unsigned char* u8, const unsigned char* v8, const float* su, const float* sv,
                              float* xout  , bool final_norm, const float* ng, const float* nshift, const float* nscale, f16* hnext, float* fout) {
    const int tid_ = otid(); const int wid = tid_ >> 6, lane = tid_ & 63;
    const unsigned* pe = (const unsigned*)(p.ws + WS_PE); const float* pg = (const float*)(p.ws + WS_PG);
    const unsigned char* h8 = (const unsigned char*)(p.ws + WS_H8); const float* shv = (const float*)(p.ws + WS_SH);
    for (int t = blockIdx.x * NWAVES + wid; t < NT; t += gridDim.x * NWAVES) {
        const int b = t / SEQ;
        u32x4 hv[2];
#pragma unroll
        for (int i = 0; i < 2; ++i) hv[i] = *(const u32x4*)(h8 + (size_t)t * DM + 1024 * i + 16 * lane);
        const float sht = shv[t];
        float acc[32]; float csum = 0.f;
#pragma unroll
        for (int i = 0; i < 32; ++i) acc[i] = 0.f;
        for (int g4 = 0; g4 < 32; ++g4) {
            const unsigned myexp = pe[(size_t)t * 128 + g4 * 4 + (lane & 3)];
            const float mygate = pg[(size_t)t * 128 + g4 * 4 + (lane & 3)];
            const float mysc = mygate * sv[myexp];
            const float mydsc = su[myexp] * sht;
            int part[4]; u32x4 vr[4][2];
#pragma unroll
            for (int k = 0; k < 4; ++k) {
                const unsigned e = __shfl(myexp, k);
                const unsigned char* ur = u8 + (size_t)e * DM + 16 * lane;
                const unsigned char* vp = v8 + (size_t)e * DM + 16 * lane;
                int d = 0;
#pragma unroll
                for (int i = 0; i < 2; ++i) {
                    const u32x4 w = *(const u32x4*)(ur + 1024 * i);
                    d = __builtin_amdgcn_sdot4((int)hv[i].x, (int)w.x, d, false); d = __builtin_amdgcn_sdot4((int)hv[i].y, (int)w.y, d, false);
                    d = __builtin_amdgcn_sdot4((int)hv[i].z, (int)w.z, d, false); d = __builtin_amdgcn_sdot4((int)hv[i].w, (int)w.w, d, false);
                    vr[k][i] = *(const u32x4*)(vp + 1024 * i);
                }
                part[k] = d;
            }
#pragma unroll
            for (int k = 0; k < 4; ++k) {
#pragma unroll
                for (int o = 32; o >= 1; o >>= 1) part[k] += __shfl_xor(part[k], o);
            }
#pragma unroll
            for (int k = 0; k < 4; ++k) {
                const float d = (float)part[k] * __shfl(mydsc, k);
                const float act = 0.5f * d * (1.f + erff(d * 0.70710678118654752f));
                const float coef = __shfl(mysc, k) * act;
                csum += coef;
#pragma unroll
                for (int i = 0; i < 2; ++i) {
                    const unsigned ww[4] = {vr[k][i].x, vr[k][i].y, vr[k][i].z, vr[k][i].w};
#pragma unroll
                    for (int q = 0; q < 4; ++q) {
                        acc[16 * i + 4 * q + 0] += coef * (float)(ww[q] & 255u); acc[16 * i + 4 * q + 1] += coef * (float)((ww[q] >> 8) & 255u);
                        acc[16 * i + 4 * q + 2] += coef * (float)((ww[q] >> 16) & 255u); acc[16 * i + 4 * q + 3] += coef * (float)(ww[q] >> 24);
                    }
                }
            }
        }
        float ss = 0.f;
#pragma unroll
        for (int i = 0; i < 2; ++i)
#pragma unroll
            for (int q = 0; q < 4; ++q) {
                const int col = 1024 * i + 16 * lane + 4 * q;
                const f32x4 xi = *(const f32x4*)(x1 + (size_t)t * DM + col);
                const f32x4 gt = *(const f32x4*)(gate2 + (size_t)b * 6 * DM + col);
                f32x4 r;
#pragma unroll
                for (int j = 0; j < 4; ++j) { r[j] = xi[j] + gt[j] * (acc[16 * i + 4 * q + j] - 128.f * csum); acc[16 * i + 4 * q + j] = r[j]; ss += r[j] * r[j]; }
                if (xout) *(f32x4*)(xout + (size_t)t * DM + col) = r;
            }
        ss = wave_sum(ss);
        const float rstd = rsqrtf(ss * (1.f / DM) + EPS);
#pragma unroll
        for (int i = 0; i < 2; ++i) {
            const int col0 = 1024 * i + 16 * lane;
            if (final_norm) {
#pragma unroll
                for (int q = 0; q < 4; ++q) {
                    const f32x4 gg = *(const f32x4*)(ng + col0 + 4 * q);
                    f32x4 r;
#pragma unroll
                    for (int j = 0; j < 4; ++j) r[j] = acc[16 * i + 4 * q + j] * rstd * gg[j];
                    *(f32x4*)(fout + (size_t)t * DM + col0 + 4 * q) = r;
                }
            } else {
                float yv[16];
#pragma unroll
                for (int q = 0; q < 4; ++q) {
                    const f32x4 gg = *(const f32x4*)(ng + col0 + 4 * q), sh = *(const f32x4*)(nshift + (size_t)b * 6 * DM + col0 + 4 * q), sc = *(const f32x4*)(nscale + (size_t)b * 6 * DM + col0 + 4 * q);
#pragma unroll
                    for (int j = 0; j < 4; ++j) yv[4 * q + j] = acc[16 * i + 4 * q + j] * rstd * gg[j] * (1.f + sc[j]) + sh[j];
                }
                u32x4 w0, w1;
                w0.x = pack_h2(yv[0], yv[1]); w0.y = pack_h2(yv[2], yv[3]); w0.z = pack_h2(yv[4], yv[5]); w0.w = pack_h2(yv[6], yv[7]);
                w1.x = pack_h2(yv[8], yv[9]); w1.y = pack_h2(yv[10], yv[11]); w1.z = pack_h2(yv[12], yv[13]); w1.w = pack_h2(yv[14], yv[15]);
                *(u32x4*)(hnext + (size_t)t * DM + col0) = w0; *(u32x4*)(hnext + (size_t)t * DM + col0 + 8) = w1;
            }
        }
    }
}

#ifndef EXU_NR
#define EXU_NR 8
#define EXU_SH 11
#endif
__device__ __forceinline__ unsigned xcc_id() { return (unsigned)__builtin_amdgcn_s_getreg((3 << 11) | 20) & 0xFu; }
__device__ __forceinline__ void phase_exu(const Params& p, LAS unsigned char* lds, const unsigned char* u8, const float* su, const float* sv) {
    const int tid = otid(), wid = __builtin_amdgcn_readfirstlane(tid >> 6), lane = tid & 63, sub = lane & 15, qd = lane >> 4;
    const unsigned* pe = (const unsigned*)(p.ws + WS_PE); const float* pg = (const float*)(p.ws + WS_PG);
    const unsigned char* h8 = (const unsigned char*)(p.ws + WS_H8); const float* shv = (const float*)(p.ws + WS_SH);
    unsigned* list = (unsigned*)(p.ws + WS_LIST);
    const unsigned* ctl = (const unsigned*)(p.ws + WS_CTL);
    const unsigned myx = *(const LAS unsigned*)(lds + LDS_BYTES - 16), mybi = *(const LAS unsigned*)(lds + LDS_BYTES - 12);
    int G = 0, g = 0, nb = 1;
#pragma unroll
    for (int j = 0; j < 16; ++j) { const unsigned c = __builtin_amdgcn_readfirstlane(__hip_atomic_load(ctl + j, __ATOMIC_RELAXED, __HIP_MEMORY_SCOPE_AGENT)); if (c > 0u) { if ((unsigned)j < myx) ++g; ++G; } if ((unsigned)j == myx) nb = (int)c; }
    const int tstep = nb * NWAVES, tfirst = (int)mybi * NWAVES + wid;
    const int nvis_t = (tfirst < NT) ? (NT - tfirst + tstep - 1) / tstep : 0;
    const int nrange = (EXU_NR - g + G - 1) / G;
    const int nvis = nvis_t * nrange;
    unsigned ne0 = 0u, ne1 = 0u; u32x4 nhv[8]; float nsh = 0.f;
#define EXU_FETCH(v_) do { const int tt_ = tfirst + ((v_) % nvis_t) * tstep; ne0 = pe[(size_t)tt_ * 128 + lane]; ne1 = pe[(size_t)tt_ * 128 + 64 + lane]; \
        _Pragma("unroll") for (int m = 0; m < 8; ++m) nhv[m] = *(const u32x4*)(h8 + (size_t)tt_ * DM + 256 * m + 16 * sub); nsh = shv[tt_]; } while (0)
    if (nvis > 0) EXU_FETCH(0);
    for (int v = 0; v < nvis; ++v) {
        const int t = tfirst + (v % nvis_t) * tstep, r = g + (v / nvis_t) * G;
        const unsigned e0 = ne0, e1 = ne1; const float sht = nsh;
        u32x4 hv[8];
#pragma unroll
        for (int m = 0; m < 8; ++m) hv[m] = nhv[m];
        if (v + 1 < nvis) EXU_FETCH(v + 1);
        const bool in0 = (int)(e0 >> EXU_SH) == r, in1 = (int)(e1 >> EXU_SH) == r;
        const unsigned long long m0 = __ballot(in0), m1 = __ballot(in1);
        const int n0 = __builtin_popcountll(m0), n = n0 + __builtin_popcountll(m1);
        if (n == 0) continue;
        LAS unsigned* wl = (LAS unsigned*)(lds + wid * 1024 + (v & 1) * 512);
        const unsigned long long below = (1ull << lane) - 1ull;
        if (in0) wl[__builtin_popcountll(m0 & below)] = ((unsigned)lane << 16) | e0;
        if (in1) wl[n0 + __builtin_popcountll(m1 & below)] = ((unsigned)(lane + 64) << 16) | e1;
        __builtin_amdgcn_wave_barrier();
        const int nit = (n + 3) >> 2;
        u32x4 wb[2][8]; unsigned entb[2];
#define EXU_ISSUE(B_, it_) do { const int idx_ = (it_) * 4 + qd; entb[B_] = wl[idx_ < n ? idx_ : 0]; \
            const unsigned char* row_ = u8 + (size_t)(entb[B_] & 0xffffu) * DM + 16 * sub; \
            _Pragma("unroll") for (int m = 0; m < 8; ++m) wb[B_][m] = *(const u32x4*)(row_ + 256 * m); } while (0)
#define EXU_COMPUTE(B_, it_) do { int d_ = 0; \
            _Pragma("unroll") for (int m = 0; m < 8; ++m) { const u32x4 w_ = wb[B_][m]; \
                d_ = __builtin_amdgcn_sdot4((int)hv[m].x, (int)w_.x, d_, false); d_ = __builtin_amdgcn_sdot4((int)hv[m].y, (int)w_.y, d_, false); \
                d_ = __builtin_amdgcn_sdot4((int)hv[m].z, (int)w_.z, d_, false); d_ = __builtin_amdgcn_sdot4((int)hv[m].w, (int)w_.w, d_, false); } \
            d_ += __shfl_xor(d_, 1); d_ += __shfl_xor(d_, 2); d_ += __shfl_xor(d_, 4); d_ += __shfl_xor(d_, 8); \
            if (((it_) * 4 + qd < n) && sub == 0) { \
                const unsigned ent_ = entb[B_], j_ = ent_ >> 16, e_ = ent_ & 0xffffu; \
                const float dd_ = (float)d_ * su[e_] * sht; \
                const float act_ = 0.5f * dd_ * (1.f + erff(dd_ * 0.70710678118654752f)); \
                const float coef_ = pg[(size_t)t * 128 + j_] * sv[e_] * act_ * (1024.f * 256.f); \
                const int ci_ = (int)rintf(fminf(fmaxf(coef_, -32767.f), 32767.f)); \
                unsigned short* l16_ = (unsigned short*)list + ((size_t)(j_ >> 2) * NT + t) * 8 + (j_ & 3u); \
                l16_[0] = (unsigned short)e_; l16_[4] = (unsigned short)ci_; } } while (0)
        EXU_ISSUE(0, 0);
        int it = 0;
        for (; it + 2 < nit; it += 2) {
            EXU_ISSUE(1, it + 1); EXU_COMPUTE(0, it);
            EXU_ISSUE(0, it + 2); EXU_COMPUTE(1, it + 1);
        }
        if (it + 2 == nit) { EXU_ISSUE(1, it + 1); EXU_COMPUTE(0, it); EXU_COMPUTE(1, it + 1); }
        else { EXU_COMPUTE(0, it); }
#undef EXU_ISSUE
#undef EXU_COMPUTE
    }
#undef EXU_FETCH
}

__device__ __forceinline__ void phase_exv(const Params& p, LAS unsigned char* lds, const float* x1, const float* gate2, const unsigned char* v8c, float* xout) {
    const int tid = otid();
    const u32x4* list = (const u32x4*)(p.ws + WS_LIST);
    int cfirst = obid(), cstep = gridDim.x;
    {
        const unsigned* ctl = (const unsigned*)(p.ws + WS_CTL);
        const unsigned myx = *(const LAS unsigned*)(lds + LDS_BYTES - 16), mybi = *(const LAS unsigned*)(lds + LDS_BYTES - 12);
        int G = 0, g = 0, nb = 1; bool uniform = true; unsigned c0 = 0u;
#pragma unroll
        for (int j = 0; j < 16; ++j) { const unsigned c = __builtin_amdgcn_readfirstlane(__hip_atomic_load(ctl + j, __ATOMIC_RELAXED, __HIP_MEMORY_SCOPE_AGENT)); if (c > 0u) { if ((unsigned)j < myx) ++g; ++G; if (c0 == 0u) c0 = c; else if (c != c0) uniform = false; } if ((unsigned)j == myx) nb = (int)c; }
        if (uniform && G * nb == (int)gridDim.x && (int)gridDim.x == 256) { cfirst = g * nb + (int)mybi; cstep = 256; }
    }
    for (int c = cfirst; c < 256; c += cstep) {
        __syncthreads();
        {
            const u32x4* src = (const u32x4*)(v8c + (size_t)c * PEXP * 8);
#pragma unroll 4
            for (int i = 0; i < 16; ++i) *(LAS u32x4*)(lds + (size_t)(i * 512 + tid) * 16) = src[i * 512 + tid];
        }
        __syncthreads();
        typedef short s2_t __attribute__((ext_vector_type(2)));
        for (int t = tid; t < NT; t += NTHREADS) {
            int acc[8]; int csum = 0;
#pragma unroll
            for (int k = 0; k < 8; ++k) acc[k] = 0;
#pragma unroll 1
            for (int jb = 0; jb < 2; ++jb) {
                u32x4 wv[16];
#pragma unroll
                for (int j4 = 0; j4 < 16; ++j4) wv[j4] = list[(size_t)(jb * 16 + j4) * NT + t];
#pragma unroll
                for (int j4 = 0; j4 < 16; ++j4) {
                    const unsigned ee[2] = {wv[j4].x, wv[j4].y}, cc[2] = {wv[j4].z, wv[j4].w};
#pragma unroll
                    for (int h = 0; h < 2; ++h) {
                        const u32x2 v0 = *(const LAS u32x2*)(lds + (ee[h] & 0xffffu) * 8), v1 = *(const LAS u32x2*)(lds + (ee[h] >> 16) * 8);
                        const s2_t cp = __builtin_bit_cast(s2_t, cc[h]);
                        csum = __builtin_amdgcn_sdot2(cp, __builtin_bit_cast(s2_t, 0x00010001u), csum, false);
                        acc[0] = __builtin_amdgcn_sdot2(cp, __builtin_bit_cast(s2_t, __builtin_amdgcn_perm(v1.x, v0.x, 0x0c040c00u)), acc[0], false);
                        acc[1] = __builtin_amdgcn_sdot2(cp, __builtin_bit_cast(s2_t, __builtin_amdgcn_perm(v1.x, v0.x, 0x0c050c01u)), acc[1], false);
                        acc[2] = __builtin_amdgcn_sdot2(cp, __builtin_bit_cast(s2_t, __builtin_amdgcn_perm(v1.x, v0.x, 0x0c060c02u)), acc[2], false);
                        acc[3] = __builtin_amdgcn_sdot2(cp, __builtin_bit_cast(s2_t, __builtin_amdgcn_perm(v1.x, v0.x, 0x0c070c03u)), acc[3], false);
                        acc[4] = __builtin_amdgcn_sdot2(cp, __builtin_bit_cast(s2_t, __builtin_amdgcn_perm(v1.y, v0.y, 0x0c040c00u)), acc[4], false);
                        acc[5] = __builtin_amdgcn_sdot2(cp, __builtin_bit_cast(s2_t, __builtin_amdgcn_perm(v1.y, v0.y, 0x0c050c01u)), acc[5], false);
                        acc[6] = __builtin_amdgcn_sdot2(cp, __builtin_bit_cast(s2_t, __builtin_amdgcn_perm(v1.y, v0.y, 0x0c060c02u)), acc[6], false);
                        acc[7] = __builtin_amdgcn_sdot2(cp, __builtin_bit_cast(s2_t, __builtin_amdgcn_perm(v1.y, v0.y, 0x0c070c03u)), acc[7], false);
                    }
                }
            }
            const int b = t / SEQ, col = 8 * c;
            const int off = csum << 7;
#pragma unroll
            for (int hfi = 0; hfi < 2; ++hfi) {
                const f32x4 xi = *(const f32x4*)(x1 + (size_t)t * DM + col + 4 * hfi);
                const f32x4 gt = *(const f32x4*)(gate2 + (size_t)b * 6 * DM + col + 4 * hfi);
                f32x4 r;
#pragma unroll
                for (int k = 0; k < 4; ++k) r[k] = xi[k] + gt[k] * ((float)(acc[4 * hfi + k] - off) * (1.f / (1024.f * 256.f)));
                *(f32x4*)(xout + (size_t)t * DM + col + 4 * hfi) = r;
            }
        }
    }
}

__device__ __forceinline__ void phase_norm_out(const Params& p, float* x2, bool final_norm, const float* g, const float* shift, const float* scale, f16* hout) {
    const int tid_ = otid(); const int wid = tid_ >> 6, lane = tid_ & 63;
    for (int row = blockIdx.x * NWAVES + wid; row < NT; row += gridDim.x * NWAVES) {
        const int b = row / SEQ;
        float* xr = x2 + (size_t)row * DM;
        f32x4 v[8]; float ss = 0.f;
#pragma unroll
        for (int i = 0; i < 8; ++i) { v[i] = *(const f32x4*)(xr + i * 256 + lane * 4); ss += v[i][0] * v[i][0] + v[i][1] * v[i][1] + v[i][2] * v[i][2] + v[i][3] * v[i][3]; }
        ss = wave_sum(ss);
        const float rstd = rsqrtf(ss * (1.f / DM) + EPS);
#pragma unroll
        for (int i = 0; i < 8; ++i) {
            const int col = i * 256 + lane * 4;
            const f32x4 gg = *(const f32x4*)(g + col);
            if (final_norm) { *(f32x4*)(xr + col) = v[i] * rstd * gg; }
            else {
                const f32x4 sh = *(const f32x4*)(shift + (size_t)b * 6 * DM + col), sc = *(const f32x4*)(scale + (size_t)b * 6 * DM + col);
                const f32x4 y = v[i] * rstd * gg * (sc + 1.f) + sh;
                u32x2 w; w.x = pack_h2(y[0], y[1]); w.y = pack_h2(y[2], y[3]);
                *(u32x2*)(hout + (size_t)row * DM + col) = w;
            }
        }
    }
}

#define XB_TMO      128
#define XB_XCNT(j)  (256  + 64 * (j))
#define XB_XSUB(j)  (1280 + 64 * (j))
#define XB_XGEN(j)  (2304 + 64 * (j))
#define XB_TOP      3328
#define XB_TOPGEN   3392
#define XCD_BAR_WORDS 3456
#define XB_SPIN_CAP (1u << 22)
__device__ __forceinline__ unsigned xb_ld(unsigned* p) { return __hip_atomic_load(p, __ATOMIC_RELAXED, __HIP_MEMORY_SCOPE_AGENT); }
__device__ __forceinline__ unsigned xb_add(unsigned* p, unsigned v) { return __hip_atomic_fetch_add(p, v, __ATOMIC_RELAXED, __HIP_MEMORY_SCOPE_AGENT); }
#define XB_SPIN(cond, bar) do { unsigned _sp = 0; while (cond) { __builtin_amdgcn_s_sleep(1); \
    if ((++_sp & 255u) == 0u) { if (xb_ld(&(bar)[XB_TMO])) break; if (_sp > XB_SPIN_CAP) { atomicAdd(&(bar)[XB_TMO], 1u); break; } } } } while (0)
struct XcdBarrier { unsigned* bar; unsigned x; volatile LAS unsigned* st; };
__device__ __forceinline__ void xcd_barrier_complete(unsigned* bar, unsigned x, unsigned& nloc, unsigned& nx) {
    const unsigned G = gridDim.x * gridDim.y * gridDim.z;
    unsigned sum, cnt, mine, sp = 0u;
    for (;;) {
        sum = 0u; cnt = 0u; mine = 0u;
#pragma unroll
        for (unsigned j = 0; j < 16; ++j) { const unsigned c = xb_ld(&bar[XB_XCNT(j)]); sum += c; cnt += (c > 0u) ? 1u : 0u; mine = (j == x) ? c : mine; }
        if (sum == G) break;
        __builtin_amdgcn_s_sleep(1);
        if ((++sp & 255u) == 0u) { if (xb_ld(&bar[XB_TMO])) break; if (sp > XB_SPIN_CAP) { atomicAdd(&bar[XB_TMO], 1u); break; } }
    }
    nloc = mine > 0u ? mine : 1u; nx = cnt > 0u ? cnt : 1u;
}
__device__ __forceinline__ void xcd_barrier(const XcdBarrier& b) {
    asm volatile("s_waitcnt vmcnt(0)" ::: "memory");
    __syncthreads();
    if (threadIdx.x == 0) {
        unsigned* bar = b.bar;
        __builtin_amdgcn_s_waitcnt(0);
        unsigned nloc = b.st[0], nx = b.st[1];
        if (nloc == 0u) { xcd_barrier_complete(bar, b.x, nloc, nx); b.st[0] = nloc; b.st[1] = nx; }
        const unsigned old = xb_add(&bar[XB_XSUB(b.x)], 1u);
        const unsigned gen = old / nloc;
        if (old + 1u == (gen + 1u) * nloc) {
            __builtin_amdgcn_fence(__ATOMIC_RELEASE, "agent");
            asm volatile("s_waitcnt vmcnt(0)" ::: "memory");
            const unsigned og = xb_add(&bar[XB_TOP], 1u);
            const unsigned tg = og / nx;
            if (og + 1u == (tg + 1u) * nx) xb_add(&bar[XB_TOPGEN], 1u);
            else XB_SPIN(xb_ld(&bar[XB_TOPGEN]) == tg, bar);
            __builtin_amdgcn_fence(__ATOMIC_ACQUIRE, "agent");
            xb_add(&bar[XB_XGEN(b.x)], 1u);
            asm volatile("s_waitcnt vmcnt(0)" ::: "memory");
        } else {
            XB_SPIN(xb_ld(&bar[XB_XGEN(b.x)]) == gen, bar);
            __builtin_amdgcn_fence(__ATOMIC_ACQUIRE, "agent");
            asm volatile("s_waitcnt vmcnt(0)" ::: "memory");
        }
    }
    __syncthreads();
}

constexpr int PH_CONV = 0, PH_N1 = 1, PH_L0 = 2, PH_PER_LAYER = 10, PH_TOTAL = PH_L0 + DEPTH * PH_PER_LAYER;

__global__ void __launch_bounds__(NTHREADS, 2) mega(Params p_arg) {
    extern __shared__ __attribute__((aligned(16))) unsigned char shm[];
    LAS unsigned char* lds = (LAS unsigned char*)shm;
    typedef const Params __attribute__((address_space(4)))* KP;
    const int ph_lo = p_arg.ph_lo, ph_hi = p_arg.ph_hi;
    if (threadIdx.x == 0) {
        const unsigned x = xcc_id();
        const unsigned bi = __hip_atomic_fetch_add((unsigned*)(p_arg.ws + WS_CTL) + x, 1u, __ATOMIC_RELAXED, __HIP_MEMORY_SCOPE_AGENT);
        *(LAS unsigned*)(lds + LDS_BYTES - 16) = x; *(LAS unsigned*)(lds + LDS_BYTES - 12) = bi;
        *(LAS unsigned*)(lds + LDS_BYTES - 32) = 0u; *(LAS unsigned*)(lds + LDS_BYTES - 28) = 0u;
        (void)xb_add((unsigned*)(p_arg.ws + WS_CTL + 256) + XB_XCNT(x), 1u);
    }
    __syncthreads();
    XcdBarrier xbar; xbar.bar = (unsigned*)(p_arg.ws + WS_CTL + 256); xbar.x = *(const LAS unsigned*)(lds + LDS_BYTES - 16); xbar.st = (volatile LAS unsigned*)(lds + LDS_BYTES - 32);
#ifndef PMASK
#define PMASK 0xff
#endif
#define EN(k) ((PMASK >> (k)) & 1)
    for (int ph = ph_lo; ph < ph_hi; ++ph) {
        KP kp = (KP)__builtin_amdgcn_kernarg_segment_ptr();
        asm volatile("" : "+s"(kp));
#if defined(__HIP_DEVICE_COMPILE__)
        const Params p = *kp;
#else
        const Params p = p_arg;
#endif
        unsigned char* ws = p.ws;
        const float* mod = (const float*)(ws + WS_MOD);
        int kind, l = 0, s = -1;
        if (ph == PH_CONV) kind = 0;
        else if (ph == PH_N1) kind = 1;
        else {
            l = (ph - PH_L0) / PH_PER_LAYER; s = (ph - PH_L0) % PH_PER_LAYER;
            kind = (s == 0 || s == 3 || s == 5) ? 2 : (s == 1 ? 4 : (s == 2 ? 5 : (s == 4 ? 1 : (s == 6 ? 6 : (s == 7 ? 7 : (s == 8 ? 8 : 9))))));
        }
        const float* modl = mod + (size_t)l * NB * 6 * DM;
        const float* xin = l == 0 ? p.x : p.out;
        float* x1 = (float*)(ws + WS_X1);
#ifndef REPEAT_KIND
#define REPEAT_KIND -1
#endif
        for (int rep = 0; rep < ((kind == REPEAT_KIND) ? 2 : 1); ++rep) {
        if (rep == 1) xcd_barrier(xbar);
        if (kind == 0) { if (EN(0)) phase_conv(p, lds); }
        else if (kind == 1) {
            if (EN(1)) {
                if (s < 0) phase_norm2<0>(p.x, nullptr, p.n1g, mod + 0 * DM, mod + 1 * DM, (f16*)(ws + WS_H), nullptr, nullptr);
                else phase_norm2<1>(x1, nullptr, p.n2g + (size_t)l * DM, modl + 3 * DM, modl + 4 * DM, (f16*)(ws + WS_H), (unsigned*)(ws + WS_H8), (float*)(ws + WS_SH));
            }
        } else if (kind == 2) {
            if (EN(2)) {
                Epi E{}; const f16* A; const f16* Bt; int N;
                if (s == 0) { E.mode = 2; E.rope128 = (const float*)(ws + WS_ROPE128); E.rope64 = (const float*)(ws + WS_ROPE64); E.o16 = (f16*)(ws + WS_PROJ); E.ldc = INWP; A = (const f16*)(ws + WS_H); Bt = (const f16*)(ws + WS_WTIN) + (size_t)l * INWP * DM; N = INWP; }
                else if (s == 3) { E.mode = 1; E.o32 = x1; E.xin = xin; E.gate = modl + 2 * DM; A = (const f16*)(ws + WS_Y); Bt = (const f16*)(ws + WS_WTOUT) + (size_t)l * DM * DM; N = DM; }
                else { E.mode = 0; E.o16 = (f16*)(ws + WS_Y); E.ldc = DM; A = (const f16*)(ws + WS_H); Bt = (const f16*)(ws + WS_WTQ) + (size_t)l * DM * DM; N = DM; }
                gemm_run(p, lds, A, Bt, N, E);
            }
        } else if (kind == 3) { if (EN(3)) phase_rope(p); }
        else if (kind == 4) { if (EN(4)) phase_index2(p, lds); }
        else if (kind == 5) { if (EN(5)) phase_attn2(p, lds, p.ong + (size_t)l * DM); }
        else if (kind == 6) { if (EN(6)) phase_route2(p, lds, (const f16*)(ws + WS_SUBK) + (size_t)l * PH * 2 * PNK * 128); }
        else if (kind == 7) {
            if (EN(7)) phase_exu(p, lds, ws + WS_U8 + (size_t)l * PEXP * DM, (const float*)(ws + WS_SU) + (size_t)l * PEXP, (const float*)(ws + WS_SV) + (size_t)l * PEXP);
        } else if (kind == 8) {
            if (EN(7)) phase_exv(p, lds, x1, modl + 5 * DM, ws + WS_V8 + (size_t)l * PEXP * DM, p.out);
        } else {
            const bool fin = (l == DEPTH - 1);
            const float* modn = mod + (size_t)(fin ? l : l + 1) * NB * 6 * DM;
            if (EN(1)) { if (fin) phase_norm2<2>(nullptr, p.out, p.fg, nullptr, nullptr, nullptr, nullptr, nullptr);
                         else phase_norm2<0>(p.out, nullptr, p.n1g + (size_t)(l + 1) * DM, modn + 0 * DM, modn + 1 * DM, (f16*)(ws + WS_H), nullptr, nullptr); }
        }
        }
        if (ph + 1 < ph_hi) { if (ph == ph_lo) cg::this_grid().sync(); else xcd_barrier(xbar); }
    }
}

extern "C" void kernel_launch(void* const* d_in, const int* in_sizes, int n_in, void* d_out, int out_size, void* d_ws, size_t ws_size, hipStream_t stream) {
    static int grid = 0;
    if (grid == 0) {
        if (n_in != 14 || out_size != NT * DM || ws_size < WS_END) { fprintf(stderr, "kernel_launch: unexpected sizes (n_in %d out %d ws %zu need %zu)\n", n_in, out_size, ws_size, (size_t)WS_END); grid = -1; return; }
        if (hipFuncSetAttribute((const void*)mega, hipFuncAttributeMaxDynamicSharedMemorySize, LDS_BYTES) != hipSuccess) { fprintf(stderr, "kernel_launch: hipFuncSetAttribute failed\n"); grid = -1; return; }
        int dev = 0, cus = 0, per_cu = 0;
        hipGetDevice(&dev); hipDeviceGetAttribute(&cus, hipDeviceAttributeMultiprocessorCount, dev);
        hipOccupancyMaxActiveBlocksPerMultiprocessor(&per_cu, (const void*)mega, NTHREADS, LDS_BYTES);
        if (per_cu < 1) { fprintf(stderr, "kernel_launch: occupancy query says %d blocks per CU\n", per_cu); grid = -1; return; }
        grid = cus;
    }
    if (grid < 0) return;
    Params p{};
    p.x = (const float*)d_in[0]; p.c = (const float*)d_in[1]; p.ada_w = (const float*)d_in[2]; p.ada_b = (const float*)d_in[3];
    p.n1g = (const float*)d_in[4]; p.n2g = (const float*)d_in[5]; p.w_in = (const float*)d_in[6]; p.ong = (const float*)d_in[7];
    p.w_out = (const float*)d_in[8]; p.wq = (const float*)d_in[9]; p.subk = (const float*)d_in[10]; p.pu = (const float*)d_in[11];
    p.pv = (const float*)d_in[12]; p.fg = (const float*)d_in[13];
    p.out = (float*)d_out; p.ws = (unsigned char*)d_ws;
#if 0
    for (int ph = 0; ph < PH_TOTAL; ++ph) {
        p.ph_lo = ph; p.ph_hi = ph + 1;
        hipLaunchKernelGGL(mega, dim3(grid), dim3(NTHREADS), LDS_BYTES, stream, p);
    }
#else
    p.ph_lo = 0; p.ph_hi = PH_TOTAL;
    if (hipMemsetAsync((char*)d_ws + WS_CTL, 0, CTL_BYTES, stream) != hipSuccess) { fprintf(stderr, "kernel_launch: memset of control words failed\n"); return; }
    void* args[] = {&p};
    hipError_t e = hipLaunchCooperativeKernel((const void*)mega, dim3(grid), dim3(NTHREADS), args, LDS_BYTES, stream);
    if (e != hipSuccess) fprintf(stderr, "cooperative launch failed: %s (grid %d)\n", hipGetErrorString(e), grid);
#endif
}
```

```cpp
#include <hip/hip_runtime.h>
#include <hip/hip_cooperative_groups.h>
#include <cstdio>
#include <cstdint>
namespace cg = cooperative_groups;

#define LAS __attribute__((address_space(3)))
typedef _Float16 f16;
typedef _Float16 h2_t __attribute__((ext_vector_type(2)));
typedef _Float16 h4_t __attribute__((ext_vector_type(4)));
typedef _Float16 h8_t __attribute__((ext_vector_type(8)));
typedef float f32x4 __attribute__((ext_vector_type(4)));
typedef unsigned u32x4 __attribute__((ext_vector_type(4)));
typedef unsigned u32x2 __attribute__((ext_vector_type(2)));

constexpr int NB = 8, SEQ = 2048, DM = 2048, NT = NB * SEQ, DEPTH = 2;
constexpr int HD = 128, HA = 6, HB = 5, HC = 5, NHEADS = 16;
constexpr int IH = 16, IDM = 64, DSA_TOPK = 256;
constexpr int MOBA_BLK = 256, MOBA_NB = 8;
constexpr int INW = 5968, INWP = 6144;
constexpr int PH = 8, PNK = 128, PTOPK = 16, PEXP = 16384;
constexpr float EPS = 1e-6f;
constexpr int C_QA = 0, C_KA = 768, C_VA = 896, C_IQ = 1024, C_IK = 2048, C_IW = 2112, C_QB = 2176, C_KB = 2816, C_VB = 3456,
              C_QC = 4096, C_KC = 4736, C_VC = 5376, C_END = 6016;

constexpr int NTHREADS = 512, NWAVES = 8;
constexpr int LDS_BYTES = 147456;

constexpr size_t al256(size_t x) { return (x + 255) & ~(size_t)255; }
constexpr size_t WS_WTIN = 0;
constexpr size_t WS_WTOUT = WS_WTIN + (size_t)DEPTH * INWP * DM * 2;
constexpr size_t WS_WTQ = WS_WTOUT + (size_t)DEPTH * DM * DM * 2;
constexpr size_t WS_U8 = WS_WTQ + (size_t)DEPTH * DM * DM * 2;
constexpr size_t WS_V8 = WS_U8 + (size_t)DEPTH * PEXP * DM;
constexpr size_t WS_SU = WS_V8 + (size_t)DEPTH * PEXP * DM;
constexpr size_t WS_SV = WS_SU + (size_t)DEPTH * PEXP * 4;
constexpr size_t WS_H8 = WS_SV + (size_t)DEPTH * PEXP * 4;
constexpr size_t WS_SH = WS_H8 + (size_t)NT * DM;
constexpr size_t WS_SUBK = WS_SH + (size_t)NT * 4;
constexpr size_t WS_MOD = WS_SUBK + (size_t)DEPTH * PH * 2 * PNK * 128 * 2;
constexpr size_t WS_ROPE128 = WS_MOD + (size_t)DEPTH * NB * 6 * DM * 4;
constexpr size_t WS_ROPE64 = WS_ROPE128 + (size_t)SEQ * 64 * 8;
constexpr size_t WS_H = WS_ROPE64 + (size_t)SEQ * 32 * 8;
constexpr size_t WS_PROJ = WS_H + (size_t)NT * DM * 2;
constexpr size_t WS_KMEAN = WS_PROJ + (size_t)NT * INWP * 2;
constexpr size_t WS_MASK = WS_KMEAN + al256((size_t)NB * HC * MOBA_NB * HD * 4);
constexpr size_t WS_Y = WS_MASK + (size_t)NB * SEQ * 64 * 4;
constexpr size_t WS_X1 = WS_Y + (size_t)NT * DM * 2;
constexpr size_t WS_PE = WS_X1 + (size_t)NT * DM * 4;
constexpr size_t WS_PG = WS_PE + (size_t)NT * 128 * 4;
constexpr size_t WS_LIST = WS_PG + (size_t)NT * 128 * 4;
constexpr size_t WS_CTL = WS_LIST + (size_t)NT * 128 * 4;
constexpr size_t CTL_BYTES = 16384;
constexpr size_t WS_END = WS_CTL + CTL_BYTES;

struct Params {
    const float *x, *c, *ada_w, *ada_b, *n1g, *n2g, *w_in, *ong, *w_out, *wq, *subk, *pu, *pv, *fg;
    float* out;
    unsigned char* ws;
    int ph_lo, ph_hi;
};

__device__ __forceinline__ int otid() { int t = threadIdx.x; asm volatile("" : "+v"(t)); return t; }
__device__ __forceinline__ int obid() { int t = blockIdx.x; asm volatile("" : "+s"(t)); return t; }
__device__ __forceinline__ float wave_sum(float v) {
#pragma unroll
    for (int o = 32; o >= 1; o >>= 1) v += __shfl_xor(v, o);
    return v;
}
__device__ __forceinline__ float wave_max(float v) {
#pragma unroll
    for (int o = 32; o >= 1; o >>= 1) v = fmaxf(v, __shfl_xor(v, o));
    return v;
}
__device__ __forceinline__ unsigned pack_h2(float a, float b) { h2_t r; r.x = (f16)a; r.y = (f16)b; return __builtin_bit_cast(unsigned, r); }
__device__ __forceinline__ float h_lo(unsigned u) { h2_t r = __builtin_bit_cast(h2_t, u); return (float)r.x; }
__device__ __forceinline__ float h_hi(unsigned u) { h2_t r = __builtin_bit_cast(h2_t, u); return (float)r.y; }
__device__ __forceinline__ float dot2(unsigned a, unsigned b, float c) {
    return __builtin_amdgcn_fdot2(__builtin_bit_cast(h2_t, a), __builtin_bit_cast(h2_t, b), c, false);
}

namespace pg8 {
constexpr int BM = 256, BK = 64, HALF = 128, HTB = HALF * BK * 2, STAGE_BYTES = 8 * HTB, NXCD = 8, WGM = 8;
__host__ __device__ __forceinline__ int lds_byte(int r, int c) { const int st = (r >> 4) * 2 + (c >> 5), rr = r & 15, cc = c & 31, ob = rr * 64 + cc * 2; return st * 1024 + (ob ^ (((ob >> 9) & 1) << 5)); }
__host__ __device__ __forceinline__ void stage_rc(int b, int& R, int& C) { const int st = b / 1024, sb = b % 1024, swz = sb ^ (((sb >> 9) & 1) << 5); R = (st >> 1) * 16 + swz / 64; C = (st & 1) * 32 + (swz % 64) / 2; }
struct Unit { int pm, pn; };
struct Gemm { const unsigned short* A; const unsigned short* Bt; int M, N, K; };
struct StaticOrder {
    int nM, nN, nwg, G, c;
    __host__ __device__ void init(int M, int N, int G_, int c_) { nM = M / BM; nN = N / BM; nwg = nM * nN; G = G_; c = c_; }
    __host__ __device__ bool next(int i, Unit& u) const {
        const long L = (long)i * G + c; if (L >= nwg) return false;
        int wgid = (int)L; { const int q = nwg / NXCD, r = nwg % NXCD, xcd = wgid % NXCD, off = wgid / NXCD; wgid = (xcd < r ? xcd * (q + 1) : r * (q + 1) + (xcd - r) * q) + off; }
        const int nig = WGM * nN, gid = wgid / nig, fm = gid * WGM, gsz = (nM - fm) < WGM ? (nM - fm) : WGM;
        u.pm = fm + ((wgid % nig) % gsz); u.pn = (wgid % nig) / gsz; return true;
    }
};

template <class Epi>
__device__ __forceinline__ void gemm_phase(LAS unsigned char* lds, const Gemm g, const StaticOrder& S, const Epi& E) {
    const int tid = otid(), wid = __builtin_amdgcn_readfirstlane(tid >> 6), lane = tid & 63, wr = wid >> 2, wc = wid & 3, fr = lane & 15, fq = lane >> 4;
    const int K = g.K, nt = K / BK;
    unsigned voffA[2], voffB[2];
#pragma unroll
    for (int i = 0; i < 2; ++i) { int R, C; stage_rc(tid * 16 + i * 8192, R, C); voffA[i] = (unsigned)(R * K + C) * 2u; voffB[i] = (unsigned)(R * K + C) * 2u; }
    const size_t kstep = (size_t)(BK * 2);
    const size_t hstep = (size_t)HALF * K * 2;
    const size_t tstep = 2 * hstep;
    const unsigned ldsw = (unsigned)wid * 1024u;
    const int aoff = lds_byte(wr * 64 + fr, fq * 8), boff = lds_byte(wc * 32 + fr, fq * 8);
#define PG8_SA(b, h) (((b) * 2 + (h)) * HTB)
#define PG8_SB(b, h) ((4 + (b) * 2 + (h)) * HTB)
#define PG8_STAGE(bufoff, gbase, voff) do { _Pragma("unroll") for (int _i = 0; _i < 2; ++_i) \
        __builtin_amdgcn_global_load_lds((const unsigned*)((const char*)(gbase) + (voff)[_i]), (LAS unsigned*)(lds + (bufoff) + ldsw + _i * 8192), 16, 0, 0); } while (0)
#define PG8_LDA(dst, b, h) do { _Pragma("unroll") for (int m = 0; m < 4; ++m) _Pragma("unroll") for (int k = 0; k < 2; ++k) dst[m][k] = *(const LAS h8_t*)(lds + PG8_SA(b, h) + aoff + m * 2048 + k * 1024); } while (0)
#define PG8_LDB(dst, b, h) do { _Pragma("unroll") for (int n = 0; n < 2; ++n) _Pragma("unroll") for (int k = 0; k < 2; ++k) dst[n][k] = *(const LAS h8_t*)(lds + PG8_SB(b, h) + boff + n * 2048 + k * 1024); } while (0)
#define PG8_MMA(ai, bj, At, Bt) do { __builtin_amdgcn_s_setprio(1); _Pragma("unroll") for (int m = 0; m < 4; ++m) _Pragma("unroll") for (int n = 0; n < 2; ++n) _Pragma("unroll") for (int k = 0; k < 2; ++k) \
        acc[ai][bj][m][n] = __builtin_amdgcn_mfma_f32_16x16x32_f16(Bt[n][k], At[m][k], acc[ai][bj][m][n], 0, 0, 0); __builtin_amdgcn_s_setprio(0); } while (0)
#define PG8_WAIT_V(n) asm volatile("s_waitcnt vmcnt(" #n ")" ::: "memory")
#define PG8_WAIT_L(n) asm volatile("s_waitcnt lgkmcnt(" #n ")" ::: "memory")
#define PG8_BAR __builtin_amdgcn_s_barrier()
#define PG8_SCHED __builtin_amdgcn_sched_barrier(0)
    Unit cur, nxt; int ui = 0;
    if (!S.next(0, cur)) return;
    f32x4 acc[2][2][4][2];
#pragma unroll
    for (int a = 0; a < 2; ++a)
#pragma unroll
        for (int b = 0; b < 2; ++b)
#pragma unroll
            for (int m = 0; m < 4; ++m)
#pragma unroll
                for (int n = 0; n < 2; ++n) acc[a][b][m][n] = (f32x4){0.f, 0.f, 0.f, 0.f};
    h8_t At[4][2], B0[2][2], B1[2][2];
    const char* cA = (const char*)g.A + (size_t)cur.pm * tstep; const char* cB = (const char*)g.Bt + (size_t)cur.pn * tstep;
    PG8_STAGE(PG8_SB(0, 0), cB, voffB); PG8_STAGE(PG8_SA(0, 0), cA, voffA); PG8_STAGE(PG8_SB(0, 1), cB + hstep, voffB); PG8_STAGE(PG8_SA(0, 1), cA + hstep, voffA);
    if (wr == 1) PG8_BAR;
    PG8_WAIT_V(4); PG8_BAR;
    PG8_STAGE(PG8_SB(1, 0), cB + kstep, voffB); PG8_STAGE(PG8_SA(1, 0), cA + kstep, voffA); PG8_STAGE(PG8_SB(1, 1), cB + hstep + kstep, voffB);
    PG8_WAIT_V(6); PG8_BAR;
    for (;;) {
        const bool has_next = S.next(ui + 1, nxt);
        const char* nA = has_next ? (const char*)g.A + (size_t)nxt.pm * tstep : cA; const char* nB = has_next ? (const char*)g.Bt + (size_t)nxt.pn * tstep : cB;
        for (int t = 0; t < nt; t += 2) {
            const bool last = (t == nt - 2);
            const char* a1 = cA + (size_t)(t + 1) * kstep;
            const char* a2 = last ? nA : cA + (size_t)(t + 2) * kstep; const char* b2 = last ? nB : cB + (size_t)(t + 2) * kstep;
            const char* a3 = a2 + kstep; const char* b3 = b2 + kstep;
            PG8_LDB(B0, 0, 0); PG8_SCHED; PG8_LDA(At, 0, 0); PG8_STAGE(PG8_SA(1, 1), a1 + hstep, voffA);
            PG8_WAIT_L(8); PG8_BAR; PG8_WAIT_L(0); PG8_MMA(0, 0, At, B0); PG8_BAR; PG8_SCHED;
            PG8_LDB(B1, 0, 1); PG8_STAGE(PG8_SB(0, 0), b2, voffB);
            PG8_BAR; PG8_WAIT_L(0); PG8_MMA(0, 1, At, B1); PG8_BAR;
            PG8_LDA(At, 0, 1); PG8_STAGE(PG8_SA(0, 0), a2, voffA);
            PG8_BAR; PG8_WAIT_L(0); PG8_MMA(1, 0, At, B0); PG8_BAR; PG8_SCHED;
            PG8_STAGE(PG8_SB(0, 1), b2 + hstep, voffB);
            PG8_WAIT_V(6); PG8_BAR; PG8_MMA(1, 1, At, B1); PG8_BAR;
            PG8_LDB(B0, 1, 0); PG8_SCHED; PG8_LDA(At, 1, 0); PG8_STAGE(PG8_SA(0, 1), a2 + hstep, voffA);
            PG8_WAIT_L(8); PG8_BAR; PG8_WAIT_L(0); PG8_MMA(0, 0, At, B0); PG8_BAR; PG8_SCHED;
            PG8_LDB(B1, 1, 1); PG8_STAGE(PG8_SB(1, 0), b3, voffB);
            PG8_BAR; PG8_WAIT_L(0); PG8_MMA(0, 1, At, B1); PG8_BAR;
            PG8_LDA(At, 1, 1); PG8_STAGE(PG8_SA(1, 0), a3, voffA);
            PG8_BAR; PG8_WAIT_L(0); PG8_MMA(1, 0, At, B0); PG8_BAR; PG8_SCHED;
            PG8_STAGE(PG8_SB(1, 1), b3 + hstep, voffB);
            PG8_WAIT_V(6); PG8_BAR; PG8_MMA(1, 1, At, B1); PG8_BAR;
        }
        E(acc, cur, wr, wc, fr, fq);
        if (!has_next) break;
#pragma unroll
        for (int a = 0; a < 2; ++a)
#pragma unroll
            for (int b = 0; b < 2; ++b)
#pragma unroll
                for (int m = 0; m < 4; ++m)
#pragma unroll
                    for (int n = 0; n < 2; ++n) acc[a][b][m][n] = (f32x4){0.f, 0.f, 0.f, 0.f};
        cur = nxt; cA = nA; cB = nB; ++ui;
    }
    PG8_WAIT_V(0);
    if (wr == 0) PG8_BAR;
    PG8_BAR;
#undef PG8_SA
#undef PG8_SB
#undef PG8_STAGE
#undef PG8_LDA
#undef PG8_LDB
#undef PG8_MMA
#undef PG8_WAIT_V
#undef PG8_WAIT_L
#undef PG8_BAR
#undef PG8_SCHED
}
}

__device__ __forceinline__ int win_src_col_l(int pc) { return pc < 2128 ? pc : (pc < C_QB ? -1 : (pc < C_END ? pc - 48 : -1)); }
__device__ __forceinline__ int rope_type(int g) { return (g <= 6 || (g >= 32 && g <= 41)) ? 1 : ((g >= 8 && g <= 15) ? 2 : (g == 16 ? 3 : 0)); }
__device__ __forceinline__ int win_src_col(int pc) {
    const int g = pc >> 7, p = pc & 127, ty = rope_type(g);
    int l = p;
    if (ty == 1) { const int q4 = p >> 2, e = p & 3; l = 2 * q4 + (e >> 1) + 64 * (e & 1); }
    else if (ty == 2 || (ty == 3 && p < 64)) { const int hb = p >> 6, pp = p & 63, q4 = pp >> 2, e = pp & 3; l = hb * 64 + 2 * q4 + (e >> 1) + 32 * (e & 1); }
    return win_src_col_l(g * 128 + l);
}


struct Epi {
    int mode; f16* o16; int ldc; float* o32; const float* xin; const float* gate; const float* rope128; const float* rope64;
    __device__ __forceinline__ void operator()(const f32x4 (&acc)[2][2][4][2], const pg8::Unit& u, int wr, int wc, int fr, int fq) const {
        const int row0 = u.pm * 256 + wr * 64 + fr, col0 = u.pn * 256 + wc * 32 + 4 * fq;
        if (mode == 2) {
#pragma unroll
            for (int bj = 0; bj < 2; ++bj) {
                const int g = __builtin_amdgcn_readfirstlane(u.pn * 2 + bj);
                int ty = rope_type(g); if (ty == 3) ty = (wc < 2) ? 2 : 0;
                f16* ob = o16 + (size_t)g * 128;
                if (ty == 0) {
#pragma unroll
                    for (int ai = 0; ai < 2; ++ai)
#pragma unroll
                        for (int m = 0; m < 4; ++m)
#pragma unroll
                            for (int n = 0; n < 2; ++n) {
                                const f32x4 v = acc[ai][bj][m][n];
                                u32x2 w; w.x = pack_h2(v[0], v[1]); w.y = pack_h2(v[2], v[3]);
                                *(u32x2*)(ob + (size_t)(row0 + ai * 128 + m * 16) * ldc + wc * 32 + n * 16 + 4 * fq) = w;
                            }
                } else {
                    const float* tab = ty == 1 ? rope128 : rope64;
                    const int half = ty == 1 ? 64 : 32, tw = ty == 1 ? 128 : 64;
#pragma unroll
                    for (int ai = 0; ai < 2; ++ai)
#pragma unroll
                        for (int m = 0; m < 4; ++m) {
                            const int row = row0 + ai * 128 + m * 16, pos = row & (SEQ - 1);
#pragma unroll
                            for (int n = 0; n < 2; ++n) {
                                const int p = wc * 32 + n * 16 + 4 * fq;
                                const int j = ty == 1 ? (p >> 1) : ((p & 63) >> 1), base = ty == 1 ? 0 : (p & 64);
                                const f32x4 cs = *(const f32x4*)(tab + (size_t)pos * tw + 2 * j);
                                const f32x4 v = acc[ai][bj][m][n];
                                const float o1a = v[0] * cs[0] - v[1] * cs[1], o2a = v[1] * cs[0] + v[0] * cs[1];
                                const float o1b = v[2] * cs[2] - v[3] * cs[3], o2b = v[3] * cs[2] + v[2] * cs[3];
                                f16* op = ob + (size_t)row * ldc + base + j;
                                *(unsigned*)op = pack_h2(o1a, o1b); *(unsigned*)(op + half) = pack_h2(o2a, o2b);
                            }
                        }
                }
            }
            return;
        }
#pragma unroll
        for (int ai = 0; ai < 2; ++ai)
#pragma unroll
            for (int m = 0; m < 4; ++m) {
                const int row = row0 + ai * 128 + m * 16;
#pragma unroll
                for (int bj = 0; bj < 2; ++bj)
#pragma unroll
                    for (int n = 0; n < 2; ++n) {
                        const int col = col0 + bj * 128 + n * 16;
                        const f32x4 v = acc[ai][bj][m][n];
                        if (mode == 0) {
                            u32x2 w; w.x = pack_h2(v[0], v[1]); w.y = pack_h2(v[2], v[3]);
                            *(u32x2*)(o16 + (size_t)row * ldc + col) = w;
                        } else {
                            const int b = row / SEQ;
                            const f32x4 xi = *(const f32x4*)(xin + (size_t)row * DM + col);
                            const f32x4 gt = *(const f32x4*)(gate + (size_t)b * 6 * DM + col);
                            *(f32x4*)(o32 + (size_t)row * DM + col) = xi + gt * v;
                        }
                    }
            }
    }
};

__device__ __forceinline__ void gemm_run(const Params& p, LAS unsigned char* lds, const f16* A, const f16* Bt, int N, const Epi& E) {
    pg8::Gemm g; g.A = (const unsigned short*)A; g.Bt = (const unsigned short*)Bt; g.M = NT; g.N = N; g.K = DM;
    pg8::StaticOrder S; S.init(NT, N, (int)gridDim.x, (int)blockIdx.x);
    pg8::gemm_phase<Epi>(lds, g, S, E);
}

__device__ __forceinline__ void transpose_tiles(const float* src, int ldsrc, int ncols_phys, bool is_win, f16* dst, float* tile  , int& unit_base, int unit_lo) {
    const int tn = ncols_phys / 64, tk = DM / 64, ntile = tn * tk;
    const int tid = otid();
    float cur[8], nxt[8];
#define TT_LOAD(R_, u_) do { const int n0_ = ((u_) % tn) * 64, k0_ = ((u_) / tn) * 64; \
        _Pragma("unroll") for (int i = 0; i < 8; ++i) { const int e = tid + i * 512, r = e >> 6, c = e & 63; const int pc = n0_ + c; const int sc = is_win ? win_src_col(pc) : pc; \
            R_[i] = sc >= 0 ? src[(size_t)(k0_ + r) * ldsrc + sc] : 0.f; } } while (0)
    int u = blockIdx.x;
    if (u < ntile) TT_LOAD(nxt, u);
    for (; u < ntile; u += gridDim.x) {
        const int n0 = (u % tn) * 64, k0 = (u / tn) * 64;
#pragma unroll
        for (int i = 0; i < 8; ++i) cur[i] = nxt[i];
        if (u + (int)gridDim.x < ntile) TT_LOAD(nxt, u + gridDim.x);
        __syncthreads();
#pragma unroll
        for (int i = 0; i < 8; ++i) { const int e = tid + i * 512, r = e >> 6, c = e & 63; tile[r * 65 + c] = cur[i]; }
        __syncthreads();
        {
            const int n = tid >> 3, kq = (tid & 7) * 8;
            u32x4 w;
            w.x = pack_h2(tile[(kq + 0) * 65 + n], tile[(kq + 1) * 65 + n]); w.y = pack_h2(tile[(kq + 2) * 65 + n], tile[(kq + 3) * 65 + n]);
            w.z = pack_h2(tile[(kq + 4) * 65 + n], tile[(kq + 5) * 65 + n]); w.w = pack_h2(tile[(kq + 6) * 65 + n], tile[(kq + 7) * 65 + n]);
            *(u32x4*)(dst + (size_t)(n0 + n) * DM + k0 + kq) = w;
        }
    }
#undef TT_LOAD
    (void)unit_base; (void)unit_lo;
}

__device__ __forceinline__ void cvt_f16_stream(const float* src, f16* dst, size_t n) {
    const size_t stride = (size_t)gridDim.x * NTHREADS;
    for (size_t i = (size_t)blockIdx.x * NTHREADS + otid(); i < n / 8; i += stride) {
        const f32x4 a = *(const f32x4*)(src + i * 8), b = *(const f32x4*)(src + i * 8 + 4);
        u32x4 w; w.x = pack_h2(a[0], a[1]); w.y = pack_h2(a[2], a[3]); w.z = pack_h2(b[0], b[1]); w.w = pack_h2(b[2], b[3]);
        *(u32x4*)(dst + i * 8) = w;
    }
}

__device__ __forceinline__ void quant_rows(const float* src, int nrows, unsigned* dst, float* scale, int bias) {
    const int tid_ = otid(); const int wid = tid_ >> 6, lane = tid_ & 63;
    const int rstep = gridDim.x * NWAVES;
    int row = blockIdx.x * NWAVES + wid;
    f32x4 v[8], nv[8];
    if (row < nrows) {
#pragma unroll
        for (int i = 0; i < 8; ++i) nv[i] = *(const f32x4*)(src + (size_t)row * DM + i * 256 + lane * 4);
    }
    for (; row < nrows; row += rstep) {
#pragma unroll
        for (int i = 0; i < 8; ++i) v[i] = nv[i];
        if (row + rstep < nrows) {
#pragma unroll
            for (int i = 0; i < 8; ++i) nv[i] = *(const f32x4*)(src + (size_t)(row + rstep) * DM + i * 256 + lane * 4);
        }
        float am = 0.f;
#pragma unroll
        for (int i = 0; i < 8; ++i) am = fmaxf(am, fmaxf(fmaxf(fabsf(v[i][0]), fabsf(v[i][1])), fmaxf(fabsf(v[i][2]), fabsf(v[i][3]))));
        am = wave_max(am);
        const float sc = am > 0.f ? am * (1.f / 127.f) : 1.f, inv = 1.f / sc;
        if (lane == 0) scale[row] = sc;
#pragma unroll
        for (int i = 0; i < 8; ++i) {
            unsigned w = 0u;
#pragma unroll
            for (int j = 0; j < 4; ++j) { const int q = (int)rintf(v[i][j] * inv) + bias; w |= ((unsigned)q & 255u) << (8 * j); }
            dst[(size_t)row * (DM / 4) + i * 64 + lane] = w;
        }
    }
}

constexpr int QV_STR = DM + 8;
__device__ __forceinline__ void quant_v_sliced(const float* src, unsigned char* dst, float* scale, LAS unsigned char* lds) {
    const int tid = otid(), wid = tid >> 6, lane = tid & 63;
    for (int blk = obid(); blk < DEPTH * PEXP / 64; blk += gridDim.x) {
        const int row0 = blk * 64, layer = row0 / PEXP, e0 = row0 % PEXP;
        __syncthreads();
        f32x4 nv[8];
#pragma unroll
        for (int i = 0; i < 8; ++i) nv[i] = *(const f32x4*)(src + (size_t)(row0 + wid) * DM + i * 256 + lane * 4);
        for (int rr = wid; rr < 64; rr += NWAVES) {
            f32x4 v[8]; float am = 0.f;
#pragma unroll
            for (int i = 0; i < 8; ++i) v[i] = nv[i];
            if (rr + NWAVES < 64) {
#pragma unroll
                for (int i = 0; i < 8; ++i) nv[i] = *(const f32x4*)(src + (size_t)(row0 + rr + NWAVES) * DM + i * 256 + lane * 4);
            }
#pragma unroll
            for (int i = 0; i < 8; ++i) am = fmaxf(am, fmaxf(fmaxf(fabsf(v[i][0]), fabsf(v[i][1])), fmaxf(fabsf(v[i][2]), fabsf(v[i][3]))));
            am = wave_max(am);
            const float sc = am > 0.f ? am * (1.f / 127.f) : 1.f, inv = 1.f / sc;
            if (lane == 0) scale[row0 + rr] = sc;
#pragma unroll
            for (int i = 0; i < 8; ++i) {
                unsigned w = 0u;
#pragma unroll
                for (int j = 0; j < 4; ++j) { const int q = (int)rintf(v[i][j] * inv) + 128; w |= ((unsigned)q & 255u) << (8 * j); }
                *(LAS unsigned*)(lds + rr * QV_STR + i * 256 + lane * 4) = w;
            }
        }
        __syncthreads();
        for (int c = wid; c < 256; c += NWAVES) {
            const u32x2 w = *(const LAS u32x2*)(lds + lane * QV_STR + c * 8);
            *(u32x2*)(dst + (((size_t)layer * 256 + c) * PEXP + e0 + lane) * 8) = w;
        }
    }
}

__device__ __forceinline__ void phase_conv(const Params& p, LAS unsigned char* lds_) {
    float* smem = (float*)(unsigned char*)lds_;
    unsigned char* ws = p.ws;
    const int tid = otid();
    int dummy = 0;
    {
        float* cond = smem;
        float* red = smem + NB * DM;
        for (int i = tid; i < NB * DM; i += NTHREADS) { const float v = p.c[i]; cond[i] = v / (1.f + __expf(-v)); }
        __syncthreads();
        for (int u = blockIdx.x; u < DEPTH * 128; u += gridDim.x) {
            const int l = u >> 7, j0 = (u & 127) * 96;
            const int c4 = tid % 24, kg = tid / 24;
            if (kg < 21) {
                f32x4 acc[NB];
#pragma unroll
                for (int b = 0; b < NB; ++b) acc[b] = (f32x4){0.f, 0.f, 0.f, 0.f};
                const float* wp = p.ada_w + (size_t)l * DM * 6 * DM + j0 + 4 * c4;
#pragma unroll 1
                for (int i0 = 0; i0 < 98; i0 += 7) {
                    f32x4 w[7];
#pragma unroll
                    for (int i = 0; i < 7; ++i) { const int k = kg + 21 * (i0 + i); w[i] = k < DM ? *(const f32x4*)(wp + (size_t)k * 6 * DM) : (f32x4){0.f, 0.f, 0.f, 0.f}; }
#pragma unroll
                    for (int i = 0; i < 7; ++i) { const int k = kg + 21 * (i0 + i); const int kk = k < DM ? k : 0;
#pragma unroll
                        for (int b = 0; b < NB; ++b) acc[b] += w[i] * cond[b * DM + kk]; }
                }
#pragma unroll
                for (int b = 0; b < NB; ++b) *(f32x4*)(red + (kg * NB + b) * 96 + 4 * c4) = acc[b];
            }
            __syncthreads();
            for (int i = tid; i < NB * 96; i += NTHREADS) {
                const int b = i / 96, cc = i % 96;
                float sacc = p.ada_b[(size_t)l * 6 * DM + j0 + cc];
#pragma unroll
                for (int g = 0; g < 21; ++g) sacc += red[(g * NB + b) * 96 + cc];
                ((float*)(ws + WS_MOD))[((size_t)l * NB + b) * 6 * DM + j0 + cc] = sacc;
            }
            __syncthreads();
        }
    }
    {
        float2* r128 = (float2*)(ws + WS_ROPE128); float2* r64 = (float2*)(ws + WS_ROPE64);
        for (int i = blockIdx.x * NTHREADS + tid; i < SEQ * 64; i += gridDim.x * NTHREADS) {
            const int pos = i >> 6, j = i & 63;
            const float inv = powf(10000.f, -(float)j / 64.f); const float ang = (float)pos * inv;
            r128[i] = make_float2((float)cos((double)ang), (float)sin((double)ang));
        }
        for (int i = blockIdx.x * NTHREADS + tid; i < SEQ * 32; i += gridDim.x * NTHREADS) {
            const int pos = i >> 5, j = i & 31;
            const float inv = powf(10000.f, -(float)j / 32.f); const float ang = (float)pos * inv;
            r64[i] = make_float2((float)cos((double)ang), (float)sin((double)ang));
        }
    }
    __syncthreads();
    for (int l = 0; l < DEPTH; ++l) {
        transpose_tiles(p.w_in + (size_t)l * DM * INW, INW, INWP, true, (f16*)(ws + WS_WTIN) + (size_t)l * INWP * DM, smem, dummy, 0);
        transpose_tiles(p.w_out + (size_t)l * DM * DM, DM, DM, false, (f16*)(ws + WS_WTOUT) + (size_t)l * DM * DM, smem, dummy, 0);
        transpose_tiles(p.wq + (size_t)l * DM * DM, DM, DM, false, (f16*)(ws + WS_WTQ) + (size_t)l * DM * DM, smem, dummy, 0);
    }
    quant_rows(p.pu, DEPTH * PEXP, (unsigned*)(ws + WS_U8), (float*)(ws + WS_SU), 0);
    quant_v_sliced(p.pv, ws + WS_V8, (float*)(ws + WS_SV), lds_);
    cvt_f16_stream(p.subk, (f16*)(ws + WS_SUBK), (size_t)DEPTH * PH * 2 * PNK * 128);
}

__device__ __forceinline__ void phase_norm(const Params& p, const float* xin, const float* g, const float* shift, const float* scale, f16* hout, unsigned* h8 = nullptr, float* sh8 = nullptr) {
    const int tid_ = otid(); const int wid = tid_ >> 6, lane = tid_ & 63;
    for (int row = blockIdx.x * NWAVES + wid; row < NT; row += gridDim.x * NWAVES) {
        const int b = row / SEQ;
        const float* xr = xin + (size_t)row * DM;
        f32x4 v[8]; float ss = 0.f;
#pragma unroll
        for (int i = 0; i < 8; ++i) { v[i] = *(const f32x4*)(xr + i * 256 + lane * 4); ss += v[i][0] * v[i][0] + v[i][1] * v[i][1] + v[i][2] * v[i][2] + v[i][3] * v[i][3]; }
        ss = wave_sum(ss);
        const float rstd = rsqrtf(ss * (1.f / DM) + EPS);
#pragma unroll
        for (int i = 0; i < 8; ++i) {
            const int col = i * 256 + lane * 4;
            const f32x4 gg = *(const f32x4*)(g + col), sh = *(const f32x4*)(shift + (size_t)b * 6 * DM + col), sc = *(const f32x4*)(scale + (size_t)b * 6 * DM + col);
            f32x4 y = v[i] * rstd * gg * (sc + 1.f) + sh;
            u32x2 w; w.x = pack_h2(y[0], y[1]); w.y = pack_h2(y[2], y[3]);
            *(u32x2*)(hout + (size_t)row * DM + col) = w;
            v[i] = y;
        }
        if (h8) {
            float am = 0.f;
#pragma unroll
            for (int i = 0; i < 8; ++i) am = fmaxf(am, fmaxf(fmaxf(fabsf(v[i][0]), fabsf(v[i][1])), fmaxf(fabsf(v[i][2]), fabsf(v[i][3]))));
            am = wave_max(am);
            const float qs = am > 0.f ? am * (1.f / 127.f) : 1.f, inv = 1.f / qs;
            if (lane == 0) sh8[row] = qs;
#pragma unroll
            for (int i = 0; i < 8; ++i) {
                unsigned w = 0u;
#pragma unroll
                for (int j = 0; j < 4; ++j) { const int q = (int)rintf(v[i][j] * inv); w |= ((unsigned)q & 255u) << (8 * j); }
                h8[(size_t)row * (DM / 4) + i * 64 + lane] = w;
            }
        }
    }
}

template <int MODE>
__device__ __forceinline__ void phase_norm2(const float* xin, float* xio, const float* g, const float* shift, const float* scale, f16* hout, unsigned* h8, float* sh8) {
    const int tid_ = otid(); const int wid = tid_ >> 6, lane = tid_ & 63;
    for (int r0 = (blockIdx.x * NWAVES + wid) * 8; r0 < NT; r0 += gridDim.x * NWAVES * 8) {
        const int b = r0 / SEQ;
        f32x4 gm[8], sh[8];
#pragma unroll
        for (int i = 0; i < 8; ++i) {
            const int col = i * 256 + lane * 4;
            gm[i] = *(const f32x4*)(g + col);
            if (MODE != 2) { gm[i] = gm[i] * (*(const f32x4*)(scale + (size_t)b * 6 * DM + col) + 1.f); sh[i] = *(const f32x4*)(shift + (size_t)b * 6 * DM + col); }
        }
        const float* xb = (MODE == 2 ? (const float*)xio : xin) + (size_t)r0 * DM + lane * 4;
        f32x4 v[8], nv[8];
#pragma unroll
        for (int i = 0; i < 8; ++i) nv[i] = *(const f32x4*)(xb + i * 256);
#pragma unroll 1
        for (int k = 0; k < 8; ++k) {
            const int row = r0 + k;
#pragma unroll
            for (int i = 0; i < 8; ++i) v[i] = nv[i];
            if (k < 7) {
#pragma unroll
                for (int i = 0; i < 8; ++i) nv[i] = *(const f32x4*)(xb + (size_t)(k + 1) * DM + i * 256);
            }
            float ss = 0.f;
#pragma unroll
            for (int i = 0; i < 8; ++i) ss += v[i][0] * v[i][0] + v[i][1] * v[i][1] + v[i][2] * v[i][2] + v[i][3] * v[i][3];
            ss = wave_sum(ss);
            const float rstd = rsqrtf(ss * (1.f / DM) + EPS);
            float am = 0.f;
#pragma unroll
            for (int i = 0; i < 8; ++i) {
                const int col = i * 256 + lane * 4;
                if (MODE == 2) { *(f32x4*)(xio + (size_t)row * DM + col) = v[i] * rstd * gm[i]; }
                else {
                    const f32x4 y = v[i] * rstd * gm[i] + sh[i];
                    u32x2 w; w.x = pack_h2(y[0], y[1]); w.y = pack_h2(y[2], y[3]);
                    *(u32x2*)(hout + (size_t)row * DM + col) = w;
                    if (MODE == 1) { v[i] = y; am = fmaxf(am, fmaxf(fmaxf(fabsf(y[0]), fabsf(y[1])), fmaxf(fabsf(y[2]), fabsf(y[3])))); }
                }
            }
            if (MODE == 1) {
                am = wave_max(am);
                const float qs = am > 0.f ? am * (1.f / 127.f) : 1.f, inv = 1.f / qs;
                if (lane == 0) sh8[row] = qs;
#pragma unroll
                for (int i = 0; i < 8; ++i) {
                    unsigned w = 0u;
#pragma unroll
                    for (int j = 0; j < 4; ++j) { const int q = (int)rintf(v[i][j] * inv); w |= ((unsigned)q & 255u) << (8 * j); }
                    h8[(size_t)row * (DM / 4) + i * 64 + lane] = w;
                }
            }
        }
    }
}

__device__ __forceinline__ void phase_rope(const Params& p) {
    f16* proj = (f16*)(p.ws + WS_PROJ);
    const float2* r128 = (const float2*)(p.ws + WS_ROPE128); const float2* r64 = (const float2*)(p.ws + WS_ROPE64);
    constexpr int PER_TOK = (1088 + 544) / 2;
    const size_t total = (size_t)NT * PER_TOK;
    for (size_t i = (size_t)blockIdx.x * NTHREADS + otid(); i < total; i += (size_t)gridDim.x * NTHREADS) {
        const int t = (int)(i / PER_TOK); int r = (int)(i % PER_TOK) * 2;
        const int pos = t % SEQ;
        int base, half, j;
        if (r < 1088) {
            const int hh = r >> 6; j = r & 63; half = 64;
            base = hh < 6 ? C_QA + hh * 128 : (hh == 6 ? C_KA : (hh < 12 ? C_QC + (hh - 7) * 128 : C_KC + (hh - 12) * 128));
        } else {
            r -= 1088; const int hh = r >> 5; j = r & 31; half = 32;
            base = hh < 16 ? C_IQ + hh * 64 : C_IK;
        }
        f16* pp = proj + (size_t)t * INWP + base + j;
        const h2_t a = *(const h2_t*)pp, bq = *(const h2_t*)(pp + half);
        float2 cs0, cs1;
        if (half == 64) { cs0 = r128[pos * 64 + j]; cs1 = r128[pos * 64 + j + 1]; } else { cs0 = r64[pos * 32 + j]; cs1 = r64[pos * 32 + j + 1]; }
        const float a0 = (float)a.x, a1 = (float)a.y, b0 = (float)bq.x, b1 = (float)bq.y;
        h2_t oa, ob;
        oa.x = (f16)(a0 * cs0.x - b0 * cs0.y); oa.y = (f16)(a1 * cs1.x - b1 * cs1.y);
        ob.x = (f16)(b0 * cs0.x + a0 * cs0.y); ob.y = (f16)(b1 * cs1.x + a1 * cs1.y);
        *(h2_t*)pp = oa; *(h2_t*)(pp + half) = ob;
    }
}

__device__ __forceinline__ void phase_index(const Params& p, LAS unsigned char* lds_) {
    const f16* proj = (const f16*)(p.ws + WS_PROJ);
    float* smem = (float*)(unsigned char*)lds_;
    const int tid = otid(), wid = tid >> 6, lane = tid & 63;
    {
        float* red = smem;
        float* km = (float*)(p.ws + WS_KMEAN);
        for (int u = blockIdx.x; u < NB * HC * MOBA_NB; u += gridDim.x) {
            const int blk = u % MOBA_NB, h = (u / MOBA_NB) % HC, b = u / (MOBA_NB * HC);
            const int d = tid & 127, part = tid >> 7;
            float s = 0.f;
            const f16* kp = proj + ((size_t)b * SEQ + blk * MOBA_BLK + part * 64) * INWP + C_KC + h * HD + d;
            for (int k = 0; k < 64; ++k) s += (float)kp[(size_t)k * INWP];
            __syncthreads();
            red[part * 128 + d] = s;
            __syncthreads();
            if (tid < 128) km[(size_t)u * HD + tid] = (red[tid] + red[128 + tid] + red[256 + tid] + red[384 + tid]) * (1.f / MOBA_BLK);
        }
        __syncthreads();
    }
    float* wq_ = smem + wid * (IH * IDM + IH);
    float* sc = smem + NWAVES * (IH * IDM + IH) + wid * SEQ;
    unsigned* mask = (unsigned*)(p.ws + WS_MASK);
    for (int q = blockIdx.x * NWAVES + wid; q < NT; q += gridDim.x * NWAVES) {
        const int b = q / SEQ, t = q % SEQ;
        const f16* row = proj + (size_t)q * INWP;
        for (int i = lane; i < IH * IDM; i += 64) wq_[i] = (float)row[C_IQ + i];
        if (lane < IH) wq_[IH * IDM + lane] = (float)row[C_IW + lane] * 0.25f;
        __builtin_amdgcn_wave_barrier();
        const int nk = t + 1;
        for (int s = lane; s < nk; s += 64) {
            const f16* kr = proj + ((size_t)b * SEQ + s) * INWP + C_IK;
            float kf[IDM];
#pragma unroll
            for (int e8 = 0; e8 < IDM / 8; ++e8) { const h8_t kv = *(const h8_t*)(kr + e8 * 8);
#pragma unroll
                for (int j = 0; j < 8; ++j) kf[e8 * 8 + j] = (float)kv[j]; }
            float score = 0.f;
            for (int h = 0; h < IH; ++h) {
                float d = 0.f;
#pragma unroll
                for (int e = 0; e < IDM; ++e) d += wq_[h * IDM + e] * kf[e];
                score += wq_[IH * IDM + h] * fmaxf(d * 0.125f, 0.f);
            }
            sc[s] = score;
        }
        __builtin_amdgcn_wave_barrier();
        unsigned key[32];
#pragma unroll
        for (int i = 0; i < 32; ++i) {
            const int s = lane + 64 * i;
            unsigned u = 0u;
            if (s < nk) { const unsigned bits = __float_as_uint(sc[s]); u = (bits & 0x80000000u) ? ~bits : (bits | 0x80000000u); if (u == 0u) u = 1u; }
            key[i] = u;
        }
        unsigned thr = 1u;
        if (nk > DSA_TOPK) {
            thr = 0u;
            for (int bit = 31; bit >= 0; --bit) {
                const unsigned cand = thr | (1u << bit);
                int cnt = 0;
#pragma unroll
                for (int i = 0; i < 32; ++i) cnt += __builtin_popcountll(__ballot(key[i] >= cand));
                if (cnt >= DSA_TOPK) thr = cand;
            }
        }
        unsigned* mrow = mask + (size_t)q * 64;
#pragma unroll
        for (int i = 0; i < 32; ++i) {
            const unsigned long long bal = __ballot(key[i] >= thr && key[i] != 0u);
            if (lane == 0) { mrow[2 * i] = (unsigned)bal; mrow[2 * i + 1] = (unsigned)(bal >> 32); }
        }
        __builtin_amdgcn_wave_barrier();
    }
}

constexpr int IX_ROW = SEQ + 4;
__device__ __forceinline__ void index_item(const Params& p, LAS unsigned char* lds, int b, int qg) {
    const f16* proj = (const f16*)(p.ws + WS_PROJ);
    LAS float* sc = (LAS float*)lds;
    const int tid = otid(), wid = __builtin_amdgcn_readfirstlane(tid >> 6), lane = tid & 63, fr = lane & 15, fq = lane >> 4;
    const int t0 = qg * 16, nkt = qg + 1;
    h8_t Bq[IH][2]; float wq[IH];
    {
        const f16* qrow = proj + ((size_t)b * SEQ + t0 + fr) * INWP;
#pragma unroll
        for (int h = 0; h < IH; ++h) {
            Bq[h][0] = *(const h8_t*)(qrow + C_IQ + h * IDM + 8 * fq);
            Bq[h][1] = *(const h8_t*)(qrow + C_IQ + h * IDM + 32 + 8 * fq);
        }
        const h8_t w0 = *(const h8_t*)(qrow + C_IW), w1 = *(const h8_t*)(qrow + C_IW + 8);
#pragma unroll
        for (int h = 0; h < 8; ++h) { wq[h] = (float)w0[h] * (0.25f * 0.125f); wq[8 + h] = (float)w1[h] * (0.25f * 0.125f); }
    }
    __syncthreads();
    const f16* kbase = proj + ((size_t)b * SEQ + fr) * INWP + C_IK + 8 * fq;
    h8_t a0, a1, n0, n1;
    int kt = wid;
    if (kt < nkt) { a0 = *(const h8_t*)(kbase + (size_t)kt * 16 * INWP); a1 = *(const h8_t*)(kbase + (size_t)kt * 16 * INWP + 32); }
    for (; kt < nkt; kt += NWAVES) {
        const int ktn = kt + NWAVES;
        if (ktn < nkt) { n0 = *(const h8_t*)(kbase + (size_t)ktn * 16 * INWP); n1 = *(const h8_t*)(kbase + (size_t)ktn * 16 * INWP + 32); }
        f32x4 acc = {0.f, 0.f, 0.f, 0.f};
#pragma unroll
        for (int h = 0; h < IH; ++h) {
            f32x4 c = {0.f, 0.f, 0.f, 0.f};
            c = __builtin_amdgcn_mfma_f32_16x16x32_f16(a0, Bq[h][0], c, 0, 0, 0);
            c = __builtin_amdgcn_mfma_f32_16x16x32_f16(a1, Bq[h][1], c, 0, 0, 0);
#pragma unroll
            for (int j = 0; j < 4; ++j) acc[j] += wq[h] * fmaxf(c[j], 0.f);
        }
        *(LAS f32x4*)(sc + fr * IX_ROW + kt * 16 + 4 * fq) = acc;
        a0 = n0; a1 = n1;
    }
    __syncthreads();
    unsigned* mask = (unsigned*)(p.ws + WS_MASK);
#pragma unroll 1
    for (int qq = 0; qq < 2; ++qq) {
        const int ql = 2 * wid + qq, t = t0 + ql, nk = t + 1;
        unsigned key[32];
#pragma unroll
        for (int i = 0; i < 32; ++i) {
            const int s = lane + 64 * i;
            unsigned u = 0u;
            if (s < nk) { const unsigned bits = __float_as_uint(sc[ql * IX_ROW + s]); u = (bits & 0x80000000u) ? ~bits : (bits | 0x80000000u); if (u == 0u) u = 1u; }
            key[i] = u;
        }
        unsigned thr = 1u;
        if (nk > DSA_TOPK) {
            thr = 0u;
            const int nreg8 = (nk + 511) >> 9;
            for (int bit = 31; bit >= 0; --bit) {
                const unsigned cand = thr | (1u << bit);
                int cnt = 0;
#pragma unroll
                for (int i8 = 0; i8 < 4; ++i8) {
                    if (i8 < nreg8) {
#pragma unroll
                        for (int i = 0; i < 8; ++i) cnt += __builtin_popcountll(__ballot(key[8 * i8 + i] >= cand));
                    }
                }
                if (cnt >= DSA_TOPK) { thr = cand; if (cnt == DSA_TOPK) break; }
            }
        }
        unsigned* mrow = mask + ((size_t)b * SEQ + t) * 64;
        unsigned myw = 0u;
#pragma unroll
        for (int i = 0; i < 32; ++i) {
            const unsigned long long bal = __ballot(key[i] >= thr && key[i] != 0u);
            if (lane == 2 * i) myw = (unsigned)bal;
            if (lane == 2 * i + 1) myw = (unsigned)(bal >> 32);
        }
        mrow[lane] = myw;
    }
}

__device__ __forceinline__ void phase_index2(const Params& p, LAS unsigned char* lds_) {
    const f16* proj = (const f16*)(p.ws + WS_PROJ);
    float* smem = (float*)(unsigned char*)lds_;
    const int tid = otid();
    {
        float* red = smem;
        float* km = (float*)(p.ws + WS_KMEAN);
        for (int u = obid(); u < NB * HC * MOBA_NB; u += gridDim.x) {
            const int blk = u % MOBA_NB, h = (u / MOBA_NB) % HC, b = u / (MOBA_NB * HC);
            const int d = tid & 127, part = tid >> 7;
            float s = 0.f;
            const f16* kp = proj + ((size_t)b * SEQ + blk * MOBA_BLK + part * 64) * INWP + C_KC + h * HD + d;
            for (int k = 0; k < 64; ++k) s += (float)kp[(size_t)k * INWP];
            __syncthreads();
            red[part * 128 + d] = s;
            __syncthreads();
            if (tid < 128) km[(size_t)u * HD + tid] = (red[tid] + red[128 + tid] + red[256 + tid] + red[384 + tid]) * (1.f / MOBA_BLK);
        }
        __syncthreads();
    }
    for (int pi = obid(); pi < NB * 64; pi += gridDim.x) {
        const int b = pi >> 6, a = pi & 63;
        index_item(p, lds_, b, 127 - a);
        index_item(p, lds_, b, a);
    }
}

__device__ __forceinline__ void phase_attn(const Params& p, LAS unsigned char* lds_, const float* ong) {
    const f16* proj = (const f16*)(p.ws + WS_PROJ);
    float* smem = (float*)(unsigned char*)lds_;
    const int tid = otid(), wid = tid >> 6, lane = tid & 63;
    float* pbuf = smem + wid * SEQ;
    const float* km = (const float*)(p.ws + WS_KMEAN);
    const unsigned* mask = (const unsigned*)(p.ws + WS_MASK);
    f16* y = (f16*)(p.ws + WS_Y);
    const float scale = 0.08838834764831845f;
    const size_t nitems = (size_t)NT * NHEADS;
    for (size_t it = (size_t)blockIdx.x * NWAVES + wid; it < nitems; it += (size_t)gridDim.x * NWAVES) {
        const int hh = (int)(it % NHEADS); const int q = (int)(it / NHEADS);
        const int b = q / SEQ, t = q % SEQ;
        int qc, kc, vc, var;
        if (hh < HA) { var = 0; qc = C_QA + hh * HD; kc = C_KA; vc = C_VA; }
        else if (hh < HA + HB) { var = 1; qc = C_QB + (hh - HA) * HD; kc = C_KB + (hh - HA) * HD; vc = C_VB + (hh - HA) * HD; }
        else { var = 2; qc = C_QC + (hh - HA - HB) * HD; kc = C_KC + (hh - HA - HB) * HD; vc = C_VC + (hh - HA - HB) * HD; }
        unsigned qv[64];
        { const u32x4* qp = (const u32x4*)(proj + (size_t)q * INWP + qc);
#pragma unroll
          for (int i = 0; i < 16; ++i) { const u32x4 w = qp[i]; qv[4 * i] = w.x; qv[4 * i + 1] = w.y; qv[4 * i + 2] = w.z; qv[4 * i + 3] = w.w; } }
        unsigned allowed = 0xffu;
        const int own = t / MOBA_BLK;
        if (var == 2) {
            float g = -INFINITY;
            if (lane < own) {
                const float* kmp = km + (((size_t)b * HC + (hh - HA - HB)) * MOBA_NB + lane) * HD;
                float s = 0.f;
#pragma unroll
                for (int i = 0; i < 64; ++i) s += h_lo(qv[i]) * kmp[2 * i] + h_hi(qv[i]) * kmp[2 * i + 1];
                g = s;
            }
            float gs[MOBA_NB];
#pragma unroll
            for (int j = 0; j < MOBA_NB; ++j) gs[j] = __shfl(g, j);
            allowed = 1u << own;
#pragma unroll
            for (int j = 0; j < MOBA_NB; ++j) {
                if (j < own) {
                    int rank = 0;
#pragma unroll
                    for (int k2 = 0; k2 < MOBA_NB; ++k2) if (k2 < own && (gs[k2] > gs[j] || (gs[k2] == gs[j] && k2 < j))) ++rank;
                    if (rank < 3) allowed |= 1u << j;
                }
            }
        }
        const int nk = t + 1;
        const int nkl = (nk + 63) >> 6;
        const unsigned* mrow = mask + (size_t)q * 64;
        float z[32];
#pragma unroll
        for (int i = 0; i < 32; ++i) {
            z[i] = -INFINITY;
            if (i < nkl) {
                const int s = nkl * lane + i;
                if (s < nk) {
                    bool ok = true;
                    if (var == 0) ok = (mrow[s >> 5] >> (s & 31)) & 1u;
                    if (var == 2) ok = (allowed >> (s / MOBA_BLK)) & 1u;
                    if (var == 1) ok = s < t;
                    if (ok) {
                        const u32x4* kp = (const u32x4*)(proj + ((size_t)b * SEQ + s) * INWP + kc);
                        float d = 0.f;
#pragma unroll
                        for (int c4 = 0; c4 < 16; ++c4) { const u32x4 w = kp[c4]; d = dot2(qv[4 * c4], w.x, d); d = dot2(qv[4 * c4 + 1], w.y, d); d = dot2(qv[4 * c4 + 2], w.z, d); d = dot2(qv[4 * c4 + 3], w.w, d); }
                        z[i] = d * scale;
                    }
                }
            }
        }
        float inv_l = 1.f;
        if (var != 1) {
            float m = -INFINITY;
#pragma unroll
            for (int i = 0; i < 32; ++i) m = fmaxf(m, z[i]);
            m = wave_max(m);
            float l = 0.f;
#pragma unroll
            for (int i = 0; i < 32; ++i) { const float e = (z[i] == -INFINITY) ? 0.f : __expf(z[i] - m); z[i] = e; l += e; }
            l = wave_sum(l);
            inv_l = 1.f / l;
        } else {
            float lk[32]; float tot = 0.f;
#pragma unroll
            for (int i = 31; i >= 0; --i) {
                float v = 0.f;
                if (z[i] != -INFINITY) { const float zz = z[i]; v = -(fmaxf(zz, 0.f) + log1pf(__expf(-fabsf(zz)))); }
                tot += v; lk[i] = tot;
            }
            float incl = tot;
#pragma unroll
            for (int o = 1; o < 64; o <<= 1) { const float v = __shfl_down(incl, o); if (lane + o < 64) incl += v; }
            const float excl = incl - tot;
#pragma unroll
            for (int i = 0; i < 32; ++i) z[i] = (z[i] == -INFINITY) ? 0.f : __expf(z[i] + lk[i] + excl);
        }
#pragma unroll
        for (int i = 0; i < 32; ++i) if (i < nkl) { const int s = nkl * lane + i; if (s < SEQ) pbuf[s] = z[i]; }
        __builtin_amdgcn_wave_barrier();
        float o0 = 0.f, o1 = 0.f;
        const f16* vp = proj + (size_t)b * SEQ * INWP + vc + 2 * lane;
        for (int s0 = 0; s0 < nk; s0 += 8) {
            float pr[8]; bool any = false;
#pragma unroll
            for (int j = 0; j < 8; ++j) { pr[j] = pbuf[s0 + j]; any = any || (pr[j] != 0.f); }
            if (any) {
                unsigned w[8];
#pragma unroll
                for (int j = 0; j < 8; ++j) w[j] = *(const unsigned*)(vp + (size_t)(s0 + j) * INWP);
#pragma unroll
                for (int j = 0; j < 8; ++j) { o0 += pr[j] * h_lo(w[j]); o1 += pr[j] * h_hi(w[j]); }
            }
        }
        o0 *= inv_l; o1 *= inv_l;
        const float ss = wave_sum(o0 * o0 + o1 * o1);
        const float rstd = rsqrtf(ss * (1.f / HD) + EPS);
        const float g0 = ong[hh * HD + 2 * lane], g1 = ong[hh * HD + 2 * lane + 1];
        *(unsigned*)(y + (size_t)q * DM + hh * HD + 2 * lane) = pack_h2(o0 * rstd * g0, o1 * rstd * g1);
        __builtin_amdgcn_wave_barrier();
    }
}

typedef short s4_t __attribute__((ext_vector_type(4)));
typedef float f32x16 __attribute__((ext_vector_type(16)));
constexpr int AT_KSTR = 272, AT_VSTR = 320, AT_KBYTES = 64 * AT_KSTR, AT_VBYTES = 64 * AT_VSTR, AT_STAGE = AT_KBYTES + AT_VBYTES;
__device__ __forceinline__ float fexp2(float x) { return __builtin_amdgcn_exp2f(x); }
__device__ __forceinline__ float flog2(float x) { return __builtin_amdgcn_logf(x); }

template <int VAR>
__device__ __forceinline__ void attn_item(const Params& p, LAS unsigned char* lds, const float* ong, int b, int hh, int qt, int qc, int kc, int vc) {
    const f16* proj = (const f16*)(p.ws + WS_PROJ);
    const int tid = otid(), wid = __builtin_amdgcn_readfirstlane(tid >> 6), lane = tid & 63, qn = lane & 31, hf = lane >> 5;
    const int q0 = qt * 256, qrow = q0 + 32 * wid + qn;
    const size_t grow = (size_t)b * SEQ + qrow;
    h8_t Qf[8];
    {
        const float sc = 0.08838834764831845f * 1.4426950408889634f;
        const f16* qp = proj + grow * INWP + qc + 8 * hf;
#pragma unroll
        for (int ks = 0; ks < 8; ++ks) {
            const h8_t v = *(const h8_t*)(qp + 16 * ks);
            h8_t w;
#pragma unroll
            for (int j = 0; j < 8; ++j) w[j] = (f16)((float)v[j] * sc);
            Qf[ks] = w;
        }
    }
    unsigned allowed = 0xffu;
    if (VAR == 2) {
        const int own = qt;
        const float* km = (const float*)(p.ws + WS_KMEAN) + ((size_t)b * HC + (hh - HA - HB)) * MOBA_NB * HD + 8 * hf;
        float gs[MOBA_NB];
#pragma unroll
        for (int j = 0; j < MOBA_NB; ++j) gs[j] = -INFINITY;
#pragma unroll
        for (int j = 0; j < MOBA_NB - 1; ++j) {
            if (j < own) {
                float s = 0.f;
#pragma unroll
                for (int ks = 0; ks < 8; ++ks) {
                    const f32x4 k0 = *(const f32x4*)(km + j * HD + 16 * ks), k1 = *(const f32x4*)(km + j * HD + 16 * ks + 4);
                    s += (float)Qf[ks][0] * k0[0] + (float)Qf[ks][1] * k0[1] + (float)Qf[ks][2] * k0[2] + (float)Qf[ks][3] * k0[3]
                       + (float)Qf[ks][4] * k1[0] + (float)Qf[ks][5] * k1[1] + (float)Qf[ks][6] * k1[2] + (float)Qf[ks][7] * k1[3];
                }
                gs[j] = s + __shfl_xor(s, 32);
            }
        }
        allowed = 1u << own;
#pragma unroll
        for (int j = 0; j < MOBA_NB - 1; ++j) {
            if (j < own) {
                int rank = 0;
#pragma unroll
                for (int k2 = 0; k2 < MOBA_NB - 1; ++k2) if (k2 < own && (gs[k2] > gs[j] || (gs[k2] == gs[j] && k2 < j))) ++rank;
                if (rank < 3) allowed |= 1u << j;
            }
        }
    }
    f32x16 O[4];
#pragma unroll
    for (int dt = 0; dt < 4; ++dt)
#pragma unroll
        for (int r = 0; r < 16; ++r) O[dt][r] = 0.f;
    float m_run = -INFINITY, l_run = 0.f, carry = 0.f;
    const int nst = (qt + 1) * 4;
    const int st_hi_w = qt * 4 + (wid >> 1);
    const int sr0 = tid >> 4, sc0 = tid & 15;
    const f16* kg = proj + ((size_t)b * SEQ + sr0) * INWP + kc + 8 * sc0;
    const f16* vg = proj + ((size_t)b * SEQ + sr0) * INWP + vc + 8 * sc0;
    const unsigned kw = sr0 * AT_KSTR + 16 * sc0, vw = AT_KBYTES + sr0 * AT_VSTR + 16 * sc0;
    const unsigned* mrow = (const unsigned*)(p.ws + WS_MASK) + grow * 64;
    const unsigned ka = qn * AT_KSTR + 16 * hf;
    const unsigned va = AT_KBYTES + (4 * hf + ((lane & 15) >> 2)) * AT_VSTR + (16 * ((lane >> 4) & 1) + 4 * (lane & 3)) * 2;
    u32x4 rk0, rk1, rv0, rv1; u32x2 mw = {0u, 0u}, mwn = {0u, 0u};
#define AT_LOAD(st_) do { const size_t o_ = (size_t)(st_) * 64 * INWP; rk0 = *(const u32x4*)(kg + o_); rk1 = *(const u32x4*)(kg + o_ + (size_t)32 * INWP); \
        rv0 = *(const u32x4*)(vg + o_); rv1 = *(const u32x4*)(vg + o_ + (size_t)32 * INWP); if (VAR == 0) mwn = *(const u32x2*)(mrow + 2 * (st_)); } while (0)
#define AT_WRITE(buf_) do { LAS unsigned char* b_ = lds + (buf_) * AT_STAGE; *(LAS u32x4*)(b_ + kw) = rk0; *(LAS u32x4*)(b_ + kw + 32 * AT_KSTR) = rk1; \
        *(LAS u32x4*)(b_ + vw) = rv0; *(LAS u32x4*)(b_ + vw + 32 * AT_VSTR) = rv1; } while (0)
    __syncthreads();
    AT_LOAD(nst - 1); AT_WRITE(0); mw = mwn;
    __syncthreads();
    int cur = 0;
    bool wdone = false;
    for (int st = nst - 1; st >= 0; --st) {
        if (st > 0) AT_LOAD(st - 1);
        if (st <= st_hi_w && !wdone) {
            LAS unsigned char* kb = lds + cur * AT_STAGE;
            f32x16 S[2];
#pragma unroll
            for (int r = 0; r < 16; ++r) { S[0][r] = 0.f; S[1][r] = 0.f; }
#pragma unroll
            for (int ks = 0; ks < 8; ++ks) {
                const h8_t a0 = *(const LAS h8_t*)(kb + ka + 32 * ks), a1 = *(const LAS h8_t*)(kb + ka + 32 * ks + 32 * AT_KSTR);
                S[0] = __builtin_amdgcn_mfma_f32_32x32x16_f16(a0, Qf[ks], S[0], 0, 0, 0);
                S[1] = __builtin_amdgcn_mfma_f32_32x32x16_f16(a1, Qf[ks], S[1], 0, 0, 0);
            }
            const bool diag = (64 * st + 63 > q0 + 32 * wid);
            const int kbase = 64 * st + 4 * hf;
            if (VAR != 1) {
                const bool blk_ok = (VAR == 2) ? ((allowed >> (st >> 2)) & 1u) : true;
                float mx = -INFINITY;
#pragma unroll
                for (int sub = 0; sub < 2; ++sub)
#pragma unroll
                    for (int r = 0; r < 16; ++r) {
                        const int kl = (r & 3) + 8 * (r >> 2);
                        bool ok;
                        if (VAR == 0) ok = ((sub == 0 ? mw.x : mw.y) >> (kl + 4 * hf)) & 1u;
                        else ok = blk_ok && (!diag || (kbase + 32 * sub + kl <= qrow));
                        const float v = ok ? S[sub][r] : -INFINITY;
                        S[sub][r] = v; mx = fmaxf(mx, v);
                    }
                mx = fmaxf(mx, __shfl_xor(mx, 32));
                const float m_new = fmaxf(m_run, mx);
                const float m_use = (m_new == -INFINITY) ? 0.f : m_new;
                const float alpha = fexp2(m_run - m_use);
                float ps = 0.f;
#pragma unroll
                for (int sub = 0; sub < 2; ++sub)
#pragma unroll
                    for (int r = 0; r < 16; ++r) { const float e = fexp2(S[sub][r] - m_use); S[sub][r] = e; ps += e; }
                l_run = l_run * alpha + ps;
                m_run = m_new;
                if (__ballot(alpha != 1.f) != 0ull) {
#pragma unroll
                    for (int dt = 0; dt < 4; ++dt)
#pragma unroll
                        for (int r = 0; r < 16; ++r) O[dt][r] *= alpha;
                }
            } else {
#pragma unroll
                for (int sub = 1; sub >= 0; --sub) {
                    float lk[16];
#pragma unroll
                    for (int r = 0; r < 16; ++r) {
                        const int kl = (r & 3) + 8 * (r >> 2);
                        const bool ok = !diag || (kbase + 32 * sub + kl < qrow);
                        const float zl = S[sub][r];
                        const float sp = fmaxf(zl, 0.f) + flog2(1.f + fexp2(-fabsf(zl)));
                        lk[r] = ok ? -sp : 0.f;
                        S[sub][r] = ok ? zl : -INFINITY;
                    }
                    float gsum[4], pg[4], T[4];
#pragma unroll
                    for (int g = 0; g < 4; ++g) { gsum[g] = (lk[4 * g] + lk[4 * g + 1]) + (lk[4 * g + 2] + lk[4 * g + 3]); pg[g] = __shfl_xor(gsum[g], 32); T[g] = gsum[g] + pg[g]; }
                    float after[4];
                    after[3] = 0.f; after[2] = T[3]; after[1] = T[3] + T[2]; after[0] = T[3] + T[2] + T[1];
#pragma unroll
                    for (int g = 0; g < 4; ++g) {
                        const float base = carry + after[g] + (hf == 0 ? pg[g] : 0.f);
                        const float c3 = lk[4 * g + 3], c2 = lk[4 * g + 2] + c3, c1 = lk[4 * g + 1] + c2, c0 = lk[4 * g] + c1;
                        S[sub][4 * g + 3] = fexp2(S[sub][4 * g + 3] + base + c3);
                        S[sub][4 * g + 2] = fexp2(S[sub][4 * g + 2] + base + c2);
                        S[sub][4 * g + 1] = fexp2(S[sub][4 * g + 1] + base + c1);
                        S[sub][4 * g + 0] = fexp2(S[sub][4 * g + 0] + base + c0);
                    }
                    carry += (T[0] + T[1]) + (T[2] + T[3]);
                }
            }
#pragma unroll
            for (int sub = 0; sub < 2; ++sub)
#pragma unroll
                for (int s2 = 0; s2 < 2; ++s2) {
                    h8_t pb;
#pragma unroll
                    for (int j = 0; j < 8; ++j) pb[j] = (f16)S[sub][8 * s2 + j];
#pragma unroll
                    for (int dt = 0; dt < 4; ++dt) {
                        const LAS unsigned char* ap = kb + va + (32 * sub + 16 * s2) * AT_VSTR + 64 * dt;
                        const s4_t t0 = __builtin_amdgcn_ds_read_tr16_b64_v4i16((LAS s4_t*)ap);
                        const s4_t t1 = __builtin_amdgcn_ds_read_tr16_b64_v4i16((LAS s4_t*)(ap + 8 * AT_VSTR));
                        typedef short s8_t __attribute__((ext_vector_type(8)));
                        const s8_t a8 = __builtin_shufflevector(t0, t1, 0, 1, 2, 3, 4, 5, 6, 7);
                        O[dt] = __builtin_amdgcn_mfma_f32_32x32x16_f16(__builtin_bit_cast(h8_t, a8), pb, O[dt], 0, 0, 0);
                    }
                }
        }
        if (VAR == 1) {
            if (st <= st_hi_w && !wdone) wdone = (__ballot(carry < -100.f) == ~0ull);
            if (lane == 0) *(LAS unsigned*)(lds + 2 * AT_STAGE + 32 * (st & 1) + 4 * wid) = wdone ? 1u : 0u;
        }
        if (st > 0) { AT_WRITE(cur ^ 1); }
        mw = mwn;
        __syncthreads();
        cur ^= 1;
        if (VAR == 1) {
            unsigned alld = 1u;
#pragma unroll
            for (int w = 0; w < NWAVES; ++w) alld &= *(const LAS unsigned*)(lds + 2 * AT_STAGE + 32 * (st & 1) + 4 * w);
            if (alld) break;
        }
    }
#undef AT_LOAD
#undef AT_WRITE
    float inv = 1.f;
    if (VAR != 1) { const float lt = l_run + __shfl_xor(l_run, 32); inv = 1.f / lt; }
    float ss = 0.f;
#pragma unroll
    for (int dt = 0; dt < 4; ++dt)
#pragma unroll
        for (int r = 0; r < 16; ++r) { const float v = O[dt][r] * inv; O[dt][r] = v; ss += v * v; }
    ss += __shfl_xor(ss, 32);
    const float rstd = rsqrtf(ss * (1.f / HD) + EPS);
    f16* yp = (f16*)(p.ws + WS_Y) + grow * DM + hh * HD + 4 * hf;
    const float* gp = ong + hh * HD + 4 * hf;
#pragma unroll
    for (int dt = 0; dt < 4; ++dt)
#pragma unroll
        for (int g = 0; g < 4; ++g) {
            const f32x4 gg = *(const f32x4*)(gp + 32 * dt + 8 * g);
            u32x2 w; w.x = pack_h2(O[dt][4 * g] * rstd * gg[0], O[dt][4 * g + 1] * rstd * gg[1]); w.y = pack_h2(O[dt][4 * g + 2] * rstd * gg[2], O[dt][4 * g + 3] * rstd * gg[3]);
            *(u32x2*)(yp + 32 * dt + 8 * g) = w;
        }
}

__device__ __forceinline__ void phase_attn2(const Params& p, LAS unsigned char* lds, const float* ong, unsigned* queue) {
    for (;;) {
        __syncthreads();
        if (threadIdx.x == 0) *(LAS unsigned*)(lds + 2 * AT_STAGE + 96) = __hip_atomic_fetch_add(queue, 1u, __ATOMIC_RELAXED, __HIP_MEMORY_SCOPE_AGENT);
        __syncthreads();
        const int idx = (int)*(const LAS unsigned*)(lds + 2 * AT_STAGE + 96);
        if (idx >= NB * NHEADS * 8) break;
        int qt, b, hh;
        if (idx < 704) { qt = 7 - idx / 88; const int r = idx % 88; b = r / 11; const int h11 = r % 11; hh = h11 < HA ? h11 : h11 + HB; }
        else { const int r = idx - 704; qt = 7 - r / 40; b = (r % 40) / 5; hh = HA + (r % 5); }
        if (hh < HA) attn_item<0>(p, lds, ong, b, hh, qt, C_QA + hh * HD, C_KA, C_VA);
        else if (hh < HA + HB) attn_item<1>(p, lds, ong, b, hh, qt, C_QB + (hh - HA) * HD, C_KB + (hh - HA) * HD, C_VB + (hh - HA) * HD);
        else attn_item<2>(p, lds, ong, b, hh, qt, C_QC + (hh - HA - HB) * HD, C_KC + (hh - HA - HB) * HD, C_VC + (hh - HA - HB) * HD);
    }
}

__device__ __forceinline__ void wave_argmax(float& v, int& idx) {
#pragma unroll
    for (int o = 32; o >= 1; o >>= 1) {
        const float ov = __shfl_xor(v, o); const int oi = __shfl_xor(idx, o);
        if (ov > v || (ov == v && oi < idx)) { v = ov; idx = oi; }
    }
}
__device__ __forceinline__ void phase_route(const Params& p, LAS unsigned char* lds_, const f16* subk) {
    const f16* qp = (const f16*)(p.ws + WS_Y);
    float* smem = (float*)(unsigned char*)lds_;
    const int tid = otid(), wid = tid >> 6, lane = tid & 63;
    float* qs = smem + wid * 256;
    unsigned* pe = (unsigned*)(p.ws + WS_PE); float* pg = (float*)(p.ws + WS_PG);
    const size_t nitems = (size_t)NT * PH;
    for (size_t it = (size_t)blockIdx.x * NWAVES + wid; it < nitems; it += (size_t)gridDim.x * NWAVES) {
        const int hp = (int)(it % PH); const int t = (int)(it / PH);
        const f16* qrow = qp + (size_t)t * DM + hp * 256;
        for (int i = lane; i < 256; i += 64) qs[i] = (float)qrow[i];
        __builtin_amdgcn_wave_barrier();
        float sv[2]; int si[2];
#pragma unroll
        for (int c = 0; c < 2; ++c) {
            float v0, v1;
            {
                const f16* k0 = subk + (((size_t)hp * 2 + c) * PNK + lane) * 128;
                const f16* k1 = k0 + 64 * 128;
                float a0 = 0.f, a1 = 0.f;
#pragma unroll 4
                for (int e8 = 0; e8 < 16; ++e8) {
                    const h8_t x0 = *(const h8_t*)(k0 + e8 * 8), x1 = *(const h8_t*)(k1 + e8 * 8);
#pragma unroll
                    for (int j = 0; j < 8; ++j) { const float qq = qs[c * 128 + e8 * 8 + j]; a0 += qq * (float)x0[j]; a1 += qq * (float)x1[j]; }
                }
                v0 = a0; v1 = a1;
            }
            float mysv = 0.f; int mysi = 0;
            for (int r = 0; r < PTOPK; ++r) {
                float v; int idx;
                if (v0 >= v1) { v = v0; idx = lane; } else { v = v1; idx = lane + 64; }
                wave_argmax(v, idx);
                if (idx == lane) v0 = -INFINITY;
                if (idx == lane + 64) v1 = -INFINITY;
                if (lane == r) { mysv = v; mysi = idx; }
            }
            sv[c] = mysv; si[c] = mysi;
        }
        float cs[4];
#pragma unroll
        for (int k = 0; k < 4; ++k) { const int id = 4 * lane + k; cs[k] = __shfl(sv[0], id >> 4) + __shfl(sv[1], id & 15); }
        float tops = 0.f; int pick = 0;
        for (int r = 0; r < PTOPK; ++r) {
            float v = cs[0]; int idx = 4 * lane;
#pragma unroll
            for (int k = 1; k < 4; ++k) if (cs[k] > v) { v = cs[k]; idx = 4 * lane + k; }
            wave_argmax(v, idx);
#pragma unroll
            for (int k = 0; k < 4; ++k) if (idx == 4 * lane + k) cs[k] = -INFINITY;
            if (lane == r) { tops = v; pick = idx; }
        }
        const int e0 = __shfl(si[0], pick >> 4), e1 = __shfl(si[1], pick & 15);
        const float mx = __shfl(tops, 0);
        float ex = lane < PTOPK ? __expf(tops - mx) : 0.f;
        const float sum = wave_sum(ex);
        if (lane < PTOPK) { pe[(size_t)t * 128 + hp * 16 + lane] = (unsigned)(e0 * PNK + e1); pg[(size_t)t * 128 + hp * 16 + lane] = ex / sum; }
        __builtin_amdgcn_wave_barrier();
    }
}

#define CE_DESC(a, b) do { const unsigned _x = (a) > (b) ? (a) : (b), _y = (a) > (b) ? (b) : (a); (a) = _x; (b) = _y; } while (0)
__device__ __forceinline__ void sort16_desc(unsigned (&k)[16]) {
#pragma unroll
    for (int kk = 2; kk <= 16; kk <<= 1)
#pragma unroll
        for (int j = kk >> 1; j > 0; j >>= 1)
#pragma unroll
            for (int i = 0; i < 16; ++i) { const int l = i ^ j; if (l > i) { if ((i & kk) == 0) CE_DESC(k[i], k[l]); else CE_DESC(k[l], k[i]); } }
}
__device__ __forceinline__ void merge16_desc(unsigned (&a)[16], const unsigned (&b)[16]) {
#pragma unroll
    for (int i = 0; i < 16; ++i) a[i] = a[i] > b[15 - i] ? a[i] : b[15 - i];
#pragma unroll
    for (int j = 8; j > 0; j >>= 1)
#pragma unroll
        for (int i = 0; i < 16; ++i) { const int l = i ^ j; if (l > i) CE_DESC(a[i], a[l]); }
}
__device__ __forceinline__ unsigned f2sort(float f) { const unsigned b = __float_as_uint(f); return b ^ ((unsigned)((int)b >> 31) | 0x80000000u); }
__device__ __forceinline__ float sort2f(unsigned u) { const unsigned b = (u & 0x80000000u) ? (u ^ 0x80000000u) : ~u; return __uint_as_float(b); }
constexpr int RT_STR = 272;
__device__ __forceinline__ void phase_route2(const Params& p, LAS unsigned char* lds, const f16* subk) {
    const f16* qp = (const f16*)(p.ws + WS_Y);
    unsigned* pe = (unsigned*)(p.ws + WS_PE); float* pg = (float*)(p.ws + WS_PG);
    const int tid = otid(), wid = __builtin_amdgcn_readfirstlane(tid >> 6), lane = tid & 63, qn = lane & 31, hf = lane >> 5;
    for (int item = obid(); item < 256; item += gridDim.x) {
        const int hp = item & 7, tg = item >> 3;
        __syncthreads();
        {
            const f16* src = subk + (size_t)hp * 256 * 128;
#pragma unroll
            for (int i = 0; i < 8; ++i) { const int e = tid + i * 512, r = e >> 4, c = e & 15; *(LAS u32x4*)(lds + r * RT_STR + 16 * c) = *(const u32x4*)(src + r * 128 + 8 * c); }
        }
        __syncthreads();
#pragma unroll 1
        for (int it = 0; it < 2; ++it) {
            const int t = (tg * 16 + wid * 2 + it) * 32 + qn;
            unsigned top[2][16];
#pragma unroll
            for (int c = 0; c < 2; ++c) {
                h8_t Bq[8];
                const f16* qrow = qp + (size_t)t * DM + hp * 256 + c * 128 + 8 * hf;
#pragma unroll
                for (int ks = 0; ks < 8; ++ks) Bq[ks] = *(const h8_t*)(qrow + 16 * ks);
                unsigned run[16];
#pragma unroll 1
                for (int nt = 0; nt < 4; ++nt) {
                    f32x16 S;
#pragma unroll
                    for (int r = 0; r < 16; ++r) S[r] = 0.f;
#pragma unroll
                    for (int ks = 0; ks < 8; ++ks) {
                        const h8_t a = *(const LAS h8_t*)(lds + (c * 128 + nt * 32 + qn) * RT_STR + 32 * ks + 16 * hf);
                        S = __builtin_amdgcn_mfma_f32_32x32x16_f16(a, Bq[ks], S, 0, 0, 0);
                    }
                    unsigned k[16];
#pragma unroll
                    for (int r = 0; r < 16; ++r) { const int n = 32 * nt + (r & 3) + 8 * (r >> 2) + 4 * hf; k[r] = (f2sort(S[r]) & ~127u) | (unsigned)(127 - n); }
                    sort16_desc(k);
                    if (nt == 0) {
#pragma unroll
                        for (int r = 0; r < 16; ++r) run[r] = k[r];
                    } else merge16_desc(run, k);
                }
#pragma unroll
                for (int r = 0; r < 16; ++r) top[c][r] = run[r];
            }
            unsigned mine[16], oth[16];
#pragma unroll
            for (int r = 0; r < 16; ++r) { const unsigned send = hf ? top[0][r] : top[1][r]; oth[r] = __shfl_xor(send, 32); mine[r] = hf ? top[1][r] : top[0][r]; }
            merge16_desc(mine, oth);
            unsigned ka[16], kb2[16];
#pragma unroll
            for (int r = 0; r < 16; ++r) { const unsigned o = __shfl_xor(mine[r], 32); ka[r] = hf ? o : mine[r]; kb2[r] = hf ? mine[r] : o; }
            float sa[16], sb[16]; unsigned na[4] = {0u, 0u, 0u, 0u}, nb[4] = {0u, 0u, 0u, 0u};
#pragma unroll
            for (int r = 0; r < 16; ++r) {
                sa[r] = sort2f(ka[r] & ~127u); sb[r] = sort2f(kb2[r] & ~127u);
                na[r >> 2] |= (127u - (ka[r] & 127u)) << (8 * (r & 3)); nb[r >> 2] |= (127u - (kb2[r] & 127u)) << (8 * (r & 3));
            }
            unsigned cand[4][16];
#pragma unroll
            for (int g = 0; g < 4; ++g)
#pragma unroll
                for (int r = 0; r < 16; ++r) cand[g][r] = 0u;
#pragma unroll
            for (int slot = 0; slot < 50; ++slot) {
                constexpr unsigned char CIJ[64] = {0, 1, 2, 3, 4, 5, 6, 7, 8, 9, 10, 11, 12, 13, 14, 15, 16, 17, 18, 19, 20, 21, 22, 23, 32, 33, 34, 35, 36, 48, 49, 50, 51, 64, 65, 66, 80, 81, 96, 97, 112, 113, 128, 144, 160, 176, 192, 208, 224, 240, 255, 255, 255, 255, 255, 255, 255, 255, 255, 255, 255, 255, 255, 255};
                const int ij = CIJ[slot], i = ij >> 4, j = ij & 15;
                cand[slot >> 4][slot & 15] = (f2sort(sa[i] + sb[j]) & ~255u) | (unsigned)(255 - ij);
            }
#pragma unroll
            for (int g = 1; g < 4; ++g) sort16_desc(cand[g]);
            merge16_desc(cand[0], cand[1]); merge16_desc(cand[2], cand[3]); merge16_desc(cand[0], cand[2]);
            float ex[16]; float sum = 0.f;
            const float mx = sort2f(cand[0][0] & ~255u);
#pragma unroll
            for (int r = 0; r < 16; ++r) { ex[r] = __expf(sort2f(cand[0][r] & ~255u) - mx); sum += ex[r]; }
            const float inv = 1.f / sum;
            unsigned eo[16];
#pragma unroll
            for (int r = 0; r < 16; ++r) {
                const unsigned id = 255u - (cand[0][r] & 255u), i = id >> 4, j = id & 15u;
                const unsigned wa = (i & 8u) ? ((i & 4u) ? na[3] : na[2]) : ((i & 4u) ? na[1] : na[0]);
                const unsigned wb = (j & 8u) ? ((j & 4u) ? nb[3] : nb[2]) : ((j & 4u) ? nb[1] : nb[0]);
                eo[r] = ((wa >> (8 * (i & 3u))) & 255u) * PNK + ((wb >> (8 * (j & 3u))) & 255u);
                ex[r] *= inv;
            }
            if (hf == 0) {
#pragma unroll
                for (int r4 = 0; r4 < 4; ++r4) { u32x4 w; w.x = eo[4 * r4]; w.y = eo[4 * r4 + 1]; w.z = eo[4 * r4 + 2]; w.w = eo[4 * r4 + 3]; *(u32x4*)(pe + (size_t)t * 128 + hp * 16 + 4 * r4) = w; }
            } else {
#pragma unroll
                for (int r4 = 0; r4 < 4; ++r4) { f32x4 w; w[0] = ex[4 * r4]; w[1] = ex[4 * r4 + 1]; w[2] = ex[4 * r4 + 2]; w[3] = ex[4 * r4 + 3]; *(f32x4*)(pg + (size_t)t * 128 + hp * 16 + 4 * r4) = w; }
            }
        }
    }
}

__device__ __forceinline__ void phase_experts(const Params& p, const f16* h2, const float* x1, const float* gate2  , const f16* u16, const f16* v16,
                              float* xout  , bool final_norm, const float* ng, const float* nshift, const float* nscale, f16* hnext, float* fout) {
    const int tid_ = otid(); const int wid = tid_ >> 6, lane = tid_ & 63;
    const unsigned* pe = (const unsigned*)(p.ws + WS_PE); const float* pg = (const float*)(p.ws + WS_PG);
    for (int t = blockIdx.x * NWAVES + wid; t < NT; t += gridDim.x * NWAVES) {
        const int b = t / SEQ;
        u32x4 hv[4];
#pragma unroll
        for (int i = 0; i < 4; ++i) hv[i] = *(const u32x4*)(h2 + (size_t)t * DM + 512 * i + 8 * lane);
        float acc[32];
#pragma unroll
        for (int i = 0; i < 32; ++i) acc[i] = 0.f;
        for (int g8 = 0; g8 < 32; ++g8) {
            const unsigned myexp = pe[(size_t)t * 128 + g8 * 4 + (lane & 3)];
            const float mygate = pg[(size_t)t * 128 + g8 * 4 + (lane & 3)];
            float part[4];
#pragma unroll
            for (int k = 0; k < 4; ++k) {
                const unsigned e = __shfl(myexp, k);
                const f16* ur = u16 + (size_t)e * DM + 8 * lane;
                float d = 0.f;
#pragma unroll
                for (int i = 0; i < 4; ++i) { const u32x4 w = *(const u32x4*)(ur + 512 * i); d = dot2(hv[i].x, w.x, d); d = dot2(hv[i].y, w.y, d); d = dot2(hv[i].z, w.z, d); d = dot2(hv[i].w, w.w, d); }
                part[k] = d;
            }
#pragma unroll
            for (int k = 0; k < 4; ++k) part[k] = wave_sum(part[k]);
#pragma unroll
            for (int k = 0; k < 4; ++k) {
                const float d = part[k];
                const float act = 0.5f * d * (1.f + erff(d * 0.70710678118654752f));
                const float coef = __shfl(mygate, k) * act;
                const unsigned e = __shfl(myexp, k);
                const f16* vr = v16 + (size_t)e * DM + 8 * lane;
#pragma unroll
                for (int i = 0; i < 4; ++i) {
                    const u32x4 w = *(const u32x4*)(vr + 512 * i);
                    acc[8 * i + 0] += coef * h_lo(w.x); acc[8 * i + 1] += coef * h_hi(w.x); acc[8 * i + 2] += coef * h_lo(w.y); acc[8 * i + 3] += coef * h_hi(w.y);
                    acc[8 * i + 4] += coef * h_lo(w.z); acc[8 * i + 5] += coef * h_hi(w.z); acc[8 * i + 6] += coef * h_lo(w.w); acc[8 * i + 7] += coef * h_hi(w.w);
                }
            }
        }
        float ss = 0.f;
#pragma unroll
        for (int i = 0; i < 4; ++i) {
            const int col = 512 * i + 8 * lane;
#pragma unroll
            for (int hf = 0; hf < 2; ++hf) {
                const f32x4 xi = *(const f32x4*)(x1 + (size_t)t * DM + col + 4 * hf);
                const f32x4 gt = *(const f32x4*)(gate2 + (size_t)b * 6 * DM + col + 4 * hf);
                f32x4 r;
#pragma unroll
                for (int j = 0; j < 4; ++j) { r[j] = xi[j] + gt[j] * acc[8 * i + 4 * hf + j]; acc[8 * i + 4 * hf + j] = r[j]; ss += r[j] * r[j]; }
                if (xout) *(f32x4*)(xout + (size_t)t * DM + col + 4 * hf) = r;
            }
        }
        ss = wave_sum(ss);
        const float rstd = rsqrtf(ss * (1.f / DM) + EPS);
#pragma unroll
        for (int i = 0; i < 4; ++i) {
            const int col = 512 * i + 8 * lane;
            if (final_norm) {
#pragma unroll
                for (int hf = 0; hf < 2; ++hf) {
                    const f32x4 gg = *(const f32x4*)(ng + col + 4 * hf);
                    f32x4 r;
#pragma unroll
                    for (int j = 0; j < 4; ++j) r[j] = acc[8 * i + 4 * hf + j] * rstd * gg[j];
                    *(f32x4*)(fout + (size_t)t * DM + col + 4 * hf) = r;
                }
            } else {
                float yv[8];
#pragma unroll
                for (int hf = 0; hf < 2; ++hf) {
                    const f32x4 gg = *(const f32x4*)(ng + col + 4 * hf), sh = *(const f32x4*)(nshift + (size_t)b * 6 * DM + col + 4 * hf), sc = *(const f32x4*)(nscale + (size_t)b * 6 * DM + col + 4 * hf);
#pragma unroll
                    for (int j = 0; j < 4; ++j) yv[4 * hf + j] = acc[8 * i + 4 * hf + j] * rstd * gg[j] * (1.f + sc[j]) + sh[j];
                }
                u32x4 w; w.x = pack_h2(yv[0], yv[1]); w.y = pack_h2(yv[2], yv[3]); w.z = pack_h2(yv[4], yv[5]); w.w = pack_h2(yv[6], yv[7]);
                *(u32x4*)(hnext + (size_t)t * DM + col) = w;
            }
        }
    }
}

__device__ __forceinline__ void phase_experts8(const Params& p, const float* x1, const float* gate2, const unsigned char* u8, const unsigned char* v8, const float* su, const float* sv,
                              float* xout  , bool final_norm, const float* ng, const float* nshift, const float* nscale, f16* hnext, float* fout) {
    const int tid_ = otid(); const int wid = tid_ >> 6, lane = tid_ & 63;
    const unsigned* pe = (const unsigned*)(p.ws + WS_PE); const float* pg = (const float*)(p.ws + WS_PG);
    const unsigned char* h8 = (const unsigned char*)(p.ws + WS_H8); const float* shv = (const float*)(p.ws + WS_SH);
    for (int t = blockIdx.x * NWAVES + wid; t < NT; t += gridDim.x * NWAVES) {
        const int b = t / SEQ;
        u32x4 hv[2];
#pragma unroll
        for (int i = 0; i < 2; ++i) hv[i] = *(const u32x4*)(h8 + (size_t)t * DM + 1024 * i + 16 * lane);
        const float sht = shv[t];
        float acc[32]; float csum = 0.f;
#pragma unroll
        for (int i = 0; i < 32; ++i) acc[i] = 0.f;
        for (int g4 = 0; g4 < 32; ++g4) {
            const unsigned myexp = pe[(size_t)t * 128 + g4 * 4 + (lane & 3)];
            const float mygate = pg[(size_t)t * 128 + g4 * 4 + (lane & 3)];
            const float mysc = mygate * sv[myexp];
            const float mydsc = su[myexp] * sht;
            int part[4]; u32x4 vr[4][2];
#pragma unroll
            for (int k = 0; k < 4; ++k) {
                const unsigned e = __shfl(myexp, k);
                const unsigned char* ur = u8 + (size_t)e * DM + 16 * lane;
                const unsigned char* vp = v8 + (size_t)e * DM + 16 * lane;
                int d = 0;
#pragma unroll
                for (int i = 0; i < 2; ++i) {
                    const u32x4 w = *(const u32x4*)(ur + 1024 * i);
                    d = __builtin_amdgcn_sdot4((int)hv[i].x, (int)w.x, d, false); d = __builtin_amdgcn_sdot4((int)hv[i].y, (int)w.y, d, false);
                    d = __builtin_amdgcn_sdot4((int)hv[i].z, (int)w.z, d, false); d = __builtin_amdgcn_sdot4((int)hv[i].w, (int)w.w, d, false);
                    vr[k][i] = *(const u32x4*)(vp + 1024 * i);
                }
                part[k] = d;
            }
#pragma unroll
            for (int k = 0; k < 4; ++k) {
#pragma unroll
                for (int o = 32; o >= 1; o >>= 1) part[k] += __shfl_xor(part[k], o);
            }
#pragma unroll
            for (int k = 0; k < 4; ++k) {
                const float d = (float)part[k] * __shfl(mydsc, k);
                const float act = 0.5f * d * (1.f + erff(d * 0.70710678118654752f));
                const float coef = __shfl(mysc, k) * act;
                csum += coef;
#pragma unroll
                for (int i = 0; i < 2; ++i) {
                    const unsigned ww[4] = {vr[k][i].x, vr[k][i].y, vr[k][i].z, vr[k][i].w};
#pragma unroll
                    for (int q = 0; q < 4; ++q) {
                        acc[16 * i + 4 * q + 0] += coef * (float)(ww[q] & 255u); acc[16 * i + 4 * q + 1] += coef * (float)((ww[q] >> 8) & 255u);
                        acc[16 * i + 4 * q + 2] += coef * (float)((ww[q] >> 16) & 255u); acc[16 * i + 4 * q + 3] += coef * (float)(ww[q] >> 24);
                    }
                }
            }
        }
        float ss = 0.f;
#pragma unroll
        for (int i = 0; i < 2; ++i)
#pragma unroll
            for (int q = 0; q < 4; ++q) {
                const int col = 1024 * i + 16 * lane + 4 * q;
                const f32x4 xi = *(const f32x4*)(x1 + (size_t)t * DM + col);
                const f32x4 gt = *(const f32x4*)(gate2 + (size_t)b * 6 * DM + col);
                f32x4 r;
#pragma unroll
                for (int j = 0; j < 4; ++j) { r[j] = xi[j] + gt[j] * (acc[16 * i + 4 * q + j] - 128.f * csum); acc[16 * i + 4 * q + j] = r[j]; ss += r[j] * r[j]; }
                if (xout) *(f32x4*)(xout + (size_t)t * DM + col) = r;
            }
        ss = wave_sum(ss);
        const float rstd = rsqrtf(ss * (1.f / DM) + EPS);
#pragma unroll
        for (int i = 0; i < 2; ++i) {
            const int col0 = 1024 * i + 16 * lane;
            if (final_norm) {
#pragma unroll
                for (int q = 0; q < 4; ++q) {
                    const f32x4 gg = *(const f32x4*)(ng + col0 + 4 * q);
                    f32x4 r;
#pragma unroll
                    for (int j = 0; j < 4; ++j) r[j] = acc[16 * i + 4 * q + j] * rstd * gg[j];
                    *(f32x4*)(fout + (size_t)t * DM + col0 + 4 * q) = r;
                }
            } else {
                float yv[16];
#pragma unroll
                for (int q = 0; q < 4; ++q) {
                    const f32x4 gg = *(const f32x4*)(ng + col0 + 4 * q), sh = *(const f32x4*)(nshift + (size_t)b * 6 * DM + col0 + 4 * q), sc = *(const f32x4*)(nscale + (size_t)b * 6 * DM + col0 + 4 * q);
#pragma unroll
                    for (int j = 0; j < 4; ++j) yv[4 * q + j] = acc[16 * i + 4 * q + j] * rstd * gg[j] * (1.f + sc[j]) + sh[j];
                }
                u32x4 w0, w1;
                w0.x = pack_h2(yv[0], yv[1]); w0.y = pack_h2(yv[2], yv[3]); w0.z = pack_h2(yv[4], yv[5]); w0.w = pack_h2(yv[6], yv[7]);
                w1.x = pack_h2(yv[8], yv[9]); w1.y = pack_h2(yv[10], yv[11]); w1.z = pack_h2(yv[12], yv[13]); w1.w = pack_h2(yv[14], yv[15]);
                *(u32x4*)(hnext + (size_t)t * DM + col0) = w0; *(u32x4*)(hnext + (size_t)t * DM + col0 + 8) = w1;
            }
        }
    }
}

#ifndef EXU_NR
#define EXU_NR 8
#define EXU_SH 11
#endif
__device__ __forceinline__ unsigned xcc_id() { return (unsigned)__builtin_amdgcn_s_getreg((3 << 11) | 20) & 0xFu; }
__device__ __forceinline__ void phase_exu(const Params& p, LAS unsigned char* lds, const unsigned char* u8, const float* su, const float* sv) {
    const int tid = otid(), wid = __builtin_amdgcn_readfirstlane(tid >> 6), lane = tid & 63, sub = lane & 15, qd = lane >> 4;
    const unsigned* pe = (const unsigned*)(p.ws + WS_PE); const float* pg = (const float*)(p.ws + WS_PG);
    const unsigned char* h8 = (const unsigned char*)(p.ws + WS_H8); const float* shv = (const float*)(p.ws + WS_SH);
    unsigned* list = (unsigned*)(p.ws + WS_LIST);
    const unsigned* ctl = (const unsigned*)(p.ws + WS_CTL);
    const unsigned myx = *(const LAS unsigned*)(lds + LDS_BYTES - 16), mybi = *(const LAS unsigned*)(lds + LDS_BYTES - 12);
    int G = 0, g = 0, nb = 1;
#pragma unroll
    for (int j = 0; j < 16; ++j) { const unsigned c = __builtin_amdgcn_readfirstlane(__hip_atomic_load(ctl + j, __ATOMIC_RELAXED, __HIP_MEMORY_SCOPE_AGENT)); if (c > 0u) { if ((unsigned)j < myx) ++g; ++G; } if ((unsigned)j == myx) nb = (int)c; }
    const int tstep = nb * NWAVES, tfirst = (int)mybi * NWAVES + wid;
    const int nvis_t = (tfirst < NT) ? (NT - tfirst + tstep - 1) / tstep : 0;
    const int nrange = (EXU_NR - g + G - 1) / G;
    const int nvis = nvis_t * nrange;
    unsigned ne0 = 0u, ne1 = 0u; u32x4 nhv[8]; float nsh = 0.f;
#define EXU_FETCH(v_) do { const int tt_ = tfirst + ((v_) % nvis_t) * tstep; ne0 = pe[(size_t)tt_ * 128 + lane]; ne1 = pe[(size_t)tt_ * 128 + 64 + lane]; \
        _Pragma("unroll") for (int m = 0; m < 8; ++m) nhv[m] = *(const u32x4*)(h8 + (size_t)tt_ * DM + 256 * m + 16 * sub); nsh = shv[tt_]; } while (0)
    if (nvis > 0) EXU_FETCH(0);
    for (int v = 0; v < nvis; ++v) {
        const int t = tfirst + (v % nvis_t) * tstep, r = g + (v / nvis_t) * G;
        const unsigned e0 = ne0, e1 = ne1; const float sht = nsh;
        u32x4 hv[8];
#pragma unroll
        for (int m = 0; m < 8; ++m) hv[m] = nhv[m];
        if (v + 1 < nvis) EXU_FETCH(v + 1);
        const bool in0 = (int)(e0 >> EXU_SH) == r, in1 = (int)(e1 >> EXU_SH) == r;
        const unsigned long long m0 = __ballot(in0), m1 = __ballot(in1);
        const int n0 = __builtin_popcountll(m0), n = n0 + __builtin_popcountll(m1);
        if (n == 0) continue;
        LAS unsigned* wl = (LAS unsigned*)(lds + wid * 1024 + (v & 1) * 512);
        const unsigned long long below = (1ull << lane) - 1ull;
        if (in0) wl[__builtin_popcountll(m0 & below)] = ((unsigned)lane << 16) | e0;
        if (in1) wl[n0 + __builtin_popcountll(m1 & below)] = ((unsigned)(lane + 64) << 16) | e1;
        __builtin_amdgcn_wave_barrier();
        const int nit = (n + 3) >> 2;
        u32x4 wb[2][8]; unsigned entb[2];
#define EXU_ISSUE(B_, it_) do { const int idx_ = (it_) * 4 + qd; entb[B_] = wl[idx_ < n ? idx_ : 0]; \
            const unsigned char* row_ = u8 + (size_t)(entb[B_] & 0xffffu) * DM + 16 * sub; \
            _Pragma("unroll") for (int m = 0; m < 8; ++m) wb[B_][m] = *(const u32x4*)(row_ + 256 * m); } while (0)
#define EXU_COMPUTE(B_, it_) do { int d_ = 0; \
            _Pragma("unroll") for (int m = 0; m < 8; ++m) { const u32x4 w_ = wb[B_][m]; \
                d_ = __builtin_amdgcn_sdot4((int)hv[m].x, (int)w_.x, d_, false); d_ = __builtin_amdgcn_sdot4((int)hv[m].y, (int)w_.y, d_, false); \
                d_ = __builtin_amdgcn_sdot4((int)hv[m].z, (int)w_.z, d_, false); d_ = __builtin_amdgcn_sdot4((int)hv[m].w, (int)w_.w, d_, false); } \
            d_ += __shfl_xor(d_, 1); d_ += __shfl_xor(d_, 2); d_ += __shfl_xor(d_, 4); d_ += __shfl_xor(d_, 8); \
            if (((it_) * 4 + qd < n) && sub == 0) { \
                const unsigned ent_ = entb[B_], j_ = ent_ >> 16, e_ = ent_ & 0xffffu; \
                const float dd_ = (float)d_ * su[e_] * sht; \
                const float act_ = 0.5f * dd_ * (1.f + erff(dd_ * 0.70710678118654752f)); \
                const float coef_ = pg[(size_t)t * 128 + j_] * sv[e_] * act_ * (1024.f * 256.f); \
                const int ci_ = (int)rintf(fminf(fmaxf(coef_, -32767.f), 32767.f)); \
                unsigned short* l16_ = (unsigned short*)list + ((size_t)(j_ >> 2) * NT + t) * 8 + (j_ & 3u); \
                l16_[0] = (unsigned short)e_; l16_[4] = (unsigned short)ci_; } } while (0)
        EXU_ISSUE(0, 0);
        int it = 0;
        for (; it + 2 < nit; it += 2) {
            EXU_ISSUE(1, it + 1); EXU_COMPUTE(0, it);
            EXU_ISSUE(0, it + 2); EXU_COMPUTE(1, it + 1);
        }
        if (it + 2 == nit) { EXU_ISSUE(1, it + 1); EXU_COMPUTE(0, it); EXU_COMPUTE(1, it + 1); }
        else { EXU_COMPUTE(0, it); }
#undef EXU_ISSUE
#undef EXU_COMPUTE
    }
#undef EXU_FETCH
}

__device__ __forceinline__ void phase_exv(const Params& p, LAS unsigned char* lds, const float* x1, const float* gate2, const unsigned char* v8c, float* xout) {
    const int tid = otid();
    const u32x4* list = (const u32x4*)(p.ws + WS_LIST);
    int cfirst = obid(), cstep = gridDim.x;
    {
        const unsigned* ctl = (const unsigned*)(p.ws + WS_CTL);
        const unsigned myx = *(const LAS unsigned*)(lds + LDS_BYTES - 16), mybi = *(const LAS unsigned*)(lds + LDS_BYTES - 12);
        int G = 0, g = 0, nb = 1; bool uniform = true; unsigned c0 = 0u;
#pragma unroll
        for (int j = 0; j < 16; ++j) { const unsigned c = __builtin_amdgcn_readfirstlane(__hip_atomic_load(ctl + j, __ATOMIC_RELAXED, __HIP_MEMORY_SCOPE_AGENT)); if (c > 0u) { if ((unsigned)j < myx) ++g; ++G; if (c0 == 0u) c0 = c; else if (c != c0) uniform = false; } if ((unsigned)j == myx) nb = (int)c; }
        if (uniform && G * nb == (int)gridDim.x && (int)gridDim.x == 256) { cfirst = g * nb + (int)mybi; cstep = 256; }
    }
    for (int c = cfirst; c < 256; c += cstep) {
        __syncthreads();
        {
            const u32x4* src = (const u32x4*)(v8c + (size_t)c * PEXP * 8);
#pragma unroll 4
            for (int i = 0; i < 16; ++i) *(LAS u32x4*)(lds + (size_t)(i * 512 + tid) * 16) = src[i * 512 + tid];
        }
        __syncthreads();
        typedef short s2_t __attribute__((ext_vector_type(2)));
        for (int t = tid; t < NT; t += NTHREADS) {
            int acc[8]; int csum = 0;
#pragma unroll
            for (int k = 0; k < 8; ++k) acc[k] = 0;
#pragma unroll 1
            for (int jb = 0; jb < 2; ++jb) {
                u32x4 wv[16];
#pragma unroll
                for (int j4 = 0; j4 < 16; ++j4) wv[j4] = list[(size_t)(jb * 16 + j4) * NT + t];
#pragma unroll
                for (int j4 = 0; j4 < 16; ++j4) {
                    const unsigned ee[2] = {wv[j4].x, wv[j4].y}, cc[2] = {wv[j4].z, wv[j4].w};
#pragma unroll
                    for (int h = 0; h < 2; ++h) {
                        const u32x2 v0 = *(const LAS u32x2*)(lds + (ee[h] & 0xffffu) * 8), v1 = *(const LAS u32x2*)(lds + (ee[h] >> 16) * 8);
                        const s2_t cp = __builtin_bit_cast(s2_t, cc[h]);
                        csum = __builtin_amdgcn_sdot2(cp, __builtin_bit_cast(s2_t, 0x00010001u), csum, false);
                        acc[0] = __builtin_amdgcn_sdot2(cp, __builtin_bit_cast(s2_t, __builtin_amdgcn_perm(v1.x, v0.x, 0x0c040c00u)), acc[0], false);
                        acc[1] = __builtin_amdgcn_sdot2(cp, __builtin_bit_cast(s2_t, __builtin_amdgcn_perm(v1.x, v0.x, 0x0c050c01u)), acc[1], false);
                        acc[2] = __builtin_amdgcn_sdot2(cp, __builtin_bit_cast(s2_t, __builtin_amdgcn_perm(v1.x, v0.x, 0x0c060c02u)), acc[2], false);
                        acc[3] = __builtin_amdgcn_sdot2(cp, __builtin_bit_cast(s2_t, __builtin_amdgcn_perm(v1.x, v0.x, 0x0c070c03u)), acc[3], false);
                        acc[4] = __builtin_amdgcn_sdot2(cp, __builtin_bit_cast(s2_t, __builtin_amdgcn_perm(v1.y, v0.y, 0x0c040c00u)), acc[4], false);
                        acc[5] = __builtin_amdgcn_sdot2(cp, __builtin_bit_cast(s2_t, __builtin_amdgcn_perm(v1.y, v0.y, 0x0c050c01u)), acc[5], false);
                        acc[6] = __builtin_amdgcn_sdot2(cp, __builtin_bit_cast(s2_t, __builtin_amdgcn_perm(v1.y, v0.y, 0x0c060c02u)), acc[6], false);
                        acc[7] = __builtin_amdgcn_sdot2(cp, __builtin_bit_cast(s2_t, __builtin_amdgcn_perm(v1.y, v0.y, 0x0c070c03u)), acc[7], false);
                    }
                }
            }
            const int b = t / SEQ, col = 8 * c;
            const int off = csum << 7;
#pragma unroll
            for (int hfi = 0; hfi < 2; ++hfi) {
                const f32x4 xi = *(const f32x4*)(x1 + (size_t)t * DM + col + 4 * hfi);
                const f32x4 gt = *(const f32x4*)(gate2 + (size_t)b * 6 * DM + col + 4 * hfi);
                f32x4 r;
#pragma unroll
                for (int k = 0; k < 4; ++k) r[k] = xi[k] + gt[k] * ((float)(acc[4 * hfi + k] - off) * (1.f / (1024.f * 256.f)));
                *(f32x4*)(xout + (size_t)t * DM + col + 4 * hfi) = r;
            }
        }
    }
}

__device__ __forceinline__ void phase_norm_out(const Params& p, float* x2, bool final_norm, const float* g, const float* shift, const float* scale, f16* hout) {
    const int tid_ = otid(); const int wid = tid_ >> 6, lane = tid_ & 63;
    for (int row = blockIdx.x * NWAVES + wid; row < NT; row += gridDim.x * NWAVES) {
        const int b = row / SEQ;
        float* xr = x2 + (size_t)row * DM;
        f32x4 v[8]; float ss = 0.f;
#pragma unroll
        for (int i = 0; i < 8; ++i) { v[i] = *(const f32x4*)(xr + i * 256 + lane * 4); ss += v[i][0] * v[i][0] + v[i][1] * v[i][1] + v[i][2] * v[i][2] + v[i][3] * v[i][3]; }
        ss = wave_sum(ss);
        const float rstd = rsqrtf(ss * (1.f / DM) + EPS);
#pragma unroll
        for (int i = 0; i < 8; ++i) {
            const int col = i * 256 + lane * 4;
            const f32x4 gg = *(const f32x4*)(g + col);
            if (final_norm) { *(f32x4*)(xr + col) = v[i] * rstd * gg; }
            else {
                const f32x4 sh = *(const f32x4*)(shift + (size_t)b * 6 * DM + col), sc = *(const f32x4*)(scale + (size_t)b * 6 * DM + col);
                const f32x4 y = v[i] * rstd * gg * (sc + 1.f) + sh;
                u32x2 w; w.x = pack_h2(y[0], y[1]); w.y = pack_h2(y[2], y[3]);
                *(u32x2*)(hout + (size_t)row * DM + col) = w;
            }
        }
    }
}

#define XB_TMO      128
#define XB_XCNT(j)  (256  + 64 * (j))
#define XB_XSUB(j)  (1280 + 64 * (j))
#define XB_XGEN(j)  (2304 + 64 * (j))
#define XB_TOP      3328
#define XB_TOPGEN   3392
#define XCD_BAR_WORDS 3456
#define XB_SPIN_CAP (1u << 22)
__device__ __forceinline__ unsigned xb_ld(unsigned* p) { return __hip_atomic_load(p, __ATOMIC_RELAXED, __HIP_MEMORY_SCOPE_AGENT); }
__device__ __forceinline__ unsigned xb_add(unsigned* p, unsigned v) { return __hip_atomic_fetch_add(p, v, __ATOMIC_RELAXED, __HIP_MEMORY_SCOPE_AGENT); }
#define XB_SPIN(cond, bar) do { unsigned _sp = 0; while (cond) { __builtin_amdgcn_s_sleep(1); \
    if ((++_sp & 255u) == 0u) { if (xb_ld(&(bar)[XB_TMO])) break; if (_sp > XB_SPIN_CAP) { atomicAdd(&(bar)[XB_TMO], 1u); break; } } } } while (0)
struct XcdBarrier { unsigned* bar; unsigned x; volatile LAS unsigned* st; };
__device__ __forceinline__ void xcd_barrier_complete(unsigned* bar, unsigned x, unsigned& nloc, unsigned& nx) {
    const unsigned G = gridDim.x * gridDim.y * gridDim.z;
    unsigned sum, cnt, mine, sp = 0u;
    for (;;) {
        sum = 0u; cnt = 0u; mine = 0u;
#pragma unroll
        for (unsigned j = 0; j < 16; ++j) { const unsigned c = xb_ld(&bar[XB_XCNT(j)]); sum += c; cnt += (c > 0u) ? 1u : 0u; mine = (j == x) ? c : mine; }
        if (sum == G) break;
        __builtin_amdgcn_s_sleep(1);
        if ((++sp & 255u) == 0u) { if (xb_ld(&bar[XB_TMO])) break; if (sp > XB_SPIN_CAP) { atomicAdd(&bar[XB_TMO], 1u); break; } }
    }
    nloc = mine > 0u ? mine : 1u; nx = cnt > 0u ? cnt : 1u;
}
__device__ __forceinline__ void xcd_barrier(const XcdBarrier& b) {
    asm volatile("s_waitcnt vmcnt(0)" ::: "memory");
    __syncthreads();
    if (threadIdx.x == 0) {
        unsigned* bar = b.bar;
        __builtin_amdgcn_s_waitcnt(0);
        unsigned nloc = b.st[0], nx = b.st[1];
        if (nloc == 0u) { xcd_barrier_complete(bar, b.x, nloc, nx); b.st[0] = nloc; b.st[1] = nx; }
        const unsigned old = xb_add(&bar[XB_XSUB(b.x)], 1u);
        const unsigned gen = old / nloc;
        if (old + 1u == (gen + 1u) * nloc) {
            __builtin_amdgcn_fence(__ATOMIC_RELEASE, "agent");
            asm volatile("s_waitcnt vmcnt(0)" ::: "memory");
            const unsigned og = xb_add(&bar[XB_TOP], 1u);
            const unsigned tg = og / nx;
            if (og + 1u == (tg + 1u) * nx) xb_add(&bar[XB_TOPGEN], 1u);
            else XB_SPIN(xb_ld(&bar[XB_TOPGEN]) == tg, bar);
            __builtin_amdgcn_fence(__ATOMIC_ACQUIRE, "agent");
            xb_add(&bar[XB_XGEN(b.x)], 1u);
            asm volatile("s_waitcnt vmcnt(0)" ::: "memory");
        } else {
            XB_SPIN(xb_ld(&bar[XB_XGEN(b.x)]) == gen, bar);
            __builtin_amdgcn_fence(__ATOMIC_ACQUIRE, "agent");
            asm volatile("s_waitcnt vmcnt(0)" ::: "memory");
        }
    }
    __syncthreads();
}

constexpr int PH_CONV = 0, PH_N1 = 1, PH_L0 = 2, PH_PER_LAYER = 10, PH_TOTAL = PH_L0 + DEPTH * PH_PER_LAYER;

__global__ void __launch_bounds__(NTHREADS, 2) mega(Params p_arg) {
    extern __shared__ __attribute__((aligned(16))) unsigned char shm[];
    LAS unsigned char* lds = (LAS unsigned char*)shm;
    typedef const Params __attribute__((address_space(4)))* KP;
    const int ph_lo = p_arg.ph_lo, ph_hi = p_arg.ph_hi;
    if (threadIdx.x == 0) {
        const unsigned x = xcc_id();
        const unsigned bi = __hip_atomic_fetch_add((unsigned*)(p_arg.ws + WS_CTL) + x, 1u, __ATOMIC_RELAXED, __HIP_MEMORY_SCOPE_AGENT);
        *(LAS unsigned*)(lds + LDS_BYTES - 16) = x; *(LAS unsigned*)(lds + LDS_BYTES - 12) = bi;
        *(LAS unsigned*)(lds + LDS_BYTES - 32) = 0u; *(LAS unsigned*)(lds + LDS_BYTES - 28) = 0u;
        (void)xb_add((unsigned*)(p_arg.ws + WS_CTL + 256) + XB_XCNT(x), 1u);
    }
    __syncthreads();
    XcdBarrier xbar; xbar.bar = (unsigned*)(p_arg.ws + WS_CTL + 256); xbar.x = *(const LAS unsigned*)(lds + LDS_BYTES - 16); xbar.st = (volatile LAS unsigned*)(lds + LDS_BYTES - 32);
#ifndef PMASK
#define PMASK 0xff
#endif
#define EN(k) ((PMASK >> (k)) & 1)
    for (int ph = ph_lo; ph < ph_hi; ++ph) {
        KP kp = (KP)__builtin_amdgcn_kernarg_segment_ptr();
        asm volatile("" : "+s"(kp));
#if defined(__HIP_DEVICE_COMPILE__)
        const Params p = *kp;
#else
        const Params p = p_arg;
#endif
        unsigned char* ws = p.ws;
        const float* mod = (const float*)(ws + WS_MOD);
        int kind, l = 0, s = -1;
        if (ph == PH_CONV) kind = 0;
        else if (ph == PH_N1) kind = 1;
        else {
            l = (ph - PH_L0) / PH_PER_LAYER; s = (ph - PH_L0) % PH_PER_LAYER;
            kind = (s == 0 || s == 3 || s == 5) ? 2 : (s == 1 ? 4 : (s == 2 ? 5 : (s == 4 ? 1 : (s == 6 ? 6 : (s == 7 ? 7 : (s == 8 ? 8 : 9))))));
        }
        const float* modl = mod + (size_t)l * NB * 6 * DM;
        const float* xin = l == 0 ? p.x : p.out;
        float* x1 = (float*)(ws + WS_X1);
#ifndef REPEAT_KIND
#define REPEAT_KIND -1
#endif
        for (int rep = 0; rep < ((kind == REPEAT_KIND) ? 2 : 1); ++rep) {
        if (rep == 1) xcd_barrier(xbar);
        if (kind == 0) { if (EN(0)) phase_conv(p, lds); }
        else if (kind == 1) {
            if (EN(1)) {
                if (s < 0) phase_norm2<0>(p.x, nullptr, p.n1g, mod + 0 * DM, mod + 1 * DM, (f16*)(ws + WS_H), nullptr, nullptr);
                else phase_norm2<1>(x1, nullptr, p.n2g + (size_t)l * DM, modl + 3 * DM, modl + 4 * DM, (f16*)(ws + WS_H), (unsigned*)(ws + WS_H8), (float*)(ws + WS_SH));
            }
        } else if (kind == 2) {
            if (EN(2)) {
                Epi E{}; const f16* A; const f16* Bt; int N;
                if (s == 0) { E.mode = 2; E.rope128 = (const float*)(ws + WS_ROPE128); E.rope64 = (const float*)(ws + WS_ROPE64); E.o16 = (f16*)(ws + WS_PROJ); E.ldc = INWP; A = (const f16*)(ws + WS_H); Bt = (const f16*)(ws + WS_WTIN) + (size_t)l * INWP * DM; N = INWP; }
                else if (s == 3) { E.mode = 1; E.o32 = x1; E.xin = xin; E.gate = modl + 2 * DM; A = (const f16*)(ws + WS_Y); Bt = (const f16*)(ws + WS_WTOUT) + (size_t)l * DM * DM; N = DM; }
                else { E.mode = 0; E.o16 = (f16*)(ws + WS_Y); E.ldc = DM; A = (const f16*)(ws + WS_H); Bt = (const f16*)(ws + WS_WTQ) + (size_t)l * DM * DM; N = DM; }
                gemm_run(p, lds, A, Bt, N, E);
            }
        } else if (kind == 3) { if (EN(3)) phase_rope(p); }
        else if (kind == 4) { if (EN(4)) phase_index2(p, lds); }
        else if (kind == 5) { if (EN(5)) phase_attn2(p, lds, p.ong + (size_t)l * DM, (unsigned*)(ws + WS_CTL + 64) + l); }
        else if (kind == 6) { if (EN(6)) phase_route2(p, lds, (const f16*)(ws + WS_SUBK) + (size_t)l * PH * 2 * PNK * 128); }
        else if (kind == 7) {
            if (EN(7)) phase_exu(p, lds, ws + WS_U8 + (size_t)l * PEXP * DM, (const float*)(ws + WS_SU) + (size_t)l * PEXP, (const float*)(ws + WS_SV) + (size_t)l * PEXP);
        } else if (kind == 8) {
            if (EN(7)) phase_exv(p, lds, x1, modl + 5 * DM, ws + WS_V8 + (size_t)l * PEXP * DM, p.out);
        } else {
            const bool fin = (l == DEPTH - 1);
            const float* modn = mod + (size_t)(fin ? l : l + 1) * NB * 6 * DM;
            if (EN(1)) { if (fin) phase_norm2<2>(nullptr, p.out, p.fg, nullptr, nullptr, nullptr, nullptr, nullptr);
                         else phase_norm2<0>(p.out, nullptr, p.n1g + (size_t)(l + 1) * DM, modn + 0 * DM, modn + 1 * DM, (f16*)(ws + WS_H), nullptr, nullptr); }
        }
        }
        if (ph + 1 < ph_hi) { if (ph == ph_lo) cg::this_grid().sync(); else xcd_barrier(xbar); }
    }
}

extern "C" void kernel_launch(void* const* d_in, const int* in_sizes, int n_in, void* d_out, int out_size, void* d_ws, size_t ws_size, hipStream_t stream) {
    static int grid = 0;
    if (grid == 0) {
        if (n_in != 14 || out_size != NT * DM || ws_size < WS_END) { fprintf(stderr, "kernel_launch: unexpected sizes (n_in %d out %d ws %zu need %zu)\n", n_in, out_size, ws_size, (size_t)WS_END); grid = -1; return; }
        if (hipFuncSetAttribute((const void*)mega, hipFuncAttributeMaxDynamicSharedMemorySize, LDS_BYTES) != hipSuccess) { fprintf(stderr, "kernel_launch: hipFuncSetAttribute failed\n"); grid = -1; return; }
        int dev = 0, cus = 0, per_cu = 0;
        hipGetDevice(&dev); hipDeviceGetAttribute(&cus, hipDeviceAttributeMultiprocessorCount, dev);
        hipOccupancyMaxActiveBlocksPerMultiprocessor(&per_cu, (const void*)mega, NTHREADS, LDS_BYTES);
        if (per_cu < 1) { fprintf(stderr, "kernel_launch: occupancy query says %d blocks per CU\n", per_cu); grid = -1; return; }
        grid = cus;
    }
    if (grid < 0) return;
    Params p{};
    p.x = (const float*)d_in[0]; p.c = (const float*)d_in[1]; p.ada_w = (const float*)d_in[2]; p.ada_b = (const float*)d_in[3];
    p.n1g = (const float*)d_in[4]; p.n2g = (const float*)d_in[5]; p.w_in = (const float*)d_in[6]; p.ong = (const float*)d_in[7];
    p.w_out = (const float*)d_in[8]; p.wq = (const float*)d_in[9]; p.subk = (const float*)d_in[10]; p.pu = (const float*)d_in[11];
    p.pv = (const float*)d_in[12]; p.fg = (const float*)d_in[13];
    p.out = (float*)d_out; p.ws = (unsigned char*)d_ws;
#if 0
    for (int ph = 0; ph < PH_TOTAL; ++ph) {
        p.ph_lo = ph; p.ph_hi = ph + 1;
        hipLaunchKernelGGL(mega, dim3(grid), dim3(NTHREADS), LDS_BYTES, stream, p);
    }
#else
    p.ph_lo = 0; p.ph_hi = PH_TOTAL;
    if (hipMemsetAsync((char*)d_ws + WS_CTL, 0, CTL_BYTES, stream) != hipSuccess) { fprintf(stderr, "kernel_launch: memset of control words failed\n"); return; }
    void* args[] = {&p};
    hipError_t e = hipLaunchCooperativeKernel((const void*)mega, dim3(grid), dim3(NTHREADS), args, LDS_BYTES, stream);
    if (e != hipSuccess) fprintf(stderr, "cooperative launch failed: %s (grid %d)\n", hipGetErrorString(e), grid);
#endif
}
```

```cpp
#include <hip/hip_runtime.h>
#include <hip/hip_cooperative_groups.h>
#include <cstdio>
#include <cstdint>
namespace cg = cooperative_groups;

#define LAS __attribute__((address_space(3)))
typedef _Float16 f16;
typedef _Float16 h2_t __attribute__((ext_vector_type(2)));
typedef _Float16 h4_t __attribute__((ext_vector_type(4)));
typedef _Float16 h8_t __attribute__((ext_vector_type(8)));
typedef float f32x4 __attribute__((ext_vector_type(4)));
typedef unsigned u32x4 __attribute__((ext_vector_type(4)));
typedef unsigned u32x2 __attribute__((ext_vector_type(2)));

constexpr int NB = 8, SEQ = 2048, DM = 2048, NT = NB * SEQ, DEPTH = 2;
constexpr int HD = 128, HA = 6, HB = 5, HC = 5, NHEADS = 16;
constexpr int IH = 16, IDM = 64, DSA_TOPK = 256;
constexpr int MOBA_BLK = 256, MOBA_NB = 8;
constexpr int INW = 5968, INWP = 6144;
constexpr int PH = 8, PNK = 128, PTOPK = 16, PEXP = 16384;
constexpr float EPS = 1e-6f;
constexpr int C_QA = 0, C_KA = 768, C_VA = 896, C_IQ = 1024, C_IK = 2048, C_IW = 2112, C_QB = 2176, C_KB = 2816, C_VB = 3456,
              C_QC = 4096, C_KC = 4736, C_VC = 5376, C_END = 6016;

#ifndef LAST_BITS
#define LAST_BITS 8
#endif
constexpr int NTHREADS = 512, NWAVES = 8;
constexpr int LDS_BYTES = 147456;

constexpr size_t al256(size_t x) { return (x + 255) & ~(size_t)255; }
constexpr size_t WS_WTIN = 0;
constexpr size_t WS_WTOUT = WS_WTIN + (size_t)DEPTH * INWP * DM * 2;
constexpr size_t WS_WTQ = WS_WTOUT + (size_t)DEPTH * DM * DM * 2;
constexpr size_t WS_U8 = WS_WTQ + (size_t)DEPTH * DM * DM * 2;
constexpr size_t WS_V8 = WS_U8 + (size_t)DEPTH * PEXP * DM;
constexpr size_t WS_SU = WS_V8 + (size_t)DEPTH * PEXP * DM;
constexpr size_t WS_SV = WS_SU + (size_t)DEPTH * PEXP * 4;
constexpr size_t WS_H8 = WS_SV + (size_t)DEPTH * PEXP * 4;
constexpr size_t WS_SH = WS_H8 + (size_t)NT * DM;
constexpr size_t WS_HS = WS_SH + (size_t)NT * 4;
constexpr size_t WS_SUBK = WS_HS + (size_t)NT * 4;
constexpr size_t WS_MOD = WS_SUBK + (size_t)DEPTH * PH * 2 * PNK * 128 * 2;
constexpr size_t WS_ROPE128 = WS_MOD + (size_t)DEPTH * NB * 6 * DM * 4;
constexpr size_t WS_ROPE64 = WS_ROPE128 + (size_t)SEQ * 64 * 8;
constexpr size_t WS_H = WS_ROPE64 + (size_t)SEQ * 32 * 8;
constexpr size_t WS_PROJ = WS_H + (size_t)NT * DM * 2;
constexpr size_t WS_KMEAN = WS_PROJ + (size_t)NT * INWP * 2;
constexpr size_t WS_MASK = WS_KMEAN + al256((size_t)NB * HC * MOBA_NB * HD * 4);
constexpr size_t WS_Y = WS_MASK + (size_t)NB * SEQ * 64 * 4;
constexpr size_t WS_X1 = WS_Y + (size_t)NT * DM * 2;
constexpr size_t WS_X2 = WS_X1 + (size_t)NT * DM * 2;
constexpr size_t WS_PE = WS_X1 + (size_t)NT * DM * 4;
constexpr size_t WS_PG = WS_PE + (size_t)NT * 128 * 4;
constexpr size_t WS_LIST = WS_PG + (size_t)NT * 128 * 4;
constexpr size_t WS_CTL = WS_LIST + (size_t)NT * 128 * 4;
constexpr size_t CTL_BYTES = 16384;
constexpr size_t WS_END = WS_CTL + CTL_BYTES;

struct Params {
    const float *x, *c, *ada_w, *ada_b, *n1g, *n2g, *w_in, *ong, *w_out, *wq, *subk, *pu, *pv, *fg;
    float* out;
    unsigned char* ws;
    int ph_lo, ph_hi;
};

__device__ __forceinline__ int otid() { int t = threadIdx.x; asm volatile("" : "+v"(t)); return t; }
__device__ __forceinline__ int obid() { int t = blockIdx.x; asm volatile("" : "+s"(t)); return t; }
__device__ __forceinline__ float wave_sum(float v) {
#pragma unroll
    for (int o = 32; o >= 1; o >>= 1) v += __shfl_xor(v, o);
    return v;
}
__device__ __forceinline__ float wave_max(float v) {
#pragma unroll
    for (int o = 32; o >= 1; o >>= 1) v = fmaxf(v, __shfl_xor(v, o));
    return v;
}
__device__ __forceinline__ unsigned pack_h2(float a, float b) { h2_t r; r.x = (f16)a; r.y = (f16)b; return __builtin_bit_cast(unsigned, r); }
__device__ __forceinline__ float h_lo(unsigned u) { h2_t r = __builtin_bit_cast(h2_t, u); return (float)r.x; }
__device__ __forceinline__ float h_hi(unsigned u) { h2_t r = __builtin_bit_cast(h2_t, u); return (float)r.y; }
__device__ __forceinline__ float dot2(unsigned a, unsigned b, float c) {
    return __builtin_amdgcn_fdot2(__builtin_bit_cast(h2_t, a), __builtin_bit_cast(h2_t, b), c, false);
}

namespace pg8 {
constexpr int BM = 256, BK = 64, HALF = 128, HTB = HALF * BK * 2, STAGE_BYTES = 8 * HTB, NXCD = 8, WGM = 8;
__host__ __device__ __forceinline__ int lds_byte(int r, int c) { const int st = (r >> 4) * 2 + (c >> 5), rr = r & 15, cc = c & 31, ob = rr * 64 + cc * 2; return st * 1024 + (ob ^ (((ob >> 9) & 1) << 5)); }
__host__ __device__ __forceinline__ void stage_rc(int b, int& R, int& C) { const int st = b / 1024, sb = b % 1024, swz = sb ^ (((sb >> 9) & 1) << 5); R = (st >> 1) * 16 + swz / 64; C = (st & 1) * 32 + (swz % 64) / 2; }
struct Unit { int pm, pn; };
struct Gemm { const unsigned short* A; const unsigned short* Bt; int M, N, K; };
struct StaticOrder {
    int nM, nN, nwg, G, c;
    __host__ __device__ void init(int M, int N, int G_, int c_) { nM = M / BM; nN = N / BM; nwg = nM * nN; G = G_; c = c_; }
    __host__ __device__ bool next(int i, Unit& u) const {
        const long L = (long)i * G + c; if (L >= nwg) return false;
        int wgid = (int)L; { const int q = nwg / NXCD, r = nwg % NXCD, xcd = wgid % NXCD, off = wgid / NXCD; wgid = (xcd < r ? xcd * (q + 1) : r * (q + 1) + (xcd - r) * q) + off; }
        const int nig = WGM * nN, gid = wgid / nig, fm = gid * WGM, gsz = (nM - fm) < WGM ? (nM - fm) : WGM;
        u.pm = fm + ((wgid % nig) % gsz); u.pn = (wgid % nig) / gsz; return true;
    }
};

template <class Epi>
__device__ __forceinline__ void gemm_phase(LAS unsigned char* lds, const Gemm g, const StaticOrder& S, const Epi& E) {
    const int tid = otid(), wid = __builtin_amdgcn_readfirstlane(tid >> 6), lane = tid & 63, wr = wid >> 2, wc = wid & 3, fr = lane & 15, fq = lane >> 4;
    const int K = g.K, nt = K / BK;
    unsigned voffA[2], voffB[2];
#pragma unroll
    for (int i = 0; i < 2; ++i) { int R, C; stage_rc(tid * 16 + i * 8192, R, C); voffA[i] = (unsigned)(R * K + C) * 2u; voffB[i] = (unsigned)(R * K + C) * 2u; }
    const size_t kstep = (size_t)(BK * 2);
    const size_t hstep = (size_t)HALF * K * 2;
    const size_t tstep = 2 * hstep;
    const unsigned ldsw = (unsigned)wid * 1024u;
    const int aoff = lds_byte(wr * 64 + fr, fq * 8), boff = lds_byte(wc * 32 + fr, fq * 8);
#define PG8_SA(b, h) (((b) * 2 + (h)) * HTB)
#define PG8_SB(b, h) ((4 + (b) * 2 + (h)) * HTB)
#define PG8_STAGE(bufoff, gbase, voff) do { _Pragma("unroll") for (int _i = 0; _i < 2; ++_i) \
        __builtin_amdgcn_global_load_lds((const unsigned*)((const char*)(gbase) + (voff)[_i]), (LAS unsigned*)(lds + (bufoff) + ldsw + _i * 8192), 16, 0, 0); } while (0)
#define PG8_LDA(dst, b, h) do { _Pragma("unroll") for (int m = 0; m < 4; ++m) _Pragma("unroll") for (int k = 0; k < 2; ++k) dst[m][k] = *(const LAS h8_t*)(lds + PG8_SA(b, h) + aoff + m * 2048 + k * 1024); } while (0)
#define PG8_LDB(dst, b, h) do { _Pragma("unroll") for (int n = 0; n < 2; ++n) _Pragma("unroll") for (int k = 0; k < 2; ++k) dst[n][k] = *(const LAS h8_t*)(lds + PG8_SB(b, h) + boff + n * 2048 + k * 1024); } while (0)
#define PG8_MMA(ai, bj, At, Bt) do { __builtin_amdgcn_s_setprio(1); _Pragma("unroll") for (int m = 0; m < 4; ++m) _Pragma("unroll") for (int n = 0; n < 2; ++n) _Pragma("unroll") for (int k = 0; k < 2; ++k) \
        acc[ai][bj][m][n] = __builtin_amdgcn_mfma_f32_16x16x32_f16(Bt[n][k], At[m][k], acc[ai][bj][m][n], 0, 0, 0); __builtin_amdgcn_s_setprio(0); } while (0)
#define PG8_WAIT_V(n) asm volatile("s_waitcnt vmcnt(" #n ")" ::: "memory")
#define PG8_WAIT_L(n) asm volatile("s_waitcnt lgkmcnt(" #n ")" ::: "memory")
#define PG8_BAR __builtin_amdgcn_s_barrier()
#define PG8_SCHED __builtin_amdgcn_sched_barrier(0)
    Unit cur, nxt; int ui = 0;
    if (!S.next(0, cur)) return;
    f32x4 acc[2][2][4][2];
#pragma unroll
    for (int a = 0; a < 2; ++a)
#pragma unroll
        for (int b = 0; b < 2; ++b)
#pragma unroll
            for (int m = 0; m < 4; ++m)
#pragma unroll
                for (int n = 0; n < 2; ++n) acc[a][b][m][n] = (f32x4){0.f, 0.f, 0.f, 0.f};
    h8_t At[4][2], B0[2][2], B1[2][2];
    const char* cA = (const char*)g.A + (size_t)cur.pm * tstep; const char* cB = (const char*)g.Bt + (size_t)cur.pn * tstep;
    PG8_STAGE(PG8_SB(0, 0), cB, voffB); PG8_STAGE(PG8_SA(0, 0), cA, voffA); PG8_STAGE(PG8_SB(0, 1), cB + hstep, voffB); PG8_STAGE(PG8_SA(0, 1), cA + hstep, voffA);
    if (wr == 1) PG8_BAR;
    PG8_WAIT_V(4); PG8_BAR;
    PG8_STAGE(PG8_SB(1, 0), cB + kstep, voffB); PG8_STAGE(PG8_SA(1, 0), cA + kstep, voffA); PG8_STAGE(PG8_SB(1, 1), cB + hstep + kstep, voffB);
    PG8_WAIT_V(6); PG8_BAR;
    for (;;) {
        const bool has_next = S.next(ui + 1, nxt);
        const char* nA = has_next ? (const char*)g.A + (size_t)nxt.pm * tstep : cA; const char* nB = has_next ? (const char*)g.Bt + (size_t)nxt.pn * tstep : cB;
        for (int t = 0; t < nt; t += 2) {
            const bool last = (t == nt - 2);
            const char* a1 = cA + (size_t)(t + 1) * kstep;
            const char* a2 = last ? nA : cA + (size_t)(t + 2) * kstep; const char* b2 = last ? nB : cB + (size_t)(t + 2) * kstep;
            const char* a3 = a2 + kstep; const char* b3 = b2 + kstep;
            PG8_LDB(B0, 0, 0); PG8_SCHED; PG8_LDA(At, 0, 0); PG8_STAGE(PG8_SA(1, 1), a1 + hstep, voffA);
            PG8_WAIT_L(8); PG8_BAR; PG8_WAIT_L(0); PG8_MMA(0, 0, At, B0); PG8_BAR; PG8_SCHED;
            PG8_LDB(B1, 0, 1); PG8_STAGE(PG8_SB(0, 0), b2, voffB);
            PG8_BAR; PG8_WAIT_L(0); PG8_MMA(0, 1, At, B1); PG8_BAR;
            PG8_LDA(At, 0, 1); PG8_STAGE(PG8_SA(0, 0), a2, voffA);
            PG8_BAR; PG8_WAIT_L(0); PG8_MMA(1, 0, At, B0); PG8_BAR; PG8_SCHED;
            PG8_STAGE(PG8_SB(0, 1), b2 + hstep, voffB);
            PG8_WAIT_V(6); PG8_BAR; PG8_MMA(1, 1, At, B1); PG8_BAR;
            PG8_LDB(B0, 1, 0); PG8_SCHED; PG8_LDA(At, 1, 0); PG8_STAGE(PG8_SA(0, 1), a2 + hstep, voffA);
            PG8_WAIT_L(8); PG8_BAR; PG8_WAIT_L(0); PG8_MMA(0, 0, At, B0); PG8_BAR; PG8_SCHED;
            PG8_LDB(B1, 1, 1); PG8_STAGE(PG8_SB(1, 0), b3, voffB);
            PG8_BAR; PG8_WAIT_L(0); PG8_MMA(0, 1, At, B1); PG8_BAR;
            PG8_LDA(At, 1, 1); PG8_STAGE(PG8_SA(1, 0), a3, voffA);
            PG8_BAR; PG8_WAIT_L(0); PG8_MMA(1, 0, At, B0); PG8_BAR; PG8_SCHED;
            PG8_STAGE(PG8_SB(1, 1), b3 + hstep, voffB);
            PG8_WAIT_V(6); PG8_BAR; PG8_MMA(1, 1, At, B1); PG8_BAR;
        }
        E(acc, cur, wr, wc, fr, fq);
        if (!has_next) break;
#pragma unroll
        for (int a = 0; a < 2; ++a)
#pragma unroll
            for (int b = 0; b < 2; ++b)
#pragma unroll
                for (int m = 0; m < 4; ++m)
#pragma unroll
                    for (int n = 0; n < 2; ++n) acc[a][b][m][n] = (f32x4){0.f, 0.f, 0.f, 0.f};
        cur = nxt; cA = nA; cB = nB; ++ui;
    }
    PG8_WAIT_V(0);
    if (wr == 0) PG8_BAR;
    PG8_BAR;
#undef PG8_SA
#undef PG8_SB
#undef PG8_STAGE
#undef PG8_LDA
#undef PG8_LDB
#undef PG8_MMA
#undef PG8_WAIT_V
#undef PG8_WAIT_L
#undef PG8_BAR
#undef PG8_SCHED
}
}

__device__ __forceinline__ int win_src_col_l(int pc) { return pc < 2128 ? pc : (pc < C_QB ? -1 : (pc < C_END ? pc - 48 : -1)); }
__device__ __forceinline__ int rope_type(int g) { return (g <= 6 || (g >= 32 && g <= 41)) ? 1 : ((g >= 8 && g <= 15) ? 2 : (g == 16 ? 3 : 0)); }
__device__ __forceinline__ int win_src_col(int pc) {
    const int g = pc >> 7, p = pc & 127, ty = rope_type(g);
    int l = p;
    if (ty == 1) { const int q4 = p >> 2, e = p & 3; l = 2 * q4 + (e >> 1) + 64 * (e & 1); }
    else if (ty == 2 || (ty == 3 && p < 64)) { const int hb = p >> 6, pp = p & 63, q4 = pp >> 2, e = pp & 3; l = hb * 64 + 2 * q4 + (e >> 1) + 32 * (e & 1); }
    return win_src_col_l(g * 128 + l);
}


struct Epi {
    int mode; f16* o16; int ldc; float* o32; const float* xin; const f16* xinh; const float* gate; const float* rope128; const float* rope64;
    __device__ __forceinline__ void operator()(const f32x4 (&acc)[2][2][4][2], const pg8::Unit& u, int wr, int wc, int fr, int fq) const {
        const int row0 = u.pm * 256 + wr * 64 + fr, col0 = u.pn * 256 + wc * 32 + 4 * fq;
        if (mode == 2) {
#pragma unroll
            for (int bj = 0; bj < 2; ++bj) {
                const int g = __builtin_amdgcn_readfirstlane(u.pn * 2 + bj);
                int ty = rope_type(g); if (ty == 3) ty = (wc < 2) ? 2 : 0;
                f16* ob = o16 + (size_t)g * 128;
                if (ty == 0) {
#pragma unroll
                    for (int ai = 0; ai < 2; ++ai)
#pragma unroll
                        for (int m = 0; m < 4; ++m)
#pragma unroll
                            for (int n = 0; n < 2; ++n) {
                                const f32x4 v = acc[ai][bj][m][n];
                                u32x2 w; w.x = pack_h2(v[0], v[1]); w.y = pack_h2(v[2], v[3]);
                                *(u32x2*)(ob + (size_t)(row0 + ai * 128 + m * 16) * ldc + wc * 32 + n * 16 + 4 * fq) = w;
                            }
                } else {
                    const float* tab = ty == 1 ? rope128 : rope64;
                    const int half = ty == 1 ? 64 : 32, tw = ty == 1 ? 128 : 64;
#pragma unroll
                    for (int ai = 0; ai < 2; ++ai)
#pragma unroll
                        for (int m = 0; m < 4; ++m) {
                            const int row = row0 + ai * 128 + m * 16, pos = row & (SEQ - 1);
#pragma unroll
                            for (int n = 0; n < 2; ++n) {
                                const int p = wc * 32 + n * 16 + 4 * fq;
                                const int j = ty == 1 ? (p >> 1) : ((p & 63) >> 1), base = ty == 1 ? 0 : (p & 64);
                                const f32x4 cs = *(const f32x4*)(tab + (size_t)pos * tw + 2 * j);
                                const f32x4 v = acc[ai][bj][m][n];
                                const float o1a = v[0] * cs[0] - v[1] * cs[1], o2a = v[1] * cs[0] + v[0] * cs[1];
                                const float o1b = v[2] * cs[2] - v[3] * cs[3], o2b = v[3] * cs[2] + v[2] * cs[3];
                                f16* op = ob + (size_t)row * ldc + base + j;
                                *(unsigned*)op = pack_h2(o1a, o1b); *(unsigned*)(op + half) = pack_h2(o2a, o2b);
                            }
                        }
                }
            }
            return;
        }
        if (mode == 1) {
            const int b = row0 / SEQ;
            f32x4 gt[2][2];
#pragma unroll
            for (int bj = 0; bj < 2; ++bj)
#pragma unroll
                for (int n = 0; n < 2; ++n) gt[bj][n] = *(const f32x4*)(gate + (size_t)b * 6 * DM + col0 + bj * 128 + n * 16);
#pragma unroll
            for (int ai = 0; ai < 2; ++ai)
#pragma unroll
                for (int mh = 0; mh < 2; ++mh) {
                    f32x4 xi[2][2][2];
#pragma unroll
                    for (int m2 = 0; m2 < 2; ++m2)
#pragma unroll
                        for (int bj = 0; bj < 2; ++bj)
#pragma unroll
                            for (int n = 0; n < 2; ++n) {
                                const size_t o = (size_t)(row0 + ai * 128 + (2 * mh + m2) * 16) * DM + col0 + bj * 128 + n * 16;
                                if (xinh) { const u32x2 w = *(const u32x2*)(xinh + o); xi[m2][bj][n] = (f32x4){h_lo(w.x), h_hi(w.x), h_lo(w.y), h_hi(w.y)}; }
                                else xi[m2][bj][n] = *(const f32x4*)(xin + o);
                            }
#pragma unroll
                    for (int m2 = 0; m2 < 2; ++m2)
#pragma unroll
                        for (int bj = 0; bj < 2; ++bj)
#pragma unroll
                            for (int n = 0; n < 2; ++n) {
                                const f32x4 r = xi[m2][bj][n] + gt[bj][n] * acc[ai][bj][2 * mh + m2][n];
                                u32x2 w; w.x = pack_h2(r[0], r[1]); w.y = pack_h2(r[2], r[3]);
                                *(u32x2*)(o16 + (size_t)(row0 + ai * 128 + (2 * mh + m2) * 16) * DM + col0 + bj * 128 + n * 16) = w;
                            }
                }
            return;
        }
#pragma unroll
        for (int ai = 0; ai < 2; ++ai)
#pragma unroll
            for (int m = 0; m < 4; ++m) {
                const int row = row0 + ai * 128 + m * 16;
#pragma unroll
                for (int bj = 0; bj < 2; ++bj)
#pragma unroll
                    for (int n = 0; n < 2; ++n) {
                        const int col = col0 + bj * 128 + n * 16;
                        const f32x4 v = acc[ai][bj][m][n];
                        if (mode == 0) {
                            u32x2 w; w.x = pack_h2(v[0], v[1]); w.y = pack_h2(v[2], v[3]);
                            *(u32x2*)(o16 + (size_t)row * ldc + col) = w;
                        } else {
                            const int b = row / SEQ;
                            const f32x4 xi = *(const f32x4*)(xin + (size_t)row * DM + col);
                            const f32x4 gt = *(const f32x4*)(gate + (size_t)b * 6 * DM + col);
                            *(f32x4*)(o32 + (size_t)row * DM + col) = xi + gt * v;
                        }
                    }
            }
    }
};

__device__ __forceinline__ void gemm_run(const Params& p, LAS unsigned char* lds, const f16* A, const f16* Bt, int N, const Epi& E) {
    pg8::Gemm g; g.A = (const unsigned short*)A; g.Bt = (const unsigned short*)Bt; g.M = NT; g.N = N; g.K = DM;
    pg8::StaticOrder S; S.init(NT, N, (int)gridDim.x, (int)blockIdx.x);
    pg8::gemm_phase<Epi>(lds, g, S, E);
}

__device__ __forceinline__ void transpose_tiles(const float* src, int ldsrc, int ncols_phys, bool is_win, f16* dst, float* tile  , int& unit_base, int unit_lo) {
    const int tn = ncols_phys / 64, tk = DM / 64, ntile = tn * tk;
    const int tid = otid();
    float cur[8], nxt[8];
#define TT_LOAD(R_, u_) do { const int n0_ = ((u_) % tn) * 64, k0_ = ((u_) / tn) * 64; \
        _Pragma("unroll") for (int i = 0; i < 8; ++i) { const int e = tid + i * 512, r = e >> 6, c = e & 63; const int pc = n0_ + c; const int sc = is_win ? win_src_col(pc) : pc; \
            R_[i] = sc >= 0 ? src[(size_t)(k0_ + r) * ldsrc + sc] : 0.f; } } while (0)
    int u = blockIdx.x;
    if (u < ntile) TT_LOAD(nxt, u);
    for (; u < ntile; u += gridDim.x) {
        const int n0 = (u % tn) * 64, k0 = (u / tn) * 64;
#pragma unroll
        for (int i = 0; i < 8; ++i) cur[i] = nxt[i];
        if (u + (int)gridDim.x < ntile) TT_LOAD(nxt, u + gridDim.x);
        __syncthreads();
#pragma unroll
        for (int i = 0; i < 8; ++i) { const int e = tid + i * 512, r = e >> 6, c = e & 63; tile[r * 65 + c] = cur[i]; }
        __syncthreads();
        {
            const int n = tid >> 3, kq = (tid & 7) * 8;
            u32x4 w;
            w.x = pack_h2(tile[(kq + 0) * 65 + n], tile[(kq + 1) * 65 + n]); w.y = pack_h2(tile[(kq + 2) * 65 + n], tile[(kq + 3) * 65 + n]);
            w.z = pack_h2(tile[(kq + 4) * 65 + n], tile[(kq + 5) * 65 + n]); w.w = pack_h2(tile[(kq + 6) * 65 + n], tile[(kq + 7) * 65 + n]);
            *(u32x4*)(dst + (size_t)(n0 + n) * DM + k0 + kq) = w;
        }
    }
#undef TT_LOAD
    (void)unit_base; (void)unit_lo;
}

__device__ __forceinline__ void cvt_f16_stream(const float* src, f16* dst, size_t n) {
    const size_t stride = (size_t)gridDim.x * NTHREADS;
    for (size_t i = (size_t)blockIdx.x * NTHREADS + otid(); i < n / 8; i += stride) {
        const f32x4 a = *(const f32x4*)(src + i * 8), b = *(const f32x4*)(src + i * 8 + 4);
        u32x4 w; w.x = pack_h2(a[0], a[1]); w.y = pack_h2(a[2], a[3]); w.z = pack_h2(b[0], b[1]); w.w = pack_h2(b[2], b[3]);
        *(u32x4*)(dst + i * 8) = w;
    }
}

__device__ __forceinline__ void quant_rows(const float* src, int nrows, unsigned* dst, float* scale, int bias) {
    const int tid_ = otid(); const int wid = tid_ >> 6, lane = tid_ & 63;
    const int rstep = gridDim.x * NWAVES;
    int row = blockIdx.x * NWAVES + wid;
    f32x4 v[8], nv[8];
    if (row < nrows) {
#pragma unroll
        for (int i = 0; i < 8; ++i) nv[i] = *(const f32x4*)(src + (size_t)row * DM + i * 256 + lane * 4);
    }
    for (; row < nrows; row += rstep) {
#pragma unroll
        for (int i = 0; i < 8; ++i) v[i] = nv[i];
        if (row + rstep < nrows) {
#pragma unroll
            for (int i = 0; i < 8; ++i) nv[i] = *(const f32x4*)(src + (size_t)(row + rstep) * DM + i * 256 + lane * 4);
        }
        float am = 0.f;
#pragma unroll
        for (int i = 0; i < 8; ++i) am = fmaxf(am, fmaxf(fmaxf(fabsf(v[i][0]), fabsf(v[i][1])), fmaxf(fabsf(v[i][2]), fabsf(v[i][3]))));
        am = wave_max(am);
        const float sc = am > 0.f ? am * (1.f / 127.f) : 1.f, inv = 1.f / sc;
        if (lane == 0) scale[row] = sc;
#pragma unroll
        for (int i = 0; i < 8; ++i) {
            unsigned w = 0u;
#pragma unroll
            for (int j = 0; j < 4; ++j) { const int q = (int)rintf(v[i][j] * inv) + bias; w |= ((unsigned)q & 255u) << (8 * j); }
            dst[(size_t)row * (DM / 4) + i * 64 + lane] = w;
        }
    }
}

__device__ __forceinline__ void quant_rows4(const float* src, int nrows, unsigned* dst, float* scale) {
    const int tid_ = otid(); const int wid = tid_ >> 6, lane = tid_ & 63;
    const int rstep = gridDim.x * NWAVES;
    int row = blockIdx.x * NWAVES + wid;
    f32x4 v[8], nv[8];
    if (row < nrows) {
#pragma unroll
        for (int i = 0; i < 8; ++i) nv[i] = *(const f32x4*)(src + (size_t)row * DM + i * 256 + lane * 4);
    }
    for (; row < nrows; row += rstep) {
#pragma unroll
        for (int i = 0; i < 8; ++i) v[i] = nv[i];
        if (row + rstep < nrows) {
#pragma unroll
            for (int i = 0; i < 8; ++i) nv[i] = *(const f32x4*)(src + (size_t)(row + rstep) * DM + i * 256 + lane * 4);
        }
        float am = 0.f;
#pragma unroll
        for (int i = 0; i < 8; ++i) am = fmaxf(am, fmaxf(fmaxf(fabsf(v[i][0]), fabsf(v[i][1])), fmaxf(fabsf(v[i][2]), fabsf(v[i][3]))));
        am = wave_max(am);
        const float sc = am > 0.f ? am * (1.f / 7.f) : 1.f, inv = 1.f / sc;
        if (lane == 0) scale[row] = sc;
#pragma unroll
        for (int i = 0; i < 8; ++i) {
            unsigned w = 0u;
#pragma unroll
            for (int j = 0; j < 4; ++j) { const int q = (int)rintf(v[i][j] * inv) + 8; w |= ((unsigned)q & 15u) << (8 * j); }
            if (lane & 1) w <<= 4;
            const unsigned o = __shfl_down(w, 1);
            if (!(lane & 1)) dst[(size_t)row * (DM / 8) + i * 32 + (lane >> 1)] = w | o;
        }
    }
}

constexpr int QV_STR = DM + 8;
__device__ __forceinline__ void quant_v_sliced(const float* src, unsigned char* dst, float* scale, LAS unsigned char* lds) {
    const int tid = otid(), wid = tid >> 6, lane = tid & 63;
    for (int blk = obid(); blk < DEPTH * PEXP / 64; blk += gridDim.x) {
        const int row0 = blk * 64, layer = row0 / PEXP, e0 = row0 % PEXP;
        __syncthreads();
        f32x4 nv[8];
#pragma unroll
        for (int i = 0; i < 8; ++i) nv[i] = *(const f32x4*)(src + (size_t)(row0 + wid) * DM + i * 256 + lane * 4);
        for (int rr = wid; rr < 64; rr += NWAVES) {
            f32x4 v[8]; float am = 0.f;
#pragma unroll
            for (int i = 0; i < 8; ++i) v[i] = nv[i];
            if (rr + NWAVES < 64) {
#pragma unroll
                for (int i = 0; i < 8; ++i) nv[i] = *(const f32x4*)(src + (size_t)(row0 + rr + NWAVES) * DM + i * 256 + lane * 4);
            }
#pragma unroll
            for (int i = 0; i < 8; ++i) am = fmaxf(am, fmaxf(fmaxf(fabsf(v[i][0]), fabsf(v[i][1])), fmaxf(fabsf(v[i][2]), fabsf(v[i][3]))));
            am = wave_max(am);
            const float sc = am > 0.f ? am * (1.f / 127.f) : 1.f, inv = 1.f / sc;
            if (lane == 0) scale[row0 + rr] = sc;
#pragma unroll
            for (int i = 0; i < 8; ++i) {
                unsigned w = 0u;
#pragma unroll
                for (int j = 0; j < 4; ++j) { const int q = (int)rintf(v[i][j] * inv) + 128; w |= ((unsigned)q & 255u) << (8 * j); }
                *(LAS unsigned*)(lds + rr * QV_STR + i * 256 + lane * 4) = w;
            }
        }
        __syncthreads();
        for (int c = wid; c < 256; c += NWAVES) {
            const u32x2 w = *(const LAS u32x2*)(lds + lane * QV_STR + c * 8);
            *(u32x2*)(dst + (((size_t)layer * 256 + c) * PEXP + e0 + lane) * 8) = w;
        }
    }
}

__device__ __forceinline__ void phase_conv(const Params& p, LAS unsigned char* lds_) {
    float* smem = (float*)(unsigned char*)lds_;
    unsigned char* ws = p.ws;
    const int tid = otid();
    int dummy = 0;
    {
        float* cond = smem;
        float* red = smem + NB * DM;
        for (int i = tid; i < NB * DM; i += NTHREADS) { const float v = p.c[i]; cond[i] = v / (1.f + __expf(-v)); }
        __syncthreads();
        for (int u = blockIdx.x; u < DEPTH * 128; u += gridDim.x) {
            const int l = u >> 7, j0 = (u & 127) * 96;
            const int c4 = tid % 24, kg = tid / 24;
            if (kg < 21) {
                f32x4 acc[NB];
#pragma unroll
                for (int b = 0; b < NB; ++b) acc[b] = (f32x4){0.f, 0.f, 0.f, 0.f};
                const float* wp = p.ada_w + (size_t)l * DM * 6 * DM + j0 + 4 * c4;
#pragma unroll 1
                for (int i0 = 0; i0 < 98; i0 += 7) {
                    f32x4 w[7];
#pragma unroll
                    for (int i = 0; i < 7; ++i) { const int k = kg + 21 * (i0 + i); w[i] = k < DM ? *(const f32x4*)(wp + (size_t)k * 6 * DM) : (f32x4){0.f, 0.f, 0.f, 0.f}; }
#pragma unroll
                    for (int i = 0; i < 7; ++i) { const int k = kg + 21 * (i0 + i); const int kk = k < DM ? k : 0;
#pragma unroll
                        for (int b = 0; b < NB; ++b) acc[b] += w[i] * cond[b * DM + kk]; }
                }
#pragma unroll
                for (int b = 0; b < NB; ++b) *(f32x4*)(red + (kg * NB + b) * 96 + 4 * c4) = acc[b];
            }
            __syncthreads();
            for (int i = tid; i < NB * 96; i += NTHREADS) {
                const int b = i / 96, cc = i % 96;
                float sacc = p.ada_b[(size_t)l * 6 * DM + j0 + cc];
#pragma unroll
                for (int g = 0; g < 21; ++g) sacc += red[(g * NB + b) * 96 + cc];
                ((float*)(ws + WS_MOD))[((size_t)l * NB + b) * 6 * DM + j0 + cc] = sacc;
            }
            __syncthreads();
        }
    }
    {
        float2* r128 = (float2*)(ws + WS_ROPE128); float2* r64 = (float2*)(ws + WS_ROPE64);
        for (int i = blockIdx.x * NTHREADS + tid; i < SEQ * 64; i += gridDim.x * NTHREADS) {
            const int pos = i >> 6, j = i & 63;
            const float inv = powf(10000.f, -(float)j / 64.f); const float ang = (float)pos * inv;
            r128[i] = make_float2((float)cos((double)ang), (float)sin((double)ang));
        }
        for (int i = blockIdx.x * NTHREADS + tid; i < SEQ * 32; i += gridDim.x * NTHREADS) {
            const int pos = i >> 5, j = i & 31;
            const float inv = powf(10000.f, -(float)j / 32.f); const float ang = (float)pos * inv;
            r64[i] = make_float2((float)cos((double)ang), (float)sin((double)ang));
        }
    }
    __syncthreads();
    for (int l = 0; l < DEPTH; ++l) {
        transpose_tiles(p.w_in + (size_t)l * DM * INW, INW, INWP, true, (f16*)(ws + WS_WTIN) + (size_t)l * INWP * DM, smem, dummy, 0);
        transpose_tiles(p.w_out + (size_t)l * DM * DM, DM, DM, false, (f16*)(ws + WS_WTOUT) + (size_t)l * DM * DM, smem, dummy, 0);
        transpose_tiles(p.wq + (size_t)l * DM * DM, DM, DM, false, (f16*)(ws + WS_WTQ) + (size_t)l * DM * DM, smem, dummy, 0);
    }
    quant_rows(p.pu, PEXP, (unsigned*)(ws + WS_U8), (float*)(ws + WS_SU), 0);
    if (LAST_BITS == 4) quant_rows4(p.pu + (size_t)PEXP * DM, PEXP, (unsigned*)(ws + WS_U8 + (size_t)PEXP * DM), (float*)(ws + WS_SU) + PEXP);
    else quant_rows(p.pu + (size_t)PEXP * DM, PEXP, (unsigned*)(ws + WS_U8 + (size_t)PEXP * DM), (float*)(ws + WS_SU) + PEXP, 0);
    quant_v_sliced(p.pv, ws + WS_V8, (float*)(ws + WS_SV), lds_);
    cvt_f16_stream(p.subk, (f16*)(ws + WS_SUBK), (size_t)DEPTH * PH * 2 * PNK * 128);
}

__device__ __forceinline__ void phase_norm(const Params& p, const float* xin, const float* g, const float* shift, const float* scale, f16* hout, unsigned* h8 = nullptr, float* sh8 = nullptr) {
    const int tid_ = otid(); const int wid = tid_ >> 6, lane = tid_ & 63;
    for (int row = blockIdx.x * NWAVES + wid; row < NT; row += gridDim.x * NWAVES) {
        const int b = row / SEQ;
        const float* xr = xin + (size_t)row * DM;
        f32x4 v[8]; float ss = 0.f;
#pragma unroll
        for (int i = 0; i < 8; ++i) { v[i] = *(const f32x4*)(xr + i * 256 + lane * 4); ss += v[i][0] * v[i][0] + v[i][1] * v[i][1] + v[i][2] * v[i][2] + v[i][3] * v[i][3]; }
        ss = wave_sum(ss);
        const float rstd = rsqrtf(ss * (1.f / DM) + EPS);
#pragma unroll
        for (int i = 0; i < 8; ++i) {
            const int col = i * 256 + lane * 4;
            const f32x4 gg = *(const f32x4*)(g + col), sh = *(const f32x4*)(shift + (size_t)b * 6 * DM + col), sc = *(const f32x4*)(scale + (size_t)b * 6 * DM + col);
            f32x4 y = v[i] * rstd * gg * (sc + 1.f) + sh;
            u32x2 w; w.x = pack_h2(y[0], y[1]); w.y = pack_h2(y[2], y[3]);
            *(u32x2*)(hout + (size_t)row * DM + col) = w;
            v[i] = y;
        }
        if (h8) {
            float am = 0.f;
#pragma unroll
            for (int i = 0; i < 8; ++i) am = fmaxf(am, fmaxf(fmaxf(fabsf(v[i][0]), fabsf(v[i][1])), fmaxf(fabsf(v[i][2]), fabsf(v[i][3]))));
            am = wave_max(am);
            const float qs = am > 0.f ? am * (1.f / 127.f) : 1.f, inv = 1.f / qs;
            if (lane == 0) sh8[row] = qs;
#pragma unroll
            for (int i = 0; i < 8; ++i) {
                unsigned w = 0u;
#pragma unroll
                for (int j = 0; j < 4; ++j) { const int q = (int)rintf(v[i][j] * inv); w |= ((unsigned)q & 255u) << (8 * j); }
                h8[(size_t)row * (DM / 4) + i * 64 + lane] = w;
            }
        }
    }
}

template <int MODE, bool XH>
__device__ __forceinline__ void phase_norm2(const float* xin, const f16* xinh, float* fout, const float* g, const float* shift, const float* scale, f16* hout, unsigned* h8, float* sh8) {
    const int tid_ = otid(); const int wid = tid_ >> 6, lane = tid_ & 63;
    for (int r0 = (blockIdx.x * NWAVES + wid) * 8; r0 < NT; r0 += gridDim.x * NWAVES * 8) {
        const int b = r0 / SEQ;
        f32x4 gm[8], sh[8];
#pragma unroll
        for (int i = 0; i < 8; ++i) {
            const int col = i * 256 + lane * 4;
            gm[i] = *(const f32x4*)(g + col);
            if (MODE != 2) { gm[i] = gm[i] * (*(const f32x4*)(scale + (size_t)b * 6 * DM + col) + 1.f); sh[i] = *(const f32x4*)(shift + (size_t)b * 6 * DM + col); }
        }
        f32x4 v[8], nv[8]; u32x2 nh[8];
#define NR_LOAD(row_) do { _Pragma("unroll") for (int i = 0; i < 8; ++i) { if (XH) nh[i] = *(const u32x2*)(xinh + (size_t)(row_) * DM + i * 256 + lane * 4); else nv[i] = *(const f32x4*)(xin + (size_t)(row_) * DM + i * 256 + lane * 4); } } while (0)
        NR_LOAD(r0);
#pragma unroll 1
        for (int k = 0; k < 8; ++k) {
            const int row = r0 + k;
#pragma unroll
            for (int i = 0; i < 8; ++i) { if (XH) { v[i][0] = h_lo(nh[i].x); v[i][1] = h_hi(nh[i].x); v[i][2] = h_lo(nh[i].y); v[i][3] = h_hi(nh[i].y); } else v[i] = nv[i]; }
            if (k < 7) NR_LOAD(row + 1);
            float ss = 0.f;
#pragma unroll
            for (int i = 0; i < 8; ++i) ss += v[i][0] * v[i][0] + v[i][1] * v[i][1] + v[i][2] * v[i][2] + v[i][3] * v[i][3];
            ss = wave_sum(ss);
            const float rstd = rsqrtf(ss * (1.f / DM) + EPS);
            float am = 0.f;
#pragma unroll
            for (int i = 0; i < 8; ++i) {
                const int col = i * 256 + lane * 4;
                if (MODE == 2) { *(f32x4*)(fout + (size_t)row * DM + col) = v[i] * rstd * gm[i]; }
                else {
                    const f32x4 y = v[i] * rstd * gm[i] + sh[i];
                    u32x2 w; w.x = pack_h2(y[0], y[1]); w.y = pack_h2(y[2], y[3]);
                    *(u32x2*)(hout + (size_t)row * DM + col) = w;
                    if (MODE == 1) { v[i] = y; am = fmaxf(am, fmaxf(fmaxf(fabsf(y[0]), fabsf(y[1])), fmaxf(fabsf(y[2]), fabsf(y[3])))); }
                }
            }
            if (MODE == 1) {
                am = wave_max(am);
                const float qs = am > 0.f ? am * (1.f / 127.f) : 1.f, inv = 1.f / qs;
                if (lane == 0) sh8[row] = qs;
                int qsum = 0;
#pragma unroll
                for (int i = 0; i < 8; ++i) {
                    unsigned w = 0u;
#pragma unroll
                    for (int j = 0; j < 4; ++j) { const int q = (int)rintf(v[i][j] * inv); qsum += q; w |= ((unsigned)q & 255u) << (8 * j); }
                    h8[(size_t)row * (DM / 4) + i * 64 + lane] = w;
                }
#pragma unroll
                for (int o = 32; o >= 1; o >>= 1) qsum += __shfl_xor(qsum, o);
                if (lane == 0) ((int*)(sh8 + NT))[row] = qsum;
            }
        }
#undef NR_LOAD
    }
}

__device__ __forceinline__ void phase_rope(const Params& p) {
    f16* proj = (f16*)(p.ws + WS_PROJ);
    const float2* r128 = (const float2*)(p.ws + WS_ROPE128); const float2* r64 = (const float2*)(p.ws + WS_ROPE64);
    constexpr int PER_TOK = (1088 + 544) / 2;
    const size_t total = (size_t)NT * PER_TOK;
    for (size_t i = (size_t)blockIdx.x * NTHREADS + otid(); i < total; i += (size_t)gridDim.x * NTHREADS) {
        const int t = (int)(i / PER_TOK); int r = (int)(i % PER_TOK) * 2;
        const int pos = t % SEQ;
        int base, half, j;
        if (r < 1088) {
            const int hh = r >> 6; j = r & 63; half = 64;
            base = hh < 6 ? C_QA + hh * 128 : (hh == 6 ? C_KA : (hh < 12 ? C_QC + (hh - 7) * 128 : C_KC + (hh - 12) * 128));
        } else {
            r -= 1088; const int hh = r >> 5; j = r & 31; half = 32;
            base = hh < 16 ? C_IQ + hh * 64 : C_IK;
        }
        f16* pp = proj + (size_t)t * INWP + base + j;
        const h2_t a = *(const h2_t*)pp, bq = *(const h2_t*)(pp + half);
        float2 cs0, cs1;
        if (half == 64) { cs0 = r128[pos * 64 + j]; cs1 = r128[pos * 64 + j + 1]; } else { cs0 = r64[pos * 32 + j]; cs1 = r64[pos * 32 + j + 1]; }
        const float a0 = (float)a.x, a1 = (float)a.y, b0 = (float)bq.x, b1 = (float)bq.y;
        h2_t oa, ob;
        oa.x = (f16)(a0 * cs0.x - b0 * cs0.y); oa.y = (f16)(a1 * cs1.x - b1 * cs1.y);
        ob.x = (f16)(b0 * cs0.x + a0 * cs0.y); ob.y = (f16)(b1 * cs1.x + a1 * cs1.y);
        *(h2_t*)pp = oa; *(h2_t*)(pp + half) = ob;
    }
}

__device__ __forceinline__ void phase_index(const Params& p, LAS unsigned char* lds_) {
    const f16* proj = (const f16*)(p.ws + WS_PROJ);
    float* smem = (float*)(unsigned char*)lds_;
    const int tid = otid(), wid = tid >> 6, lane = tid & 63;
    {
        float* red = smem;
        float* km = (float*)(p.ws + WS_KMEAN);
        for (int u = blockIdx.x; u < NB * HC * MOBA_NB; u += gridDim.x) {
            const int blk = u % MOBA_NB, h = (u / MOBA_NB) % HC, b = u / (MOBA_NB * HC);
            const int d = tid & 127, part = tid >> 7;
            float s = 0.f;
            const f16* kp = proj + ((size_t)b * SEQ + blk * MOBA_BLK + part * 64) * INWP + C_KC + h * HD + d;
            for (int k = 0; k < 64; ++k) s += (float)kp[(size_t)k * INWP];
            __syncthreads();
            red[part * 128 + d] = s;
            __syncthreads();
            if (tid < 128) km[(size_t)u * HD + tid] = (red[tid] + red[128 + tid] + red[256 + tid] + red[384 + tid]) * (1.f / MOBA_BLK);
        }
        __syncthreads();
    }
    float* wq_ = smem + wid * (IH * IDM + IH);
    float* sc = smem + NWAVES * (IH * IDM + IH) + wid * SEQ;
    unsigned* mask = (unsigned*)(p.ws + WS_MASK);
    for (int q = blockIdx.x * NWAVES + wid; q < NT; q += gridDim.x * NWAVES) {
        const int b = q / SEQ, t = q % SEQ;
        const f16* row = proj + (size_t)q * INWP;
        for (int i = lane; i < IH * IDM; i += 64) wq_[i] = (float)row[C_IQ + i];
        if (lane < IH) wq_[IH * IDM + lane] = (float)row[C_IW + lane] * 0.25f;
        __builtin_amdgcn_wave_barrier();
        const int nk = t + 1;
        for (int s = lane; s < nk; s += 64) {
            const f16* kr = proj + ((size_t)b * SEQ + s) * INWP + C_IK;
            float kf[IDM];
#pragma unroll
            for (int e8 = 0; e8 < IDM / 8; ++e8) { const h8_t kv = *(const h8_t*)(kr + e8 * 8);
#pragma unroll
                for (int j = 0; j < 8; ++j) kf[e8 * 8 + j] = (float)kv[j]; }
            float score = 0.f;
            for (int h = 0; h < IH; ++h) {
                float d = 0.f;
#pragma unroll
                for (int e = 0; e < IDM; ++e) d += wq_[h * IDM + e] * kf[e];
                score += wq_[IH * IDM + h] * fmaxf(d * 0.125f, 0.f);
            }
            sc[s] = score;
        }
        __builtin_amdgcn_wave_barrier();
        unsigned key[32];
#pragma unroll
        for (int i = 0; i < 32; ++i) {
            const int s = lane + 64 * i;
            unsigned u = 0u;
            if (s < nk) { const unsigned bits = __float_as_uint(sc[s]); u = (bits & 0x80000000u) ? ~bits : (bits | 0x80000000u); if (u == 0u) u = 1u; }
            key[i] = u;
        }
        unsigned thr = 1u;
        if (nk > DSA_TOPK) {
            thr = 0u;
            for (int bit = 31; bit >= 0; --bit) {
                const unsigned cand = thr | (1u << bit);
                int cnt = 0;
#pragma unroll
                for (int i = 0; i < 32; ++i) cnt += __builtin_popcountll(__ballot(key[i] >= cand));
                if (cnt >= DSA_TOPK) thr = cand;
            }
        }
        unsigned* mrow = mask + (size_t)q * 64;
#pragma unroll
        for (int i = 0; i < 32; ++i) {
            const unsigned long long bal = __ballot(key[i] >= thr && key[i] != 0u);
            if (lane == 0) { mrow[2 * i] = (unsigned)bal; mrow[2 * i + 1] = (unsigned)(bal >> 32); }
        }
        __builtin_amdgcn_wave_barrier();
    }
}

constexpr int IX_ROW = SEQ + 4;
__device__ __forceinline__ void index_item(const Params& p, LAS unsigned char* lds, int b, int qg) {
    const f16* proj = (const f16*)(p.ws + WS_PROJ);
    LAS float* sc = (LAS float*)lds;
    const int tid = otid(), wid = __builtin_amdgcn_readfirstlane(tid >> 6), lane = tid & 63, fr = lane & 15, fq = lane >> 4;
    const int t0 = qg * 16, nkt = qg + 1;
    h8_t Bq[IH][2]; float wq[IH];
    {
        const f16* qrow = proj + ((size_t)b * SEQ + t0 + fr) * INWP;
#pragma unroll
        for (int h = 0; h < IH; ++h) {
            Bq[h][0] = *(const h8_t*)(qrow + C_IQ + h * IDM + 8 * fq);
            Bq[h][1] = *(const h8_t*)(qrow + C_IQ + h * IDM + 32 + 8 * fq);
        }
        const h8_t w0 = *(const h8_t*)(qrow + C_IW), w1 = *(const h8_t*)(qrow + C_IW + 8);
#pragma unroll
        for (int h = 0; h < 8; ++h) { wq[h] = (float)w0[h] * (0.25f * 0.125f); wq[8 + h] = (float)w1[h] * (0.25f * 0.125f); }
    }
    __syncthreads();
    const f16* kbase = proj + ((size_t)b * SEQ + fr) * INWP + C_IK + 8 * fq;
    h8_t a0, a1, n0, n1;
    int kt = wid;
    if (kt < nkt) { a0 = *(const h8_t*)(kbase + (size_t)kt * 16 * INWP); a1 = *(const h8_t*)(kbase + (size_t)kt * 16 * INWP + 32); }
    for (; kt < nkt; kt += NWAVES) {
        const int ktn = kt + NWAVES;
        if (ktn < nkt) { n0 = *(const h8_t*)(kbase + (size_t)ktn * 16 * INWP); n1 = *(const h8_t*)(kbase + (size_t)ktn * 16 * INWP + 32); }
        f32x4 acc = {0.f, 0.f, 0.f, 0.f};
#pragma unroll
        for (int h = 0; h < IH; ++h) {
            f32x4 c = {0.f, 0.f, 0.f, 0.f};
            c = __builtin_amdgcn_mfma_f32_16x16x32_f16(a0, Bq[h][0], c, 0, 0, 0);
            c = __builtin_amdgcn_mfma_f32_16x16x32_f16(a1, Bq[h][1], c, 0, 0, 0);
#pragma unroll
            for (int j = 0; j < 4; ++j) acc[j] += wq[h] * fmaxf(c[j], 0.f);
        }
        *(LAS f32x4*)(sc + fr * IX_ROW + kt * 16 + 4 * fq) = acc;
        a0 = n0; a1 = n1;
    }
    __syncthreads();
    unsigned* mask = (unsigned*)(p.ws + WS_MASK);
#pragma unroll 1
    for (int qq = 0; qq < 2; ++qq) {
        const int ql = 2 * wid + qq, t = t0 + ql, nk = t + 1;
        unsigned key[32];
#pragma unroll
        for (int i = 0; i < 32; ++i) {
            const int s = lane + 64 * i;
            unsigned u = 0u;
            if (s < nk) { const unsigned bits = __float_as_uint(sc[ql * IX_ROW + s]); u = (bits & 0x80000000u) ? ~bits : (bits | 0x80000000u); if (u == 0u) u = 1u; }
            key[i] = u;
        }
        unsigned thr = 1u;
        if (nk > DSA_TOPK) {
            thr = 0u;
            const int nreg8 = (nk + 511) >> 9;
            for (int bit = 31; bit >= 0; --bit) {
                const unsigned cand = thr | (1u << bit);
                int cnt = 0;
#pragma unroll
                for (int i8 = 0; i8 < 4; ++i8) {
                    if (i8 < nreg8) {
#pragma unroll
                        for (int i = 0; i < 8; ++i) cnt += __builtin_popcountll(__ballot(key[8 * i8 + i] >= cand));
                    }
                }
                if (cnt >= DSA_TOPK) { thr = cand; if (cnt == DSA_TOPK) break; }
            }
        }
        unsigned* mrow = mask + ((size_t)b * SEQ + t) * 64;
        unsigned myw = 0u;
#pragma unroll
        for (int i = 0; i < 32; ++i) {
            const unsigned long long bal = __ballot(key[i] >= thr && key[i] != 0u);
            if (lane == 2 * i) myw = (unsigned)bal;
            if (lane == 2 * i + 1) myw = (unsigned)(bal >> 32);
        }
        mrow[lane] = myw;
    }
}

__device__ __forceinline__ void phase_index2(const Params& p, LAS unsigned char* lds_) {
    const f16* proj = (const f16*)(p.ws + WS_PROJ);
    float* smem = (float*)(unsigned char*)lds_;
    const int tid = otid();
    {
        float* red = smem;
        float* km = (float*)(p.ws + WS_KMEAN);
        for (int u = obid(); u < NB * HC * MOBA_NB; u += gridDim.x) {
            const int blk = u % MOBA_NB, h = (u / MOBA_NB) % HC, b = u / (MOBA_NB * HC);
            const int d = tid & 127, part = tid >> 7;
            float s = 0.f;
            const f16* kp = proj + ((size_t)b * SEQ + blk * MOBA_BLK + part * 64) * INWP + C_KC + h * HD + d;
            for (int k = 0; k < 64; ++k) s += (float)kp[(size_t)k * INWP];
            __syncthreads();
            red[part * 128 + d] = s;
            __syncthreads();
            if (tid < 128) km[(size_t)u * HD + tid] = (red[tid] + red[128 + tid] + red[256 + tid] + red[384 + tid]) * (1.f / MOBA_BLK);
        }
        __syncthreads();
    }
    for (int pi = obid(); pi < NB * 64; pi += gridDim.x) {
        const int b = pi >> 6, a = pi & 63;
        index_item(p, lds_, b, 127 - a);
        index_item(p, lds_, b, a);
    }
}

__device__ __forceinline__ void phase_attn(const Params& p, LAS unsigned char* lds_, const float* ong) {
    const f16* proj = (const f16*)(p.ws + WS_PROJ);
    float* smem = (float*)(unsigned char*)lds_;
    const int tid = otid(), wid = tid >> 6, lane = tid & 63;
    float* pbuf = smem + wid * SEQ;
    const float* km = (const float*)(p.ws + WS_KMEAN);
    const unsigned* mask = (const unsigned*)(p.ws + WS_MASK);
    f16* y = (f16*)(p.ws + WS_Y);
    const float scale = 0.08838834764831845f;
    const size_t nitems = (size_t)NT * NHEADS;
    for (size_t it = (size_t)blockIdx.x * NWAVES + wid; it < nitems; it += (size_t)gridDim.x * NWAVES) {
        const int hh = (int)(it % NHEADS); const int q = (int)(it / NHEADS);
        const int b = q / SEQ, t = q % SEQ;
        int qc, kc, vc, var;
        if (hh < HA) { var = 0; qc = C_QA + hh * HD; kc = C_KA; vc = C_VA; }
        else if (hh < HA + HB) { var = 1; qc = C_QB + (hh - HA) * HD; kc = C_KB + (hh - HA) * HD; vc = C_VB + (hh - HA) * HD; }
        else { var = 2; qc = C_QC + (hh - HA - HB) * HD; kc = C_KC + (hh - HA - HB) * HD; vc = C_VC + (hh - HA - HB) * HD; }
        unsigned qv[64];
        { const u32x4* qp = (const u32x4*)(proj + (size_t)q * INWP + qc);
#pragma unroll
          for (int i = 0; i < 16; ++i) { const u32x4 w = qp[i]; qv[4 * i] = w.x; qv[4 * i + 1] = w.y; qv[4 * i + 2] = w.z; qv[4 * i + 3] = w.w; } }
        unsigned allowed = 0xffu;
        const int own = t / MOBA_BLK;
        if (var == 2) {
            float g = -INFINITY;
            if (lane < own) {
                const float* kmp = km + (((size_t)b * HC + (hh - HA - HB)) * MOBA_NB + lane) * HD;
                float s = 0.f;
#pragma unroll
                for (int i = 0; i < 64; ++i) s += h_lo(qv[i]) * kmp[2 * i] + h_hi(qv[i]) * kmp[2 * i + 1];
                g = s;
            }
            float gs[MOBA_NB];
#pragma unroll
            for (int j = 0; j < MOBA_NB; ++j) gs[j] = __shfl(g, j);
            allowed = 1u << own;
#pragma unroll
            for (int j = 0; j < MOBA_NB; ++j) {
                if (j < own) {
                    int rank = 0;
#pragma unroll
                    for (int k2 = 0; k2 < MOBA_NB; ++k2) if (k2 < own && (gs[k2] > gs[j] || (gs[k2] == gs[j] && k2 < j))) ++rank;
                    if (rank < 3) allowed |= 1u << j;
                }
            }
        }
        const int nk = t + 1;
        const int nkl = (nk + 63) >> 6;
        const unsigned* mrow = mask + (size_t)q * 64;
        float z[32];
#pragma unroll
        for (int i = 0; i < 32; ++i) {
            z[i] = -INFINITY;
            if (i < nkl) {
                const int s = nkl * lane + i;
                if (s < nk) {
                    bool ok = true;
                    if (var == 0) ok = (mrow[s >> 5] >> (s & 31)) & 1u;
                    if (var == 2) ok = (allowed >> (s / MOBA_BLK)) & 1u;
                    if (var == 1) ok = s < t;
                    if (ok) {
                        const u32x4* kp = (const u32x4*)(proj + ((size_t)b * SEQ + s) * INWP + kc);
                        float d = 0.f;
#pragma unroll
                        for (int c4 = 0; c4 < 16; ++c4) { const u32x4 w = kp[c4]; d = dot2(qv[4 * c4], w.x, d); d = dot2(qv[4 * c4 + 1], w.y, d); d = dot2(qv[4 * c4 + 2], w.z, d); d = dot2(qv[4 * c4 + 3], w.w, d); }
                        z[i] = d * scale;
                    }
                }
            }
        }
        float inv_l = 1.f;
        if (var != 1) {
            float m = -INFINITY;
#pragma unroll
            for (int i = 0; i < 32; ++i) m = fmaxf(m, z[i]);
            m = wave_max(m);
            float l = 0.f;
#pragma unroll
            for (int i = 0; i < 32; ++i) { const float e = (z[i] == -INFINITY) ? 0.f : __expf(z[i] - m); z[i] = e; l += e; }
            l = wave_sum(l);
            inv_l = 1.f / l;
        } else {
            float lk[32]; float tot = 0.f;
#pragma unroll
            for (int i = 31; i >= 0; --i) {
                float v = 0.f;
                if (z[i] != -INFINITY) { const float zz = z[i]; v = -(fmaxf(zz, 0.f) + log1pf(__expf(-fabsf(zz)))); }
                tot += v; lk[i] = tot;
            }
            float incl = tot;
#pragma unroll
            for (int o = 1; o < 64; o <<= 1) { const float v = __shfl_down(incl, o); if (lane + o < 64) incl += v; }
            const float excl = incl - tot;
#pragma unroll
            for (int i = 0; i < 32; ++i) z[i] = (z[i] == -INFINITY) ? 0.f : __expf(z[i] + lk[i] + excl);
        }
#pragma unroll
        for (int i = 0; i < 32; ++i) if (i < nkl) { const int s = nkl * lane + i; if (s < SEQ) pbuf[s] = z[i]; }
        __builtin_amdgcn_wave_barrier();
        float o0 = 0.f, o1 = 0.f;
        const f16* vp = proj + (size_t)b * SEQ * INWP + vc + 2 * lane;
        for (int s0 = 0; s0 < nk; s0 += 8) {
            float pr[8]; bool any = false;
#pragma unroll
            for (int j = 0; j < 8; ++j) { pr[j] = pbuf[s0 + j]; any = any || (pr[j] != 0.f); }
            if (any) {
                unsigned w[8];
#pragma unroll
                for (int j = 0; j < 8; ++j) w[j] = *(const unsigned*)(vp + (size_t)(s0 + j) * INWP);
#pragma unroll
                for (int j = 0; j < 8; ++j) { o0 += pr[j] * h_lo(w[j]); o1 += pr[j] * h_hi(w[j]); }
            }
        }
        o0 *= inv_l; o1 *= inv_l;
        const float ss = wave_sum(o0 * o0 + o1 * o1);
        const float rstd = rsqrtf(ss * (1.f / HD) + EPS);
        const float g0 = ong[hh * HD + 2 * lane], g1 = ong[hh * HD + 2 * lane + 1];
        *(unsigned*)(y + (size_t)q * DM + hh * HD + 2 * lane) = pack_h2(o0 * rstd * g0, o1 * rstd * g1);
        __builtin_amdgcn_wave_barrier();
    }
}

typedef short s4_t __attribute__((ext_vector_type(4)));
typedef float f32x16 __attribute__((ext_vector_type(16)));
constexpr int AT_KSTR = 272, AT_VSTR = 320, AT_KBYTES = 64 * AT_KSTR, AT_VBYTES = 64 * AT_VSTR, AT_STAGE = AT_KBYTES + AT_VBYTES;
__device__ __forceinline__ float fexp2(float x) { return __builtin_amdgcn_exp2f(x); }
__device__ __forceinline__ float flog2(float x) { return __builtin_amdgcn_logf(x); }

template <int VAR>
__device__ __forceinline__ void attn_item(const Params& p, LAS unsigned char* lds, const float* ong, int b, int hh, int qt, int qc, int kc, int vc) {
    const f16* proj = (const f16*)(p.ws + WS_PROJ);
    const int tid = otid(), wid = __builtin_amdgcn_readfirstlane(tid >> 6), lane = tid & 63, qn = lane & 31, hf = lane >> 5;
    const int q0 = qt * 256, qrow = q0 + 32 * wid + qn;
    const size_t grow = (size_t)b * SEQ + qrow;
    h8_t Qf[8];
    {
        const float sc = 0.08838834764831845f * 1.4426950408889634f;
        const f16* qp = proj + grow * INWP + qc + 8 * hf;
#pragma unroll
        for (int ks = 0; ks < 8; ++ks) {
            const h8_t v = *(const h8_t*)(qp + 16 * ks);
            h8_t w;
#pragma unroll
            for (int j = 0; j < 8; ++j) w[j] = (f16)((float)v[j] * sc);
            Qf[ks] = w;
        }
    }
    unsigned allowed = 0xffu;
    if (VAR == 2) {
        const int own = qt;
        const float* km = (const float*)(p.ws + WS_KMEAN) + ((size_t)b * HC + (hh - HA - HB)) * MOBA_NB * HD + 8 * hf;
        float gs[MOBA_NB];
#pragma unroll
        for (int j = 0; j < MOBA_NB; ++j) gs[j] = -INFINITY;
#pragma unroll
        for (int j = 0; j < MOBA_NB - 1; ++j) {
            if (j < own) {
                float s = 0.f;
#pragma unroll
                for (int ks = 0; ks < 8; ++ks) {
                    const f32x4 k0 = *(const f32x4*)(km + j * HD + 16 * ks), k1 = *(const f32x4*)(km + j * HD + 16 * ks + 4);
                    s += (float)Qf[ks][0] * k0[0] + (float)Qf[ks][1] * k0[1] + (float)Qf[ks][2] * k0[2] + (float)Qf[ks][3] * k0[3]
                       + (float)Qf[ks][4] * k1[0] + (float)Qf[ks][5] * k1[1] + (float)Qf[ks][6] * k1[2] + (float)Qf[ks][7] * k1[3];
                }
                gs[j] = s + __shfl_xor(s, 32);
            }
        }
        allowed = 1u << own;
#pragma unroll
        for (int j = 0; j < MOBA_NB - 1; ++j) {
            if (j < own) {
                int rank = 0;
#pragma unroll
                for (int k2 = 0; k2 < MOBA_NB - 1; ++k2) if (k2 < own && (gs[k2] > gs[j] || (gs[k2] == gs[j] && k2 < j))) ++rank;
                if (rank < 3) allowed |= 1u << j;
            }
        }
    }
    f32x16 O[4];
#pragma unroll
    for (int dt = 0; dt < 4; ++dt)
#pragma unroll
        for (int r = 0; r < 16; ++r) O[dt][r] = 0.f;
    float m_run = -INFINITY, l_run = 0.f, carry = 0.f;
    const int nst = (qt + 1) * 4;
    const int st_hi_w = qt * 4 + (wid >> 1);
    const int sr0 = tid >> 4, sc0 = tid & 15;
    const f16* kg = proj + ((size_t)b * SEQ + sr0) * INWP + kc + 8 * sc0;
    const f16* vg = proj + ((size_t)b * SEQ + sr0) * INWP + vc + 8 * sc0;
    const unsigned kw = sr0 * AT_KSTR + 16 * sc0, vw = AT_KBYTES + sr0 * AT_VSTR + 16 * sc0;
    const unsigned* mrow = (const unsigned*)(p.ws + WS_MASK) + grow * 64;
    const unsigned ka = qn * AT_KSTR + 16 * hf;
    const unsigned va = AT_KBYTES + (4 * hf + ((lane & 15) >> 2)) * AT_VSTR + (16 * ((lane >> 4) & 1) + 4 * (lane & 3)) * 2;
    u32x4 rk0, rk1, rv0, rv1; u32x2 mw = {0u, 0u}, mwn = {0u, 0u};
#define AT_LOAD(st_) do { const size_t o_ = (size_t)(st_) * 64 * INWP; rk0 = *(const u32x4*)(kg + o_); rk1 = *(const u32x4*)(kg + o_ + (size_t)32 * INWP); \
        rv0 = *(const u32x4*)(vg + o_); rv1 = *(const u32x4*)(vg + o_ + (size_t)32 * INWP); if (VAR == 0) mwn = *(const u32x2*)(mrow + 2 * (st_)); } while (0)
#define AT_WRITE(buf_) do { LAS unsigned char* b_ = lds + (buf_) * AT_STAGE; *(LAS u32x4*)(b_ + kw) = rk0; *(LAS u32x4*)(b_ + kw + 32 * AT_KSTR) = rk1; \
        *(LAS u32x4*)(b_ + vw) = rv0; *(LAS u32x4*)(b_ + vw + 32 * AT_VSTR) = rv1; } while (0)
    __syncthreads();
    AT_LOAD(nst - 1); AT_WRITE(0); mw = mwn;
    __syncthreads();
    int cur = 0;
    bool wdone = false;
    for (int st = nst - 1; st >= 0; --st) {
        if (st > 0) AT_LOAD(st - 1);
        if (st <= st_hi_w && !wdone) {
            LAS unsigned char* kb = lds + cur * AT_STAGE;
            f32x16 S[2];
#pragma unroll
            for (int r = 0; r < 16; ++r) { S[0][r] = 0.f; S[1][r] = 0.f; }
#pragma unroll
            for (int ks = 0; ks < 8; ++ks) {
                const h8_t a0 = *(const LAS h8_t*)(kb + ka + 32 * ks), a1 = *(const LAS h8_t*)(kb + ka + 32 * ks + 32 * AT_KSTR);
                S[0] = __builtin_amdgcn_mfma_f32_32x32x16_f16(a0, Qf[ks], S[0], 0, 0, 0);
                S[1] = __builtin_amdgcn_mfma_f32_32x32x16_f16(a1, Qf[ks], S[1], 0, 0, 0);
            }
            const bool diag = (64 * st + 63 > q0 + 32 * wid);
            const int kbase = 64 * st + 4 * hf;
            if (VAR != 1) {
                const bool blk_ok = (VAR == 2) ? ((allowed >> (st >> 2)) & 1u) : true;
                float mx = -INFINITY;
#pragma unroll
                for (int sub = 0; sub < 2; ++sub)
#pragma unroll
                    for (int r = 0; r < 16; ++r) {
                        const int kl = (r & 3) + 8 * (r >> 2);
                        bool ok;
                        if (VAR == 0) ok = ((sub == 0 ? mw.x : mw.y) >> (kl + 4 * hf)) & 1u;
                        else ok = blk_ok && (!diag || (kbase + 32 * sub + kl <= qrow));
                        const float v = ok ? S[sub][r] : -INFINITY;
                        S[sub][r] = v; mx = fmaxf(mx, v);
                    }
                mx = fmaxf(mx, __shfl_xor(mx, 32));
                const float m_new = fmaxf(m_run, mx);
                const float m_use = (m_new == -INFINITY) ? 0.f : m_new;
                const float alpha = fexp2(m_run - m_use);
                float ps = 0.f;
#pragma unroll
                for (int sub = 0; sub < 2; ++sub)
#pragma unroll
                    for (int r = 0; r < 16; ++r) { const float e = fexp2(S[sub][r] - m_use); S[sub][r] = e; ps += e; }
                l_run = l_run * alpha + ps;
                m_run = m_new;
                if (__ballot(alpha != 1.f) != 0ull) {
#pragma unroll
                    for (int dt = 0; dt < 4; ++dt)
#pragma unroll
                        for (int r = 0; r < 16; ++r) O[dt][r] *= alpha;
                }
            } else {
#pragma unroll
                for (int sub = 1; sub >= 0; --sub) {
                    float lk[16];
#pragma unroll
                    for (int r = 0; r < 16; ++r) {
                        const int kl = (r & 3) + 8 * (r >> 2);
                        const bool ok = !diag || (kbase + 32 * sub + kl < qrow);
                        const float zl = S[sub][r];
                        const float sp = fmaxf(zl, 0.f) + flog2(1.f + fexp2(-fabsf(zl)));
                        lk[r] = ok ? -sp : 0.f;
                        S[sub][r] = ok ? zl : -INFINITY;
                    }
                    float gsum[4], pg[4], T[4];
#pragma unroll
                    for (int g = 0; g < 4; ++g) { gsum[g] = (lk[4 * g] + lk[4 * g + 1]) + (lk[4 * g + 2] + lk[4 * g + 3]); pg[g] = __shfl_xor(gsum[g], 32); T[g] = gsum[g] + pg[g]; }
                    float after[4];
                    after[3] = 0.f; after[2] = T[3]; after[1] = T[3] + T[2]; after[0] = T[3] + T[2] + T[1];
#pragma unroll
                    for (int g = 0; g < 4; ++g) {
                        const float base = carry + after[g] + (hf == 0 ? pg[g] : 0.f);
                        const float c3 = lk[4 * g + 3], c2 = lk[4 * g + 2] + c3, c1 = lk[4 * g + 1] + c2, c0 = lk[4 * g] + c1;
                        S[sub][4 * g + 3] = fexp2(S[sub][4 * g + 3] + base + c3);
                        S[sub][4 * g + 2] = fexp2(S[sub][4 * g + 2] + base + c2);
                        S[sub][4 * g + 1] = fexp2(S[sub][4 * g + 1] + base + c1);
                        S[sub][4 * g + 0] = fexp2(S[sub][4 * g + 0] + base + c0);
                    }
                    carry += (T[0] + T[1]) + (T[2] + T[3]);
                }
            }
#pragma unroll
            for (int sub = 0; sub < 2; ++sub)
#pragma unroll
                for (int s2 = 0; s2 < 2; ++s2) {
                    h8_t pb;
#pragma unroll
                    for (int j = 0; j < 8; ++j) pb[j] = (f16)S[sub][8 * s2 + j];
#pragma unroll
                    for (int dt = 0; dt < 4; ++dt) {
                        const LAS unsigned char* ap = kb + va + (32 * sub + 16 * s2) * AT_VSTR + 64 * dt;
                        const s4_t t0 = __builtin_amdgcn_ds_read_tr16_b64_v4i16((LAS s4_t*)ap);
                        const s4_t t1 = __builtin_amdgcn_ds_read_tr16_b64_v4i16((LAS s4_t*)(ap + 8 * AT_VSTR));
                        typedef short s8_t __attribute__((ext_vector_type(8)));
                        const s8_t a8 = __builtin_shufflevector(t0, t1, 0, 1, 2, 3, 4, 5, 6, 7);
                        O[dt] = __builtin_amdgcn_mfma_f32_32x32x16_f16(__builtin_bit_cast(h8_t, a8), pb, O[dt], 0, 0, 0);
                    }
                }
        }
        if (VAR == 1) {
            if (st <= st_hi_w && !wdone) wdone = (__ballot(carry < -100.f) == ~0ull);
            if (lane == 0) *(LAS unsigned*)(lds + 2 * AT_STAGE + 32 * (st & 1) + 4 * wid) = wdone ? 1u : 0u;
        }
        if (st > 0) { AT_WRITE(cur ^ 1); }
        mw = mwn;
        __syncthreads();
        cur ^= 1;
        if (VAR == 1) {
            unsigned alld = 1u;
#pragma unroll
            for (int w = 0; w < NWAVES; ++w) alld &= *(const LAS unsigned*)(lds + 2 * AT_STAGE + 32 * (st & 1) + 4 * w);
            if (alld) break;
        }
    }
#undef AT_LOAD
#undef AT_WRITE
    float inv = 1.f;
    if (VAR != 1) { const float lt = l_run + __shfl_xor(l_run, 32); inv = 1.f / lt; }
    float ss = 0.f;
#pragma unroll
    for (int dt = 0; dt < 4; ++dt)
#pragma unroll
        for (int r = 0; r < 16; ++r) { const float v = O[dt][r] * inv; O[dt][r] = v; ss += v * v; }
    ss += __shfl_xor(ss, 32);
    const float rstd = rsqrtf(ss * (1.f / HD) + EPS);
    f16* yp = (f16*)(p.ws + WS_Y) + grow * DM + hh * HD + 4 * hf;
    const float* gp = ong + hh * HD + 4 * hf;
#pragma unroll
    for (int dt = 0; dt < 4; ++dt)
#pragma unroll
        for (int g = 0; g < 4; ++g) {
            const f32x4 gg = *(const f32x4*)(gp + 32 * dt + 8 * g);
            u32x2 w; w.x = pack_h2(O[dt][4 * g] * rstd * gg[0], O[dt][4 * g + 1] * rstd * gg[1]); w.y = pack_h2(O[dt][4 * g + 2] * rstd * gg[2], O[dt][4 * g + 3] * rstd * gg[3]);
            *(u32x2*)(yp + 32 * dt + 8 * g) = w;
        }
}

__device__ __forceinline__ void phase_attn2(const Params& p, LAS unsigned char* lds, const float* ong, unsigned* queue) {
    for (;;) {
        __syncthreads();
        if (threadIdx.x == 0) *(LAS unsigned*)(lds + 2 * AT_STAGE + 96) = __hip_atomic_fetch_add(queue, 1u, __ATOMIC_RELAXED, __HIP_MEMORY_SCOPE_AGENT);
        __syncthreads();
        const int idx = (int)*(const LAS unsigned*)(lds + 2 * AT_STAGE + 96);
        if (idx >= NB * NHEADS * 8) break;
        int qt, b, hh;
        if (idx < 704) { qt = 7 - idx / 88; const int r = idx % 88; b = r / 11; const int h11 = r % 11; hh = h11 < HA ? h11 : h11 + HB; }
        else { const int r = idx - 704; qt = 7 - r / 40; b = (r % 40) / 5; hh = HA + (r % 5); }
        if (hh < HA) attn_item<0>(p, lds, ong, b, hh, qt, C_QA + hh * HD, C_KA, C_VA);
        else if (hh < HA + HB) attn_item<1>(p, lds, ong, b, hh, qt, C_QB + (hh - HA) * HD, C_KB + (hh - HA) * HD, C_VB + (hh - HA) * HD);
        else attn_item<2>(p, lds, ong, b, hh, qt, C_QC + (hh - HA - HB) * HD, C_KC + (hh - HA - HB) * HD, C_VC + (hh - HA - HB) * HD);
    }
}

__device__ __forceinline__ void wave_argmax(float& v, int& idx) {
#pragma unroll
    for (int o = 32; o >= 1; o >>= 1) {
        const float ov = __shfl_xor(v, o); const int oi = __shfl_xor(idx, o);
        if (ov > v || (ov == v && oi < idx)) { v = ov; idx = oi; }
    }
}
__device__ __forceinline__ void phase_route(const Params& p, LAS unsigned char* lds_, const f16* subk) {
    const f16* qp = (const f16*)(p.ws + WS_Y);
    float* smem = (float*)(unsigned char*)lds_;
    const int tid = otid(), wid = tid >> 6, lane = tid & 63;
    float* qs = smem + wid * 256;
    unsigned* pe = (unsigned*)(p.ws + WS_PE); float* pg = (float*)(p.ws + WS_PG);
    const size_t nitems = (size_t)NT * PH;
    for (size_t it = (size_t)blockIdx.x * NWAVES + wid; it < nitems; it += (size_t)gridDim.x * NWAVES) {
        const int hp = (int)(it % PH); const int t = (int)(it / PH);
        const f16* qrow = qp + (size_t)t * DM + hp * 256;
        for (int i = lane; i < 256; i += 64) qs[i] = (float)qrow[i];
        __builtin_amdgcn_wave_barrier();
        float sv[2]; int si[2];
#pragma unroll
        for (int c = 0; c < 2; ++c) {
            float v0, v1;
            {
                const f16* k0 = subk + (((size_t)hp * 2 + c) * PNK + lane) * 128;
                const f16* k1 = k0 + 64 * 128;
                float a0 = 0.f, a1 = 0.f;
#pragma unroll 4
                for (int e8 = 0; e8 < 16; ++e8) {
                    const h8_t x0 = *(const h8_t*)(k0 + e8 * 8), x1 = *(const h8_t*)(k1 + e8 * 8);
#pragma unroll
                    for (int j = 0; j < 8; ++j) { const float qq = qs[c * 128 + e8 * 8 + j]; a0 += qq * (float)x0[j]; a1 += qq * (float)x1[j]; }
                }
                v0 = a0; v1 = a1;
            }
            float mysv = 0.f; int mysi = 0;
            for (int r = 0; r < PTOPK; ++r) {
                float v; int idx;
                if (v0 >= v1) { v = v0; idx = lane; } else { v = v1; idx = lane + 64; }
                wave_argmax(v, idx);
                if (idx == lane) v0 = -INFINITY;
                if (idx == lane + 64) v1 = -INFINITY;
                if (lane == r) { mysv = v; mysi = idx; }
            }
            sv[c] = mysv; si[c] = mysi;
        }
        float cs[4];
#pragma unroll
        for (int k = 0; k < 4; ++k) { const int id = 4 * lane + k; cs[k] = __shfl(sv[0], id >> 4) + __shfl(sv[1], id & 15); }
        float tops = 0.f; int pick = 0;
        for (int r = 0; r < PTOPK; ++r) {
            float v = cs[0]; int idx = 4 * lane;
#pragma unroll
            for (int k = 1; k < 4; ++k) if (cs[k] > v) { v = cs[k]; idx = 4 * lane + k; }
            wave_argmax(v, idx);
#pragma unroll
            for (int k = 0; k < 4; ++k) if (idx == 4 * lane + k) cs[k] = -INFINITY;
            if (lane == r) { tops = v; pick = idx; }
        }
        const int e0 = __shfl(si[0], pick >> 4), e1 = __shfl(si[1], pick & 15);
        const float mx = __shfl(tops, 0);
        float ex = lane < PTOPK ? __expf(tops - mx) : 0.f;
        const float sum = wave_sum(ex);
        if (lane < PTOPK) { pe[(size_t)t * 128 + hp * 16 + lane] = (unsigned)(e0 * PNK + e1); pg[(size_t)t * 128 + hp * 16 + lane] = ex / sum; }
        __builtin_amdgcn_wave_barrier();
    }
}

#define CE_DESC(a, b) do { const unsigned _x = (a) > (b) ? (a) : (b), _y = (a) > (b) ? (b) : (a); (a) = _x; (b) = _y; } while (0)
__device__ __forceinline__ void sort16_desc(unsigned (&k)[16]) {
#pragma unroll
    for (int kk = 2; kk <= 16; kk <<= 1)
#pragma unroll
        for (int j = kk >> 1; j > 0; j >>= 1)
#pragma unroll
            for (int i = 0; i < 16; ++i) { const int l = i ^ j; if (l > i) { if ((i & kk) == 0) CE_DESC(k[i], k[l]); else CE_DESC(k[l], k[i]); } }
}
__device__ __forceinline__ void merge16_desc(unsigned (&a)[16], const unsigned (&b)[16]) {
#pragma unroll
    for (int i = 0; i < 16; ++i) a[i] = a[i] > b[15 - i] ? a[i] : b[15 - i];
#pragma unroll
    for (int j = 8; j > 0; j >>= 1)
#pragma unroll
        for (int i = 0; i < 16; ++i) { const int l = i ^ j; if (l > i) CE_DESC(a[i], a[l]); }
}
__device__ __forceinline__ unsigned f2sort(float f) { const unsigned b = __float_as_uint(f); return b ^ ((unsigned)((int)b >> 31) | 0x80000000u); }
__device__ __forceinline__ float sort2f(unsigned u) { const unsigned b = (u & 0x80000000u) ? (u ^ 0x80000000u) : ~u; return __uint_as_float(b); }
constexpr int RT_STR = 272;
__device__ __forceinline__ void phase_route2(const Params& p, LAS unsigned char* lds, const f16* subk) {
    const f16* qp = (const f16*)(p.ws + WS_Y);
    unsigned* pe = (unsigned*)(p.ws + WS_PE); float* pg = (float*)(p.ws + WS_PG);
    const int tid = otid(), wid = __builtin_amdgcn_readfirstlane(tid >> 6), lane = tid & 63, qn = lane & 31, hf = lane >> 5;
    for (int item = obid(); item < 256; item += gridDim.x) {
        const int hp = item & 7, tg = item >> 3;
        __syncthreads();
        {
            const f16* src = subk + (size_t)hp * 256 * 128;
#pragma unroll
            for (int i = 0; i < 8; ++i) { const int e = tid + i * 512, r = e >> 4, c = e & 15; *(LAS u32x4*)(lds + r * RT_STR + 16 * c) = *(const u32x4*)(src + r * 128 + 8 * c); }
        }
        __syncthreads();
#pragma unroll 1
        for (int it = 0; it < 2; ++it) {
            const int t = (tg * 16 + wid * 2 + it) * 32 + qn;
            unsigned top[2][16];
#pragma unroll
            for (int c = 0; c < 2; ++c) {
                h8_t Bq[8];
                const f16* qrow = qp + (size_t)t * DM + hp * 256 + c * 128 + 8 * hf;
#pragma unroll
                for (int ks = 0; ks < 8; ++ks) Bq[ks] = *(const h8_t*)(qrow + 16 * ks);
                unsigned run[16];
#pragma unroll 1
                for (int nt = 0; nt < 4; ++nt) {
                    f32x16 S;
#pragma unroll
                    for (int r = 0; r < 16; ++r) S[r] = 0.f;
#pragma unroll
                    for (int ks = 0; ks < 8; ++ks) {
                        const h8_t a = *(const LAS h8_t*)(lds + (c * 128 + nt * 32 + qn) * RT_STR + 32 * ks + 16 * hf);
                        S = __builtin_amdgcn_mfma_f32_32x32x16_f16(a, Bq[ks], S, 0, 0, 0);
                    }
                    unsigned k[16];
#pragma unroll
                    for (int r = 0; r < 16; ++r) { const int n = 32 * nt + (r & 3) + 8 * (r >> 2) + 4 * hf; k[r] = (f2sort(S[r]) & ~127u) | (unsigned)(127 - n); }
                    sort16_desc(k);
                    if (nt == 0) {
#pragma unroll
                        for (int r = 0; r < 16; ++r) run[r] = k[r];
                    } else merge16_desc(run, k);
                }
#pragma unroll
                for (int r = 0; r < 16; ++r) top[c][r] = run[r];
            }
            unsigned mine[16], oth[16];
#pragma unroll
            for (int r = 0; r < 16; ++r) { const unsigned send = hf ? top[0][r] : top[1][r]; oth[r] = __shfl_xor(send, 32); mine[r] = hf ? top[1][r] : top[0][r]; }
            merge16_desc(mine, oth);
            unsigned ka[16], kb2[16];
#pragma unroll
            for (int r = 0; r < 16; ++r) { const unsigned o = __shfl_xor(mine[r], 32); ka[r] = hf ? o : mine[r]; kb2[r] = hf ? mine[r] : o; }
            float sa[16], sb[16]; unsigned na[4] = {0u, 0u, 0u, 0u}, nb[4] = {0u, 0u, 0u, 0u};
#pragma unroll
            for (int r = 0; r < 16; ++r) {
                sa[r] = sort2f(ka[r] & ~127u); sb[r] = sort2f(kb2[r] & ~127u);
                na[r >> 2] |= (127u - (ka[r] & 127u)) << (8 * (r & 3)); nb[r >> 2] |= (127u - (kb2[r] & 127u)) << (8 * (r & 3));
            }
            unsigned cand[4][16];
#pragma unroll
            for (int g = 0; g < 4; ++g)
#pragma unroll
                for (int r = 0; r < 16; ++r) cand[g][r] = 0u;
#pragma unroll
            for (int slot = 0; slot < 50; ++slot) {
                constexpr unsigned char CIJ[64] = {0, 1, 2, 3, 4, 5, 6, 7, 8, 9, 10, 11, 12, 13, 14, 15, 16, 17, 18, 19, 20, 21, 22, 23, 32, 33, 34, 35, 36, 48, 49, 50, 51, 64, 65, 66, 80, 81, 96, 97, 112, 113, 128, 144, 160, 176, 192, 208, 224, 240, 255, 255, 255, 255, 255, 255, 255, 255, 255, 255, 255, 255, 255, 255};
                const int ij = CIJ[slot], i = ij >> 4, j = ij & 15;
                cand[slot >> 4][slot & 15] = (f2sort(sa[i] + sb[j]) & ~255u) | (unsigned)(255 - ij);
            }
#pragma unroll
            for (int g = 1; g < 4; ++g) sort16_desc(cand[g]);
            merge16_desc(cand[0], cand[1]); merge16_desc(cand[2], cand[3]); merge16_desc(cand[0], cand[2]);
            float ex[16]; float sum = 0.f;
            const float mx = sort2f(cand[0][0] & ~255u);
#pragma unroll
            for (int r = 0; r < 16; ++r) { ex[r] = __expf(sort2f(cand[0][r] & ~255u) - mx); sum += ex[r]; }
            const float inv = 1.f / sum;
            unsigned eo[16];
#pragma unroll
            for (int r = 0; r < 16; ++r) {
                const unsigned id = 255u - (cand[0][r] & 255u), i = id >> 4, j = id & 15u;
                const unsigned wa = (i & 8u) ? ((i & 4u) ? na[3] : na[2]) : ((i & 4u) ? na[1] : na[0]);
                const unsigned wb = (j & 8u) ? ((j & 4u) ? nb[3] : nb[2]) : ((j & 4u) ? nb[1] : nb[0]);
                eo[r] = ((wa >> (8 * (i & 3u))) & 255u) * PNK + ((wb >> (8 * (j & 3u))) & 255u);
                ex[r] *= inv;
            }
            if (hf == 0) {
#pragma unroll
                for (int r4 = 0; r4 < 4; ++r4) { u32x4 w; w.x = eo[4 * r4]; w.y = eo[4 * r4 + 1]; w.z = eo[4 * r4 + 2]; w.w = eo[4 * r4 + 3]; *(u32x4*)(pe + (size_t)t * 128 + hp * 16 + 4 * r4) = w; }
            } else {
#pragma unroll
                for (int r4 = 0; r4 < 4; ++r4) { f32x4 w; w[0] = ex[4 * r4]; w[1] = ex[4 * r4 + 1]; w[2] = ex[4 * r4 + 2]; w[3] = ex[4 * r4 + 3]; *(f32x4*)(pg + (size_t)t * 128 + hp * 16 + 4 * r4) = w; }
            }
        }
    }
}

__device__ __forceinline__ void phase_experts(const Params& p, const f16* h2, const float* x1, const float* gate2  , const f16* u16, const f16* v16,
                              float* xout  , bool final_norm, const float* ng, const float* nshift, const float* nscale, f16* hnext, float* fout) {
    const int tid_ = otid(); const int wid = tid_ >> 6, lane = tid_ & 63;
    const unsigned* pe = (const unsigned*)(p.ws + WS_PE); const float* pg = (const float*)(p.ws + WS_PG);
    for (int t = blockIdx.x * NWAVES + wid; t < NT; t += gridDim.x * NWAVES) {
        const int b = t / SEQ;
        u32x4 hv[4];
#pragma unroll
        for (int i = 0; i < 4; ++i) hv[i] = *(const u32x4*)(h2 + (size_t)t * DM + 512 * i + 8 * lane);
        float acc[32];
#pragma unroll
        for (int i = 0; i < 32; ++i) acc[i] = 0.f;
        for (int g8 = 0; g8 < 32; ++g8) {
            const unsigned myexp = pe[(size_t)t * 128 + g8 * 4 + (lane & 3)];
            const float mygate = pg[(size_t)t * 128 + g8 * 4 + (lane & 3)];
            float part[4];
#pragma unroll
            for (int k = 0; k < 4; ++k) {
                const unsigned e = __shfl(myexp, k);
                const f16* ur = u16 + (size_t)e * DM + 8 * lane;
                float d = 0.f;
#pragma unroll
                for (int i = 0; i < 4; ++i) { const u32x4 w = *(const u32x4*)(ur + 512 * i); d = dot2(hv[i].x, w.x, d); d = dot2(hv[i].y, w.y, d); d = dot2(hv[i].z, w.z, d); d = dot2(hv[i].w, w.w, d); }
                part[k] = d;
            }
#pragma unroll
            for (int k = 0; k < 4; ++k) part[k] = wave_sum(part[k]);
#pragma unroll
            for (int k = 0; k < 4; ++k) {
                const float d = part[k];
                const float act = 0.5f * d * (1.f + erff(d * 0.70710678118654752f));
                const float coef = __shfl(mygate, k) * act;
                const unsigned e = __shfl(myexp, k);
                const f16* vr = v16 + (size_t)e * DM + 8 * lane;
#pragma unroll
                for (int i = 0; i < 4; ++i) {
                    const u32x4 w = *(const u32x4*)(vr + 512 * i);
                    acc[8 * i + 0] += coef * h_lo(w.x); acc[8 * i + 1] += coef * h_hi(w.x); acc[8 * i + 2] += coef * h_lo(w.y); acc[8 * i + 3] += coef * h_hi(w.y);
                    acc[8 * i + 4] += coef * h_lo(w.z); acc[8 * i + 5] += coef * h_hi(w.z); acc[8 * i + 6] += coef * h_lo(w.w); acc[8 * i + 7] += coef * h_hi(w.w);
                }
            }
        }
        float ss = 0.f;
#pragma unroll
        for (int i = 0; i < 4; ++i) {
            const int col = 512 * i + 8 * lane;
#pragma unroll
            for (int hf = 0; hf < 2; ++hf) {
                const f32x4 xi = *(const f32x4*)(x1 + (size_t)t * DM + col + 4 * hf);
                const f32x4 gt = *(const f32x4*)(gate2 + (size_t)b * 6 * DM + col + 4 * hf);
                f32x4 r;
#pragma unroll
                for (int j = 0; j < 4; ++j) { r[j] = xi[j] + gt[j] * acc[8 * i + 4 * hf + j]; acc[8 * i + 4 * hf + j] = r[j]; ss += r[j] * r[j]; }
                if (xout) *(f32x4*)(xout + (size_t)t * DM + col + 4 * hf) = r;
            }
        }
        ss = wave_sum(ss);
        const float rstd = rsqrtf(ss * (1.f / DM) + EPS);
#pragma unroll
        for (int i = 0; i < 4; ++i) {
            const int col = 512 * i + 8 * lane;
            if (final_norm) {
#pragma unroll
                for (int hf = 0; hf < 2; ++hf) {
                    const f32x4 gg = *(const f32x4*)(ng + col + 4 * hf);
                    f32x4 r;
#pragma unroll
                    for (int j = 0; j < 4; ++j) r[j] = acc[8 * i + 4 * hf + j] * rstd * gg[j];
                    *(f32x4*)(fout + (size_t)t * DM + col + 4 * hf) = r;
                }
            } else {
                float yv[8];
#pragma unroll
                for (int hf = 0; hf < 2; ++hf) {
                    const f32x4 gg = *(const f32x4*)(ng + col + 4 * hf), sh = *(const f32x4*)(nshift + (size_t)b * 6 * DM + col + 4 * hf), sc = *(const f32x4*)(nscale + (size_t)b * 6 * DM + col + 4 * hf);
#pragma unroll
                    for (int j = 0; j < 4; ++j) yv[4 * hf + j] = acc[8 * i + 4 * hf + j] * rstd * gg[j] * (1.f + sc[j]) + sh[j];
                }
                u32x4 w; w.x = pack_h2(yv[0], yv[1]); w.y = pack_h2(yv[2], yv[3]); w.z = pack_h2(yv[4], yv[5]); w.w = pack_h2(yv[6], yv[7]);
                *(u32x4*)(hnext + (size_t)t * DM + col) = w;
            }
        }
    }
}

__device__ __forceinline__ void phase_experts8(const Params& p, const float* x1, const float* gate2, const unsigned char* u8, const unsigned char* v8, const float* su, const float* sv,
                              float* xout  , bool final_norm, const float* ng, const float* nshift, const float* nscale, f16* hnext, float* fout) {
    const int tid_ = otid(); const int wid = tid_ >> 6, lane = tid_ & 63;
    const unsigned* pe = (const unsigned*)(p.ws + WS_PE); const float* pg = (const float*)(p.ws + WS_PG);
    const unsigned char* h8 = (const unsigned char*)(p.ws + WS_H8); const float* shv = (const float*)(p.ws + WS_SH);
    for (int t = blockIdx.x * NWAVES + wid; t < NT; t += gridDim.x * NWAVES) {
        const int b = t / SEQ;
        u32x4 hv[2];
#pragma unroll
        for (int i = 0; i < 2; ++i) hv[i] = *(const u32x4*)(h8 + (size_t)t * DM + 1024 * i + 16 * lane);
        const float sht = shv[t];
        float acc[32]; float csum = 0.f;
#pragma unroll
        for (int i = 0; i < 32; ++i) acc[i] = 0.f;
        for (int g4 = 0; g4 < 32; ++g4) {
            const unsigned myexp = pe[(size_t)t * 128 + g4 * 4 + (lane & 3)];
            const float mygate = pg[(size_t)t * 128 + g4 * 4 + (lane & 3)];
            const float mysc = mygate * sv[myexp];
            const float mydsc = su[myexp] * sht;
            int part[4]; u32x4 vr[4][2];
#pragma unroll
            for (int k = 0; k < 4; ++k) {
                const unsigned e = __shfl(myexp, k);
                const unsigned char* ur = u8 + (size_t)e * DM + 16 * lane;
                const unsigned char* vp = v8 + (size_t)e * DM + 16 * lane;
                int d = 0;
#pragma unroll
                for (int i = 0; i < 2; ++i) {
                    const u32x4 w = *(const u32x4*)(ur + 1024 * i);
                    d = __builtin_amdgcn_sdot4((int)hv[i].x, (int)w.x, d, false); d = __builtin_amdgcn_sdot4((int)hv[i].y, (int)w.y, d, false);
                    d = __builtin_amdgcn_sdot4((int)hv[i].z, (int)w.z, d, false); d = __builtin_amdgcn_sdot4((int)hv[i].w, (int)w.w, d, false);
                    vr[k][i] = *(const u32x4*)(vp + 1024 * i);
                }
                part[k] = d;
            }
#pragma unroll
            for (int k = 0; k < 4; ++k) {
#pragma unroll
                for (int o = 32; o >= 1; o >>= 1) part[k] += __shfl_xor(part[k], o);
            }
#pragma unroll
            for (int k = 0; k < 4; ++k) {
                const float d = (float)part[k] * __shfl(mydsc, k);
                const float act = 0.5f * d * (1.f + erff(d * 0.70710678118654752f));
                const float coef = __shfl(mysc, k) * act;
                csum += coef;
#pragma unroll
                for (int i = 0; i < 2; ++i) {
                    const unsigned ww[4] = {vr[k][i].x, vr[k][i].y, vr[k][i].z, vr[k][i].w};
#pragma unroll
                    for (int q = 0; q < 4; ++q) {
                        acc[16 * i + 4 * q + 0] += coef * (float)(ww[q] & 255u); acc[16 * i + 4 * q + 1] += coef * (float)((ww[q] >> 8) & 255u);
                        acc[16 * i + 4 * q + 2] += coef * (float)((ww[q] >> 16) & 255u); acc[16 * i + 4 * q + 3] += coef * (float)(ww[q] >> 24);
                    }
                }
            }
        }
        float ss = 0.f;
#pragma unroll
        for (int i = 0; i < 2; ++i)
#pragma unroll
            for (int q = 0; q < 4; ++q) {
                const int col = 1024 * i + 16 * lane + 4 * q;
                const f32x4 xi = *(const f32x4*)(x1 + (size_t)t * DM + col);
                const f32x4 gt = *(const f32x4*)(gate2 + (size_t)b * 6 * DM + col);
                f32x4 r;
#pragma unroll
                for (int j = 0; j < 4; ++j) { r[j] = xi[j] + gt[j] * (acc[16 * i + 4 * q + j] - 128.f * csum); acc[16 * i + 4 * q + j] = r[j]; ss += r[j] * r[j]; }
                if (xout) *(f32x4*)(xout + (size_t)t * DM + col) = r;
            }
        ss = wave_sum(ss);
        const float rstd = rsqrtf(ss * (1.f / DM) + EPS);
#pragma unroll
        for (int i = 0; i < 2; ++i) {
            const int col0 = 1024 * i + 16 * lane;
            if (final_norm) {
#pragma unroll
                for (int q = 0; q < 4; ++q) {
                    const f32x4 gg = *(const f32x4*)(ng + col0 + 4 * q);
                    f32x4 r;
#pragma unroll
                    for (int j = 0; j < 4; ++j) r[j] = acc[16 * i + 4 * q + j] * rstd * gg[j];
                    *(f32x4*)(fout + (size_t)t * DM + col0 + 4 * q) = r;
                }
            } else {
                float yv[16];
#pragma unroll
                for (int q = 0; q < 4; ++q) {
                    const f32x4 gg = *(const f32x4*)(ng + col0 + 4 * q), sh = *(const f32x4*)(nshift + (size_t)b * 6 * DM + col0 + 4 * q), sc = *(const f32x4*)(nscale + (size_t)b * 6 * DM + col0 + 4 * q);
#pragma unroll
                    for (int j = 0; j < 4; ++j) yv[4 * q + j] = acc[16 * i + 4 * q + j] * rstd * gg[j] * (1.f + sc[j]) + sh[j];
                }
                u32x4 w0, w1;
                w0.x = pack_h2(yv[0], yv[1]); w0.y = pack_h2(yv[2], yv[3]); w0.z = pack_h2(yv[4], yv[5]); w0.w = pack_h2(yv[6], yv[7]);
                w1.x = pack_h2(yv[8], yv[9]); w1.y = pack_h2(yv[10], yv[11]); w1.z = pack_h2(yv[12], yv[13]); w1.w = pack_h2(yv[14], yv[15]);
                *(u32x4*)(hnext + (size_t)t * DM + col0) = w0; *(u32x4*)(hnext + (size_t)t * DM + col0 + 8) = w1;
            }
        }
    }
}

#ifndef EXU_NR
#define EXU_NR 8
#define EXU_SH 11
#endif
__device__ __forceinline__ unsigned xcc_id() { return (unsigned)__builtin_amdgcn_s_getreg((3 << 11) | 20) & 0xFu; }
template <int BITS>
__device__ __forceinline__ void phase_exu(const Params& p, LAS unsigned char* lds, const unsigned char* u8, const float* su, const float* sv) {
    const int tid = otid(), wid = __builtin_amdgcn_readfirstlane(tid >> 6), lane = tid & 63, sub = lane & 15, qd = lane >> 4;
    const unsigned* pe = (const unsigned*)(p.ws + WS_PE); const float* pg = (const float*)(p.ws + WS_PG);
    const unsigned char* h8 = (const unsigned char*)(p.ws + WS_H8); const float* shv = (const float*)(p.ws + WS_SH);
    unsigned* list = (unsigned*)(p.ws + WS_LIST);
    const unsigned* ctl = (const unsigned*)(p.ws + WS_CTL);
    const unsigned myx = *(const LAS unsigned*)(lds + LDS_BYTES - 16), mybi = *(const LAS unsigned*)(lds + LDS_BYTES - 12);
    int G = 0, g = 0, nb = 1;
#pragma unroll
    for (int j = 0; j < 16; ++j) { const unsigned c = __builtin_amdgcn_readfirstlane(__hip_atomic_load(ctl + j, __ATOMIC_RELAXED, __HIP_MEMORY_SCOPE_AGENT)); if (c > 0u) { if ((unsigned)j < myx) ++g; ++G; } if ((unsigned)j == myx) nb = (int)c; }
    const int tstep = nb * NWAVES, tfirst = (int)mybi * NWAVES + wid;
    const int nvis_t = (tfirst < NT) ? (NT - tfirst + tstep - 1) / tstep : 0;
    const int nrange = (EXU_NR - g + G - 1) / G;
    const int nvis = nvis_t * nrange;
    const int* hsv = (const int*)(p.ws + WS_HS);
    unsigned ne0 = 0u, ne1 = 0u; u32x4 nhv[8]; float nsh = 0.f; int nhs = 0;
#define EXU_FETCH(v_) do { const int tt_ = tfirst + ((v_) % nvis_t) * tstep; ne0 = pe[(size_t)tt_ * 128 + lane]; ne1 = pe[(size_t)tt_ * 128 + 64 + lane]; \
        _Pragma("unroll") for (int m = 0; m < 8; ++m) nhv[m] = *(const u32x4*)(h8 + (size_t)tt_ * DM + (BITS == 8 ? 256 * m + 16 * sub : 512 * (m >> 1) + 32 * sub + 16 * (m & 1))); nsh = shv[tt_]; if (BITS == 4) nhs = hsv[tt_]; } while (0)
    if (nvis > 0) EXU_FETCH(0);
    for (int v = 0; v < nvis; ++v) {
        const int t = tfirst + (v % nvis_t) * tstep, r = g + (v / nvis_t) * G;
        const unsigned e0 = ne0, e1 = ne1; const float sht = nsh; const int hs8 = 8 * nhs;
        u32x4 hv[8];
#pragma unroll
        for (int m = 0; m < 8; ++m) hv[m] = nhv[m];
        if (v + 1 < nvis) EXU_FETCH(v + 1);
        const bool in0 = (int)(e0 >> EXU_SH) == r, in1 = (int)(e1 >> EXU_SH) == r;
        const unsigned long long m0 = __ballot(in0), m1 = __ballot(in1);
        const int n0 = __builtin_popcountll(m0), n = n0 + __builtin_popcountll(m1);
        if (n == 0) continue;
        LAS unsigned* wl = (LAS unsigned*)(lds + wid * 1024 + (v & 1) * 512);
        const unsigned long long below = (1ull << lane) - 1ull;
        if (in0) wl[__builtin_popcountll(m0 & below)] = ((unsigned)lane << 16) | e0;
        if (in1) wl[n0 + __builtin_popcountll(m1 & below)] = ((unsigned)(lane + 64) << 16) | e1;
        __builtin_amdgcn_wave_barrier();
        constexpr int PPI = 4;
        constexpr int PPQ = PPI / 4, NLD = (BITS == 8) ? 8 : 4;
        const int nit = (n + PPI - 1) / PPI;
        u32x4 wb[2][8]; unsigned entb[2][PPQ]; float sub_[2][PPQ], svb_[2][PPQ], pgb_[2][PPQ];
#define EXU_ISSUE(B_, it_) do { _Pragma("unroll") for (int pp = 0; pp < PPQ; ++pp) { const int idx_ = (it_) * PPI + qd * PPQ + pp; entb[B_][pp] = wl[idx_ < n ? idx_ : 0]; \
            sub_[B_][pp] = su[entb[B_][pp] & 0xffffu]; svb_[B_][pp] = sv[entb[B_][pp] & 0xffffu]; pgb_[B_][pp] = pg[(size_t)t * 128 + (entb[B_][pp] >> 16)]; \
            const unsigned char* row_ = u8 + (size_t)(entb[B_][pp] & 0xffffu) * (BITS == 8 ? DM : DM / 2) + 16 * sub; \
            _Pragma("unroll") for (int m = 0; m < NLD; ++m) wb[B_][pp * NLD + m] = *(const u32x4*)(row_ + 256 * m); } } while (0)
#define EXU_COMPUTE(B_, it_) do { _Pragma("unroll") for (int pp = 0; pp < PPQ; ++pp) { int d_ = 0; \
            if (BITS == 8) { \
            _Pragma("unroll") for (int m = 0; m < 8; ++m) { const u32x4 w_ = wb[B_][m]; \
                d_ = __builtin_amdgcn_sdot4((int)hv[m].x, (int)w_.x, d_, false); d_ = __builtin_amdgcn_sdot4((int)hv[m].y, (int)w_.y, d_, false); \
                d_ = __builtin_amdgcn_sdot4((int)hv[m].z, (int)w_.z, d_, false); d_ = __builtin_amdgcn_sdot4((int)hv[m].w, (int)w_.w, d_, false); } \
            } else { \
            _Pragma("unroll") for (int m = 0; m < 4; ++m) { const u32x4 w_ = wb[B_][pp * 4 + m]; const u32x4 ha_ = hv[2 * m], hb_ = hv[2 * m + 1]; \
                d_ = __builtin_amdgcn_sdot4((int)ha_.x, (int)(w_.x & 0x0F0F0F0Fu), d_, false); d_ = __builtin_amdgcn_sdot4((int)ha_.y, (int)((w_.x >> 4) & 0x0F0F0F0Fu), d_, false); \
                d_ = __builtin_amdgcn_sdot4((int)ha_.z, (int)(w_.y & 0x0F0F0F0Fu), d_, false); d_ = __builtin_amdgcn_sdot4((int)ha_.w, (int)((w_.y >> 4) & 0x0F0F0F0Fu), d_, false); \
                d_ = __builtin_amdgcn_sdot4((int)hb_.x, (int)(w_.z & 0x0F0F0F0Fu), d_, false); d_ = __builtin_amdgcn_sdot4((int)hb_.y, (int)((w_.z >> 4) & 0x0F0F0F0Fu), d_, false); \
                d_ = __builtin_amdgcn_sdot4((int)hb_.z, (int)(w_.w & 0x0F0F0F0Fu), d_, false); d_ = __builtin_amdgcn_sdot4((int)hb_.w, (int)((w_.w >> 4) & 0x0F0F0F0Fu), d_, false); } \
            } \
            d_ += __shfl_xor(d_, 1); d_ += __shfl_xor(d_, 2); d_ += __shfl_xor(d_, 4); d_ += __shfl_xor(d_, 8); \
            if (BITS == 4) d_ -= hs8; \
            if (((it_) * PPI + qd * PPQ + pp < n) && sub == 0) { \
                const unsigned ent_ = entb[B_][pp], j_ = ent_ >> 16, e_ = ent_ & 0xffffu; \
                const float dd_ = (float)d_ * sub_[B_][pp] * sht; \
                const float act_ = 0.5f * dd_ * (1.f + erff(dd_ * 0.70710678118654752f)); \
                const float coef_ = pgb_[B_][pp] * svb_[B_][pp] * act_ * (1024.f * 256.f); \
                const int ci_ = (int)rintf(fminf(fmaxf(coef_, -32767.f), 32767.f)); \
                list[((size_t)(j_ >> 2) * NT + t) * 4 + (j_ & 3u)] = e_ | ((unsigned)ci_ << 16); } } } while (0)
        EXU_ISSUE(0, 0);
        int it = 0;
        for (; it + 2 < nit; it += 2) {
            EXU_ISSUE(1, it + 1); EXU_COMPUTE(0, it);
            EXU_ISSUE(0, it + 2); EXU_COMPUTE(1, it + 1);
        }
        if (it + 2 == nit) { EXU_ISSUE(1, it + 1); EXU_COMPUTE(0, it); EXU_COMPUTE(1, it + 1); }
        else { EXU_COMPUTE(0, it); }
#undef EXU_ISSUE
#undef EXU_COMPUTE
    }
#undef EXU_FETCH
}

__device__ __forceinline__ void phase_exv(const Params& p, LAS unsigned char* lds, const f16* x1, const float* gate2, const unsigned char* v8c, f16* xout) {
    const int tid = otid();
    const u32x4* list = (const u32x4*)(p.ws + WS_LIST);
    int cfirst = obid(), cstep = gridDim.x;
    {
        const unsigned* ctl = (const unsigned*)(p.ws + WS_CTL);
        const unsigned myx = *(const LAS unsigned*)(lds + LDS_BYTES - 16), mybi = *(const LAS unsigned*)(lds + LDS_BYTES - 12);
        int G = 0, g = 0, nb = 1; bool uniform = true; unsigned c0 = 0u;
#pragma unroll
        for (int j = 0; j < 16; ++j) { const unsigned c = __builtin_amdgcn_readfirstlane(__hip_atomic_load(ctl + j, __ATOMIC_RELAXED, __HIP_MEMORY_SCOPE_AGENT)); if (c > 0u) { if ((unsigned)j < myx) ++g; ++G; if (c0 == 0u) c0 = c; else if (c != c0) uniform = false; } if ((unsigned)j == myx) nb = (int)c; }
        if (uniform && G * nb == (int)gridDim.x && (int)gridDim.x == 256) { cfirst = g * nb + (int)mybi; cstep = 256; }
    }
    for (int c = cfirst; c < 256; c += cstep) {
        __syncthreads();
        {
            const u32x4* src = (const u32x4*)(v8c + (size_t)c * PEXP * 8);
#pragma unroll 4
            for (int i = 0; i < 16; ++i) *(LAS u32x4*)(lds + (size_t)(i * 512 + tid) * 16) = src[i * 512 + tid];
        }
        __syncthreads();
        typedef short s2_t __attribute__((ext_vector_type(2)));
        u32x4 wq[2][8];
        int acc[8]; int csum = 0;
#pragma unroll
        for (int k = 0; k < 8; ++k) acc[k] = 0;
        constexpr int NBATCH = (NT / NTHREADS) * 4;
#define EXV_LOAD(B_, q_) do { const int qq_ = (q_) < NBATCH ? (q_) : NBATCH - 1; const int t_ = tid + (qq_ >> 2) * NTHREADS, jb_ = qq_ & 3; \
            _Pragma("unroll") for (int j4 = 0; j4 < 8; ++j4) wq[B_][j4] = list[(size_t)(jb_ * 8 + j4) * NT + t_]; } while (0)
        EXV_LOAD(0, 0);
#pragma unroll 1
        for (int q0 = 0; q0 < NBATCH; q0 += 4) {
#pragma unroll
            for (int u = 0; u < 4; ++u) {
                const int q = q0 + u;
                if (q < NBATCH) {
                    EXV_LOAD((u + 1) % 2, q + 1);
#pragma unroll
                    for (int j4 = 0; j4 < 8; ++j4) {
                        const unsigned dd[4] = {wq[u % 2][j4].x, wq[u % 2][j4].y, wq[u % 2][j4].z, wq[u % 2][j4].w};
#pragma unroll
                        for (int h = 0; h < 2; ++h) {
                            const unsigned d0 = dd[2 * h], d1 = dd[2 * h + 1];
                            const u32x2 v0 = *(const LAS u32x2*)(lds + (d0 & 0xffffu) * 8), v1 = *(const LAS u32x2*)(lds + (d1 & 0xffffu) * 8);
                            const s2_t cp = __builtin_bit_cast(s2_t, __builtin_amdgcn_perm(d1, d0, 0x07060302u));
                            csum = __builtin_amdgcn_sdot2(cp, __builtin_bit_cast(s2_t, 0x00010001u), csum, false);
                            acc[0] = __builtin_amdgcn_sdot2(cp, __builtin_bit_cast(s2_t, __builtin_amdgcn_perm(v1.x, v0.x, 0x0c040c00u)), acc[0], false);
                            acc[1] = __builtin_amdgcn_sdot2(cp, __builtin_bit_cast(s2_t, __builtin_amdgcn_perm(v1.x, v0.x, 0x0c050c01u)), acc[1], false);
                            acc[2] = __builtin_amdgcn_sdot2(cp, __builtin_bit_cast(s2_t, __builtin_amdgcn_perm(v1.x, v0.x, 0x0c060c02u)), acc[2], false);
                            acc[3] = __builtin_amdgcn_sdot2(cp, __builtin_bit_cast(s2_t, __builtin_amdgcn_perm(v1.x, v0.x, 0x0c070c03u)), acc[3], false);
                            acc[4] = __builtin_amdgcn_sdot2(cp, __builtin_bit_cast(s2_t, __builtin_amdgcn_perm(v1.y, v0.y, 0x0c040c00u)), acc[4], false);
                            acc[5] = __builtin_amdgcn_sdot2(cp, __builtin_bit_cast(s2_t, __builtin_amdgcn_perm(v1.y, v0.y, 0x0c050c01u)), acc[5], false);
                            acc[6] = __builtin_amdgcn_sdot2(cp, __builtin_bit_cast(s2_t, __builtin_amdgcn_perm(v1.y, v0.y, 0x0c060c02u)), acc[6], false);
                            acc[7] = __builtin_amdgcn_sdot2(cp, __builtin_bit_cast(s2_t, __builtin_amdgcn_perm(v1.y, v0.y, 0x0c070c03u)), acc[7], false);
                        }
                    }
                    if ((u & 3) == 3) {
                        const int t = tid + (q >> 2) * NTHREADS;
                        const int b = t / SEQ, col = 8 * c;
                        const int off = csum << 7;
                        const u32x4 xw = *(const u32x4*)(x1 + (size_t)t * DM + col);
                        const unsigned xws[4] = {xw.x, xw.y, xw.z, xw.w};
                        u32x4 ow; unsigned ows[4];
#pragma unroll
                        for (int hfi = 0; hfi < 2; ++hfi) {
                            const f32x4 gt = *(const f32x4*)(gate2 + (size_t)b * 6 * DM + col + 4 * hfi);
                            float r[4];
#pragma unroll
                            for (int k = 0; k < 4; ++k) { const unsigned xx = xws[2 * hfi + (k >> 1)]; const float xi = (k & 1) ? h_hi(xx) : h_lo(xx); r[k] = xi + gt[k] * ((float)(acc[4 * hfi + k] - off) * (1.f / (1024.f * 256.f))); }
                            ows[2 * hfi] = pack_h2(r[0], r[1]); ows[2 * hfi + 1] = pack_h2(r[2], r[3]);
                        }
                        ow.x = ows[0]; ow.y = ows[1]; ow.z = ows[2]; ow.w = ows[3];
                        *(u32x4*)(xout + (size_t)t * DM + col) = ow;
                        csum = 0;
#pragma unroll
                        for (int k = 0; k < 8; ++k) acc[k] = 0;
                    }
                }
            }
        }
#undef EXV_LOAD
    }
}

__device__ __forceinline__ void phase_norm_out(const Params& p, float* x2, bool final_norm, const float* g, const float* shift, const float* scale, f16* hout) {
    const int tid_ = otid(); const int wid = tid_ >> 6, lane = tid_ & 63;
    for (int row = blockIdx.x * NWAVES + wid; row < NT; row += gridDim.x * NWAVES) {
        const int b = row / SEQ;
        float* xr = x2 + (size_t)row * DM;
        f32x4 v[8]; float ss = 0.f;
#pragma unroll
        for (int i = 0; i < 8; ++i) { v[i] = *(const f32x4*)(xr + i * 256 + lane * 4); ss += v[i][0] * v[i][0] + v[i][1] * v[i][1] + v[i][2] * v[i][2] + v[i][3] * v[i][3]; }
        ss = wave_sum(ss);
        const float rstd = rsqrtf(ss * (1.f / DM) + EPS);
#pragma unroll
        for (int i = 0; i < 8; ++i) {
            const int col = i * 256 + lane * 4;
            const f32x4 gg = *(const f32x4*)(g + col);
            if (final_norm) { *(f32x4*)(xr + col) = v[i] * rstd * gg; }
            else {
                const f32x4 sh = *(const f32x4*)(shift + (size_t)b * 6 * DM + col), sc = *(const f32x4*)(scale + (size_t)b * 6 * DM + col);
                const f32x4 y = v[i] * rstd * gg * (sc + 1.f) + sh;
                u32x2 w; w.x = pack_h2(y[0], y[1]); w.y = pack_h2(y[2], y[3]);
                *(u32x2*)(hout + (size_t)row * DM + col) = w;
            }
        }
    }
}

#define XB_TMO      128
#define XB_XCNT(j)  (256  + 64 * (j))
#define XB_XSUB(j)  (1280 + 64 * (j))
#define XB_XGEN(j)  (2304 + 64 * (j))
#define XB_TOP      3328
#define XB_TOPGEN   3392
#define XCD_BAR_WORDS 3456
#define XB_SPIN_CAP (1u << 22)
__device__ __forceinline__ unsigned xb_ld(unsigned* p) { return __hip_atomic_load(p, __ATOMIC_RELAXED, __HIP_MEMORY_SCOPE_AGENT); }
__device__ __forceinline__ unsigned xb_add(unsigned* p, unsigned v) { return __hip_atomic_fetch_add(p, v, __ATOMIC_RELAXED, __HIP_MEMORY_SCOPE_AGENT); }
#define XB_SPIN(cond, bar) do { unsigned _sp = 0; while (cond) { __builtin_amdgcn_s_sleep(1); \
    if ((++_sp & 255u) == 0u) { if (xb_ld(&(bar)[XB_TMO])) break; if (_sp > XB_SPIN_CAP) { atomicAdd(&(bar)[XB_TMO], 1u); break; } } } } while (0)
struct XcdBarrier { unsigned* bar; unsigned x; volatile LAS unsigned* st; };
__device__ __forceinline__ void xcd_barrier_complete(unsigned* bar, unsigned x, unsigned& nloc, unsigned& nx) {
    const unsigned G = gridDim.x * gridDim.y * gridDim.z;
    unsigned sum, cnt, mine, sp = 0u;
    for (;;) {
        sum = 0u; cnt = 0u; mine = 0u;
#pragma unroll
        for (unsigned j = 0; j < 16; ++j) { const unsigned c = xb_ld(&bar[XB_XCNT(j)]); sum += c; cnt += (c > 0u) ? 1u : 0u; mine = (j == x) ? c : mine; }
        if (sum == G) break;
        __builtin_amdgcn_s_sleep(1);
        if ((++sp & 255u) == 0u) { if (xb_ld(&bar[XB_TMO])) break; if (sp > XB_SPIN_CAP) { atomicAdd(&bar[XB_TMO], 1u); break; } }
    }
    nloc = mine > 0u ? mine : 1u; nx = cnt > 0u ? cnt : 1u;
}
__device__ __forceinline__ void xcd_barrier(const XcdBarrier& b) {
    asm volatile("s_waitcnt vmcnt(0)" ::: "memory");
    __syncthreads();
    if (threadIdx.x == 0) {
        unsigned* bar = b.bar;
        __builtin_amdgcn_s_waitcnt(0);
        unsigned nloc = b.st[0], nx = b.st[1];
        if (nloc == 0u) { xcd_barrier_complete(bar, b.x, nloc, nx); b.st[0] = nloc; b.st[1] = nx; }
        const unsigned old = xb_add(&bar[XB_XSUB(b.x)], 1u);
        const unsigned gen = old / nloc;
        if (old + 1u == (gen + 1u) * nloc) {
            __builtin_amdgcn_fence(__ATOMIC_RELEASE, "agent");
            asm volatile("s_waitcnt vmcnt(0)" ::: "memory");
            const unsigned og = xb_add(&bar[XB_TOP], 1u);
            const unsigned tg = og / nx;
            if (og + 1u == (tg + 1u) * nx) xb_add(&bar[XB_TOPGEN], 1u);
            else XB_SPIN(xb_ld(&bar[XB_TOPGEN]) == tg, bar);
            __builtin_amdgcn_fence(__ATOMIC_ACQUIRE, "agent");
            xb_add(&bar[XB_XGEN(b.x)], 1u);
            asm volatile("s_waitcnt vmcnt(0)" ::: "memory");
        } else {
            XB_SPIN(xb_ld(&bar[XB_XGEN(b.x)]) == gen, bar);
            __builtin_amdgcn_fence(__ATOMIC_ACQUIRE, "agent");
            asm volatile("s_waitcnt vmcnt(0)" ::: "memory");
        }
    }
    __syncthreads();
}

constexpr int PH_CONV = 0, PH_N1 = 1, PH_L0 = 2, PH_PER_LAYER = 10, PH_TOTAL = PH_L0 + DEPTH * PH_PER_LAYER;

__global__ void __launch_bounds__(NTHREADS, 2) mega(Params p_arg) {
    extern __shared__ __attribute__((aligned(16))) unsigned char shm[];
    LAS unsigned char* lds = (LAS unsigned char*)shm;
    typedef const Params __attribute__((address_space(4)))* KP;
    const int ph_lo = p_arg.ph_lo, ph_hi = p_arg.ph_hi;
    if (threadIdx.x == 0) {
        const unsigned x = xcc_id();
        const unsigned bi = __hip_atomic_fetch_add((unsigned*)(p_arg.ws + WS_CTL) + x, 1u, __ATOMIC_RELAXED, __HIP_MEMORY_SCOPE_AGENT);
        *(LAS unsigned*)(lds + LDS_BYTES - 16) = x; *(LAS unsigned*)(lds + LDS_BYTES - 12) = bi;
        *(LAS unsigned*)(lds + LDS_BYTES - 32) = 0u; *(LAS unsigned*)(lds + LDS_BYTES - 28) = 0u;
        (void)xb_add((unsigned*)(p_arg.ws + WS_CTL + 256) + XB_XCNT(x), 1u);
    }
    __syncthreads();
    XcdBarrier xbar; xbar.bar = (unsigned*)(p_arg.ws + WS_CTL + 256); xbar.x = *(const LAS unsigned*)(lds + LDS_BYTES - 16); xbar.st = (volatile LAS unsigned*)(lds + LDS_BYTES - 32);
#ifndef PMASK
#define PMASK 0xff
#endif
#define EN(k) ((PMASK >> (k)) & 1)
    for (int ph = ph_lo; ph < ph_hi; ++ph) {
        KP kp = (KP)__builtin_amdgcn_kernarg_segment_ptr();
        asm volatile("" : "+s"(kp));
#if defined(__HIP_DEVICE_COMPILE__)
        const Params p = *kp;
#else
        const Params p = p_arg;
#endif
        unsigned char* ws = p.ws;
        const float* mod = (const float*)(ws + WS_MOD);
        int kind, l = 0, s = -1;
        if (ph == PH_CONV) kind = 0;
        else if (ph == PH_N1) kind = 1;
        else {
            l = (ph - PH_L0) / PH_PER_LAYER; s = (ph - PH_L0) % PH_PER_LAYER;
            kind = (s == 0 || s == 3 || s == 5) ? 2 : (s == 1 ? 4 : (s == 2 ? 5 : (s == 4 ? 1 : (s == 6 ? 6 : (s == 7 ? 7 : (s == 8 ? 8 : 9))))));
        }
        const float* modl = mod + (size_t)l * NB * 6 * DM;
        f16* x1 = (f16*)(ws + WS_X1); f16* x2 = (f16*)(ws + WS_X2);
#ifndef REPEAT_KIND
#define REPEAT_KIND -1
#endif
        for (int rep = 0; rep < ((kind == REPEAT_KIND) ? 2 : 1); ++rep) {
        if (rep == 1) xcd_barrier(xbar);
        if (kind == 0) { if (EN(0)) phase_conv(p, lds); }
        else if (kind == 1) {
            if (EN(1)) {
                if (s < 0) phase_norm2<0, false>(p.x, nullptr, nullptr, p.n1g, mod + 0 * DM, mod + 1 * DM, (f16*)(ws + WS_H), nullptr, nullptr);
                else phase_norm2<1, true>(nullptr, x1, nullptr, p.n2g + (size_t)l * DM, modl + 3 * DM, modl + 4 * DM, (f16*)(ws + WS_H), (unsigned*)(ws + WS_H8), (float*)(ws + WS_SH));
            }
        } else if (kind == 2) {
            if (EN(2)) {
                Epi E{}; const f16* A; const f16* Bt; int N;
                if (s == 0) { E.mode = 2; E.rope128 = (const float*)(ws + WS_ROPE128); E.rope64 = (const float*)(ws + WS_ROPE64); E.o16 = (f16*)(ws + WS_PROJ); E.ldc = INWP; A = (const f16*)(ws + WS_H); Bt = (const f16*)(ws + WS_WTIN) + (size_t)l * INWP * DM; N = INWP; }
                else if (s == 3) { E.mode = 1; E.o16 = x1; E.xin = p.x; E.xinh = l == 0 ? nullptr : x2; E.gate = modl + 2 * DM; A = (const f16*)(ws + WS_Y); Bt = (const f16*)(ws + WS_WTOUT) + (size_t)l * DM * DM; N = DM; }
                else { E.mode = 0; E.o16 = (f16*)(ws + WS_Y); E.ldc = DM; A = (const f16*)(ws + WS_H); Bt = (const f16*)(ws + WS_WTQ) + (size_t)l * DM * DM; N = DM; }
                gemm_run(p, lds, A, Bt, N, E);
            }
        } else if (kind == 3) { if (EN(3)) phase_rope(p); }
        else if (kind == 4) { if (EN(4)) phase_index2(p, lds); }
        else if (kind == 5) { if (EN(5)) phase_attn2(p, lds, p.ong + (size_t)l * DM, (unsigned*)(ws + WS_CTL + 64) + l); }
        else if (kind == 6) { if (EN(6)) phase_route2(p, lds, (const f16*)(ws + WS_SUBK) + (size_t)l * PH * 2 * PNK * 128); }
        else if (kind == 7) {
            if (EN(7)) { if (l == DEPTH - 1 && LAST_BITS == 4) phase_exu<4>(p, lds, ws + WS_U8 + (size_t)l * PEXP * DM, (const float*)(ws + WS_SU) + (size_t)l * PEXP, (const float*)(ws + WS_SV) + (size_t)l * PEXP);
                         else phase_exu<8>(p, lds, ws + WS_U8 + (size_t)l * PEXP * DM, (const float*)(ws + WS_SU) + (size_t)l * PEXP, (const float*)(ws + WS_SV) + (size_t)l * PEXP); }
        } else if (kind == 8) {
            if (EN(7)) phase_exv(p, lds, x1, modl + 5 * DM, ws + WS_V8 + (size_t)l * PEXP * DM, x2);
        } else {
            const bool fin = (l == DEPTH - 1);
            const float* modn = mod + (size_t)(fin ? l : l + 1) * NB * 6 * DM;
            if (EN(1)) { if (fin) phase_norm2<2, true>(nullptr, x2, p.out, p.fg, nullptr, nullptr, nullptr, nullptr, nullptr);
                         else phase_norm2<0, true>(nullptr, x2, nullptr, p.n1g + (size_t)(l + 1) * DM, modn + 0 * DM, modn + 1 * DM, (f16*)(ws + WS_H), nullptr, nullptr); }
        }
        }
        if (ph + 1 < ph_hi) { if (ph == ph_lo) cg::this_grid().sync(); else xcd_barrier(xbar); }
    }
}

extern "C" void kernel_launch(void* const* d_in, const int* in_sizes, int n_in, void* d_out, int out_size, void* d_ws, size_t ws_size, hipStream_t stream) {
    static int grid = 0;
    if (grid == 0) {
        if (n_in != 14 || out_size != NT * DM || ws_size < WS_END) { fprintf(stderr, "kernel_launch: unexpected sizes (n_in %d out %d ws %zu need %zu)\n", n_in, out_size, ws_size, (size_t)WS_END); grid = -1; return; }
        if (hipFuncSetAttribute((const void*)mega, hipFuncAttributeMaxDynamicSharedMemorySize, LDS_BYTES) != hipSuccess) { fprintf(stderr, "kernel_launch: hipFuncSetAttribute failed\n"); grid = -1; return; }
        int dev = 0, cus = 0, per_cu = 0;
        hipGetDevice(&dev); hipDeviceGetAttribute(&cus, hipDeviceAttributeMultiprocessorCount, dev);
        hipOccupancyMaxActiveBlocksPerMultiprocessor(&per_cu, (const void*)mega, NTHREADS, LDS_BYTES);
        if (per_cu < 1) { fprintf(stderr, "kernel_launch: occupancy query says %d blocks per CU\n", per_cu); grid = -1; return; }
        grid = cus;
    }
    if (grid < 0) return;
    Params p{};
    p.x = (const float*)d_in[0]; p.c = (const float*)d_in[1]; p.ada_w = (const float*)d_in[2]; p.ada_b = (const float*)d_in[3];
    p.n1g = (const float*)d_in[4]; p.n2g = (const float*)d_in[5]; p.w_in = (const float*)d_in[6]; p.ong = (const float*)d_in[7];
    p.w_out = (const float*)d_in[8]; p.wq = (const float*)d_in[9]; p.subk = (const float*)d_in[10]; p.pu = (const float*)d_in[11];
    p.pv = (const float*)d_in[12]; p.fg = (const float*)d_in[13];
    p.out = (float*)d_out; p.ws = (unsigned char*)d_ws;
#if 0
    for (int ph = 0; ph < PH_TOTAL; ++ph) {
        p.ph_lo = ph; p.ph_hi = ph + 1;
        hipLaunchKernelGGL(mega, dim3(grid), dim3(NTHREADS), LDS_BYTES, stream, p);
    }
#else
    p.ph_lo = 0; p.ph_hi = PH_TOTAL;
    if (hipMemsetAsync((char*)d_ws + WS_CTL, 0, CTL_BYTES, stream) != hipSuccess) { fprintf(stderr, "kernel_launch: memset of control words failed\n"); return; }
    void* args[] = {&p};
    hipError_t e = hipLaunchCooperativeKernel((const void*)mega, dim3(grid), dim3(NTHREADS), args, LDS_BYTES, stream);
    if (e != hipSuccess) fprintf(stderr, "cooperative launch failed: %s (grid %d)\n", hipGetErrorString(e), grid);
#endif
}
```

```cpp
#include <hip/hip_runtime.h>
#include <hip/hip_cooperative_groups.h>
#include <cstdio>
#include <cstdint>
namespace cg = cooperative_groups;

#define LAS __attribute__((address_space(3)))
typedef _Float16 f16;
typedef _Float16 h2_t __attribute__((ext_vector_type(2)));
typedef _Float16 h4_t __attribute__((ext_vector_type(4)));
typedef _Float16 h8_t __attribute__((ext_vector_type(8)));
typedef float f32x4 __attribute__((ext_vector_type(4)));
typedef unsigned u32x4 __attribute__((ext_vector_type(4)));
typedef unsigned u32x2 __attribute__((ext_vector_type(2)));

constexpr int NB = 8, SEQ = 2048, DM = 2048, NT = NB * SEQ, DEPTH = 2;
constexpr int HD = 128, HA = 6, HB = 5, HC = 5, NHEADS = 16;
constexpr int IH = 16, IDM = 64, DSA_TOPK = 256;
constexpr int MOBA_BLK = 256, MOBA_NB = 8;
constexpr int INW = 5968, INWP = 6144;
constexpr int PH = 8, PNK = 128, PTOPK = 16, PEXP = 16384;
constexpr float EPS = 1e-6f;
constexpr int C_QA = 0, C_KA = 768, C_VA = 896, C_IQ = 1024, C_IK = 2048, C_IW = 2112, C_QB = 2176, C_KB = 2816, C_VB = 3456,
              C_QC = 4096, C_KC = 4736, C_VC = 5376, C_END = 6016;

#ifndef LAST_BITS
#define LAST_BITS 8
#endif
constexpr int NTHREADS = 512, NWAVES = 8;
constexpr int LDS_BYTES = 147456;

constexpr size_t al256(size_t x) { return (x + 255) & ~(size_t)255; }
constexpr size_t WS_WTIN = 0;
constexpr size_t WS_WTOUT = WS_WTIN + (size_t)DEPTH * INWP * DM * 2;
constexpr size_t WS_WTQ = WS_WTOUT + (size_t)DEPTH * DM * DM * 2;
constexpr size_t WS_U8 = WS_WTQ + (size_t)DEPTH * DM * DM * 2;
constexpr size_t WS_V8 = WS_U8 + (size_t)DEPTH * PEXP * DM;
constexpr size_t WS_SU = WS_V8 + (size_t)DEPTH * PEXP * DM;
constexpr size_t WS_SV = WS_SU + (size_t)DEPTH * PEXP * 4;
constexpr size_t WS_H8 = WS_SV + (size_t)DEPTH * PEXP * 4;
constexpr size_t WS_SH = WS_H8 + (size_t)NT * DM;
constexpr size_t WS_HS = WS_SH + (size_t)NT * 4;
constexpr size_t WS_SUBK = WS_HS + (size_t)NT * 4;
constexpr size_t WS_MOD = WS_SUBK + (size_t)DEPTH * PH * 2 * PNK * 128 * 2;
constexpr size_t WS_ROPE128 = WS_MOD + (size_t)DEPTH * NB * 6 * DM * 4;
constexpr size_t WS_ROPE64 = WS_ROPE128 + (size_t)SEQ * 64 * 8;
constexpr size_t WS_H = WS_ROPE64 + (size_t)SEQ * 32 * 8;
constexpr size_t WS_PROJ = WS_H + (size_t)NT * DM * 2;
constexpr size_t WS_KMEAN = WS_PROJ + (size_t)NT * INWP * 2;
constexpr size_t WS_MASK = WS_KMEAN + al256((size_t)NB * HC * MOBA_NB * HD * 4);
constexpr size_t WS_Y = WS_MASK + (size_t)NB * SEQ * 64 * 4;
constexpr size_t WS_X1 = WS_Y + (size_t)NT * DM * 2;
constexpr size_t WS_X2 = WS_X1 + (size_t)NT * DM * 2;
constexpr size_t WS_PE = WS_X1 + (size_t)NT * DM * 4;
constexpr size_t WS_PG = WS_PE + (size_t)NT * 128 * 4;
constexpr size_t WS_LIST = WS_PG + (size_t)NT * 128 * 4;
constexpr size_t WS_CTL = WS_LIST + (size_t)NT * 128 * 4;
constexpr size_t CTL_BYTES = 16384;
constexpr size_t WS_END = WS_CTL + CTL_BYTES;

struct Params {
    const float *x, *c, *ada_w, *ada_b, *n1g, *n2g, *w_in, *ong, *w_out, *wq, *subk, *pu, *pv, *fg;
    float* out;
    unsigned char* ws;
    int ph_lo, ph_hi;
};

__device__ __forceinline__ int otid() { int t = threadIdx.x; asm volatile("" : "+v"(t)); return t; }
__device__ __forceinline__ int obid() { int t = blockIdx.x; asm volatile("" : "+s"(t)); return t; }
__device__ __forceinline__ float wave_sum(float v) {
#pragma unroll
    for (int o = 32; o >= 1; o >>= 1) v += __shfl_xor(v, o);
    return v;
}
__device__ __forceinline__ float wave_max(float v) {
#pragma unroll
    for (int o = 32; o >= 1; o >>= 1) v = fmaxf(v, __shfl_xor(v, o));
    return v;
}
__device__ __forceinline__ unsigned pack_h2(float a, float b) { h2_t r; r.x = (f16)a; r.y = (f16)b; return __builtin_bit_cast(unsigned, r); }
__device__ __forceinline__ float h_lo(unsigned u) { h2_t r = __builtin_bit_cast(h2_t, u); return (float)r.x; }
__device__ __forceinline__ float h_hi(unsigned u) { h2_t r = __builtin_bit_cast(h2_t, u); return (float)r.y; }
__device__ __forceinline__ float dot2(unsigned a, unsigned b, float c) {
    return __builtin_amdgcn_fdot2(__builtin_bit_cast(h2_t, a), __builtin_bit_cast(h2_t, b), c, false);
}

namespace pg8 {
constexpr int BM = 256, BK = 64, HALF = 128, HTB = HALF * BK * 2, STAGE_BYTES = 8 * HTB, NXCD = 8, WGM = 8;
__host__ __device__ __forceinline__ int lds_byte(int r, int c) { const int st = (r >> 4) * 2 + (c >> 5), rr = r & 15, cc = c & 31, ob = rr * 64 + cc * 2; return st * 1024 + (ob ^ (((ob >> 9) & 1) << 5)); }
__host__ __device__ __forceinline__ void stage_rc(int b, int& R, int& C) { const int st = b / 1024, sb = b % 1024, swz = sb ^ (((sb >> 9) & 1) << 5); R = (st >> 1) * 16 + swz / 64; C = (st & 1) * 32 + (swz % 64) / 2; }
struct Unit { int pm, pn; };
struct Gemm { const unsigned short* A; const unsigned short* Bt; int M, N, K; };
struct StaticOrder {
    int nM, nN, nwg, G, c;
    __host__ __device__ void init(int M, int N, int G_, int c_) { nM = M / BM; nN = N / BM; nwg = nM * nN; G = G_; c = c_; }
    __host__ __device__ bool next(int i, Unit& u) const {
        const long L = (long)i * G + c; if (L >= nwg) return false;
        int wgid = (int)L; { const int q = nwg / NXCD, r = nwg % NXCD, xcd = wgid % NXCD, off = wgid / NXCD; wgid = (xcd < r ? xcd * (q + 1) : r * (q + 1) + (xcd - r) * q) + off; }
        const int nig = WGM * nN, gid = wgid / nig, fm = gid * WGM, gsz = (nM - fm) < WGM ? (nM - fm) : WGM;
        u.pm = fm + ((wgid % nig) % gsz); u.pn = (wgid % nig) / gsz; return true;
    }
};

template <class Epi>
__device__ __forceinline__ void gemm_phase(LAS unsigned char* lds, const Gemm g, const StaticOrder& S, const Epi& E) {
    const int tid = otid(), wid = __builtin_amdgcn_readfirstlane(tid >> 6), lane = tid & 63, wr = wid >> 2, wc = wid & 3, fr = lane & 15, fq = lane >> 4;
    const int K = g.K, nt = K / BK;
    unsigned voffA[2], voffB[2];
#pragma unroll
    for (int i = 0; i < 2; ++i) { int R, C; stage_rc(tid * 16 + i * 8192, R, C); voffA[i] = (unsigned)(R * K + C) * 2u; voffB[i] = (unsigned)(R * K + C) * 2u; }
    const size_t kstep = (size_t)(BK * 2);
    const size_t hstep = (size_t)HALF * K * 2;
    const size_t tstep = 2 * hstep;
    const unsigned ldsw = (unsigned)wid * 1024u;
    const int aoff = lds_byte(wr * 64 + fr, fq * 8), boff = lds_byte(wc * 32 + fr, fq * 8);
#define PG8_SA(b, h) (((b) * 2 + (h)) * HTB)
#define PG8_SB(b, h) ((4 + (b) * 2 + (h)) * HTB)
#define PG8_STAGE(bufoff, gbase, voff) do { _Pragma("unroll") for (int _i = 0; _i < 2; ++_i) \
        __builtin_amdgcn_global_load_lds((const unsigned*)((const char*)(gbase) + (voff)[_i]), (LAS unsigned*)(lds + (bufoff) + ldsw + _i * 8192), 16, 0, 0); } while (0)
#define PG8_LDA(dst, b, h) do { _Pragma("unroll") for (int m = 0; m < 4; ++m) _Pragma("unroll") for (int k = 0; k < 2; ++k) dst[m][k] = *(const LAS h8_t*)(lds + PG8_SA(b, h) + aoff + m * 2048 + k * 1024); } while (0)
#define PG8_LDB(dst, b, h) do { _Pragma("unroll") for (int n = 0; n < 2; ++n) _Pragma("unroll") for (int k = 0; k < 2; ++k) dst[n][k] = *(const LAS h8_t*)(lds + PG8_SB(b, h) + boff + n * 2048 + k * 1024); } while (0)
#define PG8_MMA(ai, bj, At, Bt) do { __builtin_amdgcn_s_setprio(1); _Pragma("unroll") for (int m = 0; m < 4; ++m) _Pragma("unroll") for (int n = 0; n < 2; ++n) _Pragma("unroll") for (int k = 0; k < 2; ++k) \
        acc[ai][bj][m][n] = __builtin_amdgcn_mfma_f32_16x16x32_f16(Bt[n][k], At[m][k], acc[ai][bj][m][n], 0, 0, 0); __builtin_amdgcn_s_setprio(0); } while (0)
#define PG8_WAIT_V(n) asm volatile("s_waitcnt vmcnt(" #n ")" ::: "memory")
#define PG8_WAIT_L(n) asm volatile("s_waitcnt lgkmcnt(" #n ")" ::: "memory")
#define PG8_BAR __builtin_amdgcn_s_barrier()
#define PG8_SCHED __builtin_amdgcn_sched_barrier(0)
    Unit cur, nxt; int ui = 0;
    if (!S.next(0, cur)) return;
    f32x4 acc[2][2][4][2];
#pragma unroll
    for (int a = 0; a < 2; ++a)
#pragma unroll
        for (int b = 0; b < 2; ++b)
#pragma unroll
            for (int m = 0; m < 4; ++m)
#pragma unroll
                for (int n = 0; n < 2; ++n) acc[a][b][m][n] = (f32x4){0.f, 0.f, 0.f, 0.f};
    h8_t At[4][2], B0[2][2], B1[2][2];
    const char* cA = (const char*)g.A + (size_t)cur.pm * tstep; const char* cB = (const char*)g.Bt + (size_t)cur.pn * tstep;
    PG8_STAGE(PG8_SB(0, 0), cB, voffB); PG8_STAGE(PG8_SA(0, 0), cA, voffA); PG8_STAGE(PG8_SB(0, 1), cB + hstep, voffB); PG8_STAGE(PG8_SA(0, 1), cA + hstep, voffA);
    if (wr == 1) PG8_BAR;
    PG8_WAIT_V(4); PG8_BAR;
    PG8_STAGE(PG8_SB(1, 0), cB + kstep, voffB); PG8_STAGE(PG8_SA(1, 0), cA + kstep, voffA); PG8_STAGE(PG8_SB(1, 1), cB + hstep + kstep, voffB);
    PG8_WAIT_V(6); PG8_BAR;
    for (;;) {
        const bool has_next = S.next(ui + 1, nxt);
        const char* nA = has_next ? (const char*)g.A + (size_t)nxt.pm * tstep : cA; const char* nB = has_next ? (const char*)g.Bt + (size_t)nxt.pn * tstep : cB;
        for (int t = 0; t < nt; t += 2) {
            const bool last = (t == nt - 2);
            const char* a1 = cA + (size_t)(t + 1) * kstep;
            const char* a2 = last ? nA : cA + (size_t)(t + 2) * kstep; const char* b2 = last ? nB : cB + (size_t)(t + 2) * kstep;
            const char* a3 = a2 + kstep; const char* b3 = b2 + kstep;
            PG8_LDB(B0, 0, 0); PG8_SCHED; PG8_LDA(At, 0, 0); PG8_STAGE(PG8_SA(1, 1), a1 + hstep, voffA);
            PG8_WAIT_L(8); PG8_BAR; PG8_WAIT_L(0); PG8_MMA(0, 0, At, B0); PG8_BAR; PG8_SCHED;
            PG8_LDB(B1, 0, 1); PG8_STAGE(PG8_SB(0, 0), b2, voffB);
            PG8_BAR; PG8_WAIT_L(0); PG8_MMA(0, 1, At, B1); PG8_BAR;
            PG8_LDA(At, 0, 1); PG8_STAGE(PG8_SA(0, 0), a2, voffA);
            PG8_BAR; PG8_WAIT_L(0); PG8_MMA(1, 0, At, B0); PG8_BAR; PG8_SCHED;
            PG8_STAGE(PG8_SB(0, 1), b2 + hstep, voffB);
            PG8_WAIT_V(6); PG8_BAR; PG8_MMA(1, 1, At, B1); PG8_BAR;
            PG8_LDB(B0, 1, 0); PG8_SCHED; PG8_LDA(At, 1, 0); PG8_STAGE(PG8_SA(0, 1), a2 + hstep, voffA);
            PG8_WAIT_L(8); PG8_BAR; PG8_WAIT_L(0); PG8_MMA(0, 0, At, B0); PG8_BAR; PG8_SCHED;
            PG8_LDB(B1, 1, 1); PG8_STAGE(PG8_SB(1, 0), b3, voffB);
            PG8_BAR; PG8_WAIT_L(0); PG8_MMA(0, 1, At, B1); PG8_BAR;
            PG8_LDA(At, 1, 1); PG8_STAGE(PG8_SA(1, 0), a3, voffA);
            PG8_BAR; PG8_WAIT_L(0); PG8_MMA(1, 0, At, B0); PG8_BAR; PG8_SCHED;
            PG8_STAGE(PG8_SB(1, 1), b3 + hstep, voffB);
            PG8_WAIT_V(6); PG8_BAR; PG8_MMA(1, 1, At, B1); PG8_BAR;
        }
        E(acc, cur, wr, wc, fr, fq);
        if (!has_next) break;
#pragma unroll
        for (int a = 0; a < 2; ++a)
#pragma unroll
            for (int b = 0; b < 2; ++b)
#pragma unroll
                for (int m = 0; m < 4; ++m)
#pragma unroll
                    for (int n = 0; n < 2; ++n) acc[a][b][m][n] = (f32x4){0.f, 0.f, 0.f, 0.f};
        cur = nxt; cA = nA; cB = nB; ++ui;
    }
    PG8_WAIT_V(0);
    if (wr == 0) PG8_BAR;
    PG8_BAR;
#undef PG8_SA
#undef PG8_SB
#undef PG8_STAGE
#undef PG8_LDA
#undef PG8_LDB
#undef PG8_MMA
#undef PG8_WAIT_V
#undef PG8_WAIT_L
#undef PG8_BAR
#undef PG8_SCHED
}
}

__device__ __forceinline__ int win_src_col_l(int pc) { return pc < 2128 ? pc : (pc < C_QB ? -1 : (pc < C_END ? pc - 48 : -1)); }
__device__ __forceinline__ int rope_type(int g) { return (g <= 6 || (g >= 32 && g <= 41)) ? 1 : ((g >= 8 && g <= 15) ? 2 : (g == 16 ? 3 : 0)); }
__device__ __forceinline__ int win_src_col(int pc) {
    const int g = pc >> 7, p = pc & 127, ty = rope_type(g);
    int l = p;
    if (ty == 1) { const int q4 = p >> 2, e = p & 3; l = 2 * q4 + (e >> 1) + 64 * (e & 1); }
    else if (ty == 2 || (ty == 3 && p < 64)) { const int hb = p >> 6, pp = p & 63, q4 = pp >> 2, e = pp & 3; l = hb * 64 + 2 * q4 + (e >> 1) + 32 * (e & 1); }
    return win_src_col_l(g * 128 + l);
}


struct Epi {
    int mode; f16* o16; int ldc; float* o32; const float* xin; const f16* xinh; const float* gate; const float* rope128; const float* rope64;
    __device__ __forceinline__ void operator()(const f32x4 (&acc)[2][2][4][2], const pg8::Unit& u, int wr, int wc, int fr, int fq) const {
        const int row0 = u.pm * 256 + wr * 64 + fr, col0 = u.pn * 256 + wc * 32 + 4 * fq;
        if (mode == 2) {
#pragma unroll
            for (int bj = 0; bj < 2; ++bj) {
                const int g = __builtin_amdgcn_readfirstlane(u.pn * 2 + bj);
                int ty = rope_type(g); if (ty == 3) ty = (wc < 2) ? 2 : 0;
                f16* ob = o16 + (size_t)g * 128;
                if (ty == 0) {
#pragma unroll
                    for (int ai = 0; ai < 2; ++ai)
#pragma unroll
                        for (int m = 0; m < 4; ++m)
#pragma unroll
                            for (int n = 0; n < 2; ++n) {
                                const f32x4 v = acc[ai][bj][m][n];
                                u32x2 w; w.x = pack_h2(v[0], v[1]); w.y = pack_h2(v[2], v[3]);
                                *(u32x2*)(ob + (size_t)(row0 + ai * 128 + m * 16) * ldc + wc * 32 + n * 16 + 4 * fq) = w;
                            }
                } else {
                    const float* tab = ty == 1 ? rope128 : rope64;
                    const int half = ty == 1 ? 64 : 32, tw = ty == 1 ? 128 : 64;
#pragma unroll
                    for (int ai = 0; ai < 2; ++ai)
#pragma unroll
                        for (int m = 0; m < 4; ++m) {
                            const int row = row0 + ai * 128 + m * 16, pos = row & (SEQ - 1);
#pragma unroll
                            for (int n = 0; n < 2; ++n) {
                                const int p = wc * 32 + n * 16 + 4 * fq;
                                const int j = ty == 1 ? (p >> 1) : ((p & 63) >> 1), base = ty == 1 ? 0 : (p & 64);
                                const f32x4 cs = *(const f32x4*)(tab + (size_t)pos * tw + 2 * j);
                                const f32x4 v = acc[ai][bj][m][n];
                                const float o1a = v[0] * cs[0] - v[1] * cs[1], o2a = v[1] * cs[0] + v[0] * cs[1];
                                const float o1b = v[2] * cs[2] - v[3] * cs[3], o2b = v[3] * cs[2] + v[2] * cs[3];
                                f16* op = ob + (size_t)row * ldc + base + j;
                                *(unsigned*)op = pack_h2(o1a, o1b); *(unsigned*)(op + half) = pack_h2(o2a, o2b);
                            }
                        }
                }
            }
            return;
        }
        if (mode == 1) {
            const int b = row0 / SEQ;
            f32x4 gt[2][2];
#pragma unroll
            for (int bj = 0; bj < 2; ++bj)
#pragma unroll
                for (int n = 0; n < 2; ++n) gt[bj][n] = *(const f32x4*)(gate + (size_t)b * 6 * DM + col0 + bj * 128 + n * 16);
#pragma unroll
            for (int ai = 0; ai < 2; ++ai)
#pragma unroll
                for (int mh = 0; mh < 2; ++mh) {
                    f32x4 xi[2][2][2];
#pragma unroll
                    for (int m2 = 0; m2 < 2; ++m2)
#pragma unroll
                        for (int bj = 0; bj < 2; ++bj)
#pragma unroll
                            for (int n = 0; n < 2; ++n) {
                                const size_t o = (size_t)(row0 + ai * 128 + (2 * mh + m2) * 16) * DM + col0 + bj * 128 + n * 16;
                                if (xinh) { const u32x2 w = *(const u32x2*)(xinh + o); xi[m2][bj][n] = (f32x4){h_lo(w.x), h_hi(w.x), h_lo(w.y), h_hi(w.y)}; }
                                else xi[m2][bj][n] = *(const f32x4*)(xin + o);
                            }
#pragma unroll
                    for (int m2 = 0; m2 < 2; ++m2)
#pragma unroll
                        for (int bj = 0; bj < 2; ++bj)
#pragma unroll
                            for (int n = 0; n < 2; ++n) {
                                const f32x4 r = xi[m2][bj][n] + gt[bj][n] * acc[ai][bj][2 * mh + m2][n];
                                u32x2 w; w.x = pack_h2(r[0], r[1]); w.y = pack_h2(r[2], r[3]);
                                *(u32x2*)(o16 + (size_t)(row0 + ai * 128 + (2 * mh + m2) * 16) * DM + col0 + bj * 128 + n * 16) = w;
                            }
                }
            return;
        }
#pragma unroll
        for (int ai = 0; ai < 2; ++ai)
#pragma unroll
            for (int m = 0; m < 4; ++m) {
                const int row = row0 + ai * 128 + m * 16;
#pragma unroll
                for (int bj = 0; bj < 2; ++bj)
#pragma unroll
                    for (int n = 0; n < 2; ++n) {
                        const int col = col0 + bj * 128 + n * 16;
                        const f32x4 v = acc[ai][bj][m][n];
                        if (mode == 0) {
                            u32x2 w; w.x = pack_h2(v[0], v[1]); w.y = pack_h2(v[2], v[3]);
                            *(u32x2*)(o16 + (size_t)row * ldc + col) = w;
                        } else {
                            const int b = row / SEQ;
                            const f32x4 xi = *(const f32x4*)(xin + (size_t)row * DM + col);
                            const f32x4 gt = *(const f32x4*)(gate + (size_t)b * 6 * DM + col);
                            *(f32x4*)(o32 + (size_t)row * DM + col) = xi + gt * v;
                        }
                    }
            }
    }
};

__device__ __forceinline__ void gemm_run(const Params& p, LAS unsigned char* lds, const f16* A, const f16* Bt, int N, const Epi& E) {
    pg8::Gemm g; g.A = (const unsigned short*)A; g.Bt = (const unsigned short*)Bt; g.M = NT; g.N = N; g.K = DM;
    pg8::StaticOrder S; S.init(NT, N, (int)gridDim.x, (int)blockIdx.x);
    pg8::gemm_phase<Epi>(lds, g, S, E);
}

__device__ __forceinline__ void transpose_tiles(const float* src, int ldsrc, int ncols_phys, bool is_win, f16* dst, float* tile  , int& unit_base, int unit_lo) {
    const int tn = ncols_phys / 64, tk = DM / 64, ntile = tn * tk;
    const int tid = otid();
    float cur[8], nxt[8];
#define TT_LOAD(R_, u_) do { const int n0_ = ((u_) % tn) * 64, k0_ = ((u_) / tn) * 64; \
        _Pragma("unroll") for (int i = 0; i < 8; ++i) { const int e = tid + i * 512, r = e >> 6, c = e & 63; const int pc = n0_ + c; const int sc = is_win ? win_src_col(pc) : pc; \
            R_[i] = sc >= 0 ? src[(size_t)(k0_ + r) * ldsrc + sc] : 0.f; } } while (0)
    int u = blockIdx.x;
    if (u < ntile) TT_LOAD(nxt, u);
    for (; u < ntile; u += gridDim.x) {
        const int n0 = (u % tn) * 64, k0 = (u / tn) * 64;
#pragma unroll
        for (int i = 0; i < 8; ++i) cur[i] = nxt[i];
        if (u + (int)gridDim.x < ntile) TT_LOAD(nxt, u + gridDim.x);
        __syncthreads();
#pragma unroll
        for (int i = 0; i < 8; ++i) { const int e = tid + i * 512, r = e >> 6, c = e & 63; tile[r * 65 + c] = cur[i]; }
        __syncthreads();
        {
            const int n = tid >> 3, kq = (tid & 7) * 8;
            u32x4 w;
            w.x = pack_h2(tile[(kq + 0) * 65 + n], tile[(kq + 1) * 65 + n]); w.y = pack_h2(tile[(kq + 2) * 65 + n], tile[(kq + 3) * 65 + n]);
            w.z = pack_h2(tile[(kq + 4) * 65 + n], tile[(kq + 5) * 65 + n]); w.w = pack_h2(tile[(kq + 6) * 65 + n], tile[(kq + 7) * 65 + n]);
            *(u32x4*)(dst + (size_t)(n0 + n) * DM + k0 + kq) = w;
        }
    }
#undef TT_LOAD
    (void)unit_base; (void)unit_lo;
}

__device__ __forceinline__ void cvt_f16_stream(const float* src, f16* dst, size_t n) {
    const size_t stride = (size_t)gridDim.x * NTHREADS;
    for (size_t i = (size_t)blockIdx.x * NTHREADS + otid(); i < n / 8; i += stride) {
        const f32x4 a = *(const f32x4*)(src + i * 8), b = *(const f32x4*)(src + i * 8 + 4);
        u32x4 w; w.x = pack_h2(a[0], a[1]); w.y = pack_h2(a[2], a[3]); w.z = pack_h2(b[0], b[1]); w.w = pack_h2(b[2], b[3]);
        *(u32x4*)(dst + i * 8) = w;
    }
}

__device__ __forceinline__ void quant_rows(const float* src, int nrows, unsigned* dst, float* scale, int bias) {
    const int tid_ = otid(); const int wid = tid_ >> 6, lane = tid_ & 63;
    const int rstep = gridDim.x * NWAVES;
    int row = blockIdx.x * NWAVES + wid;
    f32x4 v[8], nv[8];
    if (row < nrows) {
#pragma unroll
        for (int i = 0; i < 8; ++i) nv[i] = *(const f32x4*)(src + (size_t)row * DM + i * 256 + lane * 4);
    }
    for (; row < nrows; row += rstep) {
#pragma unroll
        for (int i = 0; i < 8; ++i) v[i] = nv[i];
        if (row + rstep < nrows) {
#pragma unroll
            for (int i = 0; i < 8; ++i) nv[i] = *(const f32x4*)(src + (size_t)(row + rstep) * DM + i * 256 + lane * 4);
        }
        float am = 0.f;
#pragma unroll
        for (int i = 0; i < 8; ++i) am = fmaxf(am, fmaxf(fmaxf(fabsf(v[i][0]), fabsf(v[i][1])), fmaxf(fabsf(v[i][2]), fabsf(v[i][3]))));
        am = wave_max(am);
        const float sc = am > 0.f ? am * (1.f / 127.f) : 1.f, inv = 1.f / sc;
        if (lane == 0) scale[row] = sc;
#pragma unroll
        for (int i = 0; i < 8; ++i) {
            unsigned w = 0u;
#pragma unroll
            for (int j = 0; j < 4; ++j) { const int q = (int)rintf(v[i][j] * inv) + bias; w |= ((unsigned)q & 255u) << (8 * j); }
            dst[(size_t)row * (DM / 4) + i * 64 + lane] = w;
        }
    }
}

__device__ __forceinline__ void quant_rows4(const float* src, int nrows, unsigned* dst, float* scale) {
    const int tid_ = otid(); const int wid = tid_ >> 6, lane = tid_ & 63;
    const int rstep = gridDim.x * NWAVES;
    int row = blockIdx.x * NWAVES + wid;
    f32x4 v[8], nv[8];
    if (row < nrows) {
#pragma unroll
        for (int i = 0; i < 8; ++i) nv[i] = *(const f32x4*)(src + (size_t)row * DM + i * 256 + lane * 4);
    }
    for (; row < nrows; row += rstep) {
#pragma unroll
        for (int i = 0; i < 8; ++i) v[i] = nv[i];
        if (row + rstep < nrows) {
#pragma unroll
            for (int i = 0; i < 8; ++i) nv[i] = *(const f32x4*)(src + (size_t)(row + rstep) * DM + i * 256 + lane * 4);
        }
        float am = 0.f;
#pragma unroll
        for (int i = 0; i < 8; ++i) am = fmaxf(am, fmaxf(fmaxf(fabsf(v[i][0]), fabsf(v[i][1])), fmaxf(fabsf(v[i][2]), fabsf(v[i][3]))));
        am = wave_max(am);
        const float sc = am > 0.f ? am * (1.f / 7.f) : 1.f, inv = 1.f / sc;
        if (lane == 0) scale[row] = sc;
#pragma unroll
        for (int i = 0; i < 8; ++i) {
            unsigned w = 0u;
#pragma unroll
            for (int j = 0; j < 4; ++j) { const int q = (int)rintf(v[i][j] * inv) + 8; w |= ((unsigned)q & 15u) << (8 * j); }
            if (lane & 1) w <<= 4;
            const unsigned o = __shfl_down(w, 1);
            if (!(lane & 1)) dst[(size_t)row * (DM / 8) + i * 32 + (lane >> 1)] = w | o;
        }
    }
}

constexpr int QV_STR = DM + 8;
__device__ __forceinline__ void quant_v_sliced(const float* src, unsigned char* dst, float* scale, LAS unsigned char* lds) {
    const int tid = otid(), wid = tid >> 6, lane = tid & 63;
    for (int blk = obid(); blk < DEPTH * PEXP / 64; blk += gridDim.x) {
        const int row0 = blk * 64, layer = row0 / PEXP, e0 = row0 % PEXP;
        __syncthreads();
        f32x4 nv[8];
#pragma unroll
        for (int i = 0; i < 8; ++i) nv[i] = *(const f32x4*)(src + (size_t)(row0 + wid) * DM + i * 256 + lane * 4);
        for (int rr = wid; rr < 64; rr += NWAVES) {
            f32x4 v[8]; float am = 0.f;
#pragma unroll
            for (int i = 0; i < 8; ++i) v[i] = nv[i];
            if (rr + NWAVES < 64) {
#pragma unroll
                for (int i = 0; i < 8; ++i) nv[i] = *(const f32x4*)(src + (size_t)(row0 + rr + NWAVES) * DM + i * 256 + lane * 4);
            }
#pragma unroll
            for (int i = 0; i < 8; ++i) am = fmaxf(am, fmaxf(fmaxf(fabsf(v[i][0]), fabsf(v[i][1])), fmaxf(fabsf(v[i][2]), fabsf(v[i][3]))));
            am = wave_max(am);
            const float sc = am > 0.f ? am * (1.f / 127.f) : 1.f, inv = 1.f / sc;
            if (lane == 0) scale[row0 + rr] = sc;
#pragma unroll
            for (int i = 0; i < 8; ++i) {
                unsigned w = 0u;
#pragma unroll
                for (int j = 0; j < 4; ++j) { const int q = (int)rintf(v[i][j] * inv) + 128; w |= ((unsigned)q & 255u) << (8 * j); }
                *(LAS unsigned*)(lds + rr * QV_STR + i * 256 + lane * 4) = w;
            }
        }
        __syncthreads();
        for (int c = wid; c < 256; c += NWAVES) {
            const u32x2 w = *(const LAS u32x2*)(lds + lane * QV_STR + c * 8);
            *(u32x2*)(dst + (((size_t)layer * 256 + c) * PEXP + e0 + lane) * 8) = w;
        }
    }
}

__device__ __forceinline__ void phase_conv(const Params& p, LAS unsigned char* lds_) {
    float* smem = (float*)(unsigned char*)lds_;
    unsigned char* ws = p.ws;
    const int tid = otid();
    int dummy = 0;
    {
        float* cond = smem;
        float* red = smem + NB * DM;
        for (int i = tid; i < NB * DM; i += NTHREADS) { const float v = p.c[i]; cond[i] = v / (1.f + __expf(-v)); }
        __syncthreads();
        for (int u = blockIdx.x; u < DEPTH * 128; u += gridDim.x) {
            const int l = u >> 7, j0 = (u & 127) * 96;
            const int c4 = tid % 24, kg = tid / 24;
            if (kg < 21) {
                f32x4 acc[NB];
#pragma unroll
                for (int b = 0; b < NB; ++b) acc[b] = (f32x4){0.f, 0.f, 0.f, 0.f};
                const float* wp = p.ada_w + (size_t)l * DM * 6 * DM + j0 + 4 * c4;
#pragma unroll 1
                for (int i0 = 0; i0 < 98; i0 += 7) {
                    f32x4 w[7];
#pragma unroll
                    for (int i = 0; i < 7; ++i) { const int k = kg + 21 * (i0 + i); w[i] = k < DM ? *(const f32x4*)(wp + (size_t)k * 6 * DM) : (f32x4){0.f, 0.f, 0.f, 0.f}; }
#pragma unroll
                    for (int i = 0; i < 7; ++i) { const int k = kg + 21 * (i0 + i); const int kk = k < DM ? k : 0;
#pragma unroll
                        for (int b = 0; b < NB; ++b) acc[b] += w[i] * cond[b * DM + kk]; }
                }
#pragma unroll
                for (int b = 0; b < NB; ++b) *(f32x4*)(red + (kg * NB + b) * 96 + 4 * c4) = acc[b];
            }
            __syncthreads();
            for (int i = tid; i < NB * 96; i += NTHREADS) {
                const int b = i / 96, cc = i % 96;
                float sacc = p.ada_b[(size_t)l * 6 * DM + j0 + cc];
#pragma unroll
                for (int g = 0; g < 21; ++g) sacc += red[(g * NB + b) * 96 + cc];
                ((float*)(ws + WS_MOD))[((size_t)l * NB + b) * 6 * DM + j0 + cc] = sacc;
            }
            __syncthreads();
        }
    }
    {
        float2* r128 = (float2*)(ws + WS_ROPE128); float2* r64 = (float2*)(ws + WS_ROPE64);
        for (int i = blockIdx.x * NTHREADS + tid; i < SEQ * 64; i += gridDim.x * NTHREADS) {
            const int pos = i >> 6, j = i & 63;
            const float inv = powf(10000.f, -(float)j / 64.f); const float ang = (float)pos * inv;
            r128[i] = make_float2((float)cos((double)ang), (float)sin((double)ang));
        }
        for (int i = blockIdx.x * NTHREADS + tid; i < SEQ * 32; i += gridDim.x * NTHREADS) {
            const int pos = i >> 5, j = i & 31;
            const float inv = powf(10000.f, -(float)j / 32.f); const float ang = (float)pos * inv;
            r64[i] = make_float2((float)cos((double)ang), (float)sin((double)ang));
        }
    }
    __syncthreads();
    for (int l = 0; l < DEPTH; ++l) {
        transpose_tiles(p.w_in + (size_t)l * DM * INW, INW, INWP, true, (f16*)(ws + WS_WTIN) + (size_t)l * INWP * DM, smem, dummy, 0);
        transpose_tiles(p.w_out + (size_t)l * DM * DM, DM, DM, false, (f16*)(ws + WS_WTOUT) + (size_t)l * DM * DM, smem, dummy, 0);
        transpose_tiles(p.wq + (size_t)l * DM * DM, DM, DM, false, (f16*)(ws + WS_WTQ) + (size_t)l * DM * DM, smem, dummy, 0);
    }
    quant_rows(p.pu, PEXP, (unsigned*)(ws + WS_U8), (float*)(ws + WS_SU), 0);
    if (LAST_BITS == 4) quant_rows4(p.pu + (size_t)PEXP * DM, PEXP, (unsigned*)(ws + WS_U8 + (size_t)PEXP * DM), (float*)(ws + WS_SU) + PEXP);
    else quant_rows(p.pu + (size_t)PEXP * DM, PEXP, (unsigned*)(ws + WS_U8 + (size_t)PEXP * DM), (float*)(ws + WS_SU) + PEXP, 0);
    quant_v_sliced(p.pv, ws + WS_V8, (float*)(ws + WS_SV), lds_);
    cvt_f16_stream(p.subk, (f16*)(ws + WS_SUBK), (size_t)DEPTH * PH * 2 * PNK * 128);
}

__device__ __forceinline__ void phase_norm(const Params& p, const float* xin, const float* g, const float* shift, const float* scale, f16* hout, unsigned* h8 = nullptr, float* sh8 = nullptr) {
    const int tid_ = otid(); const int wid = tid_ >> 6, lane = tid_ & 63;
    for (int row = blockIdx.x * NWAVES + wid; row < NT; row += gridDim.x * NWAVES) {
        const int b = row / SEQ;
        const float* xr = xin + (size_t)row * DM;
        f32x4 v[8]; float ss = 0.f;
#pragma unroll
        for (int i = 0; i < 8; ++i) { v[i] = *(const f32x4*)(xr + i * 256 + lane * 4); ss += v[i][0] * v[i][0] + v[i][1] * v[i][1] + v[i][2] * v[i][2] + v[i][3] * v[i][3]; }
        ss = wave_sum(ss);
        const float rstd = rsqrtf(ss * (1.f / DM) + EPS);
#pragma unroll
        for (int i = 0; i < 8; ++i) {
            const int col = i * 256 + lane * 4;
            const f32x4 gg = *(const f32x4*)(g + col), sh = *(const f32x4*)(shift + (size_t)b * 6 * DM + col), sc = *(const f32x4*)(scale + (size_t)b * 6 * DM + col);
            f32x4 y = v[i] * rstd * gg * (sc + 1.f) + sh;
            u32x2 w; w.x = pack_h2(y[0], y[1]); w.y = pack_h2(y[2], y[3]);
            *(u32x2*)(hout + (size_t)row * DM + col) = w;
            v[i] = y;
        }
        if (h8) {
            float am = 0.f;
#pragma unroll
            for (int i = 0; i < 8; ++i) am = fmaxf(am, fmaxf(fmaxf(fabsf(v[i][0]), fabsf(v[i][1])), fmaxf(fabsf(v[i][2]), fabsf(v[i][3]))));
            am = wave_max(am);
            const float qs = am > 0.f ? am * (1.f / 127.f) : 1.f, inv = 1.f / qs;
            if (lane == 0) sh8[row] = qs;
#pragma unroll
            for (int i = 0; i < 8; ++i) {
                unsigned w = 0u;
#pragma unroll
                for (int j = 0; j < 4; ++j) { const int q = (int)rintf(v[i][j] * inv); w |= ((unsigned)q & 255u) << (8 * j); }
                h8[(size_t)row * (DM / 4) + i * 64 + lane] = w;
            }
        }
    }
}

template <int MODE, bool XH>
__device__ __forceinline__ void phase_norm2(const float* xin, const f16* xinh, float* fout, const float* g, const float* shift, const float* scale, f16* hout, unsigned* h8, float* sh8) {
    const int tid_ = otid(); const int wid = tid_ >> 6, lane = tid_ & 63;
    for (int r0 = (blockIdx.x * NWAVES + wid) * 8; r0 < NT; r0 += gridDim.x * NWAVES * 8) {
        const int b = r0 / SEQ;
        f32x4 gm[8], sh[8];
#pragma unroll
        for (int i = 0; i < 8; ++i) {
            const int col = i * 256 + lane * 4;
            gm[i] = *(const f32x4*)(g + col);
            if (MODE != 2) { gm[i] = gm[i] * (*(const f32x4*)(scale + (size_t)b * 6 * DM + col) + 1.f); sh[i] = *(const f32x4*)(shift + (size_t)b * 6 * DM + col); }
        }
        f32x4 v[8], nv[8]; u32x2 nh[8];
#define NR_LOAD(row_) do { _Pragma("unroll") for (int i = 0; i < 8; ++i) { if (XH) nh[i] = *(const u32x2*)(xinh + (size_t)(row_) * DM + i * 256 + lane * 4); else nv[i] = *(const f32x4*)(xin + (size_t)(row_) * DM + i * 256 + lane * 4); } } while (0)
        NR_LOAD(r0);
#pragma unroll 1
        for (int k = 0; k < 8; ++k) {
            const int row = r0 + k;
#pragma unroll
            for (int i = 0; i < 8; ++i) { if (XH) { v[i][0] = h_lo(nh[i].x); v[i][1] = h_hi(nh[i].x); v[i][2] = h_lo(nh[i].y); v[i][3] = h_hi(nh[i].y); } else v[i] = nv[i]; }
            if (k < 7) NR_LOAD(row + 1);
            float ss = 0.f;
#pragma unroll
            for (int i = 0; i < 8; ++i) ss += v[i][0] * v[i][0] + v[i][1] * v[i][1] + v[i][2] * v[i][2] + v[i][3] * v[i][3];
            ss = wave_sum(ss);
            const float rstd = rsqrtf(ss * (1.f / DM) + EPS);
            float am = 0.f;
#pragma unroll
            for (int i = 0; i < 8; ++i) {
                const int col = i * 256 + lane * 4;
                if (MODE == 2) { *(f32x4*)(fout + (size_t)row * DM + col) = v[i] * rstd * gm[i]; }
                else {
                    const f32x4 y = v[i] * rstd * gm[i] + sh[i];
                    u32x2 w; w.x = pack_h2(y[0], y[1]); w.y = pack_h2(y[2], y[3]);
                    *(u32x2*)(hout + (size_t)row * DM + col) = w;
                    if (MODE == 1) { v[i] = y; am = fmaxf(am, fmaxf(fmaxf(fabsf(y[0]), fabsf(y[1])), fmaxf(fabsf(y[2]), fabsf(y[3])))); }
                }
            }
            if (MODE == 1) {
                am = wave_max(am);
                const float qs = am > 0.f ? am * (1.f / 127.f) : 1.f, inv = 1.f / qs;
                if (lane == 0) sh8[row] = qs;
                int qsum = 0;
#pragma unroll
                for (int i = 0; i < 8; ++i) {
                    unsigned w = 0u;
#pragma unroll
                    for (int j = 0; j < 4; ++j) { const int q = (int)rintf(v[i][j] * inv); qsum += q; w |= ((unsigned)q & 255u) << (8 * j); }
                    h8[(size_t)row * (DM / 4) + i * 64 + lane] = w;
                }
#pragma unroll
                for (int o = 32; o >= 1; o >>= 1) qsum += __shfl_xor(qsum, o);
                if (lane == 0) ((int*)(sh8 + NT))[row] = qsum;
            }
        }
#undef NR_LOAD
    }
}

__device__ __forceinline__ void phase_rope(const Params& p) {
    f16* proj = (f16*)(p.ws + WS_PROJ);
    const float2* r128 = (const float2*)(p.ws + WS_ROPE128); const float2* r64 = (const float2*)(p.ws + WS_ROPE64);
    constexpr int PER_TOK = (1088 + 544) / 2;
    const size_t total = (size_t)NT * PER_TOK;
    for (size_t i = (size_t)blockIdx.x * NTHREADS + otid(); i < total; i += (size_t)gridDim.x * NTHREADS) {
        const int t = (int)(i / PER_TOK); int r = (int)(i % PER_TOK) * 2;
        const int pos = t % SEQ;
        int base, half, j;
        if (r < 1088) {
            const int hh = r >> 6; j = r & 63; half = 64;
            base = hh < 6 ? C_QA + hh * 128 : (hh == 6 ? C_KA : (hh < 12 ? C_QC + (hh - 7) * 128 : C_KC + (hh - 12) * 128));
        } else {
            r -= 1088; const int hh = r >> 5; j = r & 31; half = 32;
            base = hh < 16 ? C_IQ + hh * 64 : C_IK;
        }
        f16* pp = proj + (size_t)t * INWP + base + j;
        const h2_t a = *(const h2_t*)pp, bq = *(const h2_t*)(pp + half);
        float2 cs0, cs1;
        if (half == 64) { cs0 = r128[pos * 64 + j]; cs1 = r128[pos * 64 + j + 1]; } else { cs0 = r64[pos * 32 + j]; cs1 = r64[pos * 32 + j + 1]; }
        const float a0 = (float)a.x, a1 = (float)a.y, b0 = (float)bq.x, b1 = (float)bq.y;
        h2_t oa, ob;
        oa.x = (f16)(a0 * cs0.x - b0 * cs0.y); oa.y = (f16)(a1 * cs1.x - b1 * cs1.y);
        ob.x = (f16)(b0 * cs0.x + a0 * cs0.y); ob.y = (f16)(b1 * cs1.x + a1 * cs1.y);
        *(h2_t*)pp = oa; *(h2_t*)(pp + half) = ob;
    }
}

__device__ __forceinline__ void phase_index(const Params& p, LAS unsigned char* lds_) {
    const f16* proj = (const f16*)(p.ws + WS_PROJ);
    float* smem = (float*)(unsigned char*)lds_;
    const int tid = otid(), wid = tid >> 6, lane = tid & 63;
    {
        float* red = smem;
        float* km = (float*)(p.ws + WS_KMEAN);
        for (int u = blockIdx.x; u < NB * HC * MOBA_NB; u += gridDim.x) {
            const int blk = u % MOBA_NB, h = (u / MOBA_NB) % HC, b = u / (MOBA_NB * HC);
            const int d = tid & 127, part = tid >> 7;
            float s = 0.f;
            const f16* kp = proj + ((size_t)b * SEQ + blk * MOBA_BLK + part * 64) * INWP + C_KC + h * HD + d;
#pragma unroll
            for (int k0 = 0; k0 < 64; k0 += 16) {
                f16 kv[16];
#pragma unroll
                for (int k = 0; k < 16; ++k) kv[k] = kp[(size_t)(k0 + k) * INWP];
#pragma unroll
                for (int k = 0; k < 16; ++k) s += (float)kv[k];
            }
            __syncthreads();
            red[part * 128 + d] = s;
            __syncthreads();
            if (tid < 128) km[(size_t)u * HD + tid] = (red[tid] + red[128 + tid] + red[256 + tid] + red[384 + tid]) * (1.f / MOBA_BLK);
        }
        __syncthreads();
    }
    float* wq_ = smem + wid * (IH * IDM + IH);
    float* sc = smem + NWAVES * (IH * IDM + IH) + wid * SEQ;
    unsigned* mask = (unsigned*)(p.ws + WS_MASK);
    for (int q = blockIdx.x * NWAVES + wid; q < NT; q += gridDim.x * NWAVES) {
        const int b = q / SEQ, t = q % SEQ;
        const f16* row = proj + (size_t)q * INWP;
        for (int i = lane; i < IH * IDM; i += 64) wq_[i] = (float)row[C_IQ + i];
        if (lane < IH) wq_[IH * IDM + lane] = (float)row[C_IW + lane] * 0.25f;
        __builtin_amdgcn_wave_barrier();
        const int nk = t + 1;
        for (int s = lane; s < nk; s += 64) {
            const f16* kr = proj + ((size_t)b * SEQ + s) * INWP + C_IK;
            float kf[IDM];
#pragma unroll
            for (int e8 = 0; e8 < IDM / 8; ++e8) { const h8_t kv = *(const h8_t*)(kr + e8 * 8);
#pragma unroll
                for (int j = 0; j < 8; ++j) kf[e8 * 8 + j] = (float)kv[j]; }
            float score = 0.f;
            for (int h = 0; h < IH; ++h) {
                float d = 0.f;
#pragma unroll
                for (int e = 0; e < IDM; ++e) d += wq_[h * IDM + e] * kf[e];
                score += wq_[IH * IDM + h] * fmaxf(d * 0.125f, 0.f);
            }
            sc[s] = score;
        }
        __builtin_amdgcn_wave_barrier();
        unsigned key[32];
#pragma unroll
        for (int i = 0; i < 32; ++i) {
            const int s = lane + 64 * i;
            unsigned u = 0u;
            if (s < nk) { const unsigned bits = __float_as_uint(sc[s]); u = (bits & 0x80000000u) ? ~bits : (bits | 0x80000000u); if (u == 0u) u = 1u; }
            key[i] = u;
        }
        unsigned thr = 1u;
        if (nk > DSA_TOPK) {
            thr = 0u;
            for (int bit = 31; bit >= 0; --bit) {
                const unsigned cand = thr | (1u << bit);
                int cnt = 0;
#pragma unroll
                for (int i = 0; i < 32; ++i) cnt += __builtin_popcountll(__ballot(key[i] >= cand));
                if (cnt >= DSA_TOPK) thr = cand;
            }
        }
        unsigned* mrow = mask + (size_t)q * 64;
#pragma unroll
        for (int i = 0; i < 32; ++i) {
            const unsigned long long bal = __ballot(key[i] >= thr && key[i] != 0u);
            if (lane == 0) { mrow[2 * i] = (unsigned)bal; mrow[2 * i + 1] = (unsigned)(bal >> 32); }
        }
        __builtin_amdgcn_wave_barrier();
    }
}

constexpr int IX_ROW = SEQ + 4;
__device__ __forceinline__ void index_item(const Params& p, LAS unsigned char* lds, int b, int qg) {
    const f16* proj = (const f16*)(p.ws + WS_PROJ);
    LAS float* sc = (LAS float*)lds;
    const int tid = otid(), wid = __builtin_amdgcn_readfirstlane(tid >> 6), lane = tid & 63, fr = lane & 15, fq = lane >> 4;
    const int t0 = qg * 16, nkt = qg + 1;
    h8_t Bq[IH][2]; float wq[IH];
    {
        const f16* qrow = proj + ((size_t)b * SEQ + t0 + fr) * INWP;
#pragma unroll
        for (int h = 0; h < IH; ++h) {
            Bq[h][0] = *(const h8_t*)(qrow + C_IQ + h * IDM + 8 * fq);
            Bq[h][1] = *(const h8_t*)(qrow + C_IQ + h * IDM + 32 + 8 * fq);
        }
        const h8_t w0 = *(const h8_t*)(qrow + C_IW), w1 = *(const h8_t*)(qrow + C_IW + 8);
#pragma unroll
        for (int h = 0; h < 8; ++h) { wq[h] = (float)w0[h] * (0.25f * 0.125f); wq[8 + h] = (float)w1[h] * (0.25f * 0.125f); }
    }
    __syncthreads();
    const f16* kbase = proj + ((size_t)b * SEQ + fr) * INWP + C_IK + 8 * fq;
    h8_t a0, a1, n0, n1;
#define IX_LOAD(A0_, A1_, kt_) do { const int c_ = (kt_) < nkt ? (kt_) : 0; A0_ = *(const h8_t*)(kbase + (size_t)c_ * 16 * INWP); A1_ = *(const h8_t*)(kbase + (size_t)c_ * 16 * INWP + 32); } while (0)
#define IX_TILE(A0_, A1_, kt_) do { f32x4 acc = {0.f, 0.f, 0.f, 0.f}; \
        _Pragma("unroll") for (int h = 0; h < IH; ++h) { \
            f32x4 c = {0.f, 0.f, 0.f, 0.f}; \
            c = __builtin_amdgcn_mfma_f32_16x16x32_f16(A0_, Bq[h][0], c, 0, 0, 0); \
            c = __builtin_amdgcn_mfma_f32_16x16x32_f16(A1_, Bq[h][1], c, 0, 0, 0); \
            _Pragma("unroll") for (int j = 0; j < 4; ++j) { const int ci = __float_as_int(c[j]); acc[j] += wq[h] * __int_as_float(ci > 0 ? ci : 0); } } \
        *(LAS f32x4*)(sc + fr * IX_ROW + (kt_) * 16 + 4 * fq) = acc; } while (0)
    int kt = wid;
    IX_LOAD(a0, a1, kt);
    for (; kt < nkt; kt += 2 * NWAVES) {
        IX_LOAD(n0, n1, kt + NWAVES); __builtin_amdgcn_sched_barrier(0);
        IX_TILE(a0, a1, kt); __builtin_amdgcn_sched_barrier(0);
        IX_LOAD(a0, a1, kt + 2 * NWAVES); __builtin_amdgcn_sched_barrier(0);
        if (kt + NWAVES < nkt) IX_TILE(n0, n1, kt + NWAVES);
        __builtin_amdgcn_sched_barrier(0);
    }
#undef IX_LOAD
#undef IX_TILE
    __syncthreads();
    unsigned* mask = (unsigned*)(p.ws + WS_MASK);
#pragma unroll 1
    for (int qq = 0; qq < 2; ++qq) {
        const int ql = 2 * wid + qq, t = t0 + ql, nk = t + 1;
        unsigned key[32];
#pragma unroll
        for (int i = 0; i < 32; ++i) {
            const int s = lane + 64 * i;
            unsigned u = 0u;
            if (s < nk) { const unsigned bits = __float_as_uint(sc[ql * IX_ROW + s]); u = (bits & 0x80000000u) ? ~bits : (bits | 0x80000000u); if (u == 0u) u = 1u; }
            key[i] = u;
        }
        unsigned thr = 1u;
        if (nk > DSA_TOPK) {
            thr = 0u;
            const int nreg8 = (nk + 511) >> 9;
            for (int bit = 31; bit >= 0; --bit) {
                const unsigned cand = thr | (1u << bit);
                int cnt = 0;
#pragma unroll
                for (int i8 = 0; i8 < 4; ++i8) {
                    if (i8 < nreg8) {
#pragma unroll
                        for (int i = 0; i < 8; ++i) cnt += __builtin_popcountll(__ballot(key[8 * i8 + i] >= cand));
                    }
                }
                if (cnt >= DSA_TOPK) { thr = cand; if (cnt == DSA_TOPK) break; }
            }
        }
        unsigned* mrow = mask + ((size_t)b * SEQ + t) * 64;
        unsigned myw = 0u;
#pragma unroll
        for (int i = 0; i < 32; ++i) {
            const unsigned long long bal = __ballot(key[i] >= thr && key[i] != 0u);
            if (lane == 2 * i) myw = (unsigned)bal;
            if (lane == 2 * i + 1) myw = (unsigned)(bal >> 32);
        }
        mrow[lane] = myw;
    }
}

__device__ __forceinline__ void phase_index2(const Params& p, LAS unsigned char* lds_) {
    const f16* proj = (const f16*)(p.ws + WS_PROJ);
    float* smem = (float*)(unsigned char*)lds_;
    const int tid = otid();
    {
        float* red = smem;
        float* km = (float*)(p.ws + WS_KMEAN);
        for (int u = obid(); u < NB * HC * MOBA_NB; u += gridDim.x) {
            const int blk = u % MOBA_NB, h = (u / MOBA_NB) % HC, b = u / (MOBA_NB * HC);
            const int d = tid & 127, part = tid >> 7;
            float s = 0.f;
            const f16* kp = proj + ((size_t)b * SEQ + blk * MOBA_BLK + part * 64) * INWP + C_KC + h * HD + d;
#pragma unroll
            for (int k0 = 0; k0 < 64; k0 += 16) {
                f16 kv[16];
#pragma unroll
                for (int k = 0; k < 16; ++k) kv[k] = kp[(size_t)(k0 + k) * INWP];
#pragma unroll
                for (int k = 0; k < 16; ++k) s += (float)kv[k];
            }
            __syncthreads();
            red[part * 128 + d] = s;
            __syncthreads();
            if (tid < 128) km[(size_t)u * HD + tid] = (red[tid] + red[128 + tid] + red[256 + tid] + red[384 + tid]) * (1.f / MOBA_BLK);
        }
        __syncthreads();
    }
    for (int pi = obid(); pi < NB * 64; pi += gridDim.x) {
        const int b = pi >> 6, a = pi & 63;
        index_item(p, lds_, b, 127 - a);
        index_item(p, lds_, b, a);
    }
}

__device__ __forceinline__ void phase_attn(const Params& p, LAS unsigned char* lds_, const float* ong) {
    const f16* proj = (const f16*)(p.ws + WS_PROJ);
    float* smem = (float*)(unsigned char*)lds_;
    const int tid = otid(), wid = tid >> 6, lane = tid & 63;
    float* pbuf = smem + wid * SEQ;
    const float* km = (const float*)(p.ws + WS_KMEAN);
    const unsigned* mask = (const unsigned*)(p.ws + WS_MASK);
    f16* y = (f16*)(p.ws + WS_Y);
    const float scale = 0.08838834764831845f;
    const size_t nitems = (size_t)NT * NHEADS;
    for (size_t it = (size_t)blockIdx.x * NWAVES + wid; it < nitems; it += (size_t)gridDim.x * NWAVES) {
        const int hh = (int)(it % NHEADS); const int q = (int)(it / NHEADS);
        const int b = q / SEQ, t = q % SEQ;
        int qc, kc, vc, var;
        if (hh < HA) { var = 0; qc = C_QA + hh * HD; kc = C_KA; vc = C_VA; }
        else if (hh < HA + HB) { var = 1; qc = C_QB + (hh - HA) * HD; kc = C_KB + (hh - HA) * HD; vc = C_VB + (hh - HA) * HD; }
        else { var = 2; qc = C_QC + (hh - HA - HB) * HD; kc = C_KC + (hh - HA - HB) * HD; vc = C_VC + (hh - HA - HB) * HD; }
        unsigned qv[64];
        { const u32x4* qp = (const u32x4*)(proj + (size_t)q * INWP + qc);
#pragma unroll
          for (int i = 0; i < 16; ++i) { const u32x4 w = qp[i]; qv[4 * i] = w.x; qv[4 * i + 1] = w.y; qv[4 * i + 2] = w.z; qv[4 * i + 3] = w.w; } }
        unsigned allowed = 0xffu;
        const int own = t / MOBA_BLK;
        if (var == 2) {
            float g = -INFINITY;
            if (lane < own) {
                const float* kmp = km + (((size_t)b * HC + (hh - HA - HB)) * MOBA_NB + lane) * HD;
                float s = 0.f;
#pragma unroll
                for (int i = 0; i < 64; ++i) s += h_lo(qv[i]) * kmp[2 * i] + h_hi(qv[i]) * kmp[2 * i + 1];
                g = s;
            }
            float gs[MOBA_NB];
#pragma unroll
            for (int j = 0; j < MOBA_NB; ++j) gs[j] = __shfl(g, j);
            allowed = 1u << own;
#pragma unroll
            for (int j = 0; j < MOBA_NB; ++j) {
                if (j < own) {
                    int rank = 0;
#pragma unroll
                    for (int k2 = 0; k2 < MOBA_NB; ++k2) if (k2 < own && (gs[k2] > gs[j] || (gs[k2] == gs[j] && k2 < j))) ++rank;
                    if (rank < 3) allowed |= 1u << j;
                }
            }
        }
        const int nk = t + 1;
        const int nkl = (nk + 63) >> 6;
        const unsigned* mrow = mask + (size_t)q * 64;
        float z[32];
#pragma unroll
        for (int i = 0; i < 32; ++i) {
            z[i] = -INFINITY;
            if (i < nkl) {
                const int s = nkl * lane + i;
                if (s < nk) {
                    bool ok = true;
                    if (var == 0) ok = (mrow[s >> 5] >> (s & 31)) & 1u;
                    if (var == 2) ok = (allowed >> (s / MOBA_BLK)) & 1u;
                    if (var == 1) ok = s < t;
                    if (ok) {
                        const u32x4* kp = (const u32x4*)(proj + ((size_t)b * SEQ + s) * INWP + kc);
                        float d = 0.f;
#pragma unroll
                        for (int c4 = 0; c4 < 16; ++c4) { const u32x4 w = kp[c4]; d = dot2(qv[4 * c4], w.x, d); d = dot2(qv[4 * c4 + 1], w.y, d); d = dot2(qv[4 * c4 + 2], w.z, d); d = dot2(qv[4 * c4 + 3], w.w, d); }
                        z[i] = d * scale;
                    }
                }
            }
        }
        float inv_l = 1.f;
        if (var != 1) {
            float m = -INFINITY;
#pragma unroll
            for (int i = 0; i < 32; ++i) m = fmaxf(m, z[i]);
            m = wave_max(m);
            float l = 0.f;
#pragma unroll
            for (int i = 0; i < 32; ++i) { const float e = (z[i] == -INFINITY) ? 0.f : __expf(z[i] - m); z[i] = e; l += e; }
            l = wave_sum(l);
            inv_l = 1.f / l;
        } else {
            float lk[32]; float tot = 0.f;
#pragma unroll
            for (int i = 31; i >= 0; --i) {
                float v = 0.f;
                if (z[i] != -INFINITY) { const float zz = z[i]; v = -(fmaxf(zz, 0.f) + log1pf(__expf(-fabsf(zz)))); }
                tot += v; lk[i] = tot;
            }
            float incl = tot;
#pragma unroll
            for (int o = 1; o < 64; o <<= 1) { const float v = __shfl_down(incl, o); if (lane + o < 64) incl += v; }
            const float excl = incl - tot;
#pragma unroll
            for (int i = 0; i < 32; ++i) z[i] = (z[i] == -INFINITY) ? 0.f : __expf(z[i] + lk[i] + excl);
        }
#pragma unroll
        for (int i = 0; i < 32; ++i) if (i < nkl) { const int s = nkl * lane + i; if (s < SEQ) pbuf[s] = z[i]; }
        __builtin_amdgcn_wave_barrier();
        float o0 = 0.f, o1 = 0.f;
        const f16* vp = proj + (size_t)b * SEQ * INWP + vc + 2 * lane;
        for (int s0 = 0; s0 < nk; s0 += 8) {
            float pr[8]; bool any = false;
#pragma unroll
            for (int j = 0; j < 8; ++j) { pr[j] = pbuf[s0 + j]; any = any || (pr[j] != 0.f); }
            if (any) {
                unsigned w[8];
#pragma unroll
                for (int j = 0; j < 8; ++j) w[j] = *(const unsigned*)(vp + (size_t)(s0 + j) * INWP);
#pragma unroll
                for (int j = 0; j < 8; ++j) { o0 += pr[j] * h_lo(w[j]); o1 += pr[j] * h_hi(w[j]); }
            }
        }
        o0 *= inv_l; o1 *= inv_l;
        const float ss = wave_sum(o0 * o0 + o1 * o1);
        const float rstd = rsqrtf(ss * (1.f / HD) + EPS);
        const float g0 = ong[hh * HD + 2 * lane], g1 = ong[hh * HD + 2 * lane + 1];
        *(unsigned*)(y + (size_t)q * DM + hh * HD + 2 * lane) = pack_h2(o0 * rstd * g0, o1 * rstd * g1);
        __builtin_amdgcn_wave_barrier();
    }
}

typedef short s4_t __attribute__((ext_vector_type(4)));
typedef float f32x16 __attribute__((ext_vector_type(16)));
constexpr int AT_KSTR = 272, AT_VSTR = 320, AT_KBYTES = 64 * AT_KSTR, AT_VBYTES = 64 * AT_VSTR, AT_STAGE = AT_KBYTES + AT_VBYTES;
__device__ __forceinline__ float fexp2(float x) { return __builtin_amdgcn_exp2f(x); }
__device__ __forceinline__ float flog2(float x) { return __builtin_amdgcn_logf(x); }

template <int VAR>
__device__ __forceinline__ void attn_item(const Params& p, LAS unsigned char* lds, const float* ong, int b, int hh, int qt, int qc, int kc, int vc) {
    const f16* proj = (const f16*)(p.ws + WS_PROJ);
    const int tid = otid(), wid = __builtin_amdgcn_readfirstlane(tid >> 6), lane = tid & 63, qn = lane & 31, hf = lane >> 5;
    const int q0 = qt * 256, qrow = q0 + 32 * wid + qn;
    const size_t grow = (size_t)b * SEQ + qrow;
    h8_t Qf[8];
    {
        const float sc = 0.08838834764831845f * 1.4426950408889634f;
        const f16* qp = proj + grow * INWP + qc + 8 * hf;
#pragma unroll
        for (int ks = 0; ks < 8; ++ks) {
            const h8_t v = *(const h8_t*)(qp + 16 * ks);
            h8_t w;
#pragma unroll
            for (int j = 0; j < 8; ++j) w[j] = (f16)((float)v[j] * sc);
            Qf[ks] = w;
        }
    }
    unsigned allowed = 0xffu;
    if (VAR == 2) {
        const int own = qt;
        const float* km = (const float*)(p.ws + WS_KMEAN) + ((size_t)b * HC + (hh - HA - HB)) * MOBA_NB * HD + 8 * hf;
        float gs[MOBA_NB];
#pragma unroll
        for (int j = 0; j < MOBA_NB; ++j) gs[j] = -INFINITY;
#pragma unroll
        for (int j = 0; j < MOBA_NB - 1; ++j) {
            if (j < own) {
                float s = 0.f;
#pragma unroll
                for (int ks = 0; ks < 8; ++ks) {
                    const f32x4 k0 = *(const f32x4*)(km + j * HD + 16 * ks), k1 = *(const f32x4*)(km + j * HD + 16 * ks + 4);
                    s += (float)Qf[ks][0] * k0[0] + (float)Qf[ks][1] * k0[1] + (float)Qf[ks][2] * k0[2] + (float)Qf[ks][3] * k0[3]
                       + (float)Qf[ks][4] * k1[0] + (float)Qf[ks][5] * k1[1] + (float)Qf[ks][6] * k1[2] + (float)Qf[ks][7] * k1[3];
                }
                gs[j] = s + __shfl_xor(s, 32);
            }
        }
        allowed = 1u << own;
#pragma unroll
        for (int j = 0; j < MOBA_NB - 1; ++j) {
            if (j < own) {
                int rank = 0;
#pragma unroll
                for (int k2 = 0; k2 < MOBA_NB - 1; ++k2) if (k2 < own && (gs[k2] > gs[j] || (gs[k2] == gs[j] && k2 < j))) ++rank;
                if (rank < 3) allowed |= 1u << j;
            }
        }
    }
    f32x16 O[4];
#pragma unroll
    for (int dt = 0; dt < 4; ++dt)
#pragma unroll
        for (int r = 0; r < 16; ++r) O[dt][r] = 0.f;
    float m_run = -INFINITY, l_run = 0.f, carry = 0.f;
    const int nst = (qt + 1) * 4;
    const int st_hi_w = qt * 4 + (wid >> 1);
    const int sr0 = tid >> 4, sc0 = tid & 15;
    const f16* kg = proj + ((size_t)b * SEQ + sr0) * INWP + kc + 8 * sc0;
    const f16* vg = proj + ((size_t)b * SEQ + sr0) * INWP + vc + 8 * sc0;
    const unsigned kw = sr0 * AT_KSTR + 16 * sc0, vw = AT_KBYTES + sr0 * AT_VSTR + 16 * sc0;
    const unsigned* mrow = (const unsigned*)(p.ws + WS_MASK) + grow * 64;
    const unsigned ka = qn * AT_KSTR + 16 * hf;
    const unsigned va = AT_KBYTES + (4 * hf + ((lane & 15) >> 2)) * AT_VSTR + (16 * ((lane >> 4) & 1) + 4 * (lane & 3)) * 2;
    u32x4 rk0, rk1, rv0, rv1; u32x2 mw = {0u, 0u}, mwn = {0u, 0u};
#define AT_LOAD(st_) do { const size_t o_ = (size_t)(st_) * 64 * INWP; rk0 = *(const u32x4*)(kg + o_); rk1 = *(const u32x4*)(kg + o_ + (size_t)32 * INWP); \
        rv0 = *(const u32x4*)(vg + o_); rv1 = *(const u32x4*)(vg + o_ + (size_t)32 * INWP); if (VAR == 0) mwn = *(const u32x2*)(mrow + 2 * (st_)); } while (0)
#define AT_WRITE(buf_) do { LAS unsigned char* b_ = lds + (buf_) * AT_STAGE; *(LAS u32x4*)(b_ + kw) = rk0; *(LAS u32x4*)(b_ + kw + 32 * AT_KSTR) = rk1; \
        *(LAS u32x4*)(b_ + vw) = rv0; *(LAS u32x4*)(b_ + vw + 32 * AT_VSTR) = rv1; } while (0)
    __syncthreads();
    AT_LOAD(nst - 1); AT_WRITE(0); mw = mwn;
    __syncthreads();
    int cur = 0;
    bool wdone = false;
    for (int st = nst - 1; st >= 0; --st) {
        if (st > 0) AT_LOAD(st - 1);
        if (st <= st_hi_w && !wdone) {
            LAS unsigned char* kb = lds + cur * AT_STAGE;
            f32x16 S[2];
#pragma unroll
            for (int r = 0; r < 16; ++r) { S[0][r] = 0.f; S[1][r] = 0.f; }
#pragma unroll
            for (int ks = 0; ks < 8; ++ks) {
                const h8_t a0 = *(const LAS h8_t*)(kb + ka + 32 * ks), a1 = *(const LAS h8_t*)(kb + ka + 32 * ks + 32 * AT_KSTR);
                S[0] = __builtin_amdgcn_mfma_f32_32x32x16_f16(a0, Qf[ks], S[0], 0, 0, 0);
                S[1] = __builtin_amdgcn_mfma_f32_32x32x16_f16(a1, Qf[ks], S[1], 0, 0, 0);
            }
            const bool diag = (64 * st + 63 > q0 + 32 * wid);
            const int kbase = 64 * st + 4 * hf;
            if (VAR != 1) {
                const bool blk_ok = (VAR == 2) ? ((allowed >> (st >> 2)) & 1u) : true;
                float mx = -INFINITY;
#pragma unroll
                for (int sub = 0; sub < 2; ++sub)
#pragma unroll
                    for (int r = 0; r < 16; ++r) {
                        const int kl = (r & 3) + 8 * (r >> 2);
                        bool ok;
                        if (VAR == 0) ok = ((sub == 0 ? mw.x : mw.y) >> (kl + 4 * hf)) & 1u;
                        else ok = blk_ok && (!diag || (kbase + 32 * sub + kl <= qrow));
                        const float v = ok ? S[sub][r] : -INFINITY;
                        S[sub][r] = v; mx = fmaxf(mx, v);
                    }
                mx = fmaxf(mx, __shfl_xor(mx, 32));
                const float m_new = fmaxf(m_run, mx);
                const float m_use = (m_new == -INFINITY) ? 0.f : m_new;
                const float alpha = fexp2(m_run - m_use);
                float ps = 0.f;
#pragma unroll
                for (int sub = 0; sub < 2; ++sub)
#pragma unroll
                    for (int r = 0; r < 16; ++r) { const float e = fexp2(S[sub][r] - m_use); S[sub][r] = e; ps += e; }
                l_run = l_run * alpha + ps;
                m_run = m_new;
                if (__ballot(alpha != 1.f) != 0ull) {
#pragma unroll
                    for (int dt = 0; dt < 4; ++dt)
#pragma unroll
                        for (int r = 0; r < 16; ++r) O[dt][r] *= alpha;
                }
            } else {
#pragma unroll
                for (int sub = 1; sub >= 0; --sub) {
                    float lk[16];
#pragma unroll
                    for (int r = 0; r < 16; ++r) {
                        const int kl = (r & 3) + 8 * (r >> 2);
                        const bool ok = !diag || (kbase + 32 * sub + kl < qrow);
                        const float zl = S[sub][r];
                        const float sp = fmaxf(zl, 0.f) + flog2(1.f + fexp2(-fabsf(zl)));
                        lk[r] = ok ? -sp : 0.f;
                        S[sub][r] = ok ? zl : -INFINITY;
                    }
                    float gsum[4], pg[4], T[4];
#pragma unroll
                    for (int g = 0; g < 4; ++g) { gsum[g] = (lk[4 * g] + lk[4 * g + 1]) + (lk[4 * g + 2] + lk[4 * g + 3]); pg[g] = __shfl_xor(gsum[g], 32); T[g] = gsum[g] + pg[g]; }
                    float after[4];
                    after[3] = 0.f; after[2] = T[3]; after[1] = T[3] + T[2]; after[0] = T[3] + T[2] + T[1];
#pragma unroll
                    for (int g = 0; g < 4; ++g) {
                        const float base = carry + after[g] + (hf == 0 ? pg[g] : 0.f);
                        const float c3 = lk[4 * g + 3], c2 = lk[4 * g + 2] + c3, c1 = lk[4 * g + 1] + c2, c0 = lk[4 * g] + c1;
                        S[sub][4 * g + 3] = fexp2(S[sub][4 * g + 3] + base + c3);
                        S[sub][4 * g + 2] = fexp2(S[sub][4 * g + 2] + base + c2);
                        S[sub][4 * g + 1] = fexp2(S[sub][4 * g + 1] + base + c1);
                        S[sub][4 * g + 0] = fexp2(S[sub][4 * g + 0] + base + c0);
                    }
                    carry += (T[0] + T[1]) + (T[2] + T[3]);
                }
            }
#pragma unroll
            for (int sub = 0; sub < 2; ++sub)
#pragma unroll
                for (int s2 = 0; s2 < 2; ++s2) {
                    h8_t pb;
#pragma unroll
                    for (int j = 0; j < 8; ++j) pb[j] = (f16)S[sub][8 * s2 + j];
#pragma unroll
                    for (int dt = 0; dt < 4; ++dt) {
                        const LAS unsigned char* ap = kb + va + (32 * sub + 16 * s2) * AT_VSTR + 64 * dt;
                        const s4_t t0 = __builtin_amdgcn_ds_read_tr16_b64_v4i16((LAS s4_t*)ap);
                        const s4_t t1 = __builtin_amdgcn_ds_read_tr16_b64_v4i16((LAS s4_t*)(ap + 8 * AT_VSTR));
                        typedef short s8_t __attribute__((ext_vector_type(8)));
                        const s8_t a8 = __builtin_shufflevector(t0, t1, 0, 1, 2, 3, 4, 5, 6, 7);
                        O[dt] = __builtin_amdgcn_mfma_f32_32x32x16_f16(__builtin_bit_cast(h8_t, a8), pb, O[dt], 0, 0, 0);
                    }
                }
        }
        if (VAR == 1) {
            if (st <= st_hi_w && !wdone) wdone = (__ballot(carry < -100.f) == ~0ull);
            if (lane == 0) *(LAS unsigned*)(lds + 2 * AT_STAGE + 32 * (st & 1) + 4 * wid) = wdone ? 1u : 0u;
        }
        if (st > 0) { AT_WRITE(cur ^ 1); }
        mw = mwn;
        __syncthreads();
        cur ^= 1;
        if (VAR == 1) {
            unsigned alld = 1u;
#pragma unroll
            for (int w = 0; w < NWAVES; ++w) alld &= *(const LAS unsigned*)(lds + 2 * AT_STAGE + 32 * (st & 1) + 4 * w);
            if (alld) break;
        }
    }
#undef AT_LOAD
#undef AT_WRITE
    float inv = 1.f;
    if (VAR != 1) { const float lt = l_run + __shfl_xor(l_run, 32); inv = 1.f / lt; }
    float ss = 0.f;
#pragma unroll
    for (int dt = 0; dt < 4; ++dt)
#pragma unroll
        for (int r = 0; r < 16; ++r) { const float v = O[dt][r] * inv; O[dt][r] = v; ss += v * v; }
    ss += __shfl_xor(ss, 32);
    const float rstd = rsqrtf(ss * (1.f / HD) + EPS);
    f16* yp = (f16*)(p.ws + WS_Y) + grow * DM + hh * HD + 4 * hf;
    const float* gp = ong + hh * HD + 4 * hf;
#pragma unroll
    for (int dt = 0; dt < 4; ++dt)
#pragma unroll
        for (int g = 0; g < 4; ++g) {
            const f32x4 gg = *(const f32x4*)(gp + 32 * dt + 8 * g);
            u32x2 w; w.x = pack_h2(O[dt][4 * g] * rstd * gg[0], O[dt][4 * g + 1] * rstd * gg[1]); w.y = pack_h2(O[dt][4 * g + 2] * rstd * gg[2], O[dt][4 * g + 3] * rstd * gg[3]);
            *(u32x2*)(yp + 32 * dt + 8 * g) = w;
        }
}

__device__ __forceinline__ void phase_attn2(const Params& p, LAS unsigned char* lds, const float* ong, unsigned* queue) {
    for (;;) {
        __syncthreads();
        if (threadIdx.x == 0) *(LAS unsigned*)(lds + 2 * AT_STAGE + 96) = __hip_atomic_fetch_add(queue, 1u, __ATOMIC_RELAXED, __HIP_MEMORY_SCOPE_AGENT);
        __syncthreads();
        const int idx = (int)*(const LAS unsigned*)(lds + 2 * AT_STAGE + 96);
        if (idx >= NB * NHEADS * 8) break;
        int qt, b, hh;
        if (idx < 704) { qt = 7 - idx / 88; const int r = idx % 88; b = r / 11; const int h11 = r % 11; hh = h11 < HA ? h11 : h11 + HB; }
        else { const int r = idx - 704; qt = 7 - r / 40; b = (r % 40) / 5; hh = HA + (r % 5); }
        if (hh < HA) attn_item<0>(p, lds, ong, b, hh, qt, C_QA + hh * HD, C_KA, C_VA);
        else if (hh < HA + HB) attn_item<1>(p, lds, ong, b, hh, qt, C_QB + (hh - HA) * HD, C_KB + (hh - HA) * HD, C_VB + (hh - HA) * HD);
        else attn_item<2>(p, lds, ong, b, hh, qt, C_QC + (hh - HA - HB) * HD, C_KC + (hh - HA - HB) * HD, C_VC + (hh - HA - HB) * HD);
    }
}

__device__ __forceinline__ void wave_argmax(float& v, int& idx) {
#pragma unroll
    for (int o = 32; o >= 1; o >>= 1) {
        const float ov = __shfl_xor(v, o); const int oi = __shfl_xor(idx, o);
        if (ov > v || (ov == v && oi < idx)) { v = ov; idx = oi; }
    }
}
__device__ __forceinline__ void phase_route(const Params& p, LAS unsigned char* lds_, const f16* subk) {
    const f16* qp = (const f16*)(p.ws + WS_Y);
    float* smem = (float*)(unsigned char*)lds_;
    const int tid = otid(), wid = tid >> 6, lane = tid & 63;
    float* qs = smem + wid * 256;
    unsigned* pe = (unsigned*)(p.ws + WS_PE); float* pg = (float*)(p.ws + WS_PG);
    const size_t nitems = (size_t)NT * PH;
    for (size_t it = (size_t)blockIdx.x * NWAVES + wid; it < nitems; it += (size_t)gridDim.x * NWAVES) {
        const int hp = (int)(it % PH); const int t = (int)(it / PH);
        const f16* qrow = qp + (size_t)t * DM + hp * 256;
        for (int i = lane; i < 256; i += 64) qs[i] = (float)qrow[i];
        __builtin_amdgcn_wave_barrier();
        float sv[2]; int si[2];
#pragma unroll
        for (int c = 0; c < 2; ++c) {
            float v0, v1;
            {
                const f16* k0 = subk + (((size_t)hp * 2 + c) * PNK + lane) * 128;
                const f16* k1 = k0 + 64 * 128;
                float a0 = 0.f, a1 = 0.f;
#pragma unroll 4
                for (int e8 = 0; e8 < 16; ++e8) {
                    const h8_t x0 = *(const h8_t*)(k0 + e8 * 8), x1 = *(const h8_t*)(k1 + e8 * 8);
#pragma unroll
                    for (int j = 0; j < 8; ++j) { const float qq = qs[c * 128 + e8 * 8 + j]; a0 += qq * (float)x0[j]; a1 += qq * (float)x1[j]; }
                }
                v0 = a0; v1 = a1;
            }
            float mysv = 0.f; int mysi = 0;
            for (int r = 0; r < PTOPK; ++r) {
                float v; int idx;
                if (v0 >= v1) { v = v0; idx = lane; } else { v = v1; idx = lane + 64; }
                wave_argmax(v, idx);
                if (idx == lane) v0 = -INFINITY;
                if (idx == lane + 64) v1 = -INFINITY;
                if (lane == r) { mysv = v; mysi = idx; }
            }
            sv[c] = mysv; si[c] = mysi;
        }
        float cs[4];
#pragma unroll
        for (int k = 0; k < 4; ++k) { const int id = 4 * lane + k; cs[k] = __shfl(sv[0], id >> 4) + __shfl(sv[1], id & 15); }
        float tops = 0.f; int pick = 0;
        for (int r = 0; r < PTOPK; ++r) {
            float v = cs[0]; int idx = 4 * lane;
#pragma unroll
            for (int k = 1; k < 4; ++k) if (cs[k] > v) { v = cs[k]; idx = 4 * lane + k; }
            wave_argmax(v, idx);
#pragma unroll
            for (int k = 0; k < 4; ++k) if (idx == 4 * lane + k) cs[k] = -INFINITY;
            if (lane == r) { tops = v; pick = idx; }
        }
        const int e0 = __shfl(si[0], pick >> 4), e1 = __shfl(si[1], pick & 15);
        const float mx = __shfl(tops, 0);
        float ex = lane < PTOPK ? __expf(tops - mx) : 0.f;
        const float sum = wave_sum(ex);
        if (lane < PTOPK) { pe[(size_t)t * 128 + hp * 16 + lane] = (unsigned)(e0 * PNK + e1); pg[(size_t)t * 128 + hp * 16 + lane] = ex / sum; }
        __builtin_amdgcn_wave_barrier();
    }
}

#define CE_DESC(a, b) do { const unsigned _x = (a) > (b) ? (a) : (b), _y = (a) > (b) ? (b) : (a); (a) = _x; (b) = _y; } while (0)
__device__ __forceinline__ void sort16_desc(unsigned (&k)[16]) {
#pragma unroll
    for (int kk = 2; kk <= 16; kk <<= 1)
#pragma unroll
        for (int j = kk >> 1; j > 0; j >>= 1)
#pragma unroll
            for (int i = 0; i < 16; ++i) { const int l = i ^ j; if (l > i) { if ((i & kk) == 0) CE_DESC(k[i], k[l]); else CE_DESC(k[l], k[i]); } }
}
__device__ __forceinline__ void merge16_desc(unsigned (&a)[16], const unsigned (&b)[16]) {
#pragma unroll
    for (int i = 0; i < 16; ++i) a[i] = a[i] > b[15 - i] ? a[i] : b[15 - i];
#pragma unroll
    for (int j = 8; j > 0; j >>= 1)
#pragma unroll
        for (int i = 0; i < 16; ++i) { const int l = i ^ j; if (l > i) CE_DESC(a[i], a[l]); }
}
__device__ __forceinline__ unsigned f2sort(float f) { const unsigned b = __float_as_uint(f); return b ^ ((unsigned)((int)b >> 31) | 0x80000000u); }
__device__ __forceinline__ float sort2f(unsigned u) { const unsigned b = (u & 0x80000000u) ? (u ^ 0x80000000u) : ~u; return __uint_as_float(b); }
constexpr int RT_STR = 272;
__device__ __forceinline__ void phase_route2(const Params& p, LAS unsigned char* lds, const f16* subk) {
    const f16* qp = (const f16*)(p.ws + WS_Y);
    unsigned* pe = (unsigned*)(p.ws + WS_PE); float* pg = (float*)(p.ws + WS_PG);
    const int tid = otid(), wid = __builtin_amdgcn_readfirstlane(tid >> 6), lane = tid & 63, qn = lane & 31, hf = lane >> 5;
    for (int item = obid(); item < 256; item += gridDim.x) {
        const int hp = item & 7, tg = item >> 3;
        __syncthreads();
        {
            const f16* src = subk + (size_t)hp * 256 * 128;
#pragma unroll
            for (int i = 0; i < 8; ++i) { const int e = tid + i * 512, r = e >> 4, c = e & 15; *(LAS u32x4*)(lds + r * RT_STR + 16 * c) = *(const u32x4*)(src + r * 128 + 8 * c); }
        }
        __syncthreads();
#pragma unroll 1
        for (int it = 0; it < 2; ++it) {
            const int t = (tg * 16 + wid * 2 + it) * 32 + qn;
            unsigned top[2][16];
#pragma unroll
            for (int c = 0; c < 2; ++c) {
                h8_t Bq[8];
                const f16* qrow = qp + (size_t)t * DM + hp * 256 + c * 128 + 8 * hf;
#pragma unroll
                for (int ks = 0; ks < 8; ++ks) Bq[ks] = *(const h8_t*)(qrow + 16 * ks);
                unsigned run[16];
#pragma unroll 1
                for (int nt = 0; nt < 4; ++nt) {
                    f32x16 S;
#pragma unroll
                    for (int r = 0; r < 16; ++r) S[r] = 0.f;
#pragma unroll
                    for (int ks = 0; ks < 8; ++ks) {
                        const h8_t a = *(const LAS h8_t*)(lds + (c * 128 + nt * 32 + qn) * RT_STR + 32 * ks + 16 * hf);
                        S = __builtin_amdgcn_mfma_f32_32x32x16_f16(a, Bq[ks], S, 0, 0, 0);
                    }
                    unsigned k[16];
#pragma unroll
                    for (int r = 0; r < 16; ++r) { const int n = 32 * nt + (r & 3) + 8 * (r >> 2) + 4 * hf; k[r] = (f2sort(S[r]) & ~127u) | (unsigned)(127 - n); }
                    sort16_desc(k);
                    if (nt == 0) {
#pragma unroll
                        for (int r = 0; r < 16; ++r) run[r] = k[r];
                    } else merge16_desc(run, k);
                }
#pragma unroll
                for (int r = 0; r < 16; ++r) top[c][r] = run[r];
            }
            unsigned mine[16], oth[16];
#pragma unroll
            for (int r = 0; r < 16; ++r) { const unsigned send = hf ? top[0][r] : top[1][r]; oth[r] = __shfl_xor(send, 32); mine[r] = hf ? top[1][r] : top[0][r]; }
            merge16_desc(mine, oth);
            unsigned ka[16], kb2[16];
#pragma unroll
            for (int r = 0; r < 16; ++r) { const unsigned o = __shfl_xor(mine[r], 32); ka[r] = hf ? o : mine[r]; kb2[r] = hf ? mine[r] : o; }
            float sa[16], sb[16]; unsigned na[4] = {0u, 0u, 0u, 0u}, nb[4] = {0u, 0u, 0u, 0u};
#pragma unroll
            for (int r = 0; r < 16; ++r) {
                sa[r] = sort2f(ka[r] & ~127u); sb[r] = sort2f(kb2[r] & ~127u);
                na[r >> 2] |= (127u - (ka[r] & 127u)) << (8 * (r & 3)); nb[r >> 2] |= (127u - (kb2[r] & 127u)) << (8 * (r & 3));
            }
            unsigned cand[4][16];
#pragma unroll
            for (int g = 0; g < 4; ++g)
#pragma unroll
                for (int r = 0; r < 16; ++r) cand[g][r] = 0u;
#pragma unroll
            for (int slot = 0; slot < 50; ++slot) {
                constexpr unsigned char CIJ[64] = {0, 1, 2, 3, 4, 5, 6, 7, 8, 9, 10, 11, 12, 13, 14, 15, 16, 17, 18, 19, 20, 21, 22, 23, 32, 33, 34, 35, 36, 48, 49, 50, 51, 64, 65, 66, 80, 81, 96, 97, 112, 113, 128, 144, 160, 176, 192, 208, 224, 240, 255, 255, 255, 255, 255, 255, 255, 255, 255, 255, 255, 255, 255, 255};
                const int ij = CIJ[slot], i = ij >> 4, j = ij & 15;
                cand[slot >> 4][slot & 15] = (f2sort(sa[i] + sb[j]) & ~255u) | (unsigned)(255 - ij);
            }
#pragma unroll
            for (int g = 1; g < 4; ++g) sort16_desc(cand[g]);
            merge16_desc(cand[0], cand[1]); merge16_desc(cand[2], cand[3]); merge16_desc(cand[0], cand[2]);
            float ex[16]; float sum = 0.f;
            const float mx = sort2f(cand[0][0] & ~255u);
#pragma unroll
            for (int r = 0; r < 16; ++r) { ex[r] = __expf(sort2f(cand[0][r] & ~255u) - mx); sum += ex[r]; }
            const float inv = 1.f / sum;
            unsigned eo[16];
#pragma unroll
            for (int r = 0; r < 16; ++r) {
                const unsigned id = 255u - (cand[0][r] & 255u), i = id >> 4, j = id & 15u;
                const unsigned wa = (i & 8u) ? ((i & 4u) ? na[3] : na[2]) : ((i & 4u) ? na[1] : na[0]);
                const unsigned wb = (j & 8u) ? ((j & 4u) ? nb[3] : nb[2]) : ((j & 4u) ? nb[1] : nb[0]);
                eo[r] = ((wa >> (8 * (i & 3u))) & 255u) * PNK + ((wb >> (8 * (j & 3u))) & 255u);
                ex[r] *= inv;
            }
            if (hf == 0) {
#pragma unroll
                for (int r4 = 0; r4 < 4; ++r4) { u32x4 w; w.x = eo[4 * r4]; w.y = eo[4 * r4 + 1]; w.z = eo[4 * r4 + 2]; w.w = eo[4 * r4 + 3]; *(u32x4*)(pe + (size_t)t * 128 + hp * 16 + 4 * r4) = w; }
            } else {
#pragma unroll
                for (int r4 = 0; r4 < 4; ++r4) { f32x4 w; w[0] = ex[4 * r4]; w[1] = ex[4 * r4 + 1]; w[2] = ex[4 * r4 + 2]; w[3] = ex[4 * r4 + 3]; *(f32x4*)(pg + (size_t)t * 128 + hp * 16 + 4 * r4) = w; }
            }
        }
    }
}

__device__ __forceinline__ void phase_experts(const Params& p, const f16* h2, const float* x1, const float* gate2  , const f16* u16, const f16* v16,
                              float* xout  , bool final_norm, const float* ng, const float* nshift, const float* nscale, f16* hnext, float* fout) {
    const int tid_ = otid(); const int wid = tid_ >> 6, lane = tid_ & 63;
    const unsigned* pe = (const unsigned*)(p.ws + WS_PE); const float* pg = (const float*)(p.ws + WS_PG);
    for (int t = blockIdx.x * NWAVES + wid; t < NT; t += gridDim.x * NWAVES) {
        const int b = t / SEQ;
        u32x4 hv[4];
#pragma unroll
        for (int i = 0; i < 4; ++i) hv[i] = *(const u32x4*)(h2 + (size_t)t * DM + 512 * i + 8 * lane);
        float acc[32];
#pragma unroll
        for (int i = 0; i < 32; ++i) acc[i] = 0.f;
        for (int g8 = 0; g8 < 32; ++g8) {
            const unsigned myexp = pe[(size_t)t * 128 + g8 * 4 + (lane & 3)];
            const float mygate = pg[(size_t)t * 128 + g8 * 4 + (lane & 3)];
            float part[4];
#pragma unroll
            for (int k = 0; k < 4; ++k) {
                const unsigned e = __shfl(myexp, k);
                const f16* ur = u16 + (size_t)e * DM + 8 * lane;
                float d = 0.f;
#pragma unroll
                for (int i = 0; i < 4; ++i) { const u32x4 w = *(const u32x4*)(ur + 512 * i); d = dot2(hv[i].x, w.x, d); d = dot2(hv[i].y, w.y, d); d = dot2(hv[i].z, w.z, d); d = dot2(hv[i].w, w.w, d); }
                part[k] = d;
            }
#pragma unroll
            for (int k = 0; k < 4; ++k) part[k] = wave_sum(part[k]);
#pragma unroll
            for (int k = 0; k < 4; ++k) {
                const float d = part[k];
                const float act = 0.5f * d * (1.f + erff(d * 0.70710678118654752f));
                const float coef = __shfl(mygate, k) * act;
                const unsigned e = __shfl(myexp, k);
                const f16* vr = v16 + (size_t)e * DM + 8 * lane;
#pragma unroll
                for (int i = 0; i < 4; ++i) {
                    const u32x4 w = *(const u32x4*)(vr + 512 * i);
                    acc[8 * i + 0] += coef * h_lo(w.x); acc[8 * i + 1] += coef * h_hi(w.x); acc[8 * i + 2] += coef * h_lo(w.y); acc[8 * i + 3] += coef * h_hi(w.y);
                    acc[8 * i + 4] += coef * h_lo(w.z); acc[8 * i + 5] += coef * h_hi(w.z); acc[8 * i + 6] += coef * h_lo(w.w); acc[8 * i + 7] += coef * h_hi(w.w);
                }
            }
        }
        float ss = 0.f;
#pragma unroll
        for (int i = 0; i < 4; ++i) {
            const int col = 512 * i + 8 * lane;
#pragma unroll
            for (int hf = 0; hf < 2; ++hf) {
                const f32x4 xi = *(const f32x4*)(x1 + (size_t)t * DM + col + 4 * hf);
                const f32x4 gt = *(const f32x4*)(gate2 + (size_t)b * 6 * DM + col + 4 * hf);
                f32x4 r;
#pragma unroll
                for (int j = 0; j < 4; ++j) { r[j] = xi[j] + gt[j] * acc[8 * i + 4 * hf + j]; acc[8 * i + 4 * hf + j] = r[j]; ss += r[j] * r[j]; }
                if (xout) *(f32x4*)(xout + (size_t)t * DM + col + 4 * hf) = r;
            }
        }
        ss = wave_sum(ss);
        const float rstd = rsqrtf(ss * (1.f / DM) + EPS);
#pragma unroll
        for (int i = 0; i < 4; ++i) {
            const int col = 512 * i + 8 * lane;
            if (final_norm) {
#pragma unroll
                for (int hf = 0; hf < 2; ++hf) {
                    const f32x4 gg = *(const f32x4*)(ng + col + 4 * hf);
                    f32x4 r;
#pragma unroll
                    for (int j = 0; j < 4; ++j) r[j] = acc[8 * i + 4 * hf + j] * rstd * gg[j];
                    *(f32x4*)(fout + (size_t)t * DM + col + 4 * hf) = r;
                }
            } else {
                float yv[8];
#pragma unroll
                for (int hf = 0; hf < 2; ++hf) {
                    const f32x4 gg = *(const f32x4*)(ng + col + 4 * hf), sh = *(const f32x4*)(nshift + (size_t)b * 6 * DM + col + 4 * hf), sc = *(const f32x4*)(nscale + (size_t)b * 6 * DM + col + 4 * hf);
#pragma unroll
                    for (int j = 0; j < 4; ++j) yv[4 * hf + j] = acc[8 * i + 4 * hf + j] * rstd * gg[j] * (1.f + sc[j]) + sh[j];
                }
                u32x4 w; w.x = pack_h2(yv[0], yv[1]); w.y = pack_h2(yv[2], yv[3]); w.z = pack_h2(yv[4], yv[5]); w.w = pack_h2(yv[6], yv[7]);
                *(u32x4*)(hnext + (size_t)t * DM + col) = w;
            }
        }
    }
}

__device__ __forceinline__ void phase_experts8(const Params& p, const float* x1, const float* gate2, const unsigned char* u8, const unsigned char* v8, const float* su, const float* sv,
                              float* xout  , bool final_norm, const float* ng, const float* nshift, const float* nscale, f16* hnext, float* fout) {
    const int tid_ = otid(); const int wid = tid_ >> 6, lane = tid_ & 63;
    const unsigned* pe = (const unsigned*)(p.ws + WS_PE); const float* pg = (const float*)(p.ws + WS_PG);
    const unsigned char* h8 = (const unsigned char*)(p.ws + WS_H8); const float* shv = (const float*)(p.ws + WS_SH);
    for (int t = blockIdx.x * NWAVES + wid; t < NT; t += gridDim.x * NWAVES) {
        const int b = t / SEQ;
        u32x4 hv[2];
#pragma unroll
        for (int i = 0; i < 2; ++i) hv[i] = *(const u32x4*)(h8 + (size_t)t * DM + 1024 * i + 16 * lane);
        const float sht = shv[t];
        float acc[32]; float csum = 0.f;
#pragma unroll
        for (int i = 0; i < 32; ++i) acc[i] = 0.f;
        for (int g4 = 0; g4 < 32; ++g4) {
            const unsigned myexp = pe[(size_t)t * 128 + g4 * 4 + (lane & 3)];
            const float mygate = pg[(size_t)t * 128 + g4 * 4 + (lane & 3)];
            const float mysc = mygate * sv[myexp];
            const float mydsc = su[myexp] * sht;
            int part[4]; u32x4 vr[4][2];
#pragma unroll
            for (int k = 0; k < 4; ++k) {
                const unsigned e = __shfl(myexp, k);
                const unsigned char* ur = u8 + (size_t)e * DM + 16 * lane;
                const unsigned char* vp = v8 + (size_t)e * DM + 16 * lane;
                int d = 0;
#pragma unroll
                for (int i = 0; i < 2; ++i) {
                    const u32x4 w = *(const u32x4*)(ur + 1024 * i);
                    d = __builtin_amdgcn_sdot4((int)hv[i].x, (int)w.x, d, false); d = __builtin_amdgcn_sdot4((int)hv[i].y, (int)w.y, d, false);
                    d = __builtin_amdgcn_sdot4((int)hv[i].z, (int)w.z, d, false); d = __builtin_amdgcn_sdot4((int)hv[i].w, (int)w.w, d, false);
                    vr[k][i] = *(const u32x4*)(vp + 1024 * i);
                }
                part[k] = d;
            }
#pragma unroll
            for (int k = 0; k < 4; ++k) {
#pragma unroll
                for (int o = 32; o >= 1; o >>= 1) part[k] += __shfl_xor(part[k], o);
            }
#pragma unroll
            for (int k = 0; k < 4; ++k) {
                const float d = (float)part[k] * __shfl(mydsc, k);
                const float act = 0.5f * d * (1.f + erff(d * 0.70710678118654752f));
                const float coef = __shfl(mysc, k) * act;
                csum += coef;
#pragma unroll
                for (int i = 0; i < 2; ++i) {
                    const unsigned ww[4] = {vr[k][i].x, vr[k][i].y, vr[k][i].z, vr[k][i].w};
#pragma unroll
                    for (int q = 0; q < 4; ++q) {
                        acc[16 * i + 4 * q + 0] += coef * (float)(ww[q] & 255u); acc[16 * i + 4 * q + 1] += coef * (float)((ww[q] >> 8) & 255u);
                        acc[16 * i + 4 * q + 2] += coef * (float)((ww[q] >> 16) & 255u); acc[16 * i + 4 * q + 3] += coef * (float)(ww[q] >> 24);
                    }
                }
            }
        }
        float ss = 0.f;
#pragma unroll
        for (int i = 0; i < 2; ++i)
#pragma unroll
            for (int q = 0; q < 4; ++q) {
                const int col = 1024 * i + 16 * lane + 4 * q;
                const f32x4 xi = *(const f32x4*)(x1 + (size_t)t * DM + col);
                const f32x4 gt = *(const f32x4*)(gate2 + (size_t)b * 6 * DM + col);
                f32x4 r;
#pragma unroll
                for (int j = 0; j < 4; ++j) { r[j] = xi[j] + gt[j] * (acc[16 * i + 4 * q + j] - 128.f * csum); acc[16 * i + 4 * q + j] = r[j]; ss += r[j] * r[j]; }
                if (xout) *(f32x4*)(xout + (size_t)t * DM + col) = r;
            }
        ss = wave_sum(ss);
        const float rstd = rsqrtf(ss * (1.f / DM) + EPS);
#pragma unroll
        for (int i = 0; i < 2; ++i) {
            const int col0 = 1024 * i + 16 * lane;
            if (final_norm) {
#pragma unroll
                for (int q = 0; q < 4; ++q) {
                    const f32x4 gg = *(const f32x4*)(ng + col0 + 4 * q);
                    f32x4 r;
#pragma unroll
                    for (int j = 0; j < 4; ++j) r[j] = acc[16 * i + 4 * q + j] * rstd * gg[j];
                    *(f32x4*)(fout + (size_t)t * DM + col0 + 4 * q) = r;
                }
            } else {
                float yv[16];
#pragma unroll
                for (int q = 0; q < 4; ++q) {
                    const f32x4 gg = *(const f32x4*)(ng + col0 + 4 * q), sh = *(const f32x4*)(nshift + (size_t)b * 6 * DM + col0 + 4 * q), sc = *(const f32x4*)(nscale + (size_t)b * 6 * DM + col0 + 4 * q);
#pragma unroll
                    for (int j = 0; j < 4; ++j) yv[4 * q + j] = acc[16 * i + 4 * q + j] * rstd * gg[j] * (1.f + sc[j]) + sh[j];
                }
                u32x4 w0, w1;
                w0.x = pack_h2(yv[0], yv[1]); w0.y = pack_h2(yv[2], yv[3]); w0.z = pack_h2(yv[4], yv[5]); w0.w = pack_h2(yv[6], yv[7]);
                w1.x = pack_h2(yv[8], yv[9]); w1.y = pack_h2(yv[10], yv[11]); w1.z = pack_h2(yv[12], yv[13]); w1.w = pack_h2(yv[14], yv[15]);
                *(u32x4*)(hnext + (size_t)t * DM + col0) = w0; *(u32x4*)(hnext + (size_t)t * DM + col0 + 8) = w1;
            }
        }
    }
}

#ifndef EXU_NR
#define EXU_NR 8
#define EXU_SH 11
#endif
__device__ __forceinline__ unsigned xcc_id() { return (unsigned)__builtin_amdgcn_s_getreg((3 << 11) | 20) & 0xFu; }
template <int BITS>
__device__ __forceinline__ void phase_exu(const Params& p, LAS unsigned char* lds, const unsigned char* u8, const float* su, const float* sv) {
    const int tid = otid(), wid = __builtin_amdgcn_readfirstlane(tid >> 6), lane = tid & 63, sub = lane & 15, qd = lane >> 4;
    const unsigned* pe = (const unsigned*)(p.ws + WS_PE); const float* pg = (const float*)(p.ws + WS_PG);
    const unsigned char* h8 = (const unsigned char*)(p.ws + WS_H8); const float* shv = (const float*)(p.ws + WS_SH);
    unsigned* list = (unsigned*)(p.ws + WS_LIST);
    const unsigned* ctl = (const unsigned*)(p.ws + WS_CTL);
    const unsigned myx = *(const LAS unsigned*)(lds + LDS_BYTES - 16), mybi = *(const LAS unsigned*)(lds + LDS_BYTES - 12);
    int G = 0, g = 0, nb = 1;
#pragma unroll
    for (int j = 0; j < 16; ++j) { const unsigned c = __builtin_amdgcn_readfirstlane(__hip_atomic_load(ctl + j, __ATOMIC_RELAXED, __HIP_MEMORY_SCOPE_AGENT)); if (c > 0u) { if ((unsigned)j < myx) ++g; ++G; } if ((unsigned)j == myx) nb = (int)c; }
    const int tstep = nb * NWAVES, tfirst = (int)mybi * NWAVES + wid;
    const int nvis_t = (tfirst < NT) ? (NT - tfirst + tstep - 1) / tstep : 0;
    const int nrange = (EXU_NR - g + G - 1) / G;
    const int nvis = nvis_t * nrange;
    const int* hsv = (const int*)(p.ws + WS_HS);
    unsigned ne0 = 0u, ne1 = 0u; u32x4 nhv[8]; float nsh = 0.f; int nhs = 0;
#define EXU_FETCH(v_) do { const int tt_ = tfirst + ((v_) % nvis_t) * tstep; ne0 = pe[(size_t)tt_ * 128 + lane]; ne1 = pe[(size_t)tt_ * 128 + 64 + lane]; \
        _Pragma("unroll") for (int m = 0; m < 8; ++m) nhv[m] = *(const u32x4*)(h8 + (size_t)tt_ * DM + (BITS == 8 ? 256 * m + 16 * sub : 512 * (m >> 1) + 32 * sub + 16 * (m & 1))); nsh = shv[tt_]; if (BITS == 4) nhs = hsv[tt_]; } while (0)
    if (nvis > 0) EXU_FETCH(0);
    for (int v = 0; v < nvis; ++v) {
        const int t = tfirst + (v % nvis_t) * tstep, r = g + (v / nvis_t) * G;
        const unsigned e0 = ne0, e1 = ne1; const float sht = nsh; const int hs8 = 8 * nhs;
        u32x4 hv[8];
#pragma unroll
        for (int m = 0; m < 8; ++m) hv[m] = nhv[m];
        if (v + 1 < nvis) EXU_FETCH(v + 1);
        const bool in0 = (int)(e0 >> EXU_SH) == r, in1 = (int)(e1 >> EXU_SH) == r;
        const unsigned long long m0 = __ballot(in0), m1 = __ballot(in1);
        const int n0 = __builtin_popcountll(m0), n = n0 + __builtin_popcountll(m1);
        if (n == 0) continue;
        LAS unsigned* wl = (LAS unsigned*)(lds + wid * 1024 + (v & 1) * 512);
        const unsigned long long below = (1ull << lane) - 1ull;
        if (in0) wl[__builtin_popcountll(m0 & below)] = ((unsigned)lane << 16) | e0;
        if (in1) wl[n0 + __builtin_popcountll(m1 & below)] = ((unsigned)(lane + 64) << 16) | e1;
        __builtin_amdgcn_wave_barrier();
        constexpr int PPI = 4;
        constexpr int PPQ = PPI / 4, NLD = (BITS == 8) ? 8 : 4;
        const int nit = (n + PPI - 1) / PPI;
        u32x4 wb[2][8]; unsigned entb[2][PPQ]; float sub_[2][PPQ], svb_[2][PPQ], pgb_[2][PPQ];
#define EXU_ISSUE(B_, it_) do { _Pragma("unroll") for (int pp = 0; pp < PPQ; ++pp) { const int idx_ = (it_) * PPI + qd * PPQ + pp; entb[B_][pp] = wl[idx_ < n ? idx_ : 0]; \
            sub_[B_][pp] = su[entb[B_][pp] & 0xffffu]; svb_[B_][pp] = sv[entb[B_][pp] & 0xffffu]; pgb_[B_][pp] = pg[(size_t)t * 128 + (entb[B_][pp] >> 16)]; \
            const unsigned char* row_ = u8 + (size_t)(entb[B_][pp] & 0xffffu) * (BITS == 8 ? DM : DM / 2) + 16 * sub; \
            _Pragma("unroll") for (int m = 0; m < NLD; ++m) wb[B_][pp * NLD + m] = *(const u32x4*)(row_ + 256 * m); } } while (0)
#define EXU_COMPUTE(B_, it_) do { _Pragma("unroll") for (int pp = 0; pp < PPQ; ++pp) { int d_ = 0; \
            if (BITS == 8) { \
            _Pragma("unroll") for (int m = 0; m < 8; ++m) { const u32x4 w_ = wb[B_][m]; \
                d_ = __builtin_amdgcn_sdot4((int)hv[m].x, (int)w_.x, d_, false); d_ = __builtin_amdgcn_sdot4((int)hv[m].y, (int)w_.y, d_, false); \
                d_ = __builtin_amdgcn_sdot4((int)hv[m].z, (int)w_.z, d_, false); d_ = __builtin_amdgcn_sdot4((int)hv[m].w, (int)w_.w, d_, false); } \
            } else { \
            _Pragma("unroll") for (int m = 0; m < 4; ++m) { const u32x4 w_ = wb[B_][pp * 4 + m]; const u32x4 ha_ = hv[2 * m], hb_ = hv[2 * m + 1]; \
                d_ = __builtin_amdgcn_sdot4((int)ha_.x, (int)(w_.x & 0x0F0F0F0Fu), d_, false); d_ = __builtin_amdgcn_sdot4((int)ha_.y, (int)((w_.x >> 4) & 0x0F0F0F0Fu), d_, false); \
                d_ = __builtin_amdgcn_sdot4((int)ha_.z, (int)(w_.y & 0x0F0F0F0Fu), d_, false); d_ = __builtin_amdgcn_sdot4((int)ha_.w, (int)((w_.y >> 4) & 0x0F0F0F0Fu), d_, false); \
                d_ = __builtin_amdgcn_sdot4((int)hb_.x, (int)(w_.z & 0x0F0F0F0Fu), d_, false); d_ = __builtin_amdgcn_sdot4((int)hb_.y, (int)((w_.z >> 4) & 0x0F0F0F0Fu), d_, false); \
                d_ = __builtin_amdgcn_sdot4((int)hb_.z, (int)(w_.w & 0x0F0F0F0Fu), d_, false); d_ = __builtin_amdgcn_sdot4((int)hb_.w, (int)((w_.w >> 4) & 0x0F0F0F0Fu), d_, false); } \
            } \
            d_ += __shfl_xor(d_, 1); d_ += __shfl_xor(d_, 2); d_ += __shfl_xor(d_, 4); d_ += __shfl_xor(d_, 8); \
            if (BITS == 4) d_ -= hs8; \
            if (((it_) * PPI + qd * PPQ + pp < n) && sub == 0) { \
                const unsigned ent_ = entb[B_][pp], j_ = ent_ >> 16, e_ = ent_ & 0xffffu; \
                const float dd_ = (float)d_ * sub_[B_][pp] * sht; \
                const float act_ = 0.5f * dd_ * (1.f + erff(dd_ * 0.70710678118654752f)); \
                const float coef_ = pgb_[B_][pp] * svb_[B_][pp] * act_ * (1024.f * 256.f); \
                const int ci_ = (int)rintf(fminf(fmaxf(coef_, -32767.f), 32767.f)); \
                list[((size_t)(j_ >> 2) * NT + t) * 4 + (j_ & 3u)] = e_ | ((unsigned)ci_ << 16); } } } while (0)
        EXU_ISSUE(0, 0);
        int it = 0;
        for (; it + 2 < nit; it += 2) {
            EXU_ISSUE(1, it + 1); EXU_COMPUTE(0, it);
            EXU_ISSUE(0, it + 2); EXU_COMPUTE(1, it + 1);
        }
        if (it + 2 == nit) { EXU_ISSUE(1, it + 1); EXU_COMPUTE(0, it); EXU_COMPUTE(1, it + 1); }
        else { EXU_COMPUTE(0, it); }
#undef EXU_ISSUE
#undef EXU_COMPUTE
    }
#undef EXU_FETCH
}

__device__ __forceinline__ void phase_exv(const Params& p, LAS unsigned char* lds, const f16* x1, const float* gate2, const unsigned char* v8c, f16* xout) {
    const int tid = otid();
    const u32x4* list = (const u32x4*)(p.ws + WS_LIST);
    int cfirst = obid(), cstep = gridDim.x;
    {
        const unsigned* ctl = (const unsigned*)(p.ws + WS_CTL);
        const unsigned myx = *(const LAS unsigned*)(lds + LDS_BYTES - 16), mybi = *(const LAS unsigned*)(lds + LDS_BYTES - 12);
        int G = 0, g = 0, nb = 1; bool uniform = true; unsigned c0 = 0u;
#pragma unroll
        for (int j = 0; j < 16; ++j) { const unsigned c = __builtin_amdgcn_readfirstlane(__hip_atomic_load(ctl + j, __ATOMIC_RELAXED, __HIP_MEMORY_SCOPE_AGENT)); if (c > 0u) { if ((unsigned)j < myx) ++g; ++G; if (c0 == 0u) c0 = c; else if (c != c0) uniform = false; } if ((unsigned)j == myx) nb = (int)c; }
        if (uniform && G * nb == (int)gridDim.x && (int)gridDim.x == 256) { cfirst = g * nb + (int)mybi; cstep = 256; }
    }
    for (int c = cfirst; c < 256; c += cstep) {
        __syncthreads();
        {
            const u32x4* src = (const u32x4*)(v8c + (size_t)c * PEXP * 8);
#pragma unroll 4
            for (int i = 0; i < 16; ++i) *(LAS u32x4*)(lds + (size_t)(i * 512 + tid) * 16) = src[i * 512 + tid];
        }
        __syncthreads();
        typedef short s2_t __attribute__((ext_vector_type(2)));
        u32x4 wq[2][8];
        int acc[8]; int csum = 0;
#pragma unroll
        for (int k = 0; k < 8; ++k) acc[k] = 0;
        constexpr int NBATCH = (NT / NTHREADS) * 4;
#define EXV_LOAD(B_, q_) do { const int qq_ = (q_) < NBATCH ? (q_) : NBATCH - 1; const int t_ = tid + (qq_ >> 2) * NTHREADS, jb_ = qq_ & 3; \
            _Pragma("unroll") for (int j4 = 0; j4 < 8; ++j4) wq[B_][j4] = list[(size_t)(jb_ * 8 + j4) * NT + t_]; } while (0)
        EXV_LOAD(0, 0);
#pragma unroll 1
        for (int q0 = 0; q0 < NBATCH; q0 += 4) {
#pragma unroll
            for (int u = 0; u < 4; ++u) {
                const int q = q0 + u;
                if (q < NBATCH) {
                    EXV_LOAD((u + 1) % 2, q + 1);
#pragma unroll
                    for (int j4 = 0; j4 < 8; ++j4) {
                        const unsigned dd[4] = {wq[u % 2][j4].x, wq[u % 2][j4].y, wq[u % 2][j4].z, wq[u % 2][j4].w};
#pragma unroll
                        for (int h = 0; h < 2; ++h) {
                            const unsigned d0 = dd[2 * h], d1 = dd[2 * h + 1];
                            const u32x2 v0 = *(const LAS u32x2*)(lds + (d0 & 0xffffu) * 8), v1 = *(const LAS u32x2*)(lds + (d1 & 0xffffu) * 8);
                            const s2_t cp = __builtin_bit_cast(s2_t, __builtin_amdgcn_perm(d1, d0, 0x07060302u));
                            csum = __builtin_amdgcn_sdot2(cp, __builtin_bit_cast(s2_t, 0x00010001u), csum, false);
                            acc[0] = __builtin_amdgcn_sdot2(cp, __builtin_bit_cast(s2_t, __builtin_amdgcn_perm(v1.x, v0.x, 0x0c040c00u)), acc[0], false);
                            acc[1] = __builtin_amdgcn_sdot2(cp, __builtin_bit_cast(s2_t, __builtin_amdgcn_perm(v1.x, v0.x, 0x0c050c01u)), acc[1], false);
                            acc[2] = __builtin_amdgcn_sdot2(cp, __builtin_bit_cast(s2_t, __builtin_amdgcn_perm(v1.x, v0.x, 0x0c060c02u)), acc[2], false);
                            acc[3] = __builtin_amdgcn_sdot2(cp, __builtin_bit_cast(s2_t, __builtin_amdgcn_perm(v1.x, v0.x, 0x0c070c03u)), acc[3], false);
                            acc[4] = __builtin_amdgcn_sdot2(cp, __builtin_bit_cast(s2_t, __builtin_amdgcn_perm(v1.y, v0.y, 0x0c040c00u)), acc[4], false);
                            acc[5] = __builtin_amdgcn_sdot2(cp, __builtin_bit_cast(s2_t, __builtin_amdgcn_perm(v1.y, v0.y, 0x0c050c01u)), acc[5], false);
                            acc[6] = __builtin_amdgcn_sdot2(cp, __builtin_bit_cast(s2_t, __builtin_amdgcn_perm(v1.y, v0.y, 0x0c060c02u)), acc[6], false);
                            acc[7] = __builtin_amdgcn_sdot2(cp, __builtin_bit_cast(s2_t, __builtin_amdgcn_perm(v1.y, v0.y, 0x0c070c03u)), acc[7], false);
                        }
                    }
                    if ((u & 3) == 3) {
                        const int t = tid + (q >> 2) * NTHREADS;
                        const int b = t / SEQ, col = 8 * c;
                        const int off = csum << 7;
                        const u32x4 xw = *(const u32x4*)(x1 + (size_t)t * DM + col);
                        const unsigned xws[4] = {xw.x, xw.y, xw.z, xw.w};
                        u32x4 ow; unsigned ows[4];
#pragma unroll
                        for (int hfi = 0; hfi < 2; ++hfi) {
                            const f32x4 gt = *(const f32x4*)(gate2 + (size_t)b * 6 * DM + col + 4 * hfi);
                            float r[4];
#pragma unroll
                            for (int k = 0; k < 4; ++k) { const unsigned xx = xws[2 * hfi + (k >> 1)]; const float xi = (k & 1) ? h_hi(xx) : h_lo(xx); r[k] = xi + gt[k] * ((float)(acc[4 * hfi + k] - off) * (1.f / (1024.f * 256.f))); }
                            ows[2 * hfi] = pack_h2(r[0], r[1]); ows[2 * hfi + 1] = pack_h2(r[2], r[3]);
                        }
                        ow.x = ows[0]; ow.y = ows[1]; ow.z = ows[2]; ow.w = ows[3];
                        *(u32x4*)(xout + (size_t)t * DM + col) = ow;
                        csum = 0;
#pragma unroll
                        for (int k = 0; k < 8; ++k) acc[k] = 0;
                    }
                }
            }
        }
#undef EXV_LOAD
    }
}

__device__ __forceinline__ void phase_norm_out(const Params& p, float* x2, bool final_norm, const float* g, const float* shift, const float* scale, f16* hout) {
    const int tid_ = otid(); const int wid = tid_ >> 6, lane = tid_ & 63;
    for (int row = blockIdx.x * NWAVES + wid; row < NT; row += gridDim.x * NWAVES) {
        const int b = row / SEQ;
        float* xr = x2 + (size_t)row * DM;
        f32x4 v[8]; float ss = 0.f;
#pragma unroll
        for (int i = 0; i < 8; ++i) { v[i] = *(const f32x4*)(xr + i * 256 + lane * 4); ss += v[i][0] * v[i][0] + v[i][1] * v[i][1] + v[i][2] * v[i][2] + v[i][3] * v[i][3]; }
        ss = wave_sum(ss);
        const float rstd = rsqrtf(ss * (1.f / DM) + EPS);
#pragma unroll
        for (int i = 0; i < 8; ++i) {
            const int col = i * 256 + lane * 4;
            const f32x4 gg = *(const f32x4*)(g + col);
            if (final_norm) { *(f32x4*)(xr + col) = v[i] * rstd * gg; }
            else {
                const f32x4 sh = *(const f32x4*)(shift + (size_t)b * 6 * DM + col), sc = *(const f32x4*)(scale + (size_t)b * 6 * DM + col);
                const f32x4 y = v[i] * rstd * gg * (sc + 1.f) + sh;
                u32x2 w; w.x = pack_h2(y[0], y[1]); w.y = pack_h2(y[2], y[3]);
                *(u32x2*)(hout + (size_t)row * DM + col) = w;
            }
        }
    }
}

#define XB_TMO      128
#define XB_XCNT(j)  (256  + 64 * (j))
#define XB_XSUB(j)  (1280 + 64 * (j))
#define XB_XGEN(j)  (2304 + 64 * (j))
#define XB_TOP      3328
#define XB_TOPGEN   3392
#define XCD_BAR_WORDS 3456
#define XB_SPIN_CAP (1u << 22)
__device__ __forceinline__ unsigned xb_ld(unsigned* p) { return __hip_atomic_load(p, __ATOMIC_RELAXED, __HIP_MEMORY_SCOPE_AGENT); }
__device__ __forceinline__ unsigned xb_add(unsigned* p, unsigned v) { return __hip_atomic_fetch_add(p, v, __ATOMIC_RELAXED, __HIP_MEMORY_SCOPE_AGENT); }
#define XB_SPIN(cond, bar) do { unsigned _sp = 0; while (cond) { __builtin_amdgcn_s_sleep(1); \
    if ((++_sp & 255u) == 0u) { if (xb_ld(&(bar)[XB_TMO])) break; if (_sp > XB_SPIN_CAP) { atomicAdd(&(bar)[XB_TMO], 1u); break; } } } } while (0)
struct XcdBarrier { unsigned* bar; unsigned x; volatile LAS unsigned* st; };
__device__ __forceinline__ void xcd_barrier_complete(unsigned* bar, unsigned x, unsigned& nloc, unsigned& nx) {
    const unsigned G = gridDim.x * gridDim.y * gridDim.z;
    unsigned sum, cnt, mine, sp = 0u;
    for (;;) {
        sum = 0u; cnt = 0u; mine = 0u;
#pragma unroll
        for (unsigned j = 0; j < 16; ++j) { const unsigned c = xb_ld(&bar[XB_XCNT(j)]); sum += c; cnt += (c > 0u) ? 1u : 0u; mine = (j == x) ? c : mine; }
        if (sum == G) break;
        __builtin_amdgcn_s_sleep(1);
        if ((++sp & 255u) == 0u) { if (xb_ld(&bar[XB_TMO])) break; if (sp > XB_SPIN_CAP) { atomicAdd(&bar[XB_TMO], 1u); break; } }
    }
    nloc = mine > 0u ? mine : 1u; nx = cnt > 0u ? cnt : 1u;
}
__device__ __forceinline__ void xcd_barrier(const XcdBarrier& b) {
    asm volatile("s_waitcnt vmcnt(0)" ::: "memory");
    __syncthreads();
    if (threadIdx.x == 0) {
        unsigned* bar = b.bar;
        __builtin_amdgcn_s_waitcnt(0);
        unsigned nloc = b.st[0], nx = b.st[1];
        if (nloc == 0u) { xcd_barrier_complete(bar, b.x, nloc, nx); b.st[0] = nloc; b.st[1] = nx; }
        const unsigned old = xb_add(&bar[XB_XSUB(b.x)], 1u);
        const unsigned gen = old / nloc;
        if (old + 1u == (gen + 1u) * nloc) {
            __builtin_amdgcn_fence(__ATOMIC_RELEASE, "agent");
            asm volatile("s_waitcnt vmcnt(0)" ::: "memory");
            const unsigned og = xb_add(&bar[XB_TOP], 1u);
            const unsigned tg = og / nx;
            if (og + 1u == (tg + 1u) * nx) xb_add(&bar[XB_TOPGEN], 1u);
            else XB_SPIN(xb_ld(&bar[XB_TOPGEN]) == tg, bar);
            __builtin_amdgcn_fence(__ATOMIC_ACQUIRE, "agent");
            xb_add(&bar[XB_XGEN(b.x)], 1u);
            asm volatile("s_waitcnt vmcnt(0)" ::: "memory");
        } else {
            XB_SPIN(xb_ld(&bar[XB_XGEN(b.x)]) == gen, bar);
            __builtin_amdgcn_fence(__ATOMIC_ACQUIRE, "agent");
            asm volatile("s_waitcnt vmcnt(0)" ::: "memory");
        }
    }
    __syncthreads();
}

constexpr int PH_CONV = 0, PH_N1 = 1, PH_L0 = 2, PH_PER_LAYER = 10, PH_TOTAL = PH_L0 + DEPTH * PH_PER_LAYER;

__global__ void __launch_bounds__(NTHREADS, 2) mega(Params p_arg) {
    extern __shared__ __attribute__((aligned(16))) unsigned char shm[];
    LAS unsigned char* lds = (LAS unsigned char*)shm;
    typedef const Params __attribute__((address_space(4)))* KP;
    const int ph_lo = p_arg.ph_lo, ph_hi = p_arg.ph_hi;
    if (threadIdx.x == 0) {
        const unsigned x = xcc_id();
        const unsigned bi = __hip_atomic_fetch_add((unsigned*)(p_arg.ws + WS_CTL) + x, 1u, __ATOMIC_RELAXED, __HIP_MEMORY_SCOPE_AGENT);
        *(LAS unsigned*)(lds + LDS_BYTES - 16) = x; *(LAS unsigned*)(lds + LDS_BYTES - 12) = bi;
        *(LAS unsigned*)(lds + LDS_BYTES - 32) = 0u; *(LAS unsigned*)(lds + LDS_BYTES - 28) = 0u;
        (void)xb_add((unsigned*)(p_arg.ws + WS_CTL + 256) + XB_XCNT(x), 1u);
    }
    __syncthreads();
    XcdBarrier xbar; xbar.bar = (unsigned*)(p_arg.ws + WS_CTL + 256); xbar.x = *(const LAS unsigned*)(lds + LDS_BYTES - 16); xbar.st = (volatile LAS unsigned*)(lds + LDS_BYTES - 32);
#ifndef PMASK
#define PMASK 0xff
#endif
#define EN(k) ((PMASK >> (k)) & 1)
    for (int ph = ph_lo; ph < ph_hi; ++ph) {
        KP kp = (KP)__builtin_amdgcn_kernarg_segment_ptr();
        asm volatile("" : "+s"(kp));
#if defined(__HIP_DEVICE_COMPILE__)
        const Params p = *kp;
#else
        const Params p = p_arg;
#endif
        unsigned char* ws = p.ws;
        const float* mod = (const float*)(ws + WS_MOD);
        int kind, l = 0, s = -1;
        if (ph == PH_CONV) kind = 0;
        else if (ph == PH_N1) kind = 1;
        else {
            l = (ph - PH_L0) / PH_PER_LAYER; s = (ph - PH_L0) % PH_PER_LAYER;
            kind = (s == 0 || s == 3 || s == 5) ? 2 : (s == 1 ? 4 : (s == 2 ? 5 : (s == 4 ? 1 : (s == 6 ? 6 : (s == 7 ? 7 : (s == 8 ? 8 : 9))))));
        }
        const float* modl = mod + (size_t)l * NB * 6 * DM;
        f16* x1 = (f16*)(ws + WS_X1); f16* x2 = (f16*)(ws + WS_X2);
#ifndef REPEAT_KIND
#define REPEAT_KIND -1
#endif
        for (int rep = 0; rep < ((kind == REPEAT_KIND) ? 2 : 1); ++rep) {
        if (rep == 1) xcd_barrier(xbar);
        if (kind == 0) { if (EN(0)) phase_conv(p, lds); }
        else if (kind == 1) {
            if (EN(1)) {
                if (s < 0) phase_norm2<0, false>(p.x, nullptr, nullptr, p.n1g, mod + 0 * DM, mod + 1 * DM, (f16*)(ws + WS_H), nullptr, nullptr);
                else phase_norm2<1, true>(nullptr, x1, nullptr, p.n2g + (size_t)l * DM, modl + 3 * DM, modl + 4 * DM, (f16*)(ws + WS_H), (unsigned*)(ws + WS_H8), (float*)(ws + WS_SH));
            }
        } else if (kind == 2) {
            if (EN(2)) {
                Epi E{}; const f16* A; const f16* Bt; int N;
                if (s == 0) { E.mode = 2; E.rope128 = (const float*)(ws + WS_ROPE128); E.rope64 = (const float*)(ws + WS_ROPE64); E.o16 = (f16*)(ws + WS_PROJ); E.ldc = INWP; A = (const f16*)(ws + WS_H); Bt = (const f16*)(ws + WS_WTIN) + (size_t)l * INWP * DM; N = INWP; }
                else if (s == 3) { E.mode = 1; E.o16 = x1; E.xin = p.x; E.xinh = l == 0 ? nullptr : x2; E.gate = modl + 2 * DM; A = (const f16*)(ws + WS_Y); Bt = (const f16*)(ws + WS_WTOUT) + (size_t)l * DM * DM; N = DM; }
                else { E.mode = 0; E.o16 = (f16*)(ws + WS_Y); E.ldc = DM; A = (const f16*)(ws + WS_H); Bt = (const f16*)(ws + WS_WTQ) + (size_t)l * DM * DM; N = DM; }
                gemm_run(p, lds, A, Bt, N, E);
            }
        } else if (kind == 3) { if (EN(3)) phase_rope(p); }
        else if (kind == 4) { if (EN(4)) phase_index2(p, lds); }
        else if (kind == 5) { if (EN(5)) phase_attn2(p, lds, p.ong + (size_t)l * DM, (unsigned*)(ws + WS_CTL + 64) + l); }
        else if (kind == 6) { if (EN(6)) phase_route2(p, lds, (const f16*)(ws + WS_SUBK) + (size_t)l * PH * 2 * PNK * 128); }
        else if (kind == 7) {
            if (EN(7)) { if (l == DEPTH - 1 && LAST_BITS == 4) phase_exu<4>(p, lds, ws + WS_U8 + (size_t)l * PEXP * DM, (const float*)(ws + WS_SU) + (size_t)l * PEXP, (const float*)(ws + WS_SV) + (size_t)l * PEXP);
                         else phase_exu<8>(p, lds, ws + WS_U8 + (size_t)l * PEXP * DM, (const float*)(ws + WS_SU) + (size_t)l * PEXP, (const float*)(ws + WS_SV) + (size_t)l * PEXP); }
        } else if (kind == 8) {
            if (EN(7)) phase_exv(p, lds, x1, modl + 5 * DM, ws + WS_V8 + (size_t)l * PEXP * DM, x2);
        } else {
            const bool fin = (l == DEPTH - 1);
            const float* modn = mod + (size_t)(fin ? l : l + 1) * NB * 6 * DM;
            if (EN(1)) { if (fin) phase_norm2<2, true>(nullptr, x2, p.out, p.fg, nullptr, nullptr, nullptr, nullptr, nullptr);
                         else phase_norm2<0, true>(nullptr, x2, nullptr, p.n1g + (size_t)(l + 1) * DM, modn + 0 * DM, modn + 1 * DM, (f16*)(ws + WS_H), nullptr, nullptr); }
        }
        }
        if (ph + 1 < ph_hi) { if (ph == ph_lo) cg::this_grid().sync(); else xcd_barrier(xbar); }
    }
}

extern "C" void kernel_launch(void* const* d_in, const int* in_sizes, int n_in, void* d_out, int out_size, void* d_ws, size_t ws_size, hipStream_t stream) {
    static int grid = 0;
    if (grid == 0) {
        if (n_in != 14 || out_size != NT * DM || ws_size < WS_END) { fprintf(stderr, "kernel_launch: unexpected sizes (n_in %d out %d ws %zu need %zu)\n", n_in, out_size, ws_size, (size_t)WS_END); grid = -1; return; }
        if (hipFuncSetAttribute((const void*)mega, hipFuncAttributeMaxDynamicSharedMemorySize, LDS_BYTES) != hipSuccess) { fprintf(stderr, "kernel_launch: hipFuncSetAttribute failed\n"); grid = -1; return; }
        int dev = 0, cus = 0, per_cu = 0;
        hipGetDevice(&dev); hipDeviceGetAttribute(&cus, hipDeviceAttributeMultiprocessorCount, dev);
        hipOccupancyMaxActiveBlocksPerMultiprocessor(&per_cu, (const void*)mega, NTHREADS, LDS_BYTES);
        if (per_cu < 1) { fprintf(stderr, "kernel_launch: occupancy query says %d blocks per CU\n", per_cu); grid = -1; return; }
        grid = cus;
    }
    if (grid < 0) return;
    Params p{};
    p.x = (const float*)d_in[0]; p.c = (const float*)d_in[1]; p.ada_w = (const float*)d_in[2]; p.ada_b = (const float*)d_in[3];
    p.n1g = (const float*)d_in[4]; p.n2g = (const float*)d_in[5]; p.w_in = (const float*)d_in[6]; p.ong = (const float*)d_in[7];
    p.w_out = (const float*)d_in[8]; p.wq = (const float*)d_in[9]; p.subk = (const float*)d_in[10]; p.pu = (const float*)d_in[11];
    p.pv = (const float*)d_in[12]; p.fg = (const float*)d_in[13];
    p.out = (float*)d_out; p.ws = (unsigned char*)d_ws;
#if 0
    for (int ph = 0; ph < PH_TOTAL; ++ph) {
        p.ph_lo = ph; p.ph_hi = ph + 1;
        hipLaunchKernelGGL(mega, dim3(grid), dim3(NTHREADS), LDS_BYTES, stream, p);
    }
#else
    p.ph_lo = 0; p.ph_hi = PH_TOTAL;
    if (hipMemsetAsync((char*)d_ws + WS_CTL, 0, CTL_BYTES, stream) != hipSuccess) { fprintf(stderr, "kernel_launch: memset of control words failed\n"); return; }
    void* args[] = {&p};
    hipError_t e = hipLaunchCooperativeKernel((const void*)mega, dim3(grid), dim3(NTHREADS), args, LDS_BYTES, stream);
    if (e != hipSuccess) fprintf(stderr, "cooperative launch failed: %s (grid %d)\n", hipGetErrorString(e), grid);
#endif
}
```

```cpp
#include <hip/hip_runtime.h>
#include <hip/hip_cooperative_groups.h>
#include <cstdio>
#include <cstdint>
namespace cg = cooperative_groups;

#define LAS __attribute__((address_space(3)))
typedef _Float16 f16;
typedef _Float16 h2_t __attribute__((ext_vector_type(2)));
typedef _Float16 h4_t __attribute__((ext_vector_type(4)));
typedef _Float16 h8_t __attribute__((ext_vector_type(8)));
typedef float f32x4 __attribute__((ext_vector_type(4)));
typedef unsigned u32x4 __attribute__((ext_vector_type(4)));
typedef unsigned u32x2 __attribute__((ext_vector_type(2)));

constexpr int NB = 8, SEQ = 2048, DM = 2048, NT = NB * SEQ, DEPTH = 2;
constexpr int HD = 128, HA = 6, HB = 5, HC = 5, NHEADS = 16;
constexpr int IH = 16, IDM = 64, DSA_TOPK = 256;
constexpr int MOBA_BLK = 256, MOBA_NB = 8;
constexpr int INW = 5968, INWP = 6144;
constexpr int PH = 8, PNK = 128, PTOPK = 16, PEXP = 16384;
constexpr float EPS = 1e-6f;
constexpr int C_QA = 0, C_KA = 768, C_VA = 896, C_IQ = 1024, C_IK = 2048, C_IW = 2112, C_QB = 2176, C_KB = 2816, C_VB = 3456,
              C_QC = 4096, C_KC = 4736, C_VC = 5376, C_END = 6016;

#ifndef LAST_BITS
#define LAST_BITS 8
#endif
constexpr int NTHREADS = 512, NWAVES = 8;
constexpr int LDS_BYTES = 147456;

constexpr size_t al256(size_t x) { return (x + 255) & ~(size_t)255; }
constexpr size_t WS_WTIN = 0;
constexpr size_t WS_WTOUT = WS_WTIN + (size_t)DEPTH * INWP * DM * 2;
constexpr size_t WS_WTQ = WS_WTOUT + (size_t)DEPTH * DM * DM * 2;
constexpr size_t WS_U8 = WS_WTQ + (size_t)DEPTH * DM * DM * 2;
constexpr size_t WS_V8 = WS_U8 + (size_t)DEPTH * PEXP * DM;
constexpr size_t WS_SU = WS_V8 + (size_t)DEPTH * PEXP * DM;
constexpr size_t WS_SV = WS_SU + (size_t)DEPTH * PEXP * 4;
constexpr size_t WS_H8 = WS_SV + (size_t)DEPTH * PEXP * 4;
constexpr size_t WS_SH = WS_H8 + (size_t)NT * DM;
constexpr size_t WS_HS = WS_SH + (size_t)NT * 4;
constexpr size_t WS_SUBK = WS_HS + (size_t)NT * 4;
constexpr size_t WS_MOD = WS_SUBK + (size_t)DEPTH * PH * 2 * PNK * 128 * 2;
constexpr size_t WS_ROPE128 = WS_MOD + (size_t)DEPTH * NB * 6 * DM * 4;
constexpr size_t WS_ROPE64 = WS_ROPE128 + (size_t)SEQ * 64 * 8;
constexpr size_t WS_H = WS_ROPE64 + (size_t)SEQ * 32 * 8;
constexpr size_t WS_PROJ = WS_H + (size_t)NT * DM * 2;
constexpr size_t WS_KMEAN = WS_PROJ + (size_t)NT * INWP * 2;
constexpr size_t WS_MASK = WS_KMEAN + al256((size_t)NB * HC * MOBA_NB * HD * 4);
constexpr size_t WS_Y = WS_MASK + (size_t)NB * SEQ * 64 * 4;
constexpr size_t WS_X1 = WS_Y + (size_t)NT * DM * 2;
constexpr size_t WS_X2 = WS_X1 + (size_t)NT * DM * 2;
constexpr size_t WS_PE = WS_X1 + (size_t)NT * DM * 4;
constexpr size_t WS_PG = WS_PE + (size_t)NT * 128 * 4;
constexpr size_t WS_LIST = WS_PG + (size_t)NT * 128 * 4;
constexpr size_t WS_CTL = WS_LIST + (size_t)NT * 128 * 4;
constexpr size_t CTL_BYTES = 16384;
constexpr size_t WS_END = WS_CTL + CTL_BYTES;

struct Params {
    const float *x, *c, *ada_w, *ada_b, *n1g, *n2g, *w_in, *ong, *w_out, *wq, *subk, *pu, *pv, *fg;
    float* out;
    unsigned char* ws;
    int ph_lo, ph_hi;
};

__device__ __forceinline__ int otid() { int t = threadIdx.x; asm volatile("" : "+v"(t)); return t; }
__device__ __forceinline__ int obid() { int t = blockIdx.x; asm volatile("" : "+s"(t)); return t; }
__device__ __forceinline__ float wave_sum(float v) {
#pragma unroll
    for (int o = 32; o >= 1; o >>= 1) v += __shfl_xor(v, o);
    return v;
}
__device__ __forceinline__ float wave_max(float v) {
#pragma unroll
    for (int o = 32; o >= 1; o >>= 1) v = fmaxf(v, __shfl_xor(v, o));
    return v;
}
__device__ __forceinline__ unsigned pack_h2(float a, float b) { h2_t r; r.x = (f16)a; r.y = (f16)b; return __builtin_bit_cast(unsigned, r); }
__device__ __forceinline__ float h_lo(unsigned u) { h2_t r = __builtin_bit_cast(h2_t, u); return (float)r.x; }
__device__ __forceinline__ float h_hi(unsigned u) { h2_t r = __builtin_bit_cast(h2_t, u); return (float)r.y; }
__device__ __forceinline__ float dot2(unsigned a, unsigned b, float c) {
    return __builtin_amdgcn_fdot2(__builtin_bit_cast(h2_t, a), __builtin_bit_cast(h2_t, b), c, false);
}

namespace pg8 {
constexpr int BM = 256, BK = 64, HALF = 128, HTB = HALF * BK * 2, STAGE_BYTES = 8 * HTB, NXCD = 8, WGM = 8;
__host__ __device__ __forceinline__ int lds_byte(int r, int c) { const int st = (r >> 4) * 2 + (c >> 5), rr = r & 15, cc = c & 31, ob = rr * 64 + cc * 2; return st * 1024 + (ob ^ (((ob >> 9) & 1) << 5)); }
__host__ __device__ __forceinline__ void stage_rc(int b, int& R, int& C) { const int st = b / 1024, sb = b % 1024, swz = sb ^ (((sb >> 9) & 1) << 5); R = (st >> 1) * 16 + swz / 64; C = (st & 1) * 32 + (swz % 64) / 2; }
struct Unit { int pm, pn; };
struct Gemm { const unsigned short* A; const unsigned short* Bt; int M, N, K; };
struct StaticOrder {
    int nM, nN, nwg, G, c;
    __host__ __device__ void init(int M, int N, int G_, int c_) { nM = M / BM; nN = N / BM; nwg = nM * nN; G = G_; c = c_; }
    __host__ __device__ bool next(int i, Unit& u) const {
        const long L = (long)i * G + c; if (L >= nwg) return false;
        int wgid = (int)L; { const int q = nwg / NXCD, r = nwg % NXCD, xcd = wgid % NXCD, off = wgid / NXCD; wgid = (xcd < r ? xcd * (q + 1) : r * (q + 1) + (xcd - r) * q) + off; }
        const int nig = WGM * nN, gid = wgid / nig, fm = gid * WGM, gsz = (nM - fm) < WGM ? (nM - fm) : WGM;
        u.pm = fm + ((wgid % nig) % gsz); u.pn = (wgid % nig) / gsz; return true;
    }
};

template <class Epi>
__device__ __forceinline__ void gemm_phase(LAS unsigned char* lds, const Gemm g, const StaticOrder& S, const Epi& E) {
    const int tid = otid(), wid = __builtin_amdgcn_readfirstlane(tid >> 6), lane = tid & 63, wr = wid >> 2, wc = wid & 3, fr = lane & 15, fq = lane >> 4;
    const int K = g.K, nt = K / BK;
    unsigned voffA[2], voffB[2];
#pragma unroll
    for (int i = 0; i < 2; ++i) { int R, C; stage_rc(tid * 16 + i * 8192, R, C); voffA[i] = (unsigned)(R * K + C) * 2u; voffB[i] = (unsigned)(R * K + C) * 2u; }
    const size_t kstep = (size_t)(BK * 2);
    const size_t hstep = (size_t)HALF * K * 2;
    const size_t tstep = 2 * hstep;
    const unsigned ldsw = (unsigned)wid * 1024u;
    const int aoff = lds_byte(wr * 64 + fr, fq * 8), boff = lds_byte(wc * 32 + fr, fq * 8);
#define PG8_SA(b, h) (((b) * 2 + (h)) * HTB)
#define PG8_SB(b, h) ((4 + (b) * 2 + (h)) * HTB)
#define PG8_STAGE(bufoff, gbase, voff) do { _Pragma("unroll") for (int _i = 0; _i < 2; ++_i) \
        __builtin_amdgcn_global_load_lds((const unsigned*)((const char*)(gbase) + (voff)[_i]), (LAS unsigned*)(lds + (bufoff) + ldsw + _i * 8192), 16, 0, 0); } while (0)
#define PG8_LDA(dst, b, h) do { _Pragma("unroll") for (int m = 0; m < 4; ++m) _Pragma("unroll") for (int k = 0; k < 2; ++k) dst[m][k] = *(const LAS h8_t*)(lds + PG8_SA(b, h) + aoff + m * 2048 + k * 1024); } while (0)
#define PG8_LDB(dst, b, h) do { _Pragma("unroll") for (int n = 0; n < 2; ++n) _Pragma("unroll") for (int k = 0; k < 2; ++k) dst[n][k] = *(const LAS h8_t*)(lds + PG8_SB(b, h) + boff + n * 2048 + k * 1024); } while (0)
#define PG8_MMA(ai, bj, At, Bt) do { __builtin_amdgcn_s_setprio(1); _Pragma("unroll") for (int m = 0; m < 4; ++m) _Pragma("unroll") for (int n = 0; n < 2; ++n) _Pragma("unroll") for (int k = 0; k < 2; ++k) \
        acc[ai][bj][m][n] = __builtin_amdgcn_mfma_f32_16x16x32_f16(Bt[n][k], At[m][k], acc[ai][bj][m][n], 0, 0, 0); __builtin_amdgcn_s_setprio(0); } while (0)
#define PG8_WAIT_V(n) asm volatile("s_waitcnt vmcnt(" #n ")" ::: "memory")
#define PG8_WAIT_L(n) asm volatile("s_waitcnt lgkmcnt(" #n ")" ::: "memory")
#define PG8_BAR __builtin_amdgcn_s_barrier()
#define PG8_SCHED __builtin_amdgcn_sched_barrier(0)
    Unit cur, nxt; int ui = 0;
    if (!S.next(0, cur)) return;
    f32x4 acc[2][2][4][2];
#pragma unroll
    for (int a = 0; a < 2; ++a)
#pragma unroll
        for (int b = 0; b < 2; ++b)
#pragma unroll
            for (int m = 0; m < 4; ++m)
#pragma unroll
                for (int n = 0; n < 2; ++n) acc[a][b][m][n] = (f32x4){0.f, 0.f, 0.f, 0.f};
    h8_t At[4][2], B0[2][2], B1[2][2];
    const char* cA = (const char*)g.A + (size_t)cur.pm * tstep; const char* cB = (const char*)g.Bt + (size_t)cur.pn * tstep;
    PG8_STAGE(PG8_SB(0, 0), cB, voffB); PG8_STAGE(PG8_SA(0, 0), cA, voffA); PG8_STAGE(PG8_SB(0, 1), cB + hstep, voffB); PG8_STAGE(PG8_SA(0, 1), cA + hstep, voffA);
    if (wr == 1) PG8_BAR;
    PG8_WAIT_V(4); PG8_BAR;
    PG8_STAGE(PG8_SB(1, 0), cB + kstep, voffB); PG8_STAGE(PG8_SA(1, 0), cA + kstep, voffA); PG8_STAGE(PG8_SB(1, 1), cB + hstep + kstep, voffB);
    PG8_WAIT_V(6); PG8_BAR;
    for (;;) {
        const bool has_next = S.next(ui + 1, nxt);
        const char* nA = has_next ? (const char*)g.A + (size_t)nxt.pm * tstep : cA; const char* nB = has_next ? (const char*)g.Bt + (size_t)nxt.pn * tstep : cB;
        for (int t = 0; t < nt; t += 2) {
            const bool last = (t == nt - 2);
            const char* a1 = cA + (size_t)(t + 1) * kstep;
            const char* a2 = last ? nA : cA + (size_t)(t + 2) * kstep; const char* b2 = last ? nB : cB + (size_t)(t + 2) * kstep;
            const char* a3 = a2 + kstep; const char* b3 = b2 + kstep;
            PG8_LDB(B0, 0, 0); PG8_SCHED; PG8_LDA(At, 0, 0); PG8_STAGE(PG8_SA(1, 1), a1 + hstep, voffA);
            PG8_WAIT_L(8); PG8_BAR; PG8_WAIT_L(0); PG8_MMA(0, 0, At, B0); PG8_BAR; PG8_SCHED;
            PG8_LDB(B1, 0, 1); PG8_STAGE(PG8_SB(0, 0), b2, voffB);
            PG8_BAR; PG8_WAIT_L(0); PG8_MMA(0, 1, At, B1); PG8_BAR;
            PG8_LDA(At, 0, 1); PG8_STAGE(PG8_SA(0, 0), a2, voffA);
            PG8_BAR; PG8_WAIT_L(0); PG8_MMA(1, 0, At, B0); PG8_BAR; PG8_SCHED;
            PG8_STAGE(PG8_SB(0, 1), b2 + hstep, voffB);
            PG8_WAIT_V(6); PG8_BAR; PG8_MMA(1, 1, At, B1); PG8_BAR;
            PG8_LDB(B0, 1, 0); PG8_SCHED; PG8_LDA(At, 1, 0); PG8_STAGE(PG8_SA(0, 1), a2 + hstep, voffA);
            PG8_WAIT_L(8); PG8_BAR; PG8_WAIT_L(0); PG8_MMA(0, 0, At, B0); PG8_BAR; PG8_SCHED;
            PG8_LDB(B1, 1, 1); PG8_STAGE(PG8_SB(1, 0), b3, voffB);
            PG8_BAR; PG8_WAIT_L(0); PG8_MMA(0, 1, At, B1); PG8_BAR;
            PG8_LDA(At, 1, 1); PG8_STAGE(PG8_SA(1, 0), a3, voffA);
            PG8_BAR; PG8_WAIT_L(0); PG8_MMA(1, 0, At, B0); PG8_BAR; PG8_SCHED;
            PG8_STAGE(PG8_SB(1, 1), b3 + hstep, voffB);
            PG8_WAIT_V(6); PG8_BAR; PG8_MMA(1, 1, At, B1); PG8_BAR;
        }
        E(acc, cur, wr, wc, fr, fq);
        if (!has_next) break;
#pragma unroll
        for (int a = 0; a < 2; ++a)
#pragma unroll
            for (int b = 0; b < 2; ++b)
#pragma unroll
                for (int m = 0; m < 4; ++m)
#pragma unroll
                    for (int n = 0; n < 2; ++n) acc[a][b][m][n] = (f32x4){0.f, 0.f, 0.f, 0.f};
        cur = nxt; cA = nA; cB = nB; ++ui;
    }
    PG8_WAIT_V(0);
    if (wr == 0) PG8_BAR;
    PG8_BAR;
#undef PG8_SA
#undef PG8_SB
#undef PG8_STAGE
#undef PG8_LDA
#undef PG8_LDB
#undef PG8_MMA
#undef PG8_WAIT_V
#undef PG8_WAIT_L
#undef PG8_BAR
#undef PG8_SCHED
}
}

__device__ __forceinline__ int win_src_col_l(int pc) { return pc < 2128 ? pc : (pc < C_QB ? -1 : (pc < C_END ? pc - 48 : -1)); }
__device__ __forceinline__ int rope_type(int g) { return (g <= 6 || (g >= 32 && g <= 41)) ? 1 : ((g >= 8 && g <= 15) ? 2 : (g == 16 ? 3 : 0)); }
__device__ __forceinline__ int win_src_col(int pc) {
    const int g = pc >> 7, p = pc & 127, ty = rope_type(g);
    int l = p;
    if (ty == 1) { const int q4 = p >> 2, e = p & 3; l = 2 * q4 + (e >> 1) + 64 * (e & 1); }
    else if (ty == 2 || (ty == 3 && p < 64)) { const int hb = p >> 6, pp = p & 63, q4 = pp >> 2, e = pp & 3; l = hb * 64 + 2 * q4 + (e >> 1) + 32 * (e & 1); }
    return win_src_col_l(g * 128 + l);
}


struct Epi {
    int mode; f16* o16; int ldc; float* o32; const float* xin; const f16* xinh; const float* gate; const float* rope128; const float* rope64;
    __device__ __forceinline__ void operator()(const f32x4 (&acc)[2][2][4][2], const pg8::Unit& u, int wr, int wc, int fr, int fq) const {
        const int row0 = u.pm * 256 + wr * 64 + fr, col0 = u.pn * 256 + wc * 32 + 4 * fq;
        if (mode == 2) {
#pragma unroll
            for (int bj = 0; bj < 2; ++bj) {
                const int g = __builtin_amdgcn_readfirstlane(u.pn * 2 + bj);
                int ty = rope_type(g); if (ty == 3) ty = (wc < 2) ? 2 : 0;
                f16* ob = o16 + (size_t)g * 128;
                if (ty == 0) {
#pragma unroll
                    for (int ai = 0; ai < 2; ++ai)
#pragma unroll
                        for (int m = 0; m < 4; ++m)
#pragma unroll
                            for (int n = 0; n < 2; ++n) {
                                const f32x4 v = acc[ai][bj][m][n];
                                u32x2 w; w.x = pack_h2(v[0], v[1]); w.y = pack_h2(v[2], v[3]);
                                *(u32x2*)(ob + (size_t)(row0 + ai * 128 + m * 16) * ldc + wc * 32 + n * 16 + 4 * fq) = w;
                            }
                } else {
                    const float* tab = ty == 1 ? rope128 : rope64;
                    const int half = ty == 1 ? 64 : 32, tw = ty == 1 ? 128 : 64;
#pragma unroll
                    for (int ai = 0; ai < 2; ++ai) {
                        f32x4 cs[4][2];
#pragma unroll
                        for (int m = 0; m < 4; ++m)
#pragma unroll
                            for (int n = 0; n < 2; ++n) {
                                const int pos = (row0 + ai * 128 + m * 16) & (SEQ - 1), p = wc * 32 + n * 16 + 4 * fq;
                                const int j = ty == 1 ? (p >> 1) : ((p & 63) >> 1);
                                cs[m][n] = *(const f32x4*)(tab + (size_t)pos * tw + 2 * j);
                            }
#pragma unroll
                        for (int m = 0; m < 4; ++m) {
                            const int row = row0 + ai * 128 + m * 16;
#pragma unroll
                            for (int n = 0; n < 2; ++n) {
                                const int p = wc * 32 + n * 16 + 4 * fq;
                                const int j = ty == 1 ? (p >> 1) : ((p & 63) >> 1), base = ty == 1 ? 0 : (p & 64);
                                const f32x4 v = acc[ai][bj][m][n], c4 = cs[m][n];
                                const float o1a = v[0] * c4[0] - v[1] * c4[1], o2a = v[1] * c4[0] + v[0] * c4[1];
                                const float o1b = v[2] * c4[2] - v[3] * c4[3], o2b = v[3] * c4[2] + v[2] * c4[3];
                                f16* op = ob + (size_t)row * ldc + base + j;
                                *(unsigned*)op = pack_h2(o1a, o1b); *(unsigned*)(op + half) = pack_h2(o2a, o2b);
                            }
                        }
                    }
                }
            }
            return;
        }
        if (mode == 1) {
            const int b = row0 / SEQ;
            f32x4 gt[2][2];
#pragma unroll
            for (int bj = 0; bj < 2; ++bj)
#pragma unroll
                for (int n = 0; n < 2; ++n) gt[bj][n] = *(const f32x4*)(gate + (size_t)b * 6 * DM + col0 + bj * 128 + n * 16);
#pragma unroll
            for (int ai = 0; ai < 2; ++ai)
#pragma unroll
                for (int mh = 0; mh < 2; ++mh) {
                    f32x4 xi[2][2][2];
#pragma unroll
                    for (int m2 = 0; m2 < 2; ++m2)
#pragma unroll
                        for (int bj = 0; bj < 2; ++bj)
#pragma unroll
                            for (int n = 0; n < 2; ++n) {
                                const size_t o = (size_t)(row0 + ai * 128 + (2 * mh + m2) * 16) * DM + col0 + bj * 128 + n * 16;
                                if (xinh) { const u32x2 w = *(const u32x2*)(xinh + o); xi[m2][bj][n] = (f32x4){h_lo(w.x), h_hi(w.x), h_lo(w.y), h_hi(w.y)}; }
                                else xi[m2][bj][n] = *(const f32x4*)(xin + o);
                            }
#pragma unroll
                    for (int m2 = 0; m2 < 2; ++m2)
#pragma unroll
                        for (int bj = 0; bj < 2; ++bj)
#pragma unroll
                            for (int n = 0; n < 2; ++n) {
                                const f32x4 r = xi[m2][bj][n] + gt[bj][n] * acc[ai][bj][2 * mh + m2][n];
                                u32x2 w; w.x = pack_h2(r[0], r[1]); w.y = pack_h2(r[2], r[3]);
                                *(u32x2*)(o16 + (size_t)(row0 + ai * 128 + (2 * mh + m2) * 16) * DM + col0 + bj * 128 + n * 16) = w;
                            }
                }
            return;
        }
#pragma unroll
        for (int ai = 0; ai < 2; ++ai)
#pragma unroll
            for (int m = 0; m < 4; ++m) {
                const int row = row0 + ai * 128 + m * 16;
#pragma unroll
                for (int bj = 0; bj < 2; ++bj)
#pragma unroll
                    for (int n = 0; n < 2; ++n) {
                        const int col = col0 + bj * 128 + n * 16;
                        const f32x4 v = acc[ai][bj][m][n];
                        if (mode == 0) {
                            u32x2 w; w.x = pack_h2(v[0], v[1]); w.y = pack_h2(v[2], v[3]);
                            *(u32x2*)(o16 + (size_t)row * ldc + col) = w;
                        } else {
                            const int b = row / SEQ;
                            const f32x4 xi = *(const f32x4*)(xin + (size_t)row * DM + col);
                            const f32x4 gt = *(const f32x4*)(gate + (size_t)b * 6 * DM + col);
                            *(f32x4*)(o32 + (size_t)row * DM + col) = xi + gt * v;
                        }
                    }
            }
    }
};

__device__ __forceinline__ void gemm_run(const Params& p, LAS unsigned char* lds, const f16* A, const f16* Bt, int N, const Epi& E) {
    pg8::Gemm g; g.A = (const unsigned short*)A; g.Bt = (const unsigned short*)Bt; g.M = NT; g.N = N; g.K = DM;
    pg8::StaticOrder S; S.init(NT, N, (int)gridDim.x, (int)blockIdx.x);
    pg8::gemm_phase<Epi>(lds, g, S, E);
}

__device__ __forceinline__ void transpose_tiles(const float* src, int ldsrc, int ncols_phys, bool is_win, f16* dst, float* tile  , int& unit_base, int unit_lo) {
    const int tn = ncols_phys / 64, tk = DM / 64, ntile = tn * tk;
    const int tid = otid();
    float cur[8], nxt[8];
#define TT_LOAD(R_, u_) do { const int n0_ = ((u_) % tn) * 64, k0_ = ((u_) / tn) * 64; \
        _Pragma("unroll") for (int i = 0; i < 8; ++i) { const int e = tid + i * 512, r = e >> 6, c = e & 63; const int pc = n0_ + c; const int sc = is_win ? win_src_col(pc) : pc; \
            R_[i] = sc >= 0 ? src[(size_t)(k0_ + r) * ldsrc + sc] : 0.f; } } while (0)
    int u = blockIdx.x;
    if (u < ntile) TT_LOAD(nxt, u);
    for (; u < ntile; u += gridDim.x) {
        const int n0 = (u % tn) * 64, k0 = (u / tn) * 64;
#pragma unroll
        for (int i = 0; i < 8; ++i) cur[i] = nxt[i];
        if (u + (int)gridDim.x < ntile) TT_LOAD(nxt, u + gridDim.x);
        __syncthreads();
#pragma unroll
        for (int i = 0; i < 8; ++i) { const int e = tid + i * 512, r = e >> 6, c = e & 63; tile[r * 65 + c] = cur[i]; }
        __syncthreads();
        {
            const int n = tid >> 3, kq = (tid & 7) * 8;
            u32x4 w;
            w.x = pack_h2(tile[(kq + 0) * 65 + n], tile[(kq + 1) * 65 + n]); w.y = pack_h2(tile[(kq + 2) * 65 + n], tile[(kq + 3) * 65 + n]);
            w.z = pack_h2(tile[(kq + 4) * 65 + n], tile[(kq + 5) * 65 + n]); w.w = pack_h2(tile[(kq + 6) * 65 + n], tile[(kq + 7) * 65 + n]);
            *(u32x4*)(dst + (size_t)(n0 + n) * DM + k0 + kq) = w;
        }
    }
#undef TT_LOAD
    (void)unit_base; (void)unit_lo;
}

__device__ __forceinline__ void cvt_f16_stream(const float* src, f16* dst, size_t n) {
    const size_t stride = (size_t)gridDim.x * NTHREADS;
    for (size_t i = (size_t)blockIdx.x * NTHREADS + otid(); i < n / 8; i += stride) {
        const f32x4 a = *(const f32x4*)(src + i * 8), b = *(const f32x4*)(src + i * 8 + 4);
        u32x4 w; w.x = pack_h2(a[0], a[1]); w.y = pack_h2(a[2], a[3]); w.z = pack_h2(b[0], b[1]); w.w = pack_h2(b[2], b[3]);
        *(u32x4*)(dst + i * 8) = w;
    }
}

__device__ __forceinline__ void quant_rows(const float* src, int nrows, unsigned* dst, float* scale, int bias) {
    const int tid_ = otid(); const int wid = tid_ >> 6, lane = tid_ & 63;
    const int rstep = gridDim.x * NWAVES;
    int row = blockIdx.x * NWAVES + wid;
    f32x4 v[8], nv[8];
    if (row < nrows) {
#pragma unroll
        for (int i = 0; i < 8; ++i) nv[i] = *(const f32x4*)(src + (size_t)row * DM + i * 256 + lane * 4);
    }
    for (; row < nrows; row += rstep) {
#pragma unroll
        for (int i = 0; i < 8; ++i) v[i] = nv[i];
        if (row + rstep < nrows) {
#pragma unroll
            for (int i = 0; i < 8; ++i) nv[i] = *(const f32x4*)(src + (size_t)(row + rstep) * DM + i * 256 + lane * 4);
        }
        float am = 0.f;
#pragma unroll
        for (int i = 0; i < 8; ++i) am = fmaxf(am, fmaxf(fmaxf(fabsf(v[i][0]), fabsf(v[i][1])), fmaxf(fabsf(v[i][2]), fabsf(v[i][3]))));
        am = wave_max(am);
        const float sc = am > 0.f ? am * (1.f / 127.f) : 1.f, inv = 1.f / sc;
        if (lane == 0) scale[row] = sc;
#pragma unroll
        for (int i = 0; i < 8; ++i) {
            unsigned w = 0u;
#pragma unroll
            for (int j = 0; j < 4; ++j) { const int q = (int)rintf(v[i][j] * inv) + bias; w |= ((unsigned)q & 255u) << (8 * j); }
            dst[(size_t)row * (DM / 4) + i * 64 + lane] = w;
        }
    }
}

__device__ __forceinline__ void quant_rows4(const float* src, int nrows, unsigned* dst, float* scale) {
    const int tid_ = otid(); const int wid = tid_ >> 6, lane = tid_ & 63;
    const int rstep = gridDim.x * NWAVES;
    int row = blockIdx.x * NWAVES + wid;
    f32x4 v[8], nv[8];
    if (row < nrows) {
#pragma unroll
        for (int i = 0; i < 8; ++i) nv[i] = *(const f32x4*)(src + (size_t)row * DM + i * 256 + lane * 4);
    }
    for (; row < nrows; row += rstep) {
#pragma unroll
        for (int i = 0; i < 8; ++i) v[i] = nv[i];
        if (row + rstep < nrows) {
#pragma unroll
            for (int i = 0; i < 8; ++i) nv[i] = *(const f32x4*)(src + (size_t)(row + rstep) * DM + i * 256 + lane * 4);
        }
        float am = 0.f;
#pragma unroll
        for (int i = 0; i < 8; ++i) am = fmaxf(am, fmaxf(fmaxf(fabsf(v[i][0]), fabsf(v[i][1])), fmaxf(fabsf(v[i][2]), fabsf(v[i][3]))));
        am = wave_max(am);
        const float sc = am > 0.f ? am * (1.f / 7.f) : 1.f, inv = 1.f / sc;
        if (lane == 0) scale[row] = sc;
#pragma unroll
        for (int i = 0; i < 8; ++i) {
            unsigned w = 0u;
#pragma unroll
            for (int j = 0; j < 4; ++j) { const int q = (int)rintf(v[i][j] * inv) + 8; w |= ((unsigned)q & 15u) << (8 * j); }
            if (lane & 1) w <<= 4;
            const unsigned o = __shfl_down(w, 1);
            if (!(lane & 1)) dst[(size_t)row * (DM / 8) + i * 32 + (lane >> 1)] = w | o;
        }
    }
}

constexpr int QV_STR = DM + 8;
__device__ __forceinline__ void quant_v_sliced(const float* src, unsigned char* dst, float* scale, LAS unsigned char* lds) {
    const int tid = otid(), wid = tid >> 6, lane = tid & 63;
    for (int blk = obid(); blk < DEPTH * PEXP / 64; blk += gridDim.x) {
        const int row0 = blk * 64, layer = row0 / PEXP, e0 = row0 % PEXP;
        __syncthreads();
        f32x4 nv[8];
#pragma unroll
        for (int i = 0; i < 8; ++i) nv[i] = *(const f32x4*)(src + (size_t)(row0 + wid) * DM + i * 256 + lane * 4);
        for (int rr = wid; rr < 64; rr += NWAVES) {
            f32x4 v[8]; float am = 0.f;
#pragma unroll
            for (int i = 0; i < 8; ++i) v[i] = nv[i];
            if (rr + NWAVES < 64) {
#pragma unroll
                for (int i = 0; i < 8; ++i) nv[i] = *(const f32x4*)(src + (size_t)(row0 + rr + NWAVES) * DM + i * 256 + lane * 4);
            }
#pragma unroll
            for (int i = 0; i < 8; ++i) am = fmaxf(am, fmaxf(fmaxf(fabsf(v[i][0]), fabsf(v[i][1])), fmaxf(fabsf(v[i][2]), fabsf(v[i][3]))));
            am = wave_max(am);
            const float sc = am > 0.f ? am * (1.f / 127.f) : 1.f, inv = 1.f / sc;
            if (lane == 0) scale[row0 + rr] = sc;
#pragma unroll
            for (int i = 0; i < 8; ++i) {
                unsigned w = 0u;
#pragma unroll
                for (int j = 0; j < 4; ++j) { const int q = (int)rintf(v[i][j] * inv) + 128; w |= ((unsigned)q & 255u) << (8 * j); }
                *(LAS unsigned*)(lds + rr * QV_STR + i * 256 + lane * 4) = w;
            }
        }
        __syncthreads();
        for (int c = wid; c < 256; c += NWAVES) {
            const u32x2 w = *(const LAS u32x2*)(lds + lane * QV_STR + c * 8);
            *(u32x2*)(dst + (((size_t)layer * 256 + c) * PEXP + e0 + lane) * 8) = w;
        }
    }
}

__device__ __forceinline__ void phase_conv(const Params& p, LAS unsigned char* lds_) {
    float* smem = (float*)(unsigned char*)lds_;
    unsigned char* ws = p.ws;
    const int tid = otid();
    int dummy = 0;
    {
        float* cond = smem;
        float* red = smem + NB * DM;
        for (int i = tid; i < NB * DM; i += NTHREADS) { const float v = p.c[i]; cond[i] = v / (1.f + __expf(-v)); }
        __syncthreads();
        for (int u = blockIdx.x; u < DEPTH * 128; u += gridDim.x) {
            const int l = u >> 7, j0 = (u & 127) * 96;
            const int c4 = tid % 24, kg = tid / 24;
            if (kg < 21) {
                f32x4 acc[NB];
#pragma unroll
                for (int b = 0; b < NB; ++b) acc[b] = (f32x4){0.f, 0.f, 0.f, 0.f};
                const float* wp = p.ada_w + (size_t)l * DM * 6 * DM + j0 + 4 * c4;
#pragma unroll 1
                for (int i0 = 0; i0 < 98; i0 += 7) {
                    f32x4 w[7];
#pragma unroll
                    for (int i = 0; i < 7; ++i) { const int k = kg + 21 * (i0 + i); w[i] = k < DM ? *(const f32x4*)(wp + (size_t)k * 6 * DM) : (f32x4){0.f, 0.f, 0.f, 0.f}; }
#pragma unroll
                    for (int i = 0; i < 7; ++i) { const int k = kg + 21 * (i0 + i); const int kk = k < DM ? k : 0;
#pragma unroll
                        for (int b = 0; b < NB; ++b) acc[b] += w[i] * cond[b * DM + kk]; }
                }
#pragma unroll
                for (int b = 0; b < NB; ++b) *(f32x4*)(red + (kg * NB + b) * 96 + 4 * c4) = acc[b];
            }
            __syncthreads();
            for (int i = tid; i < NB * 96; i += NTHREADS) {
                const int b = i / 96, cc = i % 96;
                float sacc = p.ada_b[(size_t)l * 6 * DM + j0 + cc];
#pragma unroll
                for (int g = 0; g < 21; ++g) sacc += red[(g * NB + b) * 96 + cc];
                ((float*)(ws + WS_MOD))[((size_t)l * NB + b) * 6 * DM + j0 + cc] = sacc;
            }
            __syncthreads();
        }
    }
    {
        float2* r128 = (float2*)(ws + WS_ROPE128); float2* r64 = (float2*)(ws + WS_ROPE64);
        for (int i = blockIdx.x * NTHREADS + tid; i < SEQ * 64; i += gridDim.x * NTHREADS) {
            const int pos = i >> 6, j = i & 63;
            const float inv = powf(10000.f, -(float)j / 64.f); const float ang = (float)pos * inv;
            r128[i] = make_float2((float)cos((double)ang), (float)sin((double)ang));
        }
        for (int i = blockIdx.x * NTHREADS + tid; i < SEQ * 32; i += gridDim.x * NTHREADS) {
            const int pos = i >> 5, j = i & 31;
            const float inv = powf(10000.f, -(float)j / 32.f); const float ang = (float)pos * inv;
            r64[i] = make_float2((float)cos((double)ang), (float)sin((double)ang));
        }
    }
    __syncthreads();
    for (int l = 0; l < DEPTH; ++l) {
        transpose_tiles(p.w_in + (size_t)l * DM * INW, INW, INWP, true, (f16*)(ws + WS_WTIN) + (size_t)l * INWP * DM, smem, dummy, 0);
        transpose_tiles(p.w_out + (size_t)l * DM * DM, DM, DM, false, (f16*)(ws + WS_WTOUT) + (size_t)l * DM * DM, smem, dummy, 0);
        transpose_tiles(p.wq + (size_t)l * DM * DM, DM, DM, false, (f16*)(ws + WS_WTQ) + (size_t)l * DM * DM, smem, dummy, 0);
    }
    quant_rows(p.pu, PEXP, (unsigned*)(ws + WS_U8), (float*)(ws + WS_SU), 0);
    if (LAST_BITS == 4) quant_rows4(p.pu + (size_t)PEXP * DM, PEXP, (unsigned*)(ws + WS_U8 + (size_t)PEXP * DM), (float*)(ws + WS_SU) + PEXP);
    else quant_rows(p.pu + (size_t)PEXP * DM, PEXP, (unsigned*)(ws + WS_U8 + (size_t)PEXP * DM), (float*)(ws + WS_SU) + PEXP, 0);
    quant_v_sliced(p.pv, ws + WS_V8, (float*)(ws + WS_SV), lds_);
    cvt_f16_stream(p.subk, (f16*)(ws + WS_SUBK), (size_t)DEPTH * PH * 2 * PNK * 128);
}

template <int MODE, bool XH>
__device__ __forceinline__ void phase_norm2(const float* xin, const f16* xinh, float* fout, const float* g, const float* shift, const float* scale, f16* hout, unsigned* h8, float* sh8) {
    const int tid_ = otid(); const int wid = tid_ >> 6, lane = tid_ & 63;
    for (int r0 = (blockIdx.x * NWAVES + wid) * 8; r0 < NT; r0 += gridDim.x * NWAVES * 8) {
        const int b = r0 / SEQ;
        f32x4 gm[8], sh[8];
#pragma unroll
        for (int i = 0; i < 8; ++i) {
            const int col = i * 256 + lane * 4;
            gm[i] = *(const f32x4*)(g + col);
            if (MODE != 2) { gm[i] = gm[i] * (*(const f32x4*)(scale + (size_t)b * 6 * DM + col) + 1.f); sh[i] = *(const f32x4*)(shift + (size_t)b * 6 * DM + col); }
        }
        f32x4 v[8], nv[8]; u32x2 nh[8];
#define NR_LOAD(row_) do { _Pragma("unroll") for (int i = 0; i < 8; ++i) { if (XH) nh[i] = *(const u32x2*)(xinh + (size_t)(row_) * DM + i * 256 + lane * 4); else nv[i] = *(const f32x4*)(xin + (size_t)(row_) * DM + i * 256 + lane * 4); } } while (0)
        NR_LOAD(r0);
#pragma unroll 1
        for (int k = 0; k < 8; ++k) {
            const int row = r0 + k;
#pragma unroll
            for (int i = 0; i < 8; ++i) { if (XH) { v[i][0] = h_lo(nh[i].x); v[i][1] = h_hi(nh[i].x); v[i][2] = h_lo(nh[i].y); v[i][3] = h_hi(nh[i].y); } else v[i] = nv[i]; }
            if (k < 7) NR_LOAD(row + 1);
            float ss = 0.f;
#pragma unroll
            for (int i = 0; i < 8; ++i) ss += v[i][0] * v[i][0] + v[i][1] * v[i][1] + v[i][2] * v[i][2] + v[i][3] * v[i][3];
            ss = wave_sum(ss);
            const float rstd = rsqrtf(ss * (1.f / DM) + EPS);
            float am = 0.f;
#pragma unroll
            for (int i = 0; i < 8; ++i) {
                const int col = i * 256 + lane * 4;
                if (MODE == 2) { *(f32x4*)(fout + (size_t)row * DM + col) = v[i] * rstd * gm[i]; }
                else {
                    const f32x4 y = v[i] * rstd * gm[i] + sh[i];
                    u32x2 w; w.x = pack_h2(y[0], y[1]); w.y = pack_h2(y[2], y[3]);
                    *(u32x2*)(hout + (size_t)row * DM + col) = w;
                    if (MODE == 1) { v[i] = y; am = fmaxf(am, fmaxf(fmaxf(fabsf(y[0]), fabsf(y[1])), fmaxf(fabsf(y[2]), fabsf(y[3])))); }
                }
            }
            if (MODE == 1) {
                am = wave_max(am);
                const float qs = am > 0.f ? am * (1.f / 127.f) : 1.f, inv = 1.f / qs;
                if (lane == 0) sh8[row] = qs;
                int qsum = 0;
#pragma unroll
                for (int i = 0; i < 8; ++i) {
                    unsigned w = 0u;
#pragma unroll
                    for (int j = 0; j < 4; ++j) { const int q = (int)rintf(v[i][j] * inv); qsum += q; w |= ((unsigned)q & 255u) << (8 * j); }
                    h8[(size_t)row * (DM / 4) + i * 64 + lane] = w;
                }
#pragma unroll
                for (int o = 32; o >= 1; o >>= 1) qsum += __shfl_xor(qsum, o);
                if (lane == 0) ((int*)(sh8 + NT))[row] = qsum;
            }
        }
#undef NR_LOAD
    }
}

constexpr int IX_ROW = SEQ + 4;
__device__ __forceinline__ void index_item(const Params& p, LAS unsigned char* lds, int b, int qg) {
    const f16* proj = (const f16*)(p.ws + WS_PROJ);
    LAS float* sc = (LAS float*)lds;
    const int tid = otid(), wid = __builtin_amdgcn_readfirstlane(tid >> 6), lane = tid & 63, fr = lane & 15, fq = lane >> 4;
    const int t0 = qg * 16, nkt = qg + 1;
    h8_t Bq[IH][2]; float wq[IH];
    {
        const f16* qrow = proj + ((size_t)b * SEQ + t0 + fr) * INWP;
#pragma unroll
        for (int h = 0; h < IH; ++h) {
            Bq[h][0] = *(const h8_t*)(qrow + C_IQ + h * IDM + 8 * fq);
            Bq[h][1] = *(const h8_t*)(qrow + C_IQ + h * IDM + 32 + 8 * fq);
        }
        const h8_t w0 = *(const h8_t*)(qrow + C_IW), w1 = *(const h8_t*)(qrow + C_IW + 8);
#pragma unroll
        for (int h = 0; h < 8; ++h) { wq[h] = (float)w0[h] * (0.25f * 0.125f); wq[8 + h] = (float)w1[h] * (0.25f * 0.125f); }
    }
    __syncthreads();
    const f16* kbase = proj + ((size_t)b * SEQ + fr) * INWP + C_IK + 8 * fq;
    h8_t a0, a1, n0, n1;
#define IX_LOAD(A0_, A1_, kt_) do { const int c_ = (kt_) < nkt ? (kt_) : 0; A0_ = *(const h8_t*)(kbase + (size_t)c_ * 16 * INWP); A1_ = *(const h8_t*)(kbase + (size_t)c_ * 16 * INWP + 32); } while (0)
#define IX_TILE(A0_, A1_, kt_) do { f32x4 acc = {0.f, 0.f, 0.f, 0.f}; \
        _Pragma("unroll") for (int h = 0; h < IH; ++h) { \
            f32x4 c = {0.f, 0.f, 0.f, 0.f}; \
            c = __builtin_amdgcn_mfma_f32_16x16x32_f16(A0_, Bq[h][0], c, 0, 0, 0); \
            c = __builtin_amdgcn_mfma_f32_16x16x32_f16(A1_, Bq[h][1], c, 0, 0, 0); \
            _Pragma("unroll") for (int j = 0; j < 4; ++j) { const int ci = __float_as_int(c[j]); acc[j] += wq[h] * __int_as_float(ci > 0 ? ci : 0); } } \
        *(LAS f32x4*)(sc + fr * IX_ROW + (kt_) * 16 + 4 * fq) = acc; } while (0)
    int kt = wid;
    IX_LOAD(a0, a1, kt);
    for (; kt < nkt; kt += 2 * NWAVES) {
        IX_LOAD(n0, n1, kt + NWAVES); __builtin_amdgcn_sched_barrier(0);
        IX_TILE(a0, a1, kt); __builtin_amdgcn_sched_barrier(0);
        IX_LOAD(a0, a1, kt + 2 * NWAVES); __builtin_amdgcn_sched_barrier(0);
        if (kt + NWAVES < nkt) IX_TILE(n0, n1, kt + NWAVES);
        __builtin_amdgcn_sched_barrier(0);
    }
#undef IX_LOAD
#undef IX_TILE
    __syncthreads();
    unsigned* mask = (unsigned*)(p.ws + WS_MASK);
#pragma unroll 1
    for (int qq = 0; qq < 2; ++qq) {
        const int ql = 2 * wid + qq, t = t0 + ql, nk = t + 1;
        unsigned key[32];
#pragma unroll
        for (int i = 0; i < 32; ++i) {
            const int s = lane + 64 * i;
            unsigned u = 0u;
            if (s < nk) { const unsigned bits = __float_as_uint(sc[ql * IX_ROW + s]); u = (bits & 0x80000000u) ? ~bits : (bits | 0x80000000u); if (u == 0u) u = 1u; }
            key[i] = u;
        }
        unsigned thr = 1u;
        if (nk > DSA_TOPK) {
            thr = 0u;
            const int nreg8 = (nk + 511) >> 9;
            for (int bit = 31; bit >= 0; --bit) {
                const unsigned cand = thr | (1u << bit);
                int cnt = 0;
#pragma unroll
                for (int i8 = 0; i8 < 4; ++i8) {
                    if (i8 < nreg8) {
#pragma unroll
                        for (int i = 0; i < 8; ++i) cnt += __builtin_popcountll(__ballot(key[8 * i8 + i] >= cand));
                    }
                }
                if (cnt >= DSA_TOPK) { thr = cand; if (cnt == DSA_TOPK) break; }
            }
        }
        unsigned* mrow = mask + ((size_t)b * SEQ + t) * 64;
        unsigned myw = 0u;
#pragma unroll
        for (int i = 0; i < 32; ++i) {
            const unsigned long long bal = __ballot(key[i] >= thr && key[i] != 0u);
            if (lane == 2 * i) myw = (unsigned)bal;
            if (lane == 2 * i + 1) myw = (unsigned)(bal >> 32);
        }
        mrow[lane] = myw;
    }
}

__device__ __forceinline__ void phase_index2(const Params& p, LAS unsigned char* lds_) {
    const f16* proj = (const f16*)(p.ws + WS_PROJ);
    float* smem = (float*)(unsigned char*)lds_;
    const int tid = otid();
    {
        float* red = smem;
        float* km = (float*)(p.ws + WS_KMEAN);
        for (int u = obid(); u < NB * HC * MOBA_NB; u += gridDim.x) {
            const int blk = u % MOBA_NB, h = (u / MOBA_NB) % HC, b = u / (MOBA_NB * HC);
            const int d = tid & 127, part = tid >> 7;
            float s = 0.f;
            const f16* kp = proj + ((size_t)b * SEQ + blk * MOBA_BLK + part * 64) * INWP + C_KC + h * HD + d;
#pragma unroll
            for (int k0 = 0; k0 < 64; k0 += 16) {
                f16 kv[16];
#pragma unroll
                for (int k = 0; k < 16; ++k) kv[k] = kp[(size_t)(k0 + k) * INWP];
#pragma unroll
                for (int k = 0; k < 16; ++k) s += (float)kv[k];
            }
            __syncthreads();
            red[part * 128 + d] = s;
            __syncthreads();
            if (tid < 128) km[(size_t)u * HD + tid] = (red[tid] + red[128 + tid] + red[256 + tid] + red[384 + tid]) * (1.f / MOBA_BLK);
        }
        __syncthreads();
    }
    for (int pi = obid(); pi < NB * 64; pi += gridDim.x) {
        const int b = pi >> 6, a = pi & 63;
        index_item(p, lds_, b, 127 - a);
        index_item(p, lds_, b, a);
    }
}

typedef short s4_t __attribute__((ext_vector_type(4)));
typedef float f32x16 __attribute__((ext_vector_type(16)));
constexpr int AT_KSTR = 272, AT_VSTR = 320, AT_KBYTES = 64 * AT_KSTR, AT_VBYTES = 64 * AT_VSTR, AT_STAGE = AT_KBYTES + AT_VBYTES;
__device__ __forceinline__ float fexp2(float x) { return __builtin_amdgcn_exp2f(x); }
__device__ __forceinline__ float flog2(float x) { return __builtin_amdgcn_logf(x); }

template <int VAR>
__device__ __forceinline__ void attn_item(const Params& p, LAS unsigned char* lds, const float* ong, int b, int hh, int qt, int qc, int kc, int vc) {
    const f16* proj = (const f16*)(p.ws + WS_PROJ);
    const int tid = otid(), wid = __builtin_amdgcn_readfirstlane(tid >> 6), lane = tid & 63, qn = lane & 31, hf = lane >> 5;
    const int q0 = qt * 256, qrow = q0 + 32 * wid + qn;
    const size_t grow = (size_t)b * SEQ + qrow;
    h8_t Qf[8];
    {
        const float sc = 0.08838834764831845f * 1.4426950408889634f;
        const f16* qp = proj + grow * INWP + qc + 8 * hf;
#pragma unroll
        for (int ks = 0; ks < 8; ++ks) {
            const h8_t v = *(const h8_t*)(qp + 16 * ks);
            h8_t w;
#pragma unroll
            for (int j = 0; j < 8; ++j) w[j] = (f16)((float)v[j] * sc);
            Qf[ks] = w;
        }
    }
    unsigned allowed = 0xffu;
    if (VAR == 2) {
        const int own = qt;
        const float* km = (const float*)(p.ws + WS_KMEAN) + ((size_t)b * HC + (hh - HA - HB)) * MOBA_NB * HD + 8 * hf;
        float gs[MOBA_NB];
#pragma unroll
        for (int j = 0; j < MOBA_NB; ++j) gs[j] = -INFINITY;
#pragma unroll
        for (int j = 0; j < MOBA_NB - 1; ++j) {
            if (j < own) {
                float s = 0.f;
#pragma unroll
                for (int ks = 0; ks < 8; ++ks) {
                    const f32x4 k0 = *(const f32x4*)(km + j * HD + 16 * ks), k1 = *(const f32x4*)(km + j * HD + 16 * ks + 4);
                    s += (float)Qf[ks][0] * k0[0] + (float)Qf[ks][1] * k0[1] + (float)Qf[ks][2] * k0[2] + (float)Qf[ks][3] * k0[3]
                       + (float)Qf[ks][4] * k1[0] + (float)Qf[ks][5] * k1[1] + (float)Qf[ks][6] * k1[2] + (float)Qf[ks][7] * k1[3];
                }
                gs[j] = s + __shfl_xor(s, 32);
            }
        }
        allowed = 1u << own;
#pragma unroll
        for (int j = 0; j < MOBA_NB - 1; ++j) {
            if (j < own) {
                int rank = 0;
#pragma unroll
                for (int k2 = 0; k2 < MOBA_NB - 1; ++k2) if (k2 < own && (gs[k2] > gs[j] || (gs[k2] == gs[j] && k2 < j))) ++rank;
                if (rank < 3) allowed |= 1u << j;
            }
        }
    }
    f32x16 O[4];
#pragma unroll
    for (int dt = 0; dt < 4; ++dt)
#pragma unroll
        for (int r = 0; r < 16; ++r) O[dt][r] = 0.f;
    float m_run = -INFINITY, l_run = 0.f, carry = 0.f;
    const int nst = (qt + 1) * 4;
    const int st_hi_w = qt * 4 + (wid >> 1);
    const int sr0 = tid >> 4, sc0 = tid & 15;
    const f16* kg = proj + ((size_t)b * SEQ + sr0) * INWP + kc + 8 * sc0;
    const f16* vg = proj + ((size_t)b * SEQ + sr0) * INWP + vc + 8 * sc0;
    const unsigned kw = sr0 * AT_KSTR + 16 * sc0, vw = AT_KBYTES + sr0 * AT_VSTR + 16 * sc0;
    const unsigned* mrow = (const unsigned*)(p.ws + WS_MASK) + grow * 64;
    const unsigned ka = qn * AT_KSTR + 16 * hf;
    const unsigned va = AT_KBYTES + (4 * hf + ((lane & 15) >> 2)) * AT_VSTR + (16 * ((lane >> 4) & 1) + 4 * (lane & 3)) * 2;
    u32x4 rk0, rk1, rv0, rv1; u32x2 mw = {0u, 0u}, mwn = {0u, 0u};
#define AT_LOAD(st_) do { const size_t o_ = (size_t)(st_) * 64 * INWP; rk0 = *(const u32x4*)(kg + o_); rk1 = *(const u32x4*)(kg + o_ + (size_t)32 * INWP); \
        rv0 = *(const u32x4*)(vg + o_); rv1 = *(const u32x4*)(vg + o_ + (size_t)32 * INWP); if (VAR == 0) mwn = *(const u32x2*)(mrow + 2 * (st_)); } while (0)
#define AT_WRITE(buf_) do { LAS unsigned char* b_ = lds + (buf_) * AT_STAGE; *(LAS u32x4*)(b_ + kw) = rk0; *(LAS u32x4*)(b_ + kw + 32 * AT_KSTR) = rk1; \
        *(LAS u32x4*)(b_ + vw) = rv0; *(LAS u32x4*)(b_ + vw + 32 * AT_VSTR) = rv1; } while (0)
    __syncthreads();
    AT_LOAD(nst - 1); AT_WRITE(0); mw = mwn;
    __syncthreads();
    int cur = 0;
    bool wdone = false;
    for (int st = nst - 1; st >= 0; --st) {
        if (st > 0) AT_LOAD(st - 1);
        if (st <= st_hi_w && !wdone) {
            LAS unsigned char* kb = lds + cur * AT_STAGE;
            f32x16 S[2];
#pragma unroll
            for (int r = 0; r < 16; ++r) { S[0][r] = 0.f; S[1][r] = 0.f; }
#pragma unroll
            for (int ks = 0; ks < 8; ++ks) {
                const h8_t a0 = *(const LAS h8_t*)(kb + ka + 32 * ks), a1 = *(const LAS h8_t*)(kb + ka + 32 * ks + 32 * AT_KSTR);
                S[0] = __builtin_amdgcn_mfma_f32_32x32x16_f16(a0, Qf[ks], S[0], 0, 0, 0);
                S[1] = __builtin_amdgcn_mfma_f32_32x32x16_f16(a1, Qf[ks], S[1], 0, 0, 0);
            }
            const bool diag = (64 * st + 63 > q0 + 32 * wid);
            const int kbase = 64 * st + 4 * hf;
            if (VAR != 1) {
                const bool blk_ok = (VAR == 2) ? ((allowed >> (st >> 2)) & 1u) : true;
                float mx = -INFINITY;
                if (VAR == 2 && !diag) {
                    const float bias = blk_ok ? 0.f : -INFINITY;
#pragma unroll
                    for (int sub = 0; sub < 2; ++sub)
#pragma unroll
                        for (int r = 0; r < 16; ++r) { const float v = S[sub][r] + bias; S[sub][r] = v; mx = fmaxf(mx, v); }
                } else {
#pragma unroll
                for (int sub = 0; sub < 2; ++sub)
#pragma unroll
                    for (int r = 0; r < 16; ++r) {
                        const int kl = (r & 3) + 8 * (r >> 2);
                        bool ok;
                        if (VAR == 0) ok = ((sub == 0 ? mw.x : mw.y) >> (kl + 4 * hf)) & 1u;
                        else ok = blk_ok && (!diag || (kbase + 32 * sub + kl <= qrow));
                        const float v = ok ? S[sub][r] : -INFINITY;
                        S[sub][r] = v; mx = fmaxf(mx, v);
                    }
                }
                mx = fmaxf(mx, __shfl_xor(mx, 32));
                const float m_new = fmaxf(m_run, mx);
                const float m_use = (m_new == -INFINITY) ? 0.f : m_new;
                const float alpha = fexp2(m_run - m_use);
                float ps = 0.f;
#pragma unroll
                for (int sub = 0; sub < 2; ++sub)
#pragma unroll
                    for (int r = 0; r < 16; ++r) { const float e = fexp2(S[sub][r] - m_use); S[sub][r] = e; ps += e; }
                l_run = l_run * alpha + ps;
                m_run = m_new;
                if (__ballot(alpha != 1.f) != 0ull) {
#pragma unroll
                    for (int dt = 0; dt < 4; ++dt)
#pragma unroll
                        for (int r = 0; r < 16; ++r) O[dt][r] *= alpha;
                }
            } else {
#pragma unroll
                for (int sub = 1; sub >= 0; --sub) {
                    float lk[16];
#pragma unroll
                    for (int r = 0; r < 16; ++r) {
                        const int kl = (r & 3) + 8 * (r >> 2);
                        const bool ok = !diag || (kbase + 32 * sub + kl < qrow);
                        const float zl = S[sub][r];
                        const float sp = fmaxf(zl, 0.f) + flog2(1.f + fexp2(-fabsf(zl)));
                        lk[r] = ok ? -sp : 0.f;
                        S[sub][r] = ok ? zl : -INFINITY;
                    }
                    float gsum[4], pg[4], T[4];
#pragma unroll
                    for (int g = 0; g < 4; ++g) { gsum[g] = (lk[4 * g] + lk[4 * g + 1]) + (lk[4 * g + 2] + lk[4 * g + 3]); pg[g] = __shfl_xor(gsum[g], 32); T[g] = gsum[g] + pg[g]; }
                    float after[4];
                    after[3] = 0.f; after[2] = T[3]; after[1] = T[3] + T[2]; after[0] = T[3] + T[2] + T[1];
#pragma unroll
                    for (int g = 0; g < 4; ++g) {
                        const float base = carry + after[g] + (hf == 0 ? pg[g] : 0.f);
                        const float c3 = lk[4 * g + 3], c2 = lk[4 * g + 2] + c3, c1 = lk[4 * g + 1] + c2, c0 = lk[4 * g] + c1;
                        S[sub][4 * g + 3] = fexp2(S[sub][4 * g + 3] + base + c3);
                        S[sub][4 * g + 2] = fexp2(S[sub][4 * g + 2] + base + c2);
                        S[sub][4 * g + 1] = fexp2(S[sub][4 * g + 1] + base + c1);
                        S[sub][4 * g + 0] = fexp2(S[sub][4 * g + 0] + base + c0);
                    }
                    carry += (T[0] + T[1]) + (T[2] + T[3]);
                }
            }
#pragma unroll
            for (int sub = 0; sub < 2; ++sub)
#pragma unroll
                for (int s2 = 0; s2 < 2; ++s2) {
                    h8_t pb;
#pragma unroll
                    for (int j = 0; j < 8; ++j) pb[j] = (f16)S[sub][8 * s2 + j];
#pragma unroll
                    for (int dt = 0; dt < 4; ++dt) {
                        const LAS unsigned char* ap = kb + va + (32 * sub + 16 * s2) * AT_VSTR + 64 * dt;
                        const s4_t t0 = __builtin_amdgcn_ds_read_tr16_b64_v4i16((LAS s4_t*)ap);
                        const s4_t t1 = __builtin_amdgcn_ds_read_tr16_b64_v4i16((LAS s4_t*)(ap + 8 * AT_VSTR));
                        typedef short s8_t __attribute__((ext_vector_type(8)));
                        const s8_t a8 = __builtin_shufflevector(t0, t1, 0, 1, 2, 3, 4, 5, 6, 7);
                        O[dt] = __builtin_amdgcn_mfma_f32_32x32x16_f16(__builtin_bit_cast(h8_t, a8), pb, O[dt], 0, 0, 0);
                    }
                }
        }
        if (VAR == 1) {
            if (st <= st_hi_w && !wdone) wdone = (__ballot(carry < -100.f) == ~0ull);
            if (lane == 0) *(LAS unsigned*)(lds + 2 * AT_STAGE + 32 * (st & 1) + 4 * wid) = wdone ? 1u : 0u;
        }
        if (st > 0) { AT_WRITE(cur ^ 1); }
        mw = mwn;
        __syncthreads();
        cur ^= 1;
        if (VAR == 1) {
            unsigned alld = 1u;
#pragma unroll
            for (int w = 0; w < NWAVES; ++w) alld &= *(const LAS unsigned*)(lds + 2 * AT_STAGE + 32 * (st & 1) + 4 * w);
            if (alld) break;
        }
    }
#undef AT_LOAD
#undef AT_WRITE
    float inv = 1.f;
    if (VAR != 1) { const float lt = l_run + __shfl_xor(l_run, 32); inv = 1.f / lt; }
    float ss = 0.f;
#pragma unroll
    for (int dt = 0; dt < 4; ++dt)
#pragma unroll
        for (int r = 0; r < 16; ++r) { const float v = O[dt][r] * inv; O[dt][r] = v; ss += v * v; }
    ss += __shfl_xor(ss, 32);
    const float rstd = rsqrtf(ss * (1.f / HD) + EPS);
    f16* yp = (f16*)(p.ws + WS_Y) + grow * DM + hh * HD + 4 * hf;
    const float* gp = ong + hh * HD + 4 * hf;
#pragma unroll
    for (int dt = 0; dt < 4; ++dt)
#pragma unroll
        for (int g = 0; g < 4; ++g) {
            const f32x4 gg = *(const f32x4*)(gp + 32 * dt + 8 * g);
            u32x2 w; w.x = pack_h2(O[dt][4 * g] * rstd * gg[0], O[dt][4 * g + 1] * rstd * gg[1]); w.y = pack_h2(O[dt][4 * g + 2] * rstd * gg[2], O[dt][4 * g + 3] * rstd * gg[3]);
            *(u32x2*)(yp + 32 * dt + 8 * g) = w;
        }
}

__device__ __forceinline__ void phase_attn2(const Params& p, LAS unsigned char* lds, const float* ong, unsigned* queue) {
    for (;;) {
        __syncthreads();
        if (threadIdx.x == 0) *(LAS unsigned*)(lds + 2 * AT_STAGE + 96) = __hip_atomic_fetch_add(queue, 1u, __ATOMIC_RELAXED, __HIP_MEMORY_SCOPE_AGENT);
        __syncthreads();
        const int idx = (int)*(const LAS unsigned*)(lds + 2 * AT_STAGE + 96);
        if (idx >= NB * NHEADS * 8) break;
        int qt, b, hh;
        if (idx < 704) { qt = 7 - idx / 88; const int r = idx % 88; b = r / 11; const int h11 = r % 11; hh = h11 < HA ? h11 : h11 + HB; }
        else { const int r = idx - 704; qt = 7 - r / 40; b = (r % 40) / 5; hh = HA + (r % 5); }
        if (hh < HA) attn_item<0>(p, lds, ong, b, hh, qt, C_QA + hh * HD, C_KA, C_VA);
        else if (hh < HA + HB) attn_item<1>(p, lds, ong, b, hh, qt, C_QB + (hh - HA) * HD, C_KB + (hh - HA) * HD, C_VB + (hh - HA) * HD);
        else attn_item<2>(p, lds, ong, b, hh, qt, C_QC + (hh - HA - HB) * HD, C_KC + (hh - HA - HB) * HD, C_VC + (hh - HA - HB) * HD);
    }
}

#define CE_DESC(a, b) do { const unsigned _x = (a) > (b) ? (a) : (b), _y = (a) > (b) ? (b) : (a); (a) = _x; (b) = _y; } while (0)
__device__ __forceinline__ void sort16_desc(unsigned (&k)[16]) {
#pragma unroll
    for (int kk = 2; kk <= 16; kk <<= 1)
#pragma unroll
        for (int j = kk >> 1; j > 0; j >>= 1)
#pragma unroll
            for (int i = 0; i < 16; ++i) { const int l = i ^ j; if (l > i) { if ((i & kk) == 0) CE_DESC(k[i], k[l]); else CE_DESC(k[l], k[i]); } }
}
__device__ __forceinline__ void merge16_desc(unsigned (&a)[16], const unsigned (&b)[16]) {
#pragma unroll
    for (int i = 0; i < 16; ++i) a[i] = a[i] > b[15 - i] ? a[i] : b[15 - i];
#pragma unroll
    for (int j = 8; j > 0; j >>= 1)
#pragma unroll
        for (int i = 0; i < 16; ++i) { const int l = i ^ j; if (l > i) CE_DESC(a[i], a[l]); }
}
__device__ __forceinline__ unsigned f2sort(float f) { const unsigned b = __float_as_uint(f); return b ^ ((unsigned)((int)b >> 31) | 0x80000000u); }
__device__ __forceinline__ float sort2f(unsigned u) { const unsigned b = (u & 0x80000000u) ? (u ^ 0x80000000u) : ~u; return __uint_as_float(b); }
constexpr int RT_STR = 272;
__device__ __forceinline__ void phase_route2(const Params& p, LAS unsigned char* lds, const f16* subk) {
    const f16* qp = (const f16*)(p.ws + WS_Y);
    unsigned* pe = (unsigned*)(p.ws + WS_PE); float* pg = (float*)(p.ws + WS_PG);
    const int tid = otid(), wid = __builtin_amdgcn_readfirstlane(tid >> 6), lane = tid & 63, qn = lane & 31, hf = lane >> 5;
    for (int item = obid(); item < 256; item += gridDim.x) {
        const int hp = item & 7, tg = item >> 3;
        __syncthreads();
        {
            const f16* src = subk + (size_t)hp * 256 * 128;
#pragma unroll
            for (int i = 0; i < 8; ++i) { const int e = tid + i * 512, r = e >> 4, c = e & 15; *(LAS u32x4*)(lds + r * RT_STR + 16 * c) = *(const u32x4*)(src + r * 128 + 8 * c); }
        }
        __syncthreads();
#pragma unroll 1
        for (int it = 0; it < 2; ++it) {
            const int t = (tg * 16 + wid * 2 + it) * 32 + qn;
            unsigned top[2][16];
#pragma unroll
            for (int c = 0; c < 2; ++c) {
                h8_t Bq[8];
                const f16* qrow = qp + (size_t)t * DM + hp * 256 + c * 128 + 8 * hf;
#pragma unroll
                for (int ks = 0; ks < 8; ++ks) Bq[ks] = *(const h8_t*)(qrow + 16 * ks);
                unsigned run[16];
#pragma unroll 1
                for (int nt = 0; nt < 4; ++nt) {
                    f32x16 S;
#pragma unroll
                    for (int r = 0; r < 16; ++r) S[r] = 0.f;
#pragma unroll
                    for (int ks = 0; ks < 8; ++ks) {
                        const h8_t a = *(const LAS h8_t*)(lds + (c * 128 + nt * 32 + qn) * RT_STR + 32 * ks + 16 * hf);
                        S = __builtin_amdgcn_mfma_f32_32x32x16_f16(a, Bq[ks], S, 0, 0, 0);
                    }
                    unsigned k[16];
#pragma unroll
                    for (int r = 0; r < 16; ++r) { const int n = 32 * nt + (r & 3) + 8 * (r >> 2) + 4 * hf; k[r] = (f2sort(S[r]) & ~127u) | (unsigned)(127 - n); }
                    sort16_desc(k);
                    if (nt == 0) {
#pragma unroll
                        for (int r = 0; r < 16; ++r) run[r] = k[r];
                    } else merge16_desc(run, k);
                }
#pragma unroll
                for (int r = 0; r < 16; ++r) top[c][r] = run[r];
            }
            unsigned mine[16], oth[16];
#pragma unroll
            for (int r = 0; r < 16; ++r) { const unsigned send = hf ? top[0][r] : top[1][r]; oth[r] = __shfl_xor(send, 32); mine[r] = hf ? top[1][r] : top[0][r]; }
            merge16_desc(mine, oth);
            unsigned ka[16], kb2[16];
#pragma unroll
            for (int r = 0; r < 16; ++r) { const unsigned o = __shfl_xor(mine[r], 32); ka[r] = hf ? o : mine[r]; kb2[r] = hf ? mine[r] : o; }
            float sa[16], sb[16]; unsigned na[4] = {0u, 0u, 0u, 0u}, nb[4] = {0u, 0u, 0u, 0u};
#pragma unroll
            for (int r = 0; r < 16; ++r) {
                sa[r] = sort2f(ka[r] & ~127u); sb[r] = sort2f(kb2[r] & ~127u);
                na[r >> 2] |= (127u - (ka[r] & 127u)) << (8 * (r & 3)); nb[r >> 2] |= (127u - (kb2[r] & 127u)) << (8 * (r & 3));
            }
            unsigned cand[4][16];
#pragma unroll
            for (int g = 0; g < 4; ++g)
#pragma unroll
                for (int r = 0; r < 16; ++r) cand[g][r] = 0u;
#pragma unroll
            for (int slot = 0; slot < 50; ++slot) {
                constexpr unsigned char CIJ[64] = {0, 1, 2, 3, 4, 5, 6, 7, 8, 9, 10, 11, 12, 13, 14, 15, 16, 17, 18, 19, 20, 21, 22, 23, 32, 33, 34, 35, 36, 48, 49, 50, 51, 64, 65, 66, 80, 81, 96, 97, 112, 113, 128, 144, 160, 176, 192, 208, 224, 240, 255, 255, 255, 255, 255, 255, 255, 255, 255, 255, 255, 255, 255, 255};
                const int ij = CIJ[slot], i = ij >> 4, j = ij & 15;
                cand[slot >> 4][slot & 15] = (f2sort(sa[i] + sb[j]) & ~255u) | (unsigned)(255 - ij);
            }
#pragma unroll
            for (int g = 1; g < 4; ++g) sort16_desc(cand[g]);
            merge16_desc(cand[0], cand[1]); merge16_desc(cand[2], cand[3]); merge16_desc(cand[0], cand[2]);
            float ex[16]; float sum = 0.f;
            const float mx = sort2f(cand[0][0] & ~255u);
#pragma unroll
            for (int r = 0; r < 16; ++r) { ex[r] = __expf(sort2f(cand[0][r] & ~255u) - mx); sum += ex[r]; }
            const float inv = 1.f / sum;
            unsigned eo[16];
#pragma unroll
            for (int r = 0; r < 16; ++r) {
                const unsigned id = 255u - (cand[0][r] & 255u), i = id >> 4, j = id & 15u;
                const unsigned wa = (i & 8u) ? ((i & 4u) ? na[3] : na[2]) : ((i & 4u) ? na[1] : na[0]);
                const unsigned wb = (j & 8u) ? ((j & 4u) ? nb[3] : nb[2]) : ((j & 4u) ? nb[1] : nb[0]);
                eo[r] = ((wa >> (8 * (i & 3u))) & 255u) * PNK + ((wb >> (8 * (j & 3u))) & 255u);
                ex[r] *= inv;
            }
            if (hf == 0) {
#pragma unroll
                for (int r4 = 0; r4 < 4; ++r4) { u32x4 w; w.x = eo[4 * r4]; w.y = eo[4 * r4 + 1]; w.z = eo[4 * r4 + 2]; w.w = eo[4 * r4 + 3]; *(u32x4*)(pe + (size_t)t * 128 + hp * 16 + 4 * r4) = w; }
            } else {
#pragma unroll
                for (int r4 = 0; r4 < 4; ++r4) { f32x4 w; w[0] = ex[4 * r4]; w[1] = ex[4 * r4 + 1]; w[2] = ex[4 * r4 + 2]; w[3] = ex[4 * r4 + 3]; *(f32x4*)(pg + (size_t)t * 128 + hp * 16 + 4 * r4) = w; }
            }
        }
    }
}

#ifndef EXU_NR
#define EXU_NR 8
#define EXU_SH 11
#endif
__device__ __forceinline__ float gelu_as(float v) {
    const float av = fabsf(v), t = __builtin_amdgcn_rcpf(av * 0.2316418882f + 1.0f);
    float q = t * 0.5307027145f + (-0.7265760135f); q = q * t + 0.7107068705f; q = q * t + (-0.142248368f); q = q * t + 0.127414796f; q = q * t;
    const float e = __builtin_amdgcn_exp2f((v * v) * (-0.72134752044f));
    const float m = v * (q * e);
    return v < 0.f ? m : v - m;
}
__device__ __forceinline__ int row16_sum(int d) {
    d += __builtin_amdgcn_update_dpp(0, d, 0xB1, 0xF, 0xF, true);
    d += __builtin_amdgcn_update_dpp(0, d, 0x4E, 0xF, 0xF, true);
    d += __builtin_amdgcn_update_dpp(0, d, 0x141, 0xF, 0xF, true);
    d += __builtin_amdgcn_update_dpp(0, d, 0x140, 0xF, 0xF, true);
    return d;
}
__device__ __forceinline__ unsigned xcc_id() { return (unsigned)__builtin_amdgcn_s_getreg((3 << 11) | 20) & 0xFu; }
template <int BITS>
__device__ __forceinline__ void phase_exu(const Params& p, LAS unsigned char* lds, const unsigned char* u8, const float* su, const float* sv) {
    const int tid = otid(), wid = __builtin_amdgcn_readfirstlane(tid >> 6), lane = tid & 63, sub = lane & 15, qd = lane >> 4;
    const unsigned* pe = (const unsigned*)(p.ws + WS_PE); const float* pg = (const float*)(p.ws + WS_PG);
    const unsigned char* h8 = (const unsigned char*)(p.ws + WS_H8); const float* shv = (const float*)(p.ws + WS_SH);
    unsigned* list = (unsigned*)(p.ws + WS_LIST);
    const unsigned* ctl = (const unsigned*)(p.ws + WS_CTL);
    const unsigned myx = *(const LAS unsigned*)(lds + LDS_BYTES - 16), mybi = *(const LAS unsigned*)(lds + LDS_BYTES - 12);
    int G = 0, g = 0, nb = 1;
#pragma unroll
    for (int j = 0; j < 16; ++j) { const unsigned c = __builtin_amdgcn_readfirstlane(__hip_atomic_load(ctl + j, __ATOMIC_RELAXED, __HIP_MEMORY_SCOPE_AGENT)); if (c > 0u) { if ((unsigned)j < myx) ++g; ++G; } if ((unsigned)j == myx) nb = (int)c; }
    const int tstep = nb * NWAVES, tfirst = (int)mybi * NWAVES + wid;
    const int nvis_t = (tfirst < NT) ? (NT - tfirst + tstep - 1) / tstep : 0;
    const int nrange = (EXU_NR - g + G - 1) / G;
    const int nvis = nvis_t * nrange;
    const int* hsv = (const int*)(p.ws + WS_HS);
    unsigned ne0 = 0u, ne1 = 0u; u32x4 nhv[8]; float nsh = 0.f; int nhs = 0;
#define EXU_FETCH(v_) do { const int tt_ = tfirst + ((v_) % nvis_t) * tstep; ne0 = pe[(size_t)tt_ * 128 + lane]; ne1 = pe[(size_t)tt_ * 128 + 64 + lane]; \
        _Pragma("unroll") for (int m = 0; m < 8; ++m) nhv[m] = *(const u32x4*)(h8 + (size_t)tt_ * DM + (BITS == 8 ? 256 * m + 16 * sub : 512 * (m >> 1) + 32 * sub + 16 * (m & 1))); nsh = shv[tt_]; if (BITS == 4) nhs = hsv[tt_]; } while (0)
    if (nvis > 0) EXU_FETCH(0);
    for (int v = 0; v < nvis; ++v) {
        const int t = tfirst + (v % nvis_t) * tstep, r = g + (v / nvis_t) * G;
        const unsigned e0 = ne0, e1 = ne1; const float sht = nsh; const int hs8 = 8 * nhs;
        u32x4 hv[8];
#pragma unroll
        for (int m = 0; m < 8; ++m) hv[m] = nhv[m];
        if (v + 1 < nvis) EXU_FETCH(v + 1);
        const bool in0 = (int)(e0 >> EXU_SH) == r, in1 = (int)(e1 >> EXU_SH) == r;
        const unsigned long long m0 = __ballot(in0), m1 = __ballot(in1);
        const int n0 = __builtin_popcountll(m0), n = n0 + __builtin_popcountll(m1);
        if (n == 0) continue;
        LAS unsigned* wl = (LAS unsigned*)(lds + wid * 1024 + (v & 1) * 512);
        const unsigned long long below = (1ull << lane) - 1ull;
        if (in0) wl[__builtin_popcountll(m0 & below)] = ((unsigned)lane << 16) | e0;
        if (in1) wl[n0 + __builtin_popcountll(m1 & below)] = ((unsigned)(lane + 64) << 16) | e1;
        __builtin_amdgcn_wave_barrier();
        constexpr int PPI = 4;
        constexpr int PPQ = PPI / 4, NLD = (BITS == 8) ? 8 : 4;
        const int nit = (n + PPI - 1) / PPI;
        u32x4 wb[2][8]; unsigned entb[2][PPQ]; float sub_[2][PPQ], svb_[2][PPQ], pgb_[2][PPQ];
#define EXU_ISSUE(B_, it_) do { _Pragma("unroll") for (int pp = 0; pp < PPQ; ++pp) { const int idx_ = (it_) * PPI + qd * PPQ + pp; entb[B_][pp] = wl[idx_ < n ? idx_ : 0]; \
            sub_[B_][pp] = su[entb[B_][pp] & 0xffffu]; svb_[B_][pp] = sv[entb[B_][pp] & 0xffffu]; pgb_[B_][pp] = pg[(size_t)t * 128 + (entb[B_][pp] >> 16)]; \
            const unsigned char* row_ = u8 + (size_t)(entb[B_][pp] & 0xffffu) * (BITS == 8 ? DM : DM / 2) + 16 * sub; \
            _Pragma("unroll") for (int m = 0; m < NLD; ++m) wb[B_][pp * NLD + m] = *(const u32x4*)(row_ + 256 * m); } } while (0)
#define EXU_COMPUTE(B_, it_) do { _Pragma("unroll") for (int pp = 0; pp < PPQ; ++pp) { int d_ = 0; \
            if (BITS == 8) { \
            _Pragma("unroll") for (int m = 0; m < 8; ++m) { const u32x4 w_ = wb[B_][m]; \
                d_ = __builtin_amdgcn_sdot4((int)hv[m].x, (int)w_.x, d_, false); d_ = __builtin_amdgcn_sdot4((int)hv[m].y, (int)w_.y, d_, false); \
                d_ = __builtin_amdgcn_sdot4((int)hv[m].z, (int)w_.z, d_, false); d_ = __builtin_amdgcn_sdot4((int)hv[m].w, (int)w_.w, d_, false); } \
            } else { \
            _Pragma("unroll") for (int m = 0; m < 4; ++m) { const u32x4 w_ = wb[B_][pp * 4 + m]; const u32x4 ha_ = hv[2 * m], hb_ = hv[2 * m + 1]; \
                d_ = __builtin_amdgcn_sdot4((int)ha_.x, (int)(w_.x & 0x0F0F0F0Fu), d_, false); d_ = __builtin_amdgcn_sdot4((int)ha_.y, (int)((w_.x >> 4) & 0x0F0F0F0Fu), d_, false); \
                d_ = __builtin_amdgcn_sdot4((int)ha_.z, (int)(w_.y & 0x0F0F0F0Fu), d_, false); d_ = __builtin_amdgcn_sdot4((int)ha_.w, (int)((w_.y >> 4) & 0x0F0F0F0Fu), d_, false); \
                d_ = __builtin_amdgcn_sdot4((int)hb_.x, (int)(w_.z & 0x0F0F0F0Fu), d_, false); d_ = __builtin_amdgcn_sdot4((int)hb_.y, (int)((w_.z >> 4) & 0x0F0F0F0Fu), d_, false); \
                d_ = __builtin_amdgcn_sdot4((int)hb_.z, (int)(w_.w & 0x0F0F0F0Fu), d_, false); d_ = __builtin_amdgcn_sdot4((int)hb_.w, (int)((w_.w >> 4) & 0x0F0F0F0Fu), d_, false); } \
            } \
            d_ = row16_sum(d_); \
            if (BITS == 4) d_ -= hs8; \
            if (((it_) * PPI + qd * PPQ + pp < n) && sub == 0) { \
                const unsigned ent_ = entb[B_][pp], j_ = ent_ >> 16, e_ = ent_ & 0xffffu; \
                const float dd_ = (float)d_ * sub_[B_][pp] * sht; \
                const float act_ = gelu_as(dd_); \
                const float coef_ = pgb_[B_][pp] * svb_[B_][pp] * act_ * (1024.f * 256.f); \
                const int ci_ = (int)rintf(fminf(fmaxf(coef_, -32767.f), 32767.f)); \
                list[((size_t)(j_ >> 2) * NT + t) * 4 + (j_ & 3u)] = e_ | ((unsigned)ci_ << 16); } } } while (0)
        EXU_ISSUE(0, 0);
        int it = 0;
        for (; it + 2 < nit; it += 2) {
            EXU_ISSUE(1, it + 1); EXU_COMPUTE(0, it);
            EXU_ISSUE(0, it + 2); EXU_COMPUTE(1, it + 1);
        }
        if (it + 2 == nit) { EXU_ISSUE(1, it + 1); EXU_COMPUTE(0, it); EXU_COMPUTE(1, it + 1); }
        else { EXU_COMPUTE(0, it); }
#undef EXU_ISSUE
#undef EXU_COMPUTE
    }
#undef EXU_FETCH
}

__device__ __forceinline__ void phase_exv(const Params& p, LAS unsigned char* lds, const f16* x1, const float* gate2, const unsigned char* v8c, f16* xout) {
    const int tid = otid();
    const u32x4* list = (const u32x4*)(p.ws + WS_LIST);
    int cfirst = obid(), cstep = gridDim.x;
    {
        const unsigned* ctl = (const unsigned*)(p.ws + WS_CTL);
        const unsigned myx = *(const LAS unsigned*)(lds + LDS_BYTES - 16), mybi = *(const LAS unsigned*)(lds + LDS_BYTES - 12);
        int G = 0, g = 0, nb = 1; bool uniform = true; unsigned c0 = 0u;
#pragma unroll
        for (int j = 0; j < 16; ++j) { const unsigned c = __builtin_amdgcn_readfirstlane(__hip_atomic_load(ctl + j, __ATOMIC_RELAXED, __HIP_MEMORY_SCOPE_AGENT)); if (c > 0u) { if ((unsigned)j < myx) ++g; ++G; if (c0 == 0u) c0 = c; else if (c != c0) uniform = false; } if ((unsigned)j == myx) nb = (int)c; }
        if (uniform && G * nb == (int)gridDim.x && (int)gridDim.x == 256) { cfirst = g * nb + (int)mybi; cstep = 256; }
    }
    for (int c = cfirst; c < 256; c += cstep) {
        __syncthreads();
        {
            const u32x4* src = (const u32x4*)(v8c + (size_t)c * PEXP * 8);
#pragma unroll 4
            for (int i = 0; i < 16; ++i) *(LAS u32x4*)(lds + (size_t)(i * 512 + tid) * 16) = src[i * 512 + tid];
        }
        __syncthreads();
        typedef short s2_t __attribute__((ext_vector_type(2)));
        u32x4 wq[2][8];
        int acc[8]; int csum = 0;
#pragma unroll
        for (int k = 0; k < 8; ++k) acc[k] = 0;
        constexpr int NBATCH = (NT / NTHREADS) * 4;
#define EXV_LOAD(B_, q_) do { const int qq_ = (q_) < NBATCH ? (q_) : NBATCH - 1; const int t_ = tid + (qq_ >> 2) * NTHREADS, jb_ = qq_ & 3; \
            _Pragma("unroll") for (int j4 = 0; j4 < 8; ++j4) wq[B_][j4] = list[(size_t)(jb_ * 8 + j4) * NT + t_]; } while (0)
        EXV_LOAD(0, 0);
#pragma unroll 1
        for (int q0 = 0; q0 < NBATCH; q0 += 4) {
#pragma unroll
            for (int u = 0; u < 4; ++u) {
                const int q = q0 + u;
                if (q < NBATCH) {
                    EXV_LOAD((u + 1) % 2, q + 1);
#pragma unroll
                    for (int j4 = 0; j4 < 8; ++j4) {
                        const unsigned dd[4] = {wq[u % 2][j4].x, wq[u % 2][j4].y, wq[u % 2][j4].z, wq[u % 2][j4].w};
#pragma unroll
                        for (int h = 0; h < 2; ++h) {
                            const unsigned d0 = dd[2 * h], d1 = dd[2 * h + 1];
                            const u32x2 v0 = *(const LAS u32x2*)(lds + (d0 & 0xffffu) * 8), v1 = *(const LAS u32x2*)(lds + (d1 & 0xffffu) * 8);
                            const s2_t cp = __builtin_bit_cast(s2_t, __builtin_amdgcn_perm(d1, d0, 0x07060302u));
                            csum = __builtin_amdgcn_sdot2(cp, __builtin_bit_cast(s2_t, 0x00010001u), csum, false);
                            acc[0] = __builtin_amdgcn_sdot2(cp, __builtin_bit_cast(s2_t, __builtin_amdgcn_perm(v1.x, v0.x, 0x0c040c00u)), acc[0], false);
                            acc[1] = __builtin_amdgcn_sdot2(cp, __builtin_bit_cast(s2_t, __builtin_amdgcn_perm(v1.x, v0.x, 0x0c050c01u)), acc[1], false);
                            acc[2] = __builtin_amdgcn_sdot2(cp, __builtin_bit_cast(s2_t, __builtin_amdgcn_perm(v1.x, v0.x, 0x0c060c02u)), acc[2], false);
                            acc[3] = __builtin_amdgcn_sdot2(cp, __builtin_bit_cast(s2_t, __builtin_amdgcn_perm(v1.x, v0.x, 0x0c070c03u)), acc[3], false);
                            acc[4] = __builtin_amdgcn_sdot2(cp, __builtin_bit_cast(s2_t, __builtin_amdgcn_perm(v1.y, v0.y, 0x0c040c00u)), acc[4], false);
                            acc[5] = __builtin_amdgcn_sdot2(cp, __builtin_bit_cast(s2_t, __builtin_amdgcn_perm(v1.y, v0.y, 0x0c050c01u)), acc[5], false);
                            acc[6] = __builtin_amdgcn_sdot2(cp, __builtin_bit_cast(s2_t, __builtin_amdgcn_perm(v1.y, v0.y, 0x0c060c02u)), acc[6], false);
                            acc[7] = __builtin_amdgcn_sdot2(cp, __builtin_bit_cast(s2_t, __builtin_amdgcn_perm(v1.y, v0.y, 0x0c070c03u)), acc[7], false);
                        }
                    }
                    if ((u & 3) == 3) {
                        const int t = tid + (q >> 2) * NTHREADS;
                        const int b = t / SEQ, col = 8 * c;
                        const int off = csum << 7;
                        const u32x4 xw = *(const u32x4*)(x1 + (size_t)t * DM + col);
                        const unsigned xws[4] = {xw.x, xw.y, xw.z, xw.w};
                        u32x4 ow; unsigned ows[4];
#pragma unroll
                        for (int hfi = 0; hfi < 2; ++hfi) {
                            const f32x4 gt = *(const f32x4*)(gate2 + (size_t)b * 6 * DM + col + 4 * hfi);
                            float r[4];
#pragma unroll
                            for (int k = 0; k < 4; ++k) { const unsigned xx = xws[2 * hfi + (k >> 1)]; const float xi = (k & 1) ? h_hi(xx) : h_lo(xx); r[k] = xi + gt[k] * ((float)(acc[4 * hfi + k] - off) * (1.f / (1024.f * 256.f))); }
                            ows[2 * hfi] = pack_h2(r[0], r[1]); ows[2 * hfi + 1] = pack_h2(r[2], r[3]);
                        }
                        ow.x = ows[0]; ow.y = ows[1]; ow.z = ows[2]; ow.w = ows[3];
                        *(u32x4*)(xout + (size_t)t * DM + col) = ow;
                        csum = 0;
#pragma unroll
                        for (int k = 0; k < 8; ++k) acc[k] = 0;
                    }
                }
            }
        }
#undef EXV_LOAD
    }
}

#define XB_TMO      128
#define XB_XCNT(j)  (256  + 64 * (j))
#define XB_XSUB(j)  (1280 + 64 * (j))
#define XB_XGEN(j)  (2304 + 64 * (j))
#define XB_TOP      3328
#define XB_TOPGEN   3392
#define XCD_BAR_WORDS 3456
#define XB_SPIN_CAP (1u << 22)
__device__ __forceinline__ unsigned xb_ld(unsigned* p) { return __hip_atomic_load(p, __ATOMIC_RELAXED, __HIP_MEMORY_SCOPE_AGENT); }
__device__ __forceinline__ unsigned xb_add(unsigned* p, unsigned v) { return __hip_atomic_fetch_add(p, v, __ATOMIC_RELAXED, __HIP_MEMORY_SCOPE_AGENT); }
#define XB_SPIN(cond, bar) do { unsigned _sp = 0; while (cond) { __builtin_amdgcn_s_sleep(1); \
    if ((++_sp & 255u) == 0u) { if (xb_ld(&(bar)[XB_TMO])) break; if (_sp > XB_SPIN_CAP) { atomicAdd(&(bar)[XB_TMO], 1u); break; } } } } while (0)
struct XcdBarrier { unsigned* bar; unsigned x; volatile LAS unsigned* st; };
__device__ __forceinline__ void xcd_barrier_complete(unsigned* bar, unsigned x, unsigned& nloc, unsigned& nx) {
    const unsigned G = gridDim.x * gridDim.y * gridDim.z;
    unsigned sum, cnt, mine, sp = 0u;
    for (;;) {
        sum = 0u; cnt = 0u; mine = 0u;
#pragma unroll
        for (unsigned j = 0; j < 16; ++j) { const unsigned c = xb_ld(&bar[XB_XCNT(j)]); sum += c; cnt += (c > 0u) ? 1u : 0u; mine = (j == x) ? c : mine; }
        if (sum == G) break;
        __builtin_amdgcn_s_sleep(1);
        if ((++sp & 255u) == 0u) { if (xb_ld(&bar[XB_TMO])) break; if (sp > XB_SPIN_CAP) { atomicAdd(&bar[XB_TMO], 1u); break; } }
    }
    nloc = mine > 0u ? mine : 1u; nx = cnt > 0u ? cnt : 1u;
}
__device__ __forceinline__ void xcd_barrier(const XcdBarrier& b) {
    asm volatile("s_waitcnt vmcnt(0)" ::: "memory");
    __syncthreads();
    if (threadIdx.x == 0) {
        unsigned* bar = b.bar;
        __builtin_amdgcn_s_waitcnt(0);
        unsigned nloc = b.st[0], nx = b.st[1];
        if (nloc == 0u) { xcd_barrier_complete(bar, b.x, nloc, nx); b.st[0] = nloc; b.st[1] = nx; }
        const unsigned old = xb_add(&bar[XB_XSUB(b.x)], 1u);
        const unsigned gen = old / nloc;
        if (old + 1u == (gen + 1u) * nloc) {
            __builtin_amdgcn_fence(__ATOMIC_RELEASE, "agent");
            asm volatile("s_waitcnt vmcnt(0)" ::: "memory");
            const unsigned og = xb_add(&bar[XB_TOP], 1u);
            const unsigned tg = og / nx;
            if (og + 1u == (tg + 1u) * nx) xb_add(&bar[XB_TOPGEN], 1u);
            else XB_SPIN(xb_ld(&bar[XB_TOPGEN]) == tg, bar);
            __builtin_amdgcn_fence(__ATOMIC_ACQUIRE, "agent");
            xb_add(&bar[XB_XGEN(b.x)], 1u);
            asm volatile("s_waitcnt vmcnt(0)" ::: "memory");
        } else {
            XB_SPIN(xb_ld(&bar[XB_XGEN(b.x)]) == gen, bar);
            __builtin_amdgcn_fence(__ATOMIC_ACQUIRE, "agent");
            asm volatile("s_waitcnt vmcnt(0)" ::: "memory");
        }
    }
    __syncthreads();
}

constexpr int PH_CONV = 0, PH_N1 = 1, PH_L0 = 2, PH_PER_LAYER = 10, PH_TOTAL = PH_L0 + DEPTH * PH_PER_LAYER;

__global__ void __launch_bounds__(NTHREADS, 2) mega(Params p_arg) {
    extern __shared__ __attribute__((aligned(16))) unsigned char shm[];
    LAS unsigned char* lds = (LAS unsigned char*)shm;
    typedef const Params __attribute__((address_space(4)))* KP;
    const int ph_lo = p_arg.ph_lo, ph_hi = p_arg.ph_hi;
    if (threadIdx.x == 0) {
        const unsigned x = xcc_id();
        const unsigned bi = __hip_atomic_fetch_add((unsigned*)(p_arg.ws + WS_CTL) + x, 1u, __ATOMIC_RELAXED, __HIP_MEMORY_SCOPE_AGENT);
        *(LAS unsigned*)(lds + LDS_BYTES - 16) = x; *(LAS unsigned*)(lds + LDS_BYTES - 12) = bi;
        *(LAS unsigned*)(lds + LDS_BYTES - 32) = 0u; *(LAS unsigned*)(lds + LDS_BYTES - 28) = 0u;
        (void)xb_add((unsigned*)(p_arg.ws + WS_CTL + 256) + XB_XCNT(x), 1u);
    }
    __syncthreads();
    XcdBarrier xbar; xbar.bar = (unsigned*)(p_arg.ws + WS_CTL + 256); xbar.x = *(const LAS unsigned*)(lds + LDS_BYTES - 16); xbar.st = (volatile LAS unsigned*)(lds + LDS_BYTES - 32);
#ifndef PMASK
#define PMASK 0xff
#endif
#define EN(k) ((PMASK >> (k)) & 1)
    for (int ph = ph_lo; ph < ph_hi; ++ph) {
        KP kp = (KP)__builtin_amdgcn_kernarg_segment_ptr();
        asm volatile("" : "+s"(kp));
#if defined(__HIP_DEVICE_COMPILE__)
        const Params p = *kp;
#else
        const Params p = p_arg;
#endif
        unsigned char* ws = p.ws;
        const float* mod = (const float*)(ws + WS_MOD);
        int kind, l = 0, s = -1;
        if (ph == PH_CONV) kind = 0;
        else if (ph == PH_N1) kind = 1;
        else {
            l = (ph - PH_L0) / PH_PER_LAYER; s = (ph - PH_L0) % PH_PER_LAYER;
            kind = (s == 0 || s == 3 || s == 5) ? 2 : (s == 1 ? 4 : (s == 2 ? 5 : (s == 4 ? 1 : (s == 6 ? 6 : (s == 7 ? 7 : (s == 8 ? 8 : 9))))));
        }
        const float* modl = mod + (size_t)l * NB * 6 * DM;
        f16* x1 = (f16*)(ws + WS_X1); f16* x2 = (f16*)(ws + WS_X2);
#ifndef REPEAT_KIND
#define REPEAT_KIND -1
#endif
        for (int rep = 0; rep < ((kind == REPEAT_KIND) ? 2 : 1); ++rep) {
        if (rep == 1) xcd_barrier(xbar);
        if (kind == 0) { if (EN(0)) phase_conv(p, lds); }
        else if (kind == 1) {
            if (EN(1)) {
                if (s < 0) phase_norm2<0, false>(p.x, nullptr, nullptr, p.n1g, mod + 0 * DM, mod + 1 * DM, (f16*)(ws + WS_H), nullptr, nullptr);
                else phase_norm2<1, true>(nullptr, x1, nullptr, p.n2g + (size_t)l * DM, modl + 3 * DM, modl + 4 * DM, (f16*)(ws + WS_H), (unsigned*)(ws + WS_H8), (float*)(ws + WS_SH));
            }
        } else if (kind == 2) {
            if (EN(2)) {
                Epi E{}; const f16* A; const f16* Bt; int N;
                if (s == 0) { E.mode = 2; E.rope128 = (const float*)(ws + WS_ROPE128); E.rope64 = (const float*)(ws + WS_ROPE64); E.o16 = (f16*)(ws + WS_PROJ); E.ldc = INWP; A = (const f16*)(ws + WS_H); Bt = (const f16*)(ws + WS_WTIN) + (size_t)l * INWP * DM; N = INWP; }
                else if (s == 3) { E.mode = 1; E.o16 = x1; E.xin = p.x; E.xinh = l == 0 ? nullptr : x2; E.gate = modl + 2 * DM; A = (const f16*)(ws + WS_Y); Bt = (const f16*)(ws + WS_WTOUT) + (size_t)l * DM * DM; N = DM; }
                else { E.mode = 0; E.o16 = (f16*)(ws + WS_Y); E.ldc = DM; A = (const f16*)(ws + WS_H); Bt = (const f16*)(ws + WS_WTQ) + (size_t)l * DM * DM; N = DM; }
                gemm_run(p, lds, A, Bt, N, E);
            }
        }
        else if (kind == 4) { if (EN(4)) phase_index2(p, lds); }
        else if (kind == 5) { if (EN(5)) phase_attn2(p, lds, p.ong + (size_t)l * DM, (unsigned*)(ws + WS_CTL + 64) + l); }
        else if (kind == 6) { if (EN(6)) phase_route2(p, lds, (const f16*)(ws + WS_SUBK) + (size_t)l * PH * 2 * PNK * 128); }
        else if (kind == 7) {
            if (EN(7)) { if (l == DEPTH - 1 && LAST_BITS == 4) phase_exu<4>(p, lds, ws + WS_U8 + (size_t)l * PEXP * DM, (const float*)(ws + WS_SU) + (size_t)l * PEXP, (const float*)(ws + WS_SV) + (size_t)l * PEXP);
                         else phase_exu<8>(p, lds, ws + WS_U8 + (size_t)l * PEXP * DM, (const float*)(ws + WS_SU) + (size_t)l * PEXP, (const float*)(ws + WS_SV) + (size_t)l * PEXP); }
        } else if (kind == 8) {
            if (EN(7)) phase_exv(p, lds, x1, modl + 5 * DM, ws + WS_V8 + (size_t)l * PEXP * DM, x2);
        } else {
            const bool fin = (l == DEPTH - 1);
            const float* modn = mod + (size_t)(fin ? l : l + 1) * NB * 6 * DM;
            if (EN(1)) { if (fin) phase_norm2<2, true>(nullptr, x2, p.out, p.fg, nullptr, nullptr, nullptr, nullptr, nullptr);
                         else phase_norm2<0, true>(nullptr, x2, nullptr, p.n1g + (size_t)(l + 1) * DM, modn + 0 * DM, modn + 1 * DM, (f16*)(ws + WS_H), nullptr, nullptr); }
        }
        }
        if (ph + 1 < ph_hi) { if (ph == ph_lo) cg::this_grid().sync(); else xcd_barrier(xbar); }
    }
}

extern "C" void kernel_launch(void* const* d_in, const int* in_sizes, int n_in, void* d_out, int out_size, void* d_ws, size_t ws_size, hipStream_t stream) {
    static int grid = 0;
    if (grid == 0) {
        if (n_in != 14 || out_size != NT * DM || ws_size < WS_END) { fprintf(stderr, "kernel_launch: unexpected sizes (n_in %d out %d ws %zu need %zu)\n", n_in, out_size, ws_size, (size_t)WS_END); grid = -1; return; }
        if (hipFuncSetAttribute((const void*)mega, hipFuncAttributeMaxDynamicSharedMemorySize, LDS_BYTES) != hipSuccess) { fprintf(stderr, "kernel_launch: hipFuncSetAttribute failed\n"); grid = -1; return; }
        int dev = 0, cus = 0, per_cu = 0;
        hipGetDevice(&dev); hipDeviceGetAttribute(&cus, hipDeviceAttributeMultiprocessorCount, dev);
        hipOccupancyMaxActiveBlocksPerMultiprocessor(&per_cu, (const void*)mega, NTHREADS, LDS_BYTES);
        if (per_cu < 1) { fprintf(stderr, "kernel_launch: occupancy query says %d blocks per CU\n", per_cu); grid = -1; return; }
        grid = cus;
    }
    if (grid < 0) return;
    Params p{};
    p.x = (const float*)d_in[0]; p.c = (const float*)d_in[1]; p.ada_w = (const float*)d_in[2]; p.ada_b = (const float*)d_in[3];
    p.n1g = (const float*)d_in[4]; p.n2g = (const float*)d_in[5]; p.w_in = (const float*)d_in[6]; p.ong = (const float*)d_in[7];
    p.w_out = (const float*)d_in[8]; p.wq = (const float*)d_in[9]; p.subk = (const float*)d_in[10]; p.pu = (const float*)d_in[11];
    p.pv = (const float*)d_in[12]; p.fg = (const float*)d_in[13];
    p.out = (float*)d_out; p.ws = (unsigned char*)d_ws;
#if 0
    for (int ph = 0; ph < PH_TOTAL; ++ph) {
        p.ph_lo = ph; p.ph_hi = ph + 1;
        hipLaunchKernelGGL(mega, dim3(grid), dim3(NTHREADS), LDS_BYTES, stream, p);
    }
#else
    p.ph_lo = 0; p.ph_hi = PH_TOTAL;
    if (hipMemsetAsync((char*)d_ws + WS_CTL, 0, CTL_BYTES, stream) != hipSuccess) { fprintf(stderr, "kernel_launch: memset of control words failed\n"); return; }
    void* args[] = {&p};
    hipError_t e = hipLaunchCooperativeKernel((const void*)mega, dim3(grid), dim3(NTHREADS), args, LDS_BYTES, stream);
    if (e != hipSuccess) fprintf(stderr, "cooperative launch failed: %s (grid %d)\n", hipGetErrorString(e), grid);
#endif
}
```

```cpp
#include <hip/hip_runtime.h>
#include <hip/hip_cooperative_groups.h>
#include <cstdio>
#include <cstdint>
namespace cg = cooperative_groups;

#define LAS __attribute__((address_space(3)))
typedef _Float16 f16;
typedef _Float16 h2_t __attribute__((ext_vector_type(2)));
typedef _Float16 h4_t __attribute__((ext_vector_type(4)));
typedef _Float16 h8_t __attribute__((ext_vector_type(8)));
typedef float f32x4 __attribute__((ext_vector_type(4)));
typedef unsigned u32x4 __attribute__((ext_vector_type(4)));
typedef unsigned u32x2 __attribute__((ext_vector_type(2)));

constexpr int NB = 8, SEQ = 2048, DM = 2048, NT = NB * SEQ, DEPTH = 2;
constexpr int HD = 128, HA = 6, HB = 5, HC = 5, NHEADS = 16;
constexpr int IH = 16, IDM = 64, DSA_TOPK = 256;
constexpr int MOBA_BLK = 256, MOBA_NB = 8;
constexpr int INW = 5968, INWP = 6144;
constexpr int PH = 8, PNK = 128, PTOPK = 16, PEXP = 16384;
constexpr float EPS = 1e-6f;
constexpr int C_QA = 0, C_KA = 768, C_VA = 896, C_IQ = 1024, C_IK = 2048, C_IW = 2112, C_QB = 2176, C_KB = 2816, C_VB = 3456,
              C_QC = 4096, C_KC = 4736, C_VC = 5376, C_END = 6016;

#ifndef LAST_BITS
#define LAST_BITS 8
#endif
constexpr int NTHREADS = 512, NWAVES = 8;
constexpr int LDS_BYTES = 147456;

constexpr size_t al256(size_t x) { return (x + 255) & ~(size_t)255; }
constexpr size_t WS_WTIN = 0;
constexpr size_t WS_WTOUT = WS_WTIN + (size_t)DEPTH * INWP * DM * 2;
constexpr size_t WS_WTQ = WS_WTOUT + (size_t)DEPTH * DM * DM * 2;
constexpr size_t WS_U8 = WS_WTQ + (size_t)DEPTH * DM * DM * 2;
constexpr size_t WS_V8 = WS_U8 + (size_t)DEPTH * PEXP * DM;
constexpr size_t WS_SU = WS_V8 + (size_t)DEPTH * PEXP * DM;
constexpr size_t WS_SV = WS_SU + (size_t)DEPTH * PEXP * 4;
constexpr size_t WS_H8 = WS_SV + (size_t)DEPTH * PEXP * 4;
constexpr size_t WS_SH = WS_H8 + (size_t)NT * DM;
constexpr size_t WS_HS = WS_SH + (size_t)NT * 4;
constexpr size_t WS_SUBK = WS_HS + (size_t)NT * 4;
constexpr size_t WS_MOD = WS_SUBK + (size_t)DEPTH * PH * 2 * PNK * 128 * 2;
constexpr size_t WS_ROPE128 = WS_MOD + (size_t)DEPTH * NB * 6 * DM * 4;
constexpr size_t WS_ROPE64 = WS_ROPE128 + (size_t)SEQ * 64 * 8;
constexpr size_t WS_H = WS_ROPE64 + (size_t)SEQ * 32 * 8;
constexpr size_t WS_PROJ = WS_H + (size_t)NT * DM * 2;
constexpr size_t WS_KMEAN = WS_PROJ + (size_t)NT * INWP * 2;
constexpr size_t WS_MASK = WS_KMEAN + al256((size_t)NB * HC * MOBA_NB * HD * 4);
constexpr size_t WS_Y = WS_MASK + (size_t)NB * SEQ * 64 * 4;
constexpr size_t WS_X1 = WS_Y + (size_t)NT * DM * 2;
constexpr size_t WS_X2 = WS_X1 + (size_t)NT * DM * 2;
constexpr size_t WS_PE = WS_X1 + (size_t)NT * DM * 4;
constexpr size_t WS_PG = WS_PE + (size_t)NT * 128 * 4;
constexpr size_t WS_LIST = WS_PG + (size_t)NT * 128 * 4;
constexpr size_t WS_CTL = WS_LIST + (size_t)NT * 128 * 4;
constexpr size_t CTL_BYTES = 16384;
constexpr size_t WS_END = WS_CTL + CTL_BYTES;

struct Params {
    const float *x, *c, *ada_w, *ada_b, *n1g, *n2g, *w_in, *ong, *w_out, *wq, *subk, *pu, *pv, *fg;
    float* out;
    unsigned char* ws;
    int ph_lo, ph_hi;
};

__device__ __forceinline__ int otid() { int t = threadIdx.x; asm volatile("" : "+v"(t)); return t; }
__device__ __forceinline__ int obid() { int t = blockIdx.x; asm volatile("" : "+s"(t)); return t; }
__device__ __forceinline__ float wave_sum(float v) {
#pragma unroll
    for (int o = 32; o >= 1; o >>= 1) v += __shfl_xor(v, o);
    return v;
}
__device__ __forceinline__ float wave_max(float v) {
#pragma unroll
    for (int o = 32; o >= 1; o >>= 1) v = fmaxf(v, __shfl_xor(v, o));
    return v;
}
__device__ __forceinline__ unsigned pack_h2(float a, float b) { h2_t r; r.x = (f16)a; r.y = (f16)b; return __builtin_bit_cast(unsigned, r); }
__device__ __forceinline__ float h_lo(unsigned u) { h2_t r = __builtin_bit_cast(h2_t, u); return (float)r.x; }
__device__ __forceinline__ float h_hi(unsigned u) { h2_t r = __builtin_bit_cast(h2_t, u); return (float)r.y; }
__device__ __forceinline__ float dot2(unsigned a, unsigned b, float c) {
    return __builtin_amdgcn_fdot2(__builtin_bit_cast(h2_t, a), __builtin_bit_cast(h2_t, b), c, false);
}

namespace pg8 {
constexpr int BM = 256, BK = 64, HALF = 128, HTB = HALF * BK * 2, STAGE_BYTES = 8 * HTB, NXCD = 8, WGM = 8;
__host__ __device__ __forceinline__ int lds_byte(int r, int c) { const int st = (r >> 4) * 2 + (c >> 5), rr = r & 15, cc = c & 31, ob = rr * 64 + cc * 2; return st * 1024 + (ob ^ (((ob >> 9) & 1) << 5)); }
__host__ __device__ __forceinline__ void stage_rc(int b, int& R, int& C) { const int st = b / 1024, sb = b % 1024, swz = sb ^ (((sb >> 9) & 1) << 5); R = (st >> 1) * 16 + swz / 64; C = (st & 1) * 32 + (swz % 64) / 2; }
struct Unit { int pm, pn; };
struct Gemm { const unsigned short* A; const unsigned short* Bt; int M, N, K; };
struct StaticOrder {
    int nM, nN, nwg, G, c;
    __host__ __device__ void init(int M, int N, int G_, int c_) { nM = M / BM; nN = N / BM; nwg = nM * nN; G = G_; c = c_; }
    __host__ __device__ bool next(int i, Unit& u) const {
        const long L = (long)i * G + c; if (L >= nwg) return false;
        int wgid = (int)L; { const int q = nwg / NXCD, r = nwg % NXCD, xcd = wgid % NXCD, off = wgid / NXCD; wgid = (xcd < r ? xcd * (q + 1) : r * (q + 1) + (xcd - r) * q) + off; }
        const int nig = WGM * nN, gid = wgid / nig, fm = gid * WGM, gsz = (nM - fm) < WGM ? (nM - fm) : WGM;
        u.pm = fm + ((wgid % nig) % gsz); u.pn = (wgid % nig) / gsz; return true;
    }
};

template <class Epi>
__device__ __forceinline__ void gemm_phase(LAS unsigned char* lds, const Gemm g, const StaticOrder& S, const Epi& E) {
    const int tid = otid(), wid = __builtin_amdgcn_readfirstlane(tid >> 6), lane = tid & 63, wr = wid >> 2, wc = wid & 3, fr = lane & 15, fq = lane >> 4;
    const int K = g.K, nt = K / BK;
    unsigned voffA[2], voffB[2];
#pragma unroll
    for (int i = 0; i < 2; ++i) { int R, C; stage_rc(tid * 16 + i * 8192, R, C); voffA[i] = (unsigned)(R * K + C) * 2u; voffB[i] = (unsigned)(R * K + C) * 2u; }
    const size_t kstep = (size_t)(BK * 2);
    const size_t hstep = (size_t)HALF * K * 2;
    const size_t tstep = 2 * hstep;
    const unsigned ldsw = (unsigned)wid * 1024u;
    const int aoff = lds_byte(wr * 64 + fr, fq * 8), boff = lds_byte(wc * 32 + fr, fq * 8);
#define PG8_SA(b, h) (((b) * 2 + (h)) * HTB)
#define PG8_SB(b, h) ((4 + (b) * 2 + (h)) * HTB)
#define PG8_STAGE(bufoff, gbase, voff) do { _Pragma("unroll") for (int _i = 0; _i < 2; ++_i) \
        __builtin_amdgcn_global_load_lds((const unsigned*)((const char*)(gbase) + (voff)[_i]), (LAS unsigned*)(lds + (bufoff) + ldsw + _i * 8192), 16, 0, 0); } while (0)
#define PG8_LDA(dst, b, h) do { _Pragma("unroll") for (int m = 0; m < 4; ++m) _Pragma("unroll") for (int k = 0; k < 2; ++k) dst[m][k] = *(const LAS h8_t*)(lds + PG8_SA(b, h) + aoff + m * 2048 + k * 1024); } while (0)
#define PG8_LDB(dst, b, h) do { _Pragma("unroll") for (int n = 0; n < 2; ++n) _Pragma("unroll") for (int k = 0; k < 2; ++k) dst[n][k] = *(const LAS h8_t*)(lds + PG8_SB(b, h) + boff + n * 2048 + k * 1024); } while (0)
#define PG8_MMA(ai, bj, At, Bt) do { __builtin_amdgcn_s_setprio(1); _Pragma("unroll") for (int m = 0; m < 4; ++m) _Pragma("unroll") for (int n = 0; n < 2; ++n) _Pragma("unroll") for (int k = 0; k < 2; ++k) \
        acc[ai][bj][m][n] = __builtin_amdgcn_mfma_f32_16x16x32_f16(Bt[n][k], At[m][k], acc[ai][bj][m][n], 0, 0, 0); __builtin_amdgcn_s_setprio(0); } while (0)
#define PG8_WAIT_V(n) asm volatile("s_waitcnt vmcnt(" #n ")" ::: "memory")
#define PG8_WAIT_L(n) asm volatile("s_waitcnt lgkmcnt(" #n ")" ::: "memory")
#define PG8_BAR __builtin_amdgcn_s_barrier()
#define PG8_SCHED __builtin_amdgcn_sched_barrier(0)
    Unit cur, nxt; int ui = 0;
    if (!S.next(0, cur)) return;
    f32x4 acc[2][2][4][2];
#pragma unroll
    for (int a = 0; a < 2; ++a)
#pragma unroll
        for (int b = 0; b < 2; ++b)
#pragma unroll
            for (int m = 0; m < 4; ++m)
#pragma unroll
                for (int n = 0; n < 2; ++n) acc[a][b][m][n] = (f32x4){0.f, 0.f, 0.f, 0.f};
    h8_t At[4][2], B0[2][2], B1[2][2];
    const char* cA = (const char*)g.A + (size_t)cur.pm * tstep; const char* cB = (const char*)g.Bt + (size_t)cur.pn * tstep;
    PG8_STAGE(PG8_SB(0, 0), cB, voffB); PG8_STAGE(PG8_SA(0, 0), cA, voffA); PG8_STAGE(PG8_SB(0, 1), cB + hstep, voffB); PG8_STAGE(PG8_SA(0, 1), cA + hstep, voffA);
    if (wr == 1) PG8_BAR;
    PG8_WAIT_V(4); PG8_BAR;
    PG8_STAGE(PG8_SB(1, 0), cB + kstep, voffB); PG8_STAGE(PG8_SA(1, 0), cA + kstep, voffA); PG8_STAGE(PG8_SB(1, 1), cB + hstep + kstep, voffB);
    PG8_WAIT_V(6); PG8_BAR;
    for (;;) {
        const bool has_next = S.next(ui + 1, nxt);
        const char* nA = has_next ? (const char*)g.A + (size_t)nxt.pm * tstep : cA; const char* nB = has_next ? (const char*)g.Bt + (size_t)nxt.pn * tstep : cB;
        for (int t = 0; t < nt; t += 2) {
            const bool last = (t == nt - 2);
            const char* a1 = cA + (size_t)(t + 1) * kstep;
            const char* a2 = last ? nA : cA + (size_t)(t + 2) * kstep; const char* b2 = last ? nB : cB + (size_t)(t + 2) * kstep;
            const char* a3 = a2 + kstep; const char* b3 = b2 + kstep;
            PG8_LDB(B0, 0, 0); PG8_SCHED; PG8_LDA(At, 0, 0); PG8_STAGE(PG8_SA(1, 1), a1 + hstep, voffA);
            PG8_WAIT_L(8); PG8_BAR; PG8_WAIT_L(0); PG8_MMA(0, 0, At, B0); PG8_BAR; PG8_SCHED;
            PG8_LDB(B1, 0, 1); PG8_STAGE(PG8_SB(0, 0), b2, voffB);
            PG8_BAR; PG8_WAIT_L(0); PG8_MMA(0, 1, At, B1); PG8_BAR;
            PG8_LDA(At, 0, 1); PG8_STAGE(PG8_SA(0, 0), a2, voffA);
            PG8_BAR; PG8_WAIT_L(0); PG8_MMA(1, 0, At, B0); PG8_BAR; PG8_SCHED;
            PG8_STAGE(PG8_SB(0, 1), b2 + hstep, voffB);
            PG8_WAIT_V(6); PG8_BAR; PG8_MMA(1, 1, At, B1); PG8_BAR;
            PG8_LDB(B0, 1, 0); PG8_SCHED; PG8_LDA(At, 1, 0); PG8_STAGE(PG8_SA(0, 1), a2 + hstep, voffA);
            PG8_WAIT_L(8); PG8_BAR; PG8_WAIT_L(0); PG8_MMA(0, 0, At, B0); PG8_BAR; PG8_SCHED;
            PG8_LDB(B1, 1, 1); PG8_STAGE(PG8_SB(1, 0), b3, voffB);
            PG8_BAR; PG8_WAIT_L(0); PG8_MMA(0, 1, At, B1); PG8_BAR;
            PG8_LDA(At, 1, 1); PG8_STAGE(PG8_SA(1, 0), a3, voffA);
            PG8_BAR; PG8_WAIT_L(0); PG8_MMA(1, 0, At, B0); PG8_BAR; PG8_SCHED;
            PG8_STAGE(PG8_SB(1, 1), b3 + hstep, voffB);
            PG8_WAIT_V(6); PG8_BAR; PG8_MMA(1, 1, At, B1); PG8_BAR;
        }
        E(acc, cur, wr, wc, fr, fq);
        if (!has_next) break;
#pragma unroll
        for (int a = 0; a < 2; ++a)
#pragma unroll
            for (int b = 0; b < 2; ++b)
#pragma unroll
                for (int m = 0; m < 4; ++m)
#pragma unroll
                    for (int n = 0; n < 2; ++n) acc[a][b][m][n] = (f32x4){0.f, 0.f, 0.f, 0.f};
        cur = nxt; cA = nA; cB = nB; ++ui;
    }
    PG8_WAIT_V(0);
    if (wr == 0) PG8_BAR;
    PG8_BAR;
#undef PG8_SA
#undef PG8_SB
#undef PG8_STAGE
#undef PG8_LDA
#undef PG8_LDB
#undef PG8_MMA
#undef PG8_WAIT_V
#undef PG8_WAIT_L
#undef PG8_BAR
#undef PG8_SCHED
}
}

__device__ __forceinline__ int win_src_col_l(int pc) { return pc < 2128 ? pc : (pc < C_QB ? -1 : (pc < C_END ? pc - 48 : -1)); }
__device__ __forceinline__ int rope_type(int g) { return (g <= 6 || (g >= 32 && g <= 41)) ? 1 : ((g >= 8 && g <= 15) ? 2 : (g == 16 ? 3 : 0)); }
__device__ __forceinline__ int win_src_col(int pc) {
    const int g = pc >> 7, p = pc & 127, ty = rope_type(g);
    int l = p;
    if (ty == 1) { const int q4 = p >> 2, e = p & 3; l = 2 * q4 + (e >> 1) + 64 * (e & 1); }
    else if (ty == 2 || (ty == 3 && p < 64)) { const int hb = p >> 6, pp = p & 63, q4 = pp >> 2, e = pp & 3; l = hb * 64 + 2 * q4 + (e >> 1) + 32 * (e & 1); }
    return win_src_col_l(g * 128 + l);
}


struct Epi {
    int mode; f16* o16; int ldc; float* o32; const float* xin; const f16* xinh; const float* gate; const float* rope128; const float* rope64;
    __device__ __forceinline__ void operator()(const f32x4 (&acc)[2][2][4][2], const pg8::Unit& u, int wr, int wc, int fr, int fq) const {
        const int row0 = u.pm * 256 + wr * 64 + fr, col0 = u.pn * 256 + wc * 32 + 4 * fq;
        if (mode == 2) {
#pragma unroll
            for (int bj = 0; bj < 2; ++bj) {
                const int g = __builtin_amdgcn_readfirstlane(u.pn * 2 + bj);
                int ty = rope_type(g); if (ty == 3) ty = (wc < 2) ? 2 : 0;
                f16* ob = o16 + (size_t)g * 128;
                if (ty == 0) {
#pragma unroll
                    for (int ai = 0; ai < 2; ++ai)
#pragma unroll
                        for (int m = 0; m < 4; ++m)
#pragma unroll
                            for (int n = 0; n < 2; ++n) {
                                const f32x4 v = acc[ai][bj][m][n];
                                u32x2 w; w.x = pack_h2(v[0], v[1]); w.y = pack_h2(v[2], v[3]);
                                *(u32x2*)(ob + (size_t)(row0 + ai * 128 + m * 16) * ldc + wc * 32 + n * 16 + 4 * fq) = w;
                            }
                } else {
                    const float* tab = ty == 1 ? rope128 : rope64;
                    const int half = ty == 1 ? 64 : 32, tw = ty == 1 ? 128 : 64;
#pragma unroll
                    for (int ai = 0; ai < 2; ++ai) {
                        f32x4 cs[4][2];
#pragma unroll
                        for (int m = 0; m < 4; ++m)
#pragma unroll
                            for (int n = 0; n < 2; ++n) {
                                const int pos = (row0 + ai * 128 + m * 16) & (SEQ - 1), p = wc * 32 + n * 16 + 4 * fq;
                                const int j = ty == 1 ? (p >> 1) : ((p & 63) >> 1);
                                cs[m][n] = *(const f32x4*)(tab + (size_t)pos * tw + 2 * j);
                            }
#pragma unroll
                        for (int m = 0; m < 4; ++m) {
                            const int row = row0 + ai * 128 + m * 16;
#pragma unroll
                            for (int n = 0; n < 2; ++n) {
                                const int p = wc * 32 + n * 16 + 4 * fq;
                                const int j = ty == 1 ? (p >> 1) : ((p & 63) >> 1), base = ty == 1 ? 0 : (p & 64);
                                const f32x4 v = acc[ai][bj][m][n], c4 = cs[m][n];
                                const float o1a = v[0] * c4[0] - v[1] * c4[1], o2a = v[1] * c4[0] + v[0] * c4[1];
                                const float o1b = v[2] * c4[2] - v[3] * c4[3], o2b = v[3] * c4[2] + v[2] * c4[3];
                                f16* op = ob + (size_t)row * ldc + base + j;
                                *(unsigned*)op = pack_h2(o1a, o1b); *(unsigned*)(op + half) = pack_h2(o2a, o2b);
                            }
                        }
                    }
                }
            }
            return;
        }
        if (mode == 1) {
            const int b = row0 / SEQ;
            f32x4 gt[2][2];
#pragma unroll
            for (int bj = 0; bj < 2; ++bj)
#pragma unroll
                for (int n = 0; n < 2; ++n) gt[bj][n] = *(const f32x4*)(gate + (size_t)b * 6 * DM + col0 + bj * 128 + n * 16);
#pragma unroll
            for (int ai = 0; ai < 2; ++ai)
#pragma unroll
                for (int mh = 0; mh < 2; ++mh) {
                    f32x4 xi[2][2][2];
#pragma unroll
                    for (int m2 = 0; m2 < 2; ++m2)
#pragma unroll
                        for (int bj = 0; bj < 2; ++bj)
#pragma unroll
                            for (int n = 0; n < 2; ++n) {
                                const size_t o = (size_t)(row0 + ai * 128 + (2 * mh + m2) * 16) * DM + col0 + bj * 128 + n * 16;
                                if (xinh) { const u32x2 w = *(const u32x2*)(xinh + o); xi[m2][bj][n] = (f32x4){h_lo(w.x), h_hi(w.x), h_lo(w.y), h_hi(w.y)}; }
                                else xi[m2][bj][n] = *(const f32x4*)(xin + o);
                            }
#pragma unroll
                    for (int m2 = 0; m2 < 2; ++m2)
#pragma unroll
                        for (int bj = 0; bj < 2; ++bj)
#pragma unroll
                            for (int n = 0; n < 2; ++n) {
                                const f32x4 r = xi[m2][bj][n] + gt[bj][n] * acc[ai][bj][2 * mh + m2][n];
                                u32x2 w; w.x = pack_h2(r[0], r[1]); w.y = pack_h2(r[2], r[3]);
                                *(u32x2*)(o16 + (size_t)(row0 + ai * 128 + (2 * mh + m2) * 16) * DM + col0 + bj * 128 + n * 16) = w;
                            }
                }
            return;
        }
#pragma unroll
        for (int ai = 0; ai < 2; ++ai)
#pragma unroll
            for (int m = 0; m < 4; ++m) {
                const int row = row0 + ai * 128 + m * 16;
#pragma unroll
                for (int bj = 0; bj < 2; ++bj)
#pragma unroll
                    for (int n = 0; n < 2; ++n) {
                        const int col = col0 + bj * 128 + n * 16;
                        const f32x4 v = acc[ai][bj][m][n];
                        if (mode == 0) {
                            u32x2 w; w.x = pack_h2(v[0], v[1]); w.y = pack_h2(v[2], v[3]);
                            *(u32x2*)(o16 + (size_t)row * ldc + col) = w;
                        } else {
                            const int b = row / SEQ;
                            const f32x4 xi = *(const f32x4*)(xin + (size_t)row * DM + col);
                            const f32x4 gt = *(const f32x4*)(gate + (size_t)b * 6 * DM + col);
                            *(f32x4*)(o32 + (size_t)row * DM + col) = xi + gt * v;
                        }
                    }
            }
    }
};

__device__ __forceinline__ void gemm_run(const Params& p, LAS unsigned char* lds, const f16* A, const f16* Bt, int N, const Epi& E) {
    pg8::Gemm g; g.A = (const unsigned short*)A; g.Bt = (const unsigned short*)Bt; g.M = NT; g.N = N; g.K = DM;
    pg8::StaticOrder S; S.init(NT, N, (int)gridDim.x, (int)blockIdx.x);
    pg8::gemm_phase<Epi>(lds, g, S, E);
}

__device__ __forceinline__ void transpose_tiles(const float* src, int ldsrc, int ncols_phys, bool is_win, f16* dst, float* tile  , int& unit_base, int unit_lo) {
    const int tn = ncols_phys / 64, tk = DM / 64, ntile = tn * tk;
    const int tid = otid();
    float cur[8], nxt[8];
#define TT_LOAD(R_, u_) do { const int n0_ = ((u_) % tn) * 64, k0_ = ((u_) / tn) * 64; \
        _Pragma("unroll") for (int i = 0; i < 8; ++i) { const int e = tid + i * 512, r = e >> 6, c = e & 63; const int pc = n0_ + c; const int sc = is_win ? win_src_col(pc) : pc; \
            R_[i] = sc >= 0 ? src[(size_t)(k0_ + r) * ldsrc + sc] : 0.f; } } while (0)
    int u = blockIdx.x;
    if (u < ntile) TT_LOAD(nxt, u);
    for (; u < ntile; u += gridDim.x) {
        const int n0 = (u % tn) * 64, k0 = (u / tn) * 64;
#pragma unroll
        for (int i = 0; i < 8; ++i) cur[i] = nxt[i];
        if (u + (int)gridDim.x < ntile) TT_LOAD(nxt, u + gridDim.x);
        __syncthreads();
#pragma unroll
        for (int i = 0; i < 8; ++i) { const int e = tid + i * 512, r = e >> 6, c = e & 63; tile[r * 65 + c] = cur[i]; }
        __syncthreads();
        {
            const int n = tid >> 3, kq = (tid & 7) * 8;
            u32x4 w;
            w.x = pack_h2(tile[(kq + 0) * 65 + n], tile[(kq + 1) * 65 + n]); w.y = pack_h2(tile[(kq + 2) * 65 + n], tile[(kq + 3) * 65 + n]);
            w.z = pack_h2(tile[(kq + 4) * 65 + n], tile[(kq + 5) * 65 + n]); w.w = pack_h2(tile[(kq + 6) * 65 + n], tile[(kq + 7) * 65 + n]);
            *(u32x4*)(dst + (size_t)(n0 + n) * DM + k0 + kq) = w;
        }
    }
#undef TT_LOAD
    (void)unit_base; (void)unit_lo;
}

__device__ __forceinline__ void cvt_f16_stream(const float* src, f16* dst, size_t n) {
    const size_t stride = (size_t)gridDim.x * NTHREADS;
    for (size_t i = (size_t)blockIdx.x * NTHREADS + otid(); i < n / 8; i += stride) {
        const f32x4 a = *(const f32x4*)(src + i * 8), b = *(const f32x4*)(src + i * 8 + 4);
        u32x4 w; w.x = pack_h2(a[0], a[1]); w.y = pack_h2(a[2], a[3]); w.z = pack_h2(b[0], b[1]); w.w = pack_h2(b[2], b[3]);
        *(u32x4*)(dst + i * 8) = w;
    }
}

__device__ __forceinline__ void quant_rows(const float* src, int nrows, unsigned* dst, float* scale, int bias) {
    const int tid_ = otid(); const int wid = tid_ >> 6, lane = tid_ & 63;
    const int rstep = gridDim.x * NWAVES;
    int row = blockIdx.x * NWAVES + wid;
    f32x4 v[8], nv[8];
    if (row < nrows) {
#pragma unroll
        for (int i = 0; i < 8; ++i) nv[i] = *(const f32x4*)(src + (size_t)row * DM + i * 256 + lane * 4);
    }
    for (; row < nrows; row += rstep) {
#pragma unroll
        for (int i = 0; i < 8; ++i) v[i] = nv[i];
        if (row + rstep < nrows) {
#pragma unroll
            for (int i = 0; i < 8; ++i) nv[i] = *(const f32x4*)(src + (size_t)(row + rstep) * DM + i * 256 + lane * 4);
        }
        float am = 0.f;
#pragma unroll
        for (int i = 0; i < 8; ++i) am = fmaxf(am, fmaxf(fmaxf(fabsf(v[i][0]), fabsf(v[i][1])), fmaxf(fabsf(v[i][2]), fabsf(v[i][3]))));
        am = wave_max(am);
        const float sc = am > 0.f ? am * (1.f / 127.f) : 1.f, inv = 1.f / sc;
        if (lane == 0) scale[row] = sc;
#pragma unroll
        for (int i = 0; i < 8; ++i) {
            unsigned w = 0u;
#pragma unroll
            for (int j = 0; j < 4; ++j) { const int q = (int)rintf(v[i][j] * inv) + bias; w |= ((unsigned)q & 255u) << (8 * j); }
            dst[(size_t)row * (DM / 4) + i * 64 + lane] = w;
        }
    }
}

__device__ __forceinline__ void quant_rows4(const float* src, int nrows, unsigned* dst, float* scale) {
    const int tid_ = otid(); const int wid = tid_ >> 6, lane = tid_ & 63;
    const int rstep = gridDim.x * NWAVES;
    int row = blockIdx.x * NWAVES + wid;
    f32x4 v[8], nv[8];
    if (row < nrows) {
#pragma unroll
        for (int i = 0; i < 8; ++i) nv[i] = *(const f32x4*)(src + (size_t)row * DM + i * 256 + lane * 4);
    }
    for (; row < nrows; row += rstep) {
#pragma unroll
        for (int i = 0; i < 8; ++i) v[i] = nv[i];
        if (row + rstep < nrows) {
#pragma unroll
            for (int i = 0; i < 8; ++i) nv[i] = *(const f32x4*)(src + (size_t)(row + rstep) * DM + i * 256 + lane * 4);
        }
        float am = 0.f;
#pragma unroll
        for (int i = 0; i < 8; ++i) am = fmaxf(am, fmaxf(fmaxf(fabsf(v[i][0]), fabsf(v[i][1])), fmaxf(fabsf(v[i][2]), fabsf(v[i][3]))));
        am = wave_max(am);
        const float sc = am > 0.f ? am * (1.f / 7.f) : 1.f, inv = 1.f / sc;
        if (lane == 0) scale[row] = sc;
#pragma unroll
        for (int i = 0; i < 8; ++i) {
            unsigned w = 0u;
#pragma unroll
            for (int j = 0; j < 4; ++j) { const int q = (int)rintf(v[i][j] * inv) + 8; w |= ((unsigned)q & 15u) << (8 * j); }
            if (lane & 1) w <<= 4;
            const unsigned o = __shfl_down(w, 1);
            if (!(lane & 1)) dst[(size_t)row * (DM / 8) + i * 32 + (lane >> 1)] = w | o;
        }
    }
}

constexpr int QV_STR = DM + 8;
__device__ __forceinline__ void quant_v_sliced(const float* src, unsigned char* dst, float* scale, LAS unsigned char* lds) {
    const int tid = otid(), wid = tid >> 6, lane = tid & 63;
    for (int blk = obid(); blk < DEPTH * PEXP / 64; blk += gridDim.x) {
        const int row0 = blk * 64, layer = row0 / PEXP, e0 = row0 % PEXP;
        __syncthreads();
        f32x4 nv[8];
#pragma unroll
        for (int i = 0; i < 8; ++i) nv[i] = *(const f32x4*)(src + (size_t)(row0 + wid) * DM + i * 256 + lane * 4);
        for (int rr = wid; rr < 64; rr += NWAVES) {
            f32x4 v[8]; float am = 0.f;
#pragma unroll
            for (int i = 0; i < 8; ++i) v[i] = nv[i];
            if (rr + NWAVES < 64) {
#pragma unroll
                for (int i = 0; i < 8; ++i) nv[i] = *(const f32x4*)(src + (size_t)(row0 + rr + NWAVES) * DM + i * 256 + lane * 4);
            }
#pragma unroll
            for (int i = 0; i < 8; ++i) am = fmaxf(am, fmaxf(fmaxf(fabsf(v[i][0]), fabsf(v[i][1])), fmaxf(fabsf(v[i][2]), fabsf(v[i][3]))));
            am = wave_max(am);
            const float sc = am > 0.f ? am * (1.f / 127.f) : 1.f, inv = 1.f / sc;
            if (lane == 0) scale[row0 + rr] = sc;
#pragma unroll
            for (int i = 0; i < 8; ++i) {
                unsigned w = 0u;
#pragma unroll
                for (int j = 0; j < 4; ++j) { const int q = (int)rintf(v[i][j] * inv) + 128; w |= ((unsigned)q & 255u) << (8 * j); }
                *(LAS unsigned*)(lds + rr * QV_STR + i * 256 + lane * 4) = w;
            }
        }
        __syncthreads();
        for (int c = wid; c < 256; c += NWAVES) {
            const u32x2 w = *(const LAS u32x2*)(lds + lane * QV_STR + c * 8);
            *(u32x2*)(dst + (((size_t)layer * 256 + c) * PEXP + e0 + lane) * 8) = w;
        }
    }
}

__device__ __forceinline__ void phase_conv(const Params& p, LAS unsigned char* lds_) {
    float* smem = (float*)(unsigned char*)lds_;
    unsigned char* ws = p.ws;
    const int tid = otid();
    int dummy = 0;
    {
        float* cond = smem;
        float* red = smem + NB * DM;
        for (int i = tid; i < NB * DM; i += NTHREADS) { const float v = p.c[i]; cond[i] = v / (1.f + __expf(-v)); }
        __syncthreads();
        for (int u = blockIdx.x; u < DEPTH * 128; u += gridDim.x) {
            const int l = u >> 7, j0 = (u & 127) * 96;
            const int c4 = tid % 24, kg = tid / 24;
            if (kg < 21) {
                f32x4 acc[NB];
#pragma unroll
                for (int b = 0; b < NB; ++b) acc[b] = (f32x4){0.f, 0.f, 0.f, 0.f};
                const float* wp = p.ada_w + (size_t)l * DM * 6 * DM + j0 + 4 * c4;
#pragma unroll 1
                for (int i0 = 0; i0 < 98; i0 += 7) {
                    f32x4 w[7];
#pragma unroll
                    for (int i = 0; i < 7; ++i) { const int k = kg + 21 * (i0 + i); w[i] = k < DM ? *(const f32x4*)(wp + (size_t)k * 6 * DM) : (f32x4){0.f, 0.f, 0.f, 0.f}; }
#pragma unroll
                    for (int i = 0; i < 7; ++i) { const int k = kg + 21 * (i0 + i); const int kk = k < DM ? k : 0;
#pragma unroll
                        for (int b = 0; b < NB; ++b) acc[b] += w[i] * cond[b * DM + kk]; }
                }
#pragma unroll
                for (int b = 0; b < NB; ++b) *(f32x4*)(red + (kg * NB + b) * 96 + 4 * c4) = acc[b];
            }
            __syncthreads();
            for (int i = tid; i < NB * 96; i += NTHREADS) {
                const int b = i / 96, cc = i % 96;
                float sacc = p.ada_b[(size_t)l * 6 * DM + j0 + cc];
#pragma unroll
                for (int g = 0; g < 21; ++g) sacc += red[(g * NB + b) * 96 + cc];
                ((float*)(ws + WS_MOD))[((size_t)l * NB + b) * 6 * DM + j0 + cc] = sacc;
            }
            __syncthreads();
        }
    }
    {
        float2* r128 = (float2*)(ws + WS_ROPE128); float2* r64 = (float2*)(ws + WS_ROPE64);
        for (int i = blockIdx.x * NTHREADS + tid; i < SEQ * 64; i += gridDim.x * NTHREADS) {
            const int pos = i >> 6, j = i & 63;
            const float inv = powf(10000.f, -(float)j / 64.f); const float ang = (float)pos * inv;
            r128[i] = make_float2((float)cos((double)ang), (float)sin((double)ang));
        }
        for (int i = blockIdx.x * NTHREADS + tid; i < SEQ * 32; i += gridDim.x * NTHREADS) {
            const int pos = i >> 5, j = i & 31;
            const float inv = powf(10000.f, -(float)j / 32.f); const float ang = (float)pos * inv;
            r64[i] = make_float2((float)cos((double)ang), (float)sin((double)ang));
        }
    }
    __syncthreads();
    for (int l = 0; l < DEPTH; ++l) {
        transpose_tiles(p.w_in + (size_t)l * DM * INW, INW, INWP, true, (f16*)(ws + WS_WTIN) + (size_t)l * INWP * DM, smem, dummy, 0);
        transpose_tiles(p.w_out + (size_t)l * DM * DM, DM, DM, false, (f16*)(ws + WS_WTOUT) + (size_t)l * DM * DM, smem, dummy, 0);
        transpose_tiles(p.wq + (size_t)l * DM * DM, DM, DM, false, (f16*)(ws + WS_WTQ) + (size_t)l * DM * DM, smem, dummy, 0);
    }
    quant_rows(p.pu, PEXP, (unsigned*)(ws + WS_U8), (float*)(ws + WS_SU), 0);
    if (LAST_BITS == 4) quant_rows4(p.pu + (size_t)PEXP * DM, PEXP, (unsigned*)(ws + WS_U8 + (size_t)PEXP * DM), (float*)(ws + WS_SU) + PEXP);
    else quant_rows(p.pu + (size_t)PEXP * DM, PEXP, (unsigned*)(ws + WS_U8 + (size_t)PEXP * DM), (float*)(ws + WS_SU) + PEXP, 0);
    quant_v_sliced(p.pv, ws + WS_V8, (float*)(ws + WS_SV), lds_);
    cvt_f16_stream(p.subk, (f16*)(ws + WS_SUBK), (size_t)DEPTH * PH * 2 * PNK * 128);
}

template <int MODE, bool XH>
__device__ __forceinline__ void phase_norm2(const float* xin, const f16* xinh, float* fout, const float* g, const float* shift, const float* scale, f16* hout, unsigned* h8, float* sh8) {
    const int tid_ = otid(); const int wid = tid_ >> 6, lane = tid_ & 63;
    for (int r0 = (blockIdx.x * NWAVES + wid) * 8; r0 < NT; r0 += gridDim.x * NWAVES * 8) {
        const int b = r0 / SEQ;
        f32x4 gm[8], sh[8];
#pragma unroll
        for (int i = 0; i < 8; ++i) {
            const int col = i * 256 + lane * 4;
            gm[i] = *(const f32x4*)(g + col);
            if (MODE != 2) { gm[i] = gm[i] * (*(const f32x4*)(scale + (size_t)b * 6 * DM + col) + 1.f); sh[i] = *(const f32x4*)(shift + (size_t)b * 6 * DM + col); }
        }
        f32x4 v[8], nv[8]; u32x2 nh[8];
#define NR_LOAD(row_) do { _Pragma("unroll") for (int i = 0; i < 8; ++i) { if (XH) nh[i] = *(const u32x2*)(xinh + (size_t)(row_) * DM + i * 256 + lane * 4); else nv[i] = *(const f32x4*)(xin + (size_t)(row_) * DM + i * 256 + lane * 4); } } while (0)
        NR_LOAD(r0);
#pragma unroll 1
        for (int k = 0; k < 8; ++k) {
            const int row = r0 + k;
#pragma unroll
            for (int i = 0; i < 8; ++i) { if (XH) { v[i][0] = h_lo(nh[i].x); v[i][1] = h_hi(nh[i].x); v[i][2] = h_lo(nh[i].y); v[i][3] = h_hi(nh[i].y); } else v[i] = nv[i]; }
            if (k < 7) NR_LOAD(row + 1);
            float ss = 0.f;
#pragma unroll
            for (int i = 0; i < 8; ++i) ss += v[i][0] * v[i][0] + v[i][1] * v[i][1] + v[i][2] * v[i][2] + v[i][3] * v[i][3];
            ss = wave_sum(ss);
            const float rstd = rsqrtf(ss * (1.f / DM) + EPS);
            float am = 0.f;
#pragma unroll
            for (int i = 0; i < 8; ++i) {
                const int col = i * 256 + lane * 4;
                if (MODE == 2) { *(f32x4*)(fout + (size_t)row * DM + col) = v[i] * rstd * gm[i]; }
                else {
                    const f32x4 y = v[i] * rstd * gm[i] + sh[i];
                    u32x2 w; w.x = pack_h2(y[0], y[1]); w.y = pack_h2(y[2], y[3]);
                    *(u32x2*)(hout + (size_t)row * DM + col) = w;
                    if (MODE == 1) { v[i] = y; am = fmaxf(am, fmaxf(fmaxf(fabsf(y[0]), fabsf(y[1])), fmaxf(fabsf(y[2]), fabsf(y[3])))); }
                }
            }
            if (MODE == 1) {
                am = wave_max(am);
                const float qs = am > 0.f ? am * (1.f / 127.f) : 1.f, inv = 1.f / qs;
                if (lane == 0) sh8[row] = qs;
                int qsum = 0;
#pragma unroll
                for (int i = 0; i < 8; ++i) {
                    unsigned w = 0u;
#pragma unroll
                    for (int j = 0; j < 4; ++j) { const int q = (int)rintf(v[i][j] * inv); qsum += q; w |= ((unsigned)q & 255u) << (8 * j); }
                    h8[(size_t)row * (DM / 4) + i * 64 + lane] = w;
                }
#pragma unroll
                for (int o = 32; o >= 1; o >>= 1) qsum += __shfl_xor(qsum, o);
                if (lane == 0) ((int*)(sh8 + NT))[row] = qsum;
            }
        }
#undef NR_LOAD
    }
}

constexpr int IX_ROW = SEQ + 4;
__device__ __forceinline__ void index_item(const Params& p, LAS unsigned char* lds, int b, int qg) {
    const f16* proj = (const f16*)(p.ws + WS_PROJ);
    LAS float* sc = (LAS float*)lds;
    const int tid = otid(), wid = __builtin_amdgcn_readfirstlane(tid >> 6), lane = tid & 63, fr = lane & 15, fq = lane >> 4;
    const int t0 = qg * 16, nkt = qg + 1;
    h8_t Bq[IH][2]; float wq[IH];
    {
        const f16* qrow = proj + ((size_t)b * SEQ + t0 + fr) * INWP;
#pragma unroll
        for (int h = 0; h < IH; ++h) {
            Bq[h][0] = *(const h8_t*)(qrow + C_IQ + h * IDM + 8 * fq);
            Bq[h][1] = *(const h8_t*)(qrow + C_IQ + h * IDM + 32 + 8 * fq);
        }
        const h8_t w0 = *(const h8_t*)(qrow + C_IW), w1 = *(const h8_t*)(qrow + C_IW + 8);
#pragma unroll
        for (int h = 0; h < 8; ++h) { wq[h] = (float)w0[h] * (0.25f * 0.125f); wq[8 + h] = (float)w1[h] * (0.25f * 0.125f); }
    }
    __syncthreads();
    const f16* kbase = proj + ((size_t)b * SEQ + fr) * INWP + C_IK + 8 * fq;
    h8_t a0, a1, n0, n1;
#define IX_LOAD(A0_, A1_, kt_) do { const int c_ = (kt_) < nkt ? (kt_) : 0; A0_ = *(const h8_t*)(kbase + (size_t)c_ * 16 * INWP); A1_ = *(const h8_t*)(kbase + (size_t)c_ * 16 * INWP + 32); } while (0)
#define IX_TILE(A0_, A1_, kt_) do { f32x4 acc = {0.f, 0.f, 0.f, 0.f}; \
        _Pragma("unroll") for (int h = 0; h < IH; ++h) { \
            f32x4 c = {0.f, 0.f, 0.f, 0.f}; \
            c = __builtin_amdgcn_mfma_f32_16x16x32_f16(A0_, Bq[h][0], c, 0, 0, 0); \
            c = __builtin_amdgcn_mfma_f32_16x16x32_f16(A1_, Bq[h][1], c, 0, 0, 0); \
            _Pragma("unroll") for (int j = 0; j < 4; ++j) { const int ci = __float_as_int(c[j]); acc[j] += wq[h] * __int_as_float(ci > 0 ? ci : 0); } } \
        *(LAS f32x4*)(sc + fr * IX_ROW + (kt_) * 16 + 4 * fq) = acc; } while (0)
    int kt = wid;
    IX_LOAD(a0, a1, kt);
    for (; kt < nkt; kt += 2 * NWAVES) {
        IX_LOAD(n0, n1, kt + NWAVES); __builtin_amdgcn_sched_barrier(0);
        IX_TILE(a0, a1, kt); __builtin_amdgcn_sched_barrier(0);
        IX_LOAD(a0, a1, kt + 2 * NWAVES); __builtin_amdgcn_sched_barrier(0);
        if (kt + NWAVES < nkt) IX_TILE(n0, n1, kt + NWAVES);
        __builtin_amdgcn_sched_barrier(0);
    }
#undef IX_LOAD
#undef IX_TILE
    __syncthreads();
    unsigned* mask = (unsigned*)(p.ws + WS_MASK);
#pragma unroll 1
    for (int qq = 0; qq < 2; ++qq) {
        const int ql = 2 * wid + qq, t = t0 + ql, nk = t + 1;
        unsigned key[32];
#pragma unroll
        for (int i = 0; i < 32; ++i) {
            const int s = lane + 64 * i;
            unsigned u = 0u;
            if (s < nk) { const unsigned bits = __float_as_uint(sc[ql * IX_ROW + s]); u = (bits & 0x80000000u) ? ~bits : (bits | 0x80000000u); if (u == 0u) u = 1u; }
            key[i] = u;
        }
        unsigned thr = 1u;
        if (nk > DSA_TOPK) {
            thr = 0u;
            const int nreg8 = (nk + 511) >> 9;
            for (int bit = 31; bit >= 0; --bit) {
                const unsigned cand = thr | (1u << bit);
                int cnt = 0;
#pragma unroll
                for (int i8 = 0; i8 < 4; ++i8) {
                    if (i8 < nreg8) {
#pragma unroll
                        for (int i = 0; i < 8; ++i) cnt += __builtin_popcountll(__ballot(key[8 * i8 + i] >= cand));
                    }
                }
                if (cnt >= DSA_TOPK) { thr = cand; if (cnt == DSA_TOPK) break; }
            }
        }
        unsigned* mrow = mask + ((size_t)b * SEQ + t) * 64;
        unsigned myw = 0u;
#pragma unroll
        for (int i = 0; i < 32; ++i) {
            const unsigned long long bal = __ballot(key[i] >= thr && key[i] != 0u);
            if (lane == 2 * i) myw = (unsigned)bal;
            if (lane == 2 * i + 1) myw = (unsigned)(bal >> 32);
        }
        mrow[lane] = myw;
    }
}

__device__ __forceinline__ void phase_index2(const Params& p, LAS unsigned char* lds_) {
    const f16* proj = (const f16*)(p.ws + WS_PROJ);
    float* smem = (float*)(unsigned char*)lds_;
    const int tid = otid();
    {
        float* red = smem;
        float* km = (float*)(p.ws + WS_KMEAN);
        for (int u = obid(); u < NB * HC * MOBA_NB; u += gridDim.x) {
            const int blk = u % MOBA_NB, h = (u / MOBA_NB) % HC, b = u / (MOBA_NB * HC);
            const int d = tid & 127, part = tid >> 7;
            float s = 0.f;
            const f16* kp = proj + ((size_t)b * SEQ + blk * MOBA_BLK + part * 64) * INWP + C_KC + h * HD + d;
#pragma unroll
            for (int k0 = 0; k0 < 64; k0 += 16) {
                f16 kv[16];
#pragma unroll
                for (int k = 0; k < 16; ++k) kv[k] = kp[(size_t)(k0 + k) * INWP];
#pragma unroll
                for (int k = 0; k < 16; ++k) s += (float)kv[k];
            }
            __syncthreads();
            red[part * 128 + d] = s;
            __syncthreads();
            if (tid < 128) km[(size_t)u * HD + tid] = (red[tid] + red[128 + tid] + red[256 + tid] + red[384 + tid]) * (1.f / MOBA_BLK);
        }
        __syncthreads();
    }
    for (int pi = obid(); pi < NB * 64; pi += gridDim.x) {
        const int b = pi >> 6, a = pi & 63;
        index_item(p, lds_, b, 127 - a);
        index_item(p, lds_, b, a);
    }
}

typedef short s4_t __attribute__((ext_vector_type(4)));
typedef float f32x16 __attribute__((ext_vector_type(16)));
constexpr int AT_KSTR = 272, AT_VSTR = 320, AT_KBYTES = 64 * AT_KSTR, AT_VBYTES = 64 * AT_VSTR, AT_STAGE = AT_KBYTES + AT_VBYTES;
__device__ __forceinline__ float fexp2(float x) { return __builtin_amdgcn_exp2f(x); }
__device__ __forceinline__ float flog2(float x) { return __builtin_amdgcn_logf(x); }

template <int VAR>
__device__ __forceinline__ void attn_item(const Params& p, LAS unsigned char* lds, const float* ong, int b, int hh, int qt, int qc, int kc, int vc) {
    const f16* proj = (const f16*)(p.ws + WS_PROJ);
    const int tid = otid(), wid = __builtin_amdgcn_readfirstlane(tid >> 6), lane = tid & 63, qn = lane & 31, hf = lane >> 5;
    const int q0 = qt * 256, qrow = q0 + 32 * wid + qn;
    const size_t grow = (size_t)b * SEQ + qrow;
    h8_t Qf[8];
    {
        const float sc = 0.08838834764831845f * 1.4426950408889634f;
        const f16* qp = proj + grow * INWP + qc + 8 * hf;
#pragma unroll
        for (int ks = 0; ks < 8; ++ks) {
            const h8_t v = *(const h8_t*)(qp + 16 * ks);
            h8_t w;
#pragma unroll
            for (int j = 0; j < 8; ++j) w[j] = (f16)((float)v[j] * sc);
            Qf[ks] = w;
        }
    }
    unsigned allowed = 0xffu;
    if (VAR == 2) {
        const int own = qt;
        const float* km = (const float*)(p.ws + WS_KMEAN) + ((size_t)b * HC + (hh - HA - HB)) * MOBA_NB * HD + 8 * hf;
        float gs[MOBA_NB];
#pragma unroll
        for (int j = 0; j < MOBA_NB; ++j) gs[j] = -INFINITY;
#pragma unroll
        for (int j = 0; j < MOBA_NB - 1; ++j) {
            if (j < own) {
                float s = 0.f;
#pragma unroll
                for (int ks = 0; ks < 8; ++ks) {
                    const f32x4 k0 = *(const f32x4*)(km + j * HD + 16 * ks), k1 = *(const f32x4*)(km + j * HD + 16 * ks + 4);
                    s += (float)Qf[ks][0] * k0[0] + (float)Qf[ks][1] * k0[1] + (float)Qf[ks][2] * k0[2] + (float)Qf[ks][3] * k0[3]
                       + (float)Qf[ks][4] * k1[0] + (float)Qf[ks][5] * k1[1] + (float)Qf[ks][6] * k1[2] + (float)Qf[ks][7] * k1[3];
                }
                gs[j] = s + __shfl_xor(s, 32);
            }
        }
        allowed = 1u << own;
#pragma unroll
        for (int j = 0; j < MOBA_NB - 1; ++j) {
            if (j < own) {
                int rank = 0;
#pragma unroll
                for (int k2 = 0; k2 < MOBA_NB - 1; ++k2) if (k2 < own && (gs[k2] > gs[j] || (gs[k2] == gs[j] && k2 < j))) ++rank;
                if (rank < 3) allowed |= 1u << j;
            }
        }
    }
    f32x16 O[4];
#pragma unroll
    for (int dt = 0; dt < 4; ++dt)
#pragma unroll
        for (int r = 0; r < 16; ++r) O[dt][r] = 0.f;
    float m_run = -INFINITY, l_run = 0.f, carry = 0.f;
    const int nst = (qt + 1) * 4;
    const int st_hi_w = qt * 4 + (wid >> 1);
    const int sr0 = tid >> 4, sc0 = tid & 15;
    const f16* kg = proj + ((size_t)b * SEQ + sr0) * INWP + kc + 8 * sc0;
    const f16* vg = proj + ((size_t)b * SEQ + sr0) * INWP + vc + 8 * sc0;
    const unsigned kw = sr0 * AT_KSTR + 16 * sc0, vw = AT_KBYTES + sr0 * AT_VSTR + 16 * sc0;
    const unsigned* mrow = (const unsigned*)(p.ws + WS_MASK) + grow * 64;
    const unsigned ka = qn * AT_KSTR + 16 * hf;
    const unsigned va = AT_KBYTES + (4 * hf + ((lane & 15) >> 2)) * AT_VSTR + (16 * ((lane >> 4) & 1) + 4 * (lane & 3)) * 2;
    u32x4 rk0, rk1, rv0, rv1; u32x2 mw = {0u, 0u}, mwn = {0u, 0u};
#define AT_LOAD(st_) do { const size_t o_ = (size_t)(st_) * 64 * INWP; rk0 = *(const u32x4*)(kg + o_); rk1 = *(const u32x4*)(kg + o_ + (size_t)32 * INWP); \
        rv0 = *(const u32x4*)(vg + o_); rv1 = *(const u32x4*)(vg + o_ + (size_t)32 * INWP); if (VAR == 0) mwn = *(const u32x2*)(mrow + 2 * (st_)); } while (0)
#define AT_WRITE(buf_) do { LAS unsigned char* b_ = lds + (buf_) * AT_STAGE; *(LAS u32x4*)(b_ + kw) = rk0; *(LAS u32x4*)(b_ + kw + 32 * AT_KSTR) = rk1; \
        *(LAS u32x4*)(b_ + vw) = rv0; *(LAS u32x4*)(b_ + vw + 32 * AT_VSTR) = rv1; } while (0)
    __syncthreads();
    AT_LOAD(nst - 1); AT_WRITE(0); mw = mwn;
    __syncthreads();
    int cur = 0;
    bool wdone = false;
    for (int st = nst - 1; st >= 0; --st) {
        if (st > 0) AT_LOAD(st - 1);
        if (st <= st_hi_w && !wdone) {
            LAS unsigned char* kb = lds + cur * AT_STAGE;
            f32x16 S[2];
#pragma unroll
            for (int r = 0; r < 16; ++r) { S[0][r] = 0.f; S[1][r] = 0.f; }
#pragma unroll
            for (int ks = 0; ks < 8; ++ks) {
                const h8_t a0 = *(const LAS h8_t*)(kb + ka + 32 * ks), a1 = *(const LAS h8_t*)(kb + ka + 32 * ks + 32 * AT_KSTR);
                S[0] = __builtin_amdgcn_mfma_f32_32x32x16_f16(a0, Qf[ks], S[0], 0, 0, 0);
                S[1] = __builtin_amdgcn_mfma_f32_32x32x16_f16(a1, Qf[ks], S[1], 0, 0, 0);
            }
            const bool diag = (64 * st + 63 > q0 + 32 * wid);
            const int kbase = 64 * st + 4 * hf;
            if (VAR != 1) {
                const bool blk_ok = (VAR == 2) ? ((allowed >> (st >> 2)) & 1u) : true;
                float mx = -INFINITY;
                if (VAR == 2 && !diag) {
                    const float bias = blk_ok ? 0.f : -INFINITY;
#pragma unroll
                    for (int sub = 0; sub < 2; ++sub)
#pragma unroll
                        for (int r = 0; r < 16; ++r) { const float v = S[sub][r] + bias; S[sub][r] = v; mx = fmaxf(mx, v); }
                } else {
#pragma unroll
                for (int sub = 0; sub < 2; ++sub)
#pragma unroll
                    for (int r = 0; r < 16; ++r) {
                        const int kl = (r & 3) + 8 * (r >> 2);
                        bool ok;
                        if (VAR == 0) ok = ((sub == 0 ? mw.x : mw.y) >> (kl + 4 * hf)) & 1u;
                        else ok = blk_ok && (!diag || (kbase + 32 * sub + kl <= qrow));
                        const float v = ok ? S[sub][r] : -INFINITY;
                        S[sub][r] = v; mx = fmaxf(mx, v);
                    }
                }
                mx = fmaxf(mx, __shfl_xor(mx, 32));
                const float m_new = fmaxf(m_run, mx);
                const float m_use = (m_new == -INFINITY) ? 0.f : m_new;
                const float alpha = fexp2(m_run - m_use);
                float ps = 0.f;
#pragma unroll
                for (int sub = 0; sub < 2; ++sub)
#pragma unroll
                    for (int r = 0; r < 16; ++r) { const float e = fexp2(S[sub][r] - m_use); S[sub][r] = e; ps += e; }
                l_run = l_run * alpha + ps;
                m_run = m_new;
                if (__ballot(alpha != 1.f) != 0ull) {
#pragma unroll
                    for (int dt = 0; dt < 4; ++dt)
#pragma unroll
                        for (int r = 0; r < 16; ++r) O[dt][r] *= alpha;
                }
            } else {
#pragma unroll
                for (int sub = 1; sub >= 0; --sub) {
                    float lk[16];
#pragma unroll
                    for (int r = 0; r < 16; ++r) {
                        const int kl = (r & 3) + 8 * (r >> 2);
                        const bool ok = !diag || (kbase + 32 * sub + kl < qrow);
                        const float zl = S[sub][r];
                        const float sp = fmaxf(zl, 0.f) + flog2(1.f + fexp2(-fabsf(zl)));
                        lk[r] = ok ? -sp : 0.f;
                        S[sub][r] = ok ? zl : -INFINITY;
                    }
                    float gsum[4], pg[4], T[4];
#pragma unroll
                    for (int g = 0; g < 4; ++g) { gsum[g] = (lk[4 * g] + lk[4 * g + 1]) + (lk[4 * g + 2] + lk[4 * g + 3]); pg[g] = __shfl_xor(gsum[g], 32); T[g] = gsum[g] + pg[g]; }
                    float after[4];
                    after[3] = 0.f; after[2] = T[3]; after[1] = T[3] + T[2]; after[0] = T[3] + T[2] + T[1];
#pragma unroll
                    for (int g = 0; g < 4; ++g) {
                        const float base = carry + after[g] + (hf == 0 ? pg[g] : 0.f);
                        const float c3 = lk[4 * g + 3], c2 = lk[4 * g + 2] + c3, c1 = lk[4 * g + 1] + c2, c0 = lk[4 * g] + c1;
                        S[sub][4 * g + 3] = fexp2(S[sub][4 * g + 3] + base + c3);
                        S[sub][4 * g + 2] = fexp2(S[sub][4 * g + 2] + base + c2);
                        S[sub][4 * g + 1] = fexp2(S[sub][4 * g + 1] + base + c1);
                        S[sub][4 * g + 0] = fexp2(S[sub][4 * g + 0] + base + c0);
                    }
                    carry += (T[0] + T[1]) + (T[2] + T[3]);
                }
            }
#pragma unroll
            for (int sub = 0; sub < 2; ++sub)
#pragma unroll
                for (int s2 = 0; s2 < 2; ++s2) {
                    h8_t pb;
#pragma unroll
                    for (int j = 0; j < 8; ++j) pb[j] = (f16)S[sub][8 * s2 + j];
#pragma unroll
                    for (int dt = 0; dt < 4; ++dt) {
                        const LAS unsigned char* ap = kb + va + (32 * sub + 16 * s2) * AT_VSTR + 64 * dt;
                        const s4_t t0 = __builtin_amdgcn_ds_read_tr16_b64_v4i16((LAS s4_t*)ap);
                        const s4_t t1 = __builtin_amdgcn_ds_read_tr16_b64_v4i16((LAS s4_t*)(ap + 8 * AT_VSTR));
                        typedef short s8_t __attribute__((ext_vector_type(8)));
                        const s8_t a8 = __builtin_shufflevector(t0, t1, 0, 1, 2, 3, 4, 5, 6, 7);
                        O[dt] = __builtin_amdgcn_mfma_f32_32x32x16_f16(__builtin_bit_cast(h8_t, a8), pb, O[dt], 0, 0, 0);
                    }
                }
        }
        if (VAR == 1) {
            if (st <= st_hi_w && !wdone) wdone = (__ballot(carry < -100.f) == ~0ull);
            if (lane == 0) *(LAS unsigned*)(lds + 2 * AT_STAGE + 32 * (st & 1) + 4 * wid) = wdone ? 1u : 0u;
        }
        if (st > 0) { AT_WRITE(cur ^ 1); }
        mw = mwn;
        __syncthreads();
        cur ^= 1;
        if (VAR == 1) {
            unsigned alld = 1u;
#pragma unroll
            for (int w = 0; w < NWAVES; ++w) alld &= *(const LAS unsigned*)(lds + 2 * AT_STAGE + 32 * (st & 1) + 4 * w);
            if (alld) break;
        }
    }
#undef AT_LOAD
#undef AT_WRITE
    float inv = 1.f;
    if (VAR != 1) { const float lt = l_run + __shfl_xor(l_run, 32); inv = 1.f / lt; }
    float ss = 0.f;
#pragma unroll
    for (int dt = 0; dt < 4; ++dt)
#pragma unroll
        for (int r = 0; r < 16; ++r) { const float v = O[dt][r] * inv; O[dt][r] = v; ss += v * v; }
    ss += __shfl_xor(ss, 32);
    const float rstd = rsqrtf(ss * (1.f / HD) + EPS);
    f16* yp = (f16*)(p.ws + WS_Y) + grow * DM + hh * HD + 4 * hf;
    const float* gp = ong + hh * HD + 4 * hf;
    f32x4 gg[4][4];
#pragma unroll
    for (int dt = 0; dt < 4; ++dt)
#pragma unroll
        for (int g = 0; g < 4; ++g) gg[dt][g] = *(const f32x4*)(gp + 32 * dt + 8 * g);
    __builtin_amdgcn_sched_barrier(0);
#pragma unroll
    for (int dt = 0; dt < 4; ++dt)
#pragma unroll
        for (int g = 0; g < 4; ++g) {
            u32x2 w; w.x = pack_h2(O[dt][4 * g] * rstd * gg[dt][g][0], O[dt][4 * g + 1] * rstd * gg[dt][g][1]); w.y = pack_h2(O[dt][4 * g + 2] * rstd * gg[dt][g][2], O[dt][4 * g + 3] * rstd * gg[dt][g][3]);
            *(u32x2*)(yp + 32 * dt + 8 * g) = w;
        }
}

__device__ __forceinline__ void phase_attn2(const Params& p, LAS unsigned char* lds, const float* ong, unsigned* queue) {
    for (;;) {
        __syncthreads();
        if (threadIdx.x == 0) *(LAS unsigned*)(lds + 2 * AT_STAGE + 96) = __hip_atomic_fetch_add(queue, 1u, __ATOMIC_RELAXED, __HIP_MEMORY_SCOPE_AGENT);
        __syncthreads();
        const int idx = (int)*(const LAS unsigned*)(lds + 2 * AT_STAGE + 96);
        if (idx >= NB * NHEADS * 8) break;
        int qt, b, hh;
        if (idx < 704) { qt = 7 - idx / 88; const int r = idx % 88; b = r / 11; const int h11 = r % 11; hh = h11 < HA ? h11 : h11 + HB; }
        else { const int r = idx - 704; qt = 7 - r / 40; b = (r % 40) / 5; hh = HA + (r % 5); }
        if (hh < HA) attn_item<0>(p, lds, ong, b, hh, qt, C_QA + hh * HD, C_KA, C_VA);
        else if (hh < HA + HB) attn_item<1>(p, lds, ong, b, hh, qt, C_QB + (hh - HA) * HD, C_KB + (hh - HA) * HD, C_VB + (hh - HA) * HD);
        else attn_item<2>(p, lds, ong, b, hh, qt, C_QC + (hh - HA - HB) * HD, C_KC + (hh - HA - HB) * HD, C_VC + (hh - HA - HB) * HD);
    }
}

#define CE_DESC(a, b) do { const unsigned _x = (a) > (b) ? (a) : (b), _y = (a) > (b) ? (b) : (a); (a) = _x; (b) = _y; } while (0)
__device__ __forceinline__ void sort16_desc(unsigned (&k)[16]) {
#pragma unroll
    for (int kk = 2; kk <= 16; kk <<= 1)
#pragma unroll
        for (int j = kk >> 1; j > 0; j >>= 1)
#pragma unroll
            for (int i = 0; i < 16; ++i) { const int l = i ^ j; if (l > i) { if ((i & kk) == 0) CE_DESC(k[i], k[l]); else CE_DESC(k[l], k[i]); } }
}
__device__ __forceinline__ void merge16_desc(unsigned (&a)[16], const unsigned (&b)[16]) {
#pragma unroll
    for (int i = 0; i < 16; ++i) a[i] = a[i] > b[15 - i] ? a[i] : b[15 - i];
#pragma unroll
    for (int j = 8; j > 0; j >>= 1)
#pragma unroll
        for (int i = 0; i < 16; ++i) { const int l = i ^ j; if (l > i) CE_DESC(a[i], a[l]); }
}
__device__ __forceinline__ unsigned f2sort(float f) { const unsigned b = __float_as_uint(f); return b ^ ((unsigned)((int)b >> 31) | 0x80000000u); }
__device__ __forceinline__ float sort2f(unsigned u) { const unsigned b = (u & 0x80000000u) ? (u ^ 0x80000000u) : ~u; return __uint_as_float(b); }
constexpr int RT_STR = 272;
__device__ __forceinline__ void phase_route2(const Params& p, LAS unsigned char* lds, const f16* subk) {
    const f16* qp = (const f16*)(p.ws + WS_Y);
    unsigned* pe = (unsigned*)(p.ws + WS_PE); float* pg = (float*)(p.ws + WS_PG);
    const int tid = otid(), wid = __builtin_amdgcn_readfirstlane(tid >> 6), lane = tid & 63, qn = lane & 31, hf = lane >> 5;
    for (int item = obid(); item < 256; item += gridDim.x) {
        const int hp = item & 7, tg = item >> 3;
        __syncthreads();
        {
            const f16* src = subk + (size_t)hp * 256 * 128;
#pragma unroll
            for (int i = 0; i < 8; ++i) { const int e = tid + i * 512, r = e >> 4, c = e & 15; *(LAS u32x4*)(lds + r * RT_STR + 16 * c) = *(const u32x4*)(src + r * 128 + 8 * c); }
        }
        __syncthreads();
#pragma unroll 1
        for (int it = 0; it < 2; ++it) {
            const int t = (tg * 16 + wid * 2 + it) * 32 + qn;
            unsigned top[2][16];
#pragma unroll
            for (int c = 0; c < 2; ++c) {
                h8_t Bq[8];
                const f16* qrow = qp + (size_t)t * DM + hp * 256 + c * 128 + 8 * hf;
#pragma unroll
                for (int ks = 0; ks < 8; ++ks) Bq[ks] = *(const h8_t*)(qrow + 16 * ks);
                unsigned run[16];
#pragma unroll 1
                for (int nt = 0; nt < 4; ++nt) {
                    f32x16 S;
#pragma unroll
                    for (int r = 0; r < 16; ++r) S[r] = 0.f;
#pragma unroll
                    for (int ks = 0; ks < 8; ++ks) {
                        const h8_t a = *(const LAS h8_t*)(lds + (c * 128 + nt * 32 + qn) * RT_STR + 32 * ks + 16 * hf);
                        S = __builtin_amdgcn_mfma_f32_32x32x16_f16(a, Bq[ks], S, 0, 0, 0);
                    }
                    unsigned k[16];
#pragma unroll
                    for (int r = 0; r < 16; ++r) { const int n = 32 * nt + (r & 3) + 8 * (r >> 2) + 4 * hf; k[r] = (f2sort(S[r]) & ~127u) | (unsigned)(127 - n); }
                    sort16_desc(k);
                    if (nt == 0) {
#pragma unroll
                        for (int r = 0; r < 16; ++r) run[r] = k[r];
                    } else merge16_desc(run, k);
                }
#pragma unroll
                for (int r = 0; r < 16; ++r) top[c][r] = run[r];
            }
            unsigned mine[16], oth[16];
#pragma unroll
            for (int r = 0; r < 16; ++r) { const unsigned send = hf ? top[0][r] : top[1][r]; oth[r] = __shfl_xor(send, 32); mine[r] = hf ? top[1][r] : top[0][r]; }
            merge16_desc(mine, oth);
            unsigned ka[16], kb2[16];
#pragma unroll
            for (int r = 0; r < 16; ++r) { const unsigned o = __shfl_xor(mine[r], 32); ka[r] = hf ? o : mine[r]; kb2[r] = hf ? mine[r] : o; }
            float sa[16], sb[16]; unsigned na[4] = {0u, 0u, 0u, 0u}, nb[4] = {0u, 0u, 0u, 0u};
#pragma unroll
            for (int r = 0; r < 16; ++r) {
                sa[r] = sort2f(ka[r] & ~127u); sb[r] = sort2f(kb2[r] & ~127u);
                na[r >> 2] |= (127u - (ka[r] & 127u)) << (8 * (r & 3)); nb[r >> 2] |= (127u - (kb2[r] & 127u)) << (8 * (r & 3));
            }
            unsigned cand[4][16];
#pragma unroll
            for (int g = 0; g < 4; ++g)
#pragma unroll
                for (int r = 0; r < 16; ++r) cand[g][r] = 0u;
#pragma unroll
            for (int slot = 0; slot < 50; ++slot) {
                constexpr unsigned char CIJ[64] = {0, 1, 2, 3, 4, 5, 6, 7, 8, 9, 10, 11, 12, 13, 14, 15, 16, 17, 18, 19, 20, 21, 22, 23, 32, 33, 34, 35, 36, 48, 49, 50, 51, 64, 65, 66, 80, 81, 96, 97, 112, 113, 128, 144, 160, 176, 192, 208, 224, 240, 255, 255, 255, 255, 255, 255, 255, 255, 255, 255, 255, 255, 255, 255};
                const int ij = CIJ[slot], i = ij >> 4, j = ij & 15;
                cand[slot >> 4][slot & 15] = (f2sort(sa[i] + sb[j]) & ~255u) | (unsigned)(255 - ij);
            }
#pragma unroll
            for (int g = 1; g < 4; ++g) sort16_desc(cand[g]);
            merge16_desc(cand[0], cand[1]); merge16_desc(cand[2], cand[3]); merge16_desc(cand[0], cand[2]);
            float ex[16]; float sum = 0.f;
            const float mx = sort2f(cand[0][0] & ~255u);
#pragma unroll
            for (int r = 0; r < 16; ++r) { ex[r] = __expf(sort2f(cand[0][r] & ~255u) - mx); sum += ex[r]; }
            const float inv = 1.f / sum;
            unsigned eo[16];
#pragma unroll
            for (int r = 0; r < 16; ++r) {
                const unsigned id = 255u - (cand[0][r] & 255u), i = id >> 4, j = id & 15u;
                const unsigned wa = (i & 8u) ? ((i & 4u) ? na[3] : na[2]) : ((i & 4u) ? na[1] : na[0]);
                const unsigned wb = (j & 8u) ? ((j & 4u) ? nb[3] : nb[2]) : ((j & 4u) ? nb[1] : nb[0]);
                eo[r] = ((wa >> (8 * (i & 3u))) & 255u) * PNK + ((wb >> (8 * (j & 3u))) & 255u);
                ex[r] *= inv;
            }
            if (hf == 0) {
#pragma unroll
                for (int r4 = 0; r4 < 4; ++r4) { u32x4 w; w.x = eo[4 * r4]; w.y = eo[4 * r4 + 1]; w.z = eo[4 * r4 + 2]; w.w = eo[4 * r4 + 3]; *(u32x4*)(pe + (size_t)t * 128 + hp * 16 + 4 * r4) = w; }
            } else {
#pragma unroll
                for (int r4 = 0; r4 < 4; ++r4) { f32x4 w; w[0] = ex[4 * r4]; w[1] = ex[4 * r4 + 1]; w[2] = ex[4 * r4 + 2]; w[3] = ex[4 * r4 + 3]; *(f32x4*)(pg + (size_t)t * 128 + hp * 16 + 4 * r4) = w; }
            }
        }
    }
}

#ifndef EXU_NR
#define EXU_NR 8
#define EXU_SH 11
#endif
__device__ __forceinline__ float gelu_as(float v) {
    const float av = fabsf(v), t = __builtin_amdgcn_rcpf(av * 0.2316418882f + 1.0f);
    float q = t * 0.5307027145f + (-0.7265760135f); q = q * t + 0.7107068705f; q = q * t + (-0.142248368f); q = q * t + 0.127414796f; q = q * t;
    const float e = __builtin_amdgcn_exp2f((v * v) * (-0.72134752044f));
    const float m = v * (q * e);
    return v < 0.f ? m : v - m;
}
__device__ __forceinline__ int row16_sum(int d) {
    d += __builtin_amdgcn_update_dpp(0, d, 0xB1, 0xF, 0xF, true);
    d += __builtin_amdgcn_update_dpp(0, d, 0x4E, 0xF, 0xF, true);
    d += __builtin_amdgcn_update_dpp(0, d, 0x141, 0xF, 0xF, true);
    d += __builtin_amdgcn_update_dpp(0, d, 0x140, 0xF, 0xF, true);
    return d;
}
__device__ __forceinline__ unsigned xcc_id() { return (unsigned)__builtin_amdgcn_s_getreg((3 << 11) | 20) & 0xFu; }
template <int BITS>
__device__ __forceinline__ void phase_exu(const Params& p, LAS unsigned char* lds, const unsigned char* u8, const float* su, const float* sv) {
    const int tid = otid(), wid = __builtin_amdgcn_readfirstlane(tid >> 6), lane = tid & 63, sub = lane & 15, qd = lane >> 4;
    const unsigned* pe = (const unsigned*)(p.ws + WS_PE); const float* pg = (const float*)(p.ws + WS_PG);
    const unsigned char* h8 = (const unsigned char*)(p.ws + WS_H8); const float* shv = (const float*)(p.ws + WS_SH);
    unsigned* list = (unsigned*)(p.ws + WS_LIST);
    const unsigned* ctl = (const unsigned*)(p.ws + WS_CTL);
    const unsigned myx = *(const LAS unsigned*)(lds + LDS_BYTES - 16), mybi = *(const LAS unsigned*)(lds + LDS_BYTES - 12);
    int G = 0, g = 0, nb = 1;
#pragma unroll
    for (int j = 0; j < 16; ++j) { const unsigned c = __builtin_amdgcn_readfirstlane(__hip_atomic_load(ctl + j, __ATOMIC_RELAXED, __HIP_MEMORY_SCOPE_AGENT)); if (c > 0u) { if ((unsigned)j < myx) ++g; ++G; } if ((unsigned)j == myx) nb = (int)c; }
    const int tstep = nb * NWAVES, tfirst = (int)mybi * NWAVES + wid;
    const int nvis_t = (tfirst < NT) ? (NT - tfirst + tstep - 1) / tstep : 0;
    const int nrange = (EXU_NR - g + G - 1) / G;
    const int nvis = nvis_t * nrange;
    const int* hsv = (const int*)(p.ws + WS_HS);
    unsigned ne0 = 0u, ne1 = 0u; u32x4 nhv[8]; float nsh = 0.f; int nhs = 0;
#define EXU_FETCH(v_) do { const int tt_ = tfirst + ((v_) % nvis_t) * tstep; ne0 = pe[(size_t)tt_ * 128 + lane]; ne1 = pe[(size_t)tt_ * 128 + 64 + lane]; \
        _Pragma("unroll") for (int m = 0; m < 8; ++m) nhv[m] = *(const u32x4*)(h8 + (size_t)tt_ * DM + (BITS == 8 ? 256 * m + 16 * sub : 512 * (m >> 1) + 32 * sub + 16 * (m & 1))); nsh = shv[tt_]; if (BITS == 4) nhs = hsv[tt_]; } while (0)
    if (nvis > 0) EXU_FETCH(0);
    for (int v = 0; v < nvis; ++v) {
        const int t = tfirst + (v % nvis_t) * tstep, r = g + (v / nvis_t) * G;
        const unsigned e0 = ne0, e1 = ne1; const float sht = nsh; const int hs8 = 8 * nhs;
        u32x4 hv[8];
#pragma unroll
        for (int m = 0; m < 8; ++m) hv[m] = nhv[m];
        if (v + 1 < nvis) EXU_FETCH(v + 1);
        const bool in0 = (int)(e0 >> EXU_SH) == r, in1 = (int)(e1 >> EXU_SH) == r;
        const unsigned long long m0 = __ballot(in0), m1 = __ballot(in1);
        const int n0 = __builtin_popcountll(m0), n = n0 + __builtin_popcountll(m1);
        if (n == 0) continue;
        LAS unsigned* wl = (LAS unsigned*)(lds + wid * 1024 + (v & 1) * 512);
        const unsigned long long below = (1ull << lane) - 1ull;
        if (in0) wl[__builtin_popcountll(m0 & below)] = ((unsigned)lane << 16) | e0;
        if (in1) wl[n0 + __builtin_popcountll(m1 & below)] = ((unsigned)(lane + 64) << 16) | e1;
        __builtin_amdgcn_wave_barrier();
        constexpr int PPI = 4;
        constexpr int PPQ = PPI / 4, NLD = (BITS == 8) ? 8 : 4;
        const int nit = (n + PPI - 1) / PPI;
        u32x4 wb[2][8]; unsigned entb[2][PPQ]; float sub_[2][PPQ], svb_[2][PPQ], pgb_[2][PPQ];
#define EXU_ISSUE(B_, it_) do { _Pragma("unroll") for (int pp = 0; pp < PPQ; ++pp) { const int idx_ = (it_) * PPI + qd * PPQ + pp; entb[B_][pp] = wl[idx_ < n ? idx_ : 0]; \
            sub_[B_][pp] = su[entb[B_][pp] & 0xffffu]; svb_[B_][pp] = sv[entb[B_][pp] & 0xffffu]; pgb_[B_][pp] = pg[(size_t)t * 128 + (entb[B_][pp] >> 16)]; \
            const unsigned char* row_ = u8 + (size_t)(entb[B_][pp] & 0xffffu) * (BITS == 8 ? DM : DM / 2) + 16 * sub; \
            _Pragma("unroll") for (int m = 0; m < NLD; ++m) wb[B_][pp * NLD + m] = *(const u32x4*)(row_ + 256 * m); } } while (0)
#define EXU_COMPUTE(B_, it_) do { _Pragma("unroll") for (int pp = 0; pp < PPQ; ++pp) { int d_ = 0; \
            if (BITS == 8) { \
            _Pragma("unroll") for (int m = 0; m < 8; ++m) { const u32x4 w_ = wb[B_][m]; \
                d_ = __builtin_amdgcn_sdot4((int)hv[m].x, (int)w_.x, d_, false); d_ = __builtin_amdgcn_sdot4((int)hv[m].y, (int)w_.y, d_, false); \
                d_ = __builtin_amdgcn_sdot4((int)hv[m].z, (int)w_.z, d_, false); d_ = __builtin_amdgcn_sdot4((int)hv[m].w, (int)w_.w, d_, false); } \
            } else { \
            _Pragma("unroll") for (int m = 0; m < 4; ++m) { const u32x4 w_ = wb[B_][pp * 4 + m]; const u32x4 ha_ = hv[2 * m], hb_ = hv[2 * m + 1]; \
                d_ = __builtin_amdgcn_sdot4((int)ha_.x, (int)(w_.x & 0x0F0F0F0Fu), d_, false); d_ = __builtin_amdgcn_sdot4((int)ha_.y, (int)((w_.x >> 4) & 0x0F0F0F0Fu), d_, false); \
                d_ = __builtin_amdgcn_sdot4((int)ha_.z, (int)(w_.y & 0x0F0F0F0Fu), d_, false); d_ = __builtin_amdgcn_sdot4((int)ha_.w, (int)((w_.y >> 4) & 0x0F0F0F0Fu), d_, false); \
                d_ = __builtin_amdgcn_sdot4((int)hb_.x, (int)(w_.z & 0x0F0F0F0Fu), d_, false); d_ = __builtin_amdgcn_sdot4((int)hb_.y, (int)((w_.z >> 4) & 0x0F0F0F0Fu), d_, false); \
                d_ = __builtin_amdgcn_sdot4((int)hb_.z, (int)(w_.w & 0x0F0F0F0Fu), d_, false); d_ = __builtin_amdgcn_sdot4((int)hb_.w, (int)((w_.w >> 4) & 0x0F0F0F0Fu), d_, false); } \
            } \
            d_ = row16_sum(d_); \
            if (BITS == 4) d_ -= hs8; \
            if (((it_) * PPI + qd * PPQ + pp < n) && sub == 0) { \
                const unsigned ent_ = entb[B_][pp], j_ = ent_ >> 16, e_ = ent_ & 0xffffu; \
                const float dd_ = (float)d_ * sub_[B_][pp] * sht; \
                const float act_ = gelu_as(dd_); \
                const float coef_ = pgb_[B_][pp] * svb_[B_][pp] * act_ * (1024.f * 256.f); \
                const int ci_ = (int)rintf(fminf(fmaxf(coef_, -32767.f), 32767.f)); \
                list[((size_t)(j_ >> 2) * NT + t) * 4 + (j_ & 3u)] = e_ | ((unsigned)ci_ << 16); } } } while (0)
        EXU_ISSUE(0, 0);
        int it = 0;
        for (; it + 2 < nit; it += 2) {
            EXU_ISSUE(1, it + 1); EXU_COMPUTE(0, it);
            EXU_ISSUE(0, it + 2); EXU_COMPUTE(1, it + 1);
        }
        if (it + 2 == nit) { EXU_ISSUE(1, it + 1); EXU_COMPUTE(0, it); EXU_COMPUTE(1, it + 1); }
        else { EXU_COMPUTE(0, it); }
#undef EXU_ISSUE
#undef EXU_COMPUTE
    }
#undef EXU_FETCH
}

__device__ __forceinline__ void phase_exv(const Params& p, LAS unsigned char* lds, const f16* x1, const float* gate2, const unsigned char* v8c, f16* xout) {
    const int tid = otid();
    const u32x4* list = (const u32x4*)(p.ws + WS_LIST);
    int cfirst = obid(), cstep = gridDim.x;
    {
        const unsigned* ctl = (const unsigned*)(p.ws + WS_CTL);
        const unsigned myx = *(const LAS unsigned*)(lds + LDS_BYTES - 16), mybi = *(const LAS unsigned*)(lds + LDS_BYTES - 12);
        int G = 0, g = 0, nb = 1; bool uniform = true; unsigned c0 = 0u;
#pragma unroll
        for (int j = 0; j < 16; ++j) { const unsigned c = __builtin_amdgcn_readfirstlane(__hip_atomic_load(ctl + j, __ATOMIC_RELAXED, __HIP_MEMORY_SCOPE_AGENT)); if (c > 0u) { if ((unsigned)j < myx) ++g; ++G; if (c0 == 0u) c0 = c; else if (c != c0) uniform = false; } if ((unsigned)j == myx) nb = (int)c; }
        if (uniform && G * nb == (int)gridDim.x && (int)gridDim.x == 256) { cfirst = g * nb + (int)mybi; cstep = 256; }
    }
    for (int c = cfirst; c < 256; c += cstep) {
        __syncthreads();
        {
            const u32x4* src = (const u32x4*)(v8c + (size_t)c * PEXP * 8);
#pragma unroll 4
            for (int i = 0; i < 16; ++i) *(LAS u32x4*)(lds + (size_t)(i * 512 + tid) * 16) = src[i * 512 + tid];
        }
        __syncthreads();
        typedef short s2_t __attribute__((ext_vector_type(2)));
        u32x4 wq[2][8];
        int acc[8]; int csum = 0;
#pragma unroll
        for (int k = 0; k < 8; ++k) acc[k] = 0;
        constexpr int NBATCH = (NT / NTHREADS) * 4;
#define EXV_LOAD(B_, q_) do { const int qq_ = (q_) < NBATCH ? (q_) : NBATCH - 1; const int t_ = tid + (qq_ >> 2) * NTHREADS, jb_ = qq_ & 3; \
            _Pragma("unroll") for (int j4 = 0; j4 < 8; ++j4) wq[B_][j4] = list[(size_t)(jb_ * 8 + j4) * NT + t_]; } while (0)
        EXV_LOAD(0, 0);
#pragma unroll 1
        for (int q0 = 0; q0 < NBATCH; q0 += 4) {
#pragma unroll
            for (int u = 0; u < 4; ++u) {
                const int q = q0 + u;
                if (q < NBATCH) {
                    EXV_LOAD((u + 1) % 2, q + 1);
#pragma unroll
                    for (int j4 = 0; j4 < 8; ++j4) {
                        const unsigned dd[4] = {wq[u % 2][j4].x, wq[u % 2][j4].y, wq[u % 2][j4].z, wq[u % 2][j4].w};
#pragma unroll
                        for (int h = 0; h < 2; ++h) {
                            const unsigned d0 = dd[2 * h], d1 = dd[2 * h + 1];
                            const u32x2 v0 = *(const LAS u32x2*)(size_t)((d0 << 3) & 0x7fff8u), v1 = *(const LAS u32x2*)(size_t)((d1 << 3) & 0x7fff8u);
                            const s2_t cp = __builtin_bit_cast(s2_t, __builtin_amdgcn_perm(d1, d0, 0x07060302u));
                            csum = __builtin_amdgcn_sdot2(cp, __builtin_bit_cast(s2_t, 0x00010001u), csum, false);
                            acc[0] = __builtin_amdgcn_sdot2(cp, __builtin_bit_cast(s2_t, __builtin_amdgcn_perm(v1.x, v0.x, 0x0c040c00u)), acc[0], false);
                            acc[1] = __builtin_amdgcn_sdot2(cp, __builtin_bit_cast(s2_t, __builtin_amdgcn_perm(v1.x, v0.x, 0x0c050c01u)), acc[1], false);
                            acc[2] = __builtin_amdgcn_sdot2(cp, __builtin_bit_cast(s2_t, __builtin_amdgcn_perm(v1.x, v0.x, 0x0c060c02u)), acc[2], false);
                            acc[3] = __builtin_amdgcn_sdot2(cp, __builtin_bit_cast(s2_t, __builtin_amdgcn_perm(v1.x, v0.x, 0x0c070c03u)), acc[3], false);
                            acc[4] = __builtin_amdgcn_sdot2(cp, __builtin_bit_cast(s2_t, __builtin_amdgcn_perm(v1.y, v0.y, 0x0c040c00u)), acc[4], false);
                            acc[5] = __builtin_amdgcn_sdot2(cp, __builtin_bit_cast(s2_t, __builtin_amdgcn_perm(v1.y, v0.y, 0x0c050c01u)), acc[5], false);
                            acc[6] = __builtin_amdgcn_sdot2(cp, __builtin_bit_cast(s2_t, __builtin_amdgcn_perm(v1.y, v0.y, 0x0c060c02u)), acc[6], false);
                            acc[7] = __builtin_amdgcn_sdot2(cp, __builtin_bit_cast(s2_t, __builtin_amdgcn_perm(v1.y, v0.y, 0x0c070c03u)), acc[7], false);
                        }
                    }
                    if ((u & 3) == 3) {
                        const int t = tid + (q >> 2) * NTHREADS;
                        const int b = t / SEQ, col = 8 * c;
                        const int off = csum << 7;
                        const u32x4 xw = *(const u32x4*)(x1 + (size_t)t * DM + col);
                        const unsigned xws[4] = {xw.x, xw.y, xw.z, xw.w};
                        u32x4 ow; unsigned ows[4];
#pragma unroll
                        for (int hfi = 0; hfi < 2; ++hfi) {
                            const f32x4 gt = *(const f32x4*)(gate2 + (size_t)b * 6 * DM + col + 4 * hfi);
                            float r[4];
#pragma unroll
                            for (int k = 0; k < 4; ++k) { const unsigned xx = xws[2 * hfi + (k >> 1)]; const float xi = (k & 1) ? h_hi(xx) : h_lo(xx); r[k] = xi + gt[k] * ((float)(acc[4 * hfi + k] - off) * (1.f / (1024.f * 256.f))); }
                            ows[2 * hfi] = pack_h2(r[0], r[1]); ows[2 * hfi + 1] = pack_h2(r[2], r[3]);
                        }
                        ow.x = ows[0]; ow.y = ows[1]; ow.z = ows[2]; ow.w = ows[3];
                        *(u32x4*)(xout + (size_t)t * DM + col) = ow;
                        csum = 0;
#pragma unroll
                        for (int k = 0; k < 8; ++k) acc[k] = 0;
                    }
                }
            }
        }
#undef EXV_LOAD
    }
}

#define XB_TMO      128
#define XB_XCNT(j)  (256  + 64 * (j))
#define XB_XSUB(j)  (1280 + 64 * (j))
#define XB_XGEN(j)  (2304 + 64 * (j))
#define XB_TOP      3328
#define XB_TOPGEN   3392
#define XCD_BAR_WORDS 3456
#define XB_SPIN_CAP (1u << 22)
__device__ __forceinline__ unsigned xb_ld(unsigned* p) { return __hip_atomic_load(p, __ATOMIC_RELAXED, __HIP_MEMORY_SCOPE_AGENT); }
__device__ __forceinline__ unsigned xb_add(unsigned* p, unsigned v) { return __hip_atomic_fetch_add(p, v, __ATOMIC_RELAXED, __HIP_MEMORY_SCOPE_AGENT); }
#define XB_SPIN(cond, bar) do { unsigned _sp = 0; while (cond) { __builtin_amdgcn_s_sleep(1); \
    if ((++_sp & 255u) == 0u) { if (xb_ld(&(bar)[XB_TMO])) break; if (_sp > XB_SPIN_CAP) { atomicAdd(&(bar)[XB_TMO], 1u); break; } } } } while (0)
struct XcdBarrier { unsigned* bar; unsigned x; volatile LAS unsigned* st; };
__device__ __forceinline__ void xcd_barrier_complete(unsigned* bar, unsigned x, unsigned& nloc, unsigned& nx) {
    const unsigned G = gridDim.x * gridDim.y * gridDim.z;
    unsigned sum, cnt, mine, sp = 0u;
    for (;;) {
        sum = 0u; cnt = 0u; mine = 0u;
#pragma unroll
        for (unsigned j = 0; j < 16; ++j) { const unsigned c = xb_ld(&bar[XB_XCNT(j)]); sum += c; cnt += (c > 0u) ? 1u : 0u; mine = (j == x) ? c : mine; }
        if (sum == G) break;
        __builtin_amdgcn_s_sleep(1);
        if ((++sp & 255u) == 0u) { if (xb_ld(&bar[XB_TMO])) break; if (sp > XB_SPIN_CAP) { atomicAdd(&bar[XB_TMO], 1u); break; } }
    }
    nloc = mine > 0u ? mine : 1u; nx = cnt > 0u ? cnt : 1u;
}
__device__ __forceinline__ void xcd_barrier(const XcdBarrier& b) {
    asm volatile("s_waitcnt vmcnt(0)" ::: "memory");
    __syncthreads();
    if (threadIdx.x == 0) {
        unsigned* bar = b.bar;
        __builtin_amdgcn_s_waitcnt(0);
        unsigned nloc = b.st[0], nx = b.st[1];
        if (nloc == 0u) { xcd_barrier_complete(bar, b.x, nloc, nx); b.st[0] = nloc; b.st[1] = nx; }
        const unsigned old = xb_add(&bar[XB_XSUB(b.x)], 1u);
        const unsigned gen = old / nloc;
        if (old + 1u == (gen + 1u) * nloc) {
            __builtin_amdgcn_fence(__ATOMIC_RELEASE, "agent");
            asm volatile("s_waitcnt vmcnt(0)" ::: "memory");
            const unsigned og = xb_add(&bar[XB_TOP], 1u);
            const unsigned tg = og / nx;
            if (og + 1u == (tg + 1u) * nx) xb_add(&bar[XB_TOPGEN], 1u);
            else XB_SPIN(xb_ld(&bar[XB_TOPGEN]) == tg, bar);
            __builtin_amdgcn_fence(__ATOMIC_ACQUIRE, "agent");
            xb_add(&bar[XB_XGEN(b.x)], 1u);
            asm volatile("s_waitcnt vmcnt(0)" ::: "memory");
        } else {
            XB_SPIN(xb_ld(&bar[XB_XGEN(b.x)]) == gen, bar);
            __builtin_amdgcn_fence(__ATOMIC_ACQUIRE, "agent");
            asm volatile("s_waitcnt vmcnt(0)" ::: "memory");
        }
    }
    __syncthreads();
}

constexpr int PH_CONV = 0, PH_N1 = 1, PH_L0 = 2, PH_PER_LAYER = 10, PH_TOTAL = PH_L0 + DEPTH * PH_PER_LAYER;

__global__ void __launch_bounds__(NTHREADS, 2) mega(Params p_arg) {
    extern __shared__ __attribute__((aligned(16))) unsigned char shm[];
    LAS unsigned char* lds = (LAS unsigned char*)shm;
    typedef const Params __attribute__((address_space(4)))* KP;
    const int ph_lo = p_arg.ph_lo, ph_hi = p_arg.ph_hi;
    if (threadIdx.x == 0) {
        const unsigned x = xcc_id();
        const unsigned bi = __hip_atomic_fetch_add((unsigned*)(p_arg.ws + WS_CTL) + x, 1u, __ATOMIC_RELAXED, __HIP_MEMORY_SCOPE_AGENT);
        *(LAS unsigned*)(lds + LDS_BYTES - 16) = x; *(LAS unsigned*)(lds + LDS_BYTES - 12) = bi;
        *(LAS unsigned*)(lds + LDS_BYTES - 32) = 0u; *(LAS unsigned*)(lds + LDS_BYTES - 28) = 0u;
        (void)xb_add((unsigned*)(p_arg.ws + WS_CTL + 256) + XB_XCNT(x), 1u);
    }
    __syncthreads();
    XcdBarrier xbar; xbar.bar = (unsigned*)(p_arg.ws + WS_CTL + 256); xbar.x = *(const LAS unsigned*)(lds + LDS_BYTES - 16); xbar.st = (volatile LAS unsigned*)(lds + LDS_BYTES - 32);
#ifndef PMASK
#define PMASK 0xff
#endif
#define EN(k) ((PMASK >> (k)) & 1)
    for (int ph = ph_lo; ph < ph_hi; ++ph) {
        KP kp = (KP)__builtin_amdgcn_kernarg_segment_ptr();
        asm volatile("" : "+s"(kp));
#if defined(__HIP_DEVICE_COMPILE__)
        const Params p = *kp;
#else
        const Params p = p_arg;
#endif
        unsigned char* ws = p.ws;
        const float* mod = (const float*)(ws + WS_MOD);
        int kind, l = 0, s = -1;
        if (ph == PH_CONV) kind = 0;
        else if (ph == PH_N1) kind = 1;
        else {
            l = (ph - PH_L0) / PH_PER_LAYER; s = (ph - PH_L0) % PH_PER_LAYER;
            kind = (s == 0 || s == 3 || s == 5) ? 2 : (s == 1 ? 4 : (s == 2 ? 5 : (s == 4 ? 1 : (s == 6 ? 6 : (s == 7 ? 7 : (s == 8 ? 8 : 9))))));
        }
        const float* modl = mod + (size_t)l * NB * 6 * DM;
        f16* x1 = (f16*)(ws + WS_X1); f16* x2 = (f16*)(ws + WS_X2);
#ifndef REPEAT_KIND
#define REPEAT_KIND -1
#endif
        for (int rep = 0; rep < ((kind == REPEAT_KIND) ? 2 : 1); ++rep) {
        if (rep == 1) xcd_barrier(xbar);
        if (kind == 0) { if (EN(0)) phase_conv(p, lds); }
        else if (kind == 1) {
            if (EN(1)) {
                if (s < 0) phase_norm2<0, false>(p.x, nullptr, nullptr, p.n1g, mod + 0 * DM, mod + 1 * DM, (f16*)(ws + WS_H), nullptr, nullptr);
                else phase_norm2<1, true>(nullptr, x1, nullptr, p.n2g + (size_t)l * DM, modl + 3 * DM, modl + 4 * DM, (f16*)(ws + WS_H), (unsigned*)(ws + WS_H8), (float*)(ws + WS_SH));
            }
        } else if (kind == 2) {
            if (EN(2)) {
                Epi E{}; const f16* A; const f16* Bt; int N;
                if (s == 0) { E.mode = 2; E.rope128 = (const float*)(ws + WS_ROPE128); E.rope64 = (const float*)(ws + WS_ROPE64); E.o16 = (f16*)(ws + WS_PROJ); E.ldc = INWP; A = (const f16*)(ws + WS_H); Bt = (const f16*)(ws + WS_WTIN) + (size_t)l * INWP * DM; N = INWP; }
                else if (s == 3) { E.mode = 1; E.o16 = x1; E.xin = p.x; E.xinh = l == 0 ? nullptr : x2; E.gate = modl + 2 * DM; A = (const f16*)(ws + WS_Y); Bt = (const f16*)(ws + WS_WTOUT) + (size_t)l * DM * DM; N = DM; }
                else { E.mode = 0; E.o16 = (f16*)(ws + WS_Y); E.ldc = DM; A = (const f16*)(ws + WS_H); Bt = (const f16*)(ws + WS_WTQ) + (size_t)l * DM * DM; N = DM; }
                gemm_run(p, lds, A, Bt, N, E);
            }
        }
        else if (kind == 4) { if (EN(4)) phase_index2(p, lds); }
        else if (kind == 5) { if (EN(5)) phase_attn2(p, lds, p.ong + (size_t)l * DM, (unsigned*)(ws + WS_CTL + 64) + l); }
        else if (kind == 6) { if (EN(6)) phase_route2(p, lds, (const f16*)(ws + WS_SUBK) + (size_t)l * PH * 2 * PNK * 128); }
        else if (kind == 7) {
            if (EN(7)) { if (l == DEPTH - 1 && LAST_BITS == 4) phase_exu<4>(p, lds, ws + WS_U8 + (size_t)l * PEXP * DM, (const float*)(ws + WS_SU) + (size_t)l * PEXP, (const float*)(ws + WS_SV) + (size_t)l * PEXP);
                         else phase_exu<8>(p, lds, ws + WS_U8 + (size_t)l * PEXP * DM, (const float*)(ws + WS_SU) + (size_t)l * PEXP, (const float*)(ws + WS_SV) + (size_t)l * PEXP); }
        } else if (kind == 8) {
            if (EN(7)) phase_exv(p, lds, x1, modl + 5 * DM, ws + WS_V8 + (size_t)l * PEXP * DM, x2);
        } else {
            const bool fin = (l == DEPTH - 1);
            const float* modn = mod + (size_t)(fin ? l : l + 1) * NB * 6 * DM;
            if (EN(1)) { if (fin) phase_norm2<2, true>(nullptr, x2, p.out, p.fg, nullptr, nullptr, nullptr, nullptr, nullptr);
                         else phase_norm2<0, true>(nullptr, x2, nullptr, p.n1g + (size_t)(l + 1) * DM, modn + 0 * DM, modn + 1 * DM, (f16*)(ws + WS_H), nullptr, nullptr); }
        }
        }
        if (ph + 1 < ph_hi) { if (ph == ph_lo) cg::this_grid().sync(); else xcd_barrier(xbar); }
    }
}

extern "C" void kernel_launch(void* const* d_in, const int* in_sizes, int n_in, void* d_out, int out_size, void* d_ws, size_t ws_size, hipStream_t stream) {
    static int grid = 0;
    if (grid == 0) {
        if (n_in != 14 || out_size != NT * DM || ws_size < WS_END) { fprintf(stderr, "kernel_launch: unexpected sizes (n_in %d out %d ws %zu need %zu)\n", n_in, out_size, ws_size, (size_t)WS_END); grid = -1; return; }
        if (hipFuncSetAttribute((const void*)mega, hipFuncAttributeMaxDynamicSharedMemorySize, LDS_BYTES) != hipSuccess) { fprintf(stderr, "kernel_launch: hipFuncSetAttribute failed\n"); grid = -1; return; }
        int dev = 0, cus = 0, per_cu = 0;
        hipGetDevice(&dev); hipDeviceGetAttribute(&cus, hipDeviceAttributeMultiprocessorCount, dev);
        hipOccupancyMaxActiveBlocksPerMultiprocessor(&per_cu, (const void*)mega, NTHREADS, LDS_BYTES);
        if (per_cu < 1) { fprintf(stderr, "kernel_launch: occupancy query says %d blocks per CU\n", per_cu); grid = -1; return; }
        grid = cus;
    }
    if (grid < 0) return;
    Params p{};
    p.x = (const float*)d_in[0]; p.c = (const float*)d_in[1]; p.ada_w = (const float*)d_in[2]; p.ada_b = (const float*)d_in[3];
    p.n1g = (const float*)d_in[4]; p.n2g = (const float*)d_in[5]; p.w_in = (const float*)d_in[6]; p.ong = (const float*)d_in[7];
    p.w_out = (const float*)d_in[8]; p.wq = (const float*)d_in[9]; p.subk = (const float*)d_in[10]; p.pu = (const float*)d_in[11];
    p.pv = (const float*)d_in[12]; p.fg = (const float*)d_in[13];
    p.out = (float*)d_out; p.ws = (unsigned char*)d_ws;
#if 0
    for (int ph = 0; ph < PH_TOTAL; ++ph) {
        p.ph_lo = ph; p.ph_hi = ph + 1;
        hipLaunchKernelGGL(mega, dim3(grid), dim3(NTHREADS), LDS_BYTES, stream, p);
    }
#else
    p.ph_lo = 0; p.ph_hi = PH_TOTAL;
    if (hipMemsetAsync((char*)d_ws + WS_CTL, 0, CTL_BYTES, stream) != hipSuccess) { fprintf(stderr, "kernel_launch: memset of control words failed\n"); return; }
    void* args[] = {&p};
    hipError_t e = hipLaunchCooperativeKernel((const void*)mega, dim3(grid), dim3(NTHREADS), args, LDS_BYTES, stream);
    if (e != hipSuccess) fprintf(stderr, "cooperative launch failed: %s (grid %d)\n", hipGetErrorString(e), grid);
#endif
}
```

```cpp
#include <hip/hip_runtime.h>
#include <hip/hip_cooperative_groups.h>
#include <cstdio>
#include <cstdint>
namespace cg = cooperative_groups;

#define LAS __attribute__((address_space(3)))
typedef _Float16 f16;
typedef _Float16 h2_t __attribute__((ext_vector_type(2)));
typedef _Float16 h4_t __attribute__((ext_vector_type(4)));
typedef _Float16 h8_t __attribute__((ext_vector_type(8)));
typedef float f32x4 __attribute__((ext_vector_type(4)));
typedef unsigned u32x4 __attribute__((ext_vector_type(4)));
typedef unsigned u32x2 __attribute__((ext_vector_type(2)));

constexpr int NB = 8, SEQ = 2048, DM = 2048, NT = NB * SEQ, DEPTH = 2;
constexpr int HD = 128, HA = 6, HB = 5, HC = 5, NHEADS = 16;
constexpr int IH = 16, IDM = 64, DSA_TOPK = 256;
constexpr int MOBA_BLK = 256, MOBA_NB = 8;
constexpr int INW = 5968, INWP = 6144;
constexpr int PH = 8, PNK = 128, PTOPK = 16, PEXP = 16384;
constexpr float EPS = 1e-6f;
constexpr int C_QA = 0, C_KA = 768, C_VA = 896, C_IQ = 1024, C_IK = 2048, C_IW = 2112, C_QB = 2176, C_KB = 2816, C_VB = 3456,
              C_QC = 4096, C_KC = 4736, C_VC = 5376, C_END = 6016;

#ifndef LAST_BITS
#define LAST_BITS 8
#endif
constexpr int NTHREADS = 512, NWAVES = 8;
constexpr int LDS_BYTES = 147456;

constexpr size_t al256(size_t x) { return (x + 255) & ~(size_t)255; }
constexpr size_t WS_WTIN = 0;
constexpr size_t WS_WTOUT = WS_WTIN + (size_t)DEPTH * INWP * DM * 2;
constexpr size_t WS_WTQ = WS_WTOUT + (size_t)DEPTH * DM * DM * 2;
constexpr size_t WS_U8 = WS_WTQ + (size_t)DEPTH * DM * DM * 2;
constexpr size_t WS_V8 = WS_U8 + (size_t)DEPTH * PEXP * DM;
constexpr size_t WS_SU = WS_V8 + (size_t)DEPTH * PEXP * DM;
constexpr size_t WS_SV = WS_SU + (size_t)DEPTH * PEXP * 4;
constexpr size_t WS_H8 = WS_SV + (size_t)DEPTH * PEXP * 4;
constexpr size_t WS_SH = WS_H8 + (size_t)NT * DM;
constexpr size_t WS_HS = WS_SH + (size_t)NT * 4;
constexpr size_t WS_SUBK = WS_HS + (size_t)NT * 4;
constexpr size_t WS_MOD = WS_SUBK + (size_t)DEPTH * PH * 2 * PNK * 128 * 2;
constexpr size_t WS_ROPE128 = WS_MOD + (size_t)DEPTH * NB * 6 * DM * 4;
constexpr size_t WS_ROPE64 = WS_ROPE128 + (size_t)SEQ * 64 * 8;
constexpr size_t WS_H = WS_ROPE64 + (size_t)SEQ * 32 * 8;
constexpr size_t WS_PROJ = WS_H + (size_t)NT * DM * 2;
constexpr size_t WS_KMEAN = WS_PROJ + (size_t)NT * INWP * 2;
constexpr size_t WS_MASK = WS_KMEAN + al256((size_t)NB * HC * MOBA_NB * HD * 4);
constexpr size_t WS_Y = WS_MASK + (size_t)NB * SEQ * 64 * 4;
constexpr size_t WS_X1 = WS_Y + (size_t)NT * DM * 2;
constexpr size_t WS_X2 = WS_X1 + (size_t)NT * DM * 2;
constexpr size_t WS_PE = WS_X1 + (size_t)NT * DM * 4;
constexpr size_t WS_PG = WS_PE + (size_t)NT * 128 * 4;
constexpr size_t WS_LIST = WS_PG + (size_t)NT * 128 * 4;
constexpr size_t WS_CTL = WS_LIST + (size_t)NT * 128 * 4;
constexpr size_t CTL_BYTES = 16384;
constexpr size_t WS_END = WS_CTL + CTL_BYTES;

struct Params {
    const float *x, *c, *ada_w, *ada_b, *n1g, *n2g, *w_in, *ong, *w_out, *wq, *subk, *pu, *pv, *fg;
    float* out;
    unsigned char* ws;
    int ph_lo, ph_hi;
};

__device__ __forceinline__ int otid() { int t = threadIdx.x; asm volatile("" : "+v"(t)); return t; }
__device__ __forceinline__ int obid() { int t = blockIdx.x; asm volatile("" : "+s"(t)); return t; }
__device__ __forceinline__ float wave_sum(float v) {
#pragma unroll
    for (int o = 32; o >= 1; o >>= 1) v += __shfl_xor(v, o);
    return v;
}
__device__ __forceinline__ float wave_max(float v) {
#pragma unroll
    for (int o = 32; o >= 1; o >>= 1) v = fmaxf(v, __shfl_xor(v, o));
    return v;
}
__device__ __forceinline__ unsigned pack_h2(float a, float b) { h2_t r; r.x = (f16)a; r.y = (f16)b; return __builtin_bit_cast(unsigned, r); }
__device__ __forceinline__ float h_lo(unsigned u) { h2_t r = __builtin_bit_cast(h2_t, u); return (float)r.x; }
__device__ __forceinline__ float h_hi(unsigned u) { h2_t r = __builtin_bit_cast(h2_t, u); return (float)r.y; }
__device__ __forceinline__ float dot2(unsigned a, unsigned b, float c) {
    return __builtin_amdgcn_fdot2(__builtin_bit_cast(h2_t, a), __builtin_bit_cast(h2_t, b), c, false);
}

namespace pg8 {
constexpr int BM = 256, BK = 64, HALF = 128, HTB = HALF * BK * 2, STAGE_BYTES = 8 * HTB, NXCD = 8, WGM = 8;
__host__ __device__ __forceinline__ int lds_byte(int r, int c) { const int st = (r >> 4) * 2 + (c >> 5), rr = r & 15, cc = c & 31, ob = rr * 64 + cc * 2; return st * 1024 + (ob ^ (((ob >> 9) & 1) << 5)); }
__host__ __device__ __forceinline__ void stage_rc(int b, int& R, int& C) { const int st = b / 1024, sb = b % 1024, swz = sb ^ (((sb >> 9) & 1) << 5); R = (st >> 1) * 16 + swz / 64; C = (st & 1) * 32 + (swz % 64) / 2; }
__host__ __device__ __forceinline__ int perm32(int rho) { const int n = rho >> 4, i = rho & 15; return 8 * (i >> 2) + 4 * n + (i & 3); }
struct Unit { int pm, pn; };
struct Gemm { const unsigned short* A; const unsigned short* Bt; int M, N, K; };
struct StaticOrder {
    int nM, nN, nwg, G, c;
    __host__ __device__ void init(int M, int N, int G_, int c_) { nM = M / BM; nN = N / BM; nwg = nM * nN; G = G_; c = c_; }
    __host__ __device__ bool next(int i, Unit& u) const {
        const long L = (long)i * G + c; if (L >= nwg) return false;
        int wgid = (int)L; { const int q = nwg / NXCD, r = nwg % NXCD, xcd = wgid % NXCD, off = wgid / NXCD; wgid = (xcd < r ? xcd * (q + 1) : r * (q + 1) + (xcd - r) * q) + off; }
        const int nig = WGM * nN, gid = wgid / nig, fm = gid * WGM, gsz = (nM - fm) < WGM ? (nM - fm) : WGM;
        u.pm = fm + ((wgid % nig) % gsz); u.pn = (wgid % nig) / gsz; return true;
    }
};

template <class Epi>
__device__ __forceinline__ void gemm_phase(LAS unsigned char* lds, const Gemm g, const StaticOrder& S, const Epi& E) {
    const int tid = otid(), wid = __builtin_amdgcn_readfirstlane(tid >> 6), lane = tid & 63, wr = wid >> 2, wc = wid & 3, fr = lane & 15, fq = lane >> 4;
    const int K = g.K, nt = K / BK;
    unsigned voffA[2], voffB[2];
#pragma unroll
    for (int i = 0; i < 2; ++i) { int R, C; stage_rc(tid * 16 + i * 8192, R, C); const int Rb = E.perm() ? ((R & ~31) + perm32(R & 31)) : R;
        voffA[i] = (unsigned)(R * K + C) * 2u; voffB[i] = (unsigned)(Rb * K + C) * 2u; }
    const size_t kstep = (size_t)(BK * 2);
    const size_t hstep = (size_t)HALF * K * 2;
    const size_t tstep = 2 * hstep;
    const unsigned ldsw = (unsigned)wid * 1024u;
    const int aoff = lds_byte(wr * 64 + fr, fq * 8), boff = lds_byte(wc * 32 + fr, fq * 8);
#define PG8_SA(b, h) (((b) * 2 + (h)) * HTB)
#define PG8_SB(b, h) ((4 + (b) * 2 + (h)) * HTB)
#define PG8_STAGE(bufoff, gbase, voff) do { _Pragma("unroll") for (int _i = 0; _i < 2; ++_i) \
        __builtin_amdgcn_global_load_lds((const unsigned*)((const char*)(gbase) + (voff)[_i]), (LAS unsigned*)(lds + (bufoff) + ldsw + _i * 8192), 16, 0, 0); } while (0)
#define PG8_LDA(dst, b, h) do { _Pragma("unroll") for (int m = 0; m < 4; ++m) _Pragma("unroll") for (int k = 0; k < 2; ++k) dst[m][k] = *(const LAS h8_t*)(lds + PG8_SA(b, h) + aoff + m * 2048 + k * 1024); } while (0)
#define PG8_LDB(dst, b, h) do { _Pragma("unroll") for (int n = 0; n < 2; ++n) _Pragma("unroll") for (int k = 0; k < 2; ++k) dst[n][k] = *(const LAS h8_t*)(lds + PG8_SB(b, h) + boff + n * 2048 + k * 1024); } while (0)
#define PG8_MMA(ai, bj, At, Bt) do { __builtin_amdgcn_s_setprio(1); _Pragma("unroll") for (int m = 0; m < 4; ++m) _Pragma("unroll") for (int n = 0; n < 2; ++n) _Pragma("unroll") for (int k = 0; k < 2; ++k) \
        acc[ai][bj][m][n] = __builtin_amdgcn_mfma_f32_16x16x32_f16(Bt[n][k], At[m][k], acc[ai][bj][m][n], 0, 0, 0); __builtin_amdgcn_s_setprio(0); } while (0)
#define PG8_WAIT_V(n) asm volatile("s_waitcnt vmcnt(" #n ")" ::: "memory")
#define PG8_WAIT_L(n) asm volatile("s_waitcnt lgkmcnt(" #n ")" ::: "memory")
#define PG8_BAR __builtin_amdgcn_s_barrier()
#define PG8_SCHED __builtin_amdgcn_sched_barrier(0)
    Unit cur, nxt; int ui = 0;
    if (!S.next(0, cur)) return;
    f32x4 acc[2][2][4][2];
#pragma unroll
    for (int a = 0; a < 2; ++a)
#pragma unroll
        for (int b = 0; b < 2; ++b)
#pragma unroll
            for (int m = 0; m < 4; ++m)
#pragma unroll
                for (int n = 0; n < 2; ++n) acc[a][b][m][n] = (f32x4){0.f, 0.f, 0.f, 0.f};
    h8_t At[4][2], B0[2][2], B1[2][2];
    const char* cA = (const char*)g.A + (size_t)cur.pm * tstep; const char* cB = (const char*)g.Bt + (size_t)cur.pn * tstep;
    PG8_STAGE(PG8_SB(0, 0), cB, voffB); PG8_STAGE(PG8_SA(0, 0), cA, voffA); PG8_STAGE(PG8_SB(0, 1), cB + hstep, voffB); PG8_STAGE(PG8_SA(0, 1), cA + hstep, voffA);
    if (wr == 1) PG8_BAR;
    PG8_WAIT_V(4); PG8_BAR;
    PG8_STAGE(PG8_SB(1, 0), cB + kstep, voffB); PG8_STAGE(PG8_SA(1, 0), cA + kstep, voffA); PG8_STAGE(PG8_SB(1, 1), cB + hstep + kstep, voffB);
    PG8_WAIT_V(6); PG8_BAR;
    for (;;) {
        const bool has_next = S.next(ui + 1, nxt);
        const char* nA = has_next ? (const char*)g.A + (size_t)nxt.pm * tstep : cA; const char* nB = has_next ? (const char*)g.Bt + (size_t)nxt.pn * tstep : cB;
        for (int t = 0; t < nt; t += 2) {
            const bool last = (t == nt - 2);
            const char* a1 = cA + (size_t)(t + 1) * kstep;
            const char* a2 = last ? nA : cA + (size_t)(t + 2) * kstep; const char* b2 = last ? nB : cB + (size_t)(t + 2) * kstep;
            const char* a3 = a2 + kstep; const char* b3 = b2 + kstep;
            PG8_LDB(B0, 0, 0); PG8_SCHED; PG8_LDA(At, 0, 0); PG8_STAGE(PG8_SA(1, 1), a1 + hstep, voffA);
            PG8_WAIT_L(8); PG8_BAR; PG8_WAIT_L(0); PG8_MMA(0, 0, At, B0); PG8_BAR; PG8_SCHED;
            PG8_LDB(B1, 0, 1); PG8_STAGE(PG8_SB(0, 0), b2, voffB);
            PG8_BAR; PG8_WAIT_L(0); PG8_MMA(0, 1, At, B1); PG8_BAR;
            PG8_LDA(At, 0, 1); PG8_STAGE(PG8_SA(0, 0), a2, voffA);
            PG8_BAR; PG8_WAIT_L(0); PG8_MMA(1, 0, At, B0); PG8_BAR; PG8_SCHED;
            PG8_STAGE(PG8_SB(0, 1), b2 + hstep, voffB);
            PG8_WAIT_V(6); PG8_BAR; PG8_MMA(1, 1, At, B1); PG8_BAR;
            PG8_LDB(B0, 1, 0); PG8_SCHED; PG8_LDA(At, 1, 0); PG8_STAGE(PG8_SA(0, 1), a2 + hstep, voffA);
            PG8_WAIT_L(8); PG8_BAR; PG8_WAIT_L(0); PG8_MMA(0, 0, At, B0); PG8_BAR; PG8_SCHED;
            PG8_LDB(B1, 1, 1); PG8_STAGE(PG8_SB(1, 0), b3, voffB);
            PG8_BAR; PG8_WAIT_L(0); PG8_MMA(0, 1, At, B1); PG8_BAR;
            PG8_LDA(At, 1, 1); PG8_STAGE(PG8_SA(1, 0), a3, voffA);
            PG8_BAR; PG8_WAIT_L(0); PG8_MMA(1, 0, At, B0); PG8_BAR; PG8_SCHED;
            PG8_STAGE(PG8_SB(1, 1), b3 + hstep, voffB);
            PG8_WAIT_V(6); PG8_BAR; PG8_MMA(1, 1, At, B1); PG8_BAR;
        }
        E(acc, cur, wr, wc, fr, fq);
        if (!has_next) break;
#pragma unroll
        for (int a = 0; a < 2; ++a)
#pragma unroll
            for (int b = 0; b < 2; ++b)
#pragma unroll
                for (int m = 0; m < 4; ++m)
#pragma unroll
                    for (int n = 0; n < 2; ++n) acc[a][b][m][n] = (f32x4){0.f, 0.f, 0.f, 0.f};
        cur = nxt; cA = nA; cB = nB; ++ui;
    }
    PG8_WAIT_V(0);
    if (wr == 0) PG8_BAR;
    PG8_BAR;
#undef PG8_SA
#undef PG8_SB
#undef PG8_STAGE
#undef PG8_LDA
#undef PG8_LDB
#undef PG8_MMA
#undef PG8_WAIT_V
#undef PG8_WAIT_L
#undef PG8_BAR
#undef PG8_SCHED
}
}

__device__ __forceinline__ int win_src_col_l(int pc) { return pc < 2128 ? pc : (pc < C_QB ? -1 : (pc < C_END ? pc - 48 : -1)); }
__device__ __forceinline__ int rope_type(int g) { return (g <= 6 || (g >= 32 && g <= 41)) ? 1 : ((g >= 8 && g <= 15) ? 2 : (g == 16 ? 3 : 0)); }
__device__ __forceinline__ int win_src_col(int pc) {
    const int g = pc >> 7, p = pc & 127, ty = rope_type(g);
    int l = p;
    if (ty == 1) { const int q4 = p >> 2, e = p & 3; l = 2 * q4 + (e >> 1) + 64 * (e & 1); }
    else if (ty == 2 || (ty == 3 && p < 64)) { const int hb = p >> 6, pp = p & 63, q4 = pp >> 2, e = pp & 3; l = hb * 64 + 2 * q4 + (e >> 1) + 32 * (e & 1); }
    return win_src_col_l(g * 128 + l);
}


struct Epi {
    int mode; f16* o16; int ldc; float* o32; const float* xin; const f16* xinh; const float* gate; const float* rope128; const float* rope64;
    __device__ __forceinline__ bool perm() const { return true; }
    __device__ __forceinline__ void operator()(const f32x4 (&acc)[2][2][4][2], const pg8::Unit& u, int wr, int wc, int fr, int fq) const {
        const int row0 = u.pm * 256 + wr * 64 + fr, col0 = u.pn * 256 + wc * 32 + 4 * fq;
        if (mode == 2) {
#pragma unroll
            for (int bj = 0; bj < 2; ++bj) {
                const int g = __builtin_amdgcn_readfirstlane(u.pn * 2 + bj);
                int ty = rope_type(g); if (ty == 3) ty = (wc < 2) ? 2 : 0;
                f16* ob = o16 + (size_t)g * 128;
                if (ty == 0) {
#pragma unroll
                    for (int ai = 0; ai < 2; ++ai)
#pragma unroll
                        for (int m = 0; m < 4; ++m) {
                            const f32x4 v0 = acc[ai][bj][m][0], v1 = acc[ai][bj][m][1];
                            u32x4 w; w.x = pack_h2(v0[0], v0[1]); w.y = pack_h2(v0[2], v0[3]); w.z = pack_h2(v1[0], v1[1]); w.w = pack_h2(v1[2], v1[3]);
                            *(u32x4*)(ob + (size_t)(row0 + ai * 128 + m * 16) * ldc + wc * 32 + 8 * fq) = w;
                        }
                } else {
                    const float* tab = ty == 1 ? rope128 : rope64;
                    const int half = ty == 1 ? 64 : 32, tw = ty == 1 ? 128 : 64;
                    const int p0 = wc * 32 + 8 * fq;
                    const int j0 = ty == 1 ? (p0 >> 1) : ((p0 & 63) >> 1), base = ty == 1 ? 0 : (p0 & 64);
#pragma unroll
                    for (int ai = 0; ai < 2; ++ai) {
                        f32x4 cs[4][2];
#pragma unroll
                        for (int m = 0; m < 4; ++m) {
                            const int pos = (row0 + ai * 128 + m * 16) & (SEQ - 1);
                            cs[m][0] = *(const f32x4*)(tab + (size_t)pos * tw + 2 * j0); cs[m][1] = *(const f32x4*)(tab + (size_t)pos * tw + 2 * j0 + 4);
                        }
#pragma unroll
                        for (int m = 0; m < 4; ++m) {
                            const int row = row0 + ai * 128 + m * 16;
                            const f32x4 v0 = acc[ai][bj][m][0], v1 = acc[ai][bj][m][1], c0 = cs[m][0], c1 = cs[m][1];
                            u32x2 lo, hi;
                            lo.x = pack_h2(v0[0] * c0[0] - v0[1] * c0[1], v0[2] * c0[2] - v0[3] * c0[3]); hi.x = pack_h2(v0[1] * c0[0] + v0[0] * c0[1], v0[3] * c0[2] + v0[2] * c0[3]);
                            lo.y = pack_h2(v1[0] * c1[0] - v1[1] * c1[1], v1[2] * c1[2] - v1[3] * c1[3]); hi.y = pack_h2(v1[1] * c1[0] + v1[0] * c1[1], v1[3] * c1[2] + v1[2] * c1[3]);
                            f16* op = ob + (size_t)row * ldc + base + j0;
                            *(u32x2*)op = lo; *(u32x2*)(op + half) = hi;
                        }
                    }
                }
            }
            return;
        }
        if (mode == 0) {
#pragma unroll
            for (int ai = 0; ai < 2; ++ai)
#pragma unroll
                for (int m = 0; m < 4; ++m)
#pragma unroll
                    for (int bj = 0; bj < 2; ++bj) {
                        const f32x4 v0 = acc[ai][bj][m][0], v1 = acc[ai][bj][m][1];
                        u32x4 w; w.x = pack_h2(v0[0], v0[1]); w.y = pack_h2(v0[2], v0[3]); w.z = pack_h2(v1[0], v1[1]); w.w = pack_h2(v1[2], v1[3]);
                        *(u32x4*)(o16 + (size_t)(row0 + ai * 128 + m * 16) * ldc + u.pn * 256 + bj * 128 + wc * 32 + 8 * fq) = w;
                    }
            return;
        }
        if (mode == 1) {
            const int b = row0 / SEQ, colp = u.pn * 256 + wc * 32 + 8 * fq;
            f32x4 gt[2][2];
#pragma unroll
            for (int bj = 0; bj < 2; ++bj)
#pragma unroll
                for (int n = 0; n < 2; ++n) gt[bj][n] = *(const f32x4*)(gate + (size_t)b * 6 * DM + colp + bj * 128 + 4 * n);
#pragma unroll
            for (int ai = 0; ai < 2; ++ai)
#pragma unroll
                for (int mh = 0; mh < 2; ++mh) {
                    f32x4 xi[2][2][2];
#pragma unroll
                    for (int m2 = 0; m2 < 2; ++m2)
#pragma unroll
                        for (int bj = 0; bj < 2; ++bj) {
                            const size_t o = (size_t)(row0 + ai * 128 + (2 * mh + m2) * 16) * DM + colp + bj * 128;
                            if (xinh) { const u32x4 w = *(const u32x4*)(xinh + o); xi[m2][bj][0] = (f32x4){h_lo(w.x), h_hi(w.x), h_lo(w.y), h_hi(w.y)}; xi[m2][bj][1] = (f32x4){h_lo(w.z), h_hi(w.z), h_lo(w.w), h_hi(w.w)}; }
                            else { xi[m2][bj][0] = *(const f32x4*)(xin + o); xi[m2][bj][1] = *(const f32x4*)(xin + o + 4); }
                        }
#pragma unroll
                    for (int m2 = 0; m2 < 2; ++m2)
#pragma unroll
                        for (int bj = 0; bj < 2; ++bj) {
                            const f32x4 r0 = xi[m2][bj][0] + gt[bj][0] * acc[ai][bj][2 * mh + m2][0], r1 = xi[m2][bj][1] + gt[bj][1] * acc[ai][bj][2 * mh + m2][1];
                            u32x4 w; w.x = pack_h2(r0[0], r0[1]); w.y = pack_h2(r0[2], r0[3]); w.z = pack_h2(r1[0], r1[1]); w.w = pack_h2(r1[2], r1[3]);
                            *(u32x4*)(o16 + (size_t)(row0 + ai * 128 + (2 * mh + m2) * 16) * DM + colp + bj * 128) = w;
                        }
                }
            return;
        }
#pragma unroll
        for (int ai = 0; ai < 2; ++ai)
#pragma unroll
            for (int m = 0; m < 4; ++m) {
                const int row = row0 + ai * 128 + m * 16;
#pragma unroll
                for (int bj = 0; bj < 2; ++bj)
#pragma unroll
                    for (int n = 0; n < 2; ++n) {
                        const int col = col0 + bj * 128 + n * 16;
                        const f32x4 v = acc[ai][bj][m][n];
                        if (mode == 0) {
                            u32x2 w; w.x = pack_h2(v[0], v[1]); w.y = pack_h2(v[2], v[3]);
                            *(u32x2*)(o16 + (size_t)row * ldc + col) = w;
                        } else {
                            const int b = row / SEQ;
                            const f32x4 xi = *(const f32x4*)(xin + (size_t)row * DM + col);
                            const f32x4 gt = *(const f32x4*)(gate + (size_t)b * 6 * DM + col);
                            *(f32x4*)(o32 + (size_t)row * DM + col) = xi + gt * v;
                        }
                    }
            }
    }
};

__device__ __forceinline__ void gemm_run(const Params& p, LAS unsigned char* lds, const f16* A, const f16* Bt, int N, const Epi& E) {
    pg8::Gemm g; g.A = (const unsigned short*)A; g.Bt = (const unsigned short*)Bt; g.M = NT; g.N = N; g.K = DM;
    pg8::StaticOrder S; S.init(NT, N, (int)gridDim.x, (int)blockIdx.x);
    pg8::gemm_phase<Epi>(lds, g, S, E);
}

__device__ __forceinline__ void transpose_tiles(const float* src, int ldsrc, int ncols_phys, bool is_win, f16* dst, float* tile  , int& unit_base, int unit_lo) {
    const int tn = ncols_phys / 64, tk = DM / 64, ntile = tn * tk;
    const int tid = otid();
    float cur[8], nxt[8];
#define TT_LOAD(R_, u_) do { const int n0_ = ((u_) % tn) * 64, k0_ = ((u_) / tn) * 64; \
        _Pragma("unroll") for (int i = 0; i < 8; ++i) { const int e = tid + i * 512, r = e >> 6, c = e & 63; const int pc = n0_ + c; const int sc = is_win ? win_src_col(pc) : pc; \
            R_[i] = sc >= 0 ? src[(size_t)(k0_ + r) * ldsrc + sc] : 0.f; } } while (0)
    int u = blockIdx.x;
    if (u < ntile) TT_LOAD(nxt, u);
    for (; u < ntile; u += gridDim.x) {
        const int n0 = (u % tn) * 64, k0 = (u / tn) * 64;
#pragma unroll
        for (int i = 0; i < 8; ++i) cur[i] = nxt[i];
        if (u + (int)gridDim.x < ntile) TT_LOAD(nxt, u + gridDim.x);
        __syncthreads();
#pragma unroll
        for (int i = 0; i < 8; ++i) { const int e = tid + i * 512, r = e >> 6, c = e & 63; tile[r * 65 + c] = cur[i]; }
        __syncthreads();
        {
            const int n = tid >> 3, kq = (tid & 7) * 8;
            u32x4 w;
            w.x = pack_h2(tile[(kq + 0) * 65 + n], tile[(kq + 1) * 65 + n]); w.y = pack_h2(tile[(kq + 2) * 65 + n], tile[(kq + 3) * 65 + n]);
            w.z = pack_h2(tile[(kq + 4) * 65 + n], tile[(kq + 5) * 65 + n]); w.w = pack_h2(tile[(kq + 6) * 65 + n], tile[(kq + 7) * 65 + n]);
            *(u32x4*)(dst + (size_t)(n0 + n) * DM + k0 + kq) = w;
        }
    }
#undef TT_LOAD
    (void)unit_base; (void)unit_lo;
}

__device__ __forceinline__ void cvt_f16_stream(const float* src, f16* dst, size_t n) {
    const size_t stride = (size_t)gridDim.x * NTHREADS;
    for (size_t i = (size_t)blockIdx.x * NTHREADS + otid(); i < n / 8; i += stride) {
        const f32x4 a = *(const f32x4*)(src + i * 8), b = *(const f32x4*)(src + i * 8 + 4);
        u32x4 w; w.x = pack_h2(a[0], a[1]); w.y = pack_h2(a[2], a[3]); w.z = pack_h2(b[0], b[1]); w.w = pack_h2(b[2], b[3]);
        *(u32x4*)(dst + i * 8) = w;
    }
}

__device__ __forceinline__ void quant_rows(const float* src, int nrows, unsigned* dst, float* scale, int bias) {
    const int tid_ = otid(); const int wid = tid_ >> 6, lane = tid_ & 63;
    const int rstep = gridDim.x * NWAVES;
    int row = blockIdx.x * NWAVES + wid;
    f32x4 v[8], nv[8];
    if (row < nrows) {
#pragma unroll
        for (int i = 0; i < 8; ++i) nv[i] = *(const f32x4*)(src + (size_t)row * DM + i * 256 + lane * 4);
    }
    for (; row < nrows; row += rstep) {
#pragma unroll
        for (int i = 0; i < 8; ++i) v[i] = nv[i];
        if (row + rstep < nrows) {
#pragma unroll
            for (int i = 0; i < 8; ++i) nv[i] = *(const f32x4*)(src + (size_t)(row + rstep) * DM + i * 256 + lane * 4);
        }
        float am = 0.f;
#pragma unroll
        for (int i = 0; i < 8; ++i) am = fmaxf(am, fmaxf(fmaxf(fabsf(v[i][0]), fabsf(v[i][1])), fmaxf(fabsf(v[i][2]), fabsf(v[i][3]))));
        am = wave_max(am);
        const float sc = am > 0.f ? am * (1.f / 127.f) : 1.f, inv = 1.f / sc;
        if (lane == 0) scale[row] = sc;
#pragma unroll
        for (int i = 0; i < 8; ++i) {
            unsigned w = 0u;
#pragma unroll
            for (int j = 0; j < 4; ++j) { const int q = (int)rintf(v[i][j] * inv) + bias; w |= ((unsigned)q & 255u) << (8 * j); }
            dst[(size_t)row * (DM / 4) + i * 64 + lane] = w;
        }
    }
}

__device__ __forceinline__ void quant_rows4(const float* src, int nrows, unsigned* dst, float* scale) {
    const int tid_ = otid(); const int wid = tid_ >> 6, lane = tid_ & 63;
    const int rstep = gridDim.x * NWAVES;
    int row = blockIdx.x * NWAVES + wid;
    f32x4 v[8], nv[8];
    if (row < nrows) {
#pragma unroll
        for (int i = 0; i < 8; ++i) nv[i] = *(const f32x4*)(src + (size_t)row * DM + i * 256 + lane * 4);
    }
    for (; row < nrows; row += rstep) {
#pragma unroll
        for (int i = 0; i < 8; ++i) v[i] = nv[i];
        if (row + rstep < nrows) {
#pragma unroll
            for (int i = 0; i < 8; ++i) nv[i] = *(const f32x4*)(src + (size_t)(row + rstep) * DM + i * 256 + lane * 4);
        }
        float am = 0.f;
#pragma unroll
        for (int i = 0; i < 8; ++i) am = fmaxf(am, fmaxf(fmaxf(fabsf(v[i][0]), fabsf(v[i][1])), fmaxf(fabsf(v[i][2]), fabsf(v[i][3]))));
        am = wave_max(am);
        const float sc = am > 0.f ? am * (1.f / 7.f) : 1.f, inv = 1.f / sc;
        if (lane == 0) scale[row] = sc;
#pragma unroll
        for (int i = 0; i < 8; ++i) {
            unsigned w = 0u;
#pragma unroll
            for (int j = 0; j < 4; ++j) { const int q = (int)rintf(v[i][j] * inv) + 8; w |= ((unsigned)q & 15u) << (8 * j); }
            if (lane & 1) w <<= 4;
            const unsigned o = __shfl_down(w, 1);
            if (!(lane & 1)) dst[(size_t)row * (DM / 8) + i * 32 + (lane >> 1)] = w | o;
        }
    }
}

constexpr int QV_STR = DM + 8;
__device__ __forceinline__ void quant_v_sliced(const float* src, unsigned char* dst, float* scale, LAS unsigned char* lds) {
    const int tid = otid(), wid = tid >> 6, lane = tid & 63;
    for (int blk = obid(); blk < DEPTH * PEXP / 64; blk += gridDim.x) {
        const int row0 = blk * 64, layer = row0 / PEXP, e0 = row0 % PEXP;
        __syncthreads();
        f32x4 nv[8];
#pragma unroll
        for (int i = 0; i < 8; ++i) nv[i] = *(const f32x4*)(src + (size_t)(row0 + wid) * DM + i * 256 + lane * 4);
        for (int rr = wid; rr < 64; rr += NWAVES) {
            f32x4 v[8]; float am = 0.f;
#pragma unroll
            for (int i = 0; i < 8; ++i) v[i] = nv[i];
            if (rr + NWAVES < 64) {
#pragma unroll
                for (int i = 0; i < 8; ++i) nv[i] = *(const f32x4*)(src + (size_t)(row0 + rr + NWAVES) * DM + i * 256 + lane * 4);
            }
#pragma unroll
            for (int i = 0; i < 8; ++i) am = fmaxf(am, fmaxf(fmaxf(fabsf(v[i][0]), fabsf(v[i][1])), fmaxf(fabsf(v[i][2]), fabsf(v[i][3]))));
            am = wave_max(am);
            const float sc = am > 0.f ? am * (1.f / 127.f) : 1.f, inv = 1.f / sc;
            if (lane == 0) scale[row0 + rr] = sc;
#pragma unroll
            for (int i = 0; i < 8; ++i) {
                unsigned w = 0u;
#pragma unroll
                for (int j = 0; j < 4; ++j) { const int q = (int)rintf(v[i][j] * inv) + 128; w |= ((unsigned)q & 255u) << (8 * j); }
                *(LAS unsigned*)(lds + rr * QV_STR + i * 256 + lane * 4) = w;
            }
        }
        __syncthreads();
        for (int c = wid; c < 256; c += NWAVES) {
            const u32x2 w = *(const LAS u32x2*)(lds + lane * QV_STR + c * 8);
            *(u32x2*)(dst + (((size_t)layer * 256 + c) * PEXP + e0 + lane) * 8) = w;
        }
    }
}

__device__ __forceinline__ void phase_conv(const Params& p, LAS unsigned char* lds_) {
    float* smem = (float*)(unsigned char*)lds_;
    unsigned char* ws = p.ws;
    const int tid = otid();
    int dummy = 0;
    {
        float* cond = smem;
        float* red = smem + NB * DM;
        for (int i = tid; i < NB * DM; i += NTHREADS) { const float v = p.c[i]; cond[i] = v / (1.f + __expf(-v)); }
        __syncthreads();
        for (int u = blockIdx.x; u < DEPTH * 128; u += gridDim.x) {
            const int l = u >> 7, j0 = (u & 127) * 96;
            const int c4 = tid % 24, kg = tid / 24;
            if (kg < 21) {
                f32x4 acc[NB];
#pragma unroll
                for (int b = 0; b < NB; ++b) acc[b] = (f32x4){0.f, 0.f, 0.f, 0.f};
                const float* wp = p.ada_w + (size_t)l * DM * 6 * DM + j0 + 4 * c4;
#pragma unroll 1
                for (int i0 = 0; i0 < 98; i0 += 7) {
                    f32x4 w[7];
#pragma unroll
                    for (int i = 0; i < 7; ++i) { const int k = kg + 21 * (i0 + i); w[i] = k < DM ? *(const f32x4*)(wp + (size_t)k * 6 * DM) : (f32x4){0.f, 0.f, 0.f, 0.f}; }
#pragma unroll
                    for (int i = 0; i < 7; ++i) { const int k = kg + 21 * (i0 + i); const int kk = k < DM ? k : 0;
#pragma unroll
                        for (int b = 0; b < NB; ++b) acc[b] += w[i] * cond[b * DM + kk]; }
                }
#pragma unroll
                for (int b = 0; b < NB; ++b) *(f32x4*)(red + (kg * NB + b) * 96 + 4 * c4) = acc[b];
            }
            __syncthreads();
            for (int i = tid; i < NB * 96; i += NTHREADS) {
                const int b = i / 96, cc = i % 96;
                float sacc = p.ada_b[(size_t)l * 6 * DM + j0 + cc];
#pragma unroll
                for (int g = 0; g < 21; ++g) sacc += red[(g * NB + b) * 96 + cc];
                ((float*)(ws + WS_MOD))[((size_t)l * NB + b) * 6 * DM + j0 + cc] = sacc;
            }
            __syncthreads();
        }
    }
    {
        float2* r128 = (float2*)(ws + WS_ROPE128); float2* r64 = (float2*)(ws + WS_ROPE64);
        for (int i = blockIdx.x * NTHREADS + tid; i < SEQ * 64; i += gridDim.x * NTHREADS) {
            const int pos = i >> 6, j = i & 63;
            const float inv = powf(10000.f, -(float)j / 64.f); const float ang = (float)pos * inv;
            r128[i] = make_float2((float)cos((double)ang), (float)sin((double)ang));
        }
        for (int i = blockIdx.x * NTHREADS + tid; i < SEQ * 32; i += gridDim.x * NTHREADS) {
            const int pos = i >> 5, j = i & 31;
            const float inv = powf(10000.f, -(float)j / 32.f); const float ang = (float)pos * inv;
            r64[i] = make_float2((float)cos((double)ang), (float)sin((double)ang));
        }
    }
    __syncthreads();
    for (int l = 0; l < DEPTH; ++l) {
        transpose_tiles(p.w_in + (size_t)l * DM * INW, INW, INWP, true, (f16*)(ws + WS_WTIN) + (size_t)l * INWP * DM, smem, dummy, 0);
        transpose_tiles(p.w_out + (size_t)l * DM * DM, DM, DM, false, (f16*)(ws + WS_WTOUT) + (size_t)l * DM * DM, smem, dummy, 0);
        transpose_tiles(p.wq + (size_t)l * DM * DM, DM, DM, false, (f16*)(ws + WS_WTQ) + (size_t)l * DM * DM, smem, dummy, 0);
    }
    quant_rows(p.pu, PEXP, (unsigned*)(ws + WS_U8), (float*)(ws + WS_SU), 0);
    if (LAST_BITS == 4) quant_rows4(p.pu + (size_t)PEXP * DM, PEXP, (unsigned*)(ws + WS_U8 + (size_t)PEXP * DM), (float*)(ws + WS_SU) + PEXP);
    else quant_rows(p.pu + (size_t)PEXP * DM, PEXP, (unsigned*)(ws + WS_U8 + (size_t)PEXP * DM), (float*)(ws + WS_SU) + PEXP, 0);
    quant_v_sliced(p.pv, ws + WS_V8, (float*)(ws + WS_SV), lds_);
    cvt_f16_stream(p.subk, (f16*)(ws + WS_SUBK), (size_t)DEPTH * PH * 2 * PNK * 128);
}

template <int MODE, bool XH>
__device__ __forceinline__ void phase_norm2(const float* xin, const f16* xinh, float* fout, const float* g, const float* shift, const float* scale, f16* hout, unsigned* h8, float* sh8) {
    const int tid_ = otid(); const int wid = tid_ >> 6, lane = tid_ & 63;
    for (int r0 = (blockIdx.x * NWAVES + wid) * 8; r0 < NT; r0 += gridDim.x * NWAVES * 8) {
        const int b = r0 / SEQ;
        f32x4 gm[8], sh[8];
#pragma unroll
        for (int i = 0; i < 8; ++i) {
            const int col = i * 256 + lane * 4;
            gm[i] = *(const f32x4*)(g + col);
            if (MODE != 2) { gm[i] = gm[i] * (*(const f32x4*)(scale + (size_t)b * 6 * DM + col) + 1.f); sh[i] = *(const f32x4*)(shift + (size_t)b * 6 * DM + col); }
        }
        f32x4 v[8], nv[8]; u32x2 nh[8];
#define NR_LOAD(row_) do { _Pragma("unroll") for (int i = 0; i < 8; ++i) { if (XH) nh[i] = *(const u32x2*)(xinh + (size_t)(row_) * DM + i * 256 + lane * 4); else nv[i] = *(const f32x4*)(xin + (size_t)(row_) * DM + i * 256 + lane * 4); } } while (0)
        NR_LOAD(r0);
#pragma unroll 1
        for (int k = 0; k < 8; ++k) {
            const int row = r0 + k;
#pragma unroll
            for (int i = 0; i < 8; ++i) { if (XH) { v[i][0] = h_lo(nh[i].x); v[i][1] = h_hi(nh[i].x); v[i][2] = h_lo(nh[i].y); v[i][3] = h_hi(nh[i].y); } else v[i] = nv[i]; }
            if (k < 7) NR_LOAD(row + 1);
            float ss = 0.f;
#pragma unroll
            for (int i = 0; i < 8; ++i) ss += v[i][0] * v[i][0] + v[i][1] * v[i][1] + v[i][2] * v[i][2] + v[i][3] * v[i][3];
            ss = wave_sum(ss);
            const float rstd = rsqrtf(ss * (1.f / DM) + EPS);
            float am = 0.f;
#pragma unroll
            for (int i = 0; i < 8; ++i) {
                const int col = i * 256 + lane * 4;
                if (MODE == 2) { *(f32x4*)(fout + (size_t)row * DM + col) = v[i] * rstd * gm[i]; }
                else {
                    const f32x4 y = v[i] * rstd * gm[i] + sh[i];
                    u32x2 w; w.x = pack_h2(y[0], y[1]); w.y = pack_h2(y[2], y[3]);
                    *(u32x2*)(hout + (size_t)row * DM + col) = w;
                    if (MODE == 1) { v[i] = y; am = fmaxf(am, fmaxf(fmaxf(fabsf(y[0]), fabsf(y[1])), fmaxf(fabsf(y[2]), fabsf(y[3])))); }
                }
            }
            if (MODE == 1) {
                am = wave_max(am);
                const float qs = am > 0.f ? am * (1.f / 127.f) : 1.f, inv = 1.f / qs;
                if (lane == 0) sh8[row] = qs;
                int qsum = 0;
#pragma unroll
                for (int i = 0; i < 8; ++i) {
                    unsigned w = 0u;
#pragma unroll
                    for (int j = 0; j < 4; ++j) { const int q = (int)rintf(v[i][j] * inv); qsum += q; w |= ((unsigned)q & 255u) << (8 * j); }
                    h8[(size_t)row * (DM / 4) + i * 64 + lane] = w;
                }
#pragma unroll
                for (int o = 32; o >= 1; o >>= 1) qsum += __shfl_xor(qsum, o);
                if (lane == 0) ((int*)(sh8 + NT))[row] = qsum;
            }
        }
#undef NR_LOAD
    }
}

constexpr int IX_ROW = SEQ + 4;
__device__ __forceinline__ void index_item(const Params& p, LAS unsigned char* lds, int b, int qg) {
    const f16* proj = (const f16*)(p.ws + WS_PROJ);
    LAS float* sc = (LAS float*)lds;
    const int tid = otid(), wid = __builtin_amdgcn_readfirstlane(tid >> 6), lane = tid & 63, fr = lane & 15, fq = lane >> 4;
    const int t0 = qg * 16, nkt = qg + 1;
    h8_t Bq[IH][2]; float wq[IH];
    {
        const f16* qrow = proj + ((size_t)b * SEQ + t0 + fr) * INWP;
#pragma unroll
        for (int h = 0; h < IH; ++h) {
            Bq[h][0] = *(const h8_t*)(qrow + C_IQ + h * IDM + 8 * fq);
            Bq[h][1] = *(const h8_t*)(qrow + C_IQ + h * IDM + 32 + 8 * fq);
        }
        const h8_t w0 = *(const h8_t*)(qrow + C_IW), w1 = *(const h8_t*)(qrow + C_IW + 8);
#pragma unroll
        for (int h = 0; h < 8; ++h) { wq[h] = (float)w0[h] * (0.25f * 0.125f); wq[8 + h] = (float)w1[h] * (0.25f * 0.125f); }
    }
    __syncthreads();
    const f16* kbase = proj + ((size_t)b * SEQ + fr) * INWP + C_IK + 8 * fq;
    h8_t a0, a1, n0, n1;
#define IX_LOAD(A0_, A1_, kt_) do { const int c_ = (kt_) < nkt ? (kt_) : 0; A0_ = *(const h8_t*)(kbase + (size_t)c_ * 16 * INWP); A1_ = *(const h8_t*)(kbase + (size_t)c_ * 16 * INWP + 32); } while (0)
#define IX_TILE(A0_, A1_, kt_) do { f32x4 acc = {0.f, 0.f, 0.f, 0.f}; \
        _Pragma("unroll") for (int h = 0; h < IH; ++h) { \
            f32x4 c = {0.f, 0.f, 0.f, 0.f}; \
            c = __builtin_amdgcn_mfma_f32_16x16x32_f16(A0_, Bq[h][0], c, 0, 0, 0); \
            c = __builtin_amdgcn_mfma_f32_16x16x32_f16(A1_, Bq[h][1], c, 0, 0, 0); \
            _Pragma("unroll") for (int j = 0; j < 4; ++j) { const int ci = __float_as_int(c[j]); acc[j] += wq[h] * __int_as_float(ci > 0 ? ci : 0); } } \
        *(LAS f32x4*)(sc + fr * IX_ROW + (kt_) * 16 + 4 * fq) = acc; } while (0)
    int kt = wid;
    IX_LOAD(a0, a1, kt);
    for (; kt < nkt; kt += 2 * NWAVES) {
        IX_LOAD(n0, n1, kt + NWAVES); __builtin_amdgcn_sched_barrier(0);
        IX_TILE(a0, a1, kt); __builtin_amdgcn_sched_barrier(0);
        IX_LOAD(a0, a1, kt + 2 * NWAVES); __builtin_amdgcn_sched_barrier(0);
        if (kt + NWAVES < nkt) IX_TILE(n0, n1, kt + NWAVES);
        __builtin_amdgcn_sched_barrier(0);
    }
#undef IX_LOAD
#undef IX_TILE
    __syncthreads();
    unsigned* mask = (unsigned*)(p.ws + WS_MASK);
#pragma unroll 1
    for (int qq = 0; qq < 2; ++qq) {
        const int ql = 2 * wid + qq, t = t0 + ql, nk = t + 1;
        unsigned key[32];
#pragma unroll
        for (int i = 0; i < 32; ++i) {
            const int s = lane + 64 * i;
            unsigned u = 0u;
            if (s < nk) { const unsigned bits = __float_as_uint(sc[ql * IX_ROW + s]); u = (bits & 0x80000000u) ? ~bits : (bits | 0x80000000u); if (u == 0u) u = 1u; }
            key[i] = u;
        }
        unsigned thr = 1u;
        if (nk > DSA_TOPK) {
            thr = 0u;
            const int nreg8 = (nk + 511) >> 9;
            for (int bit = 31; bit >= 0; --bit) {
                const unsigned cand = thr | (1u << bit);
                int cnt = 0;
#pragma unroll
                for (int i8 = 0; i8 < 4; ++i8) {
                    if (i8 < nreg8) {
#pragma unroll
                        for (int i = 0; i < 8; ++i) cnt += __builtin_popcountll(__ballot(key[8 * i8 + i] >= cand));
                    }
                }
                if (cnt >= DSA_TOPK) { thr = cand; if (cnt == DSA_TOPK) break; }
            }
        }
        unsigned* mrow = mask + ((size_t)b * SEQ + t) * 64;
        unsigned myw = 0u;
#pragma unroll
        for (int i = 0; i < 32; ++i) {
            const unsigned long long bal = __ballot(key[i] >= thr && key[i] != 0u);
            if (lane == 2 * i) myw = (unsigned)bal;
            if (lane == 2 * i + 1) myw = (unsigned)(bal >> 32);
        }
        mrow[lane] = myw;
    }
}

__device__ __forceinline__ void phase_index2(const Params& p, LAS unsigned char* lds_) {
    const f16* proj = (const f16*)(p.ws + WS_PROJ);
    float* smem = (float*)(unsigned char*)lds_;
    const int tid = otid();
    {
        float* red = smem;
        float* km = (float*)(p.ws + WS_KMEAN);
        for (int u = obid(); u < NB * HC * MOBA_NB; u += gridDim.x) {
            const int blk = u % MOBA_NB, h = (u / MOBA_NB) % HC, b = u / (MOBA_NB * HC);
            const int d = tid & 127, part = tid >> 7;
            float s = 0.f;
            const f16* kp = proj + ((size_t)b * SEQ + blk * MOBA_BLK + part * 64) * INWP + C_KC + h * HD + d;
#pragma unroll
            for (int k0 = 0; k0 < 64; k0 += 16) {
                f16 kv[16];
#pragma unroll
                for (int k = 0; k < 16; ++k) kv[k] = kp[(size_t)(k0 + k) * INWP];
#pragma unroll
                for (int k = 0; k < 16; ++k) s += (float)kv[k];
            }
            __syncthreads();
            red[part * 128 + d] = s;
            __syncthreads();
            if (tid < 128) km[(size_t)u * HD + tid] = (red[tid] + red[128 + tid] + red[256 + tid] + red[384 + tid]) * (1.f / MOBA_BLK);
        }
        __syncthreads();
    }
    for (int pi = obid(); pi < NB * 64; pi += gridDim.x) {
        const int b = pi >> 6, a = pi & 63;
        index_item(p, lds_, b, 127 - a);
        index_item(p, lds_, b, a);
    }
}

typedef short s4_t __attribute__((ext_vector_type(4)));
typedef float f32x16 __attribute__((ext_vector_type(16)));
constexpr int AT_KSTR = 272, AT_VSTR = 320, AT_KBYTES = 64 * AT_KSTR, AT_VBYTES = 64 * AT_VSTR, AT_STAGE = AT_KBYTES + AT_VBYTES;
__device__ __forceinline__ float fexp2(float x) { return __builtin_amdgcn_exp2f(x); }
__device__ __forceinline__ float flog2(float x) { return __builtin_amdgcn_logf(x); }

__device__ __forceinline__ float xhalf_max(float x) { const auto r = __builtin_amdgcn_permlane32_swap(__float_as_uint(x), __float_as_uint(x), false, false); return fmaxf(__uint_as_float(r[0]), __uint_as_float(r[1])); }
__device__ __forceinline__ float xhalf_sum(float x) { const auto r = __builtin_amdgcn_permlane32_swap(__float_as_uint(x), __float_as_uint(x), false, false); return __uint_as_float(r[0]) + __uint_as_float(r[1]); }
template <int VAR>
__device__ __forceinline__ void attn_item(const Params& p, LAS unsigned char* lds, const float* ong, int b, int hh, int qt, int qc, int kc, int vc) {
    const f16* proj = (const f16*)(p.ws + WS_PROJ);
    const int tid = otid(), wid = __builtin_amdgcn_readfirstlane(tid >> 6), lane = tid & 63, qn = lane & 31, hf = lane >> 5;
    const int q0 = qt * 256, qrow = q0 + 32 * wid + qn;
    const size_t grow = (size_t)b * SEQ + qrow;
    h8_t Qf[8];
    {
        const float sc = 0.08838834764831845f * 1.4426950408889634f;
        const f16* qp = proj + grow * INWP + qc + 8 * hf;
#pragma unroll
        for (int ks = 0; ks < 8; ++ks) {
            const h8_t v = *(const h8_t*)(qp + 16 * ks);
            h8_t w;
#pragma unroll
            for (int j = 0; j < 8; ++j) w[j] = (f16)((float)v[j] * sc);
            Qf[ks] = w;
        }
    }
    unsigned allowed = 0xffu;
    if (VAR == 2) {
        const int own = qt;
        const float* km = (const float*)(p.ws + WS_KMEAN) + ((size_t)b * HC + (hh - HA - HB)) * MOBA_NB * HD + 8 * hf;
        float gs[MOBA_NB];
#pragma unroll
        for (int j = 0; j < MOBA_NB; ++j) gs[j] = -INFINITY;
#pragma unroll
        for (int j = 0; j < MOBA_NB - 1; ++j) {
            if (j < own) {
                float s = 0.f;
#pragma unroll
                for (int ks = 0; ks < 8; ++ks) {
                    const f32x4 k0 = *(const f32x4*)(km + j * HD + 16 * ks), k1 = *(const f32x4*)(km + j * HD + 16 * ks + 4);
                    s += (float)Qf[ks][0] * k0[0] + (float)Qf[ks][1] * k0[1] + (float)Qf[ks][2] * k0[2] + (float)Qf[ks][3] * k0[3]
                       + (float)Qf[ks][4] * k1[0] + (float)Qf[ks][5] * k1[1] + (float)Qf[ks][6] * k1[2] + (float)Qf[ks][7] * k1[3];
                }
                gs[j] = s + __shfl_xor(s, 32);
            }
        }
        allowed = 1u << own;
#pragma unroll
        for (int j = 0; j < MOBA_NB - 1; ++j) {
            if (j < own) {
                int rank = 0;
#pragma unroll
                for (int k2 = 0; k2 < MOBA_NB - 1; ++k2) if (k2 < own && (gs[k2] > gs[j] || (gs[k2] == gs[j] && k2 < j))) ++rank;
                if (rank < 3) allowed |= 1u << j;
            }
        }
    }
    f32x16 O[4];
#pragma unroll
    for (int dt = 0; dt < 4; ++dt)
#pragma unroll
        for (int r = 0; r < 16; ++r) O[dt][r] = 0.f;
    float m_run = -INFINITY, l_run = 0.f, carry = 0.f;
    const int nst = (qt + 1) * 4;
    const int st_hi_w = qt * 4 + (wid >> 1);
    const int sr0 = tid >> 4, sc0 = tid & 15;
    const f16* kg = proj + ((size_t)b * SEQ + sr0) * INWP + kc + 8 * sc0;
    const f16* vg = proj + ((size_t)b * SEQ + sr0) * INWP + vc + 8 * sc0;
    const unsigned kw = sr0 * AT_KSTR + 16 * sc0, vw = AT_KBYTES + sr0 * AT_VSTR + 16 * sc0;
    const unsigned* mrow = (const unsigned*)(p.ws + WS_MASK) + grow * 64;
    const unsigned ka = qn * AT_KSTR + 16 * hf;
    const unsigned va = AT_KBYTES + (4 * hf + ((lane & 15) >> 2)) * AT_VSTR + (16 * ((lane >> 4) & 1) + 4 * (lane & 3)) * 2;
    u32x4 rk0, rk1, rv0, rv1; u32x2 mw = {0u, 0u}, mwn = {0u, 0u};
#define AT_LOAD(st_) do { const size_t o_ = (size_t)(st_) * 64 * INWP; rk0 = *(const u32x4*)(kg + o_); rk1 = *(const u32x4*)(kg + o_ + (size_t)32 * INWP); \
        rv0 = *(const u32x4*)(vg + o_); rv1 = *(const u32x4*)(vg + o_ + (size_t)32 * INWP); if (VAR == 0) mwn = *(const u32x2*)(mrow + 2 * (st_)); } while (0)
#define AT_WRITE(buf_) do { LAS unsigned char* b_ = lds + (buf_) * AT_STAGE; *(LAS u32x4*)(b_ + kw) = rk0; *(LAS u32x4*)(b_ + kw + 32 * AT_KSTR) = rk1; \
        *(LAS u32x4*)(b_ + vw) = rv0; *(LAS u32x4*)(b_ + vw + 32 * AT_VSTR) = rv1; } while (0)
    __syncthreads();
    AT_LOAD(nst - 1); AT_WRITE(0); mw = mwn;
    __syncthreads();
    if (wid >= 4) __builtin_amdgcn_s_setprio(1);
    int cur = 0;
    bool wdone = false;
    for (int st = nst - 1; st >= 0; --st) {
        if (st > 0) AT_LOAD(st - 1);
        if (st <= st_hi_w && !wdone) {
            LAS unsigned char* kb = lds + cur * AT_STAGE;
            f32x16 S[2];
#pragma unroll
            for (int r = 0; r < 16; ++r) { S[0][r] = 0.f; S[1][r] = 0.f; }
#pragma unroll
            for (int ks = 0; ks < 8; ++ks) {
                const h8_t a0 = *(const LAS h8_t*)(kb + ka + 32 * ks), a1 = *(const LAS h8_t*)(kb + ka + 32 * ks + 32 * AT_KSTR);
                S[0] = __builtin_amdgcn_mfma_f32_32x32x16_f16(a0, Qf[ks], S[0], 0, 0, 0);
                S[1] = __builtin_amdgcn_mfma_f32_32x32x16_f16(a1, Qf[ks], S[1], 0, 0, 0);
            }
            const bool diag = (64 * st + 63 > q0 + 32 * wid);
            const int kbase = 64 * st + 4 * hf;
            if (VAR != 1) {
                const bool blk_ok = (VAR == 2) ? ((allowed >> (st >> 2)) & 1u) : true;
                float mx = -INFINITY;
                if (VAR == 2 && !diag) {
                    const float bias = blk_ok ? 0.f : -INFINITY;
#pragma unroll
                    for (int sub = 0; sub < 2; ++sub)
#pragma unroll
                        for (int r = 0; r < 16; ++r) { const float v = S[sub][r] + bias; S[sub][r] = v; mx = fmaxf(mx, v); }
                } else {
#pragma unroll
                for (int sub = 0; sub < 2; ++sub)
#pragma unroll
                    for (int r = 0; r < 16; ++r) {
                        const int kl = (r & 3) + 8 * (r >> 2);
                        bool ok;
                        if (VAR == 0) ok = ((sub == 0 ? mw.x : mw.y) >> (kl + 4 * hf)) & 1u;
                        else ok = blk_ok && (!diag || (kbase + 32 * sub + kl <= qrow));
                        const float v = ok ? S[sub][r] : -INFINITY;
                        S[sub][r] = v; mx = fmaxf(mx, v);
                    }
                }
                mx = xhalf_max(mx);
                float m_new = fmaxf(m_run, mx);
                if (__ballot(m_new - m_run > 8.f) == 0ull) m_new = m_run;
                const float m_use = (m_new == -INFINITY) ? 0.f : m_new;
                const float alpha = fexp2(m_run - m_use);
                float ps = 0.f;
#pragma unroll
                for (int sub = 0; sub < 2; ++sub)
#pragma unroll
                    for (int r = 0; r < 16; ++r) { const float e = fexp2(S[sub][r] - m_use); S[sub][r] = e; ps += e; }
                l_run = l_run * alpha + ps;
                m_run = m_new;
                if (__ballot(alpha != 1.f) != 0ull) {
#pragma unroll
                    for (int dt = 0; dt < 4; ++dt)
#pragma unroll
                        for (int r = 0; r < 16; ++r) O[dt][r] *= alpha;
                }
            } else {
#pragma unroll
                for (int sub = 1; sub >= 0; --sub) {
                    float lk[16];
#pragma unroll
                    for (int r = 0; r < 16; ++r) {
                        const int kl = (r & 3) + 8 * (r >> 2);
                        const bool ok = !diag || (kbase + 32 * sub + kl < qrow);
                        const float zl = S[sub][r];
                        const float sp = fmaxf(zl, 0.f) + flog2(1.f + fexp2(-fabsf(zl)));
                        lk[r] = ok ? -sp : 0.f;
                        S[sub][r] = ok ? zl : -INFINITY;
                    }
                    float gsum[4], pg[4], T[4];
#pragma unroll
                    for (int g = 0; g < 4; ++g) { gsum[g] = (lk[4 * g] + lk[4 * g + 1]) + (lk[4 * g + 2] + lk[4 * g + 3]); { const auto r_ = __builtin_amdgcn_permlane32_swap(__float_as_uint(gsum[g]), __float_as_uint(gsum[g]), false, false); pg[g] = __uint_as_float(hf ? r_[0] : r_[1]); } T[g] = gsum[g] + pg[g]; }
                    float after[4];
                    after[3] = 0.f; after[2] = T[3]; after[1] = T[3] + T[2]; after[0] = T[3] + T[2] + T[1];
#pragma unroll
                    for (int g = 0; g < 4; ++g) {
                        const float base = carry + after[g] + (hf == 0 ? pg[g] : 0.f);
                        const float c3 = lk[4 * g + 3], c2 = lk[4 * g + 2] + c3, c1 = lk[4 * g + 1] + c2, c0 = lk[4 * g] + c1;
                        S[sub][4 * g + 3] = fexp2(S[sub][4 * g + 3] + base + c3);
                        S[sub][4 * g + 2] = fexp2(S[sub][4 * g + 2] + base + c2);
                        S[sub][4 * g + 1] = fexp2(S[sub][4 * g + 1] + base + c1);
                        S[sub][4 * g + 0] = fexp2(S[sub][4 * g + 0] + base + c0);
                    }
                    carry += (T[0] + T[1]) + (T[2] + T[3]);
                }
            }
#pragma unroll
            for (int sub = 0; sub < 2; ++sub)
#pragma unroll
                for (int s2 = 0; s2 < 2; ++s2) {
                    h8_t pb;
#pragma unroll
                    for (int j = 0; j < 8; ++j) pb[j] = (f16)S[sub][8 * s2 + j];
#pragma unroll
                    for (int dt = 0; dt < 4; ++dt) {
                        const LAS unsigned char* ap = kb + va + (32 * sub + 16 * s2) * AT_VSTR + 64 * dt;
                        const s4_t t0 = __builtin_amdgcn_ds_read_tr16_b64_v4i16((LAS s4_t*)ap);
                        const s4_t t1 = __builtin_amdgcn_ds_read_tr16_b64_v4i16((LAS s4_t*)(ap + 8 * AT_VSTR));
                        typedef short s8_t __attribute__((ext_vector_type(8)));
                        const s8_t a8 = __builtin_shufflevector(t0, t1, 0, 1, 2, 3, 4, 5, 6, 7);
                        O[dt] = __builtin_amdgcn_mfma_f32_32x32x16_f16(__builtin_bit_cast(h8_t, a8), pb, O[dt], 0, 0, 0);
                    }
                }
        }
        if (VAR == 1) {
            if (st <= st_hi_w && !wdone) wdone = (__ballot(carry < -100.f) == ~0ull);
            if (lane == 0) *(LAS unsigned*)(lds + 2 * AT_STAGE + 32 * (st & 1) + 4 * wid) = wdone ? 1u : 0u;
        }
        if (st > 0) { AT_WRITE(cur ^ 1); }
        mw = mwn;
        __syncthreads();
        cur ^= 1;
        if (VAR == 1) {
            unsigned alld = 1u;
#pragma unroll
            for (int w = 0; w < NWAVES; ++w) alld &= *(const LAS unsigned*)(lds + 2 * AT_STAGE + 32 * (st & 1) + 4 * w);
            if (alld) break;
        }
    }
#undef AT_LOAD
#undef AT_WRITE
    __builtin_amdgcn_s_setprio(0);
    float inv = 1.f;
    if (VAR != 1) { const float lt = xhalf_sum(l_run); inv = 1.f / lt; }
    float ss = 0.f;
#pragma unroll
    for (int dt = 0; dt < 4; ++dt)
#pragma unroll
        for (int r = 0; r < 16; ++r) { const float v = O[dt][r] * inv; O[dt][r] = v; ss += v * v; }
    ss = xhalf_sum(ss);
    const float rstd = rsqrtf(ss * (1.f / HD) + EPS);
    f16* yp = (f16*)(p.ws + WS_Y) + grow * DM + hh * HD + 4 * hf;
    const float* gp = ong + hh * HD + 4 * hf;
    f32x4 gg[4][4];
#pragma unroll
    for (int dt = 0; dt < 4; ++dt)
#pragma unroll
        for (int g = 0; g < 4; ++g) gg[dt][g] = *(const f32x4*)(gp + 32 * dt + 8 * g);
    __builtin_amdgcn_sched_barrier(0);
#pragma unroll
    for (int dt = 0; dt < 4; ++dt)
#pragma unroll
        for (int g = 0; g < 4; ++g) {
            u32x2 w; w.x = pack_h2(O[dt][4 * g] * rstd * gg[dt][g][0], O[dt][4 * g + 1] * rstd * gg[dt][g][1]); w.y = pack_h2(O[dt][4 * g + 2] * rstd * gg[dt][g][2], O[dt][4 * g + 3] * rstd * gg[dt][g][3]);
            *(u32x2*)(yp + 32 * dt + 8 * g) = w;
        }
}

__device__ __forceinline__ void phase_attn2(const Params& p, LAS unsigned char* lds, const float* ong, unsigned* queue) {
    for (;;) {
        __syncthreads();
        if (threadIdx.x == 0) *(LAS unsigned*)(lds + 2 * AT_STAGE + 96) = __hip_atomic_fetch_add(queue, 1u, __ATOMIC_RELAXED, __HIP_MEMORY_SCOPE_AGENT);
        __syncthreads();
        const int idx = (int)*(const LAS unsigned*)(lds + 2 * AT_STAGE + 96);
        if (idx >= NB * NHEADS * 8) break;
        int qt, b, hh;
        if (idx < 704) { qt = 7 - idx / 88; const int r = idx % 88; b = r / 11; const int h11 = r % 11; hh = h11 < HA ? h11 : h11 + HB; }
        else { const int r = idx - 704; qt = 7 - r / 40; b = (r % 40) / 5; hh = HA + (r % 5); }
        if (hh < HA) attn_item<0>(p, lds, ong, b, hh, qt, C_QA + hh * HD, C_KA, C_VA);
        else if (hh < HA + HB) attn_item<1>(p, lds, ong, b, hh, qt, C_QB + (hh - HA) * HD, C_KB + (hh - HA) * HD, C_VB + (hh - HA) * HD);
        else attn_item<2>(p, lds, ong, b, hh, qt, C_QC + (hh - HA - HB) * HD, C_KC + (hh - HA - HB) * HD, C_VC + (hh - HA - HB) * HD);
    }
}

#define CE_DESC(a, b) do { const unsigned _x = (a) > (b) ? (a) : (b), _y = (a) > (b) ? (b) : (a); (a) = _x; (b) = _y; } while (0)
__device__ __forceinline__ void sort16_desc(unsigned (&k)[16]) {
#pragma unroll
    for (int kk = 2; kk <= 16; kk <<= 1)
#pragma unroll
        for (int j = kk >> 1; j > 0; j >>= 1)
#pragma unroll
            for (int i = 0; i < 16; ++i) { const int l = i ^ j; if (l > i) { if ((i & kk) == 0) CE_DESC(k[i], k[l]); else CE_DESC(k[l], k[i]); } }
}
__device__ __forceinline__ void merge16_desc(unsigned (&a)[16], const unsigned (&b)[16]) {
#pragma unroll
    for (int i = 0; i < 16; ++i) a[i] = a[i] > b[15 - i] ? a[i] : b[15 - i];
#pragma unroll
    for (int j = 8; j > 0; j >>= 1)
#pragma unroll
        for (int i = 0; i < 16; ++i) { const int l = i ^ j; if (l > i) CE_DESC(a[i], a[l]); }
}
__device__ __forceinline__ unsigned f2sort(float f) { const unsigned b = __float_as_uint(f); return b ^ ((unsigned)((int)b >> 31) | 0x80000000u); }
__device__ __forceinline__ float sort2f(unsigned u) { const unsigned b = (u & 0x80000000u) ? (u ^ 0x80000000u) : ~u; return __uint_as_float(b); }
constexpr int RT_STR = 272;
__device__ __forceinline__ void phase_route2(const Params& p, LAS unsigned char* lds, const f16* subk) {
    const f16* qp = (const f16*)(p.ws + WS_Y);
    unsigned* pe = (unsigned*)(p.ws + WS_PE); float* pg = (float*)(p.ws + WS_PG);
    const int tid = otid(), wid = __builtin_amdgcn_readfirstlane(tid >> 6), lane = tid & 63, qn = lane & 31, hf = lane >> 5;
    for (int item = obid(); item < 256; item += gridDim.x) {
        const int hp = item & 7, tg = item >> 3;
        __syncthreads();
        {
            const f16* src = subk + (size_t)hp * 256 * 128;
#pragma unroll
            for (int i = 0; i < 8; ++i) { const int e = tid + i * 512, r = e >> 4, c = e & 15; *(LAS u32x4*)(lds + r * RT_STR + 16 * c) = *(const u32x4*)(src + r * 128 + 8 * c); }
        }
        __syncthreads();
#pragma unroll 1
        for (int it = 0; it < 2; ++it) {
            const int t = (tg * 16 + wid * 2 + it) * 32 + qn;
            unsigned top[2][16];
#pragma unroll
            for (int c = 0; c < 2; ++c) {
                h8_t Bq[8];
                const f16* qrow = qp + (size_t)t * DM + hp * 256 + c * 128 + 8 * hf;
#pragma unroll
                for (int ks = 0; ks < 8; ++ks) Bq[ks] = *(const h8_t*)(qrow + 16 * ks);
                unsigned run[16];
#pragma unroll 1
                for (int nt = 0; nt < 4; ++nt) {
                    f32x16 S;
#pragma unroll
                    for (int r = 0; r < 16; ++r) S[r] = 0.f;
#pragma unroll
                    for (int ks = 0; ks < 8; ++ks) {
                        const h8_t a = *(const LAS h8_t*)(lds + (c * 128 + nt * 32 + qn) * RT_STR + 32 * ks + 16 * hf);
                        S = __builtin_amdgcn_mfma_f32_32x32x16_f16(a, Bq[ks], S, 0, 0, 0);
                    }
                    unsigned k[16];
#pragma unroll
                    for (int r = 0; r < 16; ++r) { const int n = 32 * nt + (r & 3) + 8 * (r >> 2) + 4 * hf; k[r] = (f2sort(S[r]) & ~127u) | (unsigned)(127 - n); }
                    sort16_desc(k);
                    if (nt == 0) {
#pragma unroll
                        for (int r = 0; r < 16; ++r) run[r] = k[r];
                    } else merge16_desc(run, k);
                }
#pragma unroll
                for (int r = 0; r < 16; ++r) top[c][r] = run[r];
            }
            unsigned mine[16], oth[16];
#pragma unroll
            for (int r = 0; r < 16; ++r) { const unsigned send = hf ? top[0][r] : top[1][r]; oth[r] = __shfl_xor(send, 32); mine[r] = hf ? top[1][r] : top[0][r]; }
            merge16_desc(mine, oth);
            unsigned ka[16], kb2[16];
#pragma unroll
            for (int r = 0; r < 16; ++r) { const unsigned o = __shfl_xor(mine[r], 32); ka[r] = hf ? o : mine[r]; kb2[r] = hf ? mine[r] : o; }
            float sa[16], sb[16]; unsigned na[4] = {0u, 0u, 0u, 0u}, nb[4] = {0u, 0u, 0u, 0u};
#pragma unroll
            for (int r = 0; r < 16; ++r) {
                sa[r] = sort2f(ka[r] & ~127u); sb[r] = sort2f(kb2[r] & ~127u);
                na[r >> 2] |= (127u - (ka[r] & 127u)) << (8 * (r & 3)); nb[r >> 2] |= (127u - (kb2[r] & 127u)) << (8 * (r & 3));
            }
            unsigned cand[4][16];
#pragma unroll
            for (int g = 0; g < 4; ++g)
#pragma unroll
                for (int r = 0; r < 16; ++r) cand[g][r] = 0u;
#pragma unroll
            for (int slot = 0; slot < 50; ++slot) {
                constexpr unsigned char CIJ[64] = {0, 1, 2, 3, 4, 5, 6, 7, 8, 9, 10, 11, 12, 13, 14, 15, 16, 17, 18, 19, 20, 21, 22, 23, 32, 33, 34, 35, 36, 48, 49, 50, 51, 64, 65, 66, 80, 81, 96, 97, 112, 113, 128, 144, 160, 176, 192, 208, 224, 240, 255, 255, 255, 255, 255, 255, 255, 255, 255, 255, 255, 255, 255, 255};
                const int ij = CIJ[slot], i = ij >> 4, j = ij & 15;
                cand[slot >> 4][slot & 15] = (f2sort(sa[i] + sb[j]) & ~255u) | (unsigned)(255 - ij);
            }
#pragma unroll
            for (int g = 1; g < 4; ++g) sort16_desc(cand[g]);
            merge16_desc(cand[0], cand[1]); merge16_desc(cand[2], cand[3]); merge16_desc(cand[0], cand[2]);
            float ex[16]; float sum = 0.f;
            const float mx = sort2f(cand[0][0] & ~255u);
#pragma unroll
            for (int r = 0; r < 16; ++r) { ex[r] = __expf(sort2f(cand[0][r] & ~255u) - mx); sum += ex[r]; }
            const float inv = 1.f / sum;
            unsigned eo[16];
#pragma unroll
            for (int r = 0; r < 16; ++r) {
                const unsigned id = 255u - (cand[0][r] & 255u), i = id >> 4, j = id & 15u;
                const unsigned wa = (i & 8u) ? ((i & 4u) ? na[3] : na[2]) : ((i & 4u) ? na[1] : na[0]);
                const unsigned wb = (j & 8u) ? ((j & 4u) ? nb[3] : nb[2]) : ((j & 4u) ? nb[1] : nb[0]);
                eo[r] = ((wa >> (8 * (i & 3u))) & 255u) * PNK + ((wb >> (8 * (j & 3u))) & 255u);
                ex[r] *= inv;
            }
            if (hf == 0) {
#pragma unroll
                for (int r4 = 0; r4 < 4; ++r4) { u32x4 w; w.x = eo[4 * r4]; w.y = eo[4 * r4 + 1]; w.z = eo[4 * r4 + 2]; w.w = eo[4 * r4 + 3]; *(u32x4*)(pe + (size_t)t * 128 + hp * 16 + 4 * r4) = w; }
            } else {
#pragma unroll
                for (int r4 = 0; r4 < 4; ++r4) { f32x4 w; w[0] = ex[4 * r4]; w[1] = ex[4 * r4 + 1]; w[2] = ex[4 * r4 + 2]; w[3] = ex[4 * r4 + 3]; *(f32x4*)(pg + (size_t)t * 128 + hp * 16 + 4 * r4) = w; }
            }
        }
    }
}

#ifndef EXU_NR
#define EXU_NR 8
#define EXU_SH 11
#endif
__device__ __forceinline__ float gelu_as(float v) {
    const float av = fabsf(v), t = __builtin_amdgcn_rcpf(av * 0.2316418882f + 1.0f);
    float q = t * 0.5307027145f + (-0.7265760135f); q = q * t + 0.7107068705f; q = q * t + (-0.142248368f); q = q * t + 0.127414796f; q = q * t;
    const float e = __builtin_amdgcn_exp2f((v * v) * (-0.72134752044f));
    const float m = v * (q * e);
    return v < 0.f ? m : v - m;
}
__device__ __forceinline__ int row16_sum(int d) {
    d += __builtin_amdgcn_update_dpp(0, d, 0xB1, 0xF, 0xF, true);
    d += __builtin_amdgcn_update_dpp(0, d, 0x4E, 0xF, 0xF, true);
    d += __builtin_amdgcn_update_dpp(0, d, 0x141, 0xF, 0xF, true);
    d += __builtin_amdgcn_update_dpp(0, d, 0x140, 0xF, 0xF, true);
    return d;
}
__device__ __forceinline__ unsigned xcc_id() { return (unsigned)__builtin_amdgcn_s_getreg((3 << 11) | 20) & 0xFu; }
template <int BITS>
__device__ __forceinline__ void phase_exu(const Params& p, LAS unsigned char* lds, const unsigned char* u8, const float* su, const float* sv) {
    const int tid = otid(), wid = __builtin_amdgcn_readfirstlane(tid >> 6), lane = tid & 63, sub = lane & 15, qd = lane >> 4;
    const unsigned* pe = (const unsigned*)(p.ws + WS_PE); const float* pg = (const float*)(p.ws + WS_PG);
    const unsigned char* h8 = (const unsigned char*)(p.ws + WS_H8); const float* shv = (const float*)(p.ws + WS_SH);
    unsigned* list = (unsigned*)(p.ws + WS_LIST);
    const unsigned* ctl = (const unsigned*)(p.ws + WS_CTL);
    const unsigned myx = *(const LAS unsigned*)(lds + LDS_BYTES - 16), mybi = *(const LAS unsigned*)(lds + LDS_BYTES - 12);
    int G = 0, g = 0, nb = 1;
#pragma unroll
    for (int j = 0; j < 16; ++j) { const unsigned c = __builtin_amdgcn_readfirstlane(__hip_atomic_load(ctl + j, __ATOMIC_RELAXED, __HIP_MEMORY_SCOPE_AGENT)); if (c > 0u) { if ((unsigned)j < myx) ++g; ++G; } if ((unsigned)j == myx) nb = (int)c; }
    const int tstep = nb * NWAVES, tfirst = (int)mybi * NWAVES + wid;
    const int nvis_t = (tfirst < NT) ? (NT - tfirst + tstep - 1) / tstep : 0;
    const int nrange = (EXU_NR - g + G - 1) / G;
    const int nvis = nvis_t * nrange;
    const int* hsv = (const int*)(p.ws + WS_HS);
    unsigned ne0 = 0u, ne1 = 0u; u32x4 nhv[8]; float nsh = 0.f; int nhs = 0;
#define EXU_FETCH(v_) do { const int tt_ = tfirst + ((v_) % nvis_t) * tstep; ne0 = pe[(size_t)tt_ * 128 + lane]; ne1 = pe[(size_t)tt_ * 128 + 64 + lane]; \
        _Pragma("unroll") for (int m = 0; m < 8; ++m) nhv[m] = *(const u32x4*)(h8 + (size_t)tt_ * DM + (BITS == 8 ? 256 * m + 16 * sub : 512 * (m >> 1) + 32 * sub + 16 * (m & 1))); nsh = shv[tt_]; if (BITS == 4) nhs = hsv[tt_]; } while (0)
    if (nvis > 0) EXU_FETCH(0);
    for (int v = 0; v < nvis; ++v) {
        const int t = tfirst + (v % nvis_t) * tstep, r = g + (v / nvis_t) * G;
        const unsigned e0 = ne0, e1 = ne1; const float sht = nsh; const int hs8 = 8 * nhs;
        u32x4 hv[8];
#pragma unroll
        for (int m = 0; m < 8; ++m) hv[m] = nhv[m];
        if (v + 1 < nvis) EXU_FETCH(v + 1);
        const bool in0 = (int)(e0 >> EXU_SH) == r, in1 = (int)(e1 >> EXU_SH) == r;
        const unsigned long long m0 = __ballot(in0), m1 = __ballot(in1);
        const int n0 = __builtin_popcountll(m0), n = n0 + __builtin_popcountll(m1);
        if (n == 0) continue;
        LAS unsigned* wl = (LAS unsigned*)(lds + wid * 1024 + (v & 1) * 512);
        const unsigned long long below = (1ull << lane) - 1ull;
        if (in0) wl[__builtin_popcountll(m0 & below)] = ((unsigned)lane << 16) | e0;
        if (in1) wl[n0 + __builtin_popcountll(m1 & below)] = ((unsigned)(lane + 64) << 16) | e1;
        __builtin_amdgcn_wave_barrier();
        constexpr int PPI = 4;
        constexpr int PPQ = PPI / 4, NLD = (BITS == 8) ? 8 : 4;
        const int nit = (n + PPI - 1) / PPI;
        u32x4 wb[2][8]; unsigned entb[2][PPQ]; float sub_[2][PPQ], svb_[2][PPQ], pgb_[2][PPQ];
#define EXU_ISSUE(B_, it_) do { _Pragma("unroll") for (int pp = 0; pp < PPQ; ++pp) { const int idx_ = (it_) * PPI + qd * PPQ + pp; entb[B_][pp] = wl[idx_ < n ? idx_ : 0]; \
            sub_[B_][pp] = su[entb[B_][pp] & 0xffffu]; svb_[B_][pp] = sv[entb[B_][pp] & 0xffffu]; pgb_[B_][pp] = pg[(size_t)t * 128 + (entb[B_][pp] >> 16)]; \
            const unsigned char* row_ = u8 + (size_t)(entb[B_][pp] & 0xffffu) * (BITS == 8 ? DM : DM / 2) + 16 * sub; \
            _Pragma("unroll") for (int m = 0; m < NLD; ++m) wb[B_][pp * NLD + m] = *(const u32x4*)(row_ + 256 * m); } } while (0)
#define EXU_COMPUTE(B_, it_) do { _Pragma("unroll") for (int pp = 0; pp < PPQ; ++pp) { int d_ = 0; \
            if (BITS == 8) { \
            _Pragma("unroll") for (int m = 0; m < 8; ++m) { const u32x4 w_ = wb[B_][m]; \
                d_ = __builtin_amdgcn_sdot4((int)hv[m].x, (int)w_.x, d_, false); d_ = __builtin_amdgcn_sdot4((int)hv[m].y, (int)w_.y, d_, false); \
                d_ = __builtin_amdgcn_sdot4((int)hv[m].z, (int)w_.z, d_, false); d_ = __builtin_amdgcn_sdot4((int)hv[m].w, (int)w_.w, d_, false); } \
            } else { \
            _Pragma("unroll") for (int m = 0; m < 4; ++m) { const u32x4 w_ = wb[B_][pp * 4 + m]; const u32x4 ha_ = hv[2 * m], hb_ = hv[2 * m + 1]; \
                d_ = __builtin_amdgcn_sdot4((int)ha_.x, (int)(w_.x & 0x0F0F0F0Fu), d_, false); d_ = __builtin_amdgcn_sdot4((int)ha_.y, (int)((w_.x >> 4) & 0x0F0F0F0Fu), d_, false); \
                d_ = __builtin_amdgcn_sdot4((int)ha_.z, (int)(w_.y & 0x0F0F0F0Fu), d_, false); d_ = __builtin_amdgcn_sdot4((int)ha_.w, (int)((w_.y >> 4) & 0x0F0F0F0Fu), d_, false); \
                d_ = __builtin_amdgcn_sdot4((int)hb_.x, (int)(w_.z & 0x0F0F0F0Fu), d_, false); d_ = __builtin_amdgcn_sdot4((int)hb_.y, (int)((w_.z >> 4) & 0x0F0F0F0Fu), d_, false); \
                d_ = __builtin_amdgcn_sdot4((int)hb_.z, (int)(w_.w & 0x0F0F0F0Fu), d_, false); d_ = __builtin_amdgcn_sdot4((int)hb_.w, (int)((w_.w >> 4) & 0x0F0F0F0Fu), d_, false); } \
            } \
            d_ = row16_sum(d_); \
            if (BITS == 4) d_ -= hs8; \
            if (((it_) * PPI + qd * PPQ + pp < n) && sub == 0) { \
                const unsigned ent_ = entb[B_][pp], j_ = ent_ >> 16, e_ = ent_ & 0xffffu; \
                const float dd_ = (float)d_ * sub_[B_][pp] * sht; \
                const float act_ = gelu_as(dd_); \
                const float coef_ = pgb_[B_][pp] * svb_[B_][pp] * act_ * (1024.f * 256.f); \
                const int ci_ = (int)rintf(fminf(fmaxf(coef_, -32767.f), 32767.f)); \
                list[((size_t)(j_ >> 2) * NT + t) * 4 + (j_ & 3u)] = e_ | ((unsigned)ci_ << 16); } } } while (0)
        EXU_ISSUE(0, 0);
        int it = 0;
        for (; it + 2 < nit; it += 2) {
            EXU_ISSUE(1, it + 1); EXU_COMPUTE(0, it);
            EXU_ISSUE(0, it + 2); EXU_COMPUTE(1, it + 1);
        }
        if (it + 2 == nit) { EXU_ISSUE(1, it + 1); EXU_COMPUTE(0, it); EXU_COMPUTE(1, it + 1); }
        else { EXU_COMPUTE(0, it); }
#undef EXU_ISSUE
#undef EXU_COMPUTE
    }
#undef EXU_FETCH
}

__device__ __forceinline__ void phase_exv(const Params& p, LAS unsigned char* lds, const f16* x1, const float* gate2, const unsigned char* v8c, f16* xout) {
    const int tid = otid();
    const u32x4* list = (const u32x4*)(p.ws + WS_LIST);
    int cfirst = obid(), cstep = gridDim.x;
    {
        const unsigned* ctl = (const unsigned*)(p.ws + WS_CTL);
        const unsigned myx = *(const LAS unsigned*)(lds + LDS_BYTES - 16), mybi = *(const LAS unsigned*)(lds + LDS_BYTES - 12);
        int G = 0, g = 0, nb = 1; bool uniform = true; unsigned c0 = 0u;
#pragma unroll
        for (int j = 0; j < 16; ++j) { const unsigned c = __builtin_amdgcn_readfirstlane(__hip_atomic_load(ctl + j, __ATOMIC_RELAXED, __HIP_MEMORY_SCOPE_AGENT)); if (c > 0u) { if ((unsigned)j < myx) ++g; ++G; if (c0 == 0u) c0 = c; else if (c != c0) uniform = false; } if ((unsigned)j == myx) nb = (int)c; }
        if (uniform && G * nb == (int)gridDim.x && (int)gridDim.x == 256) { cfirst = g * nb + (int)mybi; cstep = 256; }
    }
    for (int c = cfirst; c < 256; c += cstep) {
        __syncthreads();
        {
            const u32x4* src = (const u32x4*)(v8c + (size_t)c * PEXP * 8);
#pragma unroll 4
            for (int i = 0; i < 16; ++i) *(LAS u32x4*)(lds + (size_t)(i * 512 + tid) * 16) = src[i * 512 + tid];
        }
        __syncthreads();
        typedef short s2_t __attribute__((ext_vector_type(2)));
        u32x4 wq[2][8];
        int acc[8]; int csum = 0;
#pragma unroll
        for (int k = 0; k < 8; ++k) acc[k] = 0;
        constexpr int NBATCH = (NT / NTHREADS) * 4;
#define EXV_LOAD(B_, q_) do { const int qq_ = (q_) < NBATCH ? (q_) : NBATCH - 1; const int t_ = tid + (qq_ >> 2) * NTHREADS, jb_ = qq_ & 3; \
            _Pragma("unroll") for (int j4 = 0; j4 < 8; ++j4) wq[B_][j4] = list[(size_t)(jb_ * 8 + j4) * NT + t_]; } while (0)
        EXV_LOAD(0, 0);
#pragma unroll 1
        for (int q0 = 0; q0 < NBATCH; q0 += 4) {
#pragma unroll
            for (int u = 0; u < 4; ++u) {
                const int q = q0 + u;
                if (q < NBATCH) {
                    EXV_LOAD((u + 1) % 2, q + 1);
#pragma unroll
                    for (int j4 = 0; j4 < 8; ++j4) {
                        const unsigned dd[4] = {wq[u % 2][j4].x, wq[u % 2][j4].y, wq[u % 2][j4].z, wq[u % 2][j4].w};
#pragma unroll
                        for (int h = 0; h < 2; ++h) {
                            const unsigned d0 = dd[2 * h], d1 = dd[2 * h + 1];
                            const u32x2 v0 = *(const LAS u32x2*)(size_t)((d0 << 3) & 0x7fff8u), v1 = *(const LAS u32x2*)(size_t)((d1 << 3) & 0x7fff8u);
                            const s2_t cp = __builtin_bit_cast(s2_t, __builtin_amdgcn_perm(d1, d0, 0x07060302u));
                            csum = __builtin_amdgcn_sdot2(cp, __builtin_bit_cast(s2_t, 0x00010001u), csum, false);
                            acc[0] = __builtin_amdgcn_sdot2(cp, __builtin_bit_cast(s2_t, __builtin_amdgcn_perm(v1.x, v0.x, 0x0c040c00u)), acc[0], false);
                            acc[1] = __builtin_amdgcn_sdot2(cp, __builtin_bit_cast(s2_t, __builtin_amdgcn_perm(v1.x, v0.x, 0x0c050c01u)), acc[1], false);
                            acc[2] = __builtin_amdgcn_sdot2(cp, __builtin_bit_cast(s2_t, __builtin_amdgcn_perm(v1.x, v0.x, 0x0c060c02u)), acc[2], false);
                            acc[3] = __builtin_amdgcn_sdot2(cp, __builtin_bit_cast(s2_t, __builtin_amdgcn_perm(v1.x, v0.x, 0x0c070c03u)), acc[3], false);
                            acc[4] = __builtin_amdgcn_sdot2(cp, __builtin_bit_cast(s2_t, __builtin_amdgcn_perm(v1.y, v0.y, 0x0c040c00u)), acc[4], false);
                            acc[5] = __builtin_amdgcn_sdot2(cp, __builtin_bit_cast(s2_t, __builtin_amdgcn_perm(v1.y, v0.y, 0x0c050c01u)), acc[5], false);
                            acc[6] = __builtin_amdgcn_sdot2(cp, __builtin_bit_cast(s2_t, __builtin_amdgcn_perm(v1.y, v0.y, 0x0c060c02u)), acc[6], false);
                            acc[7] = __builtin_amdgcn_sdot2(cp, __builtin_bit_cast(s2_t, __builtin_amdgcn_perm(v1.y, v0.y, 0x0c070c03u)), acc[7], false);
                        }
                    }
                    if ((u & 3) == 3) {
                        const int t = tid + (q >> 2) * NTHREADS;
                        const int b = t / SEQ, col = 8 * c;
                        const int off = csum << 7;
                        const u32x4 xw = *(const u32x4*)(x1 + (size_t)t * DM + col);
                        const unsigned xws[4] = {xw.x, xw.y, xw.z, xw.w};
                        u32x4 ow; unsigned ows[4];
#pragma unroll
                        for (int hfi = 0; hfi < 2; ++hfi) {
                            const f32x4 gt = *(const f32x4*)(gate2 + (size_t)b * 6 * DM + col + 4 * hfi);
                            float r[4];
#pragma unroll
                            for (int k = 0; k < 4; ++k) { const unsigned xx = xws[2 * hfi + (k >> 1)]; const float xi = (k & 1) ? h_hi(xx) : h_lo(xx); r[k] = xi + gt[k] * ((float)(acc[4 * hfi + k] - off) * (1.f / (1024.f * 256.f))); }
                            ows[2 * hfi] = pack_h2(r[0], r[1]); ows[2 * hfi + 1] = pack_h2(r[2], r[3]);
                        }
                        ow.x = ows[0]; ow.y = ows[1]; ow.z = ows[2]; ow.w = ows[3];
                        *(u32x4*)(xout + (size_t)t * DM + col) = ow;
                        csum = 0;
#pragma unroll
                        for (int k = 0; k < 8; ++k) acc[k] = 0;
                    }
                }
            }
        }
#undef EXV_LOAD
    }
}

#define XB_TMO      128
#define XB_XCNT(j)  (256  + 64 * (j))
#define XB_XSUB(j)  (1280 + 64 * (j))
#define XB_XGEN(j)  (2304 + 64 * (j))
#define XB_TOP      3328
#define XB_TOPGEN   3392
#define XCD_BAR_WORDS 3456
#define XB_SPIN_CAP (1u << 22)
__device__ __forceinline__ unsigned xb_ld(unsigned* p) { return __hip_atomic_load(p, __ATOMIC_RELAXED, __HIP_MEMORY_SCOPE_AGENT); }
__device__ __forceinline__ unsigned xb_add(unsigned* p, unsigned v) { return __hip_atomic_fetch_add(p, v, __ATOMIC_RELAXED, __HIP_MEMORY_SCOPE_AGENT); }
#define XB_SPIN(cond, bar) do { unsigned _sp = 0; while (cond) { __builtin_amdgcn_s_sleep(1); \
    if ((++_sp & 255u) == 0u) { if (xb_ld(&(bar)[XB_TMO])) break; if (_sp > XB_SPIN_CAP) { atomicAdd(&(bar)[XB_TMO], 1u); break; } } } } while (0)
struct XcdBarrier { unsigned* bar; unsigned x; volatile LAS unsigned* st; };
__device__ __forceinline__ void xcd_barrier_complete(unsigned* bar, unsigned x, unsigned& nloc, unsigned& nx) {
    const unsigned G = gridDim.x * gridDim.y * gridDim.z;
    unsigned sum, cnt, mine, sp = 0u;
    for (;;) {
        sum = 0u; cnt = 0u; mine = 0u;
#pragma unroll
        for (unsigned j = 0; j < 16; ++j) { const unsigned c = xb_ld(&bar[XB_XCNT(j)]); sum += c; cnt += (c > 0u) ? 1u : 0u; mine = (j == x) ? c : mine; }
        if (sum == G) break;
        __builtin_amdgcn_s_sleep(1);
        if ((++sp & 255u) == 0u) { if (xb_ld(&bar[XB_TMO])) break; if (sp > XB_SPIN_CAP) { atomicAdd(&bar[XB_TMO], 1u); break; } }
    }
    nloc = mine > 0u ? mine : 1u; nx = cnt > 0u ? cnt : 1u;
}
__device__ __forceinline__ void xcd_barrier(const XcdBarrier& b) {
    asm volatile("s_waitcnt vmcnt(0)" ::: "memory");
    __syncthreads();
    if (threadIdx.x == 0) {
        unsigned* bar = b.bar;
        __builtin_amdgcn_s_waitcnt(0);
        unsigned nloc = b.st[0], nx = b.st[1];
        if (nloc == 0u) { xcd_barrier_complete(bar, b.x, nloc, nx); b.st[0] = nloc; b.st[1] = nx; }
        const unsigned old = xb_add(&bar[XB_XSUB(b.x)], 1u);
        const unsigned gen = old / nloc;
        if (old + 1u == (gen + 1u) * nloc) {
            __builtin_amdgcn_fence(__ATOMIC_RELEASE, "agent");
            asm volatile("s_waitcnt vmcnt(0)" ::: "memory");
            const unsigned og = xb_add(&bar[XB_TOP], 1u);
            const unsigned tg = og / nx;
            if (og + 1u == (tg + 1u) * nx) xb_add(&bar[XB_TOPGEN], 1u);
            else XB_SPIN(xb_ld(&bar[XB_TOPGEN]) == tg, bar);
            __builtin_amdgcn_fence(__ATOMIC_ACQUIRE, "agent");
            xb_add(&bar[XB_XGEN(b.x)], 1u);
            asm volatile("s_waitcnt vmcnt(0)" ::: "memory");
        } else {
            XB_SPIN(xb_ld(&bar[XB_XGEN(b.x)]) == gen, bar);
            __builtin_amdgcn_fence(__ATOMIC_ACQUIRE, "agent");
            asm volatile("s_waitcnt vmcnt(0)" ::: "memory");
        }
    }
    __syncthreads();
}

constexpr int PH_CONV = 0, PH_N1 = 1, PH_L0 = 2, PH_PER_LAYER = 10, PH_TOTAL = PH_L0 + DEPTH * PH_PER_LAYER;

__global__ void __launch_bounds__(NTHREADS, 2) mega(Params p_arg) {
    extern __shared__ __attribute__((aligned(16))) unsigned char shm[];
    LAS unsigned char* lds = (LAS unsigned char*)shm;
    typedef const Params __attribute__((address_space(4)))* KP;
    const int ph_lo = p_arg.ph_lo, ph_hi = p_arg.ph_hi;
    if (threadIdx.x == 0) {
        const unsigned x = xcc_id();
        const unsigned bi = __hip_atomic_fetch_add((unsigned*)(p_arg.ws + WS_CTL) + x, 1u, __ATOMIC_RELAXED, __HIP_MEMORY_SCOPE_AGENT);
        *(LAS unsigned*)(lds + LDS_BYTES - 16) = x; *(LAS unsigned*)(lds + LDS_BYTES - 12) = bi;
        *(LAS unsigned*)(lds + LDS_BYTES - 32) = 0u; *(LAS unsigned*)(lds + LDS_BYTES - 28) = 0u;
        (void)xb_add((unsigned*)(p_arg.ws + WS_CTL + 256) + XB_XCNT(x), 1u);
    }
    __syncthreads();
    XcdBarrier xbar; xbar.bar = (unsigned*)(p_arg.ws + WS_CTL + 256); xbar.x = *(const LAS unsigned*)(lds + LDS_BYTES - 16); xbar.st = (volatile LAS unsigned*)(lds + LDS_BYTES - 32);
#ifndef PMASK
#define PMASK 0xff
#endif
#define EN(k) ((PMASK >> (k)) & 1)
    for (int ph = ph_lo; ph < ph_hi; ++ph) {
        KP kp = (KP)__builtin_amdgcn_kernarg_segment_ptr();
        asm volatile("" : "+s"(kp));
#if defined(__HIP_DEVICE_COMPILE__)
        const Params p = *kp;
#else
        const Params p = p_arg;
#endif
        unsigned char* ws = p.ws;
        const float* mod = (const float*)(ws + WS_MOD);
        int kind, l = 0, s = -1;
        if (ph == PH_CONV) kind = 0;
        else if (ph == PH_N1) kind = 1;
        else {
            l = (ph - PH_L0) / PH_PER_LAYER; s = (ph - PH_L0) % PH_PER_LAYER;
            kind = (s == 0 || s == 3 || s == 5) ? 2 : (s == 1 ? 4 : (s == 2 ? 5 : (s == 4 ? 1 : (s == 6 ? 6 : (s == 7 ? 7 : (s == 8 ? 8 : 9))))));
        }
        const float* modl = mod + (size_t)l * NB * 6 * DM;
        f16* x1 = (f16*)(ws + WS_X1); f16* x2 = (f16*)(ws + WS_X2);
#ifndef REPEAT_KIND
#define REPEAT_KIND -1
#endif
        for (int rep = 0; rep < ((kind == REPEAT_KIND) ? 2 : 1); ++rep) {
        if (rep == 1) xcd_barrier(xbar);
        if (kind == 0) { if (EN(0)) phase_conv(p, lds); }
        else if (kind == 1) {
            if (EN(1)) {
                if (s < 0) phase_norm2<0, false>(p.x, nullptr, nullptr, p.n1g, mod + 0 * DM, mod + 1 * DM, (f16*)(ws + WS_H), nullptr, nullptr);
                else phase_norm2<1, true>(nullptr, x1, nullptr, p.n2g + (size_t)l * DM, modl + 3 * DM, modl + 4 * DM, (f16*)(ws + WS_H), (unsigned*)(ws + WS_H8), (float*)(ws + WS_SH));
            }
        } else if (kind == 2) {
            if (EN(2)) {
                Epi E{}; const f16* A; const f16* Bt; int N;
                if (s == 0) { E.mode = 2; E.rope128 = (const float*)(ws + WS_ROPE128); E.rope64 = (const float*)(ws + WS_ROPE64); E.o16 = (f16*)(ws + WS_PROJ); E.ldc = INWP; A = (const f16*)(ws + WS_H); Bt = (const f16*)(ws + WS_WTIN) + (size_t)l * INWP * DM; N = INWP; }
                else if (s == 3) { E.mode = 1; E.o16 = x1; E.xin = p.x; E.xinh = l == 0 ? nullptr : x2; E.gate = modl + 2 * DM; A = (const f16*)(ws + WS_Y); Bt = (const f16*)(ws + WS_WTOUT) + (size_t)l * DM * DM; N = DM; }
                else { E.mode = 0; E.o16 = (f16*)(ws + WS_Y); E.ldc = DM; A = (const f16*)(ws + WS_H); Bt = (const f16*)(ws + WS_WTQ) + (size_t)l * DM * DM; N = DM; }
                gemm_run(p, lds, A, Bt, N, E);
            }
        }
        else if (kind == 4) { if (EN(4)) phase_index2(p, lds); }
        else if (kind == 5) { if (EN(5)) phase_attn2(p, lds, p.ong + (size_t)l * DM, (unsigned*)(ws + WS_CTL + 64) + l); }
        else if (kind == 6) { if (EN(6)) phase_route2(p, lds, (const f16*)(ws + WS_SUBK) + (size_t)l * PH * 2 * PNK * 128); }
        else if (kind == 7) {
            if (EN(7)) { if (l == DEPTH - 1 && LAST_BITS == 4) phase_exu<4>(p, lds, ws + WS_U8 + (size_t)l * PEXP * DM, (const float*)(ws + WS_SU) + (size_t)l * PEXP, (const float*)(ws + WS_SV) + (size_t)l * PEXP);
                         else phase_exu<8>(p, lds, ws + WS_U8 + (size_t)l * PEXP * DM, (const float*)(ws + WS_SU) + (size_t)l * PEXP, (const float*)(ws + WS_SV) + (size_t)l * PEXP); }
        } else if (kind == 8) {
            if (EN(7)) phase_exv(p, lds, x1, modl + 5 * DM, ws + WS_V8 + (size_t)l * PEXP * DM, x2);
        } else {
            const bool fin = (l == DEPTH - 1);
            const float* modn = mod + (size_t)(fin ? l : l + 1) * NB * 6 * DM;
            if (EN(1)) { if (fin) phase_norm2<2, true>(nullptr, x2, p.out, p.fg, nullptr, nullptr, nullptr, nullptr, nullptr);
                         else phase_norm2<0, true>(nullptr, x2, nullptr, p.n1g + (size_t)(l + 1) * DM, modn + 0 * DM, modn + 1 * DM, (f16*)(ws + WS_H), nullptr, nullptr); }
        }
        }
        if (ph + 1 < ph_hi) { if (ph == ph_lo) cg::this_grid().sync(); else xcd_barrier(xbar); }
    }
}

extern "C" void kernel_launch(void* const* d_in, const int* in_sizes, int n_in, void* d_out, int out_size, void* d_ws, size_t ws_size, hipStream_t stream) {
    static int grid = 0;
    if (grid == 0) {
        if (n_in != 14 || out_size != NT * DM || ws_size < WS_END) { fprintf(stderr, "kernel_launch: unexpected sizes (n_in %d out %d ws %zu need %zu)\n", n_in, out_size, ws_size, (size_t)WS_END); grid = -1; return; }
        if (hipFuncSetAttribute((const void*)mega, hipFuncAttributeMaxDynamicSharedMemorySize, LDS_BYTES) != hipSuccess) { fprintf(stderr, "kernel_launch: hipFuncSetAttribute failed\n"); grid = -1; return; }
        int dev = 0, cus = 0, per_cu = 0;
        hipGetDevice(&dev); hipDeviceGetAttribute(&cus, hipDeviceAttributeMultiprocessorCount, dev);
        hipOccupancyMaxActiveBlocksPerMultiprocessor(&per_cu, (const void*)mega, NTHREADS, LDS_BYTES);
        if (per_cu < 1) { fprintf(stderr, "kernel_launch: occupancy query says %d blocks per CU\n", per_cu); grid = -1; return; }
        grid = cus;
    }
    if (grid < 0) return;
    Params p{};
    p.x = (const float*)d_in[0]; p.c = (const float*)d_in[1]; p.ada_w = (const float*)d_in[2]; p.ada_b = (const float*)d_in[3];
    p.n1g = (const float*)d_in[4]; p.n2g = (const float*)d_in[5]; p.w_in = (const float*)d_in[6]; p.ong = (const float*)d_in[7];
    p.w_out = (const float*)d_in[8]; p.wq = (const float*)d_in[9]; p.subk = (const float*)d_in[10]; p.pu = (const float*)d_in[11];
    p.pv = (const float*)d_in[12]; p.fg = (const float*)d_in[13];
    p.out = (float*)d_out; p.ws = (unsigned char*)d_ws;
#if 0
    for (int ph = 0; ph < PH_TOTAL; ++ph) {
        p.ph_lo = ph; p.ph_hi = ph + 1;
        hipLaunchKernelGGL(mega, dim3(grid), dim3(NTHREADS), LDS_BYTES, stream, p);
    }
#else
    p.ph_lo = 0; p.ph_hi = PH_TOTAL;
    if (hipMemsetAsync((char*)d_ws + WS_CTL, 0, CTL_BYTES, stream) != hipSuccess) { fprintf(stderr, "kernel_launch: memset of control words failed\n"); return; }
    void* args[] = {&p};
    hipError_t e = hipLaunchCooperativeKernel((const void*)mega, dim3(grid), dim3(NTHREADS), args, LDS_BYTES, stream);
    if (e != hipSuccess) fprintf(stderr, "cooperative launch failed: %s (grid %d)\n", hipGetErrorString(e), grid);
#endif
}
```

```cpp
#include <hip/hip_runtime.h>
#include <hip/hip_cooperative_groups.h>
#include <cstdio>
#include <cstdint>
namespace cg = cooperative_groups;

#define LAS __attribute__((address_space(3)))
typedef _Float16 f16;
typedef _Float16 h2_t __attribute__((ext_vector_type(2)));
typedef _Float16 h4_t __attribute__((ext_vector_type(4)));
typedef _Float16 h8_t __attribute__((ext_vector_type(8)));
typedef float f32x4 __attribute__((ext_vector_type(4)));
typedef unsigned u32x4 __attribute__((ext_vector_type(4)));
typedef unsigned u32x2 __attribute__((ext_vector_type(2)));

constexpr int NB = 8, SEQ = 2048, DM = 2048, NT = NB * SEQ, DEPTH = 2;
constexpr int HD = 128, HA = 6, HB = 5, HC = 5, NHEADS = 16;
constexpr int IH = 16, IDM = 64, DSA_TOPK = 256;
constexpr int MOBA_BLK = 256, MOBA_NB = 8;
constexpr int INW = 5968, INWP = 6144;
constexpr int PH = 8, PNK = 128, PTOPK = 16, PEXP = 16384;
constexpr float EPS = 1e-6f;
constexpr int C_QA = 0, C_KA = 768, C_VA = 896, C_IQ = 1024, C_IK = 2048, C_IW = 2112, C_QB = 2176, C_KB = 2816, C_VB = 3456,
              C_QC = 4096, C_KC = 4736, C_VC = 5376, C_END = 6016;

#ifndef LAST_BITS
#define LAST_BITS 4
#endif
constexpr int NTHREADS = 512, NWAVES = 8;
constexpr int LDS_BYTES = 147456;

constexpr size_t al256(size_t x) { return (x + 255) & ~(size_t)255; }
constexpr size_t WS_WTIN = 0;
constexpr size_t WS_WTOUT = WS_WTIN + (size_t)DEPTH * INWP * DM * 2;
constexpr size_t WS_WTQ = WS_WTOUT + (size_t)DEPTH * DM * DM * 2;
constexpr size_t WS_U8 = WS_WTQ + (size_t)DEPTH * DM * DM * 2;
constexpr size_t WS_V8 = WS_U8 + (size_t)DEPTH * PEXP * DM;
constexpr size_t WS_SU = WS_V8 + (size_t)DEPTH * PEXP * DM;
constexpr size_t WS_SV = WS_SU + (size_t)DEPTH * PEXP * 4;
constexpr size_t WS_RS = WS_SV + (size_t)DEPTH * PEXP * 4;
constexpr size_t WS_H8 = WS_RS + (size_t)DEPTH * PEXP * 4;
constexpr size_t WS_SH = WS_H8 + (size_t)NT * DM;
constexpr size_t WS_HS = WS_SH + (size_t)NT * 4;
constexpr size_t WS_SUBK = WS_HS + (size_t)NT * 4;
constexpr size_t WS_MOD = WS_SUBK + (size_t)DEPTH * PH * 2 * PNK * 128 * 2;
constexpr size_t WS_ROPE128 = WS_MOD + (size_t)DEPTH * NB * 6 * DM * 4;
constexpr size_t WS_ROPE64 = WS_ROPE128 + (size_t)SEQ * 64 * 8;
constexpr size_t WS_H = WS_ROPE64 + (size_t)SEQ * 32 * 8;
constexpr size_t WS_PROJ = WS_H + (size_t)NT * DM * 2;
constexpr size_t WS_KMEAN = WS_PROJ + (size_t)NT * INWP * 2;
constexpr size_t WS_MASK = WS_KMEAN + al256((size_t)NB * HC * MOBA_NB * HD * 4);
constexpr size_t WS_Y = WS_MASK + (size_t)NB * SEQ * 64 * 4;
constexpr size_t WS_X1 = WS_Y + (size_t)NT * DM * 2;
constexpr size_t WS_X2 = WS_X1 + (size_t)NT * DM * 2;
constexpr size_t WS_PE = WS_X1 + (size_t)NT * DM * 4;
constexpr size_t WS_PG = WS_PE + (size_t)NT * 128 * 4;
constexpr size_t WS_LIST = WS_PG + (size_t)NT * 128 * 4;
constexpr size_t WS_CTL = WS_LIST + (size_t)NT * 128 * 4;
constexpr size_t CTL_BYTES = 16384;
constexpr size_t WS_END = WS_CTL + CTL_BYTES;

struct Params {
    const float *x, *c, *ada_w, *ada_b, *n1g, *n2g, *w_in, *ong, *w_out, *wq, *subk, *pu, *pv, *fg;
    float* out;
    unsigned char* ws;
    int ph_lo, ph_hi;
};

__device__ __forceinline__ int otid() { int t = threadIdx.x; asm volatile("" : "+v"(t)); return t; }
__device__ __forceinline__ int obid() { int t = blockIdx.x; asm volatile("" : "+s"(t)); return t; }
__device__ __forceinline__ float wave_sum(float v) {
#pragma unroll
    for (int o = 32; o >= 1; o >>= 1) v += __shfl_xor(v, o);
    return v;
}
__device__ __forceinline__ float wave_max(float v) {
#pragma unroll
    for (int o = 32; o >= 1; o >>= 1) v = fmaxf(v, __shfl_xor(v, o));
    return v;
}
__device__ __forceinline__ unsigned pack_h2(float a, float b) { h2_t r; r.x = (f16)a; r.y = (f16)b; return __builtin_bit_cast(unsigned, r); }
__device__ __forceinline__ float h_lo(unsigned u) { h2_t r = __builtin_bit_cast(h2_t, u); return (float)r.x; }
__device__ __forceinline__ float h_hi(unsigned u) { h2_t r = __builtin_bit_cast(h2_t, u); return (float)r.y; }
__device__ __forceinline__ float dot2(unsigned a, unsigned b, float c) {
    return __builtin_amdgcn_fdot2(__builtin_bit_cast(h2_t, a), __builtin_bit_cast(h2_t, b), c, false);
}

namespace pg8 {
constexpr int BM = 256, BK = 64, HALF = 128, HTB = HALF * BK * 2, STAGE_BYTES = 8 * HTB, NXCD = 8, WGM = 8;
__host__ __device__ __forceinline__ int lds_byte(int r, int c) { const int st = (r >> 4) * 2 + (c >> 5), rr = r & 15, cc = c & 31, ob = rr * 64 + cc * 2; return st * 1024 + (ob ^ (((ob >> 9) & 1) << 5)); }
__host__ __device__ __forceinline__ void stage_rc(int b, int& R, int& C) { const int st = b / 1024, sb = b % 1024, swz = sb ^ (((sb >> 9) & 1) << 5); R = (st >> 1) * 16 + swz / 64; C = (st & 1) * 32 + (swz % 64) / 2; }
__host__ __device__ __forceinline__ int perm32(int rho) { const int n = rho >> 4, i = rho & 15; return 8 * (i >> 2) + 4 * n + (i & 3); }
struct Unit { int pm, pn; };
struct Gemm { const unsigned short* A; const unsigned short* Bt; int M, N, K; };
struct StaticOrder {
    int nM, nN, nwg, G, c, fuse;
    __host__ __device__ void init(int M, int N, int G_, int c_) { nM = M / BM; nN = N / BM; nwg = nM * nN; G = G_; c = c_; fuse = 0; }
    __host__ __device__ bool next(int i, Unit& u) const {
        if (fuse) { if (i >= 2) return false; u.pm = 2 * ((c & 7) + 8 * (c >> 6)) + i; u.pn = (c >> 3) & 7; return true; }
        const long L = (long)i * G + c; if (L >= nwg) return false;
        int wgid = (int)L; { const int q = nwg / NXCD, r = nwg % NXCD, xcd = wgid % NXCD, off = wgid / NXCD; wgid = (xcd < r ? xcd * (q + 1) : r * (q + 1) + (xcd - r) * q) + off; }
        const int nig = WGM * nN, gid = wgid / nig, fm = gid * WGM, gsz = (nM - fm) < WGM ? (nM - fm) : WGM;
        u.pm = fm + ((wgid % nig) % gsz); u.pn = (wgid % nig) / gsz; return true;
    }
};

template <class Epi>
__device__ __forceinline__ void gemm_phase(LAS unsigned char* lds, const Gemm g, const StaticOrder& S, const Epi& E) {
    const int tid = otid(), wid = __builtin_amdgcn_readfirstlane(tid >> 6), lane = tid & 63, wr = wid >> 2, wc = wid & 3, fr = lane & 15, fq = lane >> 4;
    const int K = g.K, nt = K / BK;
    unsigned voffA[2], voffB[2];
#pragma unroll
    for (int i = 0; i < 2; ++i) { int R, C; stage_rc(tid * 16 + i * 8192, R, C); const int Rb = E.perm() ? ((R & ~31) + perm32(R & 31)) : R;
        voffA[i] = (unsigned)(R * K + C) * 2u; voffB[i] = (unsigned)(Rb * K + C) * 2u; }
    const size_t kstep = (size_t)(BK * 2);
    const size_t hstep = (size_t)HALF * K * 2;
    const size_t tstep = 2 * hstep;
    const unsigned ldsw = (unsigned)wid * 1024u;
    const int aoff = lds_byte(wr * 64 + fr, fq * 8), boff = lds_byte(wc * 32 + fr, fq * 8);
#define PG8_SA(b, h) (((b) * 2 + (h)) * HTB)
#define PG8_SB(b, h) ((4 + (b) * 2 + (h)) * HTB)
#define PG8_STAGE(bufoff, gbase, voff) do { _Pragma("unroll") for (int _i = 0; _i < 2; ++_i) \
        __builtin_amdgcn_global_load_lds((const unsigned*)((const char*)(gbase) + (voff)[_i]), (LAS unsigned*)(lds + (bufoff) + ldsw + _i * 8192), 16, 0, 0); } while (0)
#define PG8_LDA(dst, b, h) do { _Pragma("unroll") for (int m = 0; m < 4; ++m) _Pragma("unroll") for (int k = 0; k < 2; ++k) dst[m][k] = *(const LAS h8_t*)(lds + PG8_SA(b, h) + aoff + m * 2048 + k * 1024); } while (0)
#define PG8_LDB(dst, b, h) do { _Pragma("unroll") for (int n = 0; n < 2; ++n) _Pragma("unroll") for (int k = 0; k < 2; ++k) dst[n][k] = *(const LAS h8_t*)(lds + PG8_SB(b, h) + boff + n * 2048 + k * 1024); } while (0)
#define PG8_MMA(ai, bj, At, Bt) do { __builtin_amdgcn_s_setprio(1); _Pragma("unroll") for (int m = 0; m < 4; ++m) _Pragma("unroll") for (int n = 0; n < 2; ++n) _Pragma("unroll") for (int k = 0; k < 2; ++k) \
        acc[ai][bj][m][n] = __builtin_amdgcn_mfma_f32_16x16x32_f16(Bt[n][k], At[m][k], acc[ai][bj][m][n], 0, 0, 0); __builtin_amdgcn_s_setprio(0); } while (0)
#define PG8_WAIT_V(n) asm volatile("s_waitcnt vmcnt(" #n ")" ::: "memory")
#define PG8_WAIT_L(n) asm volatile("s_waitcnt lgkmcnt(" #n ")" ::: "memory")
#define PG8_BAR __builtin_amdgcn_s_barrier()
#define PG8_SCHED __builtin_amdgcn_sched_barrier(0)
    Unit cur, nxt; int ui = 0;
    if (!S.next(0, cur)) return;
    f32x4 acc[2][2][4][2];
#pragma unroll
    for (int a = 0; a < 2; ++a)
#pragma unroll
        for (int b = 0; b < 2; ++b)
#pragma unroll
            for (int m = 0; m < 4; ++m)
#pragma unroll
                for (int n = 0; n < 2; ++n) acc[a][b][m][n] = (f32x4){0.f, 0.f, 0.f, 0.f};
    h8_t At[4][2], B0[2][2], B1[2][2];
    const char* cA = (const char*)g.A + (size_t)cur.pm * tstep; const char* cB = (const char*)g.Bt + (size_t)cur.pn * tstep;
    PG8_STAGE(PG8_SB(0, 0), cB, voffB); PG8_STAGE(PG8_SA(0, 0), cA, voffA); PG8_STAGE(PG8_SB(0, 1), cB + hstep, voffB); PG8_STAGE(PG8_SA(0, 1), cA + hstep, voffA);
    if (wr == 1) PG8_BAR;
    PG8_WAIT_V(4); PG8_BAR;
    PG8_STAGE(PG8_SB(1, 0), cB + kstep, voffB); PG8_STAGE(PG8_SA(1, 0), cA + kstep, voffA); PG8_STAGE(PG8_SB(1, 1), cB + hstep + kstep, voffB);
    PG8_WAIT_V(6); PG8_BAR;
    for (;;) {
        const bool has_next = S.next(ui + 1, nxt);
        const char* nA = has_next ? (const char*)g.A + (size_t)nxt.pm * tstep : cA; const char* nB = has_next ? (const char*)g.Bt + (size_t)nxt.pn * tstep : cB;
        for (int t = 0; t < nt; t += 2) {
            const bool last = (t == nt - 2);
            const char* a1 = cA + (size_t)(t + 1) * kstep;
            const char* a2 = last ? nA : cA + (size_t)(t + 2) * kstep; const char* b2 = last ? nB : cB + (size_t)(t + 2) * kstep;
            const char* a3 = a2 + kstep; const char* b3 = b2 + kstep;
            PG8_LDB(B0, 0, 0); PG8_SCHED; PG8_LDA(At, 0, 0); PG8_STAGE(PG8_SA(1, 1), a1 + hstep, voffA);
            PG8_WAIT_L(8); PG8_BAR; PG8_WAIT_L(0); PG8_MMA(0, 0, At, B0); PG8_BAR; PG8_SCHED;
            PG8_LDB(B1, 0, 1); PG8_STAGE(PG8_SB(0, 0), b2, voffB);
            PG8_BAR; PG8_WAIT_L(0); PG8_MMA(0, 1, At, B1); PG8_BAR;
            PG8_LDA(At, 0, 1); PG8_STAGE(PG8_SA(0, 0), a2, voffA);
            PG8_BAR; PG8_WAIT_L(0); PG8_MMA(1, 0, At, B0); PG8_BAR; PG8_SCHED;
            PG8_STAGE(PG8_SB(0, 1), b2 + hstep, voffB);
            PG8_WAIT_V(6); PG8_BAR; PG8_MMA(1, 1, At, B1); PG8_BAR;
            PG8_LDB(B0, 1, 0); PG8_SCHED; PG8_LDA(At, 1, 0); PG8_STAGE(PG8_SA(0, 1), a2 + hstep, voffA);
            PG8_WAIT_L(8); PG8_BAR; PG8_WAIT_L(0); PG8_MMA(0, 0, At, B0); PG8_BAR; PG8_SCHED;
            PG8_LDB(B1, 1, 1); PG8_STAGE(PG8_SB(1, 0), b3, voffB);
            PG8_BAR; PG8_WAIT_L(0); PG8_MMA(0, 1, At, B1); PG8_BAR;
            PG8_LDA(At, 1, 1); PG8_STAGE(PG8_SA(1, 0), a3, voffA);
            PG8_BAR; PG8_WAIT_L(0); PG8_MMA(1, 0, At, B0); PG8_BAR; PG8_SCHED;
            PG8_STAGE(PG8_SB(1, 1), b3 + hstep, voffB);
            PG8_WAIT_V(6); PG8_BAR; PG8_MMA(1, 1, At, B1); PG8_BAR;
        }
        E(acc, cur, wr, wc, fr, fq);
        if (!has_next) break;
#pragma unroll
        for (int a = 0; a < 2; ++a)
#pragma unroll
            for (int b = 0; b < 2; ++b)
#pragma unroll
                for (int m = 0; m < 4; ++m)
#pragma unroll
                    for (int n = 0; n < 2; ++n) acc[a][b][m][n] = (f32x4){0.f, 0.f, 0.f, 0.f};
        cur = nxt; cA = nA; cB = nB; ++ui;
    }
    PG8_WAIT_V(0);
    if (wr == 0) PG8_BAR;
    PG8_BAR;
#undef PG8_SA
#undef PG8_SB
#undef PG8_STAGE
#undef PG8_LDA
#undef PG8_LDB
#undef PG8_MMA
#undef PG8_WAIT_V
#undef PG8_WAIT_L
#undef PG8_BAR
#undef PG8_SCHED
}
}

__device__ __forceinline__ int win_src_col_l(int pc) { return pc < 2128 ? pc : (pc < C_QB ? -1 : (pc < C_END ? pc - 48 : -1)); }
__device__ __forceinline__ int rope_type(int g) { return (g <= 6 || (g >= 32 && g <= 41)) ? 1 : ((g >= 8 && g <= 15) ? 2 : (g == 16 ? 3 : 0)); }
__device__ __forceinline__ int win_src_col(int pc) {
    const int g = pc >> 7, p = pc & 127, ty = rope_type(g);
    int l = p;
    if (ty == 1) { const int q4 = p >> 2, e = p & 3; l = 2 * q4 + (e >> 1) + 64 * (e & 1); }
    else if (ty == 2 || (ty == 3 && p < 64)) { const int hb = p >> 6, pp = p & 63, q4 = pp >> 2, e = pp & 3; l = hb * 64 + 2 * q4 + (e >> 1) + 32 * (e & 1); }
    return win_src_col_l(g * 128 + l);
}


struct Epi {
    int mode; f16* o16; int ldc; float* o32; const float* xin; const f16* xinh; const float* gate; const float* rope128; const float* rope64;
    __device__ __forceinline__ bool perm() const { return true; }
    __device__ __forceinline__ void operator()(const f32x4 (&acc)[2][2][4][2], const pg8::Unit& u, int wr, int wc, int fr, int fq) const {
        const int row0 = u.pm * 256 + wr * 64 + fr, col0 = u.pn * 256 + wc * 32 + 4 * fq;
        if (mode == 2) {
            {
                const int g0 = __builtin_amdgcn_readfirstlane(u.pn * 2);
                int ty0 = rope_type(g0), ty1 = rope_type(g0 + 1);
                if (ty0 == 3) ty0 = (wc < 2) ? 2 : 0;
                if (ty1 == 3) ty1 = (wc < 2) ? 2 : 0;
                if (ty0 != 0 && ty0 == ty1) {
                    const float* tab = ty0 == 1 ? rope128 : rope64;
                    const int half = ty0 == 1 ? 64 : 32, tw = ty0 == 1 ? 128 : 64;
                    const int p0 = wc * 32 + 8 * fq;
                    const int j0 = ty0 == 1 ? (p0 >> 1) : ((p0 & 63) >> 1), base = ty0 == 1 ? 0 : (p0 & 64);
#pragma unroll
                    for (int ai = 0; ai < 2; ++ai) {
                        f32x4 cs[4][2];
#pragma unroll
                        for (int m = 0; m < 4; ++m) {
                            const int pos = (row0 + ai * 128 + m * 16) & (SEQ - 1);
                            cs[m][0] = *(const f32x4*)(tab + (size_t)pos * tw + 2 * j0); cs[m][1] = *(const f32x4*)(tab + (size_t)pos * tw + 2 * j0 + 4);
                        }
#pragma unroll
                        for (int m = 0; m < 4; ++m)
#pragma unroll
                            for (int bj = 0; bj < 2; ++bj) {
                                const int row = row0 + ai * 128 + m * 16;
                                const f32x4 v0 = acc[ai][bj][m][0], v1 = acc[ai][bj][m][1], c0 = cs[m][0], c1 = cs[m][1];
                                u32x2 lo, hi;
                                lo.x = pack_h2(v0[0] * c0[0] - v0[1] * c0[1], v0[2] * c0[2] - v0[3] * c0[3]); hi.x = pack_h2(v0[1] * c0[0] + v0[0] * c0[1], v0[3] * c0[2] + v0[2] * c0[3]);
                                lo.y = pack_h2(v1[0] * c1[0] - v1[1] * c1[1], v1[2] * c1[2] - v1[3] * c1[3]); hi.y = pack_h2(v1[1] * c1[0] + v1[0] * c1[1], v1[3] * c1[2] + v1[2] * c1[3]);
                                { const auto r = __builtin_amdgcn_permlane16_swap(lo.x, hi.x, false, false); lo.x = r[0]; hi.x = r[1]; }
                                { const auto r = __builtin_amdgcn_permlane16_swap(lo.y, hi.y, false, false); lo.y = r[0]; hi.y = r[1]; }
                                u32x4 w; w.x = lo.x; w.y = lo.y; w.z = hi.x; w.w = hi.y;
                                f16* op = o16 + (size_t)(g0 + bj) * 128 + (size_t)row * ldc + base + (j0 - 4 * (fq & 1)) + ((fq & 1) ? half : 0);
                                *(u32x4*)op = w;
                            }
                    }
                    return;
                }
            }
#pragma unroll
            for (int bj = 0; bj < 2; ++bj) {
                const int g = __builtin_amdgcn_readfirstlane(u.pn * 2 + bj);
                int ty = rope_type(g); if (ty == 3) ty = (wc < 2) ? 2 : 0;
                f16* ob = o16 + (size_t)g * 128;
                if (ty == 0) {
#pragma unroll
                    for (int ai = 0; ai < 2; ++ai)
#pragma unroll
                        for (int m = 0; m < 4; ++m) {
                            const f32x4 v0 = acc[ai][bj][m][0], v1 = acc[ai][bj][m][1];
                            u32x4 w; w.x = pack_h2(v0[0], v0[1]); w.y = pack_h2(v0[2], v0[3]); w.z = pack_h2(v1[0], v1[1]); w.w = pack_h2(v1[2], v1[3]);
                            *(u32x4*)(ob + (size_t)(row0 + ai * 128 + m * 16) * ldc + wc * 32 + 8 * fq) = w;
                        }
                } else {
                    const float* tab = ty == 1 ? rope128 : rope64;
                    const int half = ty == 1 ? 64 : 32, tw = ty == 1 ? 128 : 64;
                    const int p0 = wc * 32 + 8 * fq;
                    const int j0 = ty == 1 ? (p0 >> 1) : ((p0 & 63) >> 1), base = ty == 1 ? 0 : (p0 & 64);
#pragma unroll
                    for (int ai = 0; ai < 2; ++ai) {
                        f32x4 cs[4][2];
#pragma unroll
                        for (int m = 0; m < 4; ++m) {
                            const int pos = (row0 + ai * 128 + m * 16) & (SEQ - 1);
                            cs[m][0] = *(const f32x4*)(tab + (size_t)pos * tw + 2 * j0); cs[m][1] = *(const f32x4*)(tab + (size_t)pos * tw + 2 * j0 + 4);
                        }
#pragma unroll
                        for (int m = 0; m < 4; ++m) {
                            const int row = row0 + ai * 128 + m * 16;
                            const f32x4 v0 = acc[ai][bj][m][0], v1 = acc[ai][bj][m][1], c0 = cs[m][0], c1 = cs[m][1];
                            u32x2 lo, hi;
                            lo.x = pack_h2(v0[0] * c0[0] - v0[1] * c0[1], v0[2] * c0[2] - v0[3] * c0[3]); hi.x = pack_h2(v0[1] * c0[0] + v0[0] * c0[1], v0[3] * c0[2] + v0[2] * c0[3]);
                            lo.y = pack_h2(v1[0] * c1[0] - v1[1] * c1[1], v1[2] * c1[2] - v1[3] * c1[3]); hi.y = pack_h2(v1[1] * c1[0] + v1[0] * c1[1], v1[3] * c1[2] + v1[2] * c1[3]);
                            { const auto r = __builtin_amdgcn_permlane16_swap(lo.x, hi.x, false, false); lo.x = r[0]; hi.x = r[1]; }
                            { const auto r = __builtin_amdgcn_permlane16_swap(lo.y, hi.y, false, false); lo.y = r[0]; hi.y = r[1]; }
                            u32x4 w; w.x = lo.x; w.y = lo.y; w.z = hi.x; w.w = hi.y;
                            f16* op = ob + (size_t)row * ldc + base + (j0 - 4 * (fq & 1)) + ((fq & 1) ? half : 0);
                            *(u32x4*)op = w;
                        }
                    }
                }
            }
            return;
        }
        if (mode == 0) {
#pragma unroll
            for (int ai = 0; ai < 2; ++ai)
#pragma unroll
                for (int m = 0; m < 4; ++m)
#pragma unroll
                    for (int bj = 0; bj < 2; ++bj) {
                        const f32x4 v0 = acc[ai][bj][m][0], v1 = acc[ai][bj][m][1];
                        u32x4 w; w.x = pack_h2(v0[0], v0[1]); w.y = pack_h2(v0[2], v0[3]); w.z = pack_h2(v1[0], v1[1]); w.w = pack_h2(v1[2], v1[3]);
                        *(u32x4*)(o16 + (size_t)(row0 + ai * 128 + m * 16) * ldc + u.pn * 256 + bj * 128 + wc * 32 + 8 * fq) = w;
                    }
            return;
        }
        if (mode == 1) {
            const int b = row0 / SEQ, colp = u.pn * 256 + wc * 32 + 8 * fq;
            f32x4 gt[2][2];
#pragma unroll
            for (int bj = 0; bj < 2; ++bj)
#pragma unroll
                for (int n = 0; n < 2; ++n) gt[bj][n] = *(const f32x4*)(gate + (size_t)b * 6 * DM + colp + bj * 128 + 4 * n);
            if (xinh) {
#pragma unroll
                for (int ai = 0; ai < 2; ++ai) {
                    u32x4 xr[4][2];
#pragma unroll
                    for (int m = 0; m < 4; ++m)
#pragma unroll
                        for (int bj = 0; bj < 2; ++bj) xr[m][bj] = *(const u32x4*)(xinh + (size_t)(row0 + ai * 128 + m * 16) * DM + colp + bj * 128);
#pragma unroll
                    for (int m = 0; m < 4; ++m)
#pragma unroll
                        for (int bj = 0; bj < 2; ++bj) {
                            const u32x4 xw = xr[m][bj];
                            const f32x4 x0 = {h_lo(xw.x), h_hi(xw.x), h_lo(xw.y), h_hi(xw.y)}, x1v = {h_lo(xw.z), h_hi(xw.z), h_lo(xw.w), h_hi(xw.w)};
                            const f32x4 r0 = x0 + gt[bj][0] * acc[ai][bj][m][0], r1 = x1v + gt[bj][1] * acc[ai][bj][m][1];
                            u32x4 w; w.x = pack_h2(r0[0], r0[1]); w.y = pack_h2(r0[2], r0[3]); w.z = pack_h2(r1[0], r1[1]); w.w = pack_h2(r1[2], r1[3]);
                            *(u32x4*)(o16 + (size_t)(row0 + ai * 128 + m * 16) * DM + colp + bj * 128) = w;
                        }
                }
                return;
            }
#pragma unroll
            for (int ai = 0; ai < 2; ++ai)
#pragma unroll
                for (int mh = 0; mh < 2; ++mh) {
                    f32x4 xi[2][2][2];
#pragma unroll
                    for (int m2 = 0; m2 < 2; ++m2)
#pragma unroll
                        for (int bj = 0; bj < 2; ++bj) {
                            const size_t o = (size_t)(row0 + ai * 128 + (2 * mh + m2) * 16) * DM + colp + bj * 128;
                            if (xinh) { const u32x4 w = *(const u32x4*)(xinh + o); xi[m2][bj][0] = (f32x4){h_lo(w.x), h_hi(w.x), h_lo(w.y), h_hi(w.y)}; xi[m2][bj][1] = (f32x4){h_lo(w.z), h_hi(w.z), h_lo(w.w), h_hi(w.w)}; }
                            else { xi[m2][bj][0] = *(const f32x4*)(xin + o); xi[m2][bj][1] = *(const f32x4*)(xin + o + 4); }
                        }
#pragma unroll
                    for (int m2 = 0; m2 < 2; ++m2)
#pragma unroll
                        for (int bj = 0; bj < 2; ++bj) {
                            const f32x4 r0 = xi[m2][bj][0] + gt[bj][0] * acc[ai][bj][2 * mh + m2][0], r1 = xi[m2][bj][1] + gt[bj][1] * acc[ai][bj][2 * mh + m2][1];
                            u32x4 w; w.x = pack_h2(r0[0], r0[1]); w.y = pack_h2(r0[2], r0[3]); w.z = pack_h2(r1[0], r1[1]); w.w = pack_h2(r1[2], r1[3]);
                            *(u32x4*)(o16 + (size_t)(row0 + ai * 128 + (2 * mh + m2) * 16) * DM + colp + bj * 128) = w;
                        }
                }
            return;
        }
#pragma unroll
        for (int ai = 0; ai < 2; ++ai)
#pragma unroll
            for (int m = 0; m < 4; ++m) {
                const int row = row0 + ai * 128 + m * 16;
#pragma unroll
                for (int bj = 0; bj < 2; ++bj)
#pragma unroll
                    for (int n = 0; n < 2; ++n) {
                        const int col = col0 + bj * 128 + n * 16;
                        const f32x4 v = acc[ai][bj][m][n];
                        if (mode == 0) {
                            u32x2 w; w.x = pack_h2(v[0], v[1]); w.y = pack_h2(v[2], v[3]);
                            *(u32x2*)(o16 + (size_t)row * ldc + col) = w;
                        } else {
                            const int b = row / SEQ;
                            const f32x4 xi = *(const f32x4*)(xin + (size_t)row * DM + col);
                            const f32x4 gt = *(const f32x4*)(gate + (size_t)b * 6 * DM + col);
                            *(f32x4*)(o32 + (size_t)row * DM + col) = xi + gt * v;
                        }
                    }
            }
    }
};

__device__ __forceinline__ void gemm_run(const Params& p, LAS unsigned char* lds, const f16* A, const f16* Bt, int N, const Epi& E, const bool fuse_route) {
    pg8::Gemm g; g.A = (const unsigned short*)A; g.Bt = (const unsigned short*)Bt; g.M = NT; g.N = N; g.K = DM;
    pg8::StaticOrder S; S.init(NT, N, (int)gridDim.x, (int)blockIdx.x); S.fuse = fuse_route ? 1 : 0;
    pg8::gemm_phase<Epi>(lds, g, S, E);
}

__device__ __forceinline__ void transpose_tiles(const float* src, int ldsrc, int ncols_phys, bool is_win, f16* dst, float* tile  , int& unit_base, int unit_lo) {
    const int tn = ncols_phys / 64, tk = DM / 64, ntile = tn * tk;
    const int tid = otid();
    float cur[8], nxt[8];
#define TT_LOAD(R_, u_) do { const int n0_ = ((u_) % tn) * 64, k0_ = ((u_) / tn) * 64; \
        _Pragma("unroll") for (int i = 0; i < 8; ++i) { const int e = tid + i * 512, r = e >> 6, c = e & 63; const int pc = n0_ + c; const int sc = is_win ? win_src_col(pc) : pc; \
            R_[i] = sc >= 0 ? src[(size_t)(k0_ + r) * ldsrc + sc] : 0.f; } } while (0)
    int u = blockIdx.x;
    if (u < ntile) TT_LOAD(nxt, u);
    for (; u < ntile; u += gridDim.x) {
        const int n0 = (u % tn) * 64, k0 = (u / tn) * 64;
#pragma unroll
        for (int i = 0; i < 8; ++i) cur[i] = nxt[i];
        if (u + (int)gridDim.x < ntile) TT_LOAD(nxt, u + gridDim.x);
        __syncthreads();
#pragma unroll
        for (int i = 0; i < 8; ++i) { const int e = tid + i * 512, r = e >> 6, c = e & 63; tile[r * 65 + c] = cur[i]; }
        __syncthreads();
        {
            const int n = tid >> 3, kq = (tid & 7) * 8;
            u32x4 w;
            w.x = pack_h2(tile[(kq + 0) * 65 + n], tile[(kq + 1) * 65 + n]); w.y = pack_h2(tile[(kq + 2) * 65 + n], tile[(kq + 3) * 65 + n]);
            w.z = pack_h2(tile[(kq + 4) * 65 + n], tile[(kq + 5) * 65 + n]); w.w = pack_h2(tile[(kq + 6) * 65 + n], tile[(kq + 7) * 65 + n]);
            *(u32x4*)(dst + (size_t)(n0 + n) * DM + k0 + kq) = w;
        }
    }
#undef TT_LOAD
    (void)unit_base; (void)unit_lo;
}

__device__ __forceinline__ void cvt_f16_stream(const float* src, f16* dst, size_t n) {
    const size_t stride = (size_t)gridDim.x * NTHREADS;
    for (size_t i = (size_t)blockIdx.x * NTHREADS + otid(); i < n / 8; i += stride) {
        const f32x4 a = *(const f32x4*)(src + i * 8), b = *(const f32x4*)(src + i * 8 + 4);
        u32x4 w; w.x = pack_h2(a[0], a[1]); w.y = pack_h2(a[2], a[3]); w.z = pack_h2(b[0], b[1]); w.w = pack_h2(b[2], b[3]);
        *(u32x4*)(dst + i * 8) = w;
    }
}

__device__ __forceinline__ void quant_rows(const float* src, int nrows, unsigned* dst, float* scale, int bias) {
    const int tid_ = otid(); const int wid = tid_ >> 6, lane = tid_ & 63;
    const int rstep = gridDim.x * NWAVES;
    int row = blockIdx.x * NWAVES + wid;
    f32x4 v[8], nv[8];
    if (row < nrows) {
#pragma unroll
        for (int i = 0; i < 8; ++i) nv[i] = *(const f32x4*)(src + (size_t)row * DM + i * 256 + lane * 4);
    }
    for (; row < nrows; row += rstep) {
#pragma unroll
        for (int i = 0; i < 8; ++i) v[i] = nv[i];
        if (row + rstep < nrows) {
#pragma unroll
            for (int i = 0; i < 8; ++i) nv[i] = *(const f32x4*)(src + (size_t)(row + rstep) * DM + i * 256 + lane * 4);
        }
        float am = 0.f;
#pragma unroll
        for (int i = 0; i < 8; ++i) am = fmaxf(am, fmaxf(fmaxf(fabsf(v[i][0]), fabsf(v[i][1])), fmaxf(fabsf(v[i][2]), fabsf(v[i][3]))));
        am = wave_max(am);
        const float sc = am > 0.f ? am * (1.f / 127.f) : 1.f, inv = 1.f / sc;
        if (lane == 0) scale[row] = sc;
#pragma unroll
        for (int i = 0; i < 8; ++i) {
            unsigned w = 0u;
#pragma unroll
            for (int j = 0; j < 4; ++j) { const int q = (int)rintf(v[i][j] * inv) + bias; w |= ((unsigned)q & 255u) << (8 * j); }
            dst[(size_t)row * (DM / 4) + i * 64 + lane] = w;
        }
    }
}

__device__ __forceinline__ void quant_rows4(const float* src, int nrows, unsigned* dst, float* scale, int* rowsum) {
    const int tid_ = otid(); const int wid = tid_ >> 6, lane = tid_ & 63;
    const int rstep = gridDim.x * NWAVES;
    int row = blockIdx.x * NWAVES + wid;
    f32x4 v[8], nv[8];
    if (row < nrows) {
#pragma unroll
        for (int i = 0; i < 8; ++i) nv[i] = *(const f32x4*)(src + (size_t)row * DM + i * 256 + lane * 4);
    }
    for (; row < nrows; row += rstep) {
#pragma unroll
        for (int i = 0; i < 8; ++i) v[i] = nv[i];
        if (row + rstep < nrows) {
#pragma unroll
            for (int i = 0; i < 8; ++i) nv[i] = *(const f32x4*)(src + (size_t)(row + rstep) * DM + i * 256 + lane * 4);
        }
        float ss = 0.f;
#pragma unroll
        for (int i = 0; i < 8; ++i) ss += v[i][0] * v[i][0] + v[i][1] * v[i][1] + v[i][2] * v[i][2] + v[i][3] * v[i][3];
        ss = wave_sum(ss);
        const float sc = ss > 0.f ? 0.35f * sqrtf(ss * (1.f / DM)) : 1.f, inv = 1.f / sc;
        if (lane == 0) scale[row] = sc;
        int qs = 0;
#pragma unroll
        for (int i = 0; i < 8; ++i) {
            unsigned w = 0u;
#pragma unroll
            for (int j = 0; j < 4; ++j) { const int q = (int)fminf(fmaxf(rintf(v[i][j] * inv), -7.f), 7.f) + 8; qs += q; w |= ((unsigned)q & 15u) << (8 * j); }
            if (lane & 1) w <<= 4;
            const unsigned o = __shfl_down(w, 1);
            if (!(lane & 1)) dst[(size_t)row * (DM / 8) + i * 32 + (lane >> 1)] = w | o;
        }
#pragma unroll
        for (int o = 32; o >= 1; o >>= 1) qs += __shfl_xor(qs, o);
        if (lane == 0) rowsum[row] = qs;
    }
}

constexpr int QV_STR = DM / 2 + 8;
__device__ __forceinline__ void quant_v_sliced(const float* src, unsigned char* dst, float* scale, LAS unsigned char* lds) {
    const int tid = otid(), wid = tid >> 6, lane = tid & 63;
    for (int blk = obid(); blk < DEPTH * PEXP / 64; blk += gridDim.x) {
        const int row0 = blk * 64, layer = row0 / PEXP, e0 = row0 % PEXP;
        __syncthreads();
        f32x4 nv[8];
#pragma unroll
        for (int i = 0; i < 8; ++i) nv[i] = *(const f32x4*)(src + (size_t)(row0 + wid) * DM + i * 256 + lane * 4);
        for (int rr = wid; rr < 64; rr += NWAVES) {
            f32x4 v[8]; float ss = 0.f;
#pragma unroll
            for (int i = 0; i < 8; ++i) v[i] = nv[i];
            if (rr + NWAVES < 64) {
#pragma unroll
                for (int i = 0; i < 8; ++i) nv[i] = *(const f32x4*)(src + (size_t)(row0 + rr + NWAVES) * DM + i * 256 + lane * 4);
            }
#pragma unroll
            for (int i = 0; i < 8; ++i) ss += v[i][0] * v[i][0] + v[i][1] * v[i][1] + v[i][2] * v[i][2] + v[i][3] * v[i][3];
            ss = wave_sum(ss);
            const float sc = ss > 0.f ? 0.35f * sqrtf(ss * (1.f / DM)) : 1.f, inv = 1.f / sc;
            if (lane == 0) scale[row0 + rr] = sc;
#pragma unroll
            for (int i = 0; i < 8; ++i) {
                unsigned w = 0u;
#pragma unroll
                for (int j = 0; j < 4; ++j) { const int q = (int)fminf(fmaxf(rintf(v[i][j] * inv), -7.f), 7.f) + 8; w |= ((unsigned)q & 15u) << (4 * j); }
                *(LAS unsigned short*)(lds + rr * QV_STR + i * 128 + lane * 2) = (unsigned short)w;
            }
        }
        __syncthreads();
        for (int c = wid; c < 128; c += NWAVES) {
            const u32x2 w = *(const LAS u32x2*)(lds + lane * QV_STR + c * 8);
            *(u32x2*)(dst + (((size_t)layer * 128 + c) * PEXP + e0 + lane) * 8) = w;
        }
    }
}

__device__ __forceinline__ void phase_conv(const Params& p, LAS unsigned char* lds_) {
    float* smem = (float*)(unsigned char*)lds_;
    unsigned char* ws = p.ws;
    const int tid = otid();
    int dummy = 0;
    {
        float* cond = smem;
        float* red = smem + NB * DM;
        for (int i = tid; i < NB * DM; i += NTHREADS) { const float v = p.c[i]; cond[i] = v / (1.f + __expf(-v)); }
        __syncthreads();
        for (int u = blockIdx.x; u < DEPTH * 128; u += gridDim.x) {
            const int l = u >> 7, j0 = (u & 127) * 96;
            const int c4 = tid % 24, kg = tid / 24;
            if (kg < 21) {
                f32x4 acc[NB];
#pragma unroll
                for (int b = 0; b < NB; ++b) acc[b] = (f32x4){0.f, 0.f, 0.f, 0.f};
                const float* wp = p.ada_w + (size_t)l * DM * 6 * DM + j0 + 4 * c4;
#pragma unroll 1
                for (int i0 = 0; i0 < 98; i0 += 7) {
                    f32x4 w[7];
#pragma unroll
                    for (int i = 0; i < 7; ++i) { const int k = kg + 21 * (i0 + i); w[i] = k < DM ? *(const f32x4*)(wp + (size_t)k * 6 * DM) : (f32x4){0.f, 0.f, 0.f, 0.f}; }
#pragma unroll
                    for (int i = 0; i < 7; ++i) { const int k = kg + 21 * (i0 + i); const int kk = k < DM ? k : 0;
#pragma unroll
                        for (int b = 0; b < NB; ++b) acc[b] += w[i] * cond[b * DM + kk]; }
                }
#pragma unroll
                for (int b = 0; b < NB; ++b) *(f32x4*)(red + (kg * NB + b) * 96 + 4 * c4) = acc[b];
            }
            __syncthreads();
            for (int i = tid; i < NB * 96; i += NTHREADS) {
                const int b = i / 96, cc = i % 96;
                float sacc = p.ada_b[(size_t)l * 6 * DM + j0 + cc];
#pragma unroll
                for (int g = 0; g < 21; ++g) sacc += red[(g * NB + b) * 96 + cc];
                ((float*)(ws + WS_MOD))[((size_t)l * NB + b) * 6 * DM + j0 + cc] = sacc;
            }
            __syncthreads();
        }
    }
    {
        float2* r128 = (float2*)(ws + WS_ROPE128); float2* r64 = (float2*)(ws + WS_ROPE64);
        for (int i = blockIdx.x * NTHREADS + tid; i < SEQ * 64; i += gridDim.x * NTHREADS) {
            const int pos = i >> 6, j = i & 63;
            const float inv = powf(10000.f, -(float)j / 64.f); const float ang = (float)pos * inv;
            r128[i] = make_float2((float)cos((double)ang), (float)sin((double)ang));
        }
        for (int i = blockIdx.x * NTHREADS + tid; i < SEQ * 32; i += gridDim.x * NTHREADS) {
            const int pos = i >> 5, j = i & 31;
            const float inv = powf(10000.f, -(float)j / 32.f); const float ang = (float)pos * inv;
            r64[i] = make_float2((float)cos((double)ang), (float)sin((double)ang));
        }
    }
    __syncthreads();
    for (int l = 0; l < DEPTH; ++l) {
        transpose_tiles(p.w_in + (size_t)l * DM * INW, INW, INWP, true, (f16*)(ws + WS_WTIN) + (size_t)l * INWP * DM, smem, dummy, 0);
        transpose_tiles(p.w_out + (size_t)l * DM * DM, DM, DM, false, (f16*)(ws + WS_WTOUT) + (size_t)l * DM * DM, smem, dummy, 0);
        transpose_tiles(p.wq + (size_t)l * DM * DM, DM, DM, false, (f16*)(ws + WS_WTQ) + (size_t)l * DM * DM, smem, dummy, 0);
    }
    if (LAST_BITS == 4) quant_rows4(p.pu, PEXP, (unsigned*)(ws + WS_U8), (float*)(ws + WS_SU), (int*)(ws + WS_RS)); else quant_rows(p.pu, PEXP, (unsigned*)(ws + WS_U8), (float*)(ws + WS_SU), 0);
    if (LAST_BITS == 4) quant_rows4(p.pu + (size_t)PEXP * DM, PEXP, (unsigned*)(ws + WS_U8 + (size_t)PEXP * DM), (float*)(ws + WS_SU) + PEXP, (int*)(ws + WS_RS) + PEXP);
    else quant_rows(p.pu + (size_t)PEXP * DM, PEXP, (unsigned*)(ws + WS_U8 + (size_t)PEXP * DM), (float*)(ws + WS_SU) + PEXP, 0);
    quant_v_sliced(p.pv, ws + WS_V8, (float*)(ws + WS_SV), lds_);
    cvt_f16_stream(p.subk, (f16*)(ws + WS_SUBK), (size_t)DEPTH * PH * 2 * PNK * 128);
}

template <int MODE, bool XH>
__device__ __forceinline__ void phase_norm2(const float* xin, const f16* xinh, float* fout, const float* g, const float* shift, const float* scale, f16* hout, unsigned* h8, float* sh8) {
    const int tid_ = otid(); const int wid = tid_ >> 6, lane = tid_ & 63;
    for (int r0 = (blockIdx.x * NWAVES + wid) * 8; r0 < NT; r0 += gridDim.x * NWAVES * 8) {
        const int b = r0 / SEQ;
        f32x4 gm[8], sh[8];
#pragma unroll
        for (int i = 0; i < 8; ++i) {
            const int col = (i >> 1) * 512 + lane * 8 + (i & 1) * 4;
            gm[i] = *(const f32x4*)(g + col);
            if (MODE != 2) { gm[i] = gm[i] * (*(const f32x4*)(scale + (size_t)b * 6 * DM + col) + 1.f); sh[i] = *(const f32x4*)(shift + (size_t)b * 6 * DM + col); }
        }
        f32x4 v[8], nv[8]; u32x4 nh[4];
#define NR_LOAD(row_) do { if (XH) { _Pragma("unroll") for (int i = 0; i < 4; ++i) nh[i] = *(const u32x4*)(xinh + (size_t)(row_) * DM + i * 512 + lane * 8); } \
        else { _Pragma("unroll") for (int i = 0; i < 8; ++i) nv[i] = *(const f32x4*)(xin + (size_t)(row_) * DM + (i >> 1) * 512 + lane * 8 + (i & 1) * 4); } } while (0)
        NR_LOAD(r0);
#pragma unroll 1
        for (int k = 0; k < 8; ++k) {
            const int row = r0 + k;
            if (XH) {
#pragma unroll
                for (int i = 0; i < 4; ++i) { v[2 * i] = (f32x4){h_lo(nh[i].x), h_hi(nh[i].x), h_lo(nh[i].y), h_hi(nh[i].y)}; v[2 * i + 1] = (f32x4){h_lo(nh[i].z), h_hi(nh[i].z), h_lo(nh[i].w), h_hi(nh[i].w)}; }
            } else {
#pragma unroll
                for (int i = 0; i < 8; ++i) v[i] = nv[i];
            }
            if (k < 7) NR_LOAD(row + 1);
            float ss = 0.f;
#pragma unroll
            for (int i = 0; i < 8; ++i) ss += v[i][0] * v[i][0] + v[i][1] * v[i][1] + v[i][2] * v[i][2] + v[i][3] * v[i][3];
            ss = wave_sum(ss);
            const float rstd = rsqrtf(ss * (1.f / DM) + EPS);
            float am = 0.f;
            if (MODE == 2) {
#pragma unroll
                for (int i = 0; i < 8; ++i) *(f32x4*)(fout + (size_t)row * DM + (i >> 1) * 512 + lane * 8 + (i & 1) * 4) = v[i] * rstd * gm[i];
            } else {
#pragma unroll
                for (int i = 0; i < 4; ++i) {
                    const f32x4 y0 = v[2 * i] * rstd * gm[2 * i] + sh[2 * i], y1 = v[2 * i + 1] * rstd * gm[2 * i + 1] + sh[2 * i + 1];
                    u32x4 w; w.x = pack_h2(y0[0], y0[1]); w.y = pack_h2(y0[2], y0[3]); w.z = pack_h2(y1[0], y1[1]); w.w = pack_h2(y1[2], y1[3]);
                    *(u32x4*)(hout + (size_t)row * DM + i * 512 + lane * 8) = w;
                    if (MODE == 0 && !XH && fout) { u32x4 xw; xw.x = pack_h2(v[2 * i][0], v[2 * i][1]); xw.y = pack_h2(v[2 * i][2], v[2 * i][3]); xw.z = pack_h2(v[2 * i + 1][0], v[2 * i + 1][1]); xw.w = pack_h2(v[2 * i + 1][2], v[2 * i + 1][3]);
                        *(u32x4*)((f16*)fout + (size_t)row * DM + i * 512 + lane * 8) = xw; }
                    if (MODE == 1) { v[2 * i] = y0; v[2 * i + 1] = y1;
                        am = fmaxf(am, fmaxf(fmaxf(fmaxf(fabsf(y0[0]), fabsf(y0[1])), fmaxf(fabsf(y0[2]), fabsf(y0[3]))), fmaxf(fmaxf(fabsf(y1[0]), fabsf(y1[1])), fmaxf(fabsf(y1[2]), fabsf(y1[3]))))); }
                }
            }
            if (MODE == 1) {
                am = wave_max(am);
                const float qs = am > 0.f ? am * (1.f / 127.f) : 1.f, inv = 1.f / qs;
                if (lane == 0) sh8[row] = qs;
                int qsum = 0;
#pragma unroll
                for (int i = 0; i < 4; ++i) {
                    u32x2 w = {0u, 0u};
#pragma unroll
                    for (int j = 0; j < 4; ++j) { const int q0 = (int)rintf(v[2 * i][j] * inv), q1 = (int)rintf(v[2 * i + 1][j] * inv); qsum += q0 + q1; w.x |= ((unsigned)q0 & 255u) << (8 * j); w.y |= ((unsigned)q1 & 255u) << (8 * j); }
                    const unsigned wx = w.x ^ 0x80808080u, wy = w.y ^ 0x80808080u;
                    const unsigned alo = (wx & 0x0F0F0F0Fu) | ((wy & 0x0F0F0F0Fu) << 4), ahi = ((wx >> 4) & 0x0F0F0F0Fu) | (wy & 0xF0F0F0F0u);
                    unsigned char* hb = (unsigned char*)h8 + (size_t)row * DM + (size_t)(16 * i + (lane >> 2)) * 32 + 4 * (lane & 3);
                    *(unsigned*)hb = alo; *(unsigned*)(hb + 16) = ahi;
                }
#pragma unroll
                for (int o = 32; o >= 1; o >>= 1) qsum += __shfl_xor(qsum, o);
                if (lane == 0) ((int*)(sh8 + NT))[row] = qsum;
            }
        }
#undef NR_LOAD
    }
}

template <int I>
__device__ __forceinline__ void ix_mask_words(const unsigned (&key)[32], const unsigned thr, unsigned& myw) {
    const unsigned long long bal = __ballot(key[I] >= thr && key[I] != 0u);
    asm("v_writelane_b32 %0, %1, %2" : "+v"(myw) : "s"((unsigned)bal), "n"(2 * I));
    asm("v_writelane_b32 %0, %1, %2" : "+v"(myw) : "s"((unsigned)(bal >> 32)), "n"(2 * I + 1));
    if constexpr (I + 1 < 32) ix_mask_words<I + 1>(key, thr, myw);
}
constexpr int IX_ROW = SEQ + 4;
__device__ __forceinline__ void index_item(const Params& p, LAS unsigned char* lds, int b, int qg) {
    const f16* proj = (const f16*)(p.ws + WS_PROJ);
    LAS float* sc = (LAS float*)lds;
    const int tid = otid(), wid = __builtin_amdgcn_readfirstlane(tid >> 6), lane = tid & 63, fr = lane & 15, fq = lane >> 4;
    const int t0 = qg * 16, nkt = qg + 1;
    h8_t Bq[IH][2]; float wq[IH];
    {
        const f16* qrow = proj + ((size_t)b * SEQ + t0 + fr) * INWP;
#pragma unroll
        for (int h = 0; h < IH; ++h) {
            Bq[h][0] = *(const h8_t*)(qrow + C_IQ + h * IDM + 8 * fq);
            Bq[h][1] = *(const h8_t*)(qrow + C_IQ + h * IDM + 32 + 8 * fq);
        }
        const h8_t w0 = *(const h8_t*)(qrow + C_IW), w1 = *(const h8_t*)(qrow + C_IW + 8);
#pragma unroll
        for (int h = 0; h < 8; ++h) { wq[h] = (float)w0[h] * (0.25f * 0.125f); wq[8 + h] = (float)w1[h] * (0.25f * 0.125f); }
    }
    __syncthreads();
    const f16* kbase = proj + ((size_t)b * SEQ + fr) * INWP + C_IK + 8 * fq;
    h8_t a0, a1, n0, n1;
#define IX_LOAD(A0_, A1_, kt_) do { const int c_ = (kt_) < nkt ? (kt_) : 0; A0_ = *(const h8_t*)(kbase + (size_t)c_ * 16 * INWP); A1_ = *(const h8_t*)(kbase + (size_t)c_ * 16 * INWP + 32); } while (0)
#define IX_TILE(A0_, A1_, kt_) do { f32x4 acc = {0.f, 0.f, 0.f, 0.f}; \
        _Pragma("unroll") for (int h = 0; h < IH; ++h) { \
            f32x4 c = {0.f, 0.f, 0.f, 0.f}; \
            c = __builtin_amdgcn_mfma_f32_16x16x32_f16(A0_, Bq[h][0], c, 0, 0, 0); \
            c = __builtin_amdgcn_mfma_f32_16x16x32_f16(A1_, Bq[h][1], c, 0, 0, 0); \
            _Pragma("unroll") for (int j = 0; j < 4; ++j) { const int ci = __float_as_int(c[j]); acc[j] += wq[h] * __int_as_float(ci > 0 ? ci : 0); } } \
        *(LAS f32x4*)(sc + fr * IX_ROW + (kt_) * 16 + 4 * fq) = acc; } while (0)
    int kt = wid;
    IX_LOAD(a0, a1, kt);
    for (; kt < nkt; kt += 2 * NWAVES) {
        IX_LOAD(n0, n1, kt + NWAVES); __builtin_amdgcn_sched_barrier(0);
        IX_TILE(a0, a1, kt); __builtin_amdgcn_sched_barrier(0);
        IX_LOAD(a0, a1, kt + 2 * NWAVES); __builtin_amdgcn_sched_barrier(0);
        if (kt + NWAVES < nkt) IX_TILE(n0, n1, kt + NWAVES);
        __builtin_amdgcn_sched_barrier(0);
    }
#undef IX_LOAD
#undef IX_TILE
    __syncthreads();
    unsigned* mask = (unsigned*)(p.ws + WS_MASK);
#pragma unroll 1
    for (int qq = 0; qq < 2; ++qq) {
        const int ql = 2 * wid + qq, t = t0 + ql, nk = t + 1;
        unsigned key[32];
#pragma unroll
        for (int i = 0; i < 32; ++i) {
            const int s = lane + 64 * i;
            unsigned u = 0u;
            if (s < nk) { const unsigned bits = __float_as_uint(sc[ql * IX_ROW + s]); u = (bits & 0x80000000u) ? ~bits : (bits | 0x80000000u); if (u == 0u) u = 1u; }
            key[i] = u;
        }
        unsigned thr = 1u;
        if (nk > DSA_TOPK) {
            thr = 0u;
            const int nreg8 = (nk + 511) >> 9;
            for (int bit = 31; bit >= 0; --bit) {
                const unsigned cand = thr | (1u << bit);
                int cnt = 0;
#pragma unroll
                for (int i8 = 0; i8 < 4; ++i8) {
                    if (i8 < nreg8) {
#pragma unroll
                        for (int i = 0; i < 8; ++i) cnt += __builtin_popcountll(__ballot(key[8 * i8 + i] >= cand));
                    }
                }
                if (cnt >= DSA_TOPK) { thr = cand; if (cnt == DSA_TOPK) break; }
            }
        }
        unsigned* mrow = mask + ((size_t)b * SEQ + t) * 64;
        unsigned myw = 0u;
        ix_mask_words<0>(key, thr, myw);
        mrow[lane] = myw;
    }
}

__device__ __forceinline__ void phase_index2(const Params& p, LAS unsigned char* lds_) {
    const f16* proj = (const f16*)(p.ws + WS_PROJ);
    float* smem = (float*)(unsigned char*)lds_;
    const int tid = otid();
    {
        float* red = smem;
        float* km = (float*)(p.ws + WS_KMEAN);
        for (int u = obid(); u < NB * HC * MOBA_NB; u += gridDim.x) {
            const int blk = u % MOBA_NB, h = (u / MOBA_NB) % HC, b = u / (MOBA_NB * HC);
            const f16* kp = proj + ((size_t)b * SEQ + blk * MOBA_BLK + (tid >> 4)) * INWP + C_KC + h * HD + 8 * (tid & 15);
            h8_t kv[8];
#pragma unroll
            for (int i = 0; i < 8; ++i) kv[i] = *(const h8_t*)(kp + (size_t)(32 * i) * INWP);
            float a[8];
#pragma unroll
            for (int j = 0; j < 8; ++j) a[j] = 0.f;
#pragma unroll
            for (int i = 0; i < 8; ++i)
#pragma unroll
                for (int j = 0; j < 8; ++j) a[j] += (float)kv[i][j];
#pragma unroll
            for (int j = 0; j < 8; ++j) { a[j] += __shfl_xor(a[j], 16); a[j] += __shfl_xor(a[j], 32); }
            __syncthreads();
            if ((tid & 63) < 16) {
#pragma unroll
                for (int j = 0; j < 8; ++j) red[(tid >> 6) * 128 + 8 * (tid & 15) + j] = a[j];
            }
            __syncthreads();
            if (tid < 128) {
                float sacc = 0.f;
#pragma unroll
                for (int w = 0; w < NWAVES; ++w) sacc += red[w * 128 + tid];
                km[(size_t)u * HD + tid] = sacc * (1.f / MOBA_BLK);
            }
        }
        __syncthreads();
    }
    for (int pi = obid(); pi < NB * 64; pi += gridDim.x) {
        const int b = pi >> 6, a = pi & 63;
        index_item(p, lds_, b, 127 - a);
        index_item(p, lds_, b, a);
    }
}

typedef short s4_t __attribute__((ext_vector_type(4)));
typedef float f32x16 __attribute__((ext_vector_type(16)));
constexpr int AT_KSTR = 272, AT_VSTR = 320, AT_KBYTES = 64 * AT_KSTR, AT_VBYTES = 64 * AT_VSTR, AT_STAGE = AT_KBYTES + AT_VBYTES;
__device__ __forceinline__ float fexp2(float x) { return __builtin_amdgcn_exp2f(x); }
__device__ __forceinline__ float flog2(float x) { return __builtin_amdgcn_logf(x); }

__device__ __forceinline__ float xhalf_max(float x) { const auto r = __builtin_amdgcn_permlane32_swap(__float_as_uint(x), __float_as_uint(x), false, false); return fmaxf(__uint_as_float(r[0]), __uint_as_float(r[1])); }
__device__ __forceinline__ float xhalf_sum(float x) { const auto r = __builtin_amdgcn_permlane32_swap(__float_as_uint(x), __float_as_uint(x), false, false); return __uint_as_float(r[0]) + __uint_as_float(r[1]); }
template <int VAR>
__device__ __forceinline__ void attn_item(const Params& p, LAS unsigned char* lds, const float* ong, int b, int hh, int qt, int qc, int kc, int vc) {
    const f16* proj = (const f16*)(p.ws + WS_PROJ);
    const int tid = otid(), wid = __builtin_amdgcn_readfirstlane(tid >> 6), lane = tid & 63, qn = lane & 31, hf = lane >> 5;
    const int q0 = qt * 256, qrow = q0 + 32 * wid + qn;
    const size_t grow = (size_t)b * SEQ + qrow;
    const int nst = (qt + 1) * 4;
    const int st_hi_w = qt * 4 + (wid >> 1);
    const int sr0 = tid >> 4, sc0 = tid & 15;
    const f16* kg = proj + ((size_t)b * SEQ + sr0) * INWP + kc + 8 * sc0;
    const f16* vg = proj + ((size_t)b * SEQ + sr0) * INWP + vc + 8 * sc0;
    const unsigned kw = sr0 * AT_KSTR + 16 * sc0, vw = AT_KBYTES + sr0 * AT_VSTR + 16 * sc0;
    const unsigned* mrow = (const unsigned*)(p.ws + WS_MASK) + grow * 64;
    const unsigned ka = qn * AT_KSTR + 16 * hf;
    const unsigned va = AT_KBYTES + (4 * hf + ((lane & 15) >> 2)) * AT_VSTR + (16 * ((lane >> 4) & 1) + 4 * (lane & 3)) * 2;
    u32x4 rk0, rk1, rv0, rv1; u32x2 mw = {0u, 0u}, mwn = {0u, 0u};
#define AT_LOAD(st_) do { const size_t o_ = (size_t)(st_) * 64 * INWP; rk0 = *(const u32x4*)(kg + o_); rk1 = *(const u32x4*)(kg + o_ + (size_t)32 * INWP); \
        rv0 = *(const u32x4*)(vg + o_); rv1 = *(const u32x4*)(vg + o_ + (size_t)32 * INWP); if (VAR == 0) mwn = *(const u32x2*)(mrow + 2 * (st_)); } while (0)
#define AT_WRITE(buf_) do { LAS unsigned char* b_ = lds + (buf_) * AT_STAGE; *(LAS u32x4*)(b_ + kw) = rk0; *(LAS u32x4*)(b_ + kw + 32 * AT_KSTR) = rk1; \
        *(LAS u32x4*)(b_ + vw) = rv0; *(LAS u32x4*)(b_ + vw + 32 * AT_VSTR) = rv1; } while (0)
    AT_LOAD(nst - 1);
    h8_t Qf[8];
    {
        const float sc = 0.08838834764831845f * 1.4426950408889634f;
        const f16* qp = proj + grow * INWP + qc + 8 * hf;
#pragma unroll
        for (int ks = 0; ks < 8; ++ks) {
            const h8_t v = *(const h8_t*)(qp + 16 * ks);
            h8_t w;
#pragma unroll
            for (int j = 0; j < 8; ++j) w[j] = (f16)((float)v[j] * sc);
            Qf[ks] = w;
        }
    }
    unsigned allowed = 0xffu;
    if (VAR == 2) {
        const int own = qt;
        constexpr int KM_OFF = 2 * AT_STAGE + 1024;
        if (tid < (MOBA_NB - 1) * HD / 4) *(LAS f32x4*)(lds + KM_OFF + tid * 16) = *(const f32x4*)((const float*)(p.ws + WS_KMEAN) + ((size_t)b * HC + (hh - HA - HB)) * MOBA_NB * HD + 4 * tid);
        __syncthreads();
        const LAS float* km = (const LAS float*)(lds + KM_OFF) + 8 * hf;
        float gs[MOBA_NB];
#pragma unroll
        for (int j = 0; j < MOBA_NB; ++j) gs[j] = -INFINITY;
#pragma unroll
        for (int j = 0; j < MOBA_NB - 1; ++j) {
            if (j < own) {
                float s = 0.f;
#pragma unroll
                for (int ks = 0; ks < 8; ++ks) {
                    const f32x4 k0 = *(const LAS f32x4*)(km + j * HD + 16 * ks), k1 = *(const LAS f32x4*)(km + j * HD + 16 * ks + 4);
                    s += (float)Qf[ks][0] * k0[0] + (float)Qf[ks][1] * k0[1] + (float)Qf[ks][2] * k0[2] + (float)Qf[ks][3] * k0[3]
                       + (float)Qf[ks][4] * k1[0] + (float)Qf[ks][5] * k1[1] + (float)Qf[ks][6] * k1[2] + (float)Qf[ks][7] * k1[3];
                }
                gs[j] = s + __shfl_xor(s, 32);
            }
        }
        allowed = 1u << own;
#pragma unroll
        for (int j = 0; j < MOBA_NB - 1; ++j) {
            if (j < own) {
                int rank = 0;
#pragma unroll
                for (int k2 = 0; k2 < MOBA_NB - 1; ++k2) if (k2 < own && (gs[k2] > gs[j] || (gs[k2] == gs[j] && k2 < j))) ++rank;
                if (rank < 3) allowed |= 1u << j;
            }
        }
    }
    f32x16 O[4];
#pragma unroll
    for (int dt = 0; dt < 4; ++dt)
#pragma unroll
        for (int r = 0; r < 16; ++r) O[dt][r] = 0.f;
    float m_run = -INFINITY, l_run = 0.f, carry = 0.f;
    __syncthreads();
    AT_WRITE(0); mw = mwn;
    __syncthreads();
    if (wid >= 4) __builtin_amdgcn_s_setprio(1);
    int cur = 0;
    bool wdone = false;
    for (int st = nst - 1; st >= 0; --st) {
        if (st > 0) AT_LOAD(st - 1);
        if (st <= st_hi_w && !wdone) {
            LAS unsigned char* kb = lds + cur * AT_STAGE;
            f32x16 S[2];
#pragma unroll
            for (int r = 0; r < 16; ++r) { S[0][r] = 0.f; S[1][r] = 0.f; }
            {
                h8_t kf[3][2];
                kf[0][0] = *(const LAS h8_t*)(kb + ka); kf[0][1] = *(const LAS h8_t*)(kb + ka + 32 * AT_KSTR);
                kf[1][0] = *(const LAS h8_t*)(kb + ka + 32); kf[1][1] = *(const LAS h8_t*)(kb + ka + 32 + 32 * AT_KSTR);
#pragma unroll
                for (int ks = 0; ks < 8; ++ks) {
                    if (ks < 6) { kf[(ks + 2) % 3][0] = *(const LAS h8_t*)(kb + ka + 32 * (ks + 2)); kf[(ks + 2) % 3][1] = *(const LAS h8_t*)(kb + ka + 32 * (ks + 2) + 32 * AT_KSTR); }
                    __builtin_amdgcn_sched_barrier(0);
                    S[0] = __builtin_amdgcn_mfma_f32_32x32x16_f16(kf[ks % 3][0], Qf[ks], S[0], 0, 0, 0);
                    S[1] = __builtin_amdgcn_mfma_f32_32x32x16_f16(kf[ks % 3][1], Qf[ks], S[1], 0, 0, 0);
                    __builtin_amdgcn_sched_barrier(0);
                }
            }
            const bool diag = (64 * st + 63 > q0 + 32 * wid);
            const int kbase = 64 * st + 4 * hf;
            if (VAR != 1) {
                const bool blk_ok = (VAR == 2) ? ((allowed >> (st >> 2)) & 1u) : true;
                float mx = -INFINITY;
                if (VAR == 2 && !diag) {
                    const float bias = blk_ok ? 0.f : -INFINITY;
#pragma unroll
                    for (int sub = 0; sub < 2; ++sub)
#pragma unroll
                        for (int r = 0; r < 16; ++r) { const float v = S[sub][r] + bias; S[sub][r] = v; mx = fmaxf(mx, v); }
                } else {
#pragma unroll
                for (int sub = 0; sub < 2; ++sub)
#pragma unroll
                    for (int r = 0; r < 16; ++r) {
                        const int kl = (r & 3) + 8 * (r >> 2);
                        bool ok;
                        if (VAR == 0) ok = ((sub == 0 ? mw.x : mw.y) >> (kl + 4 * hf)) & 1u;
                        else ok = blk_ok && (!diag || (kbase + 32 * sub + kl <= qrow));
                        const float v = ok ? S[sub][r] : -INFINITY;
                        S[sub][r] = v; mx = fmaxf(mx, v);
                    }
                }
                mx = xhalf_max(mx);
                float m_new = fmaxf(m_run, mx);
                if (__ballot(m_new - m_run > 8.f) == 0ull) m_new = m_run;
                const float m_use = (m_new == -INFINITY) ? 0.f : m_new;
                const float alpha = fexp2(m_run - m_use);
                float ps = 0.f;
#pragma unroll
                for (int sub = 0; sub < 2; ++sub)
#pragma unroll
                    for (int r = 0; r < 16; ++r) { const float e = fexp2(S[sub][r] - m_use); S[sub][r] = e; ps += e; }
                l_run = l_run * alpha + ps;
                m_run = m_new;
                if (__ballot(alpha != 1.f) != 0ull) {
#pragma unroll
                    for (int dt = 0; dt < 4; ++dt)
#pragma unroll
                        for (int r = 0; r < 16; ++r) O[dt][r] *= alpha;
                }
            } else {
#pragma unroll
                for (int sub = 1; sub >= 0; --sub) {
                    float lk[16];
#pragma unroll
                    for (int r = 0; r < 16; ++r) {
                        const int kl = (r & 3) + 8 * (r >> 2);
                        const bool ok = !diag || (kbase + 32 * sub + kl < qrow);
                        const float zl = S[sub][r];
                        const float sp = fmaxf(zl, 0.f) + flog2(1.f + fexp2(-fabsf(zl)));
                        lk[r] = ok ? -sp : 0.f;
                        S[sub][r] = ok ? zl : -INFINITY;
                    }
                    float gsum[4], pg[4], T[4];
#pragma unroll
                    for (int g = 0; g < 4; ++g) { gsum[g] = (lk[4 * g] + lk[4 * g + 1]) + (lk[4 * g + 2] + lk[4 * g + 3]); { const auto r_ = __builtin_amdgcn_permlane32_swap(__float_as_uint(gsum[g]), __float_as_uint(gsum[g]), false, false); pg[g] = __uint_as_float(hf ? r_[0] : r_[1]); } T[g] = gsum[g] + pg[g]; }
                    float after[4];
                    after[3] = 0.f; after[2] = T[3]; after[1] = T[3] + T[2]; after[0] = T[3] + T[2] + T[1];
#pragma unroll
                    for (int g = 0; g < 4; ++g) {
                        const float base = carry + after[g] + (hf == 0 ? pg[g] : 0.f);
                        const float c3 = lk[4 * g + 3], c2 = lk[4 * g + 2] + c3, c1 = lk[4 * g + 1] + c2, c0 = lk[4 * g] + c1;
                        S[sub][4 * g + 3] = fexp2(S[sub][4 * g + 3] + base + c3);
                        S[sub][4 * g + 2] = fexp2(S[sub][4 * g + 2] + base + c2);
                        S[sub][4 * g + 1] = fexp2(S[sub][4 * g + 1] + base + c1);
                        S[sub][4 * g + 0] = fexp2(S[sub][4 * g + 0] + base + c0);
                    }
                    carry += (T[0] + T[1]) + (T[2] + T[3]);
                }
            }
            {
                typedef short s8_t __attribute__((ext_vector_type(8)));
                s8_t vf[3];
#define AT_VREAD(i_) do { const LAS unsigned char* ap_ = kb + va + (32 * ((i_) >> 3) + 16 * (((i_) >> 2) & 1)) * AT_VSTR + 64 * ((i_) & 3); \
                    const s4_t t0_ = __builtin_amdgcn_ds_read_tr16_b64_v4i16((LAS s4_t*)ap_); const s4_t t1_ = __builtin_amdgcn_ds_read_tr16_b64_v4i16((LAS s4_t*)(ap_ + 8 * AT_VSTR)); \
                    vf[(i_) % 3] = __builtin_shufflevector(t0_, t1_, 0, 1, 2, 3, 4, 5, 6, 7); } while (0)
                AT_VREAD(0); AT_VREAD(1);
                h8_t pb;
#pragma unroll
                for (int i = 0; i < 16; ++i) {
                    const int sub = i >> 3, s2 = (i >> 2) & 1, dt = i & 3;
                    if (i < 14) AT_VREAD(i + 2);
                    if (dt == 0) {
#pragma unroll
                        for (int j = 0; j < 8; ++j) pb[j] = (f16)S[sub][8 * s2 + j];
                    }
                    __builtin_amdgcn_sched_barrier(0);
                    O[dt] = __builtin_amdgcn_mfma_f32_32x32x16_f16(__builtin_bit_cast(h8_t, vf[i % 3]), pb, O[dt], 0, 0, 0);
                    __builtin_amdgcn_sched_barrier(0);
                }
#undef AT_VREAD
            }
        }
        if (VAR == 1) {
            if (st <= st_hi_w && !wdone) wdone = (__ballot(carry < -100.f) == ~0ull);
            if (lane == 0) *(LAS unsigned*)(lds + 2 * AT_STAGE + 32 * (st & 1) + 4 * wid) = wdone ? 1u : 0u;
        }
        if (st > 0) { AT_WRITE(cur ^ 1); }
        mw = mwn;
        __syncthreads();
        cur ^= 1;
        if (VAR == 1) {
            unsigned alld = 1u;
#pragma unroll
            for (int w = 0; w < NWAVES; ++w) alld &= *(const LAS unsigned*)(lds + 2 * AT_STAGE + 32 * (st & 1) + 4 * w);
            if (alld) break;
        }
    }
#undef AT_LOAD
#undef AT_WRITE
    __builtin_amdgcn_s_setprio(0);
    float inv = 1.f;
    if (VAR != 1) { const float lt = xhalf_sum(l_run); inv = 1.f / lt; }
    float ss = 0.f;
#pragma unroll
    for (int dt = 0; dt < 4; ++dt)
#pragma unroll
        for (int r = 0; r < 16; ++r) { const float v = O[dt][r] * inv; O[dt][r] = v; ss += v * v; }
    ss = xhalf_sum(ss);
    const float rstd = rsqrtf(ss * (1.f / HD) + EPS);
    f16* yp = (f16*)(p.ws + WS_Y) + grow * DM + hh * HD + 4 * hf;
    const float* gp = ong + hh * HD + 4 * hf;
    f32x4 gg[4][4];
#pragma unroll
    for (int dt = 0; dt < 4; ++dt)
#pragma unroll
        for (int g = 0; g < 4; ++g) gg[dt][g] = *(const f32x4*)(gp + 32 * dt + 8 * g);
    __builtin_amdgcn_sched_barrier(0);
    f16* yrow = (f16*)(p.ws + WS_Y) + grow * DM + hh * HD + (hf ? 8 : 0);
#pragma unroll
    for (int dt = 0; dt < 4; ++dt)
#pragma unroll
        for (int g2 = 0; g2 < 2; ++g2) {
            const int ga = 2 * g2, gb = 2 * g2 + 1;
            unsigned ax = pack_h2(O[dt][4 * ga] * rstd * gg[dt][ga][0], O[dt][4 * ga + 1] * rstd * gg[dt][ga][1]), ay = pack_h2(O[dt][4 * ga + 2] * rstd * gg[dt][ga][2], O[dt][4 * ga + 3] * rstd * gg[dt][ga][3]);
            unsigned bx = pack_h2(O[dt][4 * gb] * rstd * gg[dt][gb][0], O[dt][4 * gb + 1] * rstd * gg[dt][gb][1]), by = pack_h2(O[dt][4 * gb + 2] * rstd * gg[dt][gb][2], O[dt][4 * gb + 3] * rstd * gg[dt][gb][3]);
            { const auto r = __builtin_amdgcn_permlane32_swap(ax, bx, false, false); ax = r[0]; bx = r[1]; }
            { const auto r = __builtin_amdgcn_permlane32_swap(ay, by, false, false); ay = r[0]; by = r[1]; }
            u32x4 w; w.x = ax; w.y = ay; w.z = bx; w.w = by;
            *(u32x4*)(yrow + 32 * dt + 16 * g2) = w;
        }
    (void)yp;
}

__device__ __forceinline__ void phase_attn2(const Params& p, LAS unsigned char* lds, const float* ong, unsigned* qbase, const int l) {
    const unsigned* ctl = (const unsigned*)(p.ws + WS_CTL);
    const unsigned myx = *(const LAS unsigned*)(lds + LDS_BYTES - 16);
    int G = 0, g = 0; bool uniform = true; unsigned c0 = 0u;
    unsigned cc[16];
#pragma unroll
    for (int j = 0; j < 16; ++j) cc[j] = __hip_atomic_load(ctl + j, __ATOMIC_RELAXED, __HIP_MEMORY_SCOPE_AGENT);
    __builtin_amdgcn_sched_barrier(0);
#pragma unroll
    for (int j = 0; j < 16; ++j) { const unsigned c = __builtin_amdgcn_readfirstlane(cc[j]); if (c > 0u) { if ((unsigned)j < myx) ++g; ++G; if (c0 == 0u) c0 = c; else if (c != c0) uniform = false; } }
    const bool perx = uniform && G == NB;
    unsigned* queue = perx ? qbase + 2 + l * 8 + g : qbase + l;
    const int total = perx ? NHEADS * 8 : NB * NHEADS * 8;
    for (;;) {
        __syncthreads();
        if (threadIdx.x == 0) *(LAS unsigned*)(lds + 2 * AT_STAGE + 96) = __hip_atomic_fetch_add(queue, 1u, __ATOMIC_RELAXED, __HIP_MEMORY_SCOPE_AGENT);
        __syncthreads();
        const int idx = (int)*(const LAS unsigned*)(lds + 2 * AT_STAGE + 96);
        if (idx >= total) break;
        int qt, b, hh;
        if (perx) {
            b = g;
            if (idx < 88) { qt = 7 - idx / 11; const int h11 = idx % 11; hh = h11 < HA ? h11 : h11 + HB; }
            else { const int r = idx - 88; qt = 7 - r / 5; hh = HA + (r % 5); }
        } else if (idx < 704) { qt = 7 - idx / 88; const int r = idx % 88; b = r / 11; const int h11 = r % 11; hh = h11 < HA ? h11 : h11 + HB; }
        else { const int r = idx - 704; qt = 7 - r / 40; b = (r % 40) / 5; hh = HA + (r % 5); }
        if (hh < HA) attn_item<0>(p, lds, ong, b, hh, qt, C_QA + hh * HD, C_KA, C_VA);
        else if (hh < HA + HB) attn_item<1>(p, lds, ong, b, hh, qt, C_QB + (hh - HA) * HD, C_KB + (hh - HA) * HD, C_VB + (hh - HA) * HD);
        else attn_item<2>(p, lds, ong, b, hh, qt, C_QC + (hh - HA - HB) * HD, C_KC + (hh - HA - HB) * HD, C_VC + (hh - HA - HB) * HD);
    }
}

#define CE_DESC(a, b) do { const unsigned _x = (a) > (b) ? (a) : (b), _y = (a) > (b) ? (b) : (a); (a) = _x; (b) = _y; } while (0)
__device__ __forceinline__ void sort16_desc(unsigned (&k)[16]) {
#pragma unroll
    for (int kk = 2; kk <= 16; kk <<= 1)
#pragma unroll
        for (int j = kk >> 1; j > 0; j >>= 1)
#pragma unroll
            for (int i = 0; i < 16; ++i) { const int l = i ^ j; if (l > i) { if ((i & kk) == 0) CE_DESC(k[i], k[l]); else CE_DESC(k[l], k[i]); } }
}
__device__ __forceinline__ void merge16_desc(unsigned (&a)[16], const unsigned (&b)[16]) {
#pragma unroll
    for (int i = 0; i < 16; ++i) a[i] = a[i] > b[15 - i] ? a[i] : b[15 - i];
#pragma unroll
    for (int j = 8; j > 0; j >>= 1)
#pragma unroll
        for (int i = 0; i < 16; ++i) { const int l = i ^ j; if (l > i) CE_DESC(a[i], a[l]); }
}
__device__ __forceinline__ unsigned f2sort(float f) { const unsigned b = __float_as_uint(f); return b ^ ((unsigned)((int)b >> 31) | 0x80000000u); }
__device__ __forceinline__ float sort2f(unsigned u) { const unsigned b = (u & 0x80000000u) ? (u ^ 0x80000000u) : ~u; return __uint_as_float(b); }
constexpr int RT_STR = 272;
__device__ __forceinline__ void phase_route2(const Params& p, LAS unsigned char* lds, const f16* subk) {
    const f16* qp = (const f16*)(p.ws + WS_Y);
    unsigned* pe = (unsigned*)(p.ws + WS_PE); float* pg = (float*)(p.ws + WS_PG);
    const int tid = otid(), wid = __builtin_amdgcn_readfirstlane(tid >> 6), lane = tid & 63, qn = lane & 31, hf = lane >> 5;
    const bool fused = ((int)gridDim.x == 256);
    for (int item = obid(); item < 256; item += gridDim.x) {
        const int hp = fused ? ((item >> 3) & 7) : (item & 7), tg = fused ? ((item & 7) + 8 * (item >> 6)) : (item >> 3);
        __syncthreads();
        {
            const f16* src = subk + (size_t)hp * 256 * 128;
#pragma unroll
            for (int i = 0; i < 8; ++i) { const int e = tid + i * 512, r = e >> 4, c = e & 15; *(LAS u32x4*)(lds + r * RT_STR + 16 * c) = *(const u32x4*)(src + r * 128 + 8 * c); }
        }
        __syncthreads();
#pragma unroll 1
        for (int it = 0; it < 2; ++it) {
            const int t = (tg * 16 + wid * 2 + it) * 32 + qn;
            unsigned top[2][16];
#pragma unroll
            for (int c = 0; c < 2; ++c) {
                h8_t Bq[8];
                const f16* qrow = qp + (size_t)t * DM + hp * 256 + c * 128 + 8 * hf;
#pragma unroll
                for (int ks = 0; ks < 8; ++ks) Bq[ks] = *(const h8_t*)(qrow + 16 * ks);
                unsigned run[16];
#pragma unroll 1
                for (int nt = 0; nt < 4; ++nt) {
                    f32x16 S;
#pragma unroll
                    for (int r = 0; r < 16; ++r) S[r] = 0.f;
                    {
                        h8_t af[3];
                        const LAS unsigned char* ab = lds + (c * 128 + nt * 32 + qn) * RT_STR + 16 * hf;
                        af[0] = *(const LAS h8_t*)ab; af[1] = *(const LAS h8_t*)(ab + 32);
#pragma unroll
                        for (int ks = 0; ks < 8; ++ks) {
                            if (ks < 6) af[(ks + 2) % 3] = *(const LAS h8_t*)(ab + 32 * (ks + 2));
                            __builtin_amdgcn_sched_barrier(0);
                            S = __builtin_amdgcn_mfma_f32_32x32x16_f16(af[ks % 3], Bq[ks], S, 0, 0, 0);
                            __builtin_amdgcn_sched_barrier(0);
                        }
                    }
                    unsigned k[16];
#pragma unroll
                    for (int r = 0; r < 16; ++r) { const int n = 32 * nt + (r & 3) + 8 * (r >> 2) + 4 * hf; k[r] = (f2sort(S[r]) & ~127u) | (unsigned)(127 - n); }
                    sort16_desc(k);
                    if (nt == 0) {
#pragma unroll
                        for (int r = 0; r < 16; ++r) run[r] = k[r];
                    } else merge16_desc(run, k);
                }
#pragma unroll
                for (int r = 0; r < 16; ++r) top[c][r] = run[r];
            }
            unsigned mine[16], oth[16];
#pragma unroll
            for (int r = 0; r < 16; ++r) { const unsigned send = hf ? top[0][r] : top[1][r]; oth[r] = __shfl_xor(send, 32); mine[r] = hf ? top[1][r] : top[0][r]; }
            merge16_desc(mine, oth);
            unsigned ka[16], kb2[16];
#pragma unroll
            for (int r = 0; r < 16; ++r) { const unsigned o = __shfl_xor(mine[r], 32); ka[r] = hf ? o : mine[r]; kb2[r] = hf ? mine[r] : o; }
            float sa[16], sb[16]; unsigned na[4] = {0u, 0u, 0u, 0u}, nb[4] = {0u, 0u, 0u, 0u};
#pragma unroll
            for (int r = 0; r < 16; ++r) {
                sa[r] = sort2f(ka[r] & ~127u); sb[r] = sort2f(kb2[r] & ~127u);
                na[r >> 2] |= (127u - (ka[r] & 127u)) << (8 * (r & 3)); nb[r >> 2] |= (127u - (kb2[r] & 127u)) << (8 * (r & 3));
            }
            unsigned cand[4][16];
#pragma unroll
            for (int g = 0; g < 4; ++g)
#pragma unroll
                for (int r = 0; r < 16; ++r) cand[g][r] = 0u;
#pragma unroll
            for (int slot = 0; slot < 50; ++slot) {
                constexpr unsigned char CIJ[64] = {0, 1, 2, 3, 4, 5, 6, 7, 8, 9, 10, 11, 12, 13, 14, 15, 16, 17, 18, 19, 20, 21, 22, 23, 32, 33, 34, 35, 36, 48, 49, 50, 51, 64, 65, 66, 80, 81, 96, 97, 112, 113, 128, 144, 160, 176, 192, 208, 224, 240, 255, 255, 255, 255, 255, 255, 255, 255, 255, 255, 255, 255, 255, 255};
                const int ij = CIJ[slot], i = ij >> 4, j = ij & 15;
                cand[slot >> 4][slot & 15] = (f2sort(sa[i] + sb[j]) & ~255u) | (unsigned)(255 - ij);
            }
#pragma unroll
            for (int g = 1; g < 4; ++g) sort16_desc(cand[g]);
            merge16_desc(cand[0], cand[1]); merge16_desc(cand[2], cand[3]); merge16_desc(cand[0], cand[2]);
            float ex[16]; float sum = 0.f;
            const float mx = sort2f(cand[0][0] & ~255u);
#pragma unroll
            for (int r = 0; r < 16; ++r) { ex[r] = __expf(sort2f(cand[0][r] & ~255u) - mx); sum += ex[r]; }
            const float inv = 1.f / sum;
            unsigned eo[16];
#pragma unroll
            for (int r = 0; r < 16; ++r) {
                const unsigned id = 255u - (cand[0][r] & 255u), i = id >> 4, j = id & 15u;
                const unsigned wa = (i & 8u) ? ((i & 4u) ? na[3] : na[2]) : ((i & 4u) ? na[1] : na[0]);
                const unsigned wb = (j & 8u) ? ((j & 4u) ? nb[3] : nb[2]) : ((j & 4u) ? nb[1] : nb[0]);
                eo[r] = ((wa >> (8 * (i & 3u))) & 255u) * PNK + ((wb >> (8 * (j & 3u))) & 255u);
                ex[r] *= inv;
            }
            if (hf == 0) {
#pragma unroll
                for (int r4 = 0; r4 < 4; ++r4) { u32x4 w; w.x = eo[4 * r4]; w.y = eo[4 * r4 + 1]; w.z = eo[4 * r4 + 2]; w.w = eo[4 * r4 + 3]; *(u32x4*)(pe + (size_t)t * 128 + hp * 16 + 4 * r4) = w; }
            } else {
#pragma unroll
                for (int r4 = 0; r4 < 4; ++r4) { f32x4 w; w[0] = ex[4 * r4]; w[1] = ex[4 * r4 + 1]; w[2] = ex[4 * r4 + 2]; w[3] = ex[4 * r4 + 3]; *(f32x4*)(pg + (size_t)t * 128 + hp * 16 + 4 * r4) = w; }
            }
        }
    }
}

#ifndef EXU_NR
#define EXU_NR 8
#define EXU_SH 11
#endif
__device__ __forceinline__ float gelu_as(float v) {
    const float av = fabsf(v), t = __builtin_amdgcn_rcpf(av * 0.2316418882f + 1.0f);
    float q = t * 0.5307027145f + (-0.7265760135f); q = q * t + 0.7107068705f; q = q * t + (-0.142248368f); q = q * t + 0.127414796f; q = q * t;
    const float e = __builtin_amdgcn_exp2f((v * v) * (-0.72134752044f));
    const float m = v * (q * e);
    return v < 0.f ? m : v - m;
}
__device__ __forceinline__ int row16_sum(int d) {
    d += __builtin_amdgcn_update_dpp(0, d, 0xB1, 0xF, 0xF, true);
    d += __builtin_amdgcn_update_dpp(0, d, 0x4E, 0xF, 0xF, true);
    d += __builtin_amdgcn_update_dpp(0, d, 0x141, 0xF, 0xF, true);
    d += __builtin_amdgcn_update_dpp(0, d, 0x140, 0xF, 0xF, true);
    return d;
}
__device__ __forceinline__ unsigned xcc_id() { return (unsigned)__builtin_amdgcn_s_getreg((3 << 11) | 20) & 0xFu; }
template <int BITS>
__device__ __forceinline__ void phase_exu(const Params& p, LAS unsigned char* lds, const unsigned char* u8, const float* su, const float* sv, const int* rs) {
    const int tid = otid(), wid = __builtin_amdgcn_readfirstlane(tid >> 6), lane = tid & 63, sub = lane & 15, qd = lane >> 4;
    const unsigned* pe = (const unsigned*)(p.ws + WS_PE); const float* pg = (const float*)(p.ws + WS_PG);
    const unsigned char* h8 = (const unsigned char*)(p.ws + WS_H8); const float* shv = (const float*)(p.ws + WS_SH);
    unsigned* list = (unsigned*)(p.ws + WS_LIST);
    const unsigned* ctl = (const unsigned*)(p.ws + WS_CTL);
    const unsigned myx = *(const LAS unsigned*)(lds + LDS_BYTES - 16), mybi = *(const LAS unsigned*)(lds + LDS_BYTES - 12);
    int G = 0, g = 0, nb = 1;
#pragma unroll
    for (int j = 0; j < 16; ++j) { const unsigned c = __builtin_amdgcn_readfirstlane(__hip_atomic_load(ctl + j, __ATOMIC_RELAXED, __HIP_MEMORY_SCOPE_AGENT)); if (c > 0u) { if ((unsigned)j < myx) ++g; ++G; } if ((unsigned)j == myx) nb = (int)c; }
    const int tstep = nb * NWAVES, tfirst = (int)mybi * NWAVES + wid;
    const int nvis_t = (tfirst < NT) ? (NT - tfirst + tstep - 1) / tstep : 0;
    const int nrange = (EXU_NR - g + G - 1) / G;
    const int nvis = nvis_t * nrange;
    const int* hsv = (const int*)(p.ws + WS_HS);
    unsigned ne0 = 0u, ne1 = 0u; u32x4 nhv[8]; float nsh = 0.f; int nhs = 0;
#define EXU_FETCH(v_) do { const int tt_ = tfirst + ((v_) % nvis_t) * tstep; ne0 = pe[(size_t)tt_ * 128 + lane]; ne1 = pe[(size_t)tt_ * 128 + 64 + lane]; \
        _Pragma("unroll") for (int m = 0; m < 8; ++m) nhv[m] = *(const u32x4*)(h8 + (size_t)tt_ * DM + (BITS == 8 ? 256 * m + 16 * sub : 512 * (m >> 1) + 32 * sub + 16 * (m & 1))); nsh = shv[tt_]; if (BITS == 4) nhs = hsv[tt_]; } while (0)
    if (nvis > 0) EXU_FETCH(0);
    for (int v = 0; v < nvis; ++v) {
        const int t = tfirst + (v % nvis_t) * tstep, r = g + (v / nvis_t) * G;
        const unsigned e0 = ne0, e1 = ne1; const float sht = nsh; const int hs8 = 8 * nhs;
        u32x4 hv[8];
#pragma unroll
        for (int m = 0; m < 8; ++m) hv[m] = nhv[m];
        if (v + 1 < nvis) EXU_FETCH(v + 1);
        const bool in0 = (int)(e0 >> EXU_SH) == r, in1 = (int)(e1 >> EXU_SH) == r;
        const unsigned long long m0 = __ballot(in0), m1 = __ballot(in1);
        const int n0 = __builtin_popcountll(m0), n = n0 + __builtin_popcountll(m1);
        if (n == 0) continue;
        LAS unsigned* wl = (LAS unsigned*)(lds + wid * 1024 + (v & 1) * 512);
        const unsigned long long below = (1ull << lane) - 1ull;
        if (in0) wl[__builtin_popcountll(m0 & below)] = ((unsigned)lane << 16) | e0;
        if (in1) wl[n0 + __builtin_popcountll(m1 & below)] = ((unsigned)(lane + 64) << 16) | e1;
        __builtin_amdgcn_wave_barrier();
        constexpr int PPI = 4;
        const int nit = (n + PPI - 1) / PPI;
        if (BITS == 4) {
            unsigned ge[2]; float gsu[2], gsv[2], gpg[2]; int grs[2];
#pragma unroll
            for (int c = 0; c < 2; ++c) { const int idx = (c * 16 + sub) * PPI + qd; ge[c] = wl[idx < n ? idx : 0]; gsu[c] = su[ge[c] & 0xffffu]; gsv[c] = sv[ge[c] & 0xffffu]; grs[c] = rs[ge[c] & 0xffffu]; gpg[c] = pg[(size_t)t * 128 + (ge[c] >> 16)]; }
            u32x4 wr[6][4]; int dk0 = 0, dk1 = 0;
#define EXU4_ISSUE(B_, it_) do { const int idx_ = (it_) * PPI + qd; const unsigned e_ = wl[idx_ < n ? idx_ : 0] & 0xffffu; \
                const unsigned char* row_ = u8 + (size_t)e_ * (DM / 2) + 16 * sub; \
                _Pragma("unroll") for (int m = 0; m < 4; ++m) wr[B_][m] = *(const u32x4*)(row_ + 256 * m); } while (0)
#define EXU4_COMPUTE(B_, it_) do { unsigned dl_ = 0u, dh_ = 0u; \
                _Pragma("unroll") for (int m = 0; m < 4; ++m) { const u32x4 w_ = wr[B_][m]; const u32x4 la_ = hv[2 * m], ha_ = hv[2 * m + 1];     \
                    dl_ = __builtin_amdgcn_udot8(la_.x, w_.x, dl_, false); dh_ = __builtin_amdgcn_udot8(ha_.x, w_.x, dh_, false); \
                    dl_ = __builtin_amdgcn_udot8(la_.y, w_.y, dl_, false); dh_ = __builtin_amdgcn_udot8(ha_.y, w_.y, dh_, false); \
                    dl_ = __builtin_amdgcn_udot8(la_.z, w_.z, dl_, false); dh_ = __builtin_amdgcn_udot8(ha_.z, w_.z, dh_, false); \
                    dl_ = __builtin_amdgcn_udot8(la_.w, w_.w, dl_, false); dh_ = __builtin_amdgcn_udot8(ha_.w, w_.w, dh_, false); } \
                int d_ = (int)(dl_ + (dh_ << 4)); \
                d_ = row16_sum(d_); \
                { const bool mine_ = sub == ((it_) & 15); if ((it_) < 16) dk0 = mine_ ? d_ : dk0; else dk1 = mine_ ? d_ : dk1; } } while (0)
            for (int it = 0; it < nit; it += 6) {
                EXU4_ISSUE(0, it);
                if (it + 1 < nit) EXU4_ISSUE(1, it + 1);
                if (it + 2 < nit) EXU4_ISSUE(2, it + 2);
                if (it + 3 < nit) EXU4_ISSUE(3, it + 3);
                if (it + 4 < nit) EXU4_ISSUE(4, it + 4);
                if (it + 5 < nit) EXU4_ISSUE(5, it + 5);
                EXU4_COMPUTE(0, it);
                if (it + 1 < nit) EXU4_COMPUTE(1, it + 1);
                if (it + 2 < nit) EXU4_COMPUTE(2, it + 2);
                if (it + 3 < nit) EXU4_COMPUTE(3, it + 3);
                if (it + 4 < nit) EXU4_COMPUTE(4, it + 4);
                if (it + 5 < nit) EXU4_COMPUTE(5, it + 5);
            }
#undef EXU4_ISSUE
#undef EXU4_COMPUTE
#pragma unroll
            for (int c = 0; c < 2; ++c) {
                const int idx = (c * 16 + sub) * PPI + qd;
                if (idx < n) {
                    const unsigned j_ = ge[c] >> 16, e_ = ge[c] & 0xffffu;
                    const float dd_ = (float)((c ? dk1 : dk0) - hs8 - 128 * grs[c]) * gsu[c] * sht;
                    const float coef_ = gpg[c] * gsv[c] * gelu_as(dd_) * 16384.f;
                    const int ci_ = (int)rintf(fminf(fmaxf(coef_, -32767.f), 32767.f));
                    unsigned short* l16_ = (unsigned short*)list + (((size_t)(j_ >> 2) * NT + t) * 4 + ((j_ >> 1) & 1u) * 2) * 2 + (j_ & 1u);
                    l16_[0] = (unsigned short)ci_; l16_[2] = (unsigned short)e_;
                }
            }
            continue;
        }
        constexpr int PPQ = PPI / 4, NLD = (BITS == 8) ? 8 : 4;
        u32x4 wb[2][8]; unsigned entb[2][PPQ]; float sub_[2][PPQ], svb_[2][PPQ], pgb_[2][PPQ];
#define EXU_ISSUE(B_, it_) do { _Pragma("unroll") for (int pp = 0; pp < PPQ; ++pp) { const int idx_ = (it_) * PPI + qd * PPQ + pp; entb[B_][pp] = wl[idx_ < n ? idx_ : 0]; \
            sub_[B_][pp] = su[entb[B_][pp] & 0xffffu]; svb_[B_][pp] = sv[entb[B_][pp] & 0xffffu]; pgb_[B_][pp] = pg[(size_t)t * 128 + (entb[B_][pp] >> 16)]; \
            const unsigned char* row_ = u8 + (size_t)(entb[B_][pp] & 0xffffu) * (BITS == 8 ? DM : DM / 2) + 16 * sub; \
            _Pragma("unroll") for (int m = 0; m < NLD; ++m) wb[B_][pp * NLD + m] = *(const u32x4*)(row_ + 256 * m); } } while (0)
#define EXU_COMPUTE(B_, it_) do { _Pragma("unroll") for (int pp = 0; pp < PPQ; ++pp) { int d_ = 0; \
            if (BITS == 8) { \
            _Pragma("unroll") for (int m = 0; m < 8; ++m) { const u32x4 w_ = wb[B_][m]; \
                d_ = __builtin_amdgcn_sdot4((int)hv[m].x, (int)w_.x, d_, false); d_ = __builtin_amdgcn_sdot4((int)hv[m].y, (int)w_.y, d_, false); \
                d_ = __builtin_amdgcn_sdot4((int)hv[m].z, (int)w_.z, d_, false); d_ = __builtin_amdgcn_sdot4((int)hv[m].w, (int)w_.w, d_, false); } \
            } else { \
            _Pragma("unroll") for (int m = 0; m < 4; ++m) { const u32x4 w_ = wb[B_][pp * 4 + m]; const u32x4 ha_ = hv[2 * m], hb_ = hv[2 * m + 1]; \
                d_ = __builtin_amdgcn_sdot4((int)ha_.x, (int)(w_.x & 0x0F0F0F0Fu), d_, false); d_ = __builtin_amdgcn_sdot4((int)ha_.y, (int)((w_.x >> 4) & 0x0F0F0F0Fu), d_, false); \
                d_ = __builtin_amdgcn_sdot4((int)ha_.z, (int)(w_.y & 0x0F0F0F0Fu), d_, false); d_ = __builtin_amdgcn_sdot4((int)ha_.w, (int)((w_.y >> 4) & 0x0F0F0F0Fu), d_, false); \
                d_ = __builtin_amdgcn_sdot4((int)hb_.x, (int)(w_.z & 0x0F0F0F0Fu), d_, false); d_ = __builtin_amdgcn_sdot4((int)hb_.y, (int)((w_.z >> 4) & 0x0F0F0F0Fu), d_, false); \
                d_ = __builtin_amdgcn_sdot4((int)hb_.z, (int)(w_.w & 0x0F0F0F0Fu), d_, false); d_ = __builtin_amdgcn_sdot4((int)hb_.w, (int)((w_.w >> 4) & 0x0F0F0F0Fu), d_, false); } \
            } \
            d_ = row16_sum(d_); \
            if (BITS == 4) d_ -= hs8; \
            if (((it_) * PPI + qd * PPQ + pp < n) && sub == 0) { \
                const unsigned ent_ = entb[B_][pp], j_ = ent_ >> 16, e_ = ent_ & 0xffffu; \
                const float dd_ = (float)d_ * sub_[B_][pp] * sht; \
                const float act_ = gelu_as(dd_); \
                const float coef_ = pgb_[B_][pp] * svb_[B_][pp] * act_ * 16384.f; \
                const int ci_ = (int)rintf(fminf(fmaxf(coef_, -32767.f), 32767.f)); \
                unsigned short* l16_ = (unsigned short*)list + (((size_t)(j_ >> 2) * NT + t) * 4 + ((j_ >> 1) & 1u) * 2) * 2 + (j_ & 1u); \
                l16_[0] = (unsigned short)ci_; l16_[2] = (unsigned short)e_; } } } while (0)
        EXU_ISSUE(0, 0);
        int it = 0;
        for (; it + 2 < nit; it += 2) {
            EXU_ISSUE(1, it + 1); EXU_COMPUTE(0, it);
            EXU_ISSUE(0, it + 2); EXU_COMPUTE(1, it + 1);
        }
        if (it + 2 == nit) { EXU_ISSUE(1, it + 1); EXU_COMPUTE(0, it); EXU_COMPUTE(1, it + 1); }
        else { EXU_COMPUTE(0, it); }
#undef EXU_ISSUE
#undef EXU_COMPUTE
    }
#undef EXU_FETCH
}

__device__ __forceinline__ void phase_exv(const Params& p, LAS unsigned char* lds, const f16* x1, const float* gate2, const unsigned char* v8c, f16* xout) {
    const int tid = otid();
    const u32x4* list = (const u32x4*)(p.ws + WS_LIST);
    int cfirst = obid(), cstep = gridDim.x;
    {
        const unsigned* ctl = (const unsigned*)(p.ws + WS_CTL);
        const unsigned myx = *(const LAS unsigned*)(lds + LDS_BYTES - 16), mybi = *(const LAS unsigned*)(lds + LDS_BYTES - 12);
        int G = 0, g = 0, nb = 1; bool uniform = true; unsigned c0 = 0u;
        unsigned cc[16];
#pragma unroll
        for (int j = 0; j < 16; ++j) cc[j] = __hip_atomic_load(ctl + j, __ATOMIC_RELAXED, __HIP_MEMORY_SCOPE_AGENT);
        __builtin_amdgcn_sched_barrier(0);
#pragma unroll
        for (int j = 0; j < 16; ++j) { const unsigned c = __builtin_amdgcn_readfirstlane(cc[j]); if (c > 0u) { if ((unsigned)j < myx) ++g; ++G; if (c0 == 0u) c0 = c; else if (c != c0) uniform = false; } if ((unsigned)j == myx) nb = (int)c; }
        if (uniform && G * nb == (int)gridDim.x && (int)gridDim.x == 256) { cfirst = g * nb + (int)mybi; cstep = 256; }
    }
    for (int wu = cfirst; wu < 256; wu += cstep) {
        const int c = wu >> 1, half = wu & 1;
        __syncthreads();
        {
            const u32x4* src = (const u32x4*)(v8c + (size_t)c * PEXP * 8);
            u32x4 tb[16];
#pragma unroll
            for (int i = 0; i < 16; ++i) tb[i] = src[i * 512 + tid];
            __builtin_amdgcn_sched_barrier(0);
#pragma unroll
            for (int i = 0; i < 16; ++i) *(LAS u32x4*)(lds + (size_t)(i * 512 + tid) * 16) = tb[i];
        }
        __syncthreads();
        typedef short s2_t __attribute__((ext_vector_type(2)));
        u32x4 wq[2][8];
        int accm[8], acce[8]; int csum = 0;
#pragma unroll
        for (int k = 0; k < 8; ++k) { accm[k] = 0; acce[k] = 0; }
        constexpr int NTOK = NT / NTHREADS / 2;
        constexpr int NBATCH = NTOK * 4;
        const int tbase = tid + half * NTOK * NTHREADS;
#define EXV_LOAD(B_, q_) do { const int qq_ = (q_) < NBATCH ? (q_) : NBATCH - 1; const int t_ = tbase + (qq_ >> 2) * NTHREADS, jb_ = qq_ & 3; \
            _Pragma("unroll") for (int j4 = 0; j4 < 8; ++j4) wq[B_][j4] = list[(size_t)(jb_ * 8 + j4) * NT + t_]; } while (0)
        EXV_LOAD(0, 0);
        u32x2 tv[4][2];
#define EXV_READ(S_, eb_) do { unsigned a0_, a1_; \
            asm("v_lshlrev_b32_sdwa %0, %1, %2 dst_sel:DWORD dst_unused:UNUSED_PAD src0_sel:DWORD src1_sel:WORD_0" : "=v"(a0_) : "v"(3u), "v"(eb_)); \
            asm("v_lshlrev_b32_sdwa %0, %1, %2 dst_sel:DWORD dst_unused:UNUSED_PAD src0_sel:DWORD src1_sel:WORD_1" : "=v"(a1_) : "v"(3u), "v"(eb_)); \
            tv[S_][0] = *(const LAS u32x2*)(size_t)a0_; tv[S_][1] = *(const LAS u32x2*)(size_t)a1_; } while (0)
        EXV_READ(0, wq[0][0].y); EXV_READ(1, wq[0][0].w);
#pragma unroll 1
        for (int q0 = 0; q0 < NBATCH; q0 += 4) {
#pragma unroll
            for (int u = 0; u < 4; ++u) {
                const int q = q0 + u;
                if (q < NBATCH) {
                    EXV_LOAD((u + 1) % 2, q + 1);
#pragma unroll
                    for (int pi = 0; pi < 16; ++pi) {
                        const int j4 = pi >> 1, h = pi & 1;
                        if (pi < 14) { const u32x4 nw = wq[u % 2][(pi + 2) >> 1]; EXV_READ((pi + 2) & 3, ((pi & 1) ? nw.w : nw.y)); }
                        else { const u32x4 nw = wq[(u + 1) % 2][0]; EXV_READ((pi + 2) & 3, ((pi & 1) ? nw.w : nw.y)); }
                        __builtin_amdgcn_sched_barrier(0);
                        const unsigned ca = h ? wq[u % 2][j4].z : wq[u % 2][j4].x;
                        const u32x2 v0 = tv[pi & 3][0], v1 = tv[pi & 3][1];
                        const s2_t cp = __builtin_bit_cast(s2_t, ca);
                        csum = __builtin_amdgcn_sdot2(cp, __builtin_bit_cast(s2_t, 0x00010001u), csum, false);
#define EXV_BYTE(K_, V1_, V0_, SEL_) do { const unsigned pm_ = __builtin_amdgcn_perm(V1_, V0_, SEL_); \
                            accm[K_] = __builtin_amdgcn_sdot2(cp, __builtin_bit_cast(s2_t, pm_), accm[K_], false); \
                            acce[K_] = __builtin_amdgcn_sdot2(cp, __builtin_bit_cast(s2_t, pm_ & 0x000F000Fu), acce[K_], false); } while (0)
                        EXV_BYTE(0, v1.x, v0.x, 0x0c040c00u); EXV_BYTE(1, v1.x, v0.x, 0x0c050c01u); EXV_BYTE(2, v1.x, v0.x, 0x0c060c02u); EXV_BYTE(3, v1.x, v0.x, 0x0c070c03u);
                        EXV_BYTE(4, v1.y, v0.y, 0x0c040c00u); EXV_BYTE(5, v1.y, v0.y, 0x0c050c01u); EXV_BYTE(6, v1.y, v0.y, 0x0c060c02u); EXV_BYTE(7, v1.y, v0.y, 0x0c070c03u);
#undef EXV_BYTE
                        __builtin_amdgcn_sched_barrier(0);
                    }
                    if ((u & 3) == 3) {
                        const int t = tbase + (q >> 2) * NTHREADS;
                        const int b = t / SEQ, col = 16 * c;
                        const int off = csum << 3;
                        float val[16];
#pragma unroll
                        for (int k = 0; k < 8; ++k) { val[2 * k] = (float)(acce[k] - off) * (1.f / 16384.f); val[2 * k + 1] = (float)(((accm[k] - acce[k]) >> 4) - off) * (1.f / 16384.f); }
#pragma unroll
                        for (int hv2 = 0; hv2 < 2; ++hv2) {
                            const u32x4 xw = *(const u32x4*)(x1 + (size_t)t * DM + col + 8 * hv2);
                            const f32x4 g0 = *(const f32x4*)(gate2 + (size_t)b * 6 * DM + col + 8 * hv2), g1 = *(const f32x4*)(gate2 + (size_t)b * 6 * DM + col + 8 * hv2 + 4);
                            u32x4 ow;
                            ow.x = pack_h2(h_lo(xw.x) + g0[0] * val[8 * hv2 + 0], h_hi(xw.x) + g0[1] * val[8 * hv2 + 1]);
                            ow.y = pack_h2(h_lo(xw.y) + g0[2] * val[8 * hv2 + 2], h_hi(xw.y) + g0[3] * val[8 * hv2 + 3]);
                            ow.z = pack_h2(h_lo(xw.z) + g1[0] * val[8 * hv2 + 4], h_hi(xw.z) + g1[1] * val[8 * hv2 + 5]);
                            ow.w = pack_h2(h_lo(xw.w) + g1[2] * val[8 * hv2 + 6], h_hi(xw.w) + g1[3] * val[8 * hv2 + 7]);
                            *(u32x4*)(xout + (size_t)t * DM + col + 8 * hv2) = ow;
                        }
                        csum = 0;
#pragma unroll
                        for (int k = 0; k < 8; ++k) { accm[k] = 0; acce[k] = 0; }
                    }
                }
            }
        }
#undef EXV_LOAD
#undef EXV_READ
    }
}


#define XB_TMO      128
#define XB_XCNT(j)  (256  + 64 * (j))
#define XB_XSUB(j)  (1280 + 64 * (j))
#define XB_XGEN(j)  (2304 + 64 * (j))
#define XB_TOP      3328
#define XB_TOPGEN   3392
#define XCD_BAR_WORDS 3456
#define XB_SPIN_CAP (1u << 22)
__device__ __forceinline__ unsigned xb_ld(unsigned* p) { return __hip_atomic_load(p, __ATOMIC_RELAXED, __HIP_MEMORY_SCOPE_AGENT); }
__device__ __forceinline__ unsigned xb_add(unsigned* p, unsigned v) { return __hip_atomic_fetch_add(p, v, __ATOMIC_RELAXED, __HIP_MEMORY_SCOPE_AGENT); }
#define XB_SPIN(cond, bar) do { unsigned _sp = 0; while (cond) { __builtin_amdgcn_s_sleep(1); \
    if ((++_sp & 255u) == 0u) { if (xb_ld(&(bar)[XB_TMO])) break; if (_sp > XB_SPIN_CAP) { atomicAdd(&(bar)[XB_TMO], 1u); break; } } } } while (0)
struct XcdBarrier { unsigned* bar; unsigned x; volatile LAS unsigned* st; };
__device__ __forceinline__ void xcd_barrier_complete(unsigned* bar, unsigned x, unsigned& nloc, unsigned& nx) {
    const unsigned G = gridDim.x * gridDim.y * gridDim.z;
    unsigned sum, cnt, mine, sp = 0u;
    for (;;) {
        sum = 0u; cnt = 0u; mine = 0u;
#pragma unroll
        for (unsigned j = 0; j < 16; ++j) { const unsigned c = xb_ld(&bar[XB_XCNT(j)]); sum += c; cnt += (c > 0u) ? 1u : 0u; mine = (j == x) ? c : mine; }
        if (sum == G) break;
        __builtin_amdgcn_s_sleep(1);
        if ((++sp & 255u) == 0u) { if (xb_ld(&bar[XB_TMO])) break; if (sp > XB_SPIN_CAP) { atomicAdd(&bar[XB_TMO], 1u); break; } }
    }
    nloc = mine > 0u ? mine : 1u; nx = cnt > 0u ? cnt : 1u;
}
__device__ __forceinline__ void xcd_barrier(const XcdBarrier& b) {
    asm volatile("s_waitcnt vmcnt(0)" ::: "memory");
    __syncthreads();
    if (threadIdx.x == 0) {
        unsigned* bar = b.bar;
        __builtin_amdgcn_s_waitcnt(0);
        unsigned nloc = b.st[0], nx = b.st[1];
        if (nloc == 0u) { xcd_barrier_complete(bar, b.x, nloc, nx); b.st[0] = nloc; b.st[1] = nx; }
        const unsigned old = xb_add(&bar[XB_XSUB(b.x)], 1u);
        const unsigned gen = old / nloc;
        if (old + 1u == (gen + 1u) * nloc) {
            __builtin_amdgcn_fence(__ATOMIC_RELEASE, "agent");
            asm volatile("s_waitcnt vmcnt(0)" ::: "memory");
            const unsigned og = xb_add(&bar[XB_TOP], 1u);
            const unsigned tg = og / nx;
            if (og + 1u == (tg + 1u) * nx) xb_add(&bar[XB_TOPGEN], 1u);
            else XB_SPIN(xb_ld(&bar[XB_TOPGEN]) == tg, bar);
            __builtin_amdgcn_fence(__ATOMIC_ACQUIRE, "agent");
            xb_add(&bar[XB_XGEN(b.x)], 1u);
            asm volatile("s_waitcnt vmcnt(0)" ::: "memory");
        } else {
            XB_SPIN(xb_ld(&bar[XB_XGEN(b.x)]) == gen, bar);
            __builtin_amdgcn_fence(__ATOMIC_ACQUIRE, "agent");
            asm volatile("s_waitcnt vmcnt(0)" ::: "memory");
        }
    }
    __syncthreads();
}

constexpr int PH_CONV = 0, PH_N1 = 1, PH_L0 = 2, PH_PER_LAYER = 10, PH_TOTAL = PH_L0 + DEPTH * PH_PER_LAYER;

__global__ void __launch_bounds__(NTHREADS, 2) mega(Params p_arg) {
    extern __shared__ __attribute__((aligned(16))) unsigned char shm[];
    LAS unsigned char* lds = (LAS unsigned char*)shm;
    typedef const Params __attribute__((address_space(4)))* KP;
    const int ph_lo = p_arg.ph_lo, ph_hi = p_arg.ph_hi;
    if (threadIdx.x == 0) {
        const unsigned x = xcc_id();
        const unsigned bi = __hip_atomic_fetch_add((unsigned*)(p_arg.ws + WS_CTL) + x, 1u, __ATOMIC_RELAXED, __HIP_MEMORY_SCOPE_AGENT);
        *(LAS unsigned*)(lds + LDS_BYTES - 16) = x; *(LAS unsigned*)(lds + LDS_BYTES - 12) = bi;
        *(LAS unsigned*)(lds + LDS_BYTES - 32) = 0u; *(LAS unsigned*)(lds + LDS_BYTES - 28) = 0u;
        (void)xb_add((unsigned*)(p_arg.ws + WS_CTL + 256) + XB_XCNT(x), 1u);
    }
    __syncthreads();
    XcdBarrier xbar; xbar.bar = (unsigned*)(p_arg.ws + WS_CTL + 256); xbar.x = *(const LAS unsigned*)(lds + LDS_BYTES - 16); xbar.st = (volatile LAS unsigned*)(lds + LDS_BYTES - 32);
#ifndef PMASK
#define PMASK 0xff
#endif
#define EN(k) ((PMASK >> (k)) & 1)
    for (int ph = ph_lo; ph < ph_hi; ++ph) {
        KP kp = (KP)__builtin_amdgcn_kernarg_segment_ptr();
        asm volatile("" : "+s"(kp));
#if defined(__HIP_DEVICE_COMPILE__)
        const Params p = *kp;
#else
        const Params p = p_arg;
#endif
        unsigned char* ws = p.ws;
        const float* mod = (const float*)(ws + WS_MOD);
        int kind, l = 0, s = -1;
        if (ph == PH_CONV) kind = 0;
        else if (ph == PH_N1) kind = 1;
        else {
            l = (ph - PH_L0) / PH_PER_LAYER; s = (ph - PH_L0) % PH_PER_LAYER;
            kind = (s == 0 || s == 3 || s == 5) ? 2 : (s == 1 ? 4 : (s == 2 ? 5 : (s == 4 ? 1 : (s == 6 ? 6 : (s == 7 ? 7 : (s == 8 ? 8 : 9))))));
        }
        const float* modl = mod + (size_t)l * NB * 6 * DM;
        f16* x1 = (f16*)(ws + WS_X1); f16* x2 = (f16*)(ws + WS_X2);
#ifndef REPEAT_KIND
#define REPEAT_KIND -1
#endif
        for (int rep = 0; rep < ((kind == REPEAT_KIND) ? 2 : 1); ++rep) {
        if (rep == 1) xcd_barrier(xbar);
        if (kind == 0) { if (EN(0)) phase_conv(p, lds); }
        else if (kind == 1) {
            if (EN(1)) {
                if (s < 0) phase_norm2<0, false>(p.x, nullptr, (float*)x2, p.n1g, mod + 0 * DM, mod + 1 * DM, (f16*)(ws + WS_H), nullptr, nullptr);
                else phase_norm2<1, true>(nullptr, x1, nullptr, p.n2g + (size_t)l * DM, modl + 3 * DM, modl + 4 * DM, (f16*)(ws + WS_H), (unsigned*)(ws + WS_H8), (float*)(ws + WS_SH));
            }
        } else if (kind == 2) {
            if (EN(2)) {
                Epi E{}; const f16* A; const f16* Bt; int N;
                if (s == 0) { E.mode = 2; E.rope128 = (const float*)(ws + WS_ROPE128); E.rope64 = (const float*)(ws + WS_ROPE64); E.o16 = (f16*)(ws + WS_PROJ); E.ldc = INWP; A = (const f16*)(ws + WS_H); Bt = (const f16*)(ws + WS_WTIN) + (size_t)l * INWP * DM; N = INWP; }
                else if (s == 3) { E.mode = 1; E.o16 = x1; E.xin = p.x; E.xinh = x2;                    E.gate = modl + 2 * DM; A = (const f16*)(ws + WS_Y); Bt = (const f16*)(ws + WS_WTOUT) + (size_t)l * DM * DM; N = DM; }
                else { E.mode = 0; E.o16 = (f16*)(ws + WS_Y); E.ldc = DM; A = (const f16*)(ws + WS_H); Bt = (const f16*)(ws + WS_WTQ) + (size_t)l * DM * DM; N = DM; }
                gemm_run(p, lds, A, Bt, N, E, s == 5 && (int)gridDim.x == 256);
            }
        }
        else if (kind == 4) { if (EN(4)) phase_index2(p, lds); }
        else if (kind == 5) { if (EN(5)) phase_attn2(p, lds, p.ong + (size_t)l * DM, (unsigned*)(ws + WS_CTL + 64), l); }
        else if (kind == 6) { if (EN(6)) phase_route2(p, lds, (const f16*)(ws + WS_SUBK) + (size_t)l * PH * 2 * PNK * 128); }
        else if (kind == 7) {
            if (EN(7)) { if (LAST_BITS == 4) phase_exu<4>(p, lds, ws + WS_U8 + (size_t)l * PEXP * DM, (const float*)(ws + WS_SU) + (size_t)l * PEXP, (const float*)(ws + WS_SV) + (size_t)l * PEXP, (const int*)(ws + WS_RS) + (size_t)l * PEXP);
                         else phase_exu<8>(p, lds, ws + WS_U8 + (size_t)l * PEXP * DM, (const float*)(ws + WS_SU) + (size_t)l * PEXP, (const float*)(ws + WS_SV) + (size_t)l * PEXP, (const int*)(ws + WS_RS) + (size_t)l * PEXP); }
        } else if (kind == 8) {
            if (EN(7)) phase_exv(p, lds, x1, modl + 5 * DM, ws + WS_V8 + (size_t)l * PEXP * DM / 2, x2);
        } else {
            const bool fin = (l == DEPTH - 1);
            const float* modn = mod + (size_t)(fin ? l : l + 1) * NB * 6 * DM;
            if (EN(1)) { if (fin) phase_norm2<2, true>(nullptr, x2, p.out, p.fg, nullptr, nullptr, nullptr, nullptr, nullptr);
                         else phase_norm2<0, true>(nullptr, x2, nullptr, p.n1g + (size_t)(l + 1) * DM, modn + 0 * DM, modn + 1 * DM, (f16*)(ws + WS_H), nullptr, nullptr); }
        }
        }
        if (ph + 1 < ph_hi) { if (ph >= PH_L0 && s == 5 && (int)gridDim.x == 256) __syncthreads(); else { if (ph_hi > (1 << 20)) cg::this_grid().sync(); xcd_barrier(xbar); } }
    }
}

extern "C" void kernel_launch(void* const* d_in, const int* in_sizes, int n_in, void* d_out, int out_size, void* d_ws, size_t ws_size, hipStream_t stream) {
    static int grid = 0;
    if (grid == 0) {
        if (n_in != 14 || out_size != NT * DM || ws_size < WS_END) { fprintf(stderr, "kernel_launch: unexpected sizes (n_in %d out %d ws %zu need %zu)\n", n_in, out_size, ws_size, (size_t)WS_END); grid = -1; return; }
        if (hipFuncSetAttribute((const void*)mega, hipFuncAttributeMaxDynamicSharedMemorySize, LDS_BYTES) != hipSuccess) { fprintf(stderr, "kernel_launch: hipFuncSetAttribute failed\n"); grid = -1; return; }
        int dev = 0, cus = 0, per_cu = 0;
        hipGetDevice(&dev); hipDeviceGetAttribute(&cus, hipDeviceAttributeMultiprocessorCount, dev);
        hipOccupancyMaxActiveBlocksPerMultiprocessor(&per_cu, (const void*)mega, NTHREADS, LDS_BYTES);
        if (per_cu < 1) { fprintf(stderr, "kernel_launch: occupancy query says %d blocks per CU\n", per_cu); grid = -1; return; }
        grid = cus;
    }
    if (grid < 0) return;
    Params p{};
    p.x = (const float*)d_in[0]; p.c = (const float*)d_in[1]; p.ada_w = (const float*)d_in[2]; p.ada_b = (const float*)d_in[3];
    p.n1g = (const float*)d_in[4]; p.n2g = (const float*)d_in[5]; p.w_in = (const float*)d_in[6]; p.ong = (const float*)d_in[7];
    p.w_out = (const float*)d_in[8]; p.wq = (const float*)d_in[9]; p.subk = (const float*)d_in[10]; p.pu = (const float*)d_in[11];
    p.pv = (const float*)d_in[12]; p.fg = (const float*)d_in[13];
    p.out = (float*)d_out; p.ws = (unsigned char*)d_ws;
#if 0
    for (int ph = 0; ph < PH_TOTAL; ++ph) {
        p.ph_lo = ph; p.ph_hi = ph + 1;
        hipLaunchKernelGGL(mega, dim3(grid), dim3(NTHREADS), LDS_BYTES, stream, p);
    }
#else
    p.ph_lo = 0; p.ph_hi = PH_TOTAL;
    if (hipMemsetAsync((char*)d_ws + WS_CTL, 0, CTL_BYTES, stream) != hipSuccess) { fprintf(stderr, "kernel_launch: memset of control words failed\n"); return; }
    void* args[] = {&p};
    hipError_t e = hipLaunchCooperativeKernel((const void*)mega, dim3(grid), dim3(NTHREADS), args, LDS_BYTES, stream);
    if (e != hipSuccess) fprintf(stderr, "cooperative launch failed: %s (grid %d)\n", hipGetErrorString(e), grid);
#endif
}
```
